# Optimizing an MI355X kernel written in HIP

```python
import math
import jax
import jax.numpy as jnp
from jax import lax
import numpy as np

D_MODEL = 2048
BATCH = 1
SEQ = 8192
DEPTH = 2

HY_WIDTH = D_MODEL // 2
HY_ORDER = 2
FILT_EMB = 33
FILT_BANDS = (FILT_EMB - 1) // 2
FILT_HIDDEN = 64
MIN_DECAY = math.log(1e-2) / 1.5
MAX_DECAY = math.log(1e-2) / 0.3
SG_CHUNK = 128
SG_GROUPS = 8
SG_WIDTH = D_MODEL // 2
SG_HEAD_DIM = SG_WIDTH // SG_GROUPS
N_HY_COLS = 3 * HY_WIDTH
N_SG_COLS = 2 * SG_WIDTH
N_GATE_COLS = 2 * D_MODEL
N_IN = N_HY_COLS + N_SG_COLS + N_GATE_COLS
N_EXPERT_GROUPS = 4
EXPERTS_PER_GROUP = 4
N_EXPERTS = N_EXPERT_GROUPS * EXPERTS_PER_GROUP
TOP_K_INNER = 2
D_EXPERT = D_MODEL // 4
EPS = 1e-6

kernel_name = 'hybrid_hyena_sgu_hmoe_encoder'


def rms_norm(x, g):
    xf = x.astype(jnp.float32)
    y = xf * lax.rsqrt(jnp.mean(xf * xf, axis=-1, keepdims=True) + EPS)
    return (y * g.astype(jnp.float32)).astype(x.dtype)


def hyena_filters(L, w1, b1, w2, b2, w3, freq):
    f32 = jnp.float32
    t = jnp.linspace(0.0, 1.0, L, dtype=f32)[:, None]
    bands = jnp.linspace(1e-4, FILT_BANDS - 1, FILT_BANDS, dtype=f32)
    w = (2.0 * math.pi / L) * jnp.arange(L, dtype=f32)[:, None]
    z = jnp.concatenate([t, jnp.cos(bands * w), -jnp.sin(bands * w)], axis=-1)
    fr = freq.astype(f32)
    a = jnp.sin(fr * (z @ w1.astype(f32) + b1.astype(f32)))
    a = jnp.sin(fr * (a @ w2.astype(f32) + b2.astype(f32)))
    h = (a @ w3.astype(f32)).reshape(L, 2, HY_ORDER, HY_WIDTH)
    deltas = jnp.abs(jnp.linspace(MIN_DECAY, MAX_DECAY, HY_WIDTH, dtype=f32))
    h = h * jnp.exp(-t * deltas)[:, None, None, :]
    fwd, bwd = h[:, 0], h[:, 1]
    fwd = fwd.at[0].add(bwd[0])
    return jnp.concatenate([fwd, jnp.zeros_like(fwd[:1]), bwd[:0:-1]], axis=0)


def hyena_mixer(z, conv_w, conv_b, k_circ, skip):
    L = z.shape[1]
    zp = jnp.pad(z, ((0, 0), (1, 1), (0, 0)))
    zc = conv_w[0] * zp[:, :-2] + conv_w[1] * zp[:, 1:-1] + conv_w[2] * zp[:, 2:] + conv_b
    x1, x2, v = jnp.split(zc.astype(jnp.float32), 3, axis=-1)
    k_f = jnp.fft.rfft(k_circ, axis=0)
    sk = skip.astype(jnp.float32)

    def long_conv(u, o):
        u_f = jnp.fft.rfft(u, n=2 * L, axis=1)
        y = jnp.fft.irfft(u_f * k_f[None, :, o], n=2 * L, axis=1)[:, :L]
        return y + u * sk[o]

    z1 = x1 * long_conv(v, 0)
    y = x2 * long_conv(z1, 1)
    return y.astype(z.dtype)


def spatial_gating(zu, zv, ln_g, ln_b, w_s, b_s):
    B, L, _ = zu.shape
    u = jax.nn.gelu(zu, approximate=False)
    v = jax.nn.gelu(zv.astype(jnp.float32), approximate=False)
    mu = jnp.mean(v, axis=-1, keepdims=True)
    var = jnp.mean(jnp.square(v - mu), axis=-1, keepdims=True)
    v = ((v - mu) * lax.rsqrt(var + EPS) * ln_g + ln_b).astype(zu.dtype)
    vc = v.reshape(B, L // SG_CHUNK, SG_CHUNK, SG_GROUPS, SG_HEAD_DIM)
    mix = jnp.einsum('gts,bcsgk->bctgk', w_s, vc) + b_s.T[:, :, None]
    return u * mix.reshape(B, L, SG_WIDTH)


def hier_moe(h, w_rg, b_rg, w_re, b_re, w_gate, w_up, w_down):
    f32 = jnp.float32
    hf = h.astype(f32)
    p_grp = jax.nn.softmax(hf @ w_rg.astype(f32) + b_rg.astype(f32), axis=-1)
    grp = jnp.argmax(p_grp, axis=-1)
    p_sel = jnp.take_along_axis(p_grp, grp[..., None], axis=-1)
    le = jnp.einsum('bsd,gde->bsge', hf, w_re.astype(f32)) + b_re.astype(f32)
    le = jnp.take_along_axis(le, grp[..., None, None], axis=2)[..., 0, :]
    top_v, top_i = lax.top_k(le, TOP_K_INNER)
    wts = p_sel * jax.nn.softmax(top_v, axis=-1)
    eid = grp[..., None] * EXPERTS_PER_GROUP + top_i
    comb = jnp.einsum('bske,bsk->bse', jax.nn.one_hot(eid, N_EXPERTS, dtype=f32), wts).astype(h.dtype)
    act = jax.nn.silu(jnp.einsum('bsd,edf->bsef', h, w_gate)) * jnp.einsum('bsd,edf->bsef', h, w_up)
    return jnp.einsum('bsef,efd->bsd', act * comb[..., None], w_down)


def setup_inputs(seed: int = 0) -> dict:
    key = jax.random.key(seed)
    ks = jax.random.split(key, 32)
    f32 = jnp.float32

    def nrm(k, shape, s):
        return s * jax.random.normal(k, shape, f32)

    D = D_MODEL
    return {
        'x': nrm(ks[0], (BATCH, SEQ, D), 1.0),
        'g_mix': 1.0 + nrm(ks[1], (DEPTH, D), 0.05),
        'w_in': nrm(ks[2], (DEPTH, D, N_IN), D ** -0.5),
        'b_in': nrm(ks[3], (DEPTH, N_IN), 0.01),
        'conv_w': nrm(ks[4], (DEPTH, 3, N_HY_COLS), 3 ** -0.5),
        'conv_b': nrm(ks[5], (DEPTH, N_HY_COLS), 0.01),
        'filt_w1': nrm(ks[6], (DEPTH, FILT_EMB, FILT_HIDDEN), FILT_EMB ** -0.5),
        'filt_b1': nrm(ks[7], (DEPTH, FILT_HIDDEN), 0.1),
        'filt_w2': nrm(ks[8], (DEPTH, FILT_HIDDEN, FILT_HIDDEN), FILT_HIDDEN ** -0.5),
        'filt_b2': nrm(ks[9], (DEPTH, FILT_HIDDEN), 0.1),
        'filt_w3': nrm(ks[10], (DEPTH, FILT_HIDDEN, 2 * HY_ORDER * HY_WIDTH), 2.0 * (FILT_HIDDEN * SEQ) ** -0.5),
        'filt_freq': 1.0 + nrm(ks[11], (DEPTH, FILT_HIDDEN), 0.1),
        'hy_skip': 1.0 + nrm(ks[12], (DEPTH, HY_ORDER, HY_WIDTH), 0.1),
        'sg_ln_g': 1.0 + nrm(ks[13], (DEPTH, SG_WIDTH), 0.05),
        'sg_ln_b': nrm(ks[14], (DEPTH, SG_WIDTH), 0.01),
        'sg_w': nrm(ks[15], (DEPTH, SG_GROUPS, SG_CHUNK, SG_CHUNK), SG_CHUNK ** -0.5),
        'sg_b': 1.0 + nrm(ks[16], (DEPTH, SG_GROUPS, SG_CHUNK), 0.01),
        'w_hy_out': nrm(ks[17], (DEPTH, HY_WIDTH, D), HY_WIDTH ** -0.5),
        'w_sg_out': nrm(ks[18], (DEPTH, SG_WIDTH, D), SG_WIDTH ** -0.5),
        'w_out': nrm(ks[19], (DEPTH, D, D), D ** -0.5),
        'g_ffn': 1.0 + nrm(ks[20], (DEPTH, D), 0.05),
        'w_rg': nrm(ks[21], (DEPTH, D, N_EXPERT_GROUPS), D ** -0.5),
        'b_rg': nrm(ks[22], (DEPTH, N_EXPERT_GROUPS), 0.01),
        'w_re': nrm(ks[23], (DEPTH, N_EXPERT_GROUPS, D, EXPERTS_PER_GROUP), D ** -0.5),
        'b_re': nrm(ks[24], (DEPTH, N_EXPERT_GROUPS, EXPERTS_PER_GROUP), 0.01),
        'w_gate': nrm(ks[25], (DEPTH, N_EXPERTS, D, D_EXPERT), D ** -0.5),
        'w_up': nrm(ks[26], (DEPTH, N_EXPERTS, D, D_EXPERT), D ** -0.5),
        'w_down': nrm(ks[27], (DEPTH, N_EXPERTS, D_EXPERT, D), D_EXPERT ** -0.5),
        'g_final': 1.0 + nrm(ks[28], (D,), 0.05),
    }


def reference(x, g_mix, w_in, b_in, conv_w, conv_b, filt_w1, filt_b1, filt_w2, filt_b2, filt_w3,
              filt_freq, hy_skip, sg_ln_g, sg_ln_b, sg_w, sg_b, w_hy_out, w_sg_out, w_out, g_ffn,
              w_rg, b_rg, w_re, b_re, w_gate, w_up, w_down, g_final):
    L = x.shape[1]
    c_u = N_HY_COLS
    c_v = N_HY_COLS + SG_WIDTH
    c_g = N_HY_COLS + N_SG_COLS
    for i in range(DEPTH):
        xn = rms_norm(x, g_mix[i])
        zin = xn @ w_in[i] + b_in[i]
        z_hy = zin[..., :c_u]
        z_u = zin[..., c_u:c_v]
        z_v = zin[..., c_v:c_g]
        gate_hy = jax.nn.sigmoid(zin[..., c_g:c_g + D_MODEL])
        gate_sg = jax.nn.sigmoid(zin[..., c_g + D_MODEL:])
        k_circ = hyena_filters(L, filt_w1[i], filt_b1[i], filt_w2[i], filt_b2[i], filt_w3[i], filt_freq[i])
        y_hy = hyena_mixer(z_hy, conv_w[i], conv_b[i], k_circ, hy_skip[i])
        y_sg = spatial_gating(z_u, z_v, sg_ln_g[i], sg_ln_b[i], sg_w[i], sg_b[i])
        merged = gate_hy * (y_hy @ w_hy_out[i]) + gate_sg * (y_sg @ w_sg_out[i])
        x = x + merged @ w_out[i]
        x = x + hier_moe(rms_norm(x, g_ffn[i]), w_rg[i], b_rg[i], w_re[i], b_re[i],
                         w_gate[i], w_up[i], w_down[i])
    return rms_norm(x, g_final)
```

```cpp
#include <hip/hip_runtime.h>
#include <cstdio>
#include <cstdint>
#define MK_ONE_LAUNCH 0
namespace pg8 {
#define PG8_LAS __attribute__((address_space(3)))
typedef unsigned short bf16_t;
typedef short bf16x8 __attribute__((ext_vector_type(8)));
typedef float f32x4 __attribute__((ext_vector_type(4)));
typedef float f32x2 __attribute__((ext_vector_type(2)));
typedef unsigned u32x4 __attribute__((ext_vector_type(4)));
typedef unsigned u32x2 __attribute__((ext_vector_type(2)));
constexpr int BM = 256, BK = 64, HALF = 128, HTB = HALF * BK * 2  , STAGE_BYTES = 8 * HTB;

__host__ __device__ __forceinline__ int lds_byte(int r, int c) { const int st = (r >> 4) * 2 + (c >> 5), rr = r & 15, cc = c & 31, ob = rr * 64 + cc * 2; return st * 1024 + (ob ^ (((ob >> 9) & 1) << 5)); }
__host__ __device__ __forceinline__ void stage_rc(int b, int& R, int& C) { const int st = b / 1024, sb = b % 1024, swz = sb ^ (((sb >> 9) & 1) << 5); R = (st >> 1) * 16 + swz / 64; C = (st & 1) * 32 + (swz % 64) / 2; }
__host__ __device__ __forceinline__ int perm32(int rho) { const int n = rho >> 4, i = rho & 15; return 8 * (i >> 2) + 4 * n + (i & 3); }

struct Unit { int pm, pn, kind, e, row0, nvalid; };

__device__ __forceinline__ unsigned cvt_pk_bf16(float lo, float hi) { unsigned r; asm volatile("v_cvt_pk_bf16_f32 %0, %1, %2" : "=v"(r) : "v"(lo), "v"(hi)); return r; }
__device__ __forceinline__ f32x2 gelu_pk(f32x2 v) {
    const f32x2 av = __builtin_elementwise_abs(v), d = av * 0.2316418882f + 1.0f;
    f32x2 t; t.x = __builtin_amdgcn_rcpf(d.x); t.y = __builtin_amdgcn_rcpf(d.y);
    f32x2 q = t * 0.5307027145f + (-0.7265760135f); q = q * t + 0.7107068705f; q = q * t + (-0.142248368f); q = q * t + 0.127414796f; q = q * t;
    const f32x2 s = (v * v) * (-0.72134752044f);
    f32x2 e; e.x = __builtin_amdgcn_exp2f(s.x); e.y = __builtin_amdgcn_exp2f(s.y);
    const f32x2 m = v * (q * e), r = v - m;
    f32x2 o; o.x = v.x < 0.f ? m.x : r.x; o.y = v.y < 0.f ? m.y : r.y; return o;
}
__device__ __forceinline__ float sigmoid_f(float x) { return __builtin_amdgcn_rcpf(1.0f + __builtin_amdgcn_exp2f(-1.4426950408889634f * x)); }

template <class Epi, class Sched>
__device__ __forceinline__ void gemm_phase(PG8_LAS unsigned char* lds, const int K, const Sched& S, const Epi& E) {
    int tid = threadIdx.x; asm volatile("" : "+v"(tid));
    const int wid = __builtin_amdgcn_readfirstlane(tid >> 6), lane = tid & 63, wr = wid >> 2, wc = wid & 3, fr = lane & 15, fq = lane >> 4;
    const int nt = K / BK;
    unsigned voffA[2], voffB[2]; int rowA[2];
#pragma unroll
    for (int i = 0; i < 2; ++i) { int R, C; stage_rc(tid * 16 + i * 8192, R, C); const int Rb = Epi::PERM ? ((R & ~31) + perm32(R & 31)) : R;
        voffA[i] = Sched::GATHER ? (unsigned)(C * 2) : (unsigned)(R * K + C) * 2u; voffB[i] = (unsigned)(Rb * K + C) * 2u; rowA[i] = R; }
    const size_t kstep = (size_t)(BK * 2);
    const size_t hstep = (size_t)HALF * K * 2;
    const unsigned ldsw = (unsigned)wid * 1024u;
    const int aoff = lds_byte(wr * 64 + fr, fq * 8), boff = lds_byte(wc * 32 + fr, fq * 8);
#define PG8_SA(b, h) (((b) * 2 + (h)) * HTB)
#define PG8_SB(b, h) ((4 + (b) * 2 + (h)) * HTB)
#define PG8_STAGE(bufoff, gbase, voff) do { _Pragma("unroll") for (int _i = 0; _i < 2; ++_i) \
        __builtin_amdgcn_global_load_lds((const unsigned*)((const char*)(gbase) + (voff)[_i]), (PG8_LAS unsigned*)(lds + (bufoff) + ldsw + _i * 8192), 16, 0, 0); } while (0)
#define PG8_STAGE_A(bufoff, gbase, h, GO) do { if constexpr (Sched::GATHER) { _Pragma("unroll") for (int _i = 0; _i < 2; ++_i) \
        __builtin_amdgcn_global_load_lds((const unsigned*)((const char*)(gbase) + (GO)[h][_i]), (PG8_LAS unsigned*)(lds + (bufoff) + ldsw + _i * 8192), 16, 0, 0); } \
        else { PG8_STAGE(bufoff, (gbase) + (h) * hstep, voffA); } } while (0)
#define PG8_LDA(dst, b, h) do { _Pragma("unroll") for (int m = 0; m < 4; ++m) _Pragma("unroll") for (int k = 0; k < 2; ++k) dst[m][k] = *(const PG8_LAS bf16x8*)(lds + PG8_SA(b, h) + aoff + m * 2048 + k * 1024); } while (0)
#define PG8_LDB(dst, b, h) do { _Pragma("unroll") for (int n = 0; n < 2; ++n) _Pragma("unroll") for (int k = 0; k < 2; ++k) dst[n][k] = *(const PG8_LAS bf16x8*)(lds + PG8_SB(b, h) + boff + n * 2048 + k * 1024); } while (0)
#define PG8_MMA(ai, bj, At, Bt) do { __builtin_amdgcn_s_setprio(1); _Pragma("unroll") for (int m = 0; m < 4; ++m) _Pragma("unroll") for (int n = 0; n < 2; ++n) _Pragma("unroll") for (int k = 0; k < 2; ++k) \
        acc[ai][bj][m][n] = __builtin_amdgcn_mfma_f32_16x16x32_bf16(Bt[n][k], At[m][k], acc[ai][bj][m][n], 0, 0, 0); __builtin_amdgcn_s_setprio(0); } while (0)
#define PG8_WAIT_V(n) asm volatile("s_waitcnt vmcnt(" #n ")" ::: "memory")
#define PG8_WAIT_L(n) asm volatile("s_waitcnt lgkmcnt(" #n ")" ::: "memory")
#define PG8_BAR __builtin_amdgcn_s_barrier()
#define PG8_SCHED __builtin_amdgcn_sched_barrier(0)
    Unit cur, nxt; int ui = 0;
    if (!S.next(0, cur)) return;
    f32x4 acc[2][2][4][2];
#pragma unroll
    for (int a = 0; a < 2; ++a)
#pragma unroll
        for (int b = 0; b < 2; ++b)
#pragma unroll
            for (int m = 0; m < 4; ++m)
#pragma unroll
                for (int n = 0; n < 2; ++n) acc[a][b][m][n] = (f32x4){0.f, 0.f, 0.f, 0.f};
    bf16x8 At[4][2], B0[2][2], B1[2][2];
    const char* cA = S.a_base(cur); const char* cB = S.b_base(cur);
    unsigned cgo[2][2], ngo[2][2];
    if constexpr (Sched::GATHER) {
#pragma unroll
        for (int h = 0; h < 2; ++h)
#pragma unroll
            for (int i = 0; i < 2; ++i) { cgo[h][i] = S.a_goff(cur, h * HALF + rowA[i]) + voffA[i]; ngo[h][i] = cgo[h][i]; }
    }
    PG8_STAGE(PG8_SB(0, 0), cB, voffB); PG8_STAGE(PG8_SB(0, 1), cB + hstep, voffB); PG8_STAGE_A(PG8_SA(0, 0), cA, 0, cgo); PG8_STAGE_A(PG8_SA(0, 1), cA, 1, cgo);
    if (wr == 1) PG8_BAR;
    PG8_WAIT_V(2); PG8_BAR;
    PG8_STAGE(PG8_SB(1, 0), cB + kstep, voffB); PG8_STAGE_A(PG8_SA(1, 0), cA + kstep, 0, cgo); PG8_STAGE(PG8_SB(1, 1), cB + hstep + kstep, voffB);
    PG8_WAIT_V(6); PG8_BAR;
    for (;;) {
        const bool has_next = S.next(ui + 1, nxt);
        const char* nA = has_next ? S.a_base(nxt) : cA; const char* nB = has_next ? S.b_base(nxt) : cB;
        if constexpr (Sched::GATHER) {
            if (has_next) {
#pragma unroll
                for (int h = 0; h < 2; ++h)
#pragma unroll
                    for (int i = 0; i < 2; ++i) ngo[h][i] = S.a_goff(nxt, h * HALF + rowA[i]) + voffA[i];
            }
        }
        for (int t = 0; t < nt; t += 2) {
            const bool last = (t == nt - 2);
            if constexpr (Epi::MIDK) { if (t == (nt >> 1)) E.mid(acc, cur, wr, wc, fr, fq); }
            const char* a1 = cA + (size_t)(t + 1) * kstep;
            const char* a2 = last ? nA : cA + (size_t)(t + 2) * kstep; const char* b2 = last ? nB : cB + (size_t)(t + 2) * kstep;
            const char* a3 = a2 + kstep; const char* b3 = b2 + kstep;
            unsigned xgo[2][2];
            if constexpr (Sched::GATHER) {
#pragma unroll
                for (int h = 0; h < 2; ++h)
#pragma unroll
                    for (int i = 0; i < 2; ++i) xgo[h][i] = last ? ngo[h][i] : cgo[h][i];
            }
            PG8_LDB(B0, 0, 0); PG8_LDB(B1, 0, 1); PG8_SCHED; PG8_LDA(At, 0, 0); PG8_STAGE_A(PG8_SA(1, 1), a1, 1, cgo);
            PG8_WAIT_V(8); PG8_WAIT_L(0); PG8_BAR; PG8_MMA(0, 0, At, B0); PG8_MMA(0, 1, At, B1); PG8_BAR; PG8_SCHED;
            PG8_LDA(At, 0, 1); PG8_STAGE(PG8_SB(0, 0), b2, voffB); PG8_STAGE(PG8_SB(0, 1), b2 + hstep, voffB); PG8_STAGE_A(PG8_SA(0, 0), a2, 0, xgo);
            PG8_WAIT_V(8); PG8_WAIT_L(0); PG8_BAR; PG8_MMA(1, 0, At, B0); PG8_MMA(1, 1, At, B1); PG8_BAR; PG8_SCHED;
            PG8_LDB(B0, 1, 0); PG8_LDB(B1, 1, 1); PG8_SCHED; PG8_LDA(At, 1, 0); PG8_STAGE_A(PG8_SA(0, 1), a2, 1, xgo);
            PG8_WAIT_V(8); PG8_WAIT_L(0); PG8_BAR; PG8_MMA(0, 0, At, B0); PG8_MMA(0, 1, At, B1); PG8_BAR; PG8_SCHED;
            PG8_LDA(At, 1, 1); PG8_STAGE(PG8_SB(1, 0), b3, voffB); PG8_STAGE(PG8_SB(1, 1), b3 + hstep, voffB); PG8_STAGE_A(PG8_SA(1, 0), a3, 0, xgo);
            PG8_WAIT_V(8); PG8_WAIT_L(0); PG8_BAR; PG8_MMA(1, 0, At, B0); PG8_MMA(1, 1, At, B1); PG8_BAR; PG8_SCHED;
        }
        if (wr == 0) PG8_BAR;
        E(acc, cur, wr, wc, fr, fq);
        if (!has_next) break;
#pragma unroll
        for (int a = 0; a < 2; ++a)
#pragma unroll
            for (int b = 0; b < 2; ++b)
#pragma unroll
                for (int m = 0; m < 4; ++m)
#pragma unroll
                    for (int n = 0; n < 2; ++n) acc[a][b][m][n] = (f32x4){0.f, 0.f, 0.f, 0.f};
        cur = nxt; cA = nA; cB = nB; ++ui;
        if constexpr (Sched::GATHER) {
#pragma unroll
            for (int h = 0; h < 2; ++h)
#pragma unroll
                for (int i = 0; i < 2; ++i) cgo[h][i] = ngo[h][i];
        }
        if (wr == 1) PG8_BAR;
    }
    PG8_WAIT_V(0);
    PG8_BAR;
#undef PG8_SA
#undef PG8_SB
#undef PG8_STAGE
#undef PG8_STAGE_A
#undef PG8_LDA
#undef PG8_LDB
#undef PG8_MMA
#undef PG8_WAIT_V
#undef PG8_WAIT_L
#undef PG8_BAR
#undef PG8_SCHED
}
}
constexpr int NWAVES = 8, NTHR = 512;
constexpr int SEQ = 8192, DM = 2048, NIN = 9216, HYW = 1024, SGW = 1024, NHY = 3072, NEXP = 16, DEXP = 512, DEPTH = 2;
constexpr float EPS = 1e-6f;
constexpr size_t MiB = 1u << 20;
constexpr size_t WS_CTL = 0, CTL_ZERO_BYTES = 1 * MiB;
constexpr size_t WS_WIN = 1 * MiB;
constexpr size_t WS_PT = WS_WIN + 36 * MiB;
constexpr size_t WS_WOT = WS_PT + 8 * MiB;
constexpr size_t WS_WGU = WS_WOT + 8 * MiB;
constexpr size_t WS_WD = WS_WGU + 64 * MiB;
constexpr size_t WS_W3T = WS_WD + 32 * MiB;
constexpr size_t WS_A2 = WS_W3T + 1 * MiB;
constexpr size_t WS_WR = WS_A2 + 1 * MiB;
constexpr size_t WS_LISTS = WS_WR + 1 * MiB;
constexpr size_t WS_XR = WS_LISTS + 2 * MiB;
constexpr size_t WS_XN = WS_XR + 64 * MiB;
constexpr size_t WS_ZT = WS_XN + 32 * MiB;
constexpr size_t WS_U = WS_ZT + 48 * MiB;
constexpr size_t WS_GV = WS_U + 16 * MiB;
constexpr size_t WS_GH = WS_GV + 16 * MiB;
constexpr size_t WS_GS = WS_GH + 32 * MiB;
constexpr size_t WS_Y = WS_GS + 32 * MiB;
constexpr size_t WS_FS = WS_Y + 32 * MiB;
constexpr size_t WS_END = WS_FS + 128 * MiB;
constexpr size_t WS_MERGED = WS_ZT, WS_ACT = WS_U, WS_MOEOUT = WS_FS;
constexpr int CW_TMO = 0;
constexpr int CW_CNT = 64;
constexpr int CW_BAR = 4096;
constexpr int SCRATCH_BYTES = 2 * 8448 * 8;
constexpr int MISC_OFF = SCRATCH_BYTES;
constexpr int LDS_BYTES = SCRATCH_BYTES + 1024;
static_assert(SCRATCH_BYTES >= pg8::STAGE_BYTES, "lds");

#define GAS __attribute__((address_space(1)))
#define LAS __attribute__((address_space(3)))
typedef unsigned short bf16;
typedef unsigned v4u __attribute__((ext_vector_type(4)));
typedef unsigned v2u __attribute__((ext_vector_type(2)));
typedef float f32x4 __attribute__((ext_vector_type(4)));
typedef short bf16x8 __attribute__((ext_vector_type(8)));
typedef GAS unsigned gu32;
#define RLX_AGENT __ATOMIC_RELAXED, __HIP_MEMORY_SCOPE_AGENT
#define LDS_WAIT() asm volatile("s_waitcnt lgkmcnt(0)" ::: "memory")
#define VM_WAIT() asm volatile("s_waitcnt vmcnt(0)" ::: "memory")
__device__ __forceinline__ unsigned f2bf(float f) { unsigned u = __builtin_bit_cast(unsigned, f); return (u + 0x7fffu + ((u >> 16) & 1u)) >> 16; }
__device__ __forceinline__ unsigned pk2(float lo, float hi) { return f2bf(lo) | (f2bf(hi) << 16); }
__device__ __forceinline__ float bfl(unsigned u) { return __builtin_bit_cast(float, u << 16); }
__device__ __forceinline__ float bfh(unsigned u) { return __builtin_bit_cast(float, u & 0xffff0000u); }

#define XB_TMO      128
#define XB_XCNT(j)  (256  + 64 * (j))
#define XB_XSUB(j)  (1280 + 64 * (j))
#define XB_XGEN(j)  (2304 + 64 * (j))
#define XB_TOP      3328
#define XB_TOPGEN   3392
#define XCD_BAR_WORDS 3456
#define XB_SPIN_CAP (1u << 18)
__device__ __forceinline__ unsigned xb_ld(unsigned* p)              { return __hip_atomic_load(p, __ATOMIC_RELAXED, __HIP_MEMORY_SCOPE_AGENT); }
__device__ __forceinline__ unsigned xb_add(unsigned* p, unsigned v) { return __hip_atomic_fetch_add(p, v, __ATOMIC_RELAXED, __HIP_MEMORY_SCOPE_AGENT); }
__device__ __forceinline__ unsigned xb_xcc_id() { return (unsigned)__builtin_amdgcn_s_getreg((3 << 11) | 20) & 0xFu; }
#define XB_SPIN(cond, bar) do { unsigned _sp = 0; while (cond) { __builtin_amdgcn_s_sleep(1); \
    if ((++_sp & 255u) == 0u) { if (xb_ld(&(bar)[XB_TMO])) break; if (_sp > XB_SPIN_CAP) { atomicAdd(&(bar)[XB_TMO], 1u); break; } } } } while (0)
struct XcdBarrier { unsigned* bar; unsigned x; volatile LAS unsigned* st; };
__device__ __forceinline__ XcdBarrier xcd_barrier_post(unsigned* bar, volatile LAS unsigned* st) {
    XcdBarrier b; b.bar = bar; b.x = xb_xcc_id(); b.st = st;
    if (threadIdx.x == 0) (void)xb_add(&bar[XB_XCNT(b.x)], 1u);
    return b;
}
__device__ __forceinline__ void xcd_barrier_complete(unsigned* bar, unsigned x, unsigned& nloc, unsigned& nx) {
    const unsigned G = gridDim.x * gridDim.y * gridDim.z;
    unsigned sum, cnt, mine, sp = 0u;
    for (;;) {
        sum = 0u; cnt = 0u; mine = 0u;
#pragma unroll
        for (unsigned j = 0; j < 16; ++j) { const unsigned c = xb_ld(&bar[XB_XCNT(j)]); sum += c; cnt += (c > 0u) ? 1u : 0u; mine = (j == x) ? c : mine; }
        if (sum == G) break;
        __builtin_amdgcn_s_sleep(1);
        if ((++sp & 255u) == 0u) { if (xb_ld(&bar[XB_TMO])) break; if (sp > XB_SPIN_CAP) { atomicAdd(&bar[XB_TMO], 1u); break; } }
    }
    nloc = mine > 0u ? mine : 1u; nx = cnt > 0u ? cnt : 1u;
}
__device__ __forceinline__ void xcd_barrier(const XcdBarrier& b) {
    asm volatile("s_waitcnt vmcnt(0)" ::: "memory");
    __syncthreads();
    if (threadIdx.x == 0) {
        unsigned* bar = b.bar;
        __builtin_amdgcn_s_waitcnt(0);
        unsigned nloc = b.st[0], nx = b.st[1];
        if (nloc == 0u) { xcd_barrier_complete(bar, b.x, nloc, nx); b.st[0] = nloc; b.st[1] = nx; }
        const unsigned old = xb_add(&bar[XB_XSUB(b.x)], 1u);
        const unsigned gen = old / nloc;
        if (old + 1u == (gen + 1u) * nloc) {
            __builtin_amdgcn_fence(__ATOMIC_RELEASE, "agent");
            asm volatile("s_waitcnt vmcnt(0)" ::: "memory");
            const unsigned og = xb_add(&bar[XB_TOP], 1u);
            const unsigned tg = og / nx;
            if (og + 1u == (tg + 1u) * nx) xb_add(&bar[XB_TOPGEN], 1u);
            else XB_SPIN(xb_ld(&bar[XB_TOPGEN]) == tg, bar);
            __builtin_amdgcn_fence(__ATOMIC_ACQUIRE, "agent");
            xb_add(&bar[XB_XGEN(b.x)], 1u);
            asm volatile("s_waitcnt vmcnt(0)" ::: "memory");
        } else {
            XB_SPIN(xb_ld(&bar[XB_XGEN(b.x)]) == gen, bar);
            __builtin_amdgcn_fence(__ATOMIC_ACQUIRE, "agent");
            asm volatile("s_waitcnt vmcnt(0)" ::: "memory");
        }
    }
    __syncthreads();
}

struct Frame {
    LAS unsigned char* lds;
    volatile LAS unsigned* MISC;
    gu32* ctl;
    int tid, lane, wave;
    int vcu, G;
    const float* in[29];
    float* out;
    unsigned char* ws;
};
enum { I_X = 0, I_GMIX, I_WIN, I_BIN, I_CONVW, I_CONVB, I_FW1, I_FB1, I_FW2, I_FB2, I_FW3, I_FFREQ, I_SKIP, I_LNG, I_LNB, I_SGW, I_SGB, I_WHY, I_WSG, I_WOUT, I_GFFN, I_WRG, I_BRG, I_WRE, I_BRE, I_WGATE, I_WUP, I_WDOWN, I_GFINAL };

__device__ __forceinline__ float wave_sum(float v) {
#pragma unroll
    for (int o = 1; o < 64; o <<= 1) v += __shfl_xor(v, o);
    return v;
}
#define HD __device__ __forceinline__
#define HY_OPAQUE(x) asm volatile("" : "+v"(x))
typedef float hy_f2v __attribute__((ext_vector_type(2)));
#define LDC(p, i) ({ const hy_f2v _v = *(const LAS hy_f2v*)((p) + (i)); c32 _r; _r.x = _v.x; _r.y = _v.y; _r; })
#define STC(p, i, v) do { const c32 _s = (v); hy_f2v _w; _w.x = _s.x; _w.y = _s.y; *(LAS hy_f2v*)((p) + (i)) = _w; } while (0)
struct c32 { float x, y; };
HD c32 cadd(c32 a, c32 b) { c32 r; r.x = a.x + b.x; r.y = a.y + b.y; return r; }
HD c32 csub(c32 a, c32 b) { c32 r; r.x = a.x - b.x; r.y = a.y - b.y; return r; }
HD c32 cmul(c32 a, c32 b) { c32 r; r.x = a.x * b.x - a.y * b.y; r.y = a.x * b.y + a.y * b.x; return r; }
HD c32 cmk(float x, float y) { c32 r; r.x = x; r.y = y; return r; }
HD int hpos(int e) { return e + (e >> 5); }
#define HY_N 8192
#define HY_LDS_C32 (8192 + 256)

template <int SIGN> HD void dft4(c32& a, c32& b, c32& c, c32& d) {
    const c32 t0 = cadd(a, c), t1 = csub(a, c), t2 = cadd(b, d), t3 = csub(b, d);
    a = cadd(t0, t2); c = csub(t0, t2);
    if (SIGN < 0) { b = cmk(t1.x + t3.y, t1.y - t3.x); d = cmk(t1.x - t3.y, t1.y + t3.x); }
    else          { b = cmk(t1.x - t3.y, t1.y + t3.x); d = cmk(t1.x + t3.y, t1.y - t3.x); }
}
template <int SIGN> HD void dft16(c32 (&a)[16]) {
    const float C1 = 0.92387953251128674f, S1 = 0.38268343236508977f, R2 = 0.70710678118654752f;
#pragma unroll
    for (int n2 = 0; n2 < 4; ++n2) dft4<SIGN>(a[n2], a[4 + n2], a[8 + n2], a[12 + n2]);
    const float sg = (SIGN < 0) ? -1.f : 1.f;
    const c32 w1 = cmk(C1, sg * S1), w2 = cmk(R2, sg * R2), w3 = cmk(S1, sg * C1), w4 = cmk(0.f, sg), w6 = cmk(-R2, sg * R2), w9 = cmk(-C1, -sg * S1);
    a[1 + 4] = cmul(a[1 + 4], w1); a[2 + 4] = cmul(a[2 + 4], w2); a[3 + 4] = cmul(a[3 + 4], w3);
    a[1 + 8] = cmul(a[1 + 8], w2); a[2 + 8] = cmul(a[2 + 8], w4); a[3 + 8] = cmul(a[3 + 8], w6);
    a[1 + 12] = cmul(a[1 + 12], w3); a[2 + 12] = cmul(a[2 + 12], w6); a[3 + 12] = cmul(a[3 + 12], w9);
#pragma unroll
    for (int k1 = 0; k1 < 4; ++k1) dft4<SIGN>(a[4 * k1], a[4 * k1 + 1], a[4 * k1 + 2], a[4 * k1 + 3]);
    c32 t[16];
#pragma unroll
    for (int i = 0; i < 16; ++i) t[i] = a[i];
#pragma unroll
    for (int k1 = 0; k1 < 4; ++k1)
#pragma unroll
        for (int k2 = 0; k2 < 4; ++k2) a[k1 + 4 * k2] = t[4 * k1 + k2];
}
HD void twiddle_chain(c32 (&a)[16], c32 w) {
    c32 wp = w;
#pragma unroll
    for (int p = 1; p < 16; ++p) { a[p] = cmul(a[p], wp); wp = cmul(wp, w); }
}
HD c32 cis_pi(float x) { c32 r; r.x = cospif(x); r.y = sinpif(x); return r; }

HD void fft_s1_fwd(int tid, LAS c32* buf, c32 (&a)[16]) { HY_OPAQUE(tid);
    dft16<-1>(a);
    twiddle_chain(a, cis_pi(-2.0f * (float)tid / 8192.0f));
#pragma unroll
    for (int p = 0; p < 16; ++p) STC(buf, hpos(tid + 512 * p), a[p]);
}
HD void fft_s2_fwd(int tid, LAS c32* buf) { HY_OPAQUE(tid);
    const int base = (tid >> 5) * 512 + (tid & 31);
    c32 a[16];
#pragma unroll
    for (int q = 0; q < 16; ++q) a[q] = LDC(buf, hpos(base + 32 * q));
    dft16<-1>(a);
    twiddle_chain(a, cis_pi(-2.0f * (float)(tid & 31) / 512.0f));
#pragma unroll
    for (int p = 0; p < 16; ++p) STC(buf, hpos(base + 32 * p), a[p]);
}
HD float w32c(int q) { switch (q) { case 0: return 1.0f; case 1: return 0.98078528040323043f; case 2: return 0.92387953251128674f; case 3: return 0.83146961230254524f; case 4: return 0.70710678118654752f; case 5: return 0.55557023301960218f; case 6: return 0.38268343236508977f; case 7: return 0.19509032201612825f;
    case 8: return 0.0f; case 9: return -0.19509032201612825f; case 10: return -0.38268343236508977f; case 11: return -0.55557023301960218f; case 12: return -0.70710678118654752f; case 13: return -0.83146961230254524f; case 14: return -0.92387953251128674f; default: return -0.98078528040323043f; } }
HD float w32s(int q) { switch (q) { case 0: return 0.0f; case 1: return 0.19509032201612825f; case 2: return 0.38268343236508977f; case 3: return 0.55557023301960218f; case 4: return 0.70710678118654752f; case 5: return 0.83146961230254524f; case 6: return 0.92387953251128674f; case 7: return 0.98078528040323043f;
    case 8: return 1.0f; case 9: return 0.98078528040323043f; case 10: return 0.92387953251128674f; case 11: return 0.83146961230254524f; case 12: return 0.70710678118654752f; case 13: return 0.55557023301960218f; case 14: return 0.38268343236508977f; default: return 0.19509032201612825f; } }
template <int SIGN> HD void fft_s3_read(int tid, const LAS c32* buf, c32 (&s)[16]) { HY_OPAQUE(tid);
    const int base = (tid >> 1) * 33, h = tid & 1;
    const float sg = (SIGN < 0) ? -1.f : 1.f;
#pragma unroll
    for (int q = 0; q < 16; ++q) {
        const c32 u = LDC(buf, base + q), v = LDC(buf, base + q + 16);
        const c32 sum = cadd(u, v), dif = csub(u, v);
        const c32 w = cmk(w32c(q), sg * w32s(q));
        const c32 dw = cmul(dif, w);
        s[q] = h ? dw : sum;
    }
    dft16<SIGN>(s);
}
HD void fft_s3_write(int tid, LAS c32* buf, const c32 (&s)[16]) { HY_OPAQUE(tid);
    const int base = (tid >> 1) * 33, h = tid & 1;
#pragma unroll
    for (int p = 0; p < 16; ++p) STC(buf, base + 2 * p + h, s[p]);
}
HD void fft_s2_inv(int tid, LAS c32* buf) { HY_OPAQUE(tid);
    const int base = (tid >> 5) * 512 + (tid & 31);
    c32 a[16];
#pragma unroll
    for (int q = 0; q < 16; ++q) a[q] = LDC(buf, hpos(base + 32 * q));
    twiddle_chain(a, cis_pi(2.0f * (float)(tid & 31) / 512.0f));
    dft16<1>(a);
#pragma unroll
    for (int p = 0; p < 16; ++p) STC(buf, hpos(base + 32 * p), a[p]);
}
HD void fft_s1_inv(int tid, const LAS c32* buf, c32 (&a)[16]) { HY_OPAQUE(tid);
#pragma unroll
    for (int p = 0; p < 16; ++p) a[p] = LDC(buf, hpos(tid + 512 * p));
    twiddle_chain(a, cis_pi(2.0f * (float)tid / 8192.0f));
    dft16<1>(a);
}
HD void pair_pass(int tid, LAS c32* Z, const LAS c32* H) { HY_OPAQUE(tid);
    const int p3 = tid & 31;
    const c32 wp3 = cis_pi(-(float)p3 / 32.0f);
    for (int it = 0; it < 9; ++it) {
        const int low = it * 16 + (tid >> 5);
        if (low > 128) continue;
        bool act = true; int p3b = 31 - p3, lowb = 256 - low;
        if (low == 0) { act = p3 <= 16; p3b = (32 - p3) & 31; lowb = 0; }
        else if (low == 128) { act = p3 <= 15; lowb = 128; }
        if (!act) continue;
        const int pa = (low & 15) * 528 + (low >> 4) * 33 + p3, pb = (lowb & 15) * 528 + (lowb >> 4) * 33 + p3b;
        const c32 Wk = cmul(cis_pi(-(float)low / 8192.0f), wp3);
        const c32 A = LDC(Z, pa), B = LDC(Z, pb), HA = LDC(H, pa), HB = LDC(H, pb);
        c32 E = cmk(0.5f * (A.x + B.x), 0.5f * (A.y - B.y)), O = cmk(0.5f * (A.y + B.y), -0.5f * (A.x - B.x));
        c32 T = cmul(Wk, O);
        const c32 X = cadd(E, T), Xp = cmk(E.x - T.x, -(E.y - T.y));
        E = cmk(0.5f * (HA.x + HB.x), 0.5f * (HA.y - HB.y)); O = cmk(0.5f * (HA.y + HB.y), -0.5f * (HA.x - HB.x));
        T = cmul(Wk, O);
        const c32 Hk = cadd(E, T), Hp = cmk(E.x - T.x, -(E.y - T.y));
        const c32 Y = cmul(X, Hk), Yp = cmul(Xp, Hp);
        const float sc = 0.5f / 8192.0f;
        const c32 Ye = cmk(sc * (Y.x + Yp.x), sc * (Y.y - Yp.y));
        const c32 Yd = cmk(sc * (Y.x - Yp.x), sc * (Y.y + Yp.y));
        const c32 Yo = cmul(Yd, cmk(Wk.x, -Wk.y));
        STC(Z, pa, cmk(Ye.x - Yo.y, Ye.y + Yo.x));
        if (pb != pa) STC(Z, pb, cmk(Ye.x + Yo.y, -Ye.y + Yo.x));
    }
}
HD float bf_lo(unsigned u) { unsigned v = u << 16; return __builtin_bit_cast(float, v); }
HD float bf_hi(unsigned u) { unsigned v = u & 0xffff0000u; return __builtin_bit_cast(float, v); }
HD void hy_conv3_load(int tid, const unsigned* zrow, float c0, float c1, float c2, float cb, float (&out)[16]) { HY_OPAQUE(tid);
#pragma unroll
    for (int q = 0; q < 8; ++q) {
        const int m = tid + 512 * q;
        const unsigned wm = zrow[m];
        const unsigned wl = (m > 0) ? zrow[m - 1] : 0u;
        const unsigned wr = (m < 4095) ? zrow[m + 1] : 0u;
        const float zm1 = bf_hi(wl), z0 = bf_lo(wm), z1 = bf_hi(wm), z2 = bf_lo(wr);
        out[2 * q] = c0 * zm1 + c1 * z0 + c2 * z1 + cb;
        out[2 * q + 1] = c0 * z0 + c1 * z1 + c2 * z2 + cb;
    }
}
HD void hy_filter_s1(int tid, LAS c32* buf, const float* fwd, const float* bwd) { HY_OPAQUE(tid);
    c32 a[16];
#pragma unroll
    for (int q = 0; q < 8; ++q) { const int m = tid + 512 * q; const float2 f = *(const float2*)(fwd + 2 * m); a[q] = cmk(f.x, f.y); }
    if (tid == 0) a[0].x += bwd[0];
#pragma unroll
    for (int q = 8; q < 16; ++q) { const int mp = tid + 512 * (q - 8); a[q] = cmk(mp == 0 ? 0.f : bwd[8192 - 2 * mp], bwd[8191 - 2 * mp]); }
    fft_s1_fwd(tid, buf, a);
}
HD void hy_data_s1(int tid, LAS c32* buf, const float (&v)[16]) { HY_OPAQUE(tid);
    c32 a[16];
#pragma unroll
    for (int q = 0; q < 8; ++q) a[q] = cmk(v[2 * q], v[2 * q + 1]);
#pragma unroll
    for (int q = 8; q < 16; ++q) a[q] = cmk(0.f, 0.f);
    fft_s1_fwd(tid, buf, a);
}
__device__ __forceinline__ void transpose_item(const float* W, int N, int k0, int n0, bf16* dst, size_t dld, LAS float* scr, int lane) {
#pragma unroll 8
    for (int i = 0; i < 32; ++i) { const int kk = 2 * i + (lane >> 5); scr[kk * 33 + (lane & 31)] = W[(size_t)(k0 + kk) * N + n0 + (lane & 31)]; }
    LDS_WAIT(); asm volatile("" ::: "memory");
    const int c = lane & 7;
#pragma unroll
    for (int j = 0; j < 4; ++j) { const int n = (lane >> 3) + 8 * j; const LAS float* s = scr + (8 * c) * 33 + n;
        v4u o; o.x = pk2(s[0 * 33], s[1 * 33]); o.y = pk2(s[2 * 33], s[3 * 33]); o.z = pk2(s[4 * 33], s[5 * 33]); o.w = pk2(s[6 * 33], s[7 * 33]);
        *(GAS v4u*)(dst + (size_t)n * dld + 8 * c) = o; }
    LDS_WAIT(); asm volatile("" ::: "memory");
}
__device__ __forceinline__ void pa_convert(Frame& F, int l) {
    LAS float* scr = (LAS float*)(F.lds + F.wave * 16384);
    const int gw = F.vcu * NWAVES + F.wave, NGW = F.G * NWAVES;
    bf16* WIN = (bf16*)(F.ws + WS_WIN); bf16* PT = (bf16*)(F.ws + WS_PT); bf16* WOT = (bf16*)(F.ws + WS_WOT); bf16* WGU = (bf16*)(F.ws + WS_WGU); bf16* WD = (bf16*)(F.ws + WS_WD); bf16* W3T = (bf16*)(F.ws + WS_W3T);
    constexpr int S0 = 32 * 288, S1 = 16 * 64, S3 = 32 * 64, S4 = 16 * 32 * 16, S6 = 16 * 8 * 64, S7 = 128;
    constexpr int NITEMS = S0 + 2 * S1 + S3 + 2 * S4 + S6 + S7;
    for (int it = gw; it < NITEMS; it += NGW) {
        int r = it;
        if (r < S0) { const int kb = r / 288, nb = r % 288; transpose_item(F.in[I_WIN] + (size_t)l * DM * NIN, NIN, 64 * kb, 32 * nb, WIN + (size_t)(32 * nb) * DM + 64 * kb, DM, scr, F.lane); continue; } r -= S0;
        if (r < S1) { const int kb = r / 64, nb = r % 64; transpose_item(F.in[I_WHY] + (size_t)l * HYW * DM, DM, 64 * kb, 32 * nb, PT + (size_t)(32 * nb) * DM + 64 * kb, DM, scr, F.lane); continue; } r -= S1;
        if (r < S1) { const int kb = r / 64, nb = r % 64; transpose_item(F.in[I_WSG] + (size_t)l * SGW * DM, DM, 64 * kb, 32 * nb, PT + (size_t)(32 * nb) * DM + 1024 + 64 * kb, DM, scr, F.lane); continue; } r -= S1;
        if (r < S3) { const int kb = r / 64, nb = r % 64; transpose_item(F.in[I_WOUT] + (size_t)l * DM * DM, DM, 64 * kb, 32 * nb, WOT + (size_t)(32 * nb) * DM + 64 * kb, DM, scr, F.lane); continue; } r -= S3;
        if (r < 2 * S4) { const int up = r / S4; r -= up * S4; const int e = r / 512, q = r % 512, kb = q / 16, nb = q % 16; const int n0 = 32 * nb, drow = 256 * (n0 / 128) + (n0 % 128) + 128 * up;
            transpose_item((up ? F.in[I_WUP] : F.in[I_WGATE]) + ((size_t)l * NEXP + e) * DM * DEXP, DEXP, 64 * kb, n0, WGU + ((size_t)e * 1024 + drow) * DM + 64 * kb, DM, scr, F.lane); continue; } r -= 2 * S4;
        if (r < S6) { const int e = r / 512, q = r % 512, kb = q / 64, nb = q % 64;
            transpose_item(F.in[I_WDOWN] + ((size_t)l * NEXP + e) * DEXP * DM, DM, 64 * kb, 32 * nb, WD + ((size_t)e * DM + 32 * nb) * DEXP + 64 * kb, DEXP, scr, F.lane); continue; } r -= S6;
        { const int nb = r; transpose_item(F.in[I_FW3] + (size_t)l * 64 * 4096, 4096, 0, 32 * nb, W3T + (size_t)(32 * nb) * 64, 64, scr, F.lane); }
    }
}
__device__ __forceinline__ void pa_features(Frame& F, int l) {
    LAS float* zf = (LAS float*)(F.lds);
    LAS float* a1 = zf + 8 * 40;
    const float* w1 = F.in[I_FW1] + l * 33 * 64; const float* b1 = F.in[I_FB1] + l * 64; const float* w2 = F.in[I_FW2] + l * 64 * 64; const float* b2 = F.in[I_FB2] + l * 64; const float* fq = F.in[I_FFREQ] + l * 64;
    bf16* A2 = (bf16*)(F.ws + WS_A2);
    const int tl = F.tid >> 6, j = F.tid & 63;
    const float fr = fq[j];
    for (int t0 = F.vcu * 8; t0 < SEQ; t0 += F.G * 8) {
        __syncthreads();
        if (F.tid < 8 * 33) { const int tt = F.tid / 33, i = F.tid % 33; const int t = t0 + tt; float v;
            const float w = 6.283185307179586f / (float)SEQ * (float)t;
            if (i == 0) v = (float)t / (float)(SEQ - 1);
            else { const int b = (i - 1) & 15; const float band = 1e-4f + (float)b * ((15.0f - 1e-4f) / 15.0f); const float a = band * w; v = (i <= 16) ? cosf(a) : -sinf(a); }
            zf[tt * 40 + i] = v; }
        __syncthreads();
        float s = b1[j];
#pragma unroll
        for (int i = 0; i < 33; ++i) s += zf[tl * 40 + i] * w1[i * 64 + j];
        a1[tl * 64 + j] = sinf(fr * s);
        __syncthreads();
        float s2 = b2[j];
#pragma unroll 8
        for (int i = 0; i < 64; ++i) s2 += a1[tl * 64 + i] * w2[i * 64 + j];
        A2[(size_t)(t0 + tl) * 64 + j] = (bf16)f2bf(sinf(fr * s2));
    }
    __syncthreads();
}
__device__ __forceinline__ void pa_router_t(Frame& F, int l) {
    float* WR = (float*)(F.ws + WS_WR);
    const float* wrg = F.in[I_WRG] + (size_t)l * DM * 4; const float* wre = F.in[I_WRE] + (size_t)l * 4 * DM * 4;
    for (int i = F.vcu * NTHR + F.tid; i < 20 * DM; i += F.G * NTHR) { const int o = i / DM, k = i % DM;
        WR[i] = (o < 4) ? wrg[k * 4 + o] : wre[((size_t)((o - 4) >> 2) * DM + k) * 4 + ((o - 4) & 3)]; }
}
__device__ __forceinline__ int moe_off(const gu32* cnt, int e) { int s = 0;
#pragma unroll
    for (int j = 0; j < 16; ++j) { const int c = (int)cnt[j]; s += (j < e) ? c : 0; } return s; }
template <int MODE, bool OUTF>
__device__ __forceinline__ void norm_row(Frame& F, int m, const float* xin, const float* g, const gu32* cntprev, float* outf) {
    float* XR = (float*)(F.ws + WS_XR); bf16* XN = (bf16*)(F.ws + WS_XN);
    const GAS f32x4* xr = (const GAS f32x4*)((MODE == 0 ? xin : XR) + (size_t)m * DM) + F.lane;
    f32x4 v[8];
#pragma unroll
    for (int j = 0; j < 8; ++j) v[j] = xr[64 * j];
    if (MODE == 1) {
        const int* TOKPOS = (const int*)(F.ws + WS_LISTS + 1 * MiB); const bf16* MO = (const bf16*)(F.ws + WS_MOEOUT);
#pragma unroll
        for (int k = 0; k < 2; ++k) { const int tp = TOKPOS[m * 2 + k]; const int e = tp >> 13, pos = tp & 8191; const int slot = moe_off(cntprev, e) + pos;
            const GAS v2u* mr = (const GAS v2u*)(MO + (size_t)slot * DM) + F.lane;
#pragma unroll
            for (int j = 0; j < 8; ++j) { const v2u w = mr[64 * j]; v[j].x += bfl(w.x); v[j].y += bfh(w.x); v[j].z += bfl(w.y); v[j].w += bfh(w.y); } }
        GAS f32x4* xw = (GAS f32x4*)(XR + (size_t)m * DM) + F.lane;
        if (!OUTF) {
#pragma unroll
            for (int j = 0; j < 8; ++j) xw[64 * j] = v[j]; }
    }
    float ss = 0.f;
#pragma unroll
    for (int j = 0; j < 8; ++j) ss += (v[j].x * v[j].x + v[j].y * v[j].y) + (v[j].z * v[j].z + v[j].w * v[j].w);
    const float rstd = 1.0f / sqrtf(wave_sum(ss) * (1.0f / DM) + EPS);
    const GAS f32x4* gp = (const GAS f32x4*)g + F.lane;
    if (OUTF) { GAS f32x4* o = (GAS f32x4*)(outf + (size_t)m * DM) + F.lane;
#pragma unroll
        for (int j = 0; j < 8; ++j) { const f32x4 gg = gp[64 * j]; o[64 * j] = v[j] * rstd * gg; } }
    else { GAS v2u* o = (GAS v2u*)(XN + (size_t)m * DM) + F.lane;
#pragma unroll
        for (int j = 0; j < 8; ++j) { const f32x4 gg = gp[64 * j]; const f32x4 r = v[j] * rstd * gg; v2u w; w.x = pk2(r.x, r.y); w.y = pk2(r.z, r.w); o[64 * j] = w; } }
}

__device__ __forceinline__ void sgu_unit(Frame& F, int l, int ch, int g) {
    constexpr int RS = 136;
    LAS bf16* Wb = (LAS bf16*)(F.lds);
    LAS bf16* Vt = (LAS bf16*)(F.lds + 128 * RS * 2);
    LAS float* st = (LAS float*)(F.lds + 2 * 128 * RS * 2);
    const bf16* GV = (const bf16*)(F.ws + WS_GV); const bf16* U = (const bf16*)(F.ws + WS_U); bf16* Y = (bf16*)(F.ws + WS_Y);
    const float* lng = F.in[I_LNG] + l * SGW; const float* lnb = F.in[I_LNB] + l * SGW;
    const float* Wg = F.in[I_SGW] + ((size_t)l * 8 + g) * 128 * 128; const float* bg = F.in[I_SGB] + (l * 8 + g) * 128;
    const int t0 = ch * 128;
    __syncthreads();
    {
        const int row = F.tid >> 2, part = F.tid & 3; const GAS v4u* rp = (const GAS v4u*)(GV + (size_t)(t0 + row) * SGW);
        float s = 0.f, q = 0.f;
#pragma unroll 4
        for (int i = 0; i < 32; ++i) { const v4u w = rp[part + 4 * i]; const unsigned ww[4] = {w.x, w.y, w.z, w.w};
#pragma unroll
            for (int j = 0; j < 4; ++j) { const float a = bfl(ww[j]), b = bfh(ww[j]); s += a + b; q += a * a + b * b; } }
        s += __shfl_xor(s, 1); s += __shfl_xor(s, 2); q += __shfl_xor(q, 1); q += __shfl_xor(q, 2);
        const float mu = s * (1.0f / SGW); const float var = fmaxf(q * (1.0f / SGW) - mu * mu, 0.f);
        if (part == 0) { st[row] = mu; st[128 + row] = 1.0f / sqrtf(var + EPS); }
    }
    {
#pragma unroll
        for (int i = 0; i < 8; ++i) { const int idx = F.tid + NTHR * i; const int t = idx >> 5, s4 = (idx & 31) * 4; const f32x4 w = *(const GAS f32x4*)(Wg + t * 128 + s4);
            v2u o; o.x = pk2(w.x, w.y); o.y = pk2(w.z, w.w); *(LAS v2u*)(Wb + t * RS + s4) = o; }
    }
    __syncthreads();
    {
#pragma unroll
        for (int i = 0; i < 4; ++i) { const int chunk = F.tid + NTHR * i; const int s = chunk >> 4, kc = chunk & 15;
            const v4u w = *(const GAS v4u*)(GV + (size_t)(t0 + s) * SGW + g * 128 + 8 * kc); const unsigned ww[4] = {w.x, w.y, w.z, w.w};
            const float mu = st[s], rs = st[128 + s];
#pragma unroll
            for (int j = 0; j < 4; ++j) { const int k = 8 * kc + 2 * j; const float a = (bfl(ww[j]) - mu) * rs * lng[g * 128 + k] + lnb[g * 128 + k], b = (bfh(ww[j]) - mu) * rs * lng[g * 128 + k + 1] + lnb[g * 128 + k + 1];
                Vt[k * RS + s] = (bf16)f2bf(a); Vt[(k + 1) * RS + s] = (bf16)f2bf(b); } }
    }
    __syncthreads();
    {
        const int fr = F.lane & 15, fq = F.lane >> 4, tw = F.wave * 16;
        bf16x8 af[4];
#pragma unroll
        for (int ks = 0; ks < 4; ++ks) af[ks] = *(const LAS bf16x8*)(Wb + (tw + fr) * RS + ks * 32 + fq * 8);
        const int t = t0 + tw + fr; const float bias = bg[tw + fr];
#pragma unroll
        for (int kt = 0; kt < 8; ++kt) { f32x4 acc = (f32x4){0.f, 0.f, 0.f, 0.f};
#pragma unroll
            for (int ks = 0; ks < 4; ++ks) { const bf16x8 bfv = *(const LAS bf16x8*)(Vt + (kt * 16 + fr) * RS + ks * 32 + fq * 8);
                acc = __builtin_amdgcn_mfma_f32_16x16x32_bf16(bfv, af[ks], acc, 0, 0, 0); }
            const int kcol = g * 128 + kt * 16 + 4 * fq;
            const v2u uw = *(const GAS v2u*)(U + (size_t)t * SGW + kcol);
            v2u o; o.x = pk2(bfl(uw.x) * (acc[0] + bias), bfh(uw.x) * (acc[1] + bias)); o.y = pk2(bfl(uw.y) * (acc[2] + bias), bfh(uw.y) * (acc[3] + bias));
            *(GAS v2u*)(Y + (size_t)t * DM + 1024 + kcol) = o; }
    }
}

__device__ __forceinline__ void hy_filter_gen(Frame& F, int c0, float* FS) {
    const bf16* A2 = (const bf16*)(F.ws + WS_A2); const bf16* W3T = (const bf16*)(F.ws + WS_W3T);
    const int fr = F.lane & 15, fq = F.lane >> 4;
    const int chl = fr >> 2, o = (fr >> 1) & 1, dir = fr & 1, col = dir * 2048 + o * 1024 + c0 + chl;
    const bf16x8 b0 = *(const GAS bf16x8*)(W3T + (size_t)col * 64 + fq * 8), b1 = *(const GAS bf16x8*)(W3T + (size_t)col * 64 + 32 + fq * 8);
    const float delta = 3.0701134573253944f + (float)(c0 + chl) * (12.280453829301579f / 1023.0f);
    const float kdec = -delta * 1.4426950408889634f / (float)(SEQ - 1);
    for (int tile = F.wave; tile < SEQ / 16; tile += NWAVES) {
        const int t0 = tile * 16;
        const bf16x8 a0 = *(const GAS bf16x8*)(A2 + (size_t)(t0 + fr) * 64 + fq * 8), a1 = *(const GAS bf16x8*)(A2 + (size_t)(t0 + fr) * 64 + 32 + fq * 8);
        f32x4 acc = (f32x4){0.f, 0.f, 0.f, 0.f};
        acc = __builtin_amdgcn_mfma_f32_16x16x32_bf16(a0, b0, acc, 0, 0, 0);
        acc = __builtin_amdgcn_mfma_f32_16x16x32_bf16(a1, b1, acc, 0, 0, 0);
        const int tb = t0 + 4 * fq;
#pragma unroll
        for (int r = 0; r < 4; ++r) acc[r] *= __builtin_amdgcn_exp2f(kdec * (float)(tb + r));
        *(GAS f32x4*)(FS + (size_t)fr * SEQ + tb) = acc;
    }
}
__device__ __forceinline__ void hyena_block(Frame& F, int l, int blk) {
    LAS c32* A = (LAS c32*)(F.lds); LAS c32* B = A + HY_LDS_C32;
    float* FS = (float*)(F.ws + WS_FS) + (size_t)blk * 16 * SEQ;
    const unsigned* ZT = (const unsigned*)(F.ws + WS_ZT); bf16* Y = (bf16*)(F.ws + WS_Y);
    const float* cw = F.in[I_CONVW] + (size_t)l * 3 * NHY; const float* cb = F.in[I_CONVB] + (size_t)l * NHY; const float* skp = F.in[I_SKIP] + (size_t)l * 2 * HYW;
    const int c0 = blk * 4, tid = F.tid;
    __syncthreads();
    hy_filter_gen(F, c0, FS);
    VM_WAIT(); __syncthreads();
    for (int chl = 0; chl < 4; ++chl) {
        const int c = c0 + chl; const float* fs = FS + (size_t)chl * 4 * SEQ;
        float keep[16];
        c32 s[16];
        hy_filter_s1(tid, B, fs, fs + SEQ);
        hy_conv3_load(tid, ZT + (size_t)(2048 + c) * (SEQ / 2), cw[2048 + c], cw[NHY + 2048 + c], cw[2 * NHY + 2048 + c], cb[2048 + c], keep);
        hy_data_s1(tid, A, keep);
#pragma unroll 1
        for (int ord = 0; ord < 2; ++ord) {
            __syncthreads();
            fft_s2_fwd(tid, A); fft_s2_fwd(tid, B);
            __syncthreads();
            fft_s3_read<-1>(tid, A, s); fft_s3_write(tid, A, s);
            fft_s3_read<-1>(tid, B, s); fft_s3_write(tid, B, s);
            __syncthreads();
            pair_pass(tid, A, B);
            __syncthreads();
            fft_s3_read<1>(tid, A, s); fft_s3_write(tid, A, s);
            __syncthreads();
            fft_s2_inv(tid, A);
            __syncthreads();
            fft_s1_inv(tid, A, s);
            if (ord == 0) {
                float x1[16];
                hy_conv3_load(tid, ZT + (size_t)c * (SEQ / 2), cw[c], cw[NHY + c], cw[2 * NHY + c], cb[c], x1);
                const float sk0 = skp[c];
#pragma unroll
                for (int q = 0; q < 8; ++q) { keep[2 * q] = x1[2 * q] * (s[q].x + keep[2 * q] * sk0); keep[2 * q + 1] = x1[2 * q + 1] * (s[q].y + keep[2 * q + 1] * sk0); }
                hy_filter_s1(tid, B, fs + 2 * SEQ, fs + 3 * SEQ);
                hy_data_s1(tid, A, keep);
            } else {
                float x2[16];
                hy_conv3_load(tid, ZT + (size_t)(1024 + c) * (SEQ / 2), cw[1024 + c], cw[NHY + 1024 + c], cw[2 * NHY + 1024 + c], cb[1024 + c], x2);
                const float sk1 = skp[HYW + c];
#pragma unroll
                for (int q = 0; q < 8; ++q) { const int m = tid + 512 * q;
                    Y[(size_t)(2 * m) * DM + c] = (bf16)f2bf(x2[2 * q] * (s[q].x + keep[2 * q] * sk1));
                    Y[(size_t)(2 * m + 1) * DM + c] = (bf16)f2bf(x2[2 * q + 1] * (s[q].y + keep[2 * q + 1] * sk1)); }
            }
        }
        __syncthreads();
    }
}

__device__ __forceinline__ void route_block(Frame& F, int l, int tb  ) {
    LAS int* lcnt = (LAS int*)(F.lds);
    LAS int* lbase = (LAS int*)(F.lds + 64);
    LAS int* le = (LAS int*)(F.lds + 128);
    LAS int* lp = (LAS int*)(F.lds + 128 + 256);
    LAS float* lw = (LAS float*)(F.lds + 128 + 512);
    const float* XR = (const float*)(F.ws + WS_XR); bf16* H = (bf16*)(F.ws + WS_XN); const float* WR = (const float*)(F.ws + WS_WR);
    const float* g = F.in[I_GFFN] + (size_t)l * DM; const float* brg = F.in[I_BRG] + l * 4; const float* bre = F.in[I_BRE] + l * 16;
    int* TOKLIST = (int*)(F.ws + WS_LISTS); float* WLIST = (float*)(F.ws + WS_LISTS + 512 * 1024); int* TOKPOS = (int*)(F.ws + WS_LISTS + 1 * MiB);
    gu32* gcnt = F.ctl + CW_CNT + 64 * l;
    __syncthreads();
    if (F.tid < 16) lcnt[F.tid] = 0;
    __syncthreads();
    const int ts = F.tid >> 4, part = F.tid & 15, tok = tb + ts;
    const float* xrow = XR + (size_t)tok * DM;
    float acc[20], ss = 0.f;
#pragma unroll
    for (int o = 0; o < 20; ++o) acc[o] = 0.f;
#pragma unroll 2
    for (int i = 0; i < 32; ++i) { const int k = 4 * (part + 16 * i);
        const f32x4 x = *(const GAS f32x4*)(xrow + k); const f32x4 gg = *(const GAS f32x4*)(g + k); const f32x4 xg = x * gg;
        ss += (x.x * x.x + x.y * x.y) + (x.z * x.z + x.w * x.w);
#pragma unroll
        for (int o = 0; o < 20; ++o) { const f32x4 w = *(const GAS f32x4*)(WR + (size_t)o * DM + k); acc[o] += (xg.x * w.x + xg.y * w.y) + (xg.z * w.z + xg.w * w.w); } }
#pragma unroll
    for (int sh = 1; sh < 16; sh <<= 1) { ss += __shfl_xor(ss, sh);
#pragma unroll
        for (int o = 0; o < 20; ++o) acc[o] += __shfl_xor(acc[o], sh); }
    const float rstd = 1.0f / sqrtf(ss * (1.0f / DM) + EPS);
    {
        float lg0 = acc[0] * rstd + brg[0], lg1 = acc[1] * rstd + brg[1], lg2 = acc[2] * rstd + brg[2], lg3 = acc[3] * rstd + brg[3];
        int grp = 0; float mx = lg0;
        if (lg1 > mx) { mx = lg1; grp = 1; } if (lg2 > mx) { mx = lg2; grp = 2; } if (lg3 > mx) { mx = lg3; grp = 3; }
        const float den = (__expf(lg0 - mx) + __expf(lg1 - mx)) + (__expf(lg2 - mx) + __expf(lg3 - mx));
        const float psel = 1.0f / den;
        const float m0 = (grp == 0) ? 1.f : 0.f, m1 = (grp == 1) ? 1.f : 0.f, m2 = (grp == 2) ? 1.f : 0.f, m3 = (grp == 3) ? 1.f : 0.f;
        float e0v = (m0 * acc[4] + m1 * acc[8]) + (m2 * acc[12] + m3 * acc[16]), e1v = (m0 * acc[5] + m1 * acc[9]) + (m2 * acc[13] + m3 * acc[17]);
        float e2v = (m0 * acc[6] + m1 * acc[10]) + (m2 * acc[14] + m3 * acc[18]), e3v = (m0 * acc[7] + m1 * acc[11]) + (m2 * acc[15] + m3 * acc[19]);
        e0v = e0v * rstd + bre[grp * 4 + 0]; e1v = e1v * rstd + bre[grp * 4 + 1]; e2v = e2v * rstd + bre[grp * 4 + 2]; e3v = e3v * rstd + bre[grp * 4 + 3];
        int i0 = 0; float v0 = e0v;
        if (e1v > v0) { v0 = e1v; i0 = 1; } if (e2v > v0) { v0 = e2v; i0 = 2; } if (e3v > v0) { v0 = e3v; i0 = 3; }
        int i1 = -1; float v1 = -3.0e38f;
        if (i0 != 0 && e0v > v1) { v1 = e0v; i1 = 0; } if (i0 != 1 && e1v > v1) { v1 = e1v; i1 = 1; } if (i0 != 2 && e2v > v1) { v1 = e2v; i1 = 2; } if (i0 != 3 && e3v > v1) { v1 = e3v; i1 = 3; }
        const float ex = __expf(v1 - v0); const float w0 = psel / (1.0f + ex), w1 = psel * ex / (1.0f + ex);
        if (part == 0) { const int ea = grp * 4 + i0, eb = grp * 4 + i1;
            le[ts * 2] = ea; le[ts * 2 + 1] = eb; lw[ts * 2] = w0; lw[ts * 2 + 1] = w1;
            lp[ts * 2] = __hip_atomic_fetch_add(lcnt + ea, 1, __ATOMIC_RELAXED, __HIP_MEMORY_SCOPE_WORKGROUP); lp[ts * 2 + 1] = __hip_atomic_fetch_add(lcnt + eb, 1, __ATOMIC_RELAXED, __HIP_MEMORY_SCOPE_WORKGROUP); }
    }
#pragma unroll 4
    for (int i = 0; i < 32; ++i) { const int k = 4 * (part + 16 * i); const f32x4 x = *(const GAS f32x4*)(xrow + k); const f32x4 gg = *(const GAS f32x4*)(g + k);
        const f32x4 r = x * rstd * gg; v2u w; w.x = pk2(r.x, r.y); w.y = pk2(r.z, r.w); *(GAS v2u*)(H + (size_t)tok * DM + k) = w; }
    __syncthreads();
    if (F.tid < 16) lbase[F.tid] = (int)__hip_atomic_fetch_add(gcnt + F.tid, (unsigned)lcnt[F.tid], RLX_AGENT);
    __syncthreads();
    if (F.tid < 64) { const int t2 = F.tid >> 1; const int e = le[F.tid], pos = lbase[e] + lp[F.tid];
        TOKLIST[e * SEQ + pos] = tb + t2; WLIST[e * SEQ + pos] = lw[F.tid]; TOKPOS[(tb + t2) * 2 + (F.tid & 1)] = (e << 13) | pos; }
}
using pg8::Unit; using pg8::f32x2; using pg8::u32x4; using pg8::cvt_pk_bf16; using pg8::gelu_pk; using pg8::sigmoid_f;
__device__ __forceinline__ void tile_of(int idx, int nM, int nN, int& pm, int& pn) {
    const int nig = 8 * nN, gid = idx / nig, fm = gid * 8, gsz = (nM - fm) < 8 ? (nM - fm) : 8;
    pm = fm + ((idx % nig) % gsz); pn = (idx % nig) / gsz;
}
__device__ __forceinline__ int xcd_remap(int L, int nwg) { const int q = nwg / 8, r = nwg % 8, xcd = L % 8, off = L / 8; return (xcd < r ? xcd * (q + 1) : r * (q + 1) + (xcd - r) * q) + off; }

struct InProjSched {
    static constexpr bool GATHER = false;
    const char* XN; const char* WIN; int G, c;
    __device__ __forceinline__ bool next(int i, Unit& u) const {
        const int L = i * G + c; if (L >= 1152) return false;
        const int w = xcd_remap(L, 1152);
        if (w < 384) { u.kind = 0; tile_of(w, 12, 32, u.pm, u.pn); } else { u.kind = 1; tile_of(w - 384, 32, 24, u.pm, u.pn); }
        u.e = 0; u.row0 = 0; u.nvalid = 256; return true;
    }
    __device__ __forceinline__ const char* a_base(const Unit& u) const { return (u.kind == 0 ? WIN : XN) + (size_t)u.pm * (256 * DM * 2); }
    __device__ __forceinline__ const char* b_base(const Unit& u) const { return (u.kind == 0 ? XN : WIN + (size_t)NHY * DM * 2) + (size_t)u.pn * (256 * DM * 2); }
    __device__ __forceinline__ unsigned a_goff(const Unit&, int) const { return 0u; }
};
struct EpiInProj {
    static constexpr bool PERM = true, MIDK = false;
    bf16 *ZT, *U; const float* bin;
    __device__ __forceinline__ void operator()(const f32x4 (&acc)[2][2][4][2], const Unit& u, int wr, int wc, int fr, int fq) const {
        if (u.kind == 0) {
            const int row0 = u.pm * 256 + wr * 64 + fr, col0 = u.pn * 256 + wc * 32 + 8 * fq;
#pragma unroll
            for (int ai = 0; ai < 2; ++ai)
#pragma unroll
                for (int m = 0; m < 4; ++m) { const int row = row0 + ai * 128 + m * 16; const float b = bin[row]; bf16* rowp = ZT + (size_t)row * SEQ + col0;
#pragma unroll
                    for (int bj = 0; bj < 2; ++bj) { const f32x4 v0 = acc[ai][bj][m][0] + b, v1 = acc[ai][bj][m][1] + b;
                        u32x4 w; w.x = cvt_pk_bf16(v0[0], v0[1]); w.y = cvt_pk_bf16(v0[2], v0[3]); w.z = cvt_pk_bf16(v1[0], v1[1]); w.w = cvt_pk_bf16(v1[2], v1[3]);
                        *(u32x4*)(rowp + bj * 128) = w; } }
        } else {
            const int seg = (u.pn < 4) ? 0 : (u.pn < 8) ? 1 : (u.pn < 16) ? 2 : 3;
            const size_t boff = (seg == 0) ? 0 : (seg == 1) ? (WS_GV - WS_U) : (seg == 2) ? (WS_GH - WS_U) : (WS_GS - WS_U);
            bf16* base = (bf16*)((char*)U + boff);
            const int ldc = (seg < 2) ? 1024 : 2048, colt = (seg == 0) ? u.pn * 256 : (seg == 1) ? (u.pn - 4) * 256 : (seg == 2) ? (u.pn - 8) * 256 : (u.pn - 16) * 256;
            const int row0 = u.pm * 256 + wr * 64 + fr, col0 = colt + wc * 32 + 8 * fq, bcol0 = NHY + u.pn * 256 + wc * 32 + 8 * fq;
            f32x4 bv[2][2];
#pragma unroll
            for (int bj = 0; bj < 2; ++bj)
#pragma unroll
                for (int n = 0; n < 2; ++n) bv[bj][n] = *(const f32x4*)(bin + bcol0 + bj * 128 + 4 * n);
#pragma unroll
            for (int ai = 0; ai < 2; ++ai)
#pragma unroll
                for (int m = 0; m < 4; ++m) { bf16* rowp = base + (size_t)(row0 + ai * 128 + m * 16) * ldc + col0;
#pragma unroll
                    for (int bj = 0; bj < 2; ++bj) { f32x4 v0 = acc[ai][bj][m][0] + bv[bj][0], v1 = acc[ai][bj][m][1] + bv[bj][1];
                        if (seg < 2) { const f32x2 a = gelu_pk((f32x2){v0[0], v0[1]}), b = gelu_pk((f32x2){v0[2], v0[3]}), c = gelu_pk((f32x2){v1[0], v1[1]}), d = gelu_pk((f32x2){v1[2], v1[3]});
                            v0 = (f32x4){a.x, a.y, b.x, b.y}; v1 = (f32x4){c.x, c.y, d.x, d.y}; }
                        else {
#pragma unroll
                            for (int j = 0; j < 4; ++j) { v0[j] = sigmoid_f(v0[j]); v1[j] = sigmoid_f(v1[j]); } }
                        u32x4 w; w.x = cvt_pk_bf16(v0[0], v0[1]); w.y = cvt_pk_bf16(v0[2], v0[3]); w.z = cvt_pk_bf16(v1[0], v1[1]); w.w = cvt_pk_bf16(v1[2], v1[3]);
                        *(u32x4*)(rowp + bj * 128) = w; } }
        }
    }
    __device__ __forceinline__ void mid(f32x4 (&)[2][2][4][2], const Unit&, int, int, int, int) const {}
};
struct GridSched {
    static constexpr bool GATHER = false;
    const char* A; const char* Bt; int nM, nN, K, G, c;
    __device__ __forceinline__ bool next(int i, Unit& u) const {
        const int L = i * G + c, nwg = nM * nN; if (L >= nwg) return false;
        tile_of(xcd_remap(L, nwg), nM, nN, u.pm, u.pn); u.kind = 0; u.e = 0; u.row0 = 0; u.nvalid = 256; return true;
    }
    __device__ __forceinline__ const char* a_base(const Unit& u) const { return A + (size_t)u.pm * 512 * K; }
    __device__ __forceinline__ const char* b_base(const Unit& u) const { return Bt + (size_t)u.pn * 512 * K; }
    __device__ __forceinline__ unsigned a_goff(const Unit&, int) const { return 0u; }
};
struct EpiMerge {
    static constexpr bool PERM = true, MIDK = true;
    const bf16 *GH, *GS; bf16* O;
    __device__ __forceinline__ void mid(f32x4 (&acc)[2][2][4][2], const Unit& u, int wr, int wc, int fr, int fq) const {
        asm volatile("" : "+v"(fr), "+v"(fq));
        const int row0 = u.pm * 256 + wr * 64 + fr, col0 = u.pn * 256 + wc * 32 + 8 * fq;
#pragma unroll
        for (int ai = 0; ai < 2; ++ai)
#pragma unroll
            for (int m = 0; m < 4; ++m) { const size_t off = (size_t)(row0 + ai * 128 + m * 16) * DM + col0;
#pragma unroll
                for (int bj = 0; bj < 2; ++bj) { const u32x4 h = *(const u32x4*)(GH + off + bj * 128), s = *(const u32x4*)(GS + off + bj * 128);
                    const unsigned hh[4] = {h.x, h.y, h.z, h.w}, sv[4] = {s.x, s.y, s.z, s.w};
#pragma unroll
                    for (int j = 0; j < 4; ++j) { const float r0 = bfl(hh[j]) * __builtin_amdgcn_rcpf(bfl(sv[j])), r1 = bfh(hh[j]) * __builtin_amdgcn_rcpf(bfh(sv[j]));
                        acc[ai][bj][m][j >> 1][(j & 1) * 2] *= r0; acc[ai][bj][m][j >> 1][(j & 1) * 2 + 1] *= r1; } }
                asm volatile("" : "+v"(acc[ai][0][m][0]), "+v"(acc[ai][0][m][1]), "+v"(acc[ai][1][m][0]), "+v"(acc[ai][1][m][1]));
                asm volatile("" ::: "memory"); }
    }
    __device__ __forceinline__ void operator()(const f32x4 (&acc)[2][2][4][2], const Unit& u, int wr, int wc, int fr, int fq) const {
        const int row0 = u.pm * 256 + wr * 64 + fr, col0 = u.pn * 256 + wc * 32 + 8 * fq;
#pragma unroll
        for (int ai = 0; ai < 2; ++ai)
#pragma unroll
            for (int m = 0; m < 4; ++m) { const size_t off = (size_t)(row0 + ai * 128 + m * 16) * DM + col0;
#pragma unroll
                for (int bj = 0; bj < 2; ++bj) { const u32x4 s = *(const u32x4*)(GS + off + bj * 128); const unsigned sv[4] = {s.x, s.y, s.z, s.w};
                    const f32x4 v0 = acc[ai][bj][m][0], v1 = acc[ai][bj][m][1];
                    u32x4 w; w.x = cvt_pk_bf16(v0[0] * bfl(sv[0]), v0[1] * bfh(sv[0])); w.y = cvt_pk_bf16(v0[2] * bfl(sv[1]), v0[3] * bfh(sv[1]));
                    w.z = cvt_pk_bf16(v1[0] * bfl(sv[2]), v1[1] * bfh(sv[2])); w.w = cvt_pk_bf16(v1[2] * bfl(sv[3]), v1[3] * bfh(sv[3]));
                    *(u32x4*)(O + off + bj * 128) = w; }
                asm volatile("" ::: "memory"); }
    }
};
struct EpiResid {
    static constexpr bool PERM = false, MIDK = false;
    const float* base; float* out;
    __device__ __forceinline__ void operator()(const f32x4 (&acc)[2][2][4][2], const Unit& u, int wr, int wc, int fr, int fq) const {
        const int row0 = u.pm * 256 + wr * 64 + fr, col0 = u.pn * 256 + wc * 32 + 4 * fq;
#pragma unroll
        for (int ai = 0; ai < 2; ++ai)
#pragma unroll
            for (int m = 0; m < 4; ++m) { const size_t off = (size_t)(row0 + ai * 128 + m * 16) * DM + col0;
#pragma unroll
                for (int bj = 0; bj < 2; ++bj)
#pragma unroll
                    for (int n = 0; n < 2; ++n) { const f32x4 b = *(const f32x4*)(base + off + bj * 128 + n * 16); *(f32x4*)(out + off + bj * 128 + n * 16) = b + acc[ai][bj][m][n]; } }
    }
    __device__ __forceinline__ void mid(f32x4 (&)[2][2][4][2], const Unit&, int, int, int, int) const {}
};
struct MoeSched1 {
    static constexpr bool GATHER = true;
    const LAS int* tab; const char* H; const char* W; const int* toklist; int G, c;
    __device__ __forceinline__ bool next(int i, Unit& u) const {
        const int L = i * G + c; const int total = __builtin_amdgcn_readfirstlane(tab[16]) * 4; if (L >= total) return false;
        const int rt = L >> 2; int e = 0;
#pragma unroll
        for (int j = 1; j < 16; ++j) e += (__builtin_amdgcn_readfirstlane(tab[j]) <= rt) ? 1 : 0;
        const int j0 = rt - __builtin_amdgcn_readfirstlane(tab[e]);
        u.pm = j0; u.pn = L & 3; u.kind = 0; u.e = e; u.row0 = __builtin_amdgcn_readfirstlane(tab[17 + e]) + 256 * j0;
        const int rem = __builtin_amdgcn_readfirstlane(tab[34 + e]) - 256 * j0; u.nvalid = rem < 256 ? rem : 256; return true;
    }
    __device__ __forceinline__ const char* a_base(const Unit&) const { return H; }
    __device__ __forceinline__ const char* b_base(const Unit& u) const { return W + ((size_t)u.e * 1024 + (size_t)u.pn * 256) * DM * 2; }
    __device__ __forceinline__ unsigned a_goff(const Unit& u, int r) const { const int tok = (r < u.nvalid) ? toklist[u.e * SEQ + u.pm * 256 + r] : 0; return (unsigned)tok * (unsigned)(DM * 2); }
};
struct EpiMoe1 {
    static constexpr bool PERM = true, MIDK = false;
    bf16* ACT; const float* wlist;
    __device__ __forceinline__ void operator()(const f32x4 (&acc)[2][2][4][2], const Unit& u, int wr, int wc, int fr, int fq) const {
        const int col0 = u.pn * 128 + wc * 32 + 8 * fq;
#pragma unroll
        for (int ai = 0; ai < 2; ++ai)
#pragma unroll
            for (int m = 0; m < 4; ++m) { const int rl = ai * 128 + wr * 64 + m * 16 + fr;
                if (rl < u.nvalid) { const float wt = wlist[u.e * SEQ + u.pm * 256 + rl];
                    const f32x4 g0 = acc[ai][0][m][0], g1 = acc[ai][0][m][1], u0 = acc[ai][1][m][0], u1 = acc[ai][1][m][1];
                    float o[8];
#pragma unroll
                    for (int j = 0; j < 4; ++j) { o[j] = g0[j] * sigmoid_f(g0[j]) * u0[j] * wt; o[4 + j] = g1[j] * sigmoid_f(g1[j]) * u1[j] * wt; }
                    u32x4 w; w.x = cvt_pk_bf16(o[0], o[1]); w.y = cvt_pk_bf16(o[2], o[3]); w.z = cvt_pk_bf16(o[4], o[5]); w.w = cvt_pk_bf16(o[6], o[7]);
                    *(u32x4*)(ACT + (size_t)(u.row0 + rl) * DEXP + col0) = w; } }
    }
    __device__ __forceinline__ void mid(f32x4 (&)[2][2][4][2], const Unit&, int, int, int, int) const {}
};
struct MoeSched2 {
    static constexpr bool GATHER = false;
    const LAS int* tab; const char* ACT; const char* W; int G, c;
    __device__ __forceinline__ bool next(int i, Unit& u) const {
        const int L = i * G + c; const int total = __builtin_amdgcn_readfirstlane(tab[16]) * 8; if (L >= total) return false;
        const int rt = L >> 3; int e = 0;
#pragma unroll
        for (int j = 1; j < 16; ++j) e += (__builtin_amdgcn_readfirstlane(tab[j]) <= rt) ? 1 : 0;
        const int j0 = rt - __builtin_amdgcn_readfirstlane(tab[e]);
        u.pm = j0; u.pn = L & 7; u.kind = 0; u.e = e; u.row0 = __builtin_amdgcn_readfirstlane(tab[17 + e]) + 256 * j0;
        const int rem = __builtin_amdgcn_readfirstlane(tab[34 + e]) - 256 * j0; u.nvalid = rem < 256 ? rem : 256; return true;
    }
    __device__ __forceinline__ const char* a_base(const Unit& u) const { return ACT + (size_t)u.row0 * DEXP * 2; }
    __device__ __forceinline__ const char* b_base(const Unit& u) const { return W + ((size_t)u.e * DM + (size_t)u.pn * 256) * DEXP * 2; }
    __device__ __forceinline__ unsigned a_goff(const Unit&, int) const { return 0u; }
};
struct EpiMoe2 {
    static constexpr bool PERM = true, MIDK = false;
    bf16* MO;
    __device__ __forceinline__ void operator()(const f32x4 (&acc)[2][2][4][2], const Unit& u, int wr, int wc, int fr, int fq) const {
        const int col0 = u.pn * 256 + wc * 32 + 8 * fq;
#pragma unroll
        for (int ai = 0; ai < 2; ++ai)
#pragma unroll
            for (int m = 0; m < 4; ++m) { const int rl = ai * 128 + wr * 64 + m * 16 + fr;
                if (rl < u.nvalid) { bf16* rowp = MO + (size_t)(u.row0 + rl) * DM + col0;
#pragma unroll
                    for (int bj = 0; bj < 2; ++bj) { const f32x4 v0 = acc[ai][bj][m][0], v1 = acc[ai][bj][m][1];
                        u32x4 w; w.x = cvt_pk_bf16(v0[0], v0[1]); w.y = cvt_pk_bf16(v0[2], v0[3]); w.z = cvt_pk_bf16(v1[0], v1[1]); w.w = cvt_pk_bf16(v1[2], v1[3]);
                        *(u32x4*)(rowp + bj * 128) = w; } } }
    }
    __device__ __forceinline__ void mid(f32x4 (&)[2][2][4][2], const Unit&, int, int, int, int) const {}
};
__device__ __forceinline__ void moe_tables(Frame& F, int l) {
    LAS int* tab = (LAS int*)(F.lds + MISC_OFF + 128);
    __syncthreads();
    if (F.tid == 0) { int tp = 0, off = 0;
        for (int e = 0; e < 16; ++e) { const int c = (int)__hip_atomic_load(F.ctl + CW_CNT + 64 * l + e, RLX_AGENT); tab[e] = tp; tab[17 + e] = off; tab[34 + e] = c; tp += (c + 255) >> 8; off += c; }
        tab[16] = tp; tab[33] = off; }
    __syncthreads();
}

struct Args { const float* in[29]; float* out; unsigned char* ws; int ph_lo, ph_hi; };
constexpr int NPHASE = 17;
__global__ void __launch_bounds__(NTHR, 2) fwd_kernel(Args args) {
    extern __shared__ __attribute__((aligned(16))) unsigned char lds[];
    Frame F;
    F.lds = (LAS unsigned char*)lds;
    F.MISC = (volatile LAS unsigned*)(F.lds + MISC_OFF);
    F.tid = threadIdx.x; F.lane = F.tid & 63; F.wave = __builtin_amdgcn_readfirstlane(F.tid >> 6);
    F.G = gridDim.x; { const int bx = blockIdx.x; F.vcu = (F.G % 8 == 0) ? (bx % 8) * (F.G / 8) + bx / 8 : bx; }
    F.ws = args.ws; F.out = args.out; F.ctl = (gu32*)(args.ws + WS_CTL);
#pragma unroll
    for (int i = 0; i < 29; ++i) F.in[i] = args.in[i];
    for (int u = F.tid; u < 256; u += NTHR) ((LAS unsigned*)(F.lds + MISC_OFF))[u] = 0u;
    __syncthreads();
    const int lo = args.ph_lo, hi = args.ph_hi;
    const bool multi = (hi - lo) > 1;
    XcdBarrier bar; bar.bar = (unsigned*)(F.ctl + CW_BAR); bar.x = 0; bar.st = nullptr;
    if (multi) bar = xcd_barrier_post((unsigned*)(F.ctl + CW_BAR), F.MISC + 8);
#ifndef PHASE_MASK
#define PHASE_MASK 0x7ff
#endif
#define IN(k) (lo <= (k) && (k) < hi)
#define ON(j) ((PHASE_MASK >> (j)) & 1)
#define LAUNDER() do { int _t = threadIdx.x; asm volatile("" : "+v"(_t)); F.tid = _t; F.lane = _t & 63; } while (0)
#define SEAM(k) do { if (IN(k) && IN((k) + 1)) xcd_barrier(bar); } while (0)
    const int gw = F.vcu * NWAVES + F.wave, NGW = F.G * NWAVES;
    for (int l = 0; l < DEPTH; ++l) {
        const int p0 = l * 8;
        if (ON(0) && IN(p0 + 0)) { LAUNDER();
            pa_convert(F, l);
            pa_features(F, l);
            pa_router_t(F, l);
            const float* g = F.in[I_GMIX] + (size_t)l * DM;
            if (l == 0) { for (int m = gw; m < SEQ; m += NGW) norm_row<0, false>(F, m, F.in[I_X], g, nullptr, nullptr); }
            else { for (int m = gw; m < SEQ; m += NGW) norm_row<1, false>(F, m, nullptr, g, F.ctl + CW_CNT + 64 * (l - 1), nullptr); }
        }
        SEAM(p0 + 0);
        if (ON(1) && IN(p0 + 1)) { LAUNDER();
            InProjSched S{(const char*)(F.ws + WS_XN), (const char*)(F.ws + WS_WIN), F.G, (int)blockIdx.x};
            EpiInProj E{(bf16*)(F.ws + WS_ZT), (bf16*)(F.ws + WS_U), F.in[I_BIN] + (size_t)l * NIN};
            pg8::gemm_phase<EpiInProj, InProjSched>(F.lds, DM, S, E);
        }
        SEAM(p0 + 1);
        if (ON(2) && IN(p0 + 2)) { LAUNDER();
            if (ON(9)) for (int u = F.vcu; u < 512; u += F.G) sgu_unit(F, l, u >> 3, u & 7);
            if (ON(10)) for (int b = F.vcu; b < 256; b += F.G) hyena_block(F, l, b);
        }
        SEAM(p0 + 2);
        if (ON(3) && IN(p0 + 3)) { LAUNDER();
            GridSched S{(const char*)(F.ws + WS_Y), (const char*)(F.ws + WS_PT), 32, 8, DM, F.G, (int)blockIdx.x};
            EpiMerge E{(const bf16*)(F.ws + WS_GH), (const bf16*)(F.ws + WS_GS), (bf16*)(F.ws + WS_MERGED)};
            pg8::gemm_phase<EpiMerge, GridSched>(F.lds, DM, S, E);
        }
        SEAM(p0 + 3);
        if (ON(4) && IN(p0 + 4)) { LAUNDER();
            GridSched S{(const char*)(F.ws + WS_MERGED), (const char*)(F.ws + WS_WOT), 32, 8, DM, F.G, (int)blockIdx.x};
            EpiResid E{l == 0 ? F.in[I_X] : (const float*)(F.ws + WS_XR), (float*)(F.ws + WS_XR)};
            pg8::gemm_phase<EpiResid, GridSched>(F.lds, DM, S, E);
        }
        SEAM(p0 + 4);
        if (ON(5) && IN(p0 + 5)) { LAUNDER(); for (int tb = F.vcu * 32; tb < SEQ; tb += F.G * 32) route_block(F, l, tb); }
        SEAM(p0 + 5);
        if (ON(6) && IN(p0 + 6)) { LAUNDER();
            moe_tables(F, l);
            MoeSched1 S{(const LAS int*)(F.lds + MISC_OFF + 128), (const char*)(F.ws + WS_XN), (const char*)(F.ws + WS_WGU), (const int*)(F.ws + WS_LISTS), F.G, F.vcu};
            EpiMoe1 E{(bf16*)(F.ws + WS_ACT), (const float*)(F.ws + WS_LISTS + 512 * 1024)};
            pg8::gemm_phase<EpiMoe1, MoeSched1>(F.lds, DM, S, E);
        }
        SEAM(p0 + 6);
        if (ON(7) && IN(p0 + 7)) { LAUNDER();
            moe_tables(F, l);
            MoeSched2 S{(const LAS int*)(F.lds + MISC_OFF + 128), (const char*)(F.ws + WS_ACT), (const char*)(F.ws + WS_WD), F.G, F.vcu};
            EpiMoe2 E{(bf16*)(F.ws + WS_MOEOUT)};
            pg8::gemm_phase<EpiMoe2, MoeSched2>(F.lds, DEXP, S, E);
        }
        SEAM(p0 + 7);
    }
    if (ON(8) && IN(16)) { LAUNDER(); for (int m = gw; m < SEQ; m += NGW) norm_row<1, true>(F, m, nullptr, F.in[I_GFINAL], F.ctl + CW_CNT + 64 * (DEPTH - 1), F.out); }
#undef IN
#undef SEAM
}

#ifndef MK_ONE_LAUNCH
#define MK_ONE_LAUNCH 0
#endif
extern "C" void kernel_launch(void* const* d_in, const int* in_sizes, int n_in, void* d_out, int out_size, void* d_ws, size_t ws_size, hipStream_t stream) {
    static int grid = 0;
    if (grid == 0) {
        if (n_in != 29 || ws_size < WS_END) { fprintf(stderr, "kernel_launch: unexpected n_in %d or ws %zu < %zu\n", n_in, ws_size, (size_t)WS_END); grid = -1; return; }
        int dev = 0, cus = 0, per_cu = 0;
        if (hipGetDevice(&dev) != hipSuccess || hipDeviceGetAttribute(&cus, hipDeviceAttributeMultiprocessorCount, dev) != hipSuccess) { grid = -1; return; }
        if (hipFuncSetAttribute((const void*)fwd_kernel, hipFuncAttributeMaxDynamicSharedMemorySize, LDS_BYTES) != hipSuccess) { fprintf(stderr, "kernel_launch: hipFuncSetAttribute failed\n"); grid = -1; return; }
        if (hipOccupancyMaxActiveBlocksPerMultiprocessor(&per_cu, (const void*)fwd_kernel, NTHR, LDS_BYTES) != hipSuccess || per_cu < 1) fprintf(stderr, "kernel_launch: occupancy query reports %d\n", per_cu);
        (void)hipGetLastError();
        grid = cus;
    }
    if (grid < 0) return;
    (void)hipMemsetAsync((char*)d_ws + WS_CTL, 0, CTL_ZERO_BYTES, stream);
    Args a{};
    for (int i = 0; i < 29; ++i) a.in[i] = (const float*)d_in[i];
    a.out = (float*)d_out; a.ws = (unsigned char*)d_ws;
#if MK_ONE_LAUNCH
    a.ph_lo = 0; a.ph_hi = NPHASE;
    hipLaunchKernelGGL(fwd_kernel, dim3(grid), dim3(NTHR), LDS_BYTES, stream, a);
#else
    for (int p = 0; p < NPHASE; ++p) { a.ph_lo = p; a.ph_hi = p + 1; hipLaunchKernelGGL(fwd_kernel, dim3(grid), dim3(NTHR), LDS_BYTES, stream, a); }
#endif
}
```

```cpp
#include <hip/hip_runtime.h>
#include <cstdio>
#include <cstdint>
#define MK_ONE_LAUNCH 1
namespace pg8 {
#define PG8_LAS __attribute__((address_space(3)))
typedef unsigned short bf16_t;
typedef short bf16x8 __attribute__((ext_vector_type(8)));
typedef float f32x4 __attribute__((ext_vector_type(4)));
typedef float f32x2 __attribute__((ext_vector_type(2)));
typedef unsigned u32x4 __attribute__((ext_vector_type(4)));
typedef unsigned u32x2 __attribute__((ext_vector_type(2)));
constexpr int BM = 256, BK = 64, HALF = 128, HTB = HALF * BK * 2  , STAGE_BYTES = 8 * HTB;

__host__ __device__ __forceinline__ int lds_byte(int r, int c) { const int st = (r >> 4) * 2 + (c >> 5), rr = r & 15, cc = c & 31, ob = rr * 64 + cc * 2; return st * 1024 + (ob ^ (((ob >> 9) & 1) << 5)); }
__host__ __device__ __forceinline__ void stage_rc(int b, int& R, int& C) { const int st = b / 1024, sb = b % 1024, swz = sb ^ (((sb >> 9) & 1) << 5); R = (st >> 1) * 16 + swz / 64; C = (st & 1) * 32 + (swz % 64) / 2; }
__host__ __device__ __forceinline__ int perm32(int rho) { const int n = rho >> 4, i = rho & 15; return 8 * (i >> 2) + 4 * n + (i & 3); }

struct Unit { int pm, pn, kind, e, row0, nvalid; };

__device__ __forceinline__ unsigned cvt_pk_bf16(float lo, float hi) { unsigned r; asm volatile("v_cvt_pk_bf16_f32 %0, %1, %2" : "=v"(r) : "v"(lo), "v"(hi)); return r; }
__device__ __forceinline__ f32x2 gelu_pk(f32x2 v) {
    const f32x2 av = __builtin_elementwise_abs(v), d = av * 0.2316418882f + 1.0f;
    f32x2 t; t.x = __builtin_amdgcn_rcpf(d.x); t.y = __builtin_amdgcn_rcpf(d.y);
    f32x2 q = t * 0.5307027145f + (-0.7265760135f); q = q * t + 0.7107068705f; q = q * t + (-0.142248368f); q = q * t + 0.127414796f; q = q * t;
    const f32x2 s = (v * v) * (-0.72134752044f);
    f32x2 e; e.x = __builtin_amdgcn_exp2f(s.x); e.y = __builtin_amdgcn_exp2f(s.y);
    const f32x2 m = v * (q * e), r = v - m;
    f32x2 o; o.x = v.x < 0.f ? m.x : r.x; o.y = v.y < 0.f ? m.y : r.y; return o;
}
__device__ __forceinline__ float sigmoid_f(float x) { return __builtin_amdgcn_rcpf(1.0f + __builtin_amdgcn_exp2f(-1.4426950408889634f * x)); }

template <class Epi, class Sched>
__device__ __forceinline__ void gemm_phase(PG8_LAS unsigned char* lds, const int K, const Sched& S, const Epi& E) {
    int tid = threadIdx.x; asm volatile("" : "+v"(tid));
    const int wid = __builtin_amdgcn_readfirstlane(tid >> 6), lane = tid & 63, wr = wid >> 2, wc = wid & 3, fr = lane & 15, fq = lane >> 4;
    const int nt = K / BK;
    unsigned voffA[2], voffB[2]; int rowA[2];
#pragma unroll
    for (int i = 0; i < 2; ++i) { int R, C; stage_rc(tid * 16 + i * 8192, R, C); const int Rb = Epi::PERM ? ((R & ~31) + perm32(R & 31)) : R;
        voffA[i] = Sched::GATHER ? (unsigned)(C * 2) : (unsigned)(R * K + C) * 2u; voffB[i] = (unsigned)(Rb * K + C) * 2u; rowA[i] = R; }
    const size_t kstep = (size_t)(BK * 2);
    const size_t hstep = (size_t)HALF * K * 2;
    const unsigned ldsw = (unsigned)wid * 1024u;
    const int aoff = lds_byte(wr * 64 + fr, fq * 8), boff = lds_byte(wc * 32 + fr, fq * 8);
#define PG8_SA(b, h) (((b) * 2 + (h)) * HTB)
#define PG8_SB(b, h) ((4 + (b) * 2 + (h)) * HTB)
#define PG8_STAGE(bufoff, gbase, voff) do { _Pragma("unroll") for (int _i = 0; _i < 2; ++_i) \
        __builtin_amdgcn_global_load_lds((const unsigned*)((const char*)(gbase) + (voff)[_i]), (PG8_LAS unsigned*)(lds + (bufoff) + ldsw + _i * 8192), 16, 0, 0); } while (0)
#define PG8_STAGE_A(bufoff, gbase, h, GO) do { if constexpr (Sched::GATHER) { _Pragma("unroll") for (int _i = 0; _i < 2; ++_i) \
        __builtin_amdgcn_global_load_lds((const unsigned*)((const char*)(gbase) + (GO)[h][_i]), (PG8_LAS unsigned*)(lds + (bufoff) + ldsw + _i * 8192), 16, 0, 0); } \
        else { PG8_STAGE(bufoff, (gbase) + (h) * hstep, voffA); } } while (0)
#define PG8_LDA(dst, b, h) do { _Pragma("unroll") for (int m = 0; m < 4; ++m) _Pragma("unroll") for (int k = 0; k < 2; ++k) dst[m][k] = *(const PG8_LAS bf16x8*)(lds + PG8_SA(b, h) + aoff + m * 2048 + k * 1024); } while (0)
#define PG8_LDB(dst, b, h) do { _Pragma("unroll") for (int n = 0; n < 2; ++n) _Pragma("unroll") for (int k = 0; k < 2; ++k) dst[n][k] = *(const PG8_LAS bf16x8*)(lds + PG8_SB(b, h) + boff + n * 2048 + k * 1024); } while (0)
#define PG8_MMA(ai, bj, At, Bt) do { __builtin_amdgcn_s_setprio(1); _Pragma("unroll") for (int m = 0; m < 4; ++m) _Pragma("unroll") for (int n = 0; n < 2; ++n) _Pragma("unroll") for (int k = 0; k < 2; ++k) \
        acc[ai][bj][m][n] = __builtin_amdgcn_mfma_f32_16x16x32_bf16(Bt[n][k], At[m][k], acc[ai][bj][m][n], 0, 0, 0); __builtin_amdgcn_s_setprio(0); } while (0)
#define PG8_WAIT_V(n) asm volatile("s_waitcnt vmcnt(" #n ")" ::: "memory")
#define PG8_WAIT_L(n) asm volatile("s_waitcnt lgkmcnt(" #n ")" ::: "memory")
#define PG8_BAR __builtin_amdgcn_s_barrier()
#define PG8_SCHED __builtin_amdgcn_sched_barrier(0)
    Unit cur, nxt; int ui = 0;
    if (!S.next(0, cur)) return;
    f32x4 acc[2][2][4][2];
#pragma unroll
    for (int a = 0; a < 2; ++a)
#pragma unroll
        for (int b = 0; b < 2; ++b)
#pragma unroll
            for (int m = 0; m < 4; ++m)
#pragma unroll
                for (int n = 0; n < 2; ++n) acc[a][b][m][n] = (f32x4){0.f, 0.f, 0.f, 0.f};
    bf16x8 At[4][2], B0[2][2], B1[2][2];
    const char* cA = S.a_base(cur); const char* cB = S.b_base(cur);
    unsigned cgo[2][2], ngo[2][2];
    if constexpr (Sched::GATHER) {
#pragma unroll
        for (int h = 0; h < 2; ++h)
#pragma unroll
            for (int i = 0; i < 2; ++i) { cgo[h][i] = S.a_goff(cur, h * HALF + rowA[i]) + voffA[i]; ngo[h][i] = cgo[h][i]; }
    }
    PG8_STAGE(PG8_SB(0, 0), cB, voffB); PG8_STAGE(PG8_SB(0, 1), cB + hstep, voffB); PG8_STAGE_A(PG8_SA(0, 0), cA, 0, cgo); PG8_STAGE_A(PG8_SA(0, 1), cA, 1, cgo);
    if (wr == 1) PG8_BAR;
    PG8_WAIT_V(2); PG8_BAR;
    PG8_STAGE(PG8_SB(1, 0), cB + kstep, voffB); PG8_STAGE_A(PG8_SA(1, 0), cA + kstep, 0, cgo); PG8_STAGE(PG8_SB(1, 1), cB + hstep + kstep, voffB);
    PG8_WAIT_V(6); PG8_BAR;
    for (;;) {
        const bool has_next = S.next(ui + 1, nxt);
        const char* nA = has_next ? S.a_base(nxt) : cA; const char* nB = has_next ? S.b_base(nxt) : cB;
        if constexpr (Sched::GATHER) {
            if (has_next) {
#pragma unroll
                for (int h = 0; h < 2; ++h)
#pragma unroll
                    for (int i = 0; i < 2; ++i) ngo[h][i] = S.a_goff(nxt, h * HALF + rowA[i]) + voffA[i];
            }
        }
        for (int t = 0; t < nt; t += 2) {
            const bool last = (t == nt - 2);
            if constexpr (Epi::MIDK) { if (t == (nt >> 1)) E.mid(acc, cur, wr, wc, fr, fq); }
            const char* a1 = cA + (size_t)(t + 1) * kstep;
            const char* a2 = last ? nA : cA + (size_t)(t + 2) * kstep; const char* b2 = last ? nB : cB + (size_t)(t + 2) * kstep;
            const char* a3 = a2 + kstep; const char* b3 = b2 + kstep;
            unsigned xgo[2][2];
            if constexpr (Sched::GATHER) {
#pragma unroll
                for (int h = 0; h < 2; ++h)
#pragma unroll
                    for (int i = 0; i < 2; ++i) xgo[h][i] = last ? ngo[h][i] : cgo[h][i];
            }
            PG8_LDB(B0, 0, 0); PG8_LDB(B1, 0, 1); PG8_SCHED; PG8_LDA(At, 0, 0); PG8_STAGE_A(PG8_SA(1, 1), a1, 1, cgo);
            PG8_WAIT_V(8); PG8_WAIT_L(0); PG8_BAR; PG8_MMA(0, 0, At, B0); PG8_MMA(0, 1, At, B1); PG8_BAR; PG8_SCHED;
            PG8_LDA(At, 0, 1); PG8_STAGE(PG8_SB(0, 0), b2, voffB); PG8_STAGE(PG8_SB(0, 1), b2 + hstep, voffB); PG8_STAGE_A(PG8_SA(0, 0), a2, 0, xgo);
            PG8_WAIT_V(8); PG8_WAIT_L(0); PG8_BAR; PG8_MMA(1, 0, At, B0); PG8_MMA(1, 1, At, B1); PG8_BAR; PG8_SCHED;
            PG8_LDB(B0, 1, 0); PG8_LDB(B1, 1, 1); PG8_SCHED; PG8_LDA(At, 1, 0); PG8_STAGE_A(PG8_SA(0, 1), a2, 1, xgo);
            PG8_WAIT_V(8); PG8_WAIT_L(0); PG8_BAR; PG8_MMA(0, 0, At, B0); PG8_MMA(0, 1, At, B1); PG8_BAR; PG8_SCHED;
            PG8_LDA(At, 1, 1); PG8_STAGE(PG8_SB(1, 0), b3, voffB); PG8_STAGE(PG8_SB(1, 1), b3 + hstep, voffB); PG8_STAGE_A(PG8_SA(1, 0), a3, 0, xgo);
            PG8_WAIT_V(8); PG8_WAIT_L(0); PG8_BAR; PG8_MMA(1, 0, At, B0); PG8_MMA(1, 1, At, B1); PG8_BAR; PG8_SCHED;
        }
        if (wr == 0) PG8_BAR;
        E(acc, cur, wr, wc, fr, fq);
        if (!has_next) break;
#pragma unroll
        for (int a = 0; a < 2; ++a)
#pragma unroll
            for (int b = 0; b < 2; ++b)
#pragma unroll
                for (int m = 0; m < 4; ++m)
#pragma unroll
                    for (int n = 0; n < 2; ++n) acc[a][b][m][n] = (f32x4){0.f, 0.f, 0.f, 0.f};
        cur = nxt; cA = nA; cB = nB; ++ui;
        if constexpr (Sched::GATHER) {
#pragma unroll
            for (int h = 0; h < 2; ++h)
#pragma unroll
                for (int i = 0; i < 2; ++i) cgo[h][i] = ngo[h][i];
        }
        if (wr == 1) PG8_BAR;
    }
    PG8_WAIT_V(0);
    PG8_BAR;
#undef PG8_SA
#undef PG8_SB
#undef PG8_STAGE
#undef PG8_STAGE_A
#undef PG8_LDA
#undef PG8_LDB
#undef PG8_MMA
#undef PG8_WAIT_V
#undef PG8_WAIT_L
#undef PG8_BAR
#undef PG8_SCHED
}
}
constexpr int NWAVES = 8, NTHR = 512;
constexpr int SEQ = 8192, DM = 2048, NIN = 9216, HYW = 1024, SGW = 1024, NHY = 3072, NEXP = 16, DEXP = 512, DEPTH = 2;
constexpr float EPS = 1e-6f;
constexpr size_t MiB = 1u << 20;
constexpr size_t WS_CTL = 0, CTL_ZERO_BYTES = 1 * MiB;
constexpr size_t WS_WIN = 1 * MiB;
constexpr size_t WS_PT = WS_WIN + 36 * MiB;
constexpr size_t WS_WOT = WS_PT + 8 * MiB;
constexpr size_t WS_WGU = WS_WOT + 8 * MiB;
constexpr size_t WS_WD = WS_WGU + 64 * MiB;
constexpr size_t WS_W3T = WS_WD + 32 * MiB;
constexpr size_t WS_A2 = WS_W3T + 1 * MiB;
constexpr size_t WS_WR = WS_A2 + 1 * MiB;
constexpr size_t WS_LISTS = WS_WR + 1 * MiB;
constexpr size_t WS_XR = WS_LISTS + 2 * MiB;
constexpr size_t WS_XN = WS_XR + 64 * MiB;
constexpr size_t WS_ZT = WS_XN + 32 * MiB;
constexpr size_t WS_U = WS_ZT + 48 * MiB;
constexpr size_t WS_GV = WS_U + 16 * MiB;
constexpr size_t WS_GH = WS_GV + 16 * MiB;
constexpr size_t WS_GS = WS_GH + 32 * MiB;
constexpr size_t WS_Y = WS_GS + 32 * MiB;
constexpr size_t WS_FS = WS_Y + 32 * MiB;
constexpr size_t WS_END = WS_FS + 128 * MiB;
constexpr size_t WS_MERGED = WS_ZT, WS_ACT = WS_U, WS_MOEOUT = WS_FS;
constexpr int CW_TMO = 0;
constexpr int CW_CNT = 64;
constexpr int CW_BAR = 4096;
constexpr int SCRATCH_BYTES = 2 * 8448 * 8;
constexpr int MISC_OFF = SCRATCH_BYTES;
constexpr int LDS_BYTES = SCRATCH_BYTES + 1024;
static_assert(SCRATCH_BYTES >= pg8::STAGE_BYTES, "lds");

#define GAS __attribute__((address_space(1)))
#define LAS __attribute__((address_space(3)))
typedef unsigned short bf16;
typedef unsigned v4u __attribute__((ext_vector_type(4)));
typedef unsigned v2u __attribute__((ext_vector_type(2)));
typedef float f32x4 __attribute__((ext_vector_type(4)));
typedef short bf16x8 __attribute__((ext_vector_type(8)));
typedef GAS unsigned gu32;
#define RLX_AGENT __ATOMIC_RELAXED, __HIP_MEMORY_SCOPE_AGENT
#define LDS_WAIT() asm volatile("s_waitcnt lgkmcnt(0)" ::: "memory")
#define VM_WAIT() asm volatile("s_waitcnt vmcnt(0)" ::: "memory")
__device__ __forceinline__ unsigned f2bf(float f) { unsigned u = __builtin_bit_cast(unsigned, f); return (u + 0x7fffu + ((u >> 16) & 1u)) >> 16; }
__device__ __forceinline__ unsigned pk2(float lo, float hi) { return f2bf(lo) | (f2bf(hi) << 16); }
__device__ __forceinline__ float bfl(unsigned u) { return __builtin_bit_cast(float, u << 16); }
__device__ __forceinline__ float bfh(unsigned u) { return __builtin_bit_cast(float, u & 0xffff0000u); }

#define XB_TMO      128
#define XB_XCNT(j)  (256  + 64 * (j))
#define XB_XSUB(j)  (1280 + 64 * (j))
#define XB_XGEN(j)  (2304 + 64 * (j))
#define XB_TOP      3328
#define XB_TOPGEN   3392
#define XCD_BAR_WORDS 3456
#define XB_SPIN_CAP (1u << 18)
__device__ __forceinline__ unsigned xb_ld(unsigned* p)              { return __hip_atomic_load(p, __ATOMIC_RELAXED, __HIP_MEMORY_SCOPE_AGENT); }
__device__ __forceinline__ unsigned xb_add(unsigned* p, unsigned v) { return __hip_atomic_fetch_add(p, v, __ATOMIC_RELAXED, __HIP_MEMORY_SCOPE_AGENT); }
__device__ __forceinline__ unsigned xb_xcc_id() { return (unsigned)__builtin_amdgcn_s_getreg((3 << 11) | 20) & 0xFu; }
#define XB_SPIN(cond, bar) do { unsigned _sp = 0; while (cond) { __builtin_amdgcn_s_sleep(1); \
    if ((++_sp & 255u) == 0u) { if (xb_ld(&(bar)[XB_TMO])) break; if (_sp > XB_SPIN_CAP) { atomicAdd(&(bar)[XB_TMO], 1u); break; } } } } while (0)
struct XcdBarrier { unsigned* bar; unsigned x; volatile LAS unsigned* st; };
__device__ __forceinline__ XcdBarrier xcd_barrier_post(unsigned* bar, volatile LAS unsigned* st) {
    XcdBarrier b; b.bar = bar; b.x = xb_xcc_id(); b.st = st;
    if (threadIdx.x == 0) (void)xb_add(&bar[XB_XCNT(b.x)], 1u);
    return b;
}
__device__ __forceinline__ void xcd_barrier_complete(unsigned* bar, unsigned x, unsigned& nloc, unsigned& nx) {
    const unsigned G = gridDim.x * gridDim.y * gridDim.z;
    unsigned sum, cnt, mine, sp = 0u;
    for (;;) {
        sum = 0u; cnt = 0u; mine = 0u;
#pragma unroll
        for (unsigned j = 0; j < 16; ++j) { const unsigned c = xb_ld(&bar[XB_XCNT(j)]); sum += c; cnt += (c > 0u) ? 1u : 0u; mine = (j == x) ? c : mine; }
        if (sum == G) break;
        __builtin_amdgcn_s_sleep(1);
        if ((++sp & 255u) == 0u) { if (xb_ld(&bar[XB_TMO])) break; if (sp > XB_SPIN_CAP) { atomicAdd(&bar[XB_TMO], 1u); break; } }
    }
    nloc = mine > 0u ? mine : 1u; nx = cnt > 0u ? cnt : 1u;
}
__device__ __forceinline__ void xcd_barrier(const XcdBarrier& b) {
    asm volatile("s_waitcnt vmcnt(0)" ::: "memory");
    __syncthreads();
    if (threadIdx.x == 0) {
        unsigned* bar = b.bar;
        __builtin_amdgcn_s_waitcnt(0);
        unsigned nloc = b.st[0], nx = b.st[1];
        if (nloc == 0u) { xcd_barrier_complete(bar, b.x, nloc, nx); b.st[0] = nloc; b.st[1] = nx; }
        const unsigned old = xb_add(&bar[XB_XSUB(b.x)], 1u);
        const unsigned gen = old / nloc;
        if (old + 1u == (gen + 1u) * nloc) {
            __builtin_amdgcn_fence(__ATOMIC_RELEASE, "agent");
            asm volatile("s_waitcnt vmcnt(0)" ::: "memory");
            const unsigned og = xb_add(&bar[XB_TOP], 1u);
            const unsigned tg = og / nx;
            if (og + 1u == (tg + 1u) * nx) xb_add(&bar[XB_TOPGEN], 1u);
            else XB_SPIN(xb_ld(&bar[XB_TOPGEN]) == tg, bar);
            __builtin_amdgcn_fence(__ATOMIC_ACQUIRE, "agent");
            xb_add(&bar[XB_XGEN(b.x)], 1u);
            asm volatile("s_waitcnt vmcnt(0)" ::: "memory");
        } else {
            XB_SPIN(xb_ld(&bar[XB_XGEN(b.x)]) == gen, bar);
            __builtin_amdgcn_fence(__ATOMIC_ACQUIRE, "agent");
            asm volatile("s_waitcnt vmcnt(0)" ::: "memory");
        }
    }
    __syncthreads();
}

struct Frame {
    LAS unsigned char* lds;
    volatile LAS unsigned* MISC;
    gu32* ctl;
    int tid, lane, wave;
    int vcu, G;
    const float* in[29];
    float* out;
    unsigned char* ws;
};
enum { I_X = 0, I_GMIX, I_WIN, I_BIN, I_CONVW, I_CONVB, I_FW1, I_FB1, I_FW2, I_FB2, I_FW3, I_FFREQ, I_SKIP, I_LNG, I_LNB, I_SGW, I_SGB, I_WHY, I_WSG, I_WOUT, I_GFFN, I_WRG, I_BRG, I_WRE, I_BRE, I_WGATE, I_WUP, I_WDOWN, I_GFINAL };

__device__ __forceinline__ float wave_sum(float v) {
#pragma unroll
    for (int o = 1; o < 64; o <<= 1) v += __shfl_xor(v, o);
    return v;
}
#define HD __device__ __forceinline__
#define HY_OPAQUE(x) asm volatile("" : "+v"(x))
typedef float hy_f2v __attribute__((ext_vector_type(2)));
#define LDC(p, i) ({ const hy_f2v _v = *(const LAS hy_f2v*)((p) + (i)); c32 _r; _r.x = _v.x; _r.y = _v.y; _r; })
#define STC(p, i, v) do { const c32 _s = (v); hy_f2v _w; _w.x = _s.x; _w.y = _s.y; *(LAS hy_f2v*)((p) + (i)) = _w; } while (0)
struct c32 { float x, y; };
HD c32 cadd(c32 a, c32 b) { c32 r; r.x = a.x + b.x; r.y = a.y + b.y; return r; }
HD c32 csub(c32 a, c32 b) { c32 r; r.x = a.x - b.x; r.y = a.y - b.y; return r; }
HD c32 cmul(c32 a, c32 b) { c32 r; r.x = a.x * b.x - a.y * b.y; r.y = a.x * b.y + a.y * b.x; return r; }
HD c32 cmk(float x, float y) { c32 r; r.x = x; r.y = y; return r; }
HD int hpos(int e) { return e + (e >> 5); }
#define HY_N 8192
#define HY_LDS_C32 (8192 + 256)

template <int SIGN> HD void dft4(c32& a, c32& b, c32& c, c32& d) {
    const c32 t0 = cadd(a, c), t1 = csub(a, c), t2 = cadd(b, d), t3 = csub(b, d);
    a = cadd(t0, t2); c = csub(t0, t2);
    if (SIGN < 0) { b = cmk(t1.x + t3.y, t1.y - t3.x); d = cmk(t1.x - t3.y, t1.y + t3.x); }
    else          { b = cmk(t1.x - t3.y, t1.y + t3.x); d = cmk(t1.x + t3.y, t1.y - t3.x); }
}
template <int SIGN> HD void dft16(c32 (&a)[16]) {
    const float C1 = 0.92387953251128674f, S1 = 0.38268343236508977f, R2 = 0.70710678118654752f;
#pragma unroll
    for (int n2 = 0; n2 < 4; ++n2) dft4<SIGN>(a[n2], a[4 + n2], a[8 + n2], a[12 + n2]);
    const float sg = (SIGN < 0) ? -1.f : 1.f;
    const c32 w1 = cmk(C1, sg * S1), w2 = cmk(R2, sg * R2), w3 = cmk(S1, sg * C1), w4 = cmk(0.f, sg), w6 = cmk(-R2, sg * R2), w9 = cmk(-C1, -sg * S1);
    a[1 + 4] = cmul(a[1 + 4], w1); a[2 + 4] = cmul(a[2 + 4], w2); a[3 + 4] = cmul(a[3 + 4], w3);
    a[1 + 8] = cmul(a[1 + 8], w2); a[2 + 8] = cmul(a[2 + 8], w4); a[3 + 8] = cmul(a[3 + 8], w6);
    a[1 + 12] = cmul(a[1 + 12], w3); a[2 + 12] = cmul(a[2 + 12], w6); a[3 + 12] = cmul(a[3 + 12], w9);
#pragma unroll
    for (int k1 = 0; k1 < 4; ++k1) dft4<SIGN>(a[4 * k1], a[4 * k1 + 1], a[4 * k1 + 2], a[4 * k1 + 3]);
    c32 t[16];
#pragma unroll
    for (int i = 0; i < 16; ++i) t[i] = a[i];
#pragma unroll
    for (int k1 = 0; k1 < 4; ++k1)
#pragma unroll
        for (int k2 = 0; k2 < 4; ++k2) a[k1 + 4 * k2] = t[4 * k1 + k2];
}
HD void twiddle_chain(c32 (&a)[16], c32 w) {
    c32 wp = w;
#pragma unroll
    for (int p = 1; p < 16; ++p) { a[p] = cmul(a[p], wp); wp = cmul(wp, w); }
}
HD c32 cis_pi(float x) { c32 r; r.x = cospif(x); r.y = sinpif(x); return r; }

HD void fft_s1_fwd(int tid, LAS c32* buf, c32 (&a)[16]) { HY_OPAQUE(tid);
    dft16<-1>(a);
    twiddle_chain(a, cis_pi(-2.0f * (float)tid / 8192.0f));
#pragma unroll
    for (int p = 0; p < 16; ++p) STC(buf, hpos(tid + 512 * p), a[p]);
}
HD void fft_s2_fwd(int tid, LAS c32* buf) { HY_OPAQUE(tid);
    const int base = (tid >> 5) * 512 + (tid & 31);
    c32 a[16];
#pragma unroll
    for (int q = 0; q < 16; ++q) a[q] = LDC(buf, hpos(base + 32 * q));
    dft16<-1>(a);
    twiddle_chain(a, cis_pi(-2.0f * (float)(tid & 31) / 512.0f));
#pragma unroll
    for (int p = 0; p < 16; ++p) STC(buf, hpos(base + 32 * p), a[p]);
}
HD float w32c(int q) { switch (q) { case 0: return 1.0f; case 1: return 0.98078528040323043f; case 2: return 0.92387953251128674f; case 3: return 0.83146961230254524f; case 4: return 0.70710678118654752f; case 5: return 0.55557023301960218f; case 6: return 0.38268343236508977f; case 7: return 0.19509032201612825f;
    case 8: return 0.0f; case 9: return -0.19509032201612825f; case 10: return -0.38268343236508977f; case 11: return -0.55557023301960218f; case 12: return -0.70710678118654752f; case 13: return -0.83146961230254524f; case 14: return -0.92387953251128674f; default: return -0.98078528040323043f; } }
HD float w32s(int q) { switch (q) { case 0: return 0.0f; case 1: return 0.19509032201612825f; case 2: return 0.38268343236508977f; case 3: return 0.55557023301960218f; case 4: return 0.70710678118654752f; case 5: return 0.83146961230254524f; case 6: return 0.92387953251128674f; case 7: return 0.98078528040323043f;
    case 8: return 1.0f; case 9: return 0.98078528040323043f; case 10: return 0.92387953251128674f; case 11: return 0.83146961230254524f; case 12: return 0.70710678118654752f; case 13: return 0.55557023301960218f; case 14: return 0.38268343236508977f; default: return 0.19509032201612825f; } }
template <int SIGN> HD void fft_s3_read(int tid, const LAS c32* buf, c32 (&s)[16]) { HY_OPAQUE(tid);
    const int base = (tid >> 1) * 33, h = tid & 1;
    const float sg = (SIGN < 0) ? -1.f : 1.f;
#pragma unroll
    for (int q = 0; q < 16; ++q) {
        const c32 u = LDC(buf, base + q), v = LDC(buf, base + q + 16);
        const c32 sum = cadd(u, v), dif = csub(u, v);
        const c32 w = cmk(w32c(q), sg * w32s(q));
        const c32 dw = cmul(dif, w);
        s[q] = h ? dw : sum;
    }
    dft16<SIGN>(s);
}
HD void fft_s3_write(int tid, LAS c32* buf, const c32 (&s)[16]) { HY_OPAQUE(tid);
    const int base = (tid >> 1) * 33, h = tid & 1;
#pragma unroll
    for (int p = 0; p < 16; ++p) STC(buf, base + 2 * p + h, s[p]);
}
HD void fft_s2_inv(int tid, LAS c32* buf) { HY_OPAQUE(tid);
    const int base = (tid >> 5) * 512 + (tid & 31);
    c32 a[16];
#pragma unroll
    for (int q = 0; q < 16; ++q) a[q] = LDC(buf, hpos(base + 32 * q));
    twiddle_chain(a, cis_pi(2.0f * (float)(tid & 31) / 512.0f));
    dft16<1>(a);
#pragma unroll
    for (int p = 0; p < 16; ++p) STC(buf, hpos(base + 32 * p), a[p]);
}
HD void fft_s1_inv(int tid, const LAS c32* buf, c32 (&a)[16]) { HY_OPAQUE(tid);
#pragma unroll
    for (int p = 0; p < 16; ++p) a[p] = LDC(buf, hpos(tid + 512 * p));
    twiddle_chain(a, cis_pi(2.0f * (float)tid / 8192.0f));
    dft16<1>(a);
}
HD void pair_pass(int tid, LAS c32* Z, const LAS c32* H) { HY_OPAQUE(tid);
    const int p3 = tid & 31;
    const c32 wp3 = cis_pi(-(float)p3 / 32.0f);
    for (int it = 0; it < 9; ++it) {
        const int low = it * 16 + (tid >> 5);
        if (low > 128) continue;
        bool act = true; int p3b = 31 - p3, lowb = 256 - low;
        if (low == 0) { act = p3 <= 16; p3b = (32 - p3) & 31; lowb = 0; }
        else if (low == 128) { act = p3 <= 15; lowb = 128; }
        if (!act) continue;
        const int pa = (low & 15) * 528 + (low >> 4) * 33 + p3, pb = (lowb & 15) * 528 + (lowb >> 4) * 33 + p3b;
        const c32 Wk = cmul(cis_pi(-(float)low / 8192.0f), wp3);
        const c32 A = LDC(Z, pa), B = LDC(Z, pb), HA = LDC(H, pa), HB = LDC(H, pb);
        c32 E = cmk(0.5f * (A.x + B.x), 0.5f * (A.y - B.y)), O = cmk(0.5f * (A.y + B.y), -0.5f * (A.x - B.x));
        c32 T = cmul(Wk, O);
        const c32 X = cadd(E, T), Xp = cmk(E.x - T.x, -(E.y - T.y));
        E = cmk(0.5f * (HA.x + HB.x), 0.5f * (HA.y - HB.y)); O = cmk(0.5f * (HA.y + HB.y), -0.5f * (HA.x - HB.x));
        T = cmul(Wk, O);
        const c32 Hk = cadd(E, T), Hp = cmk(E.x - T.x, -(E.y - T.y));
        const c32 Y = cmul(X, Hk), Yp = cmul(Xp, Hp);
        const float sc = 0.5f / 8192.0f;
        const c32 Ye = cmk(sc * (Y.x + Yp.x), sc * (Y.y - Yp.y));
        const c32 Yd = cmk(sc * (Y.x - Yp.x), sc * (Y.y + Yp.y));
        const c32 Yo = cmul(Yd, cmk(Wk.x, -Wk.y));
        STC(Z, pa, cmk(Ye.x - Yo.y, Ye.y + Yo.x));
        if (pb != pa) STC(Z, pb, cmk(Ye.x + Yo.y, -Ye.y + Yo.x));
    }
}
HD float bf_lo(unsigned u) { unsigned v = u << 16; return __builtin_bit_cast(float, v); }
HD float bf_hi(unsigned u) { unsigned v = u & 0xffff0000u; return __builtin_bit_cast(float, v); }
HD void hy_conv3_load(int tid, const unsigned* zrow, float c0, float c1, float c2, float cb, float (&out)[16]) { HY_OPAQUE(tid);
#pragma unroll
    for (int q = 0; q < 8; ++q) {
        const int m = tid + 512 * q;
        const unsigned wm = zrow[m];
        const unsigned wl = (m > 0) ? zrow[m - 1] : 0u;
        const unsigned wr = (m < 4095) ? zrow[m + 1] : 0u;
        const float zm1 = bf_hi(wl), z0 = bf_lo(wm), z1 = bf_hi(wm), z2 = bf_lo(wr);
        out[2 * q] = c0 * zm1 + c1 * z0 + c2 * z1 + cb;
        out[2 * q + 1] = c0 * z0 + c1 * z1 + c2 * z2 + cb;
    }
}
HD void hy_filter_s1(int tid, LAS c32* buf, const float* fwd, const float* bwd) { HY_OPAQUE(tid);
    c32 a[16];
#pragma unroll
    for (int q = 0; q < 8; ++q) { const int m = tid + 512 * q; const float2 f = *(const float2*)(fwd + 2 * m); a[q] = cmk(f.x, f.y); }
    if (tid == 0) a[0].x += bwd[0];
#pragma unroll
    for (int q = 8; q < 16; ++q) { const int mp = tid + 512 * (q - 8); a[q] = cmk(mp == 0 ? 0.f : bwd[8192 - 2 * mp], bwd[8191 - 2 * mp]); }
    fft_s1_fwd(tid, buf, a);
}
HD void hy_data_s1(int tid, LAS c32* buf, const float (&v)[16]) { HY_OPAQUE(tid);
    c32 a[16];
#pragma unroll
    for (int q = 0; q < 8; ++q) a[q] = cmk(v[2 * q], v[2 * q + 1]);
#pragma unroll
    for (int q = 8; q < 16; ++q) a[q] = cmk(0.f, 0.f);
    fft_s1_fwd(tid, buf, a);
}
__device__ __forceinline__ void transpose_item(const float* W, int N, int k0, int n0, bf16* dst, size_t dld, LAS float* scr, int lane) {
#pragma unroll 8
    for (int i = 0; i < 32; ++i) { const int kk = 2 * i + (lane >> 5); scr[kk * 33 + (lane & 31)] = W[(size_t)(k0 + kk) * N + n0 + (lane & 31)]; }
    LDS_WAIT(); asm volatile("" ::: "memory");
    const int c = lane & 7;
#pragma unroll
    for (int j = 0; j < 4; ++j) { const int n = (lane >> 3) + 8 * j; const LAS float* s = scr + (8 * c) * 33 + n;
        v4u o; o.x = pk2(s[0 * 33], s[1 * 33]); o.y = pk2(s[2 * 33], s[3 * 33]); o.z = pk2(s[4 * 33], s[5 * 33]); o.w = pk2(s[6 * 33], s[7 * 33]);
        *(GAS v4u*)(dst + (size_t)n * dld + 8 * c) = o; }
    LDS_WAIT(); asm volatile("" ::: "memory");
}
__device__ __forceinline__ void pa_convert(Frame& F, int l) {
    LAS float* scr = (LAS float*)(F.lds + F.wave * 16384);
    const int gw = F.vcu * NWAVES + F.wave, NGW = F.G * NWAVES;
    bf16* WIN = (bf16*)(F.ws + WS_WIN); bf16* PT = (bf16*)(F.ws + WS_PT); bf16* WOT = (bf16*)(F.ws + WS_WOT); bf16* WGU = (bf16*)(F.ws + WS_WGU); bf16* WD = (bf16*)(F.ws + WS_WD); bf16* W3T = (bf16*)(F.ws + WS_W3T);
    constexpr int S0 = 32 * 288, S1 = 16 * 64, S3 = 32 * 64, S4 = 16 * 32 * 16, S6 = 16 * 8 * 64, S7 = 128;
    constexpr int NITEMS = S0 + 2 * S1 + S3 + 2 * S4 + S6 + S7;
    for (int it = gw; it < NITEMS; it += NGW) {
        int r = it;
        if (r < S0) { const int kb = r / 288, nb = r % 288; transpose_item(F.in[I_WIN] + (size_t)l * DM * NIN, NIN, 64 * kb, 32 * nb, WIN + (size_t)(32 * nb) * DM + 64 * kb, DM, scr, F.lane); continue; } r -= S0;
        if (r < S1) { const int kb = r / 64, nb = r % 64; transpose_item(F.in[I_WHY] + (size_t)l * HYW * DM, DM, 64 * kb, 32 * nb, PT + (size_t)(32 * nb) * DM + 64 * kb, DM, scr, F.lane); continue; } r -= S1;
        if (r < S1) { const int kb = r / 64, nb = r % 64; transpose_item(F.in[I_WSG] + (size_t)l * SGW * DM, DM, 64 * kb, 32 * nb, PT + (size_t)(32 * nb) * DM + 1024 + 64 * kb, DM, scr, F.lane); continue; } r -= S1;
        if (r < S3) { const int kb = r / 64, nb = r % 64; transpose_item(F.in[I_WOUT] + (size_t)l * DM * DM, DM, 64 * kb, 32 * nb, WOT + (size_t)(32 * nb) * DM + 64 * kb, DM, scr, F.lane); continue; } r -= S3;
        if (r < 2 * S4) { const int up = r / S4; r -= up * S4; const int e = r / 512, q = r % 512, kb = q / 16, nb = q % 16; const int n0 = 32 * nb, drow = 256 * (n0 / 128) + (n0 % 128) + 128 * up;
            transpose_item((up ? F.in[I_WUP] : F.in[I_WGATE]) + ((size_t)l * NEXP + e) * DM * DEXP, DEXP, 64 * kb, n0, WGU + ((size_t)e * 1024 + drow) * DM + 64 * kb, DM, scr, F.lane); continue; } r -= 2 * S4;
        if (r < S6) { const int e = r / 512, q = r % 512, kb = q / 64, nb = q % 64;
            transpose_item(F.in[I_WDOWN] + ((size_t)l * NEXP + e) * DEXP * DM, DM, 64 * kb, 32 * nb, WD + ((size_t)e * DM + 32 * nb) * DEXP + 64 * kb, DEXP, scr, F.lane); continue; } r -= S6;
        { const int nb = r; transpose_item(F.in[I_FW3] + (size_t)l * 64 * 4096, 4096, 0, 32 * nb, W3T + (size_t)(32 * nb) * 64, 64, scr, F.lane); }
    }
}
__device__ __forceinline__ void pa_features(Frame& F, int l) {
    LAS float* zf = (LAS float*)(F.lds);
    LAS float* a1 = zf + 8 * 40;
    const float* w1 = F.in[I_FW1] + l * 33 * 64; const float* b1 = F.in[I_FB1] + l * 64; const float* w2 = F.in[I_FW2] + l * 64 * 64; const float* b2 = F.in[I_FB2] + l * 64; const float* fq = F.in[I_FFREQ] + l * 64;
    bf16* A2 = (bf16*)(F.ws + WS_A2);
    const int tl = F.tid >> 6, j = F.tid & 63;
    const float fr = fq[j];
    for (int t0 = F.vcu * 8; t0 < SEQ; t0 += F.G * 8) {
        __syncthreads();
        if (F.tid < 8 * 33) { const int tt = F.tid / 33, i = F.tid % 33; const int t = t0 + tt; float v;
            const float w = 6.283185307179586f / (float)SEQ * (float)t;
            if (i == 0) v = (float)t / (float)(SEQ - 1);
            else { const int b = (i - 1) & 15; const float band = 1e-4f + (float)b * ((15.0f - 1e-4f) / 15.0f); const float a = band * w; v = (i <= 16) ? cosf(a) : -sinf(a); }
            zf[tt * 40 + i] = v; }
        __syncthreads();
        float s = b1[j];
#pragma unroll
        for (int i = 0; i < 33; ++i) s += zf[tl * 40 + i] * w1[i * 64 + j];
        a1[tl * 64 + j] = sinf(fr * s);
        __syncthreads();
        float s2 = b2[j];
#pragma unroll 8
        for (int i = 0; i < 64; ++i) s2 += a1[tl * 64 + i] * w2[i * 64 + j];
        A2[(size_t)(t0 + tl) * 64 + j] = (bf16)f2bf(sinf(fr * s2));
    }
    __syncthreads();
}
__device__ __forceinline__ void pa_router_t(Frame& F, int l) {
    float* WR = (float*)(F.ws + WS_WR);
    const float* wrg = F.in[I_WRG] + (size_t)l * DM * 4; const float* wre = F.in[I_WRE] + (size_t)l * 4 * DM * 4;
    for (int i = F.vcu * NTHR + F.tid; i < 20 * DM; i += F.G * NTHR) { const int o = i / DM, k = i % DM;
        WR[i] = (o < 4) ? wrg[k * 4 + o] : wre[((size_t)((o - 4) >> 2) * DM + k) * 4 + ((o - 4) & 3)]; }
}
__device__ __forceinline__ int moe_off(const gu32* cnt, int e) { int s = 0;
#pragma unroll
    for (int j = 0; j < 16; ++j) { const int c = (int)cnt[j]; s += (j < e) ? c : 0; } return s; }
template <int MODE, bool OUTF>
__device__ __forceinline__ void norm_row(Frame& F, int m, const float* xin, const float* g, const gu32* cntprev, float* outf) {
    float* XR = (float*)(F.ws + WS_XR); bf16* XN = (bf16*)(F.ws + WS_XN);
    const GAS f32x4* xr = (const GAS f32x4*)((MODE == 0 ? xin : XR) + (size_t)m * DM) + F.lane;
    f32x4 v[8];
#pragma unroll
    for (int j = 0; j < 8; ++j) v[j] = xr[64 * j];
    if (MODE == 1) {
        const int* TOKPOS = (const int*)(F.ws + WS_LISTS + 1 * MiB); const bf16* MO = (const bf16*)(F.ws + WS_MOEOUT);
#pragma unroll
        for (int k = 0; k < 2; ++k) { const int tp = TOKPOS[m * 2 + k]; const int e = tp >> 13, pos = tp & 8191; const int slot = moe_off(cntprev, e) + pos;
            const GAS v2u* mr = (const GAS v2u*)(MO + (size_t)slot * DM) + F.lane;
#pragma unroll
            for (int j = 0; j < 8; ++j) { const v2u w = mr[64 * j]; v[j].x += bfl(w.x); v[j].y += bfh(w.x); v[j].z += bfl(w.y); v[j].w += bfh(w.y); } }
        GAS f32x4* xw = (GAS f32x4*)(XR + (size_t)m * DM) + F.lane;
        if (!OUTF) {
#pragma unroll
            for (int j = 0; j < 8; ++j) xw[64 * j] = v[j]; }
    }
    float ss = 0.f;
#pragma unroll
    for (int j = 0; j < 8; ++j) ss += (v[j].x * v[j].x + v[j].y * v[j].y) + (v[j].z * v[j].z + v[j].w * v[j].w);
    const float rstd = 1.0f / sqrtf(wave_sum(ss) * (1.0f / DM) + EPS);
    const GAS f32x4* gp = (const GAS f32x4*)g + F.lane;
    if (OUTF) { GAS f32x4* o = (GAS f32x4*)(outf + (size_t)m * DM) + F.lane;
#pragma unroll
        for (int j = 0; j < 8; ++j) { const f32x4 gg = gp[64 * j]; o[64 * j] = v[j] * rstd * gg; } }
    else { GAS v2u* o = (GAS v2u*)(XN + (size_t)m * DM) + F.lane;
#pragma unroll
        for (int j = 0; j < 8; ++j) { const f32x4 gg = gp[64 * j]; const f32x4 r = v[j] * rstd * gg; v2u w; w.x = pk2(r.x, r.y); w.y = pk2(r.z, r.w); o[64 * j] = w; } }
}

__device__ __forceinline__ void sgu_unit(Frame& F, int l, int ch, int g) {
    constexpr int RS = 136;
    LAS bf16* Wb = (LAS bf16*)(F.lds);
    LAS bf16* Vt = (LAS bf16*)(F.lds + 128 * RS * 2);
    LAS float* st = (LAS float*)(F.lds + 2 * 128 * RS * 2);
    const bf16* GV = (const bf16*)(F.ws + WS_GV); const bf16* U = (const bf16*)(F.ws + WS_U); bf16* Y = (bf16*)(F.ws + WS_Y);
    const float* lng = F.in[I_LNG] + l * SGW; const float* lnb = F.in[I_LNB] + l * SGW;
    const float* Wg = F.in[I_SGW] + ((size_t)l * 8 + g) * 128 * 128; const float* bg = F.in[I_SGB] + (l * 8 + g) * 128;
    const int t0 = ch * 128;
    __syncthreads();
    {
        const int row = F.tid >> 2, part = F.tid & 3; const GAS v4u* rp = (const GAS v4u*)(GV + (size_t)(t0 + row) * SGW);
        float s = 0.f, q = 0.f;
#pragma unroll 4
        for (int i = 0; i < 32; ++i) { const v4u w = rp[part + 4 * i]; const unsigned ww[4] = {w.x, w.y, w.z, w.w};
#pragma unroll
            for (int j = 0; j < 4; ++j) { const float a = bfl(ww[j]), b = bfh(ww[j]); s += a + b; q += a * a + b * b; } }
        s += __shfl_xor(s, 1); s += __shfl_xor(s, 2); q += __shfl_xor(q, 1); q += __shfl_xor(q, 2);
        const float mu = s * (1.0f / SGW); const float var = fmaxf(q * (1.0f / SGW) - mu * mu, 0.f);
        if (part == 0) { st[row] = mu; st[128 + row] = 1.0f / sqrtf(var + EPS); }
    }
    {
#pragma unroll
        for (int i = 0; i < 8; ++i) { const int idx = F.tid + NTHR * i; const int t = idx >> 5, s4 = (idx & 31) * 4; const f32x4 w = *(const GAS f32x4*)(Wg + t * 128 + s4);
            v2u o; o.x = pk2(w.x, w.y); o.y = pk2(w.z, w.w); *(LAS v2u*)(Wb + t * RS + s4) = o; }
    }
    __syncthreads();
    {
#pragma unroll
        for (int i = 0; i < 4; ++i) { const int chunk = F.tid + NTHR * i; const int s = chunk >> 4, kc = chunk & 15;
            const v4u w = *(const GAS v4u*)(GV + (size_t)(t0 + s) * SGW + g * 128 + 8 * kc); const unsigned ww[4] = {w.x, w.y, w.z, w.w};
            const float mu = st[s], rs = st[128 + s];
#pragma unroll
            for (int j = 0; j < 4; ++j) { const int k = 8 * kc + 2 * j; const float a = (bfl(ww[j]) - mu) * rs * lng[g * 128 + k] + lnb[g * 128 + k], b = (bfh(ww[j]) - mu) * rs * lng[g * 128 + k + 1] + lnb[g * 128 + k + 1];
                Vt[k * RS + s] = (bf16)f2bf(a); Vt[(k + 1) * RS + s] = (bf16)f2bf(b); } }
    }
    __syncthreads();
    {
        const int fr = F.lane & 15, fq = F.lane >> 4, tw = F.wave * 16;
        bf16x8 af[4];
#pragma unroll
        for (int ks = 0; ks < 4; ++ks) af[ks] = *(const LAS bf16x8*)(Wb + (tw + fr) * RS + ks * 32 + fq * 8);
        const int t = t0 + tw + fr; const float bias = bg[tw + fr];
#pragma unroll
        for (int kt = 0; kt < 8; ++kt) { f32x4 acc = (f32x4){0.f, 0.f, 0.f, 0.f};
#pragma unroll
            for (int ks = 0; ks < 4; ++ks) { const bf16x8 bfv = *(const LAS bf16x8*)(Vt + (kt * 16 + fr) * RS + ks * 32 + fq * 8);
                acc = __builtin_amdgcn_mfma_f32_16x16x32_bf16(bfv, af[ks], acc, 0, 0, 0); }
            const int kcol = g * 128 + kt * 16 + 4 * fq;
            const v2u uw = *(const GAS v2u*)(U + (size_t)t * SGW + kcol);
            v2u o; o.x = pk2(bfl(uw.x) * (acc[0] + bias), bfh(uw.x) * (acc[1] + bias)); o.y = pk2(bfl(uw.y) * (acc[2] + bias), bfh(uw.y) * (acc[3] + bias));
            *(GAS v2u*)(Y + (size_t)t * DM + 1024 + kcol) = o; }
    }
}

__device__ __forceinline__ void hy_filter_gen(Frame& F, int c0, float* FS) {
    const bf16* A2 = (const bf16*)(F.ws + WS_A2); const bf16* W3T = (const bf16*)(F.ws + WS_W3T);
    const int fr = F.lane & 15, fq = F.lane >> 4;
    const int chl = fr >> 2, o = (fr >> 1) & 1, dir = fr & 1, col = dir * 2048 + o * 1024 + c0 + chl;
    const bf16x8 b0 = *(const GAS bf16x8*)(W3T + (size_t)col * 64 + fq * 8), b1 = *(const GAS bf16x8*)(W3T + (size_t)col * 64 + 32 + fq * 8);
    const float delta = 3.0701134573253944f + (float)(c0 + chl) * (12.280453829301579f / 1023.0f);
    const float kdec = -delta * 1.4426950408889634f / (float)(SEQ - 1);
    for (int tile = F.wave; tile < SEQ / 16; tile += NWAVES) {
        const int t0 = tile * 16;
        const bf16x8 a0 = *(const GAS bf16x8*)(A2 + (size_t)(t0 + fr) * 64 + fq * 8), a1 = *(const GAS bf16x8*)(A2 + (size_t)(t0 + fr) * 64 + 32 + fq * 8);
        f32x4 acc = (f32x4){0.f, 0.f, 0.f, 0.f};
        acc = __builtin_amdgcn_mfma_f32_16x16x32_bf16(a0, b0, acc, 0, 0, 0);
        acc = __builtin_amdgcn_mfma_f32_16x16x32_bf16(a1, b1, acc, 0, 0, 0);
        const int tb = t0 + 4 * fq;
#pragma unroll
        for (int r = 0; r < 4; ++r) acc[r] *= __builtin_amdgcn_exp2f(kdec * (float)(tb + r));
        *(GAS f32x4*)(FS + (size_t)fr * SEQ + tb) = acc;
    }
}
__device__ __forceinline__ void hyena_block(Frame& F, int l, int blk) {
    LAS c32* A = (LAS c32*)(F.lds); LAS c32* B = A + HY_LDS_C32;
    float* FS = (float*)(F.ws + WS_FS) + (size_t)blk * 16 * SEQ;
    const unsigned* ZT = (const unsigned*)(F.ws + WS_ZT); bf16* Y = (bf16*)(F.ws + WS_Y);
    const float* cw = F.in[I_CONVW] + (size_t)l * 3 * NHY; const float* cb = F.in[I_CONVB] + (size_t)l * NHY; const float* skp = F.in[I_SKIP] + (size_t)l * 2 * HYW;
    const int c0 = blk * 4, tid = F.tid;
    __syncthreads();
    hy_filter_gen(F, c0, FS);
    VM_WAIT(); __syncthreads();
    for (int chl = 0; chl < 4; ++chl) {
        const int c = c0 + chl; const float* fs = FS + (size_t)chl * 4 * SEQ;
        float keep[16];
        c32 s[16];
        hy_filter_s1(tid, B, fs, fs + SEQ);
        hy_conv3_load(tid, ZT + (size_t)(2048 + c) * (SEQ / 2), cw[2048 + c], cw[NHY + 2048 + c], cw[2 * NHY + 2048 + c], cb[2048 + c], keep);
        hy_data_s1(tid, A, keep);
#pragma unroll 1
        for (int ord = 0; ord < 2; ++ord) {
            __syncthreads();
            fft_s2_fwd(tid, A); fft_s2_fwd(tid, B);
            __syncthreads();
            fft_s3_read<-1>(tid, A, s); fft_s3_write(tid, A, s);
            fft_s3_read<-1>(tid, B, s); fft_s3_write(tid, B, s);
            __syncthreads();
            pair_pass(tid, A, B);
            __syncthreads();
            fft_s3_read<1>(tid, A, s); fft_s3_write(tid, A, s);
            __syncthreads();
            fft_s2_inv(tid, A);
            __syncthreads();
            fft_s1_inv(tid, A, s);
            if (ord == 0) {
                float x1[16];
                hy_conv3_load(tid, ZT + (size_t)c * (SEQ / 2), cw[c], cw[NHY + c], cw[2 * NHY + c], cb[c], x1);
                const float sk0 = skp[c];
#pragma unroll
                for (int q = 0; q < 8; ++q) { keep[2 * q] = x1[2 * q] * (s[q].x + keep[2 * q] * sk0); keep[2 * q + 1] = x1[2 * q + 1] * (s[q].y + keep[2 * q + 1] * sk0); }
                hy_filter_s1(tid, B, fs + 2 * SEQ, fs + 3 * SEQ);
                hy_data_s1(tid, A, keep);
            } else {
                float x2[16];
                hy_conv3_load(tid, ZT + (size_t)(1024 + c) * (SEQ / 2), cw[1024 + c], cw[NHY + 1024 + c], cw[2 * NHY + 1024 + c], cb[1024 + c], x2);
                const float sk1 = skp[HYW + c];
#pragma unroll
                for (int q = 0; q < 8; ++q) { const int m = tid + 512 * q;
                    Y[(size_t)(2 * m) * DM + c] = (bf16)f2bf(x2[2 * q] * (s[q].x + keep[2 * q] * sk1));
                    Y[(size_t)(2 * m + 1) * DM + c] = (bf16)f2bf(x2[2 * q + 1] * (s[q].y + keep[2 * q + 1] * sk1)); }
            }
        }
        __syncthreads();
    }
}

__device__ __forceinline__ void route_block(Frame& F, int l, int tb  ) {
    LAS int* lcnt = (LAS int*)(F.lds);
    LAS int* lbase = (LAS int*)(F.lds + 64);
    LAS int* le = (LAS int*)(F.lds + 128);
    LAS int* lp = (LAS int*)(F.lds + 128 + 256);
    LAS float* lw = (LAS float*)(F.lds + 128 + 512);
    const float* XR = (const float*)(F.ws + WS_XR); bf16* H = (bf16*)(F.ws + WS_XN); const float* WR = (const float*)(F.ws + WS_WR);
    const float* g = F.in[I_GFFN] + (size_t)l * DM; const float* brg = F.in[I_BRG] + l * 4; const float* bre = F.in[I_BRE] + l * 16;
    int* TOKLIST = (int*)(F.ws + WS_LISTS); float* WLIST = (float*)(F.ws + WS_LISTS + 512 * 1024); int* TOKPOS = (int*)(F.ws + WS_LISTS + 1 * MiB);
    gu32* gcnt = F.ctl + CW_CNT + 64 * l;
    __syncthreads();
    if (F.tid < 16) lcnt[F.tid] = 0;
    __syncthreads();
    const int ts = F.tid >> 4, part = F.tid & 15, tok = tb + ts;
    const float* xrow = XR + (size_t)tok * DM;
    float acc[20], ss = 0.f;
#pragma unroll
    for (int o = 0; o < 20; ++o) acc[o] = 0.f;
#pragma unroll 2
    for (int i = 0; i < 32; ++i) { const int k = 4 * (part + 16 * i);
        const f32x4 x = *(const GAS f32x4*)(xrow + k); const f32x4 gg = *(const GAS f32x4*)(g + k); const f32x4 xg = x * gg;
        ss += (x.x * x.x + x.y * x.y) + (x.z * x.z + x.w * x.w);
#pragma unroll
        for (int o = 0; o < 20; ++o) { const f32x4 w = *(const GAS f32x4*)(WR + (size_t)o * DM + k); acc[o] += (xg.x * w.x + xg.y * w.y) + (xg.z * w.z + xg.w * w.w); } }
#pragma unroll
    for (int sh = 1; sh < 16; sh <<= 1) { ss += __shfl_xor(ss, sh);
#pragma unroll
        for (int o = 0; o < 20; ++o) acc[o] += __shfl_xor(acc[o], sh); }
    const float rstd = 1.0f / sqrtf(ss * (1.0f / DM) + EPS);
    {
        float lg0 = acc[0] * rstd + brg[0], lg1 = acc[1] * rstd + brg[1], lg2 = acc[2] * rstd + brg[2], lg3 = acc[3] * rstd + brg[3];
        int grp = 0; float mx = lg0;
        if (lg1 > mx) { mx = lg1; grp = 1; } if (lg2 > mx) { mx = lg2; grp = 2; } if (lg3 > mx) { mx = lg3; grp = 3; }
        const float den = (__expf(lg0 - mx) + __expf(lg1 - mx)) + (__expf(lg2 - mx) + __expf(lg3 - mx));
        const float psel = 1.0f / den;
        const float m0 = (grp == 0) ? 1.f : 0.f, m1 = (grp == 1) ? 1.f : 0.f, m2 = (grp == 2) ? 1.f : 0.f, m3 = (grp == 3) ? 1.f : 0.f;
        float e0v = (m0 * acc[4] + m1 * acc[8]) + (m2 * acc[12] + m3 * acc[16]), e1v = (m0 * acc[5] + m1 * acc[9]) + (m2 * acc[13] + m3 * acc[17]);
        float e2v = (m0 * acc[6] + m1 * acc[10]) + (m2 * acc[14] + m3 * acc[18]), e3v = (m0 * acc[7] + m1 * acc[11]) + (m2 * acc[15] + m3 * acc[19]);
        e0v = e0v * rstd + bre[grp * 4 + 0]; e1v = e1v * rstd + bre[grp * 4 + 1]; e2v = e2v * rstd + bre[grp * 4 + 2]; e3v = e3v * rstd + bre[grp * 4 + 3];
        int i0 = 0; float v0 = e0v;
        if (e1v > v0) { v0 = e1v; i0 = 1; } if (e2v > v0) { v0 = e2v; i0 = 2; } if (e3v > v0) { v0 = e3v; i0 = 3; }
        int i1 = -1; float v1 = -3.0e38f;
        if (i0 != 0 && e0v > v1) { v1 = e0v; i1 = 0; } if (i0 != 1 && e1v > v1) { v1 = e1v; i1 = 1; } if (i0 != 2 && e2v > v1) { v1 = e2v; i1 = 2; } if (i0 != 3 && e3v > v1) { v1 = e3v; i1 = 3; }
        const float ex = __expf(v1 - v0); const float w0 = psel / (1.0f + ex), w1 = psel * ex / (1.0f + ex);
        if (part == 0) { const int ea = grp * 4 + i0, eb = grp * 4 + i1;
            le[ts * 2] = ea; le[ts * 2 + 1] = eb; lw[ts * 2] = w0; lw[ts * 2 + 1] = w1;
            lp[ts * 2] = __hip_atomic_fetch_add(lcnt + ea, 1, __ATOMIC_RELAXED, __HIP_MEMORY_SCOPE_WORKGROUP); lp[ts * 2 + 1] = __hip_atomic_fetch_add(lcnt + eb, 1, __ATOMIC_RELAXED, __HIP_MEMORY_SCOPE_WORKGROUP); }
    }
#pragma unroll 4
    for (int i = 0; i < 32; ++i) { const int k = 4 * (part + 16 * i); const f32x4 x = *(const GAS f32x4*)(xrow + k); const f32x4 gg = *(const GAS f32x4*)(g + k);
        const f32x4 r = x * rstd * gg; v2u w; w.x = pk2(r.x, r.y); w.y = pk2(r.z, r.w); *(GAS v2u*)(H + (size_t)tok * DM + k) = w; }
    __syncthreads();
    if (F.tid < 16) lbase[F.tid] = (int)__hip_atomic_fetch_add(gcnt + F.tid, (unsigned)lcnt[F.tid], RLX_AGENT);
    __syncthreads();
    if (F.tid < 64) { const int t2 = F.tid >> 1; const int e = le[F.tid], pos = lbase[e] + lp[F.tid];
        TOKLIST[e * SEQ + pos] = tb + t2; WLIST[e * SEQ + pos] = lw[F.tid]; TOKPOS[(tb + t2) * 2 + (F.tid & 1)] = (e << 13) | pos; }
}
using pg8::Unit; using pg8::f32x2; using pg8::u32x4; using pg8::cvt_pk_bf16; using pg8::gelu_pk; using pg8::sigmoid_f;
__device__ __forceinline__ void tile_of(int idx, int nM, int nN, int& pm, int& pn) {
    const int nig = 8 * nN, gid = idx / nig, fm = gid * 8, gsz = (nM - fm) < 8 ? (nM - fm) : 8;
    pm = fm + ((idx % nig) % gsz); pn = (idx % nig) / gsz;
}
__device__ __forceinline__ int xcd_remap(int L, int nwg) { const int q = nwg / 8, r = nwg % 8, xcd = L % 8, off = L / 8; return (xcd < r ? xcd * (q + 1) : r * (q + 1) + (xcd - r) * q) + off; }

struct InProjSched {
    static constexpr bool GATHER = false;
    const char* XN; const char* WIN; int G, c;
    __device__ __forceinline__ bool next(int i, Unit& u) const {
        const int L = i * G + c; if (L >= 1152) return false;
        const int w = xcd_remap(L, 1152);
        if (w < 384) { u.kind = 0; tile_of(w, 12, 32, u.pm, u.pn); } else { u.kind = 1; tile_of(w - 384, 32, 24, u.pm, u.pn); }
        u.e = 0; u.row0 = 0; u.nvalid = 256; return true;
    }
    __device__ __forceinline__ const char* a_base(const Unit& u) const { return (u.kind == 0 ? WIN : XN) + (size_t)u.pm * (256 * DM * 2); }
    __device__ __forceinline__ const char* b_base(const Unit& u) const { return (u.kind == 0 ? XN : WIN + (size_t)NHY * DM * 2) + (size_t)u.pn * (256 * DM * 2); }
    __device__ __forceinline__ unsigned a_goff(const Unit&, int) const { return 0u; }
};
struct EpiInProj {
    static constexpr bool PERM = true, MIDK = false;
    bf16 *ZT, *U; const float* bin;
    __device__ __forceinline__ void operator()(const f32x4 (&acc)[2][2][4][2], const Unit& u, int wr, int wc, int fr, int fq) const {
        if (u.kind == 0) {
            const int row0 = u.pm * 256 + wr * 64 + fr, col0 = u.pn * 256 + wc * 32 + 8 * fq;
#pragma unroll
            for (int ai = 0; ai < 2; ++ai)
#pragma unroll
                for (int m = 0; m < 4; ++m) { const int row = row0 + ai * 128 + m * 16; const float b = bin[row]; bf16* rowp = ZT + (size_t)row * SEQ + col0;
#pragma unroll
                    for (int bj = 0; bj < 2; ++bj) { const f32x4 v0 = acc[ai][bj][m][0] + b, v1 = acc[ai][bj][m][1] + b;
                        u32x4 w; w.x = cvt_pk_bf16(v0[0], v0[1]); w.y = cvt_pk_bf16(v0[2], v0[3]); w.z = cvt_pk_bf16(v1[0], v1[1]); w.w = cvt_pk_bf16(v1[2], v1[3]);
                        *(u32x4*)(rowp + bj * 128) = w; } }
        } else {
            const int seg = (u.pn < 4) ? 0 : (u.pn < 8) ? 1 : (u.pn < 16) ? 2 : 3;
            const size_t boff = (seg == 0) ? 0 : (seg == 1) ? (WS_GV - WS_U) : (seg == 2) ? (WS_GH - WS_U) : (WS_GS - WS_U);
            bf16* base = (bf16*)((char*)U + boff);
            const int ldc = (seg < 2) ? 1024 : 2048, colt = (seg == 0) ? u.pn * 256 : (seg == 1) ? (u.pn - 4) * 256 : (seg == 2) ? (u.pn - 8) * 256 : (u.pn - 16) * 256;
            const int row0 = u.pm * 256 + wr * 64 + fr, col0 = colt + wc * 32 + 8 * fq, bcol0 = NHY + u.pn * 256 + wc * 32 + 8 * fq;
            f32x4 bv[2][2];
#pragma unroll
            for (int bj = 0; bj < 2; ++bj)
#pragma unroll
                for (int n = 0; n < 2; ++n) bv[bj][n] = *(const f32x4*)(bin + bcol0 + bj * 128 + 4 * n);
#pragma unroll
            for (int ai = 0; ai < 2; ++ai)
#pragma unroll
                for (int m = 0; m < 4; ++m) { bf16* rowp = base + (size_t)(row0 + ai * 128 + m * 16) * ldc + col0;
#pragma unroll
                    for (int bj = 0; bj < 2; ++bj) { f32x4 v0 = acc[ai][bj][m][0] + bv[bj][0], v1 = acc[ai][bj][m][1] + bv[bj][1];
                        if (seg < 2) { const f32x2 a = gelu_pk((f32x2){v0[0], v0[1]}), b = gelu_pk((f32x2){v0[2], v0[3]}), c = gelu_pk((f32x2){v1[0], v1[1]}), d = gelu_pk((f32x2){v1[2], v1[3]});
                            v0 = (f32x4){a.x, a.y, b.x, b.y}; v1 = (f32x4){c.x, c.y, d.x, d.y}; }
                        else {
#pragma unroll
                            for (int j = 0; j < 4; ++j) { v0[j] = sigmoid_f(v0[j]); v1[j] = sigmoid_f(v1[j]); } }
                        u32x4 w; w.x = cvt_pk_bf16(v0[0], v0[1]); w.y = cvt_pk_bf16(v0[2], v0[3]); w.z = cvt_pk_bf16(v1[0], v1[1]); w.w = cvt_pk_bf16(v1[2], v1[3]);
                        *(u32x4*)(rowp + bj * 128) = w; } }
        }
    }
    __device__ __forceinline__ void mid(f32x4 (&)[2][2][4][2], const Unit&, int, int, int, int) const {}
};
struct GridSched {
    static constexpr bool GATHER = false;
    const char* A; const char* Bt; int nM, nN, K, G, c;
    __device__ __forceinline__ bool next(int i, Unit& u) const {
        const int L = i * G + c, nwg = nM * nN; if (L >= nwg) return false;
        tile_of(xcd_remap(L, nwg), nM, nN, u.pm, u.pn); u.kind = 0; u.e = 0; u.row0 = 0; u.nvalid = 256; return true;
    }
    __device__ __forceinline__ const char* a_base(const Unit& u) const { return A + (size_t)u.pm * 512 * K; }
    __device__ __forceinline__ const char* b_base(const Unit& u) const { return Bt + (size_t)u.pn * 512 * K; }
    __device__ __forceinline__ unsigned a_goff(const Unit&, int) const { return 0u; }
};
struct EpiMerge {
    static constexpr bool PERM = true, MIDK = true;
    const bf16 *GH, *GS; bf16* O;
    __device__ __forceinline__ void mid(f32x4 (&acc)[2][2][4][2], const Unit& u, int wr, int wc, int fr, int fq) const {
        asm volatile("" : "+v"(fr), "+v"(fq));
        const int row0 = u.pm * 256 + wr * 64 + fr, col0 = u.pn * 256 + wc * 32 + 8 * fq;
#pragma unroll
        for (int ai = 0; ai < 2; ++ai)
#pragma unroll
            for (int m = 0; m < 4; ++m) { const size_t off = (size_t)(row0 + ai * 128 + m * 16) * DM + col0;
#pragma unroll
                for (int bj = 0; bj < 2; ++bj) { const u32x4 h = *(const u32x4*)(GH + off + bj * 128), s = *(const u32x4*)(GS + off + bj * 128);
                    const unsigned hh[4] = {h.x, h.y, h.z, h.w}, sv[4] = {s.x, s.y, s.z, s.w};
#pragma unroll
                    for (int j = 0; j < 4; ++j) { const float r0 = bfl(hh[j]) * __builtin_amdgcn_rcpf(bfl(sv[j])), r1 = bfh(hh[j]) * __builtin_amdgcn_rcpf(bfh(sv[j]));
                        acc[ai][bj][m][j >> 1][(j & 1) * 2] *= r0; acc[ai][bj][m][j >> 1][(j & 1) * 2 + 1] *= r1; } }
                asm volatile("" : "+v"(acc[ai][0][m][0]), "+v"(acc[ai][0][m][1]), "+v"(acc[ai][1][m][0]), "+v"(acc[ai][1][m][1]));
                asm volatile("" ::: "memory"); }
    }
    __device__ __forceinline__ void operator()(const f32x4 (&acc)[2][2][4][2], const Unit& u, int wr, int wc, int fr, int fq) const {
        const int row0 = u.pm * 256 + wr * 64 + fr, col0 = u.pn * 256 + wc * 32 + 8 * fq;
#pragma unroll
        for (int ai = 0; ai < 2; ++ai)
#pragma unroll
            for (int m = 0; m < 4; ++m) { const size_t off = (size_t)(row0 + ai * 128 + m * 16) * DM + col0;
#pragma unroll
                for (int bj = 0; bj < 2; ++bj) { const u32x4 s = *(const u32x4*)(GS + off + bj * 128); const unsigned sv[4] = {s.x, s.y, s.z, s.w};
                    const f32x4 v0 = acc[ai][bj][m][0], v1 = acc[ai][bj][m][1];
                    u32x4 w; w.x = cvt_pk_bf16(v0[0] * bfl(sv[0]), v0[1] * bfh(sv[0])); w.y = cvt_pk_bf16(v0[2] * bfl(sv[1]), v0[3] * bfh(sv[1]));
                    w.z = cvt_pk_bf16(v1[0] * bfl(sv[2]), v1[1] * bfh(sv[2])); w.w = cvt_pk_bf16(v1[2] * bfl(sv[3]), v1[3] * bfh(sv[3]));
                    *(u32x4*)(O + off + bj * 128) = w; }
                asm volatile("" ::: "memory"); }
    }
};
struct EpiResid {
    static constexpr bool PERM = false, MIDK = false;
    const float* base; float* out;
    __device__ __forceinline__ void operator()(const f32x4 (&acc)[2][2][4][2], const Unit& u, int wr, int wc, int fr, int fq) const {
        const int row0 = u.pm * 256 + wr * 64 + fr, col0 = u.pn * 256 + wc * 32 + 4 * fq;
#pragma unroll
        for (int ai = 0; ai < 2; ++ai)
#pragma unroll
            for (int m = 0; m < 4; ++m) { const size_t off = (size_t)(row0 + ai * 128 + m * 16) * DM + col0;
#pragma unroll
                for (int bj = 0; bj < 2; ++bj)
#pragma unroll
                    for (int n = 0; n < 2; ++n) { const f32x4 b = *(const f32x4*)(base + off + bj * 128 + n * 16); *(f32x4*)(out + off + bj * 128 + n * 16) = b + acc[ai][bj][m][n]; } }
    }
    __device__ __forceinline__ void mid(f32x4 (&)[2][2][4][2], const Unit&, int, int, int, int) const {}
};
struct MoeSched1 {
    static constexpr bool GATHER = true;
    const LAS int* tab; const char* H; const char* W; const int* toklist; int G, c;
    __device__ __forceinline__ bool next(int i, Unit& u) const {
        const int L = i * G + c; const int total = __builtin_amdgcn_readfirstlane(tab[16]) * 4; if (L >= total) return false;
        const int rt = L >> 2; int e = 0;
#pragma unroll
        for (int j = 1; j < 16; ++j) e += (__builtin_amdgcn_readfirstlane(tab[j]) <= rt) ? 1 : 0;
        const int j0 = rt - __builtin_amdgcn_readfirstlane(tab[e]);
        u.pm = j0; u.pn = L & 3; u.kind = 0; u.e = e; u.row0 = __builtin_amdgcn_readfirstlane(tab[17 + e]) + 256 * j0;
        const int rem = __builtin_amdgcn_readfirstlane(tab[34 + e]) - 256 * j0; u.nvalid = rem < 256 ? rem : 256; return true;
    }
    __device__ __forceinline__ const char* a_base(const Unit&) const { return H; }
    __device__ __forceinline__ const char* b_base(const Unit& u) const { return W + ((size_t)u.e * 1024 + (size_t)u.pn * 256) * DM * 2; }
    __device__ __forceinline__ unsigned a_goff(const Unit& u, int r) const { const int tok = (r < u.nvalid) ? toklist[u.e * SEQ + u.pm * 256 + r] : 0; return (unsigned)tok * (unsigned)(DM * 2); }
};
struct EpiMoe1 {
    static constexpr bool PERM = true, MIDK = false;
    bf16* ACT; const float* wlist;
    __device__ __forceinline__ void operator()(const f32x4 (&acc)[2][2][4][2], const Unit& u, int wr, int wc, int fr, int fq) const {
        const int col0 = u.pn * 128 + wc * 32 + 8 * fq;
#pragma unroll
        for (int ai = 0; ai < 2; ++ai)
#pragma unroll
            for (int m = 0; m < 4; ++m) { const int rl = ai * 128 + wr * 64 + m * 16 + fr;
                if (rl < u.nvalid) { const float wt = wlist[u.e * SEQ + u.pm * 256 + rl];
                    const f32x4 g0 = acc[ai][0][m][0], g1 = acc[ai][0][m][1], u0 = acc[ai][1][m][0], u1 = acc[ai][1][m][1];
                    float o[8];
#pragma unroll
                    for (int j = 0; j < 4; ++j) { o[j] = g0[j] * sigmoid_f(g0[j]) * u0[j] * wt; o[4 + j] = g1[j] * sigmoid_f(g1[j]) * u1[j] * wt; }
                    u32x4 w; w.x = cvt_pk_bf16(o[0], o[1]); w.y = cvt_pk_bf16(o[2], o[3]); w.z = cvt_pk_bf16(o[4], o[5]); w.w = cvt_pk_bf16(o[6], o[7]);
                    *(u32x4*)(ACT + (size_t)(u.row0 + rl) * DEXP + col0) = w; } }
    }
    __device__ __forceinline__ void mid(f32x4 (&)[2][2][4][2], const Unit&, int, int, int, int) const {}
};
struct MoeSched2 {
    static constexpr bool GATHER = false;
    const LAS int* tab; const char* ACT; const char* W; int G, c;
    __device__ __forceinline__ bool next(int i, Unit& u) const {
        const int L = i * G + c; const int total = __builtin_amdgcn_readfirstlane(tab[16]) * 8; if (L >= total) return false;
        const int rt = L >> 3; int e = 0;
#pragma unroll
        for (int j = 1; j < 16; ++j) e += (__builtin_amdgcn_readfirstlane(tab[j]) <= rt) ? 1 : 0;
        const int j0 = rt - __builtin_amdgcn_readfirstlane(tab[e]);
        u.pm = j0; u.pn = L & 7; u.kind = 0; u.e = e; u.row0 = __builtin_amdgcn_readfirstlane(tab[17 + e]) + 256 * j0;
        const int rem = __builtin_amdgcn_readfirstlane(tab[34 + e]) - 256 * j0; u.nvalid = rem < 256 ? rem : 256; return true;
    }
    __device__ __forceinline__ const char* a_base(const Unit& u) const { return ACT + (size_t)u.row0 * DEXP * 2; }
    __device__ __forceinline__ const char* b_base(const Unit& u) const { return W + ((size_t)u.e * DM + (size_t)u.pn * 256) * DEXP * 2; }
    __device__ __forceinline__ unsigned a_goff(const Unit&, int) const { return 0u; }
};
struct EpiMoe2 {
    static constexpr bool PERM = true, MIDK = false;
    bf16* MO;
    __device__ __forceinline__ void operator()(const f32x4 (&acc)[2][2][4][2], const Unit& u, int wr, int wc, int fr, int fq) const {
        const int col0 = u.pn * 256 + wc * 32 + 8 * fq;
#pragma unroll
        for (int ai = 0; ai < 2; ++ai)
#pragma unroll
            for (int m = 0; m < 4; ++m) { const int rl = ai * 128 + wr * 64 + m * 16 + fr;
                if (rl < u.nvalid) { bf16* rowp = MO + (size_t)(u.row0 + rl) * DM + col0;
#pragma unroll
                    for (int bj = 0; bj < 2; ++bj) { const f32x4 v0 = acc[ai][bj][m][0], v1 = acc[ai][bj][m][1];
                        u32x4 w; w.x = cvt_pk_bf16(v0[0], v0[1]); w.y = cvt_pk_bf16(v0[2], v0[3]); w.z = cvt_pk_bf16(v1[0], v1[1]); w.w = cvt_pk_bf16(v1[2], v1[3]);
                        *(u32x4*)(rowp + bj * 128) = w; } } }
    }
    __device__ __forceinline__ void mid(f32x4 (&)[2][2][4][2], const Unit&, int, int, int, int) const {}
};
__device__ __forceinline__ void moe_tables(Frame& F, int l) {
    LAS int* tab = (LAS int*)(F.lds + MISC_OFF + 128);
    __syncthreads();
    if (F.tid == 0) { int tp = 0, off = 0;
        for (int e = 0; e < 16; ++e) { const int c = (int)__hip_atomic_load(F.ctl + CW_CNT + 64 * l + e, RLX_AGENT); tab[e] = tp; tab[17 + e] = off; tab[34 + e] = c; tp += (c + 255) >> 8; off += c; }
        tab[16] = tp; tab[33] = off; }
    __syncthreads();
}

struct Args { const float* in[29]; float* out; unsigned char* ws; int ph_lo, ph_hi; };
constexpr int NPHASE = 17;
__global__ void __launch_bounds__(NTHR, 2) fwd_kernel(Args args) {
    extern __shared__ __attribute__((aligned(16))) unsigned char lds[];
    Frame F;
    F.lds = (LAS unsigned char*)lds;
    F.MISC = (volatile LAS unsigned*)(F.lds + MISC_OFF);
    F.tid = threadIdx.x; F.lane = F.tid & 63; F.wave = __builtin_amdgcn_readfirstlane(F.tid >> 6);
    F.G = gridDim.x; { const int bx = blockIdx.x; F.vcu = (F.G % 8 == 0) ? (bx % 8) * (F.G / 8) + bx / 8 : bx; }
    F.ws = args.ws; F.out = args.out; F.ctl = (gu32*)(args.ws + WS_CTL);
#pragma unroll
    for (int i = 0; i < 29; ++i) F.in[i] = args.in[i];
    for (int u = F.tid; u < 256; u += NTHR) ((LAS unsigned*)(F.lds + MISC_OFF))[u] = 0u;
    __syncthreads();
    const int lo = args.ph_lo, hi = args.ph_hi;
    const bool multi = (hi - lo) > 1;
    XcdBarrier bar; bar.bar = (unsigned*)(F.ctl + CW_BAR); bar.x = 0; bar.st = nullptr;
    if (multi) bar = xcd_barrier_post((unsigned*)(F.ctl + CW_BAR), F.MISC + 8);
#ifndef PHASE_MASK
#define PHASE_MASK 0x7ff
#endif
#define IN(k) (lo <= (k) && (k) < hi)
#define ON(j) ((PHASE_MASK >> (j)) & 1)
#define LAUNDER() do { int _t = threadIdx.x; asm volatile("" : "+v"(_t)); F.tid = _t; F.lane = _t & 63; } while (0)
#define SEAM(k) do { if (IN(k) && IN((k) + 1)) xcd_barrier(bar); } while (0)
    const int gw = F.vcu * NWAVES + F.wave, NGW = F.G * NWAVES;
    for (int l = 0; l < DEPTH; ++l) {
        const int p0 = l * 8;
        if (ON(0) && IN(p0 + 0)) { LAUNDER();
            pa_convert(F, l);
            pa_features(F, l);
            pa_router_t(F, l);
            const float* g = F.in[I_GMIX] + (size_t)l * DM;
            if (l == 0) { for (int m = gw; m < SEQ; m += NGW) norm_row<0, false>(F, m, F.in[I_X], g, nullptr, nullptr); }
            else { for (int m = gw; m < SEQ; m += NGW) norm_row<1, false>(F, m, nullptr, g, F.ctl + CW_CNT + 64 * (l - 1), nullptr); }
        }
        SEAM(p0 + 0);
        if (ON(1) && IN(p0 + 1)) { LAUNDER();
            InProjSched S{(const char*)(F.ws + WS_XN), (const char*)(F.ws + WS_WIN), F.G, (int)blockIdx.x};
            EpiInProj E{(bf16*)(F.ws + WS_ZT), (bf16*)(F.ws + WS_U), F.in[I_BIN] + (size_t)l * NIN};
            pg8::gemm_phase<EpiInProj, InProjSched>(F.lds, DM, S, E);
        }
        SEAM(p0 + 1);
        if (ON(2) && IN(p0 + 2)) { LAUNDER();
            if (ON(9)) for (int u = F.vcu; u < 512; u += F.G) sgu_unit(F, l, u >> 3, u & 7);
            if (ON(10)) for (int b = F.vcu; b < 256; b += F.G) hyena_block(F, l, b);
        }
        SEAM(p0 + 2);
        if (ON(3) && IN(p0 + 3)) { LAUNDER();
            GridSched S{(const char*)(F.ws + WS_Y), (const char*)(F.ws + WS_PT), 32, 8, DM, F.G, (int)blockIdx.x};
            EpiMerge E{(const bf16*)(F.ws + WS_GH), (const bf16*)(F.ws + WS_GS), (bf16*)(F.ws + WS_MERGED)};
            pg8::gemm_phase<EpiMerge, GridSched>(F.lds, DM, S, E);
        }
        SEAM(p0 + 3);
        if (ON(4) && IN(p0 + 4)) { LAUNDER();
            GridSched S{(const char*)(F.ws + WS_MERGED), (const char*)(F.ws + WS_WOT), 32, 8, DM, F.G, (int)blockIdx.x};
            EpiResid E{l == 0 ? F.in[I_X] : (const float*)(F.ws + WS_XR), (float*)(F.ws + WS_XR)};
            pg8::gemm_phase<EpiResid, GridSched>(F.lds, DM, S, E);
        }
        SEAM(p0 + 4);
        if (ON(5) && IN(p0 + 5)) { LAUNDER(); for (int tb = F.vcu * 32; tb < SEQ; tb += F.G * 32) route_block(F, l, tb); }
        SEAM(p0 + 5);
        if (ON(6) && IN(p0 + 6)) { LAUNDER();
            moe_tables(F, l);
            MoeSched1 S{(const LAS int*)(F.lds + MISC_OFF + 128), (const char*)(F.ws + WS_XN), (const char*)(F.ws + WS_WGU), (const int*)(F.ws + WS_LISTS), F.G, F.vcu};
            EpiMoe1 E{(bf16*)(F.ws + WS_ACT), (const float*)(F.ws + WS_LISTS + 512 * 1024)};
            pg8::gemm_phase<EpiMoe1, MoeSched1>(F.lds, DM, S, E);
        }
        SEAM(p0 + 6);
        if (ON(7) && IN(p0 + 7)) { LAUNDER();
            moe_tables(F, l);
            MoeSched2 S{(const LAS int*)(F.lds + MISC_OFF + 128), (const char*)(F.ws + WS_ACT), (const char*)(F.ws + WS_WD), F.G, F.vcu};
            EpiMoe2 E{(bf16*)(F.ws + WS_MOEOUT)};
            pg8::gemm_phase<EpiMoe2, MoeSched2>(F.lds, DEXP, S, E);
        }
        SEAM(p0 + 7);
    }
    if (ON(8) && IN(16)) { LAUNDER(); for (int m = gw; m < SEQ; m += NGW) norm_row<1, true>(F, m, nullptr, F.in[I_GFINAL], F.ctl + CW_CNT + 64 * (DEPTH - 1), F.out); }
#undef IN
#undef SEAM
}

#ifndef MK_ONE_LAUNCH
#define MK_ONE_LAUNCH 0
#endif
extern "C" void kernel_launch(void* const* d_in, const int* in_sizes, int n_in, void* d_out, int out_size, void* d_ws, size_t ws_size, hipStream_t stream) {
    static int grid = 0;
    if (grid == 0) {
        if (n_in != 29 || ws_size < WS_END) { fprintf(stderr, "kernel_launch: unexpected n_in %d or ws %zu < %zu\n", n_in, ws_size, (size_t)WS_END); grid = -1; return; }
        int dev = 0, cus = 0, per_cu = 0;
        if (hipGetDevice(&dev) != hipSuccess || hipDeviceGetAttribute(&cus, hipDeviceAttributeMultiprocessorCount, dev) != hipSuccess) { grid = -1; return; }
        if (hipFuncSetAttribute((const void*)fwd_kernel, hipFuncAttributeMaxDynamicSharedMemorySize, LDS_BYTES) != hipSuccess) { fprintf(stderr, "kernel_launch: hipFuncSetAttribute failed\n"); grid = -1; return; }
        if (hipOccupancyMaxActiveBlocksPerMultiprocessor(&per_cu, (const void*)fwd_kernel, NTHR, LDS_BYTES) != hipSuccess || per_cu < 1) fprintf(stderr, "kernel_launch: occupancy query reports %d\n", per_cu);
        (void)hipGetLastError();
        grid = cus;
    }
    if (grid < 0) return;
    (void)hipMemsetAsync((char*)d_ws + WS_CTL, 0, CTL_ZERO_BYTES, stream);
    Args a{};
    for (int i = 0; i < 29; ++i) a.in[i] = (const float*)d_in[i];
    a.out = (float*)d_out; a.ws = (unsigned char*)d_ws;
#if MK_ONE_LAUNCH
    a.ph_lo = 0; a.ph_hi = NPHASE;
    hipLaunchKernelGGL(fwd_kernel, dim3(grid), dim3(NTHR), LDS_BYTES, stream, a);
#else
    for (int p = 0; p < NPHASE; ++p) { a.ph_lo = p; a.ph_hi = p + 1; hipLaunchKernelGGL(fwd_kernel, dim3(grid), dim3(NTHR), LDS_BYTES, stream, a); }
#endif
}
```

```cpp
#include <hip/hip_runtime.h>
#include <cstdio>
#include <cstdint>
#define MK_ONE_LAUNCH 1
#define DUP_MASK 0
#define PROBE_K -1
#define PROBE_PART 0
namespace pg8 {
#define PG8_LAS __attribute__((address_space(3)))
typedef unsigned short bf16_t;
typedef short bf16x8 __attribute__((ext_vector_type(8)));
typedef float f32x4 __attribute__((ext_vector_type(4)));
typedef float f32x2 __attribute__((ext_vector_type(2)));
typedef unsigned u32x4 __attribute__((ext_vector_type(4)));
typedef unsigned u32x2 __attribute__((ext_vector_type(2)));
constexpr int BM = 256, BK = 64, HALF = 128, HTB = HALF * BK * 2  , STAGE_BYTES = 8 * HTB;

__host__ __device__ __forceinline__ int lds_byte(int r, int c) { const int st = (r >> 4) * 2 + (c >> 5), rr = r & 15, cc = c & 31, ob = rr * 64 + cc * 2; return st * 1024 + (ob ^ (((ob >> 9) & 1) << 5)); }
__host__ __device__ __forceinline__ void stage_rc(int b, int& R, int& C) { const int st = b / 1024, sb = b % 1024, swz = sb ^ (((sb >> 9) & 1) << 5); R = (st >> 1) * 16 + swz / 64; C = (st & 1) * 32 + (swz % 64) / 2; }
__host__ __device__ __forceinline__ int perm32(int rho) { const int n = rho >> 4, i = rho & 15; return 8 * (i >> 2) + 4 * n + (i & 3); }

struct Unit { int pm, pn, kind, e, row0, nvalid; };

__device__ __forceinline__ unsigned cvt_pk_bf16(float lo, float hi) { unsigned r; asm volatile("v_cvt_pk_bf16_f32 %0, %1, %2" : "=v"(r) : "v"(lo), "v"(hi)); return r; }
__device__ __forceinline__ f32x2 gelu_pk(f32x2 v) {
    const f32x2 av = __builtin_elementwise_abs(v), d = av * 0.2316418882f + 1.0f;
    f32x2 t; t.x = __builtin_amdgcn_rcpf(d.x); t.y = __builtin_amdgcn_rcpf(d.y);
    f32x2 q = t * 0.5307027145f + (-0.7265760135f); q = q * t + 0.7107068705f; q = q * t + (-0.142248368f); q = q * t + 0.127414796f; q = q * t;
    const f32x2 s = (v * v) * (-0.72134752044f);
    f32x2 e; e.x = __builtin_amdgcn_exp2f(s.x); e.y = __builtin_amdgcn_exp2f(s.y);
    const f32x2 m = v * (q * e), r = v - m;
    f32x2 o; o.x = v.x < 0.f ? m.x : r.x; o.y = v.y < 0.f ? m.y : r.y; return o;
}
__device__ __forceinline__ float sigmoid_f(float x) { return __builtin_amdgcn_rcpf(1.0f + __builtin_amdgcn_exp2f(-1.4426950408889634f * x)); }

template <class Epi, class Sched>
__device__ __forceinline__ void gemm_phase(PG8_LAS unsigned char* lds, const int K, const Sched& S, const Epi& E, int tid) {
    asm volatile("" : "+v"(tid));
    const int wid = __builtin_amdgcn_readfirstlane(tid >> 6), lane = tid & 63, wr = wid >> 2, wc = wid & 3, fr = lane & 15, fq = lane >> 4;
    const int nt = K / BK;
    unsigned voffA[2], voffB[2];
#pragma unroll
    for (int i = 0; i < 2; ++i) { int R, C; stage_rc(tid * 16 + i * 8192, R, C); const int Rb = Epi::PERM ? ((R & ~31) + perm32(R & 31)) : R;
        voffA[i] = Sched::GATHER ? 0u : (unsigned)(R * K + C) * 2u; voffB[i] = (unsigned)(Rb * K + C) * 2u; }
#define PG8_GOFF(u, h, i) ({ int _R, _C, _t = tid; asm volatile("" : "+v"(_t)); stage_rc(_t * 16 + (i) * 8192, _R, _C); S.a_goff((u), (h) * HALF + _R) + (unsigned)(_C * 2); })
    const size_t kstep = (size_t)(BK * 2);
    const size_t hstep = (size_t)HALF * K * 2;
    const unsigned ldsw = (unsigned)wid * 1024u;
    const int aoff = lds_byte(wr * 64 + fr, fq * 8), boff = lds_byte(wc * 32 + fr, fq * 8);
#define PG8_SA(b, h) (((b) * 2 + (h)) * HTB)
#define PG8_SB(b, h) ((4 + (b) * 2 + (h)) * HTB)
#define PG8_STAGE(bufoff, gbase, voff) do { _Pragma("unroll") for (int _i = 0; _i < 2; ++_i) \
        __builtin_amdgcn_global_load_lds((const unsigned*)((const char*)(gbase) + (voff)[_i]), (PG8_LAS unsigned*)(lds + (bufoff) + ldsw + _i * 8192), 16, 0, 0); } while (0)
#define PG8_STAGE_A(bufoff, gbase, h, GO) do { if constexpr (Sched::GATHER) { _Pragma("unroll") for (int _i = 0; _i < 2; ++_i) \
        __builtin_amdgcn_global_load_lds((const unsigned*)((const char*)(gbase) + (GO)[h][_i]), (PG8_LAS unsigned*)(lds + (bufoff) + ldsw + _i * 8192), 16, 0, 0); } \
        else { PG8_STAGE(bufoff, (gbase) + (h) * hstep, voffA); } } while (0)
#define PG8_LDA(dst, b, h) do { _Pragma("unroll") for (int m = 0; m < 4; ++m) _Pragma("unroll") for (int k = 0; k < 2; ++k) dst[m][k] = *(const PG8_LAS bf16x8*)(lds + PG8_SA(b, h) + aoff + m * 2048 + k * 1024); } while (0)
#define PG8_LDB(dst, b, h) do { _Pragma("unroll") for (int n = 0; n < 2; ++n) _Pragma("unroll") for (int k = 0; k < 2; ++k) dst[n][k] = *(const PG8_LAS bf16x8*)(lds + PG8_SB(b, h) + boff + n * 2048 + k * 1024); } while (0)
#define PG8_MMA(ai, bj, At, Bt) do { __builtin_amdgcn_s_setprio(1); _Pragma("unroll") for (int m = 0; m < 4; ++m) _Pragma("unroll") for (int n = 0; n < 2; ++n) _Pragma("unroll") for (int k = 0; k < 2; ++k) \
        acc[ai][bj][m][n] = __builtin_amdgcn_mfma_f32_16x16x32_bf16(Bt[n][k], At[m][k], acc[ai][bj][m][n], 0, 0, 0); __builtin_amdgcn_s_setprio(0); } while (0)
#define PG8_WAIT_V(n) asm volatile("s_waitcnt vmcnt(" #n ")" ::: "memory")
#define PG8_WAIT_L(n) asm volatile("s_waitcnt lgkmcnt(" #n ")" ::: "memory")
#define PG8_BAR __builtin_amdgcn_s_barrier()
#define PG8_SCHED __builtin_amdgcn_sched_barrier(0)
    Unit cur, nxt; int ui = 0;
    if (!S.next(0, cur)) return;
    f32x4 acc[2][2][4][2];
#pragma unroll
    for (int a = 0; a < 2; ++a)
#pragma unroll
        for (int b = 0; b < 2; ++b)
#pragma unroll
            for (int m = 0; m < 4; ++m)
#pragma unroll
                for (int n = 0; n < 2; ++n) acc[a][b][m][n] = (f32x4){0.f, 0.f, 0.f, 0.f};
    bf16x8 At[4][2], B0[2][2], B1[2][2];
    const char* cA = S.a_base(cur); const char* cB = S.b_base(cur);
    unsigned cgo[2][2], ngo[2][2];
    if constexpr (Sched::GATHER) {
#pragma unroll
        for (int h = 0; h < 2; ++h)
#pragma unroll
            for (int i = 0; i < 2; ++i) { cgo[h][i] = PG8_GOFF(cur, h, i); ngo[h][i] = cgo[h][i]; }
    }
    PG8_STAGE(PG8_SB(0, 0), cB, voffB); PG8_STAGE(PG8_SB(0, 1), cB + hstep, voffB); PG8_STAGE_A(PG8_SA(0, 0), cA, 0, cgo); PG8_STAGE_A(PG8_SA(0, 1), cA, 1, cgo);
    if (wr == 1) PG8_BAR;
    PG8_WAIT_V(2); PG8_BAR;
    PG8_STAGE(PG8_SB(1, 0), cB + kstep, voffB); PG8_STAGE_A(PG8_SA(1, 0), cA + kstep, 0, cgo); PG8_STAGE(PG8_SB(1, 1), cB + hstep + kstep, voffB);
    PG8_WAIT_V(6); PG8_BAR;
    for (;;) {
        const bool has_next = S.next(ui + 1, nxt);
        const char* nA = has_next ? S.a_base(nxt) : cA; const char* nB = has_next ? S.b_base(nxt) : cB;
        if constexpr (Sched::GATHER) {
            if (has_next) {
#pragma unroll
                for (int h = 0; h < 2; ++h)
#pragma unroll
                    for (int i = 0; i < 2; ++i) ngo[h][i] = PG8_GOFF(nxt, h, i);
            }
        }
        for (int t = 0; t < nt; t += 2) {
            const bool last = (t == nt - 2);
            if constexpr (Epi::MIDK) { if (t == (nt >> 1)) E.mid(acc, cur, wr, wc, fr, fq); }
            const char* a1 = cA + (size_t)(t + 1) * kstep;
            const char* a2 = last ? nA : cA + (size_t)(t + 2) * kstep; const char* b2 = last ? nB : cB + (size_t)(t + 2) * kstep;
            const char* a3 = a2 + kstep; const char* b3 = b2 + kstep;
            unsigned xgo[2][2];
            if constexpr (Sched::GATHER) {
#pragma unroll
                for (int h = 0; h < 2; ++h)
#pragma unroll
                    for (int i = 0; i < 2; ++i) xgo[h][i] = last ? ngo[h][i] : cgo[h][i];
            }
            PG8_LDB(B0, 0, 0); PG8_LDB(B1, 0, 1); PG8_SCHED; PG8_LDA(At, 0, 0); PG8_STAGE_A(PG8_SA(1, 1), a1, 1, cgo);
            PG8_WAIT_V(8); PG8_WAIT_L(0); PG8_BAR; PG8_MMA(0, 0, At, B0); PG8_MMA(0, 1, At, B1); PG8_BAR; PG8_SCHED;
            PG8_LDA(At, 0, 1); PG8_STAGE(PG8_SB(0, 0), b2, voffB); PG8_STAGE(PG8_SB(0, 1), b2 + hstep, voffB); PG8_STAGE_A(PG8_SA(0, 0), a2, 0, xgo);
            PG8_WAIT_V(8); PG8_WAIT_L(0); PG8_BAR; PG8_MMA(1, 0, At, B0); PG8_MMA(1, 1, At, B1); PG8_BAR; PG8_SCHED;
            PG8_LDB(B0, 1, 0); PG8_LDB(B1, 1, 1); PG8_SCHED; PG8_LDA(At, 1, 0); PG8_STAGE_A(PG8_SA(0, 1), a2, 1, xgo);
            PG8_WAIT_V(8); PG8_WAIT_L(0); PG8_BAR; PG8_MMA(0, 0, At, B0); PG8_MMA(0, 1, At, B1); PG8_BAR; PG8_SCHED;
            PG8_LDA(At, 1, 1); PG8_STAGE(PG8_SB(1, 0), b3, voffB); PG8_STAGE(PG8_SB(1, 1), b3 + hstep, voffB); PG8_STAGE_A(PG8_SA(1, 0), a3, 0, xgo);
            PG8_WAIT_V(8); PG8_WAIT_L(0); PG8_BAR; PG8_MMA(1, 0, At, B0); PG8_MMA(1, 1, At, B1); PG8_BAR; PG8_SCHED;
        }
        if (wr == 0) PG8_BAR;
        E(acc, cur, wr, wc, fr, fq);
        if (!has_next) break;
#pragma unroll
        for (int a = 0; a < 2; ++a)
#pragma unroll
            for (int b = 0; b < 2; ++b)
#pragma unroll
                for (int m = 0; m < 4; ++m)
#pragma unroll
                    for (int n = 0; n < 2; ++n) acc[a][b][m][n] = (f32x4){0.f, 0.f, 0.f, 0.f};
        cur = nxt; cA = nA; cB = nB; ++ui;
        if constexpr (Sched::GATHER) {
#pragma unroll
            for (int h = 0; h < 2; ++h)
#pragma unroll
                for (int i = 0; i < 2; ++i) cgo[h][i] = ngo[h][i];
        }
        if (wr == 1) PG8_BAR;
    }
    PG8_WAIT_V(0);
    PG8_BAR;
#undef PG8_SA
#undef PG8_SB
#undef PG8_STAGE
#undef PG8_STAGE_A
#undef PG8_GOFF
#undef PG8_LDA
#undef PG8_LDB
#undef PG8_MMA
#undef PG8_WAIT_V
#undef PG8_WAIT_L
#undef PG8_BAR
#undef PG8_SCHED
}
}
constexpr int NWAVES = 8, NTHR = 512;
constexpr int SEQ = 8192, DM = 2048, NIN = 9216, HYW = 1024, SGW = 1024, NHY = 3072, NEXP = 16, DEXP = 512, DEPTH = 2;
constexpr float EPS = 1e-6f;
constexpr size_t MiB = 1u << 20;
constexpr size_t WS_CTL = 0, CTL_ZERO_BYTES = 1 * MiB;
constexpr size_t WS_WIN = 1 * MiB;
constexpr size_t WS_PT = WS_WIN + 36 * MiB;
constexpr size_t WS_WOT = WS_PT + 8 * MiB;
constexpr size_t WS_WGU = WS_WOT + 8 * MiB;
constexpr size_t WS_WD = WS_WGU + 64 * MiB;
constexpr size_t WS_W3T = WS_WD + 32 * MiB;
constexpr size_t WS_A2 = WS_W3T + 1 * MiB;
constexpr size_t WS_WR = WS_A2 + 1 * MiB;
constexpr size_t WS_LISTS = WS_WR + 1 * MiB;
constexpr size_t WS_XR = WS_LISTS + 2 * MiB;
constexpr size_t WS_XN = WS_XR + 64 * MiB;
constexpr size_t WS_ZT = WS_XN + 32 * MiB;
constexpr size_t WS_U = WS_ZT + 48 * MiB;
constexpr size_t WS_GV = WS_U + 16 * MiB;
constexpr size_t WS_GH = WS_GV + 16 * MiB;
constexpr size_t WS_GS = WS_GH + 32 * MiB;
constexpr size_t WS_Y = WS_GS + 32 * MiB;
constexpr size_t WS_FS = WS_Y + 32 * MiB;
constexpr size_t WS_END = WS_FS + 128 * MiB;
constexpr size_t WS_MERGED = WS_ZT, WS_ACT = WS_U, WS_MOEOUT = WS_FS;
constexpr int CW_TMO = 0;
constexpr int CW_CNT = 64;
constexpr int CW_BAR = 4096;
constexpr int SCRATCH_BYTES = 2 * 8448 * 8;
constexpr int MISC_OFF = SCRATCH_BYTES;
constexpr int LDS_BYTES = SCRATCH_BYTES + 1024;
static_assert(SCRATCH_BYTES >= pg8::STAGE_BYTES, "lds");

#define GAS __attribute__((address_space(1)))
#define LAS __attribute__((address_space(3)))
typedef unsigned short bf16;
typedef unsigned v4u __attribute__((ext_vector_type(4)));
typedef unsigned v2u __attribute__((ext_vector_type(2)));
typedef float f32x4 __attribute__((ext_vector_type(4)));
typedef short bf16x8 __attribute__((ext_vector_type(8)));
typedef GAS unsigned gu32;
#define RLX_AGENT __ATOMIC_RELAXED, __HIP_MEMORY_SCOPE_AGENT
#define LDS_WAIT() asm volatile("s_waitcnt lgkmcnt(0)" ::: "memory")
#define VM_WAIT() asm volatile("s_waitcnt vmcnt(0)" ::: "memory")
__device__ __forceinline__ unsigned f2bf(float f) { unsigned u = __builtin_bit_cast(unsigned, f); return (u + 0x7fffu + ((u >> 16) & 1u)) >> 16; }
__device__ __forceinline__ unsigned pk2(float lo, float hi) { return f2bf(lo) | (f2bf(hi) << 16); }
__device__ __forceinline__ float bfl(unsigned u) { return __builtin_bit_cast(float, u << 16); }
__device__ __forceinline__ float bfh(unsigned u) { return __builtin_bit_cast(float, u & 0xffff0000u); }

#define XB_TMO      128
#define XB_XCNT(j)  (256  + 64 * (j))
#define XB_XSUB(j)  (1280 + 64 * (j))
#define XB_XGEN(j)  (2304 + 64 * (j))
#define XB_TOP      3328
#define XB_TOPGEN   3392
#define XCD_BAR_WORDS 3456
#define XB_SPIN_CAP (1u << 18)
__device__ __forceinline__ unsigned xb_ld(unsigned* p)              { return __hip_atomic_load(p, __ATOMIC_RELAXED, __HIP_MEMORY_SCOPE_AGENT); }
__device__ __forceinline__ unsigned xb_add(unsigned* p, unsigned v) { return __hip_atomic_fetch_add(p, v, __ATOMIC_RELAXED, __HIP_MEMORY_SCOPE_AGENT); }
__device__ __forceinline__ unsigned xb_xcc_id() { return (unsigned)__builtin_amdgcn_s_getreg((3 << 11) | 20) & 0xFu; }
#define XB_SPIN(cond, bar) do { unsigned _sp = 0; while (cond) { __builtin_amdgcn_s_sleep(1); \
    if ((++_sp & 255u) == 0u) { if (xb_ld(&(bar)[XB_TMO])) break; if (_sp > XB_SPIN_CAP) { atomicAdd(&(bar)[XB_TMO], 1u); break; } } } } while (0)
struct XcdBarrier { unsigned* bar; unsigned x; volatile LAS unsigned* st; };
__device__ __forceinline__ XcdBarrier xcd_barrier_post(unsigned* bar, volatile LAS unsigned* st) {
    XcdBarrier b; b.bar = bar; b.x = xb_xcc_id(); b.st = st;
    if (threadIdx.x == 0) (void)xb_add(&bar[XB_XCNT(b.x)], 1u);
    return b;
}
__device__ __forceinline__ void xcd_barrier_complete(unsigned* bar, unsigned x, unsigned& nloc, unsigned& nx) {
    const unsigned G = gridDim.x * gridDim.y * gridDim.z;
    unsigned sum, cnt, mine, sp = 0u;
    for (;;) {
        sum = 0u; cnt = 0u; mine = 0u;
#pragma unroll
        for (unsigned j = 0; j < 16; ++j) { const unsigned c = xb_ld(&bar[XB_XCNT(j)]); sum += c; cnt += (c > 0u) ? 1u : 0u; mine = (j == x) ? c : mine; }
        if (sum == G) break;
        __builtin_amdgcn_s_sleep(1);
        if ((++sp & 255u) == 0u) { if (xb_ld(&bar[XB_TMO])) break; if (sp > XB_SPIN_CAP) { atomicAdd(&bar[XB_TMO], 1u); break; } }
    }
    nloc = mine > 0u ? mine : 1u; nx = cnt > 0u ? cnt : 1u;
}
__device__ __forceinline__ void xcd_barrier(const XcdBarrier& b) {
    asm volatile("s_waitcnt vmcnt(0)" ::: "memory");
    __syncthreads();
    if (threadIdx.x == 0) {
        unsigned* bar = b.bar;
        __builtin_amdgcn_s_waitcnt(0);
        unsigned nloc = b.st[0], nx = b.st[1];
        if (nloc == 0u) { xcd_barrier_complete(bar, b.x, nloc, nx); b.st[0] = nloc; b.st[1] = nx; }
        const unsigned old = xb_add(&bar[XB_XSUB(b.x)], 1u);
        const unsigned gen = old / nloc;
        if (old + 1u == (gen + 1u) * nloc) {
            __builtin_amdgcn_fence(__ATOMIC_RELEASE, "agent");
            asm volatile("s_waitcnt vmcnt(0)" ::: "memory");
            const unsigned og = xb_add(&bar[XB_TOP], 1u);
            const unsigned tg = og / nx;
            if (og + 1u == (tg + 1u) * nx) xb_add(&bar[XB_TOPGEN], 1u);
            else XB_SPIN(xb_ld(&bar[XB_TOPGEN]) == tg, bar);
            __builtin_amdgcn_fence(__ATOMIC_ACQUIRE, "agent");
            xb_add(&bar[XB_XGEN(b.x)], 1u);
            asm volatile("s_waitcnt vmcnt(0)" ::: "memory");
        } else {
            XB_SPIN(xb_ld(&bar[XB_XGEN(b.x)]) == gen, bar);
            __builtin_amdgcn_fence(__ATOMIC_ACQUIRE, "agent");
            asm volatile("s_waitcnt vmcnt(0)" ::: "memory");
        }
    }
    __syncthreads();
}

struct Frame {
    LAS unsigned char* lds;
    volatile LAS unsigned* MISC;
    gu32* ctl;
    int tid, lane, wave;
    int vcu, G;
    const float* in[29];
    float* out;
    unsigned char* ws;
};
enum { I_X = 0, I_GMIX, I_WIN, I_BIN, I_CONVW, I_CONVB, I_FW1, I_FB1, I_FW2, I_FB2, I_FW3, I_FFREQ, I_SKIP, I_LNG, I_LNB, I_SGW, I_SGB, I_WHY, I_WSG, I_WOUT, I_GFFN, I_WRG, I_BRG, I_WRE, I_BRE, I_WGATE, I_WUP, I_WDOWN, I_GFINAL };

__device__ __forceinline__ float shfl_xor_l(float v, int mask, int lane) { return __builtin_bit_cast(float, __builtin_amdgcn_ds_bpermute((lane ^ mask) << 2, __builtin_bit_cast(int, v))); }
__device__ __forceinline__ float shfl_down1_l(float v, int lane) { return __builtin_bit_cast(float, __builtin_amdgcn_ds_bpermute(((lane + 1) & 63) << 2, __builtin_bit_cast(int, v))); }
__device__ __forceinline__ float wave_sum(float v, int lane) {
#pragma unroll
    for (int o = 1; o < 64; o <<= 1) v += shfl_xor_l(v, o, lane);
    return v;
}

#ifndef PROBE_K
#define PROBE_K -1
#endif
#define HP_ME (blockIdx.x == 0 && threadIdx.x == 0)
#define HPS(j) do { if (PROBE_K == (j) && HP_ME) ((volatile LAS unsigned long long*)(F.lds + MISC_OFF + 512))[0] = __builtin_amdgcn_s_memrealtime(); } while (0)
#define HPE(j) do { if (PROBE_K == (j) && HP_ME) { volatile LAS unsigned long long* _p = (volatile LAS unsigned long long*)(F.lds + MISC_OFF + 512); _p[1] += __builtin_amdgcn_s_memrealtime() - _p[0]; } } while (0)
#define HD __device__ __forceinline__
#define HY_OPAQUE(x) asm volatile("" : "+v"(x))
typedef float hy_f2v __attribute__((ext_vector_type(2)));
#define LDC(p, i) ((p)[i])
#define STC(p, i, v) ((p)[i] = (v))
typedef float c32 __attribute__((ext_vector_type(2)));
HD c32 cmk(float x, float y) { c32 r; r.x = x; r.y = y; return r; }
HD c32 cmul(c32 a, c32 b) { const c32 bs = cmk(-b.y, b.x); return a.xx * b + a.yy * bs; }
HD c32 cmulc(c32 a, c32 b) { const c32 bc = cmk(b.x, -b.y), bs = cmk(b.y, b.x); return a.xx * bc + a.yy * bs; }
HD c32 rot_mi(c32 a) { return cmk(a.y, -a.x); }
HD c32 rot_pi(c32 a) { return cmk(-a.y, a.x); }
#define HY_N 8192
#define HY_LDS_C32 (8192 + 256)

template <int SIGN> HD void dft4(c32& a, c32& b, c32& c, c32& d) {
    const c32 t0 = a + c, t1 = a - c, t2 = b + d, t3 = b - d;
    a = t0 + t2; c = t0 - t2;
    if (SIGN < 0) { b = t1 + rot_mi(t3); d = t1 - rot_mi(t3); }
    else          { b = t1 + rot_pi(t3); d = t1 - rot_pi(t3); }
}
template <int SIGN> HD void dft16(c32 (&a)[16]) {
    const float C1 = 0.92387953251128674f, S1 = 0.38268343236508977f, R2 = 0.70710678118654752f;
#pragma unroll
    for (int n2 = 0; n2 < 4; ++n2) dft4<SIGN>(a[n2], a[4 + n2], a[8 + n2], a[12 + n2]);
    const float sg = (SIGN < 0) ? -1.f : 1.f;
    const c32 w1 = cmk(C1, sg * S1), w2 = cmk(R2, sg * R2), w3 = cmk(S1, sg * C1), w6 = cmk(-R2, sg * R2), w9 = cmk(-C1, -sg * S1);
    a[1 + 4] = cmul(a[1 + 4], w1); a[2 + 4] = cmul(a[2 + 4], w2); a[3 + 4] = cmul(a[3 + 4], w3);
    a[1 + 8] = cmul(a[1 + 8], w2); a[2 + 8] = (SIGN < 0) ? rot_mi(a[2 + 8]) : rot_pi(a[2 + 8]); a[3 + 8] = cmul(a[3 + 8], w6);
    a[1 + 12] = cmul(a[1 + 12], w3); a[2 + 12] = cmul(a[2 + 12], w6); a[3 + 12] = cmul(a[3 + 12], w9);
#pragma unroll
    for (int k1 = 0; k1 < 4; ++k1) dft4<SIGN>(a[4 * k1], a[4 * k1 + 1], a[4 * k1 + 2], a[4 * k1 + 3]);
    c32 t[16];
#pragma unroll
    for (int i = 0; i < 16; ++i) t[i] = a[i];
#pragma unroll
    for (int k1 = 0; k1 < 4; ++k1)
#pragma unroll
        for (int k2 = 0; k2 < 4; ++k2) a[k1 + 4 * k2] = t[4 * k1 + k2];
}
HD void twiddle_tree(c32 (&a)[16], c32 w1) {
    const c32 w2 = cmul(w1, w1), w3 = cmul(w2, w1), w4 = cmul(w2, w2), w5 = cmul(w4, w1), w6 = cmul(w4, w2), w7 = cmul(w4, w3), w8 = cmul(w4, w4);
    a[1] = cmul(a[1], w1); a[2] = cmul(a[2], w2); a[3] = cmul(a[3], w3); a[4] = cmul(a[4], w4); a[5] = cmul(a[5], w5); a[6] = cmul(a[6], w6); a[7] = cmul(a[7], w7); a[8] = cmul(a[8], w8);
    a[9] = cmul(a[9], cmul(w8, w1)); a[10] = cmul(a[10], cmul(w8, w2)); a[11] = cmul(a[11], cmul(w8, w3)); a[12] = cmul(a[12], cmul(w8, w4));
    a[13] = cmul(a[13], cmul(w8, w5)); a[14] = cmul(a[14], cmul(w8, w6)); a[15] = cmul(a[15], cmul(w8, w7));
}
HD c32 cis_pi(float x) { return cmk(cospif(x), sinpif(x)); }

HD void fft_s1_fwd(int tid, LAS c32* buf, c32 (&a)[16]) { HY_OPAQUE(tid);
    dft16<-1>(a);
    twiddle_tree(a, cis_pi(-2.0f * (float)tid / 8192.0f));
    LAS c32* p0 = buf + tid + (tid >> 5);
#pragma unroll
    for (int p = 0; p < 16; ++p) STC(p0, 528 * p, a[p]);
}
HD void fft_s2_fwd(int tid, LAS c32* buf) { HY_OPAQUE(tid);
    LAS c32* p0 = buf + (tid >> 5) * 528 + (tid & 31);
    c32 a[16];
#pragma unroll
    for (int q = 0; q < 16; ++q) a[q] = LDC(p0, 33 * q);
    dft16<-1>(a);
    twiddle_tree(a, cis_pi(-2.0f * (float)(tid & 31) / 512.0f));
#pragma unroll
    for (int p = 0; p < 16; ++p) STC(p0, 33 * p, a[p]);
}
HD float w32c(int q) { switch (q) { case 0: return 1.0f; case 1: return 0.98078528040323043f; case 2: return 0.92387953251128674f; case 3: return 0.83146961230254524f; case 4: return 0.70710678118654752f; case 5: return 0.55557023301960218f; case 6: return 0.38268343236508977f; case 7: return 0.19509032201612825f;
    case 8: return 0.0f; case 9: return -0.19509032201612825f; case 10: return -0.38268343236508977f; case 11: return -0.55557023301960218f; case 12: return -0.70710678118654752f; case 13: return -0.83146961230254524f; case 14: return -0.92387953251128674f; default: return -0.98078528040323043f; } }
HD float w32s(int q) { switch (q) { case 0: return 0.0f; case 1: return 0.19509032201612825f; case 2: return 0.38268343236508977f; case 3: return 0.55557023301960218f; case 4: return 0.70710678118654752f; case 5: return 0.83146961230254524f; case 6: return 0.92387953251128674f; case 7: return 0.98078528040323043f;
    case 8: return 1.0f; case 9: return 0.98078528040323043f; case 10: return 0.92387953251128674f; case 11: return 0.83146961230254524f; case 12: return 0.70710678118654752f; case 13: return 0.55557023301960218f; case 14: return 0.38268343236508977f; default: return 0.19509032201612825f; } }
template <int SIGN> HD void fft_s3_read(int tid, const LAS c32* buf, c32 (&s)[16]) { HY_OPAQUE(tid);
    const LAS c32* p0 = buf + (tid >> 1) * 33; const int h = tid & 1;
    const float sg = (SIGN < 0) ? -1.f : 1.f, hs = h ? -1.f : 1.f;
#pragma unroll
    for (int q = 0; q < 16; ++q) {
        const c32 u = LDC(p0, q), v = LDC(p0, q + 16);
        const c32 d = u + v * hs;
        const c32 w = h ? cmk(w32c(q), sg * w32s(q)) : cmk(1.f, 0.f);
        s[q] = (q == 0) ? d : cmul(d, w);
    }
    dft16<SIGN>(s);
}
HD void fft_s3_write(int tid, LAS c32* buf, const c32 (&s)[16]) { HY_OPAQUE(tid);
    LAS c32* p0 = buf + (tid >> 1) * 33 + (tid & 1);
#pragma unroll
    for (int p = 0; p < 16; ++p) STC(p0, 2 * p, s[p]);
}
HD void fft_s2_inv(int tid, LAS c32* buf) { HY_OPAQUE(tid);
    LAS c32* p0 = buf + (tid >> 5) * 528 + (tid & 31);
    c32 a[16];
#pragma unroll
    for (int q = 0; q < 16; ++q) a[q] = LDC(p0, 33 * q);
    twiddle_tree(a, cis_pi(2.0f * (float)(tid & 31) / 512.0f));
    dft16<1>(a);
#pragma unroll
    for (int p = 0; p < 16; ++p) STC(p0, 33 * p, a[p]);
}
HD void fft_s1_inv(int tid, const LAS c32* buf, c32 (&a)[16]) { HY_OPAQUE(tid);
    const LAS c32* p0 = buf + tid + (tid >> 5);
#pragma unroll
    for (int p = 0; p < 16; ++p) a[p] = LDC(p0, 528 * p);
    twiddle_tree(a, cis_pi(2.0f * (float)tid / 8192.0f));
    dft16<1>(a);
}
HD void pair_pass(int tid, LAS c32* Z, const LAS c32* H) { HY_OPAQUE(tid);
    const int p3 = tid & 31;
    const c32 wp3 = cis_pi(-(float)p3 / 32.0f);
    const c32 wstep = cis_pi(-16.0f / 8192.0f);
    c32 wlow = cis_pi(-(float)(tid >> 5) / 8192.0f);
#pragma unroll 1
    for (int it = 0; it < 9; ++it) {
        const int low = it * 16 + (tid >> 5);
        const c32 Wk = cmul(wlow, wp3);
        wlow = cmul(wlow, wstep);
        if (low > 128) continue;
        bool act = true; int p3b = 31 - p3, lowb = 256 - low;
        if (low == 0) { act = p3 <= 16; p3b = (32 - p3) & 31; lowb = 0; }
        else if (low == 128) { act = p3 <= 15; lowb = 128; }
        if (!act) continue;
        const int pa = (low & 15) * 528 + (low >> 4) * 33 + p3, pb = (lowb & 15) * 528 + (lowb >> 4) * 33 + p3b;
        const c32 A = LDC(Z, pa), B = LDC(Z, pb), HA = LDC(H, pa), HB = LDC(H, pb);
        const c32 Bc = cmk(B.x, -B.y), HBc = cmk(HB.x, -HB.y);
        c32 E = (A + Bc) * 0.5f, O = rot_mi(A - Bc) * 0.5f;
        c32 T = cmul(Wk, O);
        const c32 X = E + T, Xm = E - T;
        E = (HA + HBc) * 0.5f; O = rot_mi(HA - HBc) * 0.5f;
        T = cmul(Wk, O);
        const c32 Hk = E + T, Hm = E - T;
        const c32 Y = cmul(X, Hk), Ypc = cmul(Xm, Hm);
        const float sc = 0.5f / 8192.0f;
        const c32 Ye = (Y + Ypc) * sc, Yd = (Y - Ypc) * sc;
        const c32 Yo = cmulc(Yd, Wk);
        STC(Z, pa, Ye + rot_pi(Yo));
        if (pb != pa) STC(Z, pb, cmk(Ye.x + Yo.y, Yo.x - Ye.y));
    }
}
HD float bf_lo(unsigned u) { unsigned v = u << 16; return __builtin_bit_cast(float, v); }
HD float bf_hi(unsigned u) { unsigned v = u & 0xffff0000u; return __builtin_bit_cast(float, v); }
HD void hy_conv3_load(int tid, const unsigned* zrow, float c0, float c1, float c2, float cb, c32 (&out)[8]) { HY_OPAQUE(tid);
    unsigned wm[8], wl[8], wr[8];
#pragma unroll
    for (int q = 0; q < 8; ++q) { const int m = tid + 512 * q; wm[q] = zrow[m]; wl[q] = (m > 0) ? zrow[m - 1] : 0u; wr[q] = (m < 4095) ? zrow[m + 1] : 0u; }
#pragma unroll
    for (int q = 0; q < 8; ++q) {
        const float zm1 = bf_hi(wl[q]), z0 = bf_lo(wm[q]), z1 = bf_hi(wm[q]), z2 = bf_lo(wr[q]);
        out[q] = cmk(c0 * zm1 + c1 * z0 + c2 * z1 + cb, c0 * z0 + c1 * z1 + c2 * z2 + cb);
    }
}
HD void hy_filter_s1(int tid, LAS c32* buf, const c32* zk) { HY_OPAQUE(tid);
    c32 a[16];
#pragma unroll
    for (int q = 0; q < 16; ++q) a[q] = zk[tid + 512 * q];
    fft_s1_fwd(tid, buf, a);
}
HD void hy_data_s1(int tid, LAS c32* buf, const c32 (&v)[8]) { HY_OPAQUE(tid);
    c32 a[16];
#pragma unroll
    for (int q = 0; q < 8; ++q) a[q] = v[q];
#pragma unroll
    for (int q = 8; q < 16; ++q) a[q] = cmk(0.f, 0.f);
    fft_s1_fwd(tid, buf, a);
}
HD void hy_pack_store(c32* zk, int dir, int a4, float t0, float t1, float t2, float t3) {
    if (dir == 0) { zk[a4 / 2] = cmk(t0, t1); zk[a4 / 2 + 1] = cmk(t2, t3); }
    else {
        const int m = 8192 - a4 / 2;
        if (a4 > 0) ((float*)(zk + m))[0] = t0;
        zk[m - 1] = cmk(t2, t1);
        if (a4 == 8188) zk[m - 2] = cmk(0.f, t3); else ((float*)(zk + m - 2))[1] = t3;
    }
}
struct CvItem { const float* src; int N; bf16* dst; size_t dld; };
__device__ __forceinline__ bool cv_decode(Frame& F, int l, int it, CvItem& d) {
    bf16* WIN = (bf16*)(F.ws + WS_WIN); bf16* PT = (bf16*)(F.ws + WS_PT); bf16* WOT = (bf16*)(F.ws + WS_WOT); bf16* WGU = (bf16*)(F.ws + WS_WGU); bf16* WD = (bf16*)(F.ws + WS_WD); bf16* W3T = (bf16*)(F.ws + WS_W3T);
    constexpr int S0 = 32 * 288, S1 = 16 * 64, S3 = 32 * 64, S4 = 16 * 32 * 16, S6 = 16 * 8 * 64, S7 = 128;
    constexpr int NITEMS = S0 + 2 * S1 + S3 + 2 * S4 + S6 + S7;
    if (it >= NITEMS) return false;
    int r = it;
    if (r < S0) { const int kb = r / 288, nb = r % 288; d.src = F.in[I_WIN] + (size_t)l * DM * NIN + (size_t)(64 * kb) * NIN + 32 * nb; d.N = NIN; d.dst = WIN + (size_t)(32 * nb) * DM + 64 * kb; d.dld = DM; return true; } r -= S0;
    if (r < S1) { const int kb = r / 64, nb = r % 64; d.src = F.in[I_WHY] + (size_t)l * HYW * DM + (size_t)(64 * kb) * DM + 32 * nb; d.N = DM; d.dst = PT + (size_t)(32 * nb) * DM + 64 * kb; d.dld = DM; return true; } r -= S1;
    if (r < S1) { const int kb = r / 64, nb = r % 64; d.src = F.in[I_WSG] + (size_t)l * SGW * DM + (size_t)(64 * kb) * DM + 32 * nb; d.N = DM; d.dst = PT + (size_t)(32 * nb) * DM + 1024 + 64 * kb; d.dld = DM; return true; } r -= S1;
    if (r < S3) { const int kb = r / 64, nb = r % 64; d.src = F.in[I_WOUT] + (size_t)l * DM * DM + (size_t)(64 * kb) * DM + 32 * nb; d.N = DM; d.dst = WOT + (size_t)(32 * nb) * DM + 64 * kb; d.dld = DM; return true; } r -= S3;
    if (r < 2 * S4) { const int up = r / S4; r -= up * S4; const int e = r / 512, q = r % 512, kb = q / 16, nb = q % 16; const int n0 = 32 * nb, drow = 256 * (n0 / 128) + (n0 % 128) + 128 * up;
        d.src = (up ? F.in[I_WUP] : F.in[I_WGATE]) + ((size_t)l * NEXP + e) * DM * DEXP + (size_t)(64 * kb) * DEXP + n0; d.N = DEXP; d.dst = WGU + ((size_t)e * 1024 + drow) * DM + 64 * kb; d.dld = DM; return true; } r -= 2 * S4;
    if (r < S6) { const int e = r / 512, q = r % 512, kb = q / 64, nb = q % 64;
        d.src = F.in[I_WDOWN] + ((size_t)l * NEXP + e) * DEXP * DM + (size_t)(64 * kb) * DM + 32 * nb; d.N = DM; d.dst = WD + ((size_t)e * DM + 32 * nb) * DEXP + 64 * kb; d.dld = DEXP; return true; } r -= S6;
    { const int nb = r; d.src = F.in[I_FW3] + (size_t)l * 64 * 4096 + 32 * nb; d.N = 4096; d.dst = W3T + (size_t)(32 * nb) * 64; d.dld = 64; return true; }
}
__device__ __forceinline__ void cv_load(const CvItem& d, int lane, float (&v)[32]) {
    const float* s = d.src + (size_t)(lane >> 5) * d.N + (lane & 31);
#pragma unroll
    for (int i = 0; i < 32; ++i) v[i] = s[(size_t)(2 * i) * d.N];
}
__device__ __forceinline__ void cv_store(const CvItem& d, int lane, const float (&v)[32], LAS float* scr) {
#pragma unroll
    for (int i = 0; i < 32; ++i) scr[(2 * i + (lane >> 5)) * 33 + (lane & 31)] = v[i];
    LDS_WAIT(); asm volatile("" ::: "memory");
    const int c = lane & 7;
#pragma unroll
    for (int j = 0; j < 4; ++j) { const int n = (lane >> 3) + 8 * j; const LAS float* s = scr + (8 * c) * 33 + n;
        v4u o; o.x = pk2(s[0 * 33], s[1 * 33]); o.y = pk2(s[2 * 33], s[3 * 33]); o.z = pk2(s[4 * 33], s[5 * 33]); o.w = pk2(s[6 * 33], s[7 * 33]);
        *(GAS v4u*)(d.dst + (size_t)n * d.dld + 8 * c) = o; }
    LDS_WAIT(); asm volatile("" ::: "memory");
}
__device__ __forceinline__ void pa_convert(Frame& F, int l) {
    LAS float* scr = (LAS float*)(F.lds + F.wave * 16384);
    const int gw = F.vcu * NWAVES + F.wave, NGW = F.G * NWAVES;
    CvItem cur, nxt; float va[32], vb[32];
    int it = gw; asm volatile("" : "+s"(it));
    bool have = cv_decode(F, l, it, cur);
    if (have) cv_load(cur, F.lane, va);
    while (have) {
        const bool hn = cv_decode(F, l, it + NGW, nxt);
        if (hn) cv_load(nxt, F.lane, vb);
        cv_store(cur, F.lane, va, scr);
        if (!hn) break;
        it += 2 * NGW; have = cv_decode(F, l, it, cur);
        if (have) cv_load(cur, F.lane, va);
        cv_store(nxt, F.lane, vb, scr);
    }
}
__device__ __forceinline__ void pa_features(Frame& F, int l) {
    LAS float* zf = (LAS float*)(F.lds);
    LAS float* a1 = zf + 8 * 40;
    const float* w1 = F.in[I_FW1] + l * 33 * 64; const float* b1 = F.in[I_FB1] + l * 64; const float* w2 = F.in[I_FW2] + l * 64 * 64; const float* b2 = F.in[I_FB2] + l * 64; const float* fq = F.in[I_FFREQ] + l * 64;
    bf16* A2 = (bf16*)(F.ws + WS_A2);
    const int tl = F.tid >> 6, j = F.tid & 63;
    const float fr = fq[j];
    float w1c[33], w2c[64];
#pragma unroll
    for (int i = 0; i < 33; ++i) w1c[i] = w1[i * 64 + j];
#pragma unroll
    for (int i = 0; i < 64; ++i) w2c[i] = w2[i * 64 + j];
    for (int t0 = F.vcu * 8; t0 < SEQ; t0 += F.G * 8) {
        __syncthreads();
        if (F.tid < 8 * 33) { const int tt = F.tid / 33, i = F.tid % 33; const int t = t0 + tt; float v;
            const float w = 6.283185307179586f / (float)SEQ * (float)t;
            if (i == 0) v = (float)t / (float)(SEQ - 1);
            else { const int b = (i - 1) & 15; const float band = 1e-4f + (float)b * ((15.0f - 1e-4f) / 15.0f); const float a = band * w; v = (i <= 16) ? cosf(a) : -sinf(a); }
            zf[tt * 40 + i] = v; }
        __syncthreads();
        float s = b1[j];
#pragma unroll
        for (int i = 0; i < 33; ++i) s += zf[tl * 40 + i] * w1c[i];
        a1[tl * 64 + j] = sinf(fr * s);
        __syncthreads();
        float s2 = b2[j];
#pragma unroll
        for (int i = 0; i < 64; ++i) s2 += a1[tl * 64 + i] * w2c[i];
        A2[(size_t)(t0 + tl) * 64 + j] = (bf16)f2bf(sinf(fr * s2));
    }
    __syncthreads();
}
__device__ __forceinline__ void pa_router_t(Frame& F, int l) {
    float* WR = (float*)(F.ws + WS_WR);
    const float* wrg = F.in[I_WRG] + (size_t)l * DM * 4; const float* wre = F.in[I_WRE] + (size_t)l * 4 * DM * 4;
    for (int i = F.vcu * NTHR + F.tid; i < 20 * DM; i += F.G * NTHR) { const int o = i / DM, k = i % DM;
        WR[i] = (o < 4) ? wrg[k * 4 + o] : wre[((size_t)((o - 4) >> 2) * DM + k) * 4 + ((o - 4) & 3)]; }
}
__device__ __forceinline__ int moe_off(const gu32* cnt, int e) { int s = 0;
#pragma unroll
    for (int j = 0; j < 16; ++j) { const int c = (int)cnt[j]; s += (j < e) ? c : 0; } return s; }
template <int MODE, bool OUTF>
__device__ __forceinline__ void norm_row(Frame& F, int m, const float* xin, const float* g, const gu32* cntprev, float* outf) {
    float* XR = (float*)(F.ws + WS_XR); bf16* XN = (bf16*)(F.ws + WS_XN);
    const GAS f32x4* xr = (const GAS f32x4*)((MODE == 0 ? xin : XR) + (size_t)m * DM) + F.lane;
    f32x4 v[8];
#pragma unroll
    for (int j = 0; j < 8; ++j) v[j] = xr[64 * j];
    if (MODE == 1) {
        const int* TOKPOS = (const int*)(F.ws + WS_LISTS + 1 * MiB); const bf16* MO = (const bf16*)(F.ws + WS_MOEOUT);
#pragma unroll
        for (int k = 0; k < 2; ++k) { const int tp = TOKPOS[m * 2 + k]; const int e = tp >> 13, pos = tp & 8191; const int slot = moe_off(cntprev, e) + pos;
            const GAS v2u* mr = (const GAS v2u*)(MO + (size_t)slot * DM) + F.lane;
#pragma unroll
            for (int j = 0; j < 8; ++j) { const v2u w = mr[64 * j]; v[j].x += bfl(w.x); v[j].y += bfh(w.x); v[j].z += bfl(w.y); v[j].w += bfh(w.y); } }
        GAS f32x4* xw = (GAS f32x4*)(XR + (size_t)m * DM) + F.lane;
        if (!OUTF) {
#pragma unroll
            for (int j = 0; j < 8; ++j) xw[64 * j] = v[j]; }
    }
    float ss = 0.f;
#pragma unroll
    for (int j = 0; j < 8; ++j) ss += (v[j].x * v[j].x + v[j].y * v[j].y) + (v[j].z * v[j].z + v[j].w * v[j].w);
    const float rstd = 1.0f / sqrtf(wave_sum(ss, F.lane) * (1.0f / DM) + EPS);
    const GAS f32x4* gp = (const GAS f32x4*)g + F.lane;
    if (OUTF) { GAS f32x4* o = (GAS f32x4*)(outf + (size_t)m * DM) + F.lane;
#pragma unroll
        for (int j = 0; j < 8; ++j) { const f32x4 gg = gp[64 * j]; o[64 * j] = v[j] * rstd * gg; } }
    else { GAS v2u* o = (GAS v2u*)(XN + (size_t)m * DM) + F.lane;
#pragma unroll
        for (int j = 0; j < 8; ++j) { const f32x4 gg = gp[64 * j]; const f32x4 r = v[j] * rstd * gg; v2u w; w.x = pk2(r.x, r.y); w.y = pk2(r.z, r.w); o[64 * j] = w; } }
}

__device__ __forceinline__ void sgu_unit(Frame& F, int l, int ch, int g) {
    constexpr int RS = 136;
    LAS bf16* Wb = (LAS bf16*)(F.lds);
    LAS bf16* Vt = (LAS bf16*)(F.lds + 128 * RS * 2);
    LAS float* st = (LAS float*)(F.lds + 2 * 128 * RS * 2);
    const bf16* GV = (const bf16*)(F.ws + WS_GV); const bf16* U = (const bf16*)(F.ws + WS_U); bf16* Y = (bf16*)(F.ws + WS_Y);
    const float* lng = F.in[I_LNG] + l * SGW; const float* lnb = F.in[I_LNB] + l * SGW;
    const float* Wg = F.in[I_SGW] + ((size_t)l * 8 + g) * 128 * 128; const float* bg = F.in[I_SGB] + (l * 8 + g) * 128;
    const int t0 = ch * 128;
    __syncthreads();
    {
        const int row = F.tid >> 2, part = F.tid & 3; const GAS v4u* rp = (const GAS v4u*)(GV + (size_t)(t0 + row) * SGW);
        float s = 0.f, q = 0.f;
#pragma unroll 4
        for (int i = 0; i < 32; ++i) { const v4u w = rp[part + 4 * i]; const unsigned ww[4] = {w.x, w.y, w.z, w.w};
#pragma unroll
            for (int j = 0; j < 4; ++j) { const float a = bfl(ww[j]), b = bfh(ww[j]); s += a + b; q += a * a + b * b; } }
        s += shfl_xor_l(s, 1, F.lane); s += shfl_xor_l(s, 2, F.lane); q += shfl_xor_l(q, 1, F.lane); q += shfl_xor_l(q, 2, F.lane);
        const float mu = s * (1.0f / SGW); const float var = fmaxf(q * (1.0f / SGW) - mu * mu, 0.f);
        if (part == 0) { st[row] = mu; st[128 + row] = 1.0f / sqrtf(var + EPS); }
    }
    {
#pragma unroll
        for (int i = 0; i < 8; ++i) { const int idx = F.tid + NTHR * i; const int t = idx >> 5, s4 = (idx & 31) * 4; const f32x4 w = *(const GAS f32x4*)(Wg + t * 128 + s4);
            v2u o; o.x = pk2(w.x, w.y); o.y = pk2(w.z, w.w); *(LAS v2u*)(Wb + t * RS + s4) = o; }
    }
    __syncthreads();
    {
#pragma unroll
        for (int i = 0; i < 4; ++i) { const int chunk = F.tid + NTHR * i; const int s = chunk >> 4, kc = chunk & 15;
            const v4u w = *(const GAS v4u*)(GV + (size_t)(t0 + s) * SGW + g * 128 + 8 * kc); const unsigned ww[4] = {w.x, w.y, w.z, w.w};
            const float mu = st[s], rs = st[128 + s];
#pragma unroll
            for (int j = 0; j < 4; ++j) { const int k = 8 * kc + 2 * j; const float a = (bfl(ww[j]) - mu) * rs * lng[g * 128 + k] + lnb[g * 128 + k], b = (bfh(ww[j]) - mu) * rs * lng[g * 128 + k + 1] + lnb[g * 128 + k + 1];
                Vt[k * RS + s] = (bf16)f2bf(a); Vt[(k + 1) * RS + s] = (bf16)f2bf(b); } }
    }
    __syncthreads();
    {
        const int fr = F.lane & 15, fq = F.lane >> 4, tw = F.wave * 16;
        bf16x8 af[4];
#pragma unroll
        for (int ks = 0; ks < 4; ++ks) af[ks] = *(const LAS bf16x8*)(Wb + (tw + fr) * RS + ks * 32 + fq * 8);
        const int t = t0 + tw + fr; const float bias = bg[tw + fr];
#pragma unroll
        for (int kt = 0; kt < 8; ++kt) { f32x4 acc = (f32x4){0.f, 0.f, 0.f, 0.f};
#pragma unroll
            for (int ks = 0; ks < 4; ++ks) { const bf16x8 bfv = *(const LAS bf16x8*)(Vt + (kt * 16 + fr) * RS + ks * 32 + fq * 8);
                acc = __builtin_amdgcn_mfma_f32_16x16x32_bf16(bfv, af[ks], acc, 0, 0, 0); }
            const int kcol = g * 128 + kt * 16 + 4 * fq;
            const v2u uw = *(const GAS v2u*)(U + (size_t)t * SGW + kcol);
            v2u o; o.x = pk2(bfl(uw.x) * (acc[0] + bias), bfh(uw.x) * (acc[1] + bias)); o.y = pk2(bfl(uw.y) * (acc[2] + bias), bfh(uw.y) * (acc[3] + bias));
            *(GAS v2u*)(Y + (size_t)t * DM + 1024 + kcol) = o; }
    }
}

__device__ __forceinline__ void hy_filter_gen(Frame& F, int c0, c32* FSP) {
    const bf16* A2 = (const bf16*)(F.ws + WS_A2); const bf16* W3T = (const bf16*)(F.ws + WS_W3T);
    int lane = F.lane; asm volatile("" : "+v"(lane));
    const int fr = lane & 15, fq = lane >> 4;
    const int chl = fr >> 2, o = (fr >> 1) & 1, dir = fr & 1, col = dir * 2048 + o * 1024 + c0 + chl;
    const bf16x8 b0 = *(const GAS bf16x8*)(W3T + (size_t)col * 64 + fq * 8), b1 = *(const GAS bf16x8*)(W3T + (size_t)col * 64 + 32 + fq * 8);
    const float delta = 3.0701134573253944f + (float)(c0 + chl) * (12.280453829301579f / 1023.0f);
    const float kdec = -delta * 1.4426950408889634f / (float)(SEQ - 1);
    c32* zk = FSP + (size_t)(chl * 2 + o) * 8192;
#pragma unroll 4
    for (int i = 0; i < 64; ++i) {
        const int tile = F.wave + 8 * i, t0 = tile * 16;
        const bf16x8 a0 = *(const GAS bf16x8*)(A2 + (size_t)(t0 + fr) * 64 + fq * 8), a1 = *(const GAS bf16x8*)(A2 + (size_t)(t0 + fr) * 64 + 32 + fq * 8);
        f32x4 acc = (f32x4){0.f, 0.f, 0.f, 0.f};
        acc = __builtin_amdgcn_mfma_f32_16x16x32_bf16(a0, b0, acc, 0, 0, 0);
        acc = __builtin_amdgcn_mfma_f32_16x16x32_bf16(a1, b1, acc, 0, 0, 0);
        const int tb = t0 + 4 * fq;
#pragma unroll
        for (int r = 0; r < 4; ++r) acc[r] *= __builtin_amdgcn_exp2f(kdec * (float)(tb + r));
        const float nb = shfl_down1_l(acc[0], lane);
        if (tile == 0 && fq == 0 && dir == 0) acc[0] += nb;
        hy_pack_store(zk, dir, tb, acc[0], acc[1], acc[2], acc[3]);
    }
}
__device__ __forceinline__ void hyena_block(Frame& F, int l, int blk) {
    LAS c32* A = (LAS c32*)(F.lds); LAS c32* B = A + HY_LDS_C32;
    c32* FSP = (c32*)(F.ws + WS_FS) + (size_t)blk * 8 * 8192;
    const unsigned* ZT = (const unsigned*)(F.ws + WS_ZT); bf16* Y = (bf16*)(F.ws + WS_Y);
    const float* cw = F.in[I_CONVW] + (size_t)l * 3 * NHY; const float* cb = F.in[I_CONVB] + (size_t)l * NHY; const float* skp = F.in[I_SKIP] + (size_t)l * 2 * HYW;
    const int c0 = blk * 4, tid = F.tid;
    __syncthreads();
    HPS(20); hy_filter_gen(F, c0, FSP);
    VM_WAIT(); __syncthreads(); HPE(20); HPS(21);
#pragma unroll 1
    for (int chl = 0; chl < 4; ++chl) {
        const int c = c0 + chl; const c32* zk = FSP + (size_t)chl * 2 * 8192;
        c32 keep[8];
        c32 s[16];
        hy_filter_s1(tid, B, zk);
        hy_conv3_load(tid, ZT + (size_t)(2048 + c) * (SEQ / 2), cw[2048 + c], cw[NHY + 2048 + c], cw[2 * NHY + 2048 + c], cb[2048 + c], keep);
        hy_data_s1(tid, A, keep);
#pragma unroll 1
        for (int ord = 0; ord < 2; ++ord) {
            __syncthreads();
            HPS(22); fft_s2_fwd(tid, A); fft_s2_fwd(tid, B);
            __syncthreads(); HPE(22); HPS(23);
            fft_s3_read<-1>(tid, A, s); fft_s3_write(tid, A, s);
            fft_s3_read<-1>(tid, B, s); fft_s3_write(tid, B, s);
            __syncthreads(); HPE(23); HPS(24);
            pair_pass(tid, A, B);
            __syncthreads(); HPE(24); HPS(25);
            fft_s3_read<1>(tid, A, s); fft_s3_write(tid, A, s);
            __syncthreads();
            fft_s2_inv(tid, A);
            __syncthreads();
            fft_s1_inv(tid, A, s); HPE(25); HPS(26);
            if (ord == 0) {
                c32 x1[8];
                hy_conv3_load(tid, ZT + (size_t)c * (SEQ / 2), cw[c], cw[NHY + c], cw[2 * NHY + c], cb[c], x1);
                const float sk0 = skp[c];
#pragma unroll
                for (int q = 0; q < 8; ++q) keep[q] = x1[q] * (s[q] + keep[q] * sk0);
                hy_filter_s1(tid, B, zk + 8192);
                hy_data_s1(tid, A, keep);
            } else {
                c32 x2[8];
                hy_conv3_load(tid, ZT + (size_t)(1024 + c) * (SEQ / 2), cw[1024 + c], cw[NHY + 1024 + c], cw[2 * NHY + 1024 + c], cb[1024 + c], x2);
                const float sk1 = skp[HYW + c];
#pragma unroll
                for (int q = 0; q < 8; ++q) { const int m = tid + 512 * q; const c32 y = x2[q] * (s[q] + keep[q] * sk1);
                    Y[(size_t)(2 * m) * DM + c] = (bf16)f2bf(y.x);
                    Y[(size_t)(2 * m + 1) * DM + c] = (bf16)f2bf(y.y); }
            }
            HPE(26);
        }
        __syncthreads();
    }
    HPE(21);
}

__device__ __forceinline__ void route_block(Frame& F, int l, int tb  ) {
    LAS int* lcnt = (LAS int*)(F.lds);
    LAS int* lbase = (LAS int*)(F.lds + 64);
    LAS int* le = (LAS int*)(F.lds + 128);
    LAS int* lp = (LAS int*)(F.lds + 128 + 256);
    LAS float* lw = (LAS float*)(F.lds + 128 + 512);
    const float* XR = (const float*)(F.ws + WS_XR); bf16* H = (bf16*)(F.ws + WS_XN); const float* WR = (const float*)(F.ws + WS_WR);
    const float* g = F.in[I_GFFN] + (size_t)l * DM; const float* brg = F.in[I_BRG] + l * 4; const float* bre = F.in[I_BRE] + l * 16;
    int* TOKLIST = (int*)(F.ws + WS_LISTS); float* WLIST = (float*)(F.ws + WS_LISTS + 512 * 1024); int* TOKPOS = (int*)(F.ws + WS_LISTS + 1 * MiB);
    gu32* gcnt = F.ctl + CW_CNT + 64 * l;
    __syncthreads();
    if (F.tid < 16) lcnt[F.tid] = 0;
    __syncthreads();
    const int ts = F.tid >> 4, part = F.tid & 15, tok = tb + ts;
    const float* xrow = XR + (size_t)tok * DM;
    LAS float* WRc = (LAS float*)(F.lds + 2048);
    LAS float* Xc = WRc + 20 * 512;
    LAS float* Gc = Xc + 32 * 512;
    float acc[20], ss = 0.f;
#pragma unroll
    for (int o = 0; o < 20; ++o) acc[o] = 0.f;
#pragma unroll 1
    for (int c = 0; c < 4; ++c) {
        __syncthreads();
#pragma unroll
        for (int i = 0; i < 5; ++i) { const int idx = F.tid + NTHR * i, o = idx >> 7, k4 = idx & 127; *(LAS f32x4*)(WRc + o * 512 + 4 * k4) = *(const GAS f32x4*)(WR + (size_t)o * DM + 512 * c + 4 * k4); }
#pragma unroll
        for (int i = 0; i < 8; ++i) { const int idx = F.tid + NTHR * i, r = idx >> 7, k4 = idx & 127; *(LAS f32x4*)(Xc + r * 512 + 4 * k4) = *(const GAS f32x4*)(XR + (size_t)(tb + r) * DM + 512 * c + 4 * k4); }
        if (F.tid < 128) *(LAS f32x4*)(Gc + 4 * F.tid) = *(const GAS f32x4*)(g + 512 * c + 4 * F.tid);
        __syncthreads();
#pragma unroll 1
        for (int i = 0; i < 8; ++i) { const int ko = 4 * (part + 16 * i);
            const f32x4 x = *(const LAS f32x4*)(Xc + ts * 512 + ko); const f32x4 gg = *(const LAS f32x4*)(Gc + ko); const f32x4 xg = x * gg;
            ss += (x.x * x.x + x.y * x.y) + (x.z * x.z + x.w * x.w);
#pragma unroll
            for (int o = 0; o < 20; ++o) { const f32x4 w = *(const LAS f32x4*)(WRc + o * 512 + ko); acc[o] += (xg.x * w.x + xg.y * w.y) + (xg.z * w.z + xg.w * w.w); } }
    }
#pragma unroll
    for (int sh = 1; sh < 16; sh <<= 1) { ss += shfl_xor_l(ss, sh, F.lane);
#pragma unroll
        for (int o = 0; o < 20; ++o) acc[o] += shfl_xor_l(acc[o], sh, F.lane); }
    const float rstd = 1.0f / sqrtf(ss * (1.0f / DM) + EPS);
    {
        float lg0 = acc[0] * rstd + brg[0], lg1 = acc[1] * rstd + brg[1], lg2 = acc[2] * rstd + brg[2], lg3 = acc[3] * rstd + brg[3];
        int grp = 0; float mx = lg0;
        if (lg1 > mx) { mx = lg1; grp = 1; } if (lg2 > mx) { mx = lg2; grp = 2; } if (lg3 > mx) { mx = lg3; grp = 3; }
        const float den = (__expf(lg0 - mx) + __expf(lg1 - mx)) + (__expf(lg2 - mx) + __expf(lg3 - mx));
        const float psel = 1.0f / den;
        const float m0 = (grp == 0) ? 1.f : 0.f, m1 = (grp == 1) ? 1.f : 0.f, m2 = (grp == 2) ? 1.f : 0.f, m3 = (grp == 3) ? 1.f : 0.f;
        float e0v = (m0 * acc[4] + m1 * acc[8]) + (m2 * acc[12] + m3 * acc[16]), e1v = (m0 * acc[5] + m1 * acc[9]) + (m2 * acc[13] + m3 * acc[17]);
        float e2v = (m0 * acc[6] + m1 * acc[10]) + (m2 * acc[14] + m3 * acc[18]), e3v = (m0 * acc[7] + m1 * acc[11]) + (m2 * acc[15] + m3 * acc[19]);
        e0v = e0v * rstd + bre[grp * 4 + 0]; e1v = e1v * rstd + bre[grp * 4 + 1]; e2v = e2v * rstd + bre[grp * 4 + 2]; e3v = e3v * rstd + bre[grp * 4 + 3];
        int i0 = 0; float v0 = e0v;
        if (e1v > v0) { v0 = e1v; i0 = 1; } if (e2v > v0) { v0 = e2v; i0 = 2; } if (e3v > v0) { v0 = e3v; i0 = 3; }
        int i1 = -1; float v1 = -3.0e38f;
        if (i0 != 0 && e0v > v1) { v1 = e0v; i1 = 0; } if (i0 != 1 && e1v > v1) { v1 = e1v; i1 = 1; } if (i0 != 2 && e2v > v1) { v1 = e2v; i1 = 2; } if (i0 != 3 && e3v > v1) { v1 = e3v; i1 = 3; }
        const float ex = __expf(v1 - v0); const float w0 = psel / (1.0f + ex), w1 = psel * ex / (1.0f + ex);
        if (part == 0) { const int ea = grp * 4 + i0, eb = grp * 4 + i1;
            le[ts * 2] = ea; le[ts * 2 + 1] = eb; lw[ts * 2] = w0; lw[ts * 2 + 1] = w1;
            lp[ts * 2] = __hip_atomic_fetch_add(lcnt + ea, 1, __ATOMIC_RELAXED, __HIP_MEMORY_SCOPE_WORKGROUP); lp[ts * 2 + 1] = __hip_atomic_fetch_add(lcnt + eb, 1, __ATOMIC_RELAXED, __HIP_MEMORY_SCOPE_WORKGROUP); }
    }
#pragma unroll 4
    for (int i = 0; i < 32; ++i) { const int k = 4 * (part + 16 * i); const f32x4 x = *(const GAS f32x4*)(xrow + k); const f32x4 gg = *(const GAS f32x4*)(g + k);
        const f32x4 r = x * rstd * gg; v2u w; w.x = pk2(r.x, r.y); w.y = pk2(r.z, r.w); *(GAS v2u*)(H + (size_t)tok * DM + k) = w; }
    __syncthreads();
    if (F.tid < 16) lbase[F.tid] = (int)__hip_atomic_fetch_add(gcnt + F.tid, (unsigned)lcnt[F.tid], RLX_AGENT);
    __syncthreads();
    if (F.tid < 64) { const int t2 = F.tid >> 1; const int e = le[F.tid], pos = lbase[e] + lp[F.tid];
        TOKLIST[e * SEQ + pos] = tb + t2; WLIST[e * SEQ + pos] = lw[F.tid]; TOKPOS[(tb + t2) * 2 + (F.tid & 1)] = (e << 13) | pos; }
}
using pg8::Unit; using pg8::f32x2; using pg8::u32x4; using pg8::cvt_pk_bf16; using pg8::gelu_pk; using pg8::sigmoid_f;
__device__ __forceinline__ void tile_of(int idx, int nM, int nN, int& pm, int& pn) {
    const int nig = 8 * nN, gid = idx / nig, fm = gid * 8, gsz = (nM - fm) < 8 ? (nM - fm) : 8;
    pm = fm + ((idx % nig) % gsz); pn = (idx % nig) / gsz;
}
__device__ __forceinline__ int xcd_remap(int L, int nwg) { const int q = nwg / 8, r = nwg % 8, xcd = L % 8, off = L / 8; return (xcd < r ? xcd * (q + 1) : r * (q + 1) + (xcd - r) * q) + off; }

struct InProjSched {
    static constexpr bool GATHER = false;
    const char* XN; const char* WIN; int G, c;
    __device__ __forceinline__ bool next(int i, Unit& u) const {
        const int L = i * G + c; if (L >= 1152) return false;
        const int w = xcd_remap(L, 1152);
        if (w < 384) { u.kind = 0; tile_of(w, 12, 32, u.pm, u.pn); } else { u.kind = 1; tile_of(w - 384, 32, 24, u.pm, u.pn); }
        u.e = 0; u.row0 = 0; u.nvalid = 256; return true;
    }
    __device__ __forceinline__ const char* a_base(const Unit& u) const { return (u.kind == 0 ? WIN : XN) + (size_t)u.pm * (256 * DM * 2); }
    __device__ __forceinline__ const char* b_base(const Unit& u) const { return (u.kind == 0 ? XN : WIN + (size_t)NHY * DM * 2) + (size_t)u.pn * (256 * DM * 2); }
    __device__ __forceinline__ unsigned a_goff(const Unit&, int) const { return 0u; }
};
struct EpiInProj {
    static constexpr bool PERM = true, MIDK = false;
    bf16 *ZT, *U; const float* bin;
    __device__ __forceinline__ void operator()(const f32x4 (&acc)[2][2][4][2], const Unit& u, int wr, int wc, int fr, int fq) const {
        if (u.kind == 0) {
            const int row0 = u.pm * 256 + wr * 64 + fr, col0 = u.pn * 256 + wc * 32 + 8 * fq;
#pragma unroll
            for (int ai = 0; ai < 2; ++ai)
#pragma unroll
                for (int m = 0; m < 4; ++m) { const int row = row0 + ai * 128 + m * 16; const float b = bin[row]; bf16* rowp = ZT + (size_t)row * SEQ + col0;
#pragma unroll
                    for (int bj = 0; bj < 2; ++bj) { const f32x4 v0 = acc[ai][bj][m][0] + b, v1 = acc[ai][bj][m][1] + b;
                        u32x4 w; w.x = cvt_pk_bf16(v0[0], v0[1]); w.y = cvt_pk_bf16(v0[2], v0[3]); w.z = cvt_pk_bf16(v1[0], v1[1]); w.w = cvt_pk_bf16(v1[2], v1[3]);
                        *(u32x4*)(rowp + bj * 128) = w; } }
        } else {
            const int seg = (u.pn < 4) ? 0 : (u.pn < 8) ? 1 : (u.pn < 16) ? 2 : 3;
            const size_t boff = (seg == 0) ? 0 : (seg == 1) ? (WS_GV - WS_U) : (seg == 2) ? (WS_GH - WS_U) : (WS_GS - WS_U);
            bf16* base = (bf16*)((char*)U + boff);
            const int ldc = (seg < 2) ? 1024 : 2048, colt = (seg == 0) ? u.pn * 256 : (seg == 1) ? (u.pn - 4) * 256 : (seg == 2) ? (u.pn - 8) * 256 : (u.pn - 16) * 256;
            const int row0 = u.pm * 256 + wr * 64 + fr, col0 = colt + wc * 32 + 8 * fq, bcol0 = NHY + u.pn * 256 + wc * 32 + 8 * fq;
            f32x4 bv[2][2];
#pragma unroll
            for (int bj = 0; bj < 2; ++bj)
#pragma unroll
                for (int n = 0; n < 2; ++n) bv[bj][n] = *(const f32x4*)(bin + bcol0 + bj * 128 + 4 * n);
#pragma unroll
            for (int ai = 0; ai < 2; ++ai)
#pragma unroll
                for (int m = 0; m < 4; ++m) { bf16* rowp = base + (size_t)(row0 + ai * 128 + m * 16) * ldc + col0;
#pragma unroll
                    for (int bj = 0; bj < 2; ++bj) { f32x4 v0 = acc[ai][bj][m][0] + bv[bj][0], v1 = acc[ai][bj][m][1] + bv[bj][1];
                        if (seg < 2) { const f32x2 a = gelu_pk((f32x2){v0[0], v0[1]}), b = gelu_pk((f32x2){v0[2], v0[3]}), c = gelu_pk((f32x2){v1[0], v1[1]}), d = gelu_pk((f32x2){v1[2], v1[3]});
                            v0 = (f32x4){a.x, a.y, b.x, b.y}; v1 = (f32x4){c.x, c.y, d.x, d.y}; }
                        else {
#pragma unroll
                            for (int j = 0; j < 4; ++j) { v0[j] = sigmoid_f(v0[j]); v1[j] = sigmoid_f(v1[j]); } }
                        u32x4 w; w.x = cvt_pk_bf16(v0[0], v0[1]); w.y = cvt_pk_bf16(v0[2], v0[3]); w.z = cvt_pk_bf16(v1[0], v1[1]); w.w = cvt_pk_bf16(v1[2], v1[3]);
                        *(u32x4*)(rowp + bj * 128) = w; } }
        }
    }
    __device__ __forceinline__ void mid(f32x4 (&)[2][2][4][2], const Unit&, int, int, int, int) const {}
};
struct GridSched {
    static constexpr bool GATHER = false;
    const char* A; const char* Bt; int nM, nN, K, G, c;
    __device__ __forceinline__ bool next(int i, Unit& u) const {
        const int L = i * G + c, nwg = nM * nN; if (L >= nwg) return false;
        tile_of(xcd_remap(L, nwg), nM, nN, u.pm, u.pn); u.kind = 0; u.e = 0; u.row0 = 0; u.nvalid = 256; return true;
    }
    __device__ __forceinline__ const char* a_base(const Unit& u) const { return A + (size_t)u.pm * 512 * K; }
    __device__ __forceinline__ const char* b_base(const Unit& u) const { return Bt + (size_t)u.pn * 512 * K; }
    __device__ __forceinline__ unsigned a_goff(const Unit&, int) const { return 0u; }
};
struct EpiMerge {
    static constexpr bool PERM = true, MIDK = true;
    const bf16 *GH, *GS; bf16* O;
    __device__ __forceinline__ void mid(f32x4 (&acc)[2][2][4][2], const Unit& u, int wr, int wc, int fr, int fq) const {
        asm volatile("" : "+v"(fr), "+v"(fq));
        const int row0 = u.pm * 256 + wr * 64 + fr, col0 = u.pn * 256 + wc * 32 + 8 * fq;
#pragma unroll
        for (int ai = 0; ai < 2; ++ai)
#pragma unroll
            for (int m = 0; m < 4; ++m) { const size_t off = (size_t)(row0 + ai * 128 + m * 16) * DM + col0;
#pragma unroll
                for (int bj = 0; bj < 2; ++bj) { const u32x4 h = *(const u32x4*)(GH + off + bj * 128), s = *(const u32x4*)(GS + off + bj * 128);
                    const unsigned hh[4] = {h.x, h.y, h.z, h.w}, sv[4] = {s.x, s.y, s.z, s.w};
#pragma unroll
                    for (int j = 0; j < 4; ++j) { const float r0 = bfl(hh[j]) * __builtin_amdgcn_rcpf(bfl(sv[j])), r1 = bfh(hh[j]) * __builtin_amdgcn_rcpf(bfh(sv[j]));
                        acc[ai][bj][m][j >> 1][(j & 1) * 2] *= r0; acc[ai][bj][m][j >> 1][(j & 1) * 2 + 1] *= r1; } }
                asm volatile("" : "+v"(acc[ai][0][m][0]), "+v"(acc[ai][0][m][1]), "+v"(acc[ai][1][m][0]), "+v"(acc[ai][1][m][1]));
                asm volatile("" ::: "memory"); }
    }
    __device__ __forceinline__ void operator()(const f32x4 (&acc)[2][2][4][2], const Unit& u, int wr, int wc, int fr, int fq) const {
        const int row0 = u.pm * 256 + wr * 64 + fr, col0 = u.pn * 256 + wc * 32 + 8 * fq;
#pragma unroll
        for (int ai = 0; ai < 2; ++ai)
#pragma unroll
            for (int m = 0; m < 4; ++m) { const size_t off = (size_t)(row0 + ai * 128 + m * 16) * DM + col0;
#pragma unroll
                for (int bj = 0; bj < 2; ++bj) { const u32x4 s = *(const u32x4*)(GS + off + bj * 128); const unsigned sv[4] = {s.x, s.y, s.z, s.w};
                    const f32x4 v0 = acc[ai][bj][m][0], v1 = acc[ai][bj][m][1];
                    u32x4 w; w.x = cvt_pk_bf16(v0[0] * bfl(sv[0]), v0[1] * bfh(sv[0])); w.y = cvt_pk_bf16(v0[2] * bfl(sv[1]), v0[3] * bfh(sv[1]));
                    w.z = cvt_pk_bf16(v1[0] * bfl(sv[2]), v1[1] * bfh(sv[2])); w.w = cvt_pk_bf16(v1[2] * bfl(sv[3]), v1[3] * bfh(sv[3]));
                    *(u32x4*)(O + off + bj * 128) = w; }
                asm volatile("" ::: "memory"); }
    }
};
struct EpiResid {
    static constexpr bool PERM = false, MIDK = false;
    const float* base; float* out;
    __device__ __forceinline__ void operator()(const f32x4 (&acc)[2][2][4][2], const Unit& u, int wr, int wc, int fr, int fq) const {
        const int row0 = u.pm * 256 + wr * 64 + fr, col0 = u.pn * 256 + wc * 32 + 4 * fq;
#pragma unroll
        for (int ai = 0; ai < 2; ++ai)
#pragma unroll
            for (int m = 0; m < 4; ++m) { const size_t off = (size_t)(row0 + ai * 128 + m * 16) * DM + col0;
#pragma unroll
                for (int bj = 0; bj < 2; ++bj)
#pragma unroll
                    for (int n = 0; n < 2; ++n) { const f32x4 b = *(const f32x4*)(base + off + bj * 128 + n * 16); *(f32x4*)(out + off + bj * 128 + n * 16) = b + acc[ai][bj][m][n]; } }
    }
    __device__ __forceinline__ void mid(f32x4 (&)[2][2][4][2], const Unit&, int, int, int, int) const {}
};
struct MoeSched1 {
    static constexpr bool GATHER = true;
    const LAS int* tab; const char* H; const char* W; const int* toklist; int G, c;
    __device__ __forceinline__ bool next(int i, Unit& u) const {
        const int L = i * G + c; const int total = __builtin_amdgcn_readfirstlane(tab[16]) * 4; if (L >= total) return false;
        const int rt = L >> 2; int e = 0;
#pragma unroll
        for (int j = 1; j < 16; ++j) e += (__builtin_amdgcn_readfirstlane(tab[j]) <= rt) ? 1 : 0;
        const int j0 = rt - __builtin_amdgcn_readfirstlane(tab[e]);
        u.pm = j0; u.pn = L & 3; u.kind = 0; u.e = e; u.row0 = __builtin_amdgcn_readfirstlane(tab[17 + e]) + 256 * j0;
        const int rem = __builtin_amdgcn_readfirstlane(tab[34 + e]) - 256 * j0; u.nvalid = rem < 256 ? rem : 256; return true;
    }
    __device__ __forceinline__ const char* a_base(const Unit&) const { return H; }
    __device__ __forceinline__ const char* b_base(const Unit& u) const { return W + ((size_t)u.e * 1024 + (size_t)u.pn * 256) * DM * 2; }
    __device__ __forceinline__ unsigned a_goff(const Unit& u, int r) const { const int tok = (r < u.nvalid) ? toklist[u.e * SEQ + u.pm * 256 + r] : 0; return (unsigned)tok * (unsigned)(DM * 2); }
};
struct EpiMoe1 {
    static constexpr bool PERM = true, MIDK = false;
    bf16* ACT; const float* wlist;
    __device__ __forceinline__ void operator()(const f32x4 (&acc)[2][2][4][2], const Unit& u, int wr, int wc, int fr, int fq) const {
        const int col0 = u.pn * 128 + wc * 32 + 8 * fq;
#pragma unroll
        for (int ai = 0; ai < 2; ++ai)
#pragma unroll
            for (int m = 0; m < 4; ++m) { const int rl = ai * 128 + wr * 64 + m * 16 + fr;
                if (rl < u.nvalid) { const float wt = wlist[u.e * SEQ + u.pm * 256 + rl];
                    const f32x4 g0 = acc[ai][0][m][0], g1 = acc[ai][0][m][1], u0 = acc[ai][1][m][0], u1 = acc[ai][1][m][1];
                    float o[8];
#pragma unroll
                    for (int j = 0; j < 4; ++j) { o[j] = g0[j] * sigmoid_f(g0[j]) * u0[j] * wt; o[4 + j] = g1[j] * sigmoid_f(g1[j]) * u1[j] * wt; }
                    u32x4 w; w.x = cvt_pk_bf16(o[0], o[1]); w.y = cvt_pk_bf16(o[2], o[3]); w.z = cvt_pk_bf16(o[4], o[5]); w.w = cvt_pk_bf16(o[6], o[7]);
                    *(u32x4*)(ACT + (size_t)(u.row0 + rl) * DEXP + col0) = w; } }
    }
    __device__ __forceinline__ void mid(f32x4 (&)[2][2][4][2], const Unit&, int, int, int, int) const {}
};
struct MoeSched2 {
    static constexpr bool GATHER = false;
    const LAS int* tab; const char* ACT; const char* W; int G, c;
    __device__ __forceinline__ bool next(int i, Unit& u) const {
        const int L = i * G + c; const int total = __builtin_amdgcn_readfirstlane(tab[16]) * 8; if (L >= total) return false;
        const int rt = L >> 3; int e = 0;
#pragma unroll
        for (int j = 1; j < 16; ++j) e += (__builtin_amdgcn_readfirstlane(tab[j]) <= rt) ? 1 : 0;
        const int j0 = rt - __builtin_amdgcn_readfirstlane(tab[e]);
        u.pm = j0; u.pn = L & 7; u.kind = 0; u.e = e; u.row0 = __builtin_amdgcn_readfirstlane(tab[17 + e]) + 256 * j0;
        const int rem = __builtin_amdgcn_readfirstlane(tab[34 + e]) - 256 * j0; u.nvalid = rem < 256 ? rem : 256; return true;
    }
    __device__ __forceinline__ const char* a_base(const Unit& u) const { return ACT + (size_t)u.row0 * DEXP * 2; }
    __device__ __forceinline__ const char* b_base(const Unit& u) const { return W + ((size_t)u.e * DM + (size_t)u.pn * 256) * DEXP * 2; }
    __device__ __forceinline__ unsigned a_goff(const Unit&, int) const { return 0u; }
};
struct EpiMoe2 {
    static constexpr bool PERM = true, MIDK = false;
    bf16* MO;
    __device__ __forceinline__ void operator()(const f32x4 (&acc)[2][2][4][2], const Unit& u, int wr, int wc, int fr, int fq) const {
        const int col0 = u.pn * 256 + wc * 32 + 8 * fq;
#pragma unroll
        for (int ai = 0; ai < 2; ++ai)
#pragma unroll
            for (int m = 0; m < 4; ++m) { const int rl = ai * 128 + wr * 64 + m * 16 + fr;
                if (rl < u.nvalid) { bf16* rowp = MO + (size_t)(u.row0 + rl) * DM + col0;
#pragma unroll
                    for (int bj = 0; bj < 2; ++bj) { const f32x4 v0 = acc[ai][bj][m][0], v1 = acc[ai][bj][m][1];
                        u32x4 w; w.x = cvt_pk_bf16(v0[0], v0[1]); w.y = cvt_pk_bf16(v0[2], v0[3]); w.z = cvt_pk_bf16(v1[0], v1[1]); w.w = cvt_pk_bf16(v1[2], v1[3]);
                        *(u32x4*)(rowp + bj * 128) = w; } } }
    }
    __device__ __forceinline__ void mid(f32x4 (&)[2][2][4][2], const Unit&, int, int, int, int) const {}
};
__device__ __forceinline__ void moe_tables(Frame& F, int l) {
    LAS int* tab = (LAS int*)(F.lds + MISC_OFF + 128);
    __syncthreads();
    if (F.tid == 0) { int tp = 0, off = 0;
        for (int e = 0; e < 16; ++e) { const int c = (int)__hip_atomic_load(F.ctl + CW_CNT + 64 * l + e, RLX_AGENT); tab[e] = tp; tab[17 + e] = off; tab[34 + e] = c; tp += (c + 255) >> 8; off += c; }
        tab[16] = tp; tab[33] = off; }
    __syncthreads();
}

struct Args { const float* in[29]; float* out; unsigned char* ws; int ph_lo, ph_hi; };
constexpr int NPHASE = 17;
__global__ void __launch_bounds__(NTHR, 2) fwd_kernel(Args args) {
    extern __shared__ __attribute__((aligned(16))) unsigned char lds[];
    Frame F;
    F.lds = (LAS unsigned char*)lds;
    F.MISC = (volatile LAS unsigned*)(F.lds + MISC_OFF);
    F.tid = threadIdx.x; F.lane = F.tid & 63; F.wave = __builtin_amdgcn_readfirstlane(F.tid >> 6);
    F.G = gridDim.x; { const int bx = blockIdx.x; F.vcu = (F.G % 8 == 0) ? (bx % 8) * (F.G / 8) + bx / 8 : bx; }
    F.ws = args.ws; F.out = args.out; F.ctl = (gu32*)(args.ws + WS_CTL);
#pragma unroll
    for (int i = 0; i < 29; ++i) F.in[i] = args.in[i];
    for (int u = F.tid; u < 256; u += NTHR) ((LAS unsigned*)(F.lds + MISC_OFF))[u] = 0u;
    __syncthreads();
    const int lo = args.ph_lo, hi = args.ph_hi;
    const bool multi = (hi - lo) > 1;
    XcdBarrier bar; bar.bar = (unsigned*)(F.ctl + CW_BAR); bar.x = 0; bar.st = nullptr;
    if (multi) bar = xcd_barrier_post((unsigned*)(F.ctl + CW_BAR), F.MISC + 8);
#ifndef PHASE_MASK
#define PHASE_MASK 0x7ff
#endif
#define IN(k) (lo <= (k) && (k) < hi)
#define ON(j) ((PHASE_MASK >> (j)) & 1)
#ifndef DUP_MASK
#define DUP_MASK 0
#endif
#define REP(j) for (int _rep = 0; _rep < (((DUP_MASK >> (j)) & 1) ? 2 : 1); ++_rep)
#define LAUNDER() do { int _l; asm volatile("v_mbcnt_lo_u32_b32 %0, -1, 0\n\tv_mbcnt_hi_u32_b32 %0, -1, %0" : "=v"(_l)); F.lane = _l; F.tid = F.wave * 64 + _l; } while (0)
#ifndef PROBE_K
#define PROBE_K -1
#endif
#ifndef PROBE_PART
#define PROBE_PART 0
#endif
#ifndef PROBE_AMP
#define PROBE_AMP 8
#endif
    volatile LAS unsigned long long* pr = (volatile LAS unsigned long long*)(F.lds + MISC_OFF + 512);
#define PR_ME (blockIdx.x == 0 && threadIdx.x == 0)
#define PSTART(j) do { if (PROBE_K == (j) && PROBE_PART != 1 && PR_ME) pr[0] = __builtin_amdgcn_s_memrealtime(); } while (0)
#define PEND(j) do { if (PROBE_K == (j) && PR_ME) { const unsigned long long _n = __builtin_amdgcn_s_memrealtime(); if (PROBE_PART == 0 || (PROBE_PART == 2 && (j) == 8)) pr[1] += _n - pr[0]; else if (PROBE_PART == 1) pr[0] = _n; } } while (0)
#define PBAR(j) do { if (PROBE_K == (j) && PROBE_PART >= 1 && PR_ME) pr[1] += __builtin_amdgcn_s_memrealtime() - pr[0]; } while (0)
#define SEAM(k) do { if (IN(k) && IN((k) + 1)) xcd_barrier(bar); } while (0)
    const int gw = F.vcu * NWAVES + F.wave, NGW = F.G * NWAVES;
    for (int l = 0; l < DEPTH; ++l) {
        const int p0 = l * 8;
        if (ON(0) && IN(p0 + 0)) { LAUNDER(); PSTART(0);
            PSTART(10); REP(0) pa_convert(F, l); PEND(10);
            PSTART(11); pa_features(F, l); PEND(11);
            PSTART(12); pa_router_t(F, l); PEND(12);
            PSTART(13);
            const float* g = F.in[I_GMIX] + (size_t)l * DM;
            if (l == 0) { for (int m = gw; m < SEQ; m += NGW) norm_row<0, false>(F, m, F.in[I_X], g, nullptr, nullptr); }
            else { for (int m = gw; m < SEQ; m += NGW) norm_row<1, false>(F, m, nullptr, g, F.ctl + CW_CNT + 64 * (l - 1), nullptr); }
            PEND(13);
        }
        PEND(0); SEAM(p0 + 0); PBAR(0);
        if (ON(1) && IN(p0 + 1)) { LAUNDER(); PSTART(1);
            InProjSched S{(const char*)(F.ws + WS_XN), (const char*)(F.ws + WS_WIN), F.G, (int)blockIdx.x};
            EpiInProj E{(bf16*)(F.ws + WS_ZT), (bf16*)(F.ws + WS_U), F.in[I_BIN] + (size_t)l * NIN};
            REP(1) pg8::gemm_phase<EpiInProj, InProjSched>(F.lds, DM, S, E, F.tid);
        }
        PEND(1); SEAM(p0 + 1); PBAR(1);
        if (ON(2) && IN(p0 + 2)) { LAUNDER(); PSTART(2);
            if (ON(9)) REP(9) for (int u = F.vcu; u < 512; u += F.G) sgu_unit(F, l, u >> 3, u & 7);
            if (ON(10)) REP(10) for (int b = F.vcu; b < 256; b += F.G) hyena_block(F, l, b);
        }
        PEND(2); SEAM(p0 + 2); PBAR(2);
        if (ON(3) && IN(p0 + 3)) { LAUNDER(); PSTART(3);
            GridSched S{(const char*)(F.ws + WS_Y), (const char*)(F.ws + WS_PT), 32, 8, DM, F.G, (int)blockIdx.x};
            EpiMerge E{(const bf16*)(F.ws + WS_GH), (const bf16*)(F.ws + WS_GS), (bf16*)(F.ws + WS_MERGED)};
            REP(3) pg8::gemm_phase<EpiMerge, GridSched>(F.lds, DM, S, E, F.tid);
        }
        PEND(3); SEAM(p0 + 3); PBAR(3);
        if (ON(4) && IN(p0 + 4)) { LAUNDER(); PSTART(4);
            GridSched S{(const char*)(F.ws + WS_MERGED), (const char*)(F.ws + WS_WOT), 32, 8, DM, F.G, (int)blockIdx.x};
            EpiResid E{l == 0 ? F.in[I_X] : (const float*)(F.ws + WS_XR), (float*)(F.ws + WS_XR)};
            pg8::gemm_phase<EpiResid, GridSched>(F.lds, DM, S, E, F.tid);
        }
        PEND(4); SEAM(p0 + 4); PBAR(4);
        if (ON(5) && IN(p0 + 5)) { LAUNDER(); PSTART(5); for (int tb = F.vcu * 32; tb < SEQ; tb += F.G * 32) route_block(F, l, tb); }
        PEND(5); SEAM(p0 + 5); PBAR(5);
        if (ON(6) && IN(p0 + 6)) { LAUNDER(); PSTART(6);
            moe_tables(F, l);
            MoeSched1 S{(const LAS int*)(F.lds + MISC_OFF + 128), (const char*)(F.ws + WS_XN), (const char*)(F.ws + WS_WGU), (const int*)(F.ws + WS_LISTS), F.G, F.vcu};
            EpiMoe1 E{(bf16*)(F.ws + WS_ACT), (const float*)(F.ws + WS_LISTS + 512 * 1024)};
            REP(6) pg8::gemm_phase<EpiMoe1, MoeSched1>(F.lds, DM, S, E, F.tid);
        }
        PEND(6); SEAM(p0 + 6); PBAR(6);
        if (ON(7) && IN(p0 + 7)) { LAUNDER(); PSTART(7);
            moe_tables(F, l);
            MoeSched2 S{(const LAS int*)(F.lds + MISC_OFF + 128), (const char*)(F.ws + WS_ACT), (const char*)(F.ws + WS_WD), F.G, F.vcu};
            EpiMoe2 E{(bf16*)(F.ws + WS_MOEOUT)};
            REP(7) pg8::gemm_phase<EpiMoe2, MoeSched2>(F.lds, DEXP, S, E, F.tid);
        }
        PEND(7); SEAM(p0 + 7); PBAR(7);
    }
    if (ON(8) && IN(16)) { LAUNDER(); PSTART(8); for (int m = gw; m < SEQ; m += NGW) norm_row<1, true>(F, m, nullptr, F.in[I_GFINAL], F.ctl + CW_CNT + 64 * (DEPTH - 1), F.out); }
    PEND(8);
    if (PROBE_K >= 0 && PR_ME) { const unsigned long long t0 = __builtin_amdgcn_s_memrealtime(), amt = pr[1] * PROBE_AMP; while (__builtin_amdgcn_s_memrealtime() - t0 < amt) __builtin_amdgcn_s_sleep(8); }
#undef IN
#undef SEAM
}

#ifndef MK_ONE_LAUNCH
#define MK_ONE_LAUNCH 0
#endif
extern "C" void kernel_launch(void* const* d_in, const int* in_sizes, int n_in, void* d_out, int out_size, void* d_ws, size_t ws_size, hipStream_t stream) {
    static int grid = 0;
    if (grid == 0) {
        if (n_in != 29 || ws_size < WS_END) { fprintf(stderr, "kernel_launch: unexpected n_in %d or ws %zu < %zu\n", n_in, ws_size, (size_t)WS_END); grid = -1; return; }
        int dev = 0, cus = 0, per_cu = 0;
        if (hipGetDevice(&dev) != hipSuccess || hipDeviceGetAttribute(&cus, hipDeviceAttributeMultiprocessorCount, dev) != hipSuccess) { grid = -1; return; }
        if (hipFuncSetAttribute((const void*)fwd_kernel, hipFuncAttributeMaxDynamicSharedMemorySize, LDS_BYTES) != hipSuccess) { fprintf(stderr, "kernel_launch: hipFuncSetAttribute failed\n"); grid = -1; return; }
        if (hipOccupancyMaxActiveBlocksPerMultiprocessor(&per_cu, (const void*)fwd_kernel, NTHR, LDS_BYTES) != hipSuccess || per_cu < 1) fprintf(stderr, "kernel_launch: occupancy query reports %d\n", per_cu);
        (void)hipGetLastError();
        grid = cus;
    }
    if (grid < 0) return;
    (void)hipMemsetAsync((char*)d_ws + WS_CTL, 0, CTL_ZERO_BYTES, stream);
    Args a{};
    for (int i = 0; i < 29; ++i) a.in[i] = (const float*)d_in[i];
    a.out = (float*)d_out; a.ws = (unsigned char*)d_ws;
#if MK_ONE_LAUNCH
    a.ph_lo = 0; a.ph_hi = NPHASE;
    hipLaunchKernelGGL(fwd_kernel, dim3(grid), dim3(NTHR), LDS_BYTES, stream, a);
#else
    for (int p = 0; p < NPHASE; ++p) { a.ph_lo = p; a.ph_hi = p + 1; hipLaunchKernelGGL(fwd_kernel, dim3(grid), dim3(NTHR), LDS_BYTES, stream, a); }
#endif
}
```

```cpp
#include <hip/hip_runtime.h>
#include <cstdio>
#include <cstdint>
#define MK_ONE_LAUNCH 1
#define DUP_MASK 0
#define PROBE_K -1
#define PROBE_PART 0
namespace pg8 {
#define PG8_LAS __attribute__((address_space(3)))
typedef unsigned short bf16_t;
typedef short bf16x8 __attribute__((ext_vector_type(8)));
typedef float f32x4 __attribute__((ext_vector_type(4)));
typedef float f32x2 __attribute__((ext_vector_type(2)));
typedef unsigned u32x4 __attribute__((ext_vector_type(4)));
typedef unsigned u32x2 __attribute__((ext_vector_type(2)));
constexpr int BM = 256, BK = 64, HALF = 128, HTB = HALF * BK * 2  , STAGE_BYTES = 8 * HTB;
constexpr int GATHER_SLOT_OFF = 2 * 8448 * 8 + 1024;

__host__ __device__ __forceinline__ int lds_byte(int r, int c) { const int st = (r >> 4) * 2 + (c >> 5), rr = r & 15, cc = c & 31, ob = rr * 64 + cc * 2; return st * 1024 + (ob ^ (((ob >> 9) & 1) << 5)); }
__host__ __device__ __forceinline__ void stage_rc(int b, int& R, int& C) { const int st = b / 1024, sb = b % 1024, swz = sb ^ (((sb >> 9) & 1) << 5); R = (st >> 1) * 16 + swz / 64; C = (st & 1) * 32 + (swz % 64) / 2; }
__host__ __device__ __forceinline__ int perm32(int rho) { const int n = rho >> 4, i = rho & 15; return 8 * (i >> 2) + 4 * n + (i & 3); }

struct Unit { int pm, pn, kind, e, row0, nvalid; };

__device__ __forceinline__ unsigned cvt_pk_bf16(float lo, float hi) { unsigned r; asm volatile("v_cvt_pk_bf16_f32 %0, %1, %2" : "=v"(r) : "v"(lo), "v"(hi)); return r; }
__device__ __forceinline__ f32x2 gelu_pk(f32x2 v) {
    const f32x2 av = __builtin_elementwise_abs(v), d = av * 0.2316418882f + 1.0f;
    f32x2 t; t.x = __builtin_amdgcn_rcpf(d.x); t.y = __builtin_amdgcn_rcpf(d.y);
    f32x2 q = t * 0.5307027145f + (-0.7265760135f); q = q * t + 0.7107068705f; q = q * t + (-0.142248368f); q = q * t + 0.127414796f; q = q * t;
    const f32x2 s = (v * v) * (-0.72134752044f);
    f32x2 e; e.x = __builtin_amdgcn_exp2f(s.x); e.y = __builtin_amdgcn_exp2f(s.y);
    const f32x2 m = v * (q * e), r = v - m;
    f32x2 o; o.x = v.x < 0.f ? m.x : r.x; o.y = v.y < 0.f ? m.y : r.y; return o;
}
__device__ __forceinline__ float sigmoid_f(float x) { return __builtin_amdgcn_rcpf(1.0f + __builtin_amdgcn_exp2f(-1.4426950408889634f * x)); }

template <class Epi, class Sched>
__device__ __forceinline__ void gemm_phase(PG8_LAS unsigned char* lds, const int K, const Sched& S, const Epi& E, int tid) {
    asm volatile("" : "+v"(tid));
    const int wid = __builtin_amdgcn_readfirstlane(tid >> 6), lane = tid & 63, wr = wid >> 2, wc = wid & 3, fr = lane & 15, fq = lane >> 4;
    const int nt = K / BK;
    unsigned voffA[2], voffB[2];
#pragma unroll
    for (int i = 0; i < 2; ++i) { int R, C; stage_rc(tid * 16 + i * 8192, R, C); const int Rb = Epi::PERM ? ((R & ~31) + perm32(R & 31)) : R;
        voffA[i] = Sched::GATHER ? 0u : (unsigned)(R * K + C) * 2u; voffB[i] = (unsigned)(Rb * K + C) * 2u; }
#define PG8_GOFF(u, h, i) ({ int _R, _C, _t = tid; asm volatile("" : "+v"(_t)); stage_rc(_t * 16 + (i) * 8192, _R, _C); S.a_goff((u), (h) * HALF + _R) + (unsigned)(_C * 2); })
    const size_t kstep = (size_t)(BK * 2);
    const size_t hstep = (size_t)HALF * K * 2;
    const unsigned ldsw = (unsigned)wid * 1024u;
    const int aoff = lds_byte(wr * 64 + fr, fq * 8), boff = lds_byte(wc * 32 + fr, fq * 8);
#define PG8_SA(b, h) (((b) * 2 + (h)) * HTB)
#define PG8_SB(b, h) ((4 + (b) * 2 + (h)) * HTB)
#define PG8_STAGE(bufoff, gbase, voff) do { _Pragma("unroll") for (int _i = 0; _i < 2; ++_i) \
        __builtin_amdgcn_global_load_lds((const unsigned*)((const char*)(gbase) + (voff)[_i]), (PG8_LAS unsigned*)(lds + (bufoff) + ldsw + _i * 8192), 16, 0, 0); } while (0)
#define PG8_STAGE_A(bufoff, gbase, h, GO) do { if constexpr (Sched::GATHER) { _Pragma("unroll") for (int _i = 0; _i < 2; ++_i) \
        __builtin_amdgcn_global_load_lds((const unsigned*)((const char*)(gbase) + (GO)[h][_i]), (PG8_LAS unsigned*)(lds + (bufoff) + ldsw + _i * 8192), 16, 0, 0); } \
        else { PG8_STAGE(bufoff, (gbase) + (h) * hstep, voffA); } } while (0)
#define PG8_LDA(dst, b, h) do { _Pragma("unroll") for (int m = 0; m < 4; ++m) _Pragma("unroll") for (int k = 0; k < 2; ++k) dst[m][k] = *(const PG8_LAS bf16x8*)(lds + PG8_SA(b, h) + aoff + m * 2048 + k * 1024); } while (0)
#define PG8_LDB(dst, b, h) do { _Pragma("unroll") for (int n = 0; n < 2; ++n) _Pragma("unroll") for (int k = 0; k < 2; ++k) dst[n][k] = *(const PG8_LAS bf16x8*)(lds + PG8_SB(b, h) + boff + n * 2048 + k * 1024); } while (0)
#define PG8_MMA(ai, bj, At, Bt) do { __builtin_amdgcn_s_setprio(1); _Pragma("unroll") for (int m = 0; m < 4; ++m) _Pragma("unroll") for (int n = 0; n < 2; ++n) _Pragma("unroll") for (int k = 0; k < 2; ++k) \
        acc[ai][bj][m][n] = __builtin_amdgcn_mfma_f32_16x16x32_bf16(Bt[n][k], At[m][k], acc[ai][bj][m][n], 0, 0, 0); __builtin_amdgcn_s_setprio(0); } while (0)
#define PG8_WAIT_V(n) asm volatile("s_waitcnt vmcnt(" #n ")" ::: "memory")
#define PG8_WAIT_L(n) asm volatile("s_waitcnt lgkmcnt(" #n ")" ::: "memory")
#define PG8_BAR __builtin_amdgcn_s_barrier()
#define PG8_SCHED __builtin_amdgcn_sched_barrier(0)
    Unit cur, nxt; int ui = 0;
    if (!S.next(0, cur)) return;
    f32x4 acc[2][2][4][2];
#pragma unroll
    for (int a = 0; a < 2; ++a)
#pragma unroll
        for (int b = 0; b < 2; ++b)
#pragma unroll
            for (int m = 0; m < 4; ++m)
#pragma unroll
                for (int n = 0; n < 2; ++n) acc[a][b][m][n] = (f32x4){0.f, 0.f, 0.f, 0.f};
    bf16x8 At[4][2], B0[2][2], B1[2][2];
    const char* cA = S.a_base(cur); const char* cB = S.b_base(cur);
    unsigned cgo[2][2];
    PG8_LAS u32x4* gslot = (PG8_LAS u32x4*)(lds + GATHER_SLOT_OFF) + tid;
    if constexpr (Sched::GATHER) {
#pragma unroll
        for (int h = 0; h < 2; ++h)
#pragma unroll
            for (int i = 0; i < 2; ++i) cgo[h][i] = PG8_GOFF(cur, h, i);
    }
    PG8_STAGE(PG8_SB(0, 0), cB, voffB); PG8_STAGE(PG8_SB(0, 1), cB + hstep, voffB); PG8_STAGE_A(PG8_SA(0, 0), cA, 0, cgo); PG8_STAGE_A(PG8_SA(0, 1), cA, 1, cgo);
    if (wr == 1) PG8_BAR;
    PG8_WAIT_V(2); PG8_BAR;
    PG8_STAGE(PG8_SB(1, 0), cB + kstep, voffB); PG8_STAGE_A(PG8_SA(1, 0), cA + kstep, 0, cgo); PG8_STAGE(PG8_SB(1, 1), cB + hstep + kstep, voffB);
    PG8_WAIT_V(6); PG8_BAR;
    for (;;) {
        const bool has_next = S.next(ui + 1, nxt);
        const char* nA = has_next ? S.a_base(nxt) : cA; const char* nB = has_next ? S.b_base(nxt) : cB;
        if constexpr (Sched::GATHER) {
            u32x4 nx = (u32x4){cgo[0][0], cgo[0][1], cgo[1][0], cgo[1][1]};
            if (has_next) { nx.x = PG8_GOFF(nxt, 0, 0); nx.y = PG8_GOFF(nxt, 0, 1); nx.z = PG8_GOFF(nxt, 1, 0); nx.w = PG8_GOFF(nxt, 1, 1); }
            *gslot = nx;
        }
        for (int t = 0; t < nt; t += 2) {
            const bool last = (t == nt - 2);
            if constexpr (Epi::MIDK) { if (t == (nt >> 1)) { int tl = tid; asm volatile("" : "+v"(tl)); E.mid(acc, cur, wr, wc, tl & 15, (tl >> 4) & 3); } }
            const char* a1 = cA + (size_t)(t + 1) * kstep;
            const char* a2 = last ? nA : cA + (size_t)(t + 2) * kstep; const char* b2 = last ? nB : cB + (size_t)(t + 2) * kstep;
            const char* a3 = a2 + kstep; const char* b3 = b2 + kstep;
            unsigned xgo[2][2];
            if constexpr (Sched::GATHER) {
                if (last) { const u32x4 nx = *gslot; xgo[0][0] = nx.x; xgo[0][1] = nx.y; xgo[1][0] = nx.z; xgo[1][1] = nx.w; }
                else { xgo[0][0] = cgo[0][0]; xgo[0][1] = cgo[0][1]; xgo[1][0] = cgo[1][0]; xgo[1][1] = cgo[1][1]; }
            }
            PG8_LDB(B0, 0, 0); PG8_LDB(B1, 0, 1); PG8_SCHED; PG8_LDA(At, 0, 0); PG8_STAGE_A(PG8_SA(1, 1), a1, 1, cgo);
            PG8_WAIT_V(8); PG8_WAIT_L(0); PG8_BAR; PG8_MMA(0, 0, At, B0); PG8_MMA(0, 1, At, B1); PG8_BAR; PG8_SCHED;
            PG8_LDA(At, 0, 1); PG8_STAGE(PG8_SB(0, 0), b2, voffB); PG8_STAGE(PG8_SB(0, 1), b2 + hstep, voffB); PG8_STAGE_A(PG8_SA(0, 0), a2, 0, xgo);
            PG8_WAIT_V(8); PG8_WAIT_L(0); PG8_BAR; PG8_MMA(1, 0, At, B0); PG8_MMA(1, 1, At, B1); PG8_BAR; PG8_SCHED;
            PG8_LDB(B0, 1, 0); PG8_LDB(B1, 1, 1); PG8_SCHED; PG8_LDA(At, 1, 0); PG8_STAGE_A(PG8_SA(0, 1), a2, 1, xgo);
            PG8_WAIT_V(8); PG8_WAIT_L(0); PG8_BAR; PG8_MMA(0, 0, At, B0); PG8_MMA(0, 1, At, B1); PG8_BAR; PG8_SCHED;
            PG8_LDA(At, 1, 1); PG8_STAGE(PG8_SB(1, 0), b3, voffB); PG8_STAGE(PG8_SB(1, 1), b3 + hstep, voffB); PG8_STAGE_A(PG8_SA(1, 0), a3, 0, xgo);
            PG8_WAIT_V(8); PG8_WAIT_L(0); PG8_BAR; PG8_MMA(1, 0, At, B0); PG8_MMA(1, 1, At, B1); PG8_BAR; PG8_SCHED;
        }
        if (wr == 0) PG8_BAR;
        { int tl = tid; asm volatile("" : "+v"(tl)); E(acc, cur, wr, wc, tl & 15, (tl >> 4) & 3); }
        if (!has_next) break;
#pragma unroll
        for (int a = 0; a < 2; ++a)
#pragma unroll
            for (int b = 0; b < 2; ++b)
#pragma unroll
                for (int m = 0; m < 4; ++m)
#pragma unroll
                    for (int n = 0; n < 2; ++n) acc[a][b][m][n] = (f32x4){0.f, 0.f, 0.f, 0.f};
        cur = nxt; cA = nA; cB = nB; ++ui;
        if constexpr (Sched::GATHER) { const u32x4 nx = *gslot; cgo[0][0] = nx.x; cgo[0][1] = nx.y; cgo[1][0] = nx.z; cgo[1][1] = nx.w; }
        if (wr == 1) PG8_BAR;
    }
    PG8_WAIT_V(0);
    PG8_BAR;
#undef PG8_SA
#undef PG8_SB
#undef PG8_STAGE
#undef PG8_STAGE_A
#undef PG8_GOFF
#undef PG8_LDA
#undef PG8_LDB
#undef PG8_MMA
#undef PG8_WAIT_V
#undef PG8_WAIT_L
#undef PG8_BAR
#undef PG8_SCHED
}
}
constexpr int NWAVES = 8, NTHR = 512;
constexpr int SEQ = 8192, DM = 2048, NIN = 9216, HYW = 1024, SGW = 1024, NHY = 3072, NEXP = 16, DEXP = 512, DEPTH = 2;
constexpr float EPS = 1e-6f;
constexpr size_t MiB = 1u << 20;
constexpr size_t WS_CTL = 0, CTL_ZERO_BYTES = 1 * MiB;
constexpr size_t WS_WIN = 1 * MiB;
constexpr size_t WS_PT = WS_WIN + 36 * MiB;
constexpr size_t WS_WOT = WS_PT + 8 * MiB;
constexpr size_t WS_WGU = WS_WOT + 8 * MiB;
constexpr size_t WS_WD = WS_WGU + 64 * MiB;
constexpr size_t WS_W3T = WS_WD + 32 * MiB;
constexpr size_t WS_A2 = WS_W3T + 1 * MiB;
constexpr size_t WS_WR = WS_A2 + 1 * MiB;
constexpr size_t WS_LISTS = WS_WR + 1 * MiB;
constexpr size_t WS_XR = WS_LISTS + 2 * MiB;
constexpr size_t WS_XN = WS_XR + 64 * MiB;
constexpr size_t WS_ZT = WS_XN + 32 * MiB;
constexpr size_t WS_U = WS_ZT + 48 * MiB;
constexpr size_t WS_GV = WS_U + 16 * MiB;
constexpr size_t WS_GH = WS_GV + 16 * MiB;
constexpr size_t WS_GS = WS_GH + 32 * MiB;
constexpr size_t WS_Y = WS_GS + 32 * MiB;
constexpr size_t WS_FS = WS_Y + 32 * MiB;
constexpr size_t WS_END = WS_FS + 128 * MiB;
constexpr size_t WS_MERGED = WS_ZT, WS_ACT = WS_U, WS_MOEOUT = WS_FS;
constexpr int CW_TMO = 0;
constexpr int CW_CNT = 8192;
constexpr int CW_BAR = 4096;
constexpr int SCRATCH_BYTES = 2 * 8448 * 8;
constexpr int MISC_OFF = SCRATCH_BYTES;
constexpr int LDS_BYTES = SCRATCH_BYTES + 1024 + 8192;
static_assert(pg8::GATHER_SLOT_OFF == MISC_OFF + 1024, "gather slots");
static_assert(SCRATCH_BYTES >= pg8::STAGE_BYTES, "lds");

#define GAS __attribute__((address_space(1)))
#define LAS __attribute__((address_space(3)))
typedef unsigned short bf16;
typedef unsigned v4u __attribute__((ext_vector_type(4)));
typedef unsigned v2u __attribute__((ext_vector_type(2)));
typedef float f32x4 __attribute__((ext_vector_type(4)));
typedef short bf16x8 __attribute__((ext_vector_type(8)));
typedef GAS unsigned gu32;
#define RLX_AGENT __ATOMIC_RELAXED, __HIP_MEMORY_SCOPE_AGENT
#define LDS_WAIT() asm volatile("s_waitcnt lgkmcnt(0)" ::: "memory")
#define VM_WAIT() asm volatile("s_waitcnt vmcnt(0)" ::: "memory")
__device__ __forceinline__ unsigned f2bf(float f) { unsigned u = __builtin_bit_cast(unsigned, f); return (u + 0x7fffu + ((u >> 16) & 1u)) >> 16; }
__device__ __forceinline__ unsigned pk2(float lo, float hi) { return f2bf(lo) | (f2bf(hi) << 16); }
__device__ __forceinline__ float bfl(unsigned u) { return __builtin_bit_cast(float, u << 16); }
__device__ __forceinline__ float bfh(unsigned u) { return __builtin_bit_cast(float, u & 0xffff0000u); }

#define XB_TMO      128
#define XB_XCNT(j)  (256  + 64 * (j))
#define XB_XSUB(j)  (1280 + 64 * (j))
#define XB_XGEN(j)  (2304 + 64 * (j))
#define XB_TOP      3328
#define XB_TOPGEN   3392
#define XCD_BAR_WORDS 3456
#define XB_SPIN_CAP (1u << 18)
__device__ __forceinline__ unsigned xb_ld(unsigned* p)              { return __hip_atomic_load(p, __ATOMIC_RELAXED, __HIP_MEMORY_SCOPE_AGENT); }
__device__ __forceinline__ unsigned xb_add(unsigned* p, unsigned v) { return __hip_atomic_fetch_add(p, v, __ATOMIC_RELAXED, __HIP_MEMORY_SCOPE_AGENT); }
__device__ __forceinline__ unsigned xb_xcc_id() { return (unsigned)__builtin_amdgcn_s_getreg((3 << 11) | 20) & 0xFu; }
#define XB_SPIN(cond, bar) do { unsigned _sp = 0; while (cond) { __builtin_amdgcn_s_sleep(1); \
    if ((++_sp & 255u) == 0u) { if (xb_ld(&(bar)[XB_TMO])) break; if (_sp > XB_SPIN_CAP) { atomicAdd(&(bar)[XB_TMO], 1u); break; } } } } while (0)
struct XcdBarrier { unsigned* bar; unsigned x; volatile LAS unsigned* st; };
__device__ __forceinline__ XcdBarrier xcd_barrier_post(unsigned* bar, volatile LAS unsigned* st) {
    XcdBarrier b; b.bar = bar; b.x = xb_xcc_id(); b.st = st;
    if (threadIdx.x == 0) (void)xb_add(&bar[XB_XCNT(b.x)], 1u);
    return b;
}
__device__ __forceinline__ void xcd_barrier_complete(unsigned* bar, unsigned x, unsigned& nloc, unsigned& nx) {
    const unsigned G = gridDim.x * gridDim.y * gridDim.z;
    unsigned sum, cnt, mine, sp = 0u;
    for (;;) {
        sum = 0u; cnt = 0u; mine = 0u;
#pragma unroll
        for (unsigned j = 0; j < 16; ++j) { const unsigned c = xb_ld(&bar[XB_XCNT(j)]); sum += c; cnt += (c > 0u) ? 1u : 0u; mine = (j == x) ? c : mine; }
        if (sum == G) break;
        __builtin_amdgcn_s_sleep(1);
        if ((++sp & 255u) == 0u) { if (xb_ld(&bar[XB_TMO])) break; if (sp > XB_SPIN_CAP) { atomicAdd(&bar[XB_TMO], 1u); break; } }
    }
    nloc = mine > 0u ? mine : 1u; nx = cnt > 0u ? cnt : 1u;
}
__device__ __forceinline__ void xcd_barrier(const XcdBarrier& b) {
    asm volatile("s_waitcnt vmcnt(0)" ::: "memory");
    __syncthreads();
    if (threadIdx.x == 0) {
        unsigned* bar = b.bar;
        __builtin_amdgcn_s_waitcnt(0);
        unsigned nloc = b.st[0], nx = b.st[1];
        if (nloc == 0u) { xcd_barrier_complete(bar, b.x, nloc, nx); b.st[0] = nloc; b.st[1] = nx; }
        const unsigned old = xb_add(&bar[XB_XSUB(b.x)], 1u);
        const unsigned gen = old / nloc;
        if (old + 1u == (gen + 1u) * nloc) {
            __builtin_amdgcn_fence(__ATOMIC_RELEASE, "agent");
            asm volatile("s_waitcnt vmcnt(0)" ::: "memory");
            const unsigned og = xb_add(&bar[XB_TOP], 1u);
            const unsigned tg = og / nx;
            if (og + 1u == (tg + 1u) * nx) xb_add(&bar[XB_TOPGEN], 1u);
            else XB_SPIN(xb_ld(&bar[XB_TOPGEN]) == tg, bar);
            __builtin_amdgcn_fence(__ATOMIC_ACQUIRE, "agent");
            xb_add(&bar[XB_XGEN(b.x)], 1u);
            asm volatile("s_waitcnt vmcnt(0)" ::: "memory");
        } else {
            XB_SPIN(xb_ld(&bar[XB_XGEN(b.x)]) == gen, bar);
            __builtin_amdgcn_fence(__ATOMIC_ACQUIRE, "agent");
            asm volatile("s_waitcnt vmcnt(0)" ::: "memory");
        }
    }
    __syncthreads();
}

struct Frame {
    LAS unsigned char* lds;
    volatile LAS unsigned* MISC;
    gu32* ctl;
    int tid, lane, wave;
    int vcu, G;
    const LAS unsigned long long* inp;
    float* out;
    unsigned char* ws;
};
enum { I_X = 0, I_GMIX, I_WIN, I_BIN, I_CONVW, I_CONVB, I_FW1, I_FB1, I_FW2, I_FB2, I_FW3, I_FFREQ, I_SKIP, I_LNG, I_LNB, I_SGW, I_SGB, I_WHY, I_WSG, I_WOUT, I_GFFN, I_WRG, I_BRG, I_WRE, I_BRE, I_WGATE, I_WUP, I_WDOWN, I_GFINAL };

__device__ __forceinline__ const float* inp(const Frame& F, int k) { const unsigned long long v = F.inp[k]; const unsigned lo = __builtin_amdgcn_readfirstlane((unsigned)v), hi = __builtin_amdgcn_readfirstlane((unsigned)(v >> 32));
    return (const float*)(((unsigned long long)hi << 32) | (unsigned long long)lo); }
__device__ __forceinline__ float shfl_xor_l(float v, int mask, int lane) { return __builtin_bit_cast(float, __builtin_amdgcn_ds_bpermute((lane ^ mask) << 2, __builtin_bit_cast(int, v))); }
__device__ __forceinline__ float shfl_down1_l(float v, int lane) { return __builtin_bit_cast(float, __builtin_amdgcn_ds_bpermute(((lane + 1) & 63) << 2, __builtin_bit_cast(int, v))); }
__device__ __forceinline__ float wave_sum(float v, int lane) {
#pragma unroll
    for (int o = 1; o < 64; o <<= 1) v += shfl_xor_l(v, o, lane);
    return v;
}

#ifndef PROBE_K
#define PROBE_K -1
#endif
#define HP_ME (blockIdx.x == 0 && threadIdx.x == 0)
#define HPS(j) do { if (PROBE_K == (j) && HP_ME) ((volatile LAS unsigned long long*)(F.lds + MISC_OFF + 512))[0] = __builtin_amdgcn_s_memrealtime(); } while (0)
#define HPE(j) do { if (PROBE_K == (j) && HP_ME) { volatile LAS unsigned long long* _p = (volatile LAS unsigned long long*)(F.lds + MISC_OFF + 512); _p[1] += __builtin_amdgcn_s_memrealtime() - _p[0]; } } while (0)
#define HD __device__ __forceinline__
#define HY_OPAQUE(x) asm volatile("" : "+v"(x))
typedef float hy_f2v __attribute__((ext_vector_type(2)));
#define LDC(p, i) ({ const hy_f2v _v = *(const LAS hy_f2v*)((p) + (i)); c32 _r; _r.x = _v.x; _r.y = _v.y; _r; })
#define STC(p, i, v) do { const c32 _s = (v); hy_f2v _w; _w.x = _s.x; _w.y = _s.y; *(LAS hy_f2v*)((p) + (i)) = _w; } while (0)
#define FADD(a, b) ({ float _r; asm("v_add_f32 %0, %1, %2" : "=v"(_r) : "v"((float)(a)), "v"((float)(b))); _r; })
#define FSUB(a, b) ({ float _r; asm("v_sub_f32 %0, %1, %2" : "=v"(_r) : "v"((float)(a)), "v"((float)(b))); _r; })
#define FMUL(a, b) ({ float _r; asm("v_mul_f32 %0, %1, %2" : "=v"(_r) : "v"((float)(a)), "v"((float)(b))); _r; })
#define FFMA(a, b, c) ({ float _r; asm("v_fma_f32 %0, %1, %2, %3" : "=v"(_r) : "v"((float)(a)), "v"((float)(b)), "v"((float)(c))); _r; })
#define FNMA(a, b, c) ({ float _r; asm("v_fma_f32 %0, -%1, %2, %3" : "=v"(_r) : "v"((float)(a)), "v"((float)(b)), "v"((float)(c))); _r; })
struct c32 { float x, y; };
HD c32 cmk(float x, float y) { c32 r; r.x = x; r.y = y; return r; }
HD c32 cadd(c32 a, c32 b) { return cmk(FADD(a.x, b.x), FADD(a.y, b.y)); }
HD c32 csub(c32 a, c32 b) { return cmk(FSUB(a.x, b.x), FSUB(a.y, b.y)); }
HD c32 cmul(c32 a, c32 b) { return cmk(FNMA(a.y, b.y, FMUL(a.x, b.x)), FFMA(a.y, b.x, FMUL(a.x, b.y))); }
HD c32 cmulc(c32 a, c32 b) { return cmk(FFMA(a.y, b.y, FMUL(a.x, b.x)), FNMA(a.x, b.y, FMUL(a.y, b.x))); }
HD c32 cscale(c32 a, float f) { return cmk(FMUL(a.x, f), FMUL(a.y, f)); }
HD c32 cadd_mi(c32 a, c32 b) { return cmk(FADD(a.x, b.y), FSUB(a.y, b.x)); }
HD c32 cadd_pi(c32 a, c32 b) { return cmk(FSUB(a.x, b.y), FADD(a.y, b.x)); }
#define HY_N 8192
#define HY_LDS_C32 (8192 + 256)

template <int SIGN> HD void dft4(c32& a, c32& b, c32& c, c32& d) {
    const c32 t0 = cadd(a, c), t1 = csub(a, c), t2 = cadd(b, d), t3 = csub(b, d);
    a = cadd(t0, t2); c = csub(t0, t2);
    if (SIGN < 0) { b = cadd_mi(t1, t3); d = cadd_pi(t1, t3); }
    else          { b = cadd_pi(t1, t3); d = cadd_mi(t1, t3); }
}
template <int SIGN> HD void dft16(c32 (&a)[16]) {
    const float C1 = 0.92387953251128674f, S1 = 0.38268343236508977f, R2 = 0.70710678118654752f;
#pragma unroll
    for (int n2 = 0; n2 < 4; ++n2) dft4<SIGN>(a[n2], a[4 + n2], a[8 + n2], a[12 + n2]);
    const float sg = (SIGN < 0) ? -1.f : 1.f;
    const c32 w1 = cmk(C1, sg * S1), w2 = cmk(R2, sg * R2), w3 = cmk(S1, sg * C1), w6 = cmk(-R2, sg * R2), w9 = cmk(-C1, -sg * S1);
    a[1 + 4] = cmul(a[1 + 4], w1); a[2 + 4] = cmul(a[2 + 4], w2); a[3 + 4] = cmul(a[3 + 4], w3);
    a[1 + 8] = cmul(a[1 + 8], w2); a[2 + 8] = (SIGN < 0) ? cmk(a[2 + 8].y, -a[2 + 8].x) : cmk(-a[2 + 8].y, a[2 + 8].x); a[3 + 8] = cmul(a[3 + 8], w6);
    a[1 + 12] = cmul(a[1 + 12], w3); a[2 + 12] = cmul(a[2 + 12], w6); a[3 + 12] = cmul(a[3 + 12], w9);
#pragma unroll
    for (int k1 = 0; k1 < 4; ++k1) dft4<SIGN>(a[4 * k1], a[4 * k1 + 1], a[4 * k1 + 2], a[4 * k1 + 3]);
    c32 t[16];
#pragma unroll
    for (int i = 0; i < 16; ++i) t[i] = a[i];
#pragma unroll
    for (int k1 = 0; k1 < 4; ++k1)
#pragma unroll
        for (int k2 = 0; k2 < 4; ++k2) a[k1 + 4 * k2] = t[4 * k1 + k2];
}
HD void twiddle_tree(c32 (&a)[16], c32 w1) {
    const c32 w2 = cmul(w1, w1), w3 = cmul(w2, w1), w4 = cmul(w2, w2), w5 = cmul(w4, w1), w6 = cmul(w4, w2), w7 = cmul(w4, w3), w8 = cmul(w4, w4);
    a[1] = cmul(a[1], w1); a[2] = cmul(a[2], w2); a[3] = cmul(a[3], w3); a[4] = cmul(a[4], w4); a[5] = cmul(a[5], w5); a[6] = cmul(a[6], w6); a[7] = cmul(a[7], w7); a[8] = cmul(a[8], w8);
    a[9] = cmul(a[9], cmul(w8, w1)); a[10] = cmul(a[10], cmul(w8, w2)); a[11] = cmul(a[11], cmul(w8, w3)); a[12] = cmul(a[12], cmul(w8, w4));
    a[13] = cmul(a[13], cmul(w8, w5)); a[14] = cmul(a[14], cmul(w8, w6)); a[15] = cmul(a[15], cmul(w8, w7));
}
HD c32 cis_pi(float x) { return cmk(cospif(x), sinpif(x)); }

HD void fft_s1_fwd(int tid, LAS c32* buf, c32 (&a)[16]) { HY_OPAQUE(tid);
    dft16<-1>(a);
    twiddle_tree(a, cis_pi(-2.0f * (float)tid / 8192.0f));
    LAS c32* p0 = buf + tid + (tid >> 5);
#pragma unroll
    for (int p = 0; p < 16; ++p) STC(p0, 528 * p, a[p]);
}
HD void fft_s2_fwd(int tid, LAS c32* buf) { HY_OPAQUE(tid);
    LAS c32* p0 = buf + (tid >> 5) * 528 + (tid & 31);
    c32 a[16];
#pragma unroll
    for (int q = 0; q < 16; ++q) a[q] = LDC(p0, 33 * q);
    dft16<-1>(a);
    twiddle_tree(a, cis_pi(-2.0f * (float)(tid & 31) / 512.0f));
#pragma unroll
    for (int p = 0; p < 16; ++p) STC(p0, 33 * p, a[p]);
}
HD float w32c(int q) { switch (q) { case 0: return 1.0f; case 1: return 0.98078528040323043f; case 2: return 0.92387953251128674f; case 3: return 0.83146961230254524f; case 4: return 0.70710678118654752f; case 5: return 0.55557023301960218f; case 6: return 0.38268343236508977f; case 7: return 0.19509032201612825f;
    case 8: return 0.0f; case 9: return -0.19509032201612825f; case 10: return -0.38268343236508977f; case 11: return -0.55557023301960218f; case 12: return -0.70710678118654752f; case 13: return -0.83146961230254524f; case 14: return -0.92387953251128674f; default: return -0.98078528040323043f; } }
HD float w32s(int q) { switch (q) { case 0: return 0.0f; case 1: return 0.19509032201612825f; case 2: return 0.38268343236508977f; case 3: return 0.55557023301960218f; case 4: return 0.70710678118654752f; case 5: return 0.83146961230254524f; case 6: return 0.92387953251128674f; case 7: return 0.98078528040323043f;
    case 8: return 1.0f; case 9: return 0.98078528040323043f; case 10: return 0.92387953251128674f; case 11: return 0.83146961230254524f; case 12: return 0.70710678118654752f; case 13: return 0.55557023301960218f; case 14: return 0.38268343236508977f; default: return 0.19509032201612825f; } }
template <int SIGN> HD void fft_s3_read(int tid, const LAS c32* buf, c32 (&s)[16]) { HY_OPAQUE(tid);
    const LAS c32* p0 = buf + (tid >> 1) * 33; const int h = tid & 1;
    const float sg = (SIGN < 0) ? -1.f : 1.f, hs = h ? -1.f : 1.f;
#pragma unroll
    for (int q = 0; q < 16; ++q) {
        const c32 u = LDC(p0, q), v = LDC(p0, q + 16);
        const c32 d = cmk(FFMA(v.x, hs, u.x), FFMA(v.y, hs, u.y));
        const c32 w = h ? cmk(w32c(q), sg * w32s(q)) : cmk(1.f, 0.f);
        s[q] = (q == 0) ? d : cmul(d, w);
    }
    dft16<SIGN>(s);
}
HD void fft_s3_write(int tid, LAS c32* buf, const c32 (&s)[16]) { HY_OPAQUE(tid);
    LAS c32* p0 = buf + (tid >> 1) * 33 + (tid & 1);
#pragma unroll
    for (int p = 0; p < 16; ++p) STC(p0, 2 * p, s[p]);
}
HD void fft_s2_inv(int tid, LAS c32* buf) { HY_OPAQUE(tid);
    LAS c32* p0 = buf + (tid >> 5) * 528 + (tid & 31);
    c32 a[16];
#pragma unroll
    for (int q = 0; q < 16; ++q) a[q] = LDC(p0, 33 * q);
    twiddle_tree(a, cis_pi(2.0f * (float)(tid & 31) / 512.0f));
    dft16<1>(a);
#pragma unroll
    for (int p = 0; p < 16; ++p) STC(p0, 33 * p, a[p]);
}
HD void fft_s1_inv(int tid, const LAS c32* buf, c32 (&a)[16]) { HY_OPAQUE(tid);
    const LAS c32* p0 = buf + tid + (tid >> 5);
#pragma unroll
    for (int p = 0; p < 16; ++p) a[p] = LDC(p0, 528 * p);
    twiddle_tree(a, cis_pi(2.0f * (float)tid / 8192.0f));
    dft16<1>(a);
}
HD void pair_pass(int tid, LAS c32* Z, const LAS c32* H) { HY_OPAQUE(tid);
    const int p3 = tid & 31;
    const c32 wp3 = cis_pi(-(float)p3 / 32.0f);
    const c32 wstep = cis_pi(-16.0f / 8192.0f);
    c32 wlow = cis_pi(-(float)(tid >> 5) / 8192.0f);
#pragma unroll 1
    for (int it = 0; it < 9; ++it) {
        const int low = it * 16 + (tid >> 5);
        const c32 Wk = cmul(wlow, wp3);
        wlow = cmul(wlow, wstep);
        if (low > 128) continue;
        bool act = true; int p3b = 31 - p3, lowb = 256 - low;
        if (low == 0) { act = p3 <= 16; p3b = (32 - p3) & 31; lowb = 0; }
        else if (low == 128) { act = p3 <= 15; lowb = 128; }
        if (!act) continue;
        const int pa = (low & 15) * 528 + (low >> 4) * 33 + p3, pb = (lowb & 15) * 528 + (lowb >> 4) * 33 + p3b;
        const c32 A = LDC(Z, pa), B = LDC(Z, pb), HA = LDC(H, pa), HB = LDC(H, pb);
        c32 E = cmk(FMUL(FADD(A.x, B.x), 0.5f), FMUL(FSUB(A.y, B.y), 0.5f)), O = cmk(FMUL(FADD(A.y, B.y), 0.5f), FMUL(FSUB(B.x, A.x), 0.5f));
        c32 T = cmul(Wk, O);
        const c32 X = cadd(E, T), Xm = csub(E, T);
        E = cmk(FMUL(FADD(HA.x, HB.x), 0.5f), FMUL(FSUB(HA.y, HB.y), 0.5f)); O = cmk(FMUL(FADD(HA.y, HB.y), 0.5f), FMUL(FSUB(HB.x, HA.x), 0.5f));
        T = cmul(Wk, O);
        const c32 Hk = cadd(E, T), Hm = csub(E, T);
        const c32 Y = cmul(X, Hk), Ypc = cmul(Xm, Hm);
        const float sc = 0.5f / 8192.0f;
        const c32 Ye = cscale(cadd(Y, Ypc), sc), Yd = cscale(csub(Y, Ypc), sc);
        const c32 Yo = cmulc(Yd, Wk);
        STC(Z, pa, cmk(FSUB(Ye.x, Yo.y), FADD(Ye.y, Yo.x)));
        if (pb != pa) STC(Z, pb, cmk(FADD(Ye.x, Yo.y), FSUB(Yo.x, Ye.y)));
    }
}
HD float bf_lo(unsigned u) { unsigned v = u << 16; return __builtin_bit_cast(float, v); }
HD float bf_hi(unsigned u) { unsigned v = u & 0xffff0000u; return __builtin_bit_cast(float, v); }
HD void hy_conv3_load(int tid, const unsigned* zrow, float c0, float c1, float c2, float cb, c32 (&out)[8]) { HY_OPAQUE(tid);
    unsigned wm[8], wl[8], wr[8];
#pragma unroll
    for (int q = 0; q < 8; ++q) { const int m = tid + 512 * q; wm[q] = zrow[m]; wl[q] = (m > 0) ? zrow[m - 1] : 0u; wr[q] = (m < 4095) ? zrow[m + 1] : 0u; }
#pragma unroll
    for (int q = 0; q < 8; ++q) {
        const float zm1 = bf_hi(wl[q]), z0 = bf_lo(wm[q]), z1 = bf_hi(wm[q]), z2 = bf_lo(wr[q]);
        out[q] = cmk(FFMA(c0, zm1, FFMA(c1, z0, FFMA(c2, z1, cb))), FFMA(c0, z0, FFMA(c1, z1, FFMA(c2, z2, cb))));
    }
}
HD void hy_filter_s1(int tid, LAS c32* buf, const unsigned* zk) { HY_OPAQUE(tid);
    unsigned w[16];
#pragma unroll
    for (int q = 0; q < 16; ++q) w[q] = zk[tid + 512 * q];
    c32 a[16];
#pragma unroll
    for (int q = 0; q < 16; ++q) a[q] = cmk(bf_lo(w[q]), bf_hi(w[q]));
    fft_s1_fwd(tid, buf, a);
}
HD void hy_data_s1(int tid, LAS c32* buf, const c32 (&v)[8]) { HY_OPAQUE(tid);
    c32 a[16];
#pragma unroll
    for (int q = 0; q < 8; ++q) a[q] = v[q];
#pragma unroll
    for (int q = 8; q < 16; ++q) a[q] = cmk(0.f, 0.f);
    fft_s1_fwd(tid, buf, a);
}
HD unsigned hy_bf(float f) { unsigned u = __builtin_bit_cast(unsigned, f); return (u + 0x7fffu + ((u >> 16) & 1u)) >> 16; }
HD void hy_pack_store(unsigned* zk, int dir, int a4, float t0, float t1, float t2, float t3) {
    if (dir == 0) { zk[a4 / 2] = hy_bf(t0) | (hy_bf(t1) << 16); zk[a4 / 2 + 1] = hy_bf(t2) | (hy_bf(t3) << 16); }
    else {
        const int m = 8192 - a4 / 2;
        if (a4 > 0) ((unsigned short*)(zk + m))[0] = (unsigned short)hy_bf(t0);
        zk[m - 1] = hy_bf(t2) | (hy_bf(t1) << 16);
        if (a4 == 8188) zk[m - 2] = hy_bf(t3) << 16; else ((unsigned short*)(zk + m - 2))[1] = (unsigned short)hy_bf(t3);
    }
}
struct CvItem { const float* src; int N; bf16* dst; size_t dld; };
__device__ __forceinline__ bool cv_decode(Frame& F, int l, int it, CvItem& d) {
    bf16* WIN = (bf16*)(F.ws + WS_WIN); bf16* PT = (bf16*)(F.ws + WS_PT); bf16* WOT = (bf16*)(F.ws + WS_WOT); bf16* WGU = (bf16*)(F.ws + WS_WGU); bf16* WD = (bf16*)(F.ws + WS_WD); bf16* W3T = (bf16*)(F.ws + WS_W3T);
    constexpr int S0 = 32 * 288, S1 = 16 * 64, S3 = 32 * 64, S4 = 16 * 32 * 16, S6 = 16 * 8 * 64, S7 = 128;
    constexpr int NITEMS = S0 + 2 * S1 + S3 + 2 * S4 + S6 + S7;
    if (it >= NITEMS) return false;
    int r = it;
    if (r < S0) { const int kb = r / 288, nb = r % 288; d.src = inp(F, I_WIN) + (size_t)l * DM * NIN + (size_t)(64 * kb) * NIN + 32 * nb; d.N = NIN; d.dst = WIN + (size_t)(32 * nb) * DM + 64 * kb; d.dld = DM; return true; } r -= S0;
    if (r < S1) { const int kb = r / 64, nb = r % 64; d.src = inp(F, I_WHY) + (size_t)l * HYW * DM + (size_t)(64 * kb) * DM + 32 * nb; d.N = DM; d.dst = PT + (size_t)(32 * nb) * DM + 64 * kb; d.dld = DM; return true; } r -= S1;
    if (r < S1) { const int kb = r / 64, nb = r % 64; d.src = inp(F, I_WSG) + (size_t)l * SGW * DM + (size_t)(64 * kb) * DM + 32 * nb; d.N = DM; d.dst = PT + (size_t)(32 * nb) * DM + 1024 + 64 * kb; d.dld = DM; return true; } r -= S1;
    if (r < S3) { const int kb = r / 64, nb = r % 64; d.src = inp(F, I_WOUT) + (size_t)l * DM * DM + (size_t)(64 * kb) * DM + 32 * nb; d.N = DM; d.dst = WOT + (size_t)(32 * nb) * DM + 64 * kb; d.dld = DM; return true; } r -= S3;
    if (r < 2 * S4) { const int up = r / S4; r -= up * S4; const int e = r / 512, q = r % 512, kb = q / 16, nb = q % 16; const int n0 = 32 * nb, drow = 256 * (n0 / 128) + (n0 % 128) + 128 * up;
        d.src = (up ? inp(F, I_WUP) : inp(F, I_WGATE)) + ((size_t)l * NEXP + e) * DM * DEXP + (size_t)(64 * kb) * DEXP + n0; d.N = DEXP; d.dst = WGU + ((size_t)e * 1024 + drow) * DM + 64 * kb; d.dld = DM; return true; } r -= 2 * S4;
    if (r < S6) { const int e = r / 512, q = r % 512, kb = q / 64, nb = q % 64;
        d.src = inp(F, I_WDOWN) + ((size_t)l * NEXP + e) * DEXP * DM + (size_t)(64 * kb) * DM + 32 * nb; d.N = DM; d.dst = WD + ((size_t)e * DM + 32 * nb) * DEXP + 64 * kb; d.dld = DEXP; return true; } r -= S6;
    { const int nb = r; d.src = inp(F, I_FW3) + (size_t)l * 64 * 4096 + 32 * nb; d.N = 4096; d.dst = W3T + (size_t)(32 * nb) * 64; d.dld = 64; return true; }
}
__device__ __forceinline__ void cv_load(const CvItem& d, int lane, float (&v)[32]) {
    const float* s = d.src + (size_t)(lane >> 5) * d.N + (lane & 31);
#pragma unroll
    for (int i = 0; i < 32; ++i) v[i] = s[(size_t)(2 * i) * d.N];
}
__device__ __forceinline__ void cv_store(const CvItem& d, int lane, const float (&v)[32], LAS float* scr) {
#pragma unroll
    for (int i = 0; i < 32; ++i) scr[(2 * i + (lane >> 5)) * 33 + (lane & 31)] = v[i];
    LDS_WAIT(); asm volatile("" ::: "memory");
    const int c = lane & 7;
#pragma unroll
    for (int j = 0; j < 4; ++j) { const int n = (lane >> 3) + 8 * j; const LAS float* s = scr + (8 * c) * 33 + n;
        v4u o; o.x = pk2(s[0 * 33], s[1 * 33]); o.y = pk2(s[2 * 33], s[3 * 33]); o.z = pk2(s[4 * 33], s[5 * 33]); o.w = pk2(s[6 * 33], s[7 * 33]);
        *(GAS v4u*)(d.dst + (size_t)n * d.dld + 8 * c) = o; }
    LDS_WAIT(); asm volatile("" ::: "memory");
}
__device__ __forceinline__ void pa_convert(Frame& F, int l) {
    LAS float* scr = (LAS float*)(F.lds + F.wave * 16384);
    const int gw = F.vcu * NWAVES + F.wave, NGW = F.G * NWAVES;
    CvItem cur, nxt; float va[32], vb[32];
    int it = gw; asm volatile("" : "+s"(it));
    bool have = cv_decode(F, l, it, cur);
    if (have) cv_load(cur, F.lane, va);
    while (have) {
        const bool hn = cv_decode(F, l, it + NGW, nxt);
        if (hn) cv_load(nxt, F.lane, vb);
        cv_store(cur, F.lane, va, scr);
        if (!hn) break;
        it += 2 * NGW; have = cv_decode(F, l, it, cur);
        if (have) cv_load(cur, F.lane, va);
        cv_store(nxt, F.lane, vb, scr);
    }
}
__device__ __forceinline__ void pa_features(Frame& F, int l) {
    LAS float* zf = (LAS float*)(F.lds);
    LAS float* a1 = zf + 8 * 40;
    const float* w1 = inp(F, I_FW1) + l * 33 * 64; const float* b1 = inp(F, I_FB1) + l * 64; const float* w2 = inp(F, I_FW2) + l * 64 * 64; const float* b2 = inp(F, I_FB2) + l * 64; const float* fq = inp(F, I_FFREQ) + l * 64;
    bf16* A2 = (bf16*)(F.ws + WS_A2);
    const int tl = F.tid >> 6, j = F.tid & 63;
    const float fr = fq[j];
    float w1c[33], w2c[64];
#pragma unroll
    for (int i = 0; i < 33; ++i) w1c[i] = w1[i * 64 + j];
#pragma unroll
    for (int i = 0; i < 64; ++i) w2c[i] = w2[i * 64 + j];
    for (int t0 = F.vcu * 8; t0 < SEQ; t0 += F.G * 8) {
        __syncthreads();
        if (F.tid < 8 * 33) { const int tt = F.tid / 33, i = F.tid % 33; const int t = t0 + tt; float v;
            const float w = 6.283185307179586f / (float)SEQ * (float)t;
            if (i == 0) v = (float)t / (float)(SEQ - 1);
            else { const int b = (i - 1) & 15; const float band = 1e-4f + (float)b * ((15.0f - 1e-4f) / 15.0f); const float a = band * w; v = (i <= 16) ? cosf(a) : -sinf(a); }
            zf[tt * 40 + i] = v; }
        __syncthreads();
        float s = b1[j];
#pragma unroll
        for (int i = 0; i < 33; ++i) s += zf[tl * 40 + i] * w1c[i];
        a1[tl * 64 + j] = sinf(fr * s);
        __syncthreads();
        float s2 = b2[j];
#pragma unroll
        for (int i = 0; i < 64; ++i) s2 += a1[tl * 64 + i] * w2c[i];
        A2[(size_t)(t0 + tl) * 64 + j] = (bf16)f2bf(sinf(fr * s2));
    }
    __syncthreads();
}
__device__ __forceinline__ void pa_router_t(Frame& F, int l) {
    float* WR = (float*)(F.ws + WS_WR);
    const float* wrg = inp(F, I_WRG) + (size_t)l * DM * 4; const float* wre = inp(F, I_WRE) + (size_t)l * 4 * DM * 4;
    for (int i = F.vcu * NTHR + F.tid; i < 20 * DM; i += F.G * NTHR) { const int o = i / DM, k = i % DM;
        WR[i] = (o < 4) ? wrg[k * 4 + o] : wre[((size_t)((o - 4) >> 2) * DM + k) * 4 + ((o - 4) & 3)]; }
}
__device__ __forceinline__ int moe_off(const gu32* cnt, int e) { int s = 0;
#pragma unroll
    for (int j = 0; j < 16; ++j) { const int c = (int)cnt[64 * j]; s += (j < e) ? c : 0; } return s; }
template <int MODE, bool OUTF, int NR>
__device__ __forceinline__ void norm_rows(Frame& F, int m0, int mstride, const float* xin, const float* g, const gu32* cntprev, float* outf) {
    float* XR = (float*)(F.ws + WS_XR); bf16* XN = (bf16*)(F.ws + WS_XN);
    f32x4 v[NR][8];
#pragma unroll
    for (int r = 0; r < NR; ++r) { const int m = m0 + r * mstride; const GAS f32x4* xr = (const GAS f32x4*)((MODE == 0 ? xin : XR) + (size_t)m * DM) + F.lane;
#pragma unroll
        for (int j = 0; j < 8; ++j) v[r][j] = xr[64 * j]; }
    if (MODE == 1) {
        const int* TOKPOS = (const int*)(F.ws + WS_LISTS + 1 * MiB); const bf16* MO = (const bf16*)(F.ws + WS_MOEOUT);
        int slot[NR][2];
#pragma unroll
        for (int r = 0; r < NR; ++r)
#pragma unroll
            for (int k = 0; k < 2; ++k) { const int tp = TOKPOS[(m0 + r * mstride) * 2 + k]; slot[r][k] = moe_off(cntprev, tp >> 13) + (tp & 8191); }
        v2u w[NR][2][8];
#pragma unroll
        for (int r = 0; r < NR; ++r)
#pragma unroll
            for (int k = 0; k < 2; ++k) { const GAS v2u* mr = (const GAS v2u*)(MO + (size_t)slot[r][k] * DM) + F.lane;
#pragma unroll
                for (int j = 0; j < 8; ++j) w[r][k][j] = mr[64 * j]; }
#pragma unroll
        for (int r = 0; r < NR; ++r) {
#pragma unroll
            for (int k = 0; k < 2; ++k)
#pragma unroll
                for (int j = 0; j < 8; ++j) { const v2u ww = w[r][k][j]; v[r][j].x += bfl(ww.x); v[r][j].y += bfh(ww.x); v[r][j].z += bfl(ww.y); v[r][j].w += bfh(ww.y); }
            if (!OUTF) { GAS f32x4* xw = (GAS f32x4*)(XR + (size_t)(m0 + r * mstride) * DM) + F.lane;
#pragma unroll
                for (int j = 0; j < 8; ++j) xw[64 * j] = v[r][j]; } }
    }
    const GAS f32x4* gp = (const GAS f32x4*)g + F.lane;
#pragma unroll
    for (int r = 0; r < NR; ++r) { const int m = m0 + r * mstride;
        float ss = 0.f;
#pragma unroll
        for (int j = 0; j < 8; ++j) ss += (v[r][j].x * v[r][j].x + v[r][j].y * v[r][j].y) + (v[r][j].z * v[r][j].z + v[r][j].w * v[r][j].w);
        const float rstd = 1.0f / sqrtf(wave_sum(ss, F.lane) * (1.0f / DM) + EPS);
        if (OUTF) { GAS f32x4* o = (GAS f32x4*)(outf + (size_t)m * DM) + F.lane;
#pragma unroll
            for (int j = 0; j < 8; ++j) { const f32x4 gg = gp[64 * j]; o[64 * j] = v[r][j] * rstd * gg; } }
        else { GAS v2u* o = (GAS v2u*)(XN + (size_t)m * DM) + F.lane;
#pragma unroll
            for (int j = 0; j < 8; ++j) { const f32x4 gg = gp[64 * j]; const f32x4 rr = v[r][j] * rstd * gg; v2u ww; ww.x = pk2(rr.x, rr.y); ww.y = pk2(rr.z, rr.w); o[64 * j] = ww; } } }
}

__device__ __forceinline__ void sgu_unit(Frame& F, int l, int ch, int g) {
    constexpr int RS = 136;
    LAS bf16* Wb = (LAS bf16*)(F.lds);
    LAS bf16* Vt = (LAS bf16*)(F.lds + 128 * RS * 2);
    LAS float* st = (LAS float*)(F.lds + 2 * 128 * RS * 2);
    const bf16* GV = (const bf16*)(F.ws + WS_GV); const bf16* U = (const bf16*)(F.ws + WS_U); bf16* Y = (bf16*)(F.ws + WS_Y);
    const float* lng = inp(F, I_LNG) + l * SGW; const float* lnb = inp(F, I_LNB) + l * SGW;
    const float* Wg = inp(F, I_SGW) + ((size_t)l * 8 + g) * 128 * 128; const float* bg = inp(F, I_SGB) + (l * 8 + g) * 128;
    const int t0 = ch * 128;
    __syncthreads();
    {
        const int row = F.tid >> 2, part = F.tid & 3; const GAS v4u* rp = (const GAS v4u*)(GV + (size_t)(t0 + row) * SGW);
        float s = 0.f, q = 0.f;
#pragma unroll 4
        for (int i = 0; i < 32; ++i) { const v4u w = rp[part + 4 * i]; const unsigned ww[4] = {w.x, w.y, w.z, w.w};
#pragma unroll
            for (int j = 0; j < 4; ++j) { const float a = bfl(ww[j]), b = bfh(ww[j]); s += a + b; q += a * a + b * b; } }
        s += shfl_xor_l(s, 1, F.lane); s += shfl_xor_l(s, 2, F.lane); q += shfl_xor_l(q, 1, F.lane); q += shfl_xor_l(q, 2, F.lane);
        const float mu = s * (1.0f / SGW); const float var = fmaxf(q * (1.0f / SGW) - mu * mu, 0.f);
        if (part == 0) { st[row] = mu; st[128 + row] = 1.0f / sqrtf(var + EPS); }
    }
    {
#pragma unroll
        for (int i = 0; i < 8; ++i) { const int idx = F.tid + NTHR * i; const int t = idx >> 5, s4 = (idx & 31) * 4; const f32x4 w = *(const GAS f32x4*)(Wg + t * 128 + s4);
            v2u o; o.x = pk2(w.x, w.y); o.y = pk2(w.z, w.w); *(LAS v2u*)(Wb + t * RS + s4) = o; }
    }
    __syncthreads();
    {
#pragma unroll
        for (int i = 0; i < 4; ++i) { const int chunk = F.tid + NTHR * i; const int s = chunk >> 4, kc = chunk & 15;
            const v4u w = *(const GAS v4u*)(GV + (size_t)(t0 + s) * SGW + g * 128 + 8 * kc); const unsigned ww[4] = {w.x, w.y, w.z, w.w};
            const float mu = st[s], rs = st[128 + s];
#pragma unroll
            for (int j = 0; j < 4; ++j) { const int k = 8 * kc + 2 * j; const float a = (bfl(ww[j]) - mu) * rs * lng[g * 128 + k] + lnb[g * 128 + k], b = (bfh(ww[j]) - mu) * rs * lng[g * 128 + k + 1] + lnb[g * 128 + k + 1];
                Vt[k * RS + s] = (bf16)f2bf(a); Vt[(k + 1) * RS + s] = (bf16)f2bf(b); } }
    }
    __syncthreads();
    {
        const int fr = F.lane & 15, fq = F.lane >> 4, tw = F.wave * 16;
        bf16x8 af[4];
#pragma unroll
        for (int ks = 0; ks < 4; ++ks) af[ks] = *(const LAS bf16x8*)(Wb + (tw + fr) * RS + ks * 32 + fq * 8);
        const int t = t0 + tw + fr; const float bias = bg[tw + fr];
#pragma unroll
        for (int kt = 0; kt < 8; ++kt) { f32x4 acc = (f32x4){0.f, 0.f, 0.f, 0.f};
#pragma unroll
            for (int ks = 0; ks < 4; ++ks) { const bf16x8 bfv = *(const LAS bf16x8*)(Vt + (kt * 16 + fr) * RS + ks * 32 + fq * 8);
                acc = __builtin_amdgcn_mfma_f32_16x16x32_bf16(bfv, af[ks], acc, 0, 0, 0); }
            const int kcol = g * 128 + kt * 16 + 4 * fq;
            const v2u uw = *(const GAS v2u*)(U + (size_t)t * SGW + kcol);
            v2u o; o.x = pk2(bfl(uw.x) * (acc[0] + bias), bfh(uw.x) * (acc[1] + bias)); o.y = pk2(bfl(uw.y) * (acc[2] + bias), bfh(uw.y) * (acc[3] + bias));
            *(GAS v2u*)(Y + (size_t)t * DM + 1024 + kcol) = o; }
    }
}

__device__ __forceinline__ void hy_filter_gen(Frame& F, int c0, unsigned* FSP) {
    const bf16* A2 = (const bf16*)(F.ws + WS_A2); const bf16* W3T = (const bf16*)(F.ws + WS_W3T);
    int lane = F.lane; asm volatile("" : "+v"(lane));
    const int fr = lane & 15, fq = lane >> 4;
    const int chl = fr >> 2, o = (fr >> 1) & 1, dir = fr & 1, col = dir * 2048 + o * 1024 + c0 + chl;
    const bf16x8 b0 = *(const GAS bf16x8*)(W3T + (size_t)col * 64 + fq * 8), b1 = *(const GAS bf16x8*)(W3T + (size_t)col * 64 + 32 + fq * 8);
    const float delta = 3.0701134573253944f + (float)(c0 + chl) * (12.280453829301579f / 1023.0f);
    const float kdec = -delta * 1.4426950408889634f / (float)(SEQ - 1);
    unsigned* zk = FSP + (size_t)(chl * 2 + o) * 8192;
    const int rot = (c0 * 10) & 511;
#pragma unroll 1
    for (int ib = 0; ib < 8; ++ib) {
        bf16x8 a0[8], a1[8];
#pragma unroll
        for (int j = 0; j < 8; ++j) { const int t0 = ((F.wave + 8 * (ib * 8 + j) + rot) & 511) * 16;
            a0[j] = *(const GAS bf16x8*)(A2 + (size_t)(t0 + fr) * 64 + fq * 8); a1[j] = *(const GAS bf16x8*)(A2 + (size_t)(t0 + fr) * 64 + 32 + fq * 8); }
#pragma unroll
        for (int j = 0; j < 8; ++j) { const int tile = (F.wave + 8 * (ib * 8 + j) + rot) & 511, t0 = tile * 16;
            f32x4 acc = (f32x4){0.f, 0.f, 0.f, 0.f};
            acc = __builtin_amdgcn_mfma_f32_16x16x32_bf16(a0[j], b0, acc, 0, 0, 0);
            acc = __builtin_amdgcn_mfma_f32_16x16x32_bf16(a1[j], b1, acc, 0, 0, 0);
            const int tb = t0 + 4 * fq;
#pragma unroll
            for (int r = 0; r < 4; ++r) acc[r] *= __builtin_amdgcn_exp2f(kdec * (float)(tb + r));
            if (tile == 0) { const float nb = shfl_down1_l(acc[0], lane);
                if (tile == 0 && fq == 0 && dir == 0) acc[0] += nb; }
            hy_pack_store(zk, dir, tb, acc[0], acc[1], acc[2], acc[3]); }
    }
}
__device__ __forceinline__ unsigned pk_c32(c32 v) { return pk2(v.x, v.y); }
__device__ __forceinline__ c32 unpk_c32(unsigned u) { return cmk(bfl(u), bfh(u)); }
__device__ __forceinline__ void hyena_block(Frame& F, int l, int blk) {
    LAS c32* A = (LAS c32*)(F.lds); LAS c32* B = A + HY_LDS_C32;
    unsigned* FSP = (unsigned*)(F.ws + WS_FS) + (size_t)blk * 8 * 8192;
    const unsigned* ZT = (const unsigned*)(F.ws + WS_ZT); bf16* Y = (bf16*)(F.ws + WS_Y);
    const float* cw = inp(F, I_CONVW) + (size_t)l * 3 * NHY; const float* cb = inp(F, I_CONVB) + (size_t)l * NHY; const float* skp = inp(F, I_SKIP) + (size_t)l * 2 * HYW;
    const int c0 = blk * 4, tid = F.tid;
    __syncthreads();
    HPS(20); hy_filter_gen(F, c0, FSP);
    VM_WAIT(); __syncthreads(); HPE(20); HPS(21);
    unsigned yb0[8], yb1[8], yb2[8], yb3[8];
#pragma unroll
    for (int q = 0; q < 8; ++q) { yb0[q] = 0u; yb1[q] = 0u; yb2[q] = 0u; yb3[q] = 0u; }
#pragma unroll 1
    for (int chl = 0; chl < 4; ++chl) {
        const int c = c0 + chl; const unsigned* zk = FSP + (size_t)chl * 2 * 8192;
        c32 keep[8]; unsigned x1p[8], x2p[8];
        c32 s[16];
        {
            unsigned fw[16]; c32 fz[16];
            { int t2 = tid; HY_OPAQUE(t2);
#pragma unroll
              for (int q = 0; q < 16; ++q) fw[q] = zk[t2 + 512 * q]; }
            c32 xa[8], xb[8];
            hy_conv3_load(tid, ZT + (size_t)(2048 + c) * (SEQ / 2), cw[2048 + c], cw[NHY + 2048 + c], cw[2 * NHY + 2048 + c], cb[2048 + c], keep);
            hy_conv3_load(tid, ZT + (size_t)c * (SEQ / 2), cw[c], cw[NHY + c], cw[2 * NHY + c], cb[c], xa);
            hy_conv3_load(tid, ZT + (size_t)(1024 + c) * (SEQ / 2), cw[1024 + c], cw[NHY + 1024 + c], cw[2 * NHY + 1024 + c], cb[1024 + c], xb);
#pragma unroll
            for (int q = 0; q < 8; ++q) { x1p[q] = pk_c32(xa[q]); x2p[q] = pk_c32(xb[q]); }
#pragma unroll
            for (int q = 0; q < 16; ++q) fz[q] = cmk(bfl(fw[q]), bfh(fw[q]));
            fft_s1_fwd(tid, B, fz);
            hy_data_s1(tid, A, keep);
        }
        const float sk0 = skp[c], sk1 = skp[HYW + c];
#pragma unroll
        for (int ord = 0; ord < 2; ++ord) {
            __syncthreads();
            HPS(22); fft_s2_fwd(tid, A); fft_s2_fwd(tid, B);
            __syncthreads(); HPE(22); HPS(23);
            fft_s3_read<-1>(tid, A, s); fft_s3_write(tid, A, s);
            fft_s3_read<-1>(tid, B, s); fft_s3_write(tid, B, s);
            unsigned fw[16];
            if (ord == 0) { int t2 = tid; HY_OPAQUE(t2);
#pragma unroll
                for (int q = 0; q < 16; ++q) fw[q] = zk[8192 + t2 + 512 * q]; }
            __syncthreads(); HPE(23); HPS(24);
            pair_pass(tid, A, B);
            __syncthreads(); HPE(24); HPS(25);
            if (ord == 0) { c32 fz[16];
#pragma unroll
                for (int q = 0; q < 16; ++q) fz[q] = cmk(bfl(fw[q]), bfh(fw[q]));
                fft_s1_fwd(tid, B, fz); }
            fft_s3_read<1>(tid, A, s); fft_s3_write(tid, A, s);
            __syncthreads();
            fft_s2_inv(tid, A);
            __syncthreads();
            fft_s1_inv(tid, A, s); HPE(25); HPS(26);
            if (ord == 0) {
#pragma unroll
                for (int q = 0; q < 8; ++q) { const c32 xv = unpk_c32(x1p[q]); keep[q] = cmk(FMUL(xv.x, FFMA(keep[q].x, sk0, s[q].x)), FMUL(xv.y, FFMA(keep[q].y, sk0, s[q].y))); }
                hy_data_s1(tid, A, keep);
            } else {
#pragma unroll
                for (int q = 0; q < 8; ++q) { const c32 xv = unpk_c32(x2p[q]); const unsigned yv = pk_c32(cmk(FMUL(xv.x, FFMA(keep[q].x, sk1, s[q].x)), FMUL(xv.y, FFMA(keep[q].y, sk1, s[q].y))));
                    yb0[q] = (chl == 0) ? yv : yb0[q]; yb1[q] = (chl == 1) ? yv : yb1[q]; yb2[q] = (chl == 2) ? yv : yb2[q]; yb3[q] = (chl == 3) ? yv : yb3[q]; }
            }
            HPE(26);
        }
        __syncthreads();
    }
    {
        int t2 = tid; HY_OPAQUE(t2);
#pragma unroll
        for (int q = 0; q < 8; ++q) { const int m = t2 + 512 * q;
            v2u lo, hi; lo.x = (yb0[q] & 0xffffu) | (yb1[q] << 16); lo.y = (yb2[q] & 0xffffu) | (yb3[q] << 16);
            hi.x = (yb0[q] >> 16) | (yb1[q] & 0xffff0000u); hi.y = (yb2[q] >> 16) | (yb3[q] & 0xffff0000u);
            *(GAS v2u*)(Y + (size_t)(2 * m) * DM + c0) = lo; *(GAS v2u*)(Y + (size_t)(2 * m + 1) * DM + c0) = hi; }
    }
    HPE(21);
}

__device__ __forceinline__ void route_block(Frame& F, int l, int tb  ) {
    LAS int* lcnt = (LAS int*)(F.lds);
    LAS int* lbase = (LAS int*)(F.lds + 64);
    LAS int* le = (LAS int*)(F.lds + 128);
    LAS int* lp = (LAS int*)(F.lds + 128 + 256);
    LAS float* lw = (LAS float*)(F.lds + 128 + 512);
    LAS float* lr = (LAS float*)(F.lds + 128 + 768);
    const float* XR = (const float*)(F.ws + WS_XR); bf16* H = (bf16*)(F.ws + WS_XN); const float* WR = (const float*)(F.ws + WS_WR);
    const float* g = inp(F, I_GFFN) + (size_t)l * DM; const float* brg = inp(F, I_BRG) + l * 4; const float* bre = inp(F, I_BRE) + l * 16;
    int* TOKLIST = (int*)(F.ws + WS_LISTS); float* WLIST = (float*)(F.ws + WS_LISTS + 512 * 1024); int* TOKPOS = (int*)(F.ws + WS_LISTS + 1 * MiB); float* RSLIST = (float*)(F.ws + WS_LISTS + 1 * MiB + 512 * 1024);
    gu32* gcnt = F.ctl + CW_CNT + 64 * 16 * l;
    __syncthreads();
    if (F.tid < 16) lcnt[F.tid] = 0;
    const int ts = F.tid >> 4, part = F.tid & 15, tok = tb + ts;
    LAS float* WRc = (LAS float*)(F.lds + 2048);
    LAS float* Xc = WRc + 20 * 512;
    LAS float* Gc = Xc + 32 * 512;
    float acc[20], ss = 0.f;
#pragma unroll
    for (int o = 0; o < 20; ++o) acc[o] = 0.f;
    f32x4 rw[5], rx[8], rg = (f32x4){0.f, 0.f, 0.f, 0.f};
#define RT_LOAD(c) do { _Pragma("unroll") for (int i = 0; i < 5; ++i) { const int idx = F.tid + NTHR * i, o = idx >> 7, k4 = idx & 127; rw[i] = *(const GAS f32x4*)(WR + (size_t)o * DM + 512 * (c) + 4 * k4); } \
        _Pragma("unroll") for (int i = 0; i < 8; ++i) { const int idx = F.tid + NTHR * i, r = idx >> 7, k4 = idx & 127; rx[i] = *(const GAS f32x4*)(XR + (size_t)(tb + r) * DM + 512 * (c) + 4 * k4); } \
        if (F.tid < 128) rg = *(const GAS f32x4*)(g + 512 * (c) + 4 * F.tid); } while (0)
    RT_LOAD(0);
#pragma unroll 1
    for (int c = 0; c < 4; ++c) {
        __syncthreads();
#pragma unroll
        for (int i = 0; i < 5; ++i) { const int idx = F.tid + NTHR * i, o = idx >> 7, k4 = idx & 127; *(LAS f32x4*)(WRc + o * 512 + 4 * k4) = rw[i]; }
#pragma unroll
        for (int i = 0; i < 8; ++i) { const int idx = F.tid + NTHR * i, r = idx >> 7, k4 = idx & 127; *(LAS f32x4*)(Xc + r * 512 + 4 * k4) = rx[i]; }
        if (F.tid < 128) *(LAS f32x4*)(Gc + 4 * F.tid) = rg;
        __syncthreads();
        if (c < 3) RT_LOAD(c + 1);
#pragma unroll 2
        for (int i = 0; i < 8; ++i) { const int ko = 4 * (part + 16 * i);
            const f32x4 x = *(const LAS f32x4*)(Xc + ts * 512 + ko); const f32x4 gg = *(const LAS f32x4*)(Gc + ko); const f32x4 xg = x * gg;
            ss += (x.x * x.x + x.y * x.y) + (x.z * x.z + x.w * x.w);
            { v2u w; w.x = pk2(xg.x, xg.y); w.y = pk2(xg.z, xg.w); *(GAS v2u*)(H + (size_t)tok * DM + 512 * c + ko) = w; }
#pragma unroll
            for (int o = 0; o < 20; ++o) { const f32x4 w = *(const LAS f32x4*)(WRc + o * 512 + ko); acc[o] += (xg.x * w.x + xg.y * w.y) + (xg.z * w.z + xg.w * w.w); } }
    }
#undef RT_LOAD
#pragma unroll
    for (int sh = 1; sh < 16; sh <<= 1) { ss += shfl_xor_l(ss, sh, F.lane);
#pragma unroll
        for (int o = 0; o < 20; ++o) acc[o] += shfl_xor_l(acc[o], sh, F.lane); }
    const float rstd = 1.0f / sqrtf(ss * (1.0f / DM) + EPS);
    {
        float lg0 = acc[0] * rstd + brg[0], lg1 = acc[1] * rstd + brg[1], lg2 = acc[2] * rstd + brg[2], lg3 = acc[3] * rstd + brg[3];
        int grp = 0; float mx = lg0;
        if (lg1 > mx) { mx = lg1; grp = 1; } if (lg2 > mx) { mx = lg2; grp = 2; } if (lg3 > mx) { mx = lg3; grp = 3; }
        const float den = (__expf(lg0 - mx) + __expf(lg1 - mx)) + (__expf(lg2 - mx) + __expf(lg3 - mx));
        const float psel = 1.0f / den;
        const float m0 = (grp == 0) ? 1.f : 0.f, m1 = (grp == 1) ? 1.f : 0.f, m2 = (grp == 2) ? 1.f : 0.f, m3 = (grp == 3) ? 1.f : 0.f;
        float e0v = (m0 * acc[4] + m1 * acc[8]) + (m2 * acc[12] + m3 * acc[16]), e1v = (m0 * acc[5] + m1 * acc[9]) + (m2 * acc[13] + m3 * acc[17]);
        float e2v = (m0 * acc[6] + m1 * acc[10]) + (m2 * acc[14] + m3 * acc[18]), e3v = (m0 * acc[7] + m1 * acc[11]) + (m2 * acc[15] + m3 * acc[19]);
        e0v = e0v * rstd + bre[grp * 4 + 0]; e1v = e1v * rstd + bre[grp * 4 + 1]; e2v = e2v * rstd + bre[grp * 4 + 2]; e3v = e3v * rstd + bre[grp * 4 + 3];
        int i0 = 0; float v0 = e0v;
        if (e1v > v0) { v0 = e1v; i0 = 1; } if (e2v > v0) { v0 = e2v; i0 = 2; } if (e3v > v0) { v0 = e3v; i0 = 3; }
        int i1 = -1; float v1 = -3.0e38f;
        if (i0 != 0 && e0v > v1) { v1 = e0v; i1 = 0; } if (i0 != 1 && e1v > v1) { v1 = e1v; i1 = 1; } if (i0 != 2 && e2v > v1) { v1 = e2v; i1 = 2; } if (i0 != 3 && e3v > v1) { v1 = e3v; i1 = 3; }
        const float ex = __expf(v1 - v0); const float w0 = psel / (1.0f + ex), w1 = psel * ex / (1.0f + ex);
        if (part == 0) { const int ea = grp * 4 + i0, eb = grp * 4 + i1;
            le[ts * 2] = ea; le[ts * 2 + 1] = eb; lw[ts * 2] = w0; lw[ts * 2 + 1] = w1; lr[ts] = rstd;
            lp[ts * 2] = __hip_atomic_fetch_add(lcnt + ea, 1, __ATOMIC_RELAXED, __HIP_MEMORY_SCOPE_WORKGROUP); lp[ts * 2 + 1] = __hip_atomic_fetch_add(lcnt + eb, 1, __ATOMIC_RELAXED, __HIP_MEMORY_SCOPE_WORKGROUP); }
    }
    __syncthreads();
    if (F.tid < 16) lbase[F.tid] = (int)__hip_atomic_fetch_add(gcnt + 64 * F.tid, (unsigned)lcnt[F.tid], RLX_AGENT);
    __syncthreads();
    if (F.tid < 64) { const int t2 = F.tid >> 1; const int e = le[F.tid], pos = lbase[e] + lp[F.tid];
        TOKLIST[e * SEQ + pos] = tb + t2; WLIST[e * SEQ + pos] = lw[F.tid]; RSLIST[e * SEQ + pos] = lr[t2]; TOKPOS[(tb + t2) * 2 + (F.tid & 1)] = (e << 13) | pos; }
}
using pg8::Unit; using pg8::f32x2; using pg8::u32x4; using pg8::cvt_pk_bf16; using pg8::gelu_pk; using pg8::sigmoid_f;
__device__ __forceinline__ void tile_of(int idx, int nM, int nN, int& pm, int& pn) {
    const int nig = 8 * nN, gid = idx / nig, fm = gid * 8, gsz = (nM - fm) < 8 ? (nM - fm) : 8;
    pm = fm + ((idx % nig) % gsz); pn = (idx % nig) / gsz;
}
__device__ __forceinline__ int xcd_remap(int L, int nwg) { const int q = nwg / 8, r = nwg % 8, xcd = L % 8, off = L / 8; return (xcd < r ? xcd * (q + 1) : r * (q + 1) + (xcd - r) * q) + off; }

struct InProjSched {
    static constexpr bool GATHER = false;
    const char* XN; const char* WIN; int G, c;
    __device__ __forceinline__ bool next(int i, Unit& u) const {
        const int L = i * G + c; if (L >= 1152) return false;
        const int w = xcd_remap(L, 1152);
        if (w < 384) { u.kind = 0; tile_of(w, 12, 32, u.pm, u.pn); } else { u.kind = 1; tile_of(w - 384, 32, 24, u.pm, u.pn); }
        u.e = 0; u.row0 = 0; u.nvalid = 256; return true;
    }
    __device__ __forceinline__ const char* a_base(const Unit& u) const { return (u.kind == 0 ? WIN : XN) + (size_t)u.pm * (256 * DM * 2); }
    __device__ __forceinline__ const char* b_base(const Unit& u) const { return (u.kind == 0 ? XN : WIN + (size_t)NHY * DM * 2) + (size_t)u.pn * (256 * DM * 2); }
    __device__ __forceinline__ unsigned a_goff(const Unit&, int) const { return 0u; }
};
struct EpiInProj {
    static constexpr bool PERM = true, MIDK = false;
    bf16 *ZT, *U; const float* bin;
    __device__ __forceinline__ void operator()(const f32x4 (&acc)[2][2][4][2], const Unit& u, int wr, int wc, int fr, int fq) const {
        asm volatile("" : "+v"(fr), "+v"(fq));
        if (u.kind == 0) {
            const int row0 = u.pm * 256 + wr * 64 + fr, col0 = u.pn * 256 + wc * 32 + 8 * fq;
#pragma unroll
            for (int ai = 0; ai < 2; ++ai)
#pragma unroll
                for (int m = 0; m < 4; ++m) { const int row = row0 + ai * 128 + m * 16; const float b = bin[row]; bf16* rowp = ZT + (size_t)row * SEQ + col0;
#pragma unroll
                    for (int bj = 0; bj < 2; ++bj) { const f32x4 v0 = acc[ai][bj][m][0] + b, v1 = acc[ai][bj][m][1] + b;
                        u32x4 w; w.x = cvt_pk_bf16(v0[0], v0[1]); w.y = cvt_pk_bf16(v0[2], v0[3]); w.z = cvt_pk_bf16(v1[0], v1[1]); w.w = cvt_pk_bf16(v1[2], v1[3]);
                        *(u32x4*)(rowp + bj * 128) = w; } }
        } else {
            const int seg = (u.pn < 4) ? 0 : (u.pn < 8) ? 1 : (u.pn < 16) ? 2 : 3;
            const size_t boff = (seg == 0) ? 0 : (seg == 1) ? (WS_GV - WS_U) : (seg == 2) ? (WS_GH - WS_U) : (WS_GS - WS_U);
            bf16* base = (bf16*)((char*)U + boff);
            const int ldc = (seg < 2) ? 1024 : 2048, colt = (seg == 0) ? u.pn * 256 : (seg == 1) ? (u.pn - 4) * 256 : (seg == 2) ? (u.pn - 8) * 256 : (u.pn - 16) * 256;
            const int row0 = u.pm * 256 + wr * 64 + fr, col0 = colt + wc * 32 + 8 * fq, bcol0 = NHY + u.pn * 256 + wc * 32 + 8 * fq;
            f32x4 bv[2][2];
#pragma unroll
            for (int bj = 0; bj < 2; ++bj)
#pragma unroll
                for (int n = 0; n < 2; ++n) bv[bj][n] = *(const f32x4*)(bin + bcol0 + bj * 128 + 4 * n);
#pragma unroll
            for (int ai = 0; ai < 2; ++ai)
#pragma unroll
                for (int m = 0; m < 4; ++m) { bf16* rowp = base + (size_t)(row0 + ai * 128 + m * 16) * ldc + col0;
#pragma unroll
                    for (int bj = 0; bj < 2; ++bj) { f32x4 v0 = acc[ai][bj][m][0] + bv[bj][0], v1 = acc[ai][bj][m][1] + bv[bj][1];
                        if (seg < 2) { const f32x2 a = gelu_pk((f32x2){v0[0], v0[1]}), b = gelu_pk((f32x2){v0[2], v0[3]}), c = gelu_pk((f32x2){v1[0], v1[1]}), d = gelu_pk((f32x2){v1[2], v1[3]});
                            v0 = (f32x4){a.x, a.y, b.x, b.y}; v1 = (f32x4){c.x, c.y, d.x, d.y}; }
                        else {
#pragma unroll
                            for (int j = 0; j < 4; ++j) { v0[j] = sigmoid_f(v0[j]); v1[j] = sigmoid_f(v1[j]); } }
                        u32x4 w; w.x = cvt_pk_bf16(v0[0], v0[1]); w.y = cvt_pk_bf16(v0[2], v0[3]); w.z = cvt_pk_bf16(v1[0], v1[1]); w.w = cvt_pk_bf16(v1[2], v1[3]);
                        *(u32x4*)(rowp + bj * 128) = w; } }
        }
    }
    __device__ __forceinline__ void mid(f32x4 (&)[2][2][4][2], const Unit&, int, int, int, int) const {}
};
struct GridSched {
    static constexpr bool GATHER = false;
    const char* A; const char* Bt; int nM, nN, K, G, c;
    __device__ __forceinline__ bool next(int i, Unit& u) const {
        const int L = i * G + c, nwg = nM * nN; if (L >= nwg) return false;
        tile_of(xcd_remap(L, nwg), nM, nN, u.pm, u.pn); u.kind = 0; u.e = 0; u.row0 = 0; u.nvalid = 256; return true;
    }
    __device__ __forceinline__ const char* a_base(const Unit& u) const { return A + (size_t)u.pm * 512 * K; }
    __device__ __forceinline__ const char* b_base(const Unit& u) const { return Bt + (size_t)u.pn * 512 * K; }
    __device__ __forceinline__ unsigned a_goff(const Unit&, int) const { return 0u; }
};
struct EpiMerge {
    static constexpr bool PERM = true, MIDK = true;
    const bf16 *GH, *GS; bf16* O;
    __device__ __forceinline__ void mid(f32x4 (&acc)[2][2][4][2], const Unit& u, int wr, int wc, int fr, int fq) const {
        asm volatile("" : "+v"(fr), "+v"(fq));
        const int row0 = u.pm * 256 + wr * 64 + fr, col0 = u.pn * 256 + wc * 32 + 8 * fq;
#pragma unroll
        for (int ai = 0; ai < 2; ++ai)
#pragma unroll
            for (int m = 0; m < 4; ++m) { const size_t off = (size_t)(row0 + ai * 128 + m * 16) * DM + col0;
#pragma unroll
                for (int bj = 0; bj < 2; ++bj) { const u32x4 h = *(const u32x4*)(GH + off + bj * 128), s = *(const u32x4*)(GS + off + bj * 128);
                    const unsigned hh[4] = {h.x, h.y, h.z, h.w}, sv[4] = {s.x, s.y, s.z, s.w};
#pragma unroll
                    for (int j = 0; j < 4; ++j) { const float r0 = bfl(hh[j]) * __builtin_amdgcn_rcpf(bfl(sv[j])), r1 = bfh(hh[j]) * __builtin_amdgcn_rcpf(bfh(sv[j]));
                        acc[ai][bj][m][j >> 1][(j & 1) * 2] *= r0; acc[ai][bj][m][j >> 1][(j & 1) * 2 + 1] *= r1; } }
                asm volatile("" : "+v"(acc[ai][0][m][0]), "+v"(acc[ai][0][m][1]), "+v"(acc[ai][1][m][0]), "+v"(acc[ai][1][m][1]));
                asm volatile("" ::: "memory"); }
    }
    __device__ __forceinline__ void operator()(const f32x4 (&acc)[2][2][4][2], const Unit& u, int wr, int wc, int fr, int fq) const {
        asm volatile("" : "+v"(fr), "+v"(fq));
        const int row0 = u.pm * 256 + wr * 64 + fr, col0 = u.pn * 256 + wc * 32 + 8 * fq;
#pragma unroll
        for (int ai = 0; ai < 2; ++ai)
#pragma unroll
            for (int m = 0; m < 4; ++m) { const size_t off = (size_t)(row0 + ai * 128 + m * 16) * DM + col0;
#pragma unroll
                for (int bj = 0; bj < 2; ++bj) { const u32x4 s = *(const u32x4*)(GS + off + bj * 128); const unsigned sv[4] = {s.x, s.y, s.z, s.w};
                    const f32x4 v0 = acc[ai][bj][m][0], v1 = acc[ai][bj][m][1];
                    u32x4 w; w.x = cvt_pk_bf16(v0[0] * bfl(sv[0]), v0[1] * bfh(sv[0])); w.y = cvt_pk_bf16(v0[2] * bfl(sv[1]), v0[3] * bfh(sv[1]));
                    w.z = cvt_pk_bf16(v1[0] * bfl(sv[2]), v1[1] * bfh(sv[2])); w.w = cvt_pk_bf16(v1[2] * bfl(sv[3]), v1[3] * bfh(sv[3]));
                    *(u32x4*)(O + off + bj * 128) = w; }
                asm volatile("" ::: "memory"); }
    }
};
struct EpiResid {
    static constexpr bool PERM = false, MIDK = false;
    const float* base; float* out;
    __device__ __forceinline__ void operator()(const f32x4 (&acc)[2][2][4][2], const Unit& u, int wr, int wc, int fr, int fq) const {
        asm volatile("" : "+v"(fr), "+v"(fq));
        const int row0 = u.pm * 256 + wr * 64 + fr, col0 = u.pn * 256 + wc * 32 + 4 * fq;
#pragma unroll
        for (int ai = 0; ai < 2; ++ai)
#pragma unroll
            for (int m = 0; m < 4; ++m) { const size_t off = (size_t)(row0 + ai * 128 + m * 16) * DM + col0;
#pragma unroll
                for (int bj = 0; bj < 2; ++bj)
#pragma unroll
                    for (int n = 0; n < 2; ++n) { const f32x4 b = *(const f32x4*)(base + off + bj * 128 + n * 16); *(f32x4*)(out + off + bj * 128 + n * 16) = b + acc[ai][bj][m][n]; } }
    }
    __device__ __forceinline__ void mid(f32x4 (&)[2][2][4][2], const Unit&, int, int, int, int) const {}
};
struct MoeSched1 {
    static constexpr bool GATHER = true;
    const LAS int* tab; const char* H; const char* W; const int* toklist; int G, c;
    __device__ __forceinline__ bool next(int i, Unit& u) const {
        const int L = i * G + c; const int total = __builtin_amdgcn_readfirstlane(tab[16]) * 4; if (L >= total) return false;
        const int rt = L >> 2; int e = 0;
#pragma unroll
        for (int j = 1; j < 16; ++j) e += (__builtin_amdgcn_readfirstlane(tab[j]) <= rt) ? 1 : 0;
        const int j0 = rt - __builtin_amdgcn_readfirstlane(tab[e]);
        u.pm = j0; u.pn = L & 3; u.kind = 0; u.e = e; u.row0 = __builtin_amdgcn_readfirstlane(tab[17 + e]) + 256 * j0;
        const int rem = __builtin_amdgcn_readfirstlane(tab[34 + e]) - 256 * j0; u.nvalid = rem < 256 ? rem : 256; return true;
    }
    __device__ __forceinline__ const char* a_base(const Unit&) const { return H; }
    __device__ __forceinline__ const char* b_base(const Unit& u) const { return W + ((size_t)u.e * 1024 + (size_t)u.pn * 256) * DM * 2; }
    __device__ __forceinline__ unsigned a_goff(const Unit& u, int r) const { const int tok = (r < u.nvalid) ? toklist[u.e * SEQ + u.pm * 256 + r] : 0; return (unsigned)tok * (unsigned)(DM * 2); }
};
struct EpiMoe1 {
    static constexpr bool PERM = true, MIDK = false;
    bf16* ACT; const float* wlist; const float* rslist;
    __device__ __forceinline__ void operator()(const f32x4 (&acc)[2][2][4][2], const Unit& u, int wr, int wc, int fr, int fq) const {
        asm volatile("" : "+v"(fr), "+v"(fq));
        const int col0 = u.pn * 128 + wc * 32 + 8 * fq;
#pragma unroll
        for (int ai = 0; ai < 2; ++ai)
#pragma unroll
            for (int m = 0; m < 4; ++m) { const int rl = ai * 128 + wr * 64 + m * 16 + fr;
                if (rl < u.nvalid) { const float wt = wlist[u.e * SEQ + u.pm * 256 + rl], rs = rslist[u.e * SEQ + u.pm * 256 + rl];
                    const f32x4 g0 = acc[ai][0][m][0], g1 = acc[ai][0][m][1], u0 = acc[ai][1][m][0], u1 = acc[ai][1][m][1];
                    float o[8];
#pragma unroll
                    for (int j = 0; j < 4; ++j) { const float ga = g0[j] * rs, gb = g1[j] * rs; o[j] = ga * sigmoid_f(ga) * (u0[j] * rs) * wt; o[4 + j] = gb * sigmoid_f(gb) * (u1[j] * rs) * wt; }
                    u32x4 w; w.x = cvt_pk_bf16(o[0], o[1]); w.y = cvt_pk_bf16(o[2], o[3]); w.z = cvt_pk_bf16(o[4], o[5]); w.w = cvt_pk_bf16(o[6], o[7]);
                    *(u32x4*)(ACT + (size_t)(u.row0 + rl) * DEXP + col0) = w; } }
    }
    __device__ __forceinline__ void mid(f32x4 (&)[2][2][4][2], const Unit&, int, int, int, int) const {}
};
struct MoeSched2 {
    static constexpr bool GATHER = false;
    const LAS int* tab; const char* ACT; const char* W; int G, c;
    __device__ __forceinline__ bool next(int i, Unit& u) const {
        const int L = i * G + c; const int total = __builtin_amdgcn_readfirstlane(tab[16]) * 8; if (L >= total) return false;
        const int rt = L >> 3; int e = 0;
#pragma unroll
        for (int j = 1; j < 16; ++j) e += (__builtin_amdgcn_readfirstlane(tab[j]) <= rt) ? 1 : 0;
        const int j0 = rt - __builtin_amdgcn_readfirstlane(tab[e]);
        u.pm = j0; u.pn = L & 7; u.kind = 0; u.e = e; u.row0 = __builtin_amdgcn_readfirstlane(tab[17 + e]) + 256 * j0;
        const int rem = __builtin_amdgcn_readfirstlane(tab[34 + e]) - 256 * j0; u.nvalid = rem < 256 ? rem : 256; return true;
    }
    __device__ __forceinline__ const char* a_base(const Unit& u) const { return ACT + (size_t)u.row0 * DEXP * 2; }
    __device__ __forceinline__ const char* b_base(const Unit& u) const { return W + ((size_t)u.e * DM + (size_t)u.pn * 256) * DEXP * 2; }
    __device__ __forceinline__ unsigned a_goff(const Unit&, int) const { return 0u; }
};
struct EpiMoe2 {
    static constexpr bool PERM = true, MIDK = false;
    bf16* MO;
    __device__ __forceinline__ void operator()(const f32x4 (&acc)[2][2][4][2], const Unit& u, int wr, int wc, int fr, int fq) const {
        asm volatile("" : "+v"(fr), "+v"(fq));
        const int col0 = u.pn * 256 + wc * 32 + 8 * fq;
#pragma unroll
        for (int ai = 0; ai < 2; ++ai)
#pragma unroll
            for (int m = 0; m < 4; ++m) { const int rl = ai * 128 + wr * 64 + m * 16 + fr;
                if (rl < u.nvalid) { bf16* rowp = MO + (size_t)(u.row0 + rl) * DM + col0;
#pragma unroll
                    for (int bj = 0; bj < 2; ++bj) { const f32x4 v0 = acc[ai][bj][m][0], v1 = acc[ai][bj][m][1];
                        u32x4 w; w.x = cvt_pk_bf16(v0[0], v0[1]); w.y = cvt_pk_bf16(v0[2], v0[3]); w.z = cvt_pk_bf16(v1[0], v1[1]); w.w = cvt_pk_bf16(v1[2], v1[3]);
                        *(u32x4*)(rowp + bj * 128) = w; } } }
    }
    __device__ __forceinline__ void mid(f32x4 (&)[2][2][4][2], const Unit&, int, int, int, int) const {}
};
__device__ __forceinline__ void moe_tables(Frame& F, int l) {
    LAS int* tab = (LAS int*)(F.lds + MISC_OFF + 128);
    __syncthreads();
    if (F.tid == 0) { int tp = 0, off = 0;
        for (int e = 0; e < 16; ++e) { const int c = (int)__hip_atomic_load(F.ctl + CW_CNT + 64 * (16 * l + e), RLX_AGENT); tab[e] = tp; tab[17 + e] = off; tab[34 + e] = c; tp += (c + 255) >> 8; off += c; }
        tab[16] = tp; tab[33] = off; }
    __syncthreads();
}

struct Args { const float* in[29]; float* out; unsigned char* ws; int ph_lo, ph_hi; };
constexpr int NPHASE = 17;
__global__ void __launch_bounds__(NTHR, 2) fwd_kernel(Args args) {
    extern __shared__ __attribute__((aligned(16))) unsigned char lds[];
    Frame F;
    F.lds = (LAS unsigned char*)lds;
    F.MISC = (volatile LAS unsigned*)(F.lds + MISC_OFF);
    F.tid = threadIdx.x; F.lane = F.tid & 63; F.wave = __builtin_amdgcn_readfirstlane(F.tid >> 6);
    F.G = gridDim.x; { const int bx = blockIdx.x; F.vcu = (F.G % 8 == 0) ? (bx % 8) * (F.G / 8) + bx / 8 : bx; }
    F.ws = args.ws; F.out = args.out; F.ctl = (gu32*)(args.ws + WS_CTL);
    for (int u = F.tid; u < 256; u += NTHR) ((LAS unsigned*)(F.lds + MISC_OFF))[u] = 0u;
    F.inp = (const LAS unsigned long long*)(F.lds + MISC_OFF + 640);
    __syncthreads();
#pragma unroll
    for (int i = 0; i < 29; ++i) if (F.tid == i) ((LAS unsigned long long*)(F.lds + MISC_OFF + 640))[i] = (unsigned long long)args.in[i];
    __syncthreads();
    const int lo = args.ph_lo, hi = args.ph_hi;
    const bool multi = (hi - lo) > 1;
    XcdBarrier bar; bar.bar = (unsigned*)(F.ctl + CW_BAR); bar.x = 0; bar.st = nullptr;
    if (multi) bar = xcd_barrier_post((unsigned*)(F.ctl + CW_BAR), F.MISC + 8);
#ifndef PHASE_MASK
#define PHASE_MASK 0x7ff
#endif
#define IN(k) (lo <= (k) && (k) < hi)
#define ON(j) ((PHASE_MASK >> (j)) & 1)
#ifndef DUP_MASK
#define DUP_MASK 0
#endif
#define REP(j) for (int _rep = 0; _rep < (((DUP_MASK >> (j)) & 1) ? 2 : 1); ++_rep)
#define LAUNDER() do { int _l; asm volatile("v_mbcnt_lo_u32_b32 %0, -1, 0\n\tv_mbcnt_hi_u32_b32 %0, -1, %0" : "=v"(_l)); F.lane = _l; F.tid = F.wave * 64 + _l; { unsigned char* _w = F.ws; asm volatile("" : "+s"(_w)); F.ws = _w; } } while (0)
#ifndef PROBE_K
#define PROBE_K -1
#endif
#ifndef PROBE_PART
#define PROBE_PART 0
#endif
#ifndef PROBE_AMP
#define PROBE_AMP 8
#endif
    volatile LAS unsigned long long* pr = (volatile LAS unsigned long long*)(F.lds + MISC_OFF + 512);
#define PR_ME (blockIdx.x == 0 && threadIdx.x == 0)
#define PSTART(j) do { if (PROBE_K == (j) && PROBE_PART != 1 && PR_ME) pr[0] = __builtin_amdgcn_s_memrealtime(); } while (0)
#define PEND(j) do { if (PROBE_K == (j) && PR_ME) { const unsigned long long _n = __builtin_amdgcn_s_memrealtime(); if (PROBE_PART == 0 || (PROBE_PART == 2 && (j) == 8)) pr[1] += _n - pr[0]; else if (PROBE_PART == 1) pr[0] = _n; } } while (0)
#define PBAR(j) do { if (PROBE_K == (j) && PROBE_PART >= 1 && PR_ME) pr[1] += __builtin_amdgcn_s_memrealtime() - pr[0]; } while (0)
#define SEAM(k) do { if (IN(k) && IN((k) + 1)) xcd_barrier(bar); } while (0)
    const int gw = F.vcu * NWAVES + F.wave, NGW = F.G * NWAVES;
    for (int l = 0; l < DEPTH; ++l) {
        const int p0 = l * 8;
        if (ON(0) && IN(p0 + 0)) { LAUNDER(); PSTART(0);
            PSTART(10); REP(0) pa_convert(F, l); PEND(10);
            PSTART(11); pa_features(F, l); PEND(11);
            PSTART(12); pa_router_t(F, l); PEND(12);
            PSTART(13);
            const float* g = inp(F, I_GMIX) + (size_t)l * DM;
            if (l == 0) { for (int m = gw; m < SEQ; m += 4 * NGW) norm_rows<0, false, 4>(F, m, NGW, inp(F, I_X), g, nullptr, nullptr); }
            else { for (int m = gw; m < SEQ; m += 2 * NGW) norm_rows<1, false, 2>(F, m, NGW, nullptr, g, F.ctl + CW_CNT + 64 * 16 * (l - 1), nullptr); }
            PEND(13);
        }
        PEND(0); SEAM(p0 + 0); PBAR(0);
        if (ON(1) && IN(p0 + 1)) { LAUNDER(); PSTART(1);
            InProjSched S{(const char*)(F.ws + WS_XN), (const char*)(F.ws + WS_WIN), F.G, (int)blockIdx.x};
            EpiInProj E{(bf16*)(F.ws + WS_ZT), (bf16*)(F.ws + WS_U), inp(F, I_BIN) + (size_t)l * NIN};
            REP(1) pg8::gemm_phase<EpiInProj, InProjSched>(F.lds, DM, S, E, F.tid);
        }
        PEND(1); SEAM(p0 + 1); PBAR(1);
        if (ON(2) && IN(p0 + 2)) { LAUNDER(); PSTART(2);
            if (ON(9)) REP(9) for (int u = F.vcu; u < 512; u += F.G) sgu_unit(F, l, u >> 3, u & 7);
            if (ON(10)) REP(10) for (int b = F.vcu; b < 256; b += F.G) hyena_block(F, l, b);
        }
        PEND(2); SEAM(p0 + 2); PBAR(2);
        if (ON(3) && IN(p0 + 3)) { LAUNDER(); PSTART(3);
            GridSched S{(const char*)(F.ws + WS_Y), (const char*)(F.ws + WS_PT), 32, 8, DM, F.G, (int)blockIdx.x};
            EpiMerge E{(const bf16*)(F.ws + WS_GH), (const bf16*)(F.ws + WS_GS), (bf16*)(F.ws + WS_MERGED)};
            REP(3) pg8::gemm_phase<EpiMerge, GridSched>(F.lds, DM, S, E, F.tid);
        }
        PEND(3); SEAM(p0 + 3); PBAR(3);
        if (ON(4) && IN(p0 + 4)) { LAUNDER(); PSTART(4);
            GridSched S{(const char*)(F.ws + WS_MERGED), (const char*)(F.ws + WS_WOT), 32, 8, DM, F.G, (int)blockIdx.x};
            EpiResid E{l == 0 ? inp(F, I_X) : (const float*)(F.ws + WS_XR), (float*)(F.ws + WS_XR)};
            pg8::gemm_phase<EpiResid, GridSched>(F.lds, DM, S, E, F.tid);
        }
        PEND(4); SEAM(p0 + 4); PBAR(4);
        if (ON(5) && IN(p0 + 5)) { LAUNDER(); PSTART(5); for (int tb = F.vcu * 32; tb < SEQ; tb += F.G * 32) route_block(F, l, tb); }
        PEND(5); SEAM(p0 + 5); PBAR(5);
        if (ON(6) && IN(p0 + 6)) { LAUNDER(); PSTART(6);
            moe_tables(F, l);
            MoeSched1 S{(const LAS int*)(F.lds + MISC_OFF + 128), (const char*)(F.ws + WS_XN), (const char*)(F.ws + WS_WGU), (const int*)(F.ws + WS_LISTS), F.G, F.vcu};
            EpiMoe1 E{(bf16*)(F.ws + WS_ACT), (const float*)(F.ws + WS_LISTS + 512 * 1024), (const float*)(F.ws + WS_LISTS + 1 * MiB + 512 * 1024)};
            REP(6) pg8::gemm_phase<EpiMoe1, MoeSched1>(F.lds, DM, S, E, F.tid);
        }
        PEND(6); SEAM(p0 + 6); PBAR(6);
        if (ON(7) && IN(p0 + 7)) { LAUNDER(); PSTART(7);
            moe_tables(F, l);
            MoeSched2 S{(const LAS int*)(F.lds + MISC_OFF + 128), (const char*)(F.ws + WS_ACT), (const char*)(F.ws + WS_WD), F.G, F.vcu};
            EpiMoe2 E{(bf16*)(F.ws + WS_MOEOUT)};
            REP(7) pg8::gemm_phase<EpiMoe2, MoeSched2>(F.lds, DEXP, S, E, F.tid);
        }
        PEND(7); SEAM(p0 + 7); PBAR(7);
    }
    if (ON(8) && IN(16)) { LAUNDER(); PSTART(8); for (int m = gw; m < SEQ; m += 2 * NGW) norm_rows<1, true, 2>(F, m, NGW, nullptr, inp(F, I_GFINAL), F.ctl + CW_CNT + 64 * 16 * (DEPTH - 1), F.out); }
    PEND(8);
    if (PROBE_K >= 0 && PR_ME) { const unsigned long long t0 = __builtin_amdgcn_s_memrealtime(), amt = pr[1] * PROBE_AMP; while (__builtin_amdgcn_s_memrealtime() - t0 < amt) __builtin_amdgcn_s_sleep(8); }
#undef IN
#undef SEAM
}

#ifndef MK_ONE_LAUNCH
#define MK_ONE_LAUNCH 0
#endif
extern "C" void kernel_launch(void* const* d_in, const int* in_sizes, int n_in, void* d_out, int out_size, void* d_ws, size_t ws_size, hipStream_t stream) {
    static int grid = 0;
    if (grid == 0) {
        if (n_in != 29 || ws_size < WS_END) { fprintf(stderr, "kernel_launch: unexpected n_in %d or ws %zu < %zu\n", n_in, ws_size, (size_t)WS_END); grid = -1; return; }
        int dev = 0, cus = 0, per_cu = 0;
        if (hipGetDevice(&dev) != hipSuccess || hipDeviceGetAttribute(&cus, hipDeviceAttributeMultiprocessorCount, dev) != hipSuccess) { grid = -1; return; }
        if (hipFuncSetAttribute((const void*)fwd_kernel, hipFuncAttributeMaxDynamicSharedMemorySize, LDS_BYTES) != hipSuccess) { fprintf(stderr, "kernel_launch: hipFuncSetAttribute failed\n"); grid = -1; return; }
        if (hipOccupancyMaxActiveBlocksPerMultiprocessor(&per_cu, (const void*)fwd_kernel, NTHR, LDS_BYTES) != hipSuccess || per_cu < 1) fprintf(stderr, "kernel_launch: occupancy query reports %d\n", per_cu);
        (void)hipGetLastError();
        grid = cus;
    }
    if (grid < 0) return;
    (void)hipMemsetAsync((char*)d_ws + WS_CTL, 0, CTL_ZERO_BYTES, stream);
    Args a{};
    for (int i = 0; i < 29; ++i) a.in[i] = (const float*)d_in[i];
    a.out = (float*)d_out; a.ws = (unsigned char*)d_ws;
#if MK_ONE_LAUNCH
    a.ph_lo = 0; a.ph_hi = NPHASE;
    hipLaunchKernelGGL(fwd_kernel, dim3(grid), dim3(NTHR), LDS_BYTES, stream, a);
#else
    for (int p = 0; p < NPHASE; ++p) { a.ph_lo = p; a.ph_hi = p + 1; hipLaunchKernelGGL(fwd_kernel, dim3(grid), dim3(NTHR), LDS_BYTES, stream, a); }
#endif
}
```

```cpp
#include <hip/hip_runtime.h>
#include <cstdio>
#include <cstdint>
#define MK_ONE_LAUNCH 1
#define DUP_MASK 0
#define PROBE_K -1
#define PROBE_PART 0
namespace pg8 {
#define PG8_LAS __attribute__((address_space(3)))
typedef unsigned short bf16_t;
typedef short bf16x8 __attribute__((ext_vector_type(8)));
typedef float f32x4 __attribute__((ext_vector_type(4)));
typedef float f32x2 __attribute__((ext_vector_type(2)));
typedef unsigned u32x4 __attribute__((ext_vector_type(4)));
typedef unsigned u32x2 __attribute__((ext_vector_type(2)));
constexpr int BM = 256, BK = 64, HALF = 128, HTB = HALF * BK * 2  , STAGE_BYTES = 8 * HTB;
constexpr int GATHER_SLOT_OFF = 2 * 8448 * 8 + 1024;

__host__ __device__ __forceinline__ int lds_byte(int r, int c) { const int st = (r >> 4) * 2 + (c >> 5), rr = r & 15, cc = c & 31, ob = rr * 64 + cc * 2; return st * 1024 + (ob ^ (((ob >> 9) & 1) << 5)); }
__host__ __device__ __forceinline__ void stage_rc(int b, int& R, int& C) { const int st = b / 1024, sb = b % 1024, swz = sb ^ (((sb >> 9) & 1) << 5); R = (st >> 1) * 16 + swz / 64; C = (st & 1) * 32 + (swz % 64) / 2; }
__host__ __device__ __forceinline__ int perm32(int rho) { const int n = rho >> 4, i = rho & 15; return 8 * (i >> 2) + 4 * n + (i & 3); }

struct Unit { int pm, pn, kind, e, row0, nvalid; };

__device__ __forceinline__ unsigned cvt_pk_bf16(float lo, float hi) { unsigned r; asm volatile("v_cvt_pk_bf16_f32 %0, %1, %2" : "=v"(r) : "v"(lo), "v"(hi)); return r; }
__device__ __forceinline__ f32x2 gelu_pk(f32x2 v) {
    const f32x2 av = __builtin_elementwise_abs(v), d = av * 0.2316418882f + 1.0f;
    f32x2 t; t.x = __builtin_amdgcn_rcpf(d.x); t.y = __builtin_amdgcn_rcpf(d.y);
    f32x2 q = t * 0.5307027145f + (-0.7265760135f); q = q * t + 0.7107068705f; q = q * t + (-0.142248368f); q = q * t + 0.127414796f; q = q * t;
    const f32x2 s = (v * v) * (-0.72134752044f);
    f32x2 e; e.x = __builtin_amdgcn_exp2f(s.x); e.y = __builtin_amdgcn_exp2f(s.y);
    const f32x2 m = v * (q * e), r = v - m;
    f32x2 o; o.x = v.x < 0.f ? m.x : r.x; o.y = v.y < 0.f ? m.y : r.y; return o;
}
__device__ __forceinline__ float sigmoid_f(float x) { return __builtin_amdgcn_rcpf(1.0f + __builtin_amdgcn_exp2f(-1.4426950408889634f * x)); }

template <class Epi, class Sched>
__device__ __forceinline__ void gemm_phase(PG8_LAS unsigned char* lds, const int K, const Sched& S, const Epi& E, int tid) {
    asm volatile("" : "+v"(tid));
    const int wid = __builtin_amdgcn_readfirstlane(tid >> 6), lane = tid & 63, wr = wid >> 2, wc = wid & 3, fr = lane & 15, fq = lane >> 4;
    const int nt = K / BK;
    unsigned voffA[2], voffB[2];
#pragma unroll
    for (int i = 0; i < 2; ++i) { int R, C; stage_rc(tid * 16 + i * 8192, R, C); const int Rb = Epi::PERM ? ((R & ~31) + perm32(R & 31)) : R;
        voffA[i] = Sched::GATHER ? 0u : (unsigned)(R * K + C) * 2u; voffB[i] = (unsigned)(Rb * K + C) * 2u; }
#define PG8_GOFF(u, h, i) ({ int _R, _C, _t = tid; asm volatile("" : "+v"(_t)); stage_rc(_t * 16 + (i) * 8192, _R, _C); S.a_goff((u), (h) * HALF + _R) + (unsigned)(_C * 2); })
    const size_t kstep = (size_t)(BK * 2);
    const size_t hstep = (size_t)HALF * K * 2;
    const unsigned ldsw = (unsigned)wid * 1024u;
    const int aoff = lds_byte(wr * 64 + fr, fq * 8), boff = lds_byte(wc * 32 + fr, fq * 8);
#define PG8_SA(b, h) (((b) * 2 + (h)) * HTB)
#define PG8_SB(b, h) ((4 + (b) * 2 + (h)) * HTB)
#define PG8_STAGE(bufoff, gbase, voff) do { _Pragma("unroll") for (int _i = 0; _i < 2; ++_i) \
        __builtin_amdgcn_global_load_lds((const unsigned*)((const char*)(gbase) + (voff)[_i]), (PG8_LAS unsigned*)(lds + (bufoff) + ldsw + _i * 8192), 16, 0, 0); } while (0)
#define PG8_STAGE_A(bufoff, gbase, h, GO) do { if constexpr (Sched::GATHER) { _Pragma("unroll") for (int _i = 0; _i < 2; ++_i) \
        __builtin_amdgcn_global_load_lds((const unsigned*)((const char*)(gbase) + (GO)[h][_i]), (PG8_LAS unsigned*)(lds + (bufoff) + ldsw + _i * 8192), 16, 0, 0); } \
        else { PG8_STAGE(bufoff, (gbase) + (h) * hstep, voffA); } } while (0)
#define PG8_LDA(dst, b, h) do { _Pragma("unroll") for (int m = 0; m < 4; ++m) _Pragma("unroll") for (int k = 0; k < 2; ++k) dst[m][k] = *(const PG8_LAS bf16x8*)(lds + PG8_SA(b, h) + aoff + m * 2048 + k * 1024); } while (0)
#define PG8_LDB(dst, b, h) do { _Pragma("unroll") for (int n = 0; n < 2; ++n) _Pragma("unroll") for (int k = 0; k < 2; ++k) dst[n][k] = *(const PG8_LAS bf16x8*)(lds + PG8_SB(b, h) + boff + n * 2048 + k * 1024); } while (0)
#define PG8_MMA(ai, bj, At, Bt) do { __builtin_amdgcn_s_setprio(1); _Pragma("unroll") for (int m = 0; m < 4; ++m) _Pragma("unroll") for (int n = 0; n < 2; ++n) _Pragma("unroll") for (int k = 0; k < 2; ++k) \
        acc[ai][bj][m][n] = __builtin_amdgcn_mfma_f32_16x16x32_bf16(Bt[n][k], At[m][k], acc[ai][bj][m][n], 0, 0, 0); __builtin_amdgcn_s_setprio(0); } while (0)
#define PG8_WAIT_V(n) asm volatile("s_waitcnt vmcnt(" #n ")" ::: "memory")
#define PG8_WAIT_L(n) asm volatile("s_waitcnt lgkmcnt(" #n ")" ::: "memory")
#define PG8_BAR __builtin_amdgcn_s_barrier()
#define PG8_SCHED __builtin_amdgcn_sched_barrier(0)
    Unit cur, nxt; int ui = 0;
    if (!S.next(0, cur)) return;
    f32x4 acc[2][2][4][2];
#pragma unroll
    for (int a = 0; a < 2; ++a)
#pragma unroll
        for (int b = 0; b < 2; ++b)
#pragma unroll
            for (int m = 0; m < 4; ++m)
#pragma unroll
                for (int n = 0; n < 2; ++n) acc[a][b][m][n] = (f32x4){0.f, 0.f, 0.f, 0.f};
    bf16x8 At[4][2], B0[2][2], B1[2][2];
    const char* cA = S.a_base(cur); const char* cB = S.b_base(cur);
    unsigned cgo[2][2];
    PG8_LAS u32x4* gslot = (PG8_LAS u32x4*)(lds + GATHER_SLOT_OFF) + tid;
    if constexpr (Sched::GATHER) {
#pragma unroll
        for (int h = 0; h < 2; ++h)
#pragma unroll
            for (int i = 0; i < 2; ++i) cgo[h][i] = PG8_GOFF(cur, h, i);
    }
    PG8_STAGE(PG8_SB(0, 0), cB, voffB); PG8_STAGE(PG8_SB(0, 1), cB + hstep, voffB); PG8_STAGE_A(PG8_SA(0, 0), cA, 0, cgo); PG8_STAGE_A(PG8_SA(0, 1), cA, 1, cgo);
    if (wr == 1) PG8_BAR;
    PG8_WAIT_V(2); PG8_BAR;
    PG8_STAGE(PG8_SB(1, 0), cB + kstep, voffB); PG8_STAGE_A(PG8_SA(1, 0), cA + kstep, 0, cgo); PG8_STAGE(PG8_SB(1, 1), cB + hstep + kstep, voffB);
    PG8_WAIT_V(6); PG8_BAR;
    for (;;) {
        const bool has_next = S.next(ui + 1, nxt);
        const char* nA = has_next ? S.a_base(nxt) : cA; const char* nB = has_next ? S.b_base(nxt) : cB;
        if constexpr (Sched::GATHER) {
            u32x4 nx = (u32x4){cgo[0][0], cgo[0][1], cgo[1][0], cgo[1][1]};
            if (has_next) { nx.x = PG8_GOFF(nxt, 0, 0); nx.y = PG8_GOFF(nxt, 0, 1); nx.z = PG8_GOFF(nxt, 1, 0); nx.w = PG8_GOFF(nxt, 1, 1); }
            *gslot = nx;
        }
        for (int t = 0; t < nt; t += 2) {
            const bool last = (t == nt - 2);
            if constexpr (Epi::MIDK) { if (t == (nt >> 1)) { int tl = tid; asm volatile("" : "+v"(tl)); E.mid(acc, cur, wr, wc, tl & 15, (tl >> 4) & 3); } }
            const char* a1 = cA + (size_t)(t + 1) * kstep;
            const char* a2 = last ? nA : cA + (size_t)(t + 2) * kstep; const char* b2 = last ? nB : cB + (size_t)(t + 2) * kstep;
            const char* a3 = a2 + kstep; const char* b3 = b2 + kstep;
            unsigned xgo[2][2];
            if constexpr (Sched::GATHER) {
                if (last) { const u32x4 nx = *gslot; xgo[0][0] = nx.x; xgo[0][1] = nx.y; xgo[1][0] = nx.z; xgo[1][1] = nx.w; }
                else { xgo[0][0] = cgo[0][0]; xgo[0][1] = cgo[0][1]; xgo[1][0] = cgo[1][0]; xgo[1][1] = cgo[1][1]; }
            }
            PG8_LDB(B0, 0, 0); PG8_LDB(B1, 0, 1); PG8_SCHED; PG8_LDA(At, 0, 0); PG8_STAGE_A(PG8_SA(1, 1), a1, 1, cgo);
            PG8_WAIT_V(8); PG8_WAIT_L(0); PG8_BAR; PG8_MMA(0, 0, At, B0); PG8_MMA(0, 1, At, B1); PG8_BAR; PG8_SCHED;
            PG8_LDA(At, 0, 1); PG8_STAGE(PG8_SB(0, 0), b2, voffB); PG8_STAGE(PG8_SB(0, 1), b2 + hstep, voffB); PG8_STAGE_A(PG8_SA(0, 0), a2, 0, xgo);
            PG8_WAIT_V(8); PG8_WAIT_L(0); PG8_BAR; PG8_MMA(1, 0, At, B0); PG8_MMA(1, 1, At, B1); PG8_BAR; PG8_SCHED;
            PG8_LDB(B0, 1, 0); PG8_LDB(B1, 1, 1); PG8_SCHED; PG8_LDA(At, 1, 0); PG8_STAGE_A(PG8_SA(0, 1), a2, 1, xgo);
            PG8_WAIT_V(8); PG8_WAIT_L(0); PG8_BAR; PG8_MMA(0, 0, At, B0); PG8_MMA(0, 1, At, B1); PG8_BAR; PG8_SCHED;
            PG8_LDA(At, 1, 1); PG8_STAGE(PG8_SB(1, 0), b3, voffB); PG8_STAGE(PG8_SB(1, 1), b3 + hstep, voffB); PG8_STAGE_A(PG8_SA(1, 0), a3, 0, xgo);
            PG8_WAIT_V(8); PG8_WAIT_L(0); PG8_BAR; PG8_MMA(1, 0, At, B0); PG8_MMA(1, 1, At, B1); PG8_BAR; PG8_SCHED;
        }
        if (wr == 0) PG8_BAR;
        { int tl = tid; asm volatile("" : "+v"(tl)); E(acc, cur, wr, wc, tl & 15, (tl >> 4) & 3); }
        if (!has_next) break;
#pragma unroll
        for (int a = 0; a < 2; ++a)
#pragma unroll
            for (int b = 0; b < 2; ++b)
#pragma unroll
                for (int m = 0; m < 4; ++m)
#pragma unroll
                    for (int n = 0; n < 2; ++n) acc[a][b][m][n] = (f32x4){0.f, 0.f, 0.f, 0.f};
        cur = nxt; cA = nA; cB = nB; ++ui;
        if constexpr (Sched::GATHER) { const u32x4 nx = *gslot; cgo[0][0] = nx.x; cgo[0][1] = nx.y; cgo[1][0] = nx.z; cgo[1][1] = nx.w; }
        if (wr == 1) PG8_BAR;
    }
    PG8_WAIT_V(0);
    PG8_BAR;
#undef PG8_SA
#undef PG8_SB
#undef PG8_STAGE
#undef PG8_STAGE_A
#undef PG8_GOFF
#undef PG8_LDA
#undef PG8_LDB
#undef PG8_MMA
#undef PG8_WAIT_V
#undef PG8_WAIT_L
#undef PG8_BAR
#undef PG8_SCHED
}
}
constexpr int NWAVES = 8, NTHR = 512;
constexpr int SEQ = 8192, DM = 2048, NIN = 9216, HYW = 1024, SGW = 1024, NHY = 3072, NEXP = 16, DEXP = 512, DEPTH = 2;
constexpr float EPS = 1e-6f;
constexpr size_t MiB = 1u << 20;
constexpr size_t WS_CTL = 0, CTL_ZERO_BYTES = 1 * MiB;
constexpr size_t WS_WIN = 1 * MiB;
constexpr size_t WS_WIN2 = WS_WIN + 36 * MiB;
constexpr size_t WS_PT = WS_WIN2 + 36 * MiB;
constexpr size_t WS_WOT = WS_PT + 8 * MiB;
constexpr size_t WS_WGU = WS_WOT + 8 * MiB;
constexpr size_t WS_WD = WS_WGU + 64 * MiB;
constexpr size_t WS_W3T = WS_WD + 32 * MiB;
constexpr size_t WS_A2 = WS_W3T + 1 * MiB;
constexpr size_t WS_WR = WS_A2 + 1 * MiB;
constexpr size_t WS_LISTS = WS_WR + 1 * MiB;
constexpr size_t WS_XR = WS_LISTS + 2 * MiB;
constexpr size_t WS_XN = WS_XR + 64 * MiB;
constexpr size_t WS_ZT = WS_XN + 32 * MiB;
constexpr size_t WS_U = WS_ZT + 48 * MiB;
constexpr size_t WS_GV = WS_U + 16 * MiB;
constexpr size_t WS_GH = WS_GV + 16 * MiB;
constexpr size_t WS_GS = WS_GH + 32 * MiB;
constexpr size_t WS_Y = WS_GS + 32 * MiB;
constexpr size_t WS_FS = WS_Y + 32 * MiB;
constexpr size_t WS_END = WS_FS + 64 * MiB;
constexpr size_t WS_MERGED = WS_ZT, WS_ACT = WS_U, WS_MOEOUT = WS_FS;
constexpr int CW_TMO = 0;
constexpr int CW_CNT = 8192;
constexpr int CW_BAR = 4096;
constexpr int SCRATCH_BYTES = 2 * 8448 * 8;
constexpr int MISC_OFF = SCRATCH_BYTES;
constexpr int CVS_OFF = MISC_OFF + 1024;
constexpr int LDS_BYTES = SCRATCH_BYTES + 1024 + 8 * 2112;
static_assert(pg8::GATHER_SLOT_OFF == MISC_OFF + 1024, "gather slots");
static_assert(SCRATCH_BYTES >= pg8::STAGE_BYTES, "lds");

#define GAS __attribute__((address_space(1)))
#define LAS __attribute__((address_space(3)))
typedef unsigned short bf16;
typedef unsigned v4u __attribute__((ext_vector_type(4)));
typedef unsigned v2u __attribute__((ext_vector_type(2)));
typedef float f32x4 __attribute__((ext_vector_type(4)));
typedef short bf16x8 __attribute__((ext_vector_type(8)));
typedef GAS unsigned gu32;
#define RLX_AGENT __ATOMIC_RELAXED, __HIP_MEMORY_SCOPE_AGENT
#define LDS_WAIT() asm volatile("s_waitcnt lgkmcnt(0)" ::: "memory")
#define VM_WAIT() asm volatile("s_waitcnt vmcnt(0)" ::: "memory")
__device__ __forceinline__ unsigned f2bf(float f) { unsigned u = __builtin_bit_cast(unsigned, f); return (u + 0x7fffu + ((u >> 16) & 1u)) >> 16; }
__device__ __forceinline__ unsigned pk2(float lo, float hi) { return f2bf(lo) | (f2bf(hi) << 16); }
__device__ __forceinline__ float bfl(unsigned u) { return __builtin_bit_cast(float, u << 16); }
__device__ __forceinline__ float bfh(unsigned u) { return __builtin_bit_cast(float, u & 0xffff0000u); }

#define XB_TMO      128
#define XB_XCNT(j)  (256  + 64 * (j))
#define XB_XSUB(j)  (1280 + 64 * (j))
#define XB_XGEN(j)  (2304 + 64 * (j))
#define XB_TOP      3328
#define XB_TOPGEN   3392
#define XCD_BAR_WORDS 3456
#define XB_SPIN_CAP (1u << 18)
__device__ __forceinline__ unsigned xb_ld(unsigned* p)              { return __hip_atomic_load(p, __ATOMIC_RELAXED, __HIP_MEMORY_SCOPE_AGENT); }
__device__ __forceinline__ unsigned xb_add(unsigned* p, unsigned v) { return __hip_atomic_fetch_add(p, v, __ATOMIC_RELAXED, __HIP_MEMORY_SCOPE_AGENT); }
__device__ __forceinline__ unsigned xb_xcc_id() { return (unsigned)__builtin_amdgcn_s_getreg((3 << 11) | 20) & 0xFu; }
#define XB_SPIN(cond, bar) do { unsigned _sp = 0; while (cond) { __builtin_amdgcn_s_sleep(1); \
    if ((++_sp & 255u) == 0u) { if (xb_ld(&(bar)[XB_TMO])) break; if (_sp > XB_SPIN_CAP) { atomicAdd(&(bar)[XB_TMO], 1u); break; } } } } while (0)
struct XcdBarrier { unsigned* bar; unsigned x; volatile LAS unsigned* st; };
__device__ __forceinline__ XcdBarrier xcd_barrier_post(unsigned* bar, volatile LAS unsigned* st) {
    XcdBarrier b; b.bar = bar; b.x = xb_xcc_id(); b.st = st;
    if (threadIdx.x == 0) (void)xb_add(&bar[XB_XCNT(b.x)], 1u);
    return b;
}
__device__ __forceinline__ void xcd_barrier_complete(unsigned* bar, unsigned x, unsigned& nloc, unsigned& nx) {
    const unsigned G = gridDim.x * gridDim.y * gridDim.z;
    unsigned sum, cnt, mine, sp = 0u;
    for (;;) {
        sum = 0u; cnt = 0u; mine = 0u;
#pragma unroll
        for (unsigned j = 0; j < 16; ++j) { const unsigned c = xb_ld(&bar[XB_XCNT(j)]); sum += c; cnt += (c > 0u) ? 1u : 0u; mine = (j == x) ? c : mine; }
        if (sum == G) break;
        __builtin_amdgcn_s_sleep(1);
        if ((++sp & 255u) == 0u) { if (xb_ld(&bar[XB_TMO])) break; if (sp > XB_SPIN_CAP) { atomicAdd(&bar[XB_TMO], 1u); break; } }
    }
    nloc = mine > 0u ? mine : 1u; nx = cnt > 0u ? cnt : 1u;
}
__device__ __forceinline__ void xcd_barrier(const XcdBarrier& b) {
    asm volatile("s_waitcnt vmcnt(0)" ::: "memory");
    __syncthreads();
    if (threadIdx.x == 0) {
        unsigned* bar = b.bar;
        __builtin_amdgcn_s_waitcnt(0);
        unsigned nloc = b.st[0], nx = b.st[1];
        if (nloc == 0u) { xcd_barrier_complete(bar, b.x, nloc, nx); b.st[0] = nloc; b.st[1] = nx; }
        const unsigned old = xb_add(&bar[XB_XSUB(b.x)], 1u);
        const unsigned gen = old / nloc;
        if (old + 1u == (gen + 1u) * nloc) {
            __builtin_amdgcn_fence(__ATOMIC_RELEASE, "agent");
            asm volatile("s_waitcnt vmcnt(0)" ::: "memory");
            const unsigned og = xb_add(&bar[XB_TOP], 1u);
            const unsigned tg = og / nx;
            if (og + 1u == (tg + 1u) * nx) xb_add(&bar[XB_TOPGEN], 1u);
            else XB_SPIN(xb_ld(&bar[XB_TOPGEN]) == tg, bar);
            __builtin_amdgcn_fence(__ATOMIC_ACQUIRE, "agent");
            xb_add(&bar[XB_XGEN(b.x)], 1u);
            asm volatile("s_waitcnt vmcnt(0)" ::: "memory");
        } else {
            XB_SPIN(xb_ld(&bar[XB_XGEN(b.x)]) == gen, bar);
            __builtin_amdgcn_fence(__ATOMIC_ACQUIRE, "agent");
            asm volatile("s_waitcnt vmcnt(0)" ::: "memory");
        }
    }
    __syncthreads();
}

struct Frame {
    LAS unsigned char* lds;
    volatile LAS unsigned* MISC;
    gu32* ctl;
    int tid, lane, wave;
    int vcu, G;
    const LAS unsigned long long* inp;
    float* out;
    unsigned char* ws;
};
enum { I_X = 0, I_GMIX, I_WIN, I_BIN, I_CONVW, I_CONVB, I_FW1, I_FB1, I_FW2, I_FB2, I_FW3, I_FFREQ, I_SKIP, I_LNG, I_LNB, I_SGW, I_SGB, I_WHY, I_WSG, I_WOUT, I_GFFN, I_WRG, I_BRG, I_WRE, I_BRE, I_WGATE, I_WUP, I_WDOWN, I_GFINAL };

__device__ __forceinline__ const float* inp(const Frame& F, int k) { const unsigned long long v = F.inp[k]; const unsigned lo = __builtin_amdgcn_readfirstlane((unsigned)v), hi = __builtin_amdgcn_readfirstlane((unsigned)(v >> 32));
    return (const float*)(((unsigned long long)hi << 32) | (unsigned long long)lo); }
__device__ __forceinline__ float shfl_xor_l(float v, int mask, int lane) { return __builtin_bit_cast(float, __builtin_amdgcn_ds_bpermute((lane ^ mask) << 2, __builtin_bit_cast(int, v))); }
__device__ __forceinline__ float shfl_down1_l(float v, int lane) { return __builtin_bit_cast(float, __builtin_amdgcn_ds_bpermute(((lane + 1) & 63) << 2, __builtin_bit_cast(int, v))); }
__device__ __forceinline__ float wave_sum(float v, int lane) {
#pragma unroll
    for (int o = 1; o < 64; o <<= 1) v += shfl_xor_l(v, o, lane);
    return v;
}

#ifndef PROBE_K
#define PROBE_K -1
#endif
#define HP_ME (blockIdx.x == 0 && threadIdx.x == 0)
#define HPS(j) do { if (PROBE_K == (j) && HP_ME) ((volatile LAS unsigned long long*)(F.lds + MISC_OFF + 512))[0] = __builtin_amdgcn_s_memrealtime(); } while (0)
#define HPE(j) do { if (PROBE_K == (j) && HP_ME) { volatile LAS unsigned long long* _p = (volatile LAS unsigned long long*)(F.lds + MISC_OFF + 512); _p[1] += __builtin_amdgcn_s_memrealtime() - _p[0]; } } while (0)
#define HD __device__ __forceinline__
#define HY_OPAQUE(x) asm volatile("" : "+v"(x))
typedef float hy_f2v __attribute__((ext_vector_type(2)));
#define LDC(p, i) ({ const hy_f2v _v = *(const LAS hy_f2v*)((p) + (i)); c32 _r; _r.x = _v.x; _r.y = _v.y; _r; })
#define STC(p, i, v) do { const c32 _s = (v); hy_f2v _w; _w.x = _s.x; _w.y = _s.y; *(LAS hy_f2v*)((p) + (i)) = _w; } while (0)
#define FADD(a, b) ({ float _r; asm("v_add_f32 %0, %1, %2" : "=v"(_r) : "v"((float)(a)), "v"((float)(b))); _r; })
#define FSUB(a, b) ({ float _r; asm("v_sub_f32 %0, %1, %2" : "=v"(_r) : "v"((float)(a)), "v"((float)(b))); _r; })
#define FMUL(a, b) ({ float _r; asm("v_mul_f32 %0, %1, %2" : "=v"(_r) : "v"((float)(a)), "v"((float)(b))); _r; })
#define FFMA(a, b, c) ({ float _r; asm("v_fma_f32 %0, %1, %2, %3" : "=v"(_r) : "v"((float)(a)), "v"((float)(b)), "v"((float)(c))); _r; })
#define FNMA(a, b, c) ({ float _r; asm("v_fma_f32 %0, -%1, %2, %3" : "=v"(_r) : "v"((float)(a)), "v"((float)(b)), "v"((float)(c))); _r; })
struct c32 { float x, y; };
HD c32 cmk(float x, float y) { c32 r; r.x = x; r.y = y; return r; }
HD c32 cadd(c32 a, c32 b) { return cmk(FADD(a.x, b.x), FADD(a.y, b.y)); }
HD c32 csub(c32 a, c32 b) { return cmk(FSUB(a.x, b.x), FSUB(a.y, b.y)); }
HD c32 cmul(c32 a, c32 b) { return cmk(FNMA(a.y, b.y, FMUL(a.x, b.x)), FFMA(a.y, b.x, FMUL(a.x, b.y))); }
HD c32 cmulc(c32 a, c32 b) { return cmk(FFMA(a.y, b.y, FMUL(a.x, b.x)), FNMA(a.x, b.y, FMUL(a.y, b.x))); }
HD c32 cscale(c32 a, float f) { return cmk(FMUL(a.x, f), FMUL(a.y, f)); }
HD c32 cadd_mi(c32 a, c32 b) { return cmk(FADD(a.x, b.y), FSUB(a.y, b.x)); }
HD c32 cadd_pi(c32 a, c32 b) { return cmk(FSUB(a.x, b.y), FADD(a.y, b.x)); }
#define HY_N 8192
#define HY_LDS_C32 (8192 + 256)

template <int SIGN> HD void dft4(c32& a, c32& b, c32& c, c32& d) {
    const c32 t0 = cadd(a, c), t1 = csub(a, c), t2 = cadd(b, d), t3 = csub(b, d);
    a = cadd(t0, t2); c = csub(t0, t2);
    if (SIGN < 0) { b = cadd_mi(t1, t3); d = cadd_pi(t1, t3); }
    else          { b = cadd_pi(t1, t3); d = cadd_mi(t1, t3); }
}
template <int SIGN> HD void dft16(c32 (&a)[16]) {
    const float C1 = 0.92387953251128674f, S1 = 0.38268343236508977f, R2 = 0.70710678118654752f;
#pragma unroll
    for (int n2 = 0; n2 < 4; ++n2) dft4<SIGN>(a[n2], a[4 + n2], a[8 + n2], a[12 + n2]);
    const float sg = (SIGN < 0) ? -1.f : 1.f;
    const c32 w1 = cmk(C1, sg * S1), w2 = cmk(R2, sg * R2), w3 = cmk(S1, sg * C1), w6 = cmk(-R2, sg * R2), w9 = cmk(-C1, -sg * S1);
    a[1 + 4] = cmul(a[1 + 4], w1); a[2 + 4] = cmul(a[2 + 4], w2); a[3 + 4] = cmul(a[3 + 4], w3);
    a[1 + 8] = cmul(a[1 + 8], w2); a[2 + 8] = (SIGN < 0) ? cmk(a[2 + 8].y, -a[2 + 8].x) : cmk(-a[2 + 8].y, a[2 + 8].x); a[3 + 8] = cmul(a[3 + 8], w6);
    a[1 + 12] = cmul(a[1 + 12], w3); a[2 + 12] = cmul(a[2 + 12], w6); a[3 + 12] = cmul(a[3 + 12], w9);
#pragma unroll
    for (int k1 = 0; k1 < 4; ++k1) dft4<SIGN>(a[4 * k1], a[4 * k1 + 1], a[4 * k1 + 2], a[4 * k1 + 3]);
    c32 t[16];
#pragma unroll
    for (int i = 0; i < 16; ++i) t[i] = a[i];
#pragma unroll
    for (int k1 = 0; k1 < 4; ++k1)
#pragma unroll
        for (int k2 = 0; k2 < 4; ++k2) a[k1 + 4 * k2] = t[4 * k1 + k2];
}
HD void twiddle_tree(c32 (&a)[16], c32 w1) {
    const c32 w2 = cmul(w1, w1), w3 = cmul(w2, w1), w4 = cmul(w2, w2), w5 = cmul(w4, w1), w6 = cmul(w4, w2), w7 = cmul(w4, w3), w8 = cmul(w4, w4);
    a[1] = cmul(a[1], w1); a[2] = cmul(a[2], w2); a[3] = cmul(a[3], w3); a[4] = cmul(a[4], w4); a[5] = cmul(a[5], w5); a[6] = cmul(a[6], w6); a[7] = cmul(a[7], w7); a[8] = cmul(a[8], w8);
    a[9] = cmul(a[9], cmul(w8, w1)); a[10] = cmul(a[10], cmul(w8, w2)); a[11] = cmul(a[11], cmul(w8, w3)); a[12] = cmul(a[12], cmul(w8, w4));
    a[13] = cmul(a[13], cmul(w8, w5)); a[14] = cmul(a[14], cmul(w8, w6)); a[15] = cmul(a[15], cmul(w8, w7));
}
HD c32 cis_pi(float x) { return cmk(cospif(x), sinpif(x)); }

HD void fft_s1_fwd(int tid, LAS c32* buf, c32 (&a)[16]) { HY_OPAQUE(tid);
    dft16<-1>(a);
    twiddle_tree(a, cis_pi(-2.0f * (float)tid / 8192.0f));
    LAS c32* p0 = buf + tid + (tid >> 5);
#pragma unroll
    for (int p = 0; p < 16; ++p) STC(p0, 528 * p, a[p]);
}
HD void fft_s2_fwd(int tid, LAS c32* buf) { HY_OPAQUE(tid);
    LAS c32* p0 = buf + (tid >> 5) * 528 + (tid & 31);
    c32 a[16];
#pragma unroll
    for (int q = 0; q < 16; ++q) a[q] = LDC(p0, 33 * q);
    dft16<-1>(a);
    twiddle_tree(a, cis_pi(-2.0f * (float)(tid & 31) / 512.0f));
#pragma unroll
    for (int p = 0; p < 16; ++p) STC(p0, 33 * p, a[p]);
}
HD float w32c(int q) { switch (q) { case 0: return 1.0f; case 1: return 0.98078528040323043f; case 2: return 0.92387953251128674f; case 3: return 0.83146961230254524f; case 4: return 0.70710678118654752f; case 5: return 0.55557023301960218f; case 6: return 0.38268343236508977f; case 7: return 0.19509032201612825f;
    case 8: return 0.0f; case 9: return -0.19509032201612825f; case 10: return -0.38268343236508977f; case 11: return -0.55557023301960218f; case 12: return -0.70710678118654752f; case 13: return -0.83146961230254524f; case 14: return -0.92387953251128674f; default: return -0.98078528040323043f; } }
HD float w32s(int q) { switch (q) { case 0: return 0.0f; case 1: return 0.19509032201612825f; case 2: return 0.38268343236508977f; case 3: return 0.55557023301960218f; case 4: return 0.70710678118654752f; case 5: return 0.83146961230254524f; case 6: return 0.92387953251128674f; case 7: return 0.98078528040323043f;
    case 8: return 1.0f; case 9: return 0.98078528040323043f; case 10: return 0.92387953251128674f; case 11: return 0.83146961230254524f; case 12: return 0.70710678118654752f; case 13: return 0.55557023301960218f; case 14: return 0.38268343236508977f; default: return 0.19509032201612825f; } }
template <int SIGN> HD void fft_s3_read(int tid, const LAS c32* buf, c32 (&s)[16]) { HY_OPAQUE(tid);
    const LAS c32* p0 = buf + (tid >> 1) * 33; const int h = tid & 1;
    const float sg = (SIGN < 0) ? -1.f : 1.f, hs = h ? -1.f : 1.f;
#pragma unroll
    for (int q = 0; q < 16; ++q) {
        const c32 u = LDC(p0, q), v = LDC(p0, q + 16);
        const c32 d = cmk(FFMA(v.x, hs, u.x), FFMA(v.y, hs, u.y));
        const c32 w = h ? cmk(w32c(q), sg * w32s(q)) : cmk(1.f, 0.f);
        s[q] = (q == 0) ? d : cmul(d, w);
    }
    dft16<SIGN>(s);
}
HD void fft_s3_write(int tid, LAS c32* buf, const c32 (&s)[16]) { HY_OPAQUE(tid);
    LAS c32* p0 = buf + (tid >> 1) * 33 + (tid & 1);
#pragma unroll
    for (int p = 0; p < 16; ++p) STC(p0, 2 * p, s[p]);
}
HD void fft_s2_inv(int tid, LAS c32* buf) { HY_OPAQUE(tid);
    LAS c32* p0 = buf + (tid >> 5) * 528 + (tid & 31);
    c32 a[16];
#pragma unroll
    for (int q = 0; q < 16; ++q) a[q] = LDC(p0, 33 * q);
    twiddle_tree(a, cis_pi(2.0f * (float)(tid & 31) / 512.0f));
    dft16<1>(a);
#pragma unroll
    for (int p = 0; p < 16; ++p) STC(p0, 33 * p, a[p]);
}
HD void fft_s1_inv(int tid, const LAS c32* buf, c32 (&a)[16]) { HY_OPAQUE(tid);
    const LAS c32* p0 = buf + tid + (tid >> 5);
#pragma unroll
    for (int p = 0; p < 16; ++p) a[p] = LDC(p0, 528 * p);
    twiddle_tree(a, cis_pi(2.0f * (float)tid / 8192.0f));
    dft16<1>(a);
}
HD void pair_pass(int tid, LAS c32* Z, const LAS c32* H) { HY_OPAQUE(tid);
    const int p3 = tid & 31;
    const c32 wp3 = cis_pi(-(float)p3 / 32.0f);
    const c32 wstep = cis_pi(-16.0f / 8192.0f);
    c32 wlow = cis_pi(-(float)(tid >> 5) / 8192.0f);
#pragma unroll 1
    for (int it = 0; it < 9; ++it) {
        const int low = it * 16 + (tid >> 5);
        const c32 Wk = cmul(wlow, wp3);
        wlow = cmul(wlow, wstep);
        if (low > 128) continue;
        bool act = true; int p3b = 31 - p3, lowb = 256 - low;
        if (low == 0) { act = p3 <= 16; p3b = (32 - p3) & 31; lowb = 0; }
        else if (low == 128) { act = p3 <= 15; lowb = 128; }
        if (!act) continue;
        const int pa = (low & 15) * 528 + (low >> 4) * 33 + p3, pb = (lowb & 15) * 528 + (lowb >> 4) * 33 + p3b;
        const c32 A = LDC(Z, pa), B = LDC(Z, pb), HA = LDC(H, pa), HB = LDC(H, pb);
        c32 E = cmk(FMUL(FADD(A.x, B.x), 0.5f), FMUL(FSUB(A.y, B.y), 0.5f)), O = cmk(FMUL(FADD(A.y, B.y), 0.5f), FMUL(FSUB(B.x, A.x), 0.5f));
        c32 T = cmul(Wk, O);
        const c32 X = cadd(E, T), Xm = csub(E, T);
        E = cmk(FMUL(FADD(HA.x, HB.x), 0.5f), FMUL(FSUB(HA.y, HB.y), 0.5f)); O = cmk(FMUL(FADD(HA.y, HB.y), 0.5f), FMUL(FSUB(HB.x, HA.x), 0.5f));
        T = cmul(Wk, O);
        const c32 Hk = cadd(E, T), Hm = csub(E, T);
        const c32 Y = cmul(X, Hk), Ypc = cmul(Xm, Hm);
        const float sc = 0.5f / 8192.0f;
        const c32 Ye = cscale(cadd(Y, Ypc), sc), Yd = cscale(csub(Y, Ypc), sc);
        const c32 Yo = cmulc(Yd, Wk);
        STC(Z, pa, cmk(FSUB(Ye.x, Yo.y), FADD(Ye.y, Yo.x)));
        if (pb != pa) STC(Z, pb, cmk(FADD(Ye.x, Yo.y), FSUB(Yo.x, Ye.y)));
    }
}
HD float bf_lo(unsigned u) { unsigned v = u << 16; return __builtin_bit_cast(float, v); }
HD float bf_hi(unsigned u) { unsigned v = u & 0xffff0000u; return __builtin_bit_cast(float, v); }
HD void hy_conv3_load(int tid, const unsigned* zrow, float c0, float c1, float c2, float cb, c32 (&out)[8]) { HY_OPAQUE(tid);
    unsigned wm[8], wl[8], wr[8];
#pragma unroll
    for (int q = 0; q < 8; ++q) { const int m = tid + 512 * q; wm[q] = zrow[m]; wl[q] = (m > 0) ? zrow[m - 1] : 0u; wr[q] = (m < 4095) ? zrow[m + 1] : 0u; }
#pragma unroll
    for (int q = 0; q < 8; ++q) {
        const float zm1 = bf_hi(wl[q]), z0 = bf_lo(wm[q]), z1 = bf_hi(wm[q]), z2 = bf_lo(wr[q]);
        out[q] = cmk(FFMA(c0, zm1, FFMA(c1, z0, FFMA(c2, z1, cb))), FFMA(c0, z0, FFMA(c1, z1, FFMA(c2, z2, cb))));
    }
}
HD void hy_filter_s1(int tid, LAS c32* buf, const unsigned* zk) { HY_OPAQUE(tid);
    unsigned w[16];
#pragma unroll
    for (int q = 0; q < 16; ++q) w[q] = zk[tid + 512 * q];
    c32 a[16];
#pragma unroll
    for (int q = 0; q < 16; ++q) a[q] = cmk(bf_lo(w[q]), bf_hi(w[q]));
    fft_s1_fwd(tid, buf, a);
}
HD void hy_data_s1(int tid, LAS c32* buf, const c32 (&v)[8]) { HY_OPAQUE(tid);
    c32 a[16];
#pragma unroll
    for (int q = 0; q < 8; ++q) a[q] = v[q];
#pragma unroll
    for (int q = 8; q < 16; ++q) a[q] = cmk(0.f, 0.f);
    fft_s1_fwd(tid, buf, a);
}
HD unsigned hy_bf(float f) { unsigned u = __builtin_bit_cast(unsigned, f); return (u + 0x7fffu + ((u >> 16) & 1u)) >> 16; }
HD void hy_pack_store(unsigned* zk, int dir, int a4, float t0, float t1, float t2, float t3) {
    if (dir == 0) { zk[a4 / 2] = hy_bf(t0) | (hy_bf(t1) << 16); zk[a4 / 2 + 1] = hy_bf(t2) | (hy_bf(t3) << 16); }
    else {
        const int m = 8192 - a4 / 2;
        if (a4 > 0) ((unsigned short*)(zk + m))[0] = (unsigned short)hy_bf(t0);
        zk[m - 1] = hy_bf(t2) | (hy_bf(t1) << 16);
        if (a4 == 8188) zk[m - 2] = hy_bf(t3) << 16; else ((unsigned short*)(zk + m - 2))[1] = (unsigned short)hy_bf(t3);
    }
}
struct CvItem { const float* src; int N; bf16* dst; size_t dld; };
constexpr int CV_S0 = 32 * 288, CV_S7 = 128, CV_SA = CV_S0 + CV_S7, CV_S1 = 16 * 64, CV_S3 = 32 * 64, CV_S4 = 16 * 32 * 16, CV_S6 = 16 * 8 * 64;
constexpr int CV_NITEMS = CV_SA + 2 * CV_S1 + CV_S3 + 2 * CV_S4 + CV_S6;
__device__ __forceinline__ void cv_decode_layer(Frame& F, int l, int r, CvItem& d) {
    bf16* WIN = (bf16*)(F.ws + ((l & 1) ? WS_WIN2 : WS_WIN)); bf16* PT = (bf16*)(F.ws + WS_PT); bf16* WOT = (bf16*)(F.ws + WS_WOT); bf16* WGU = (bf16*)(F.ws + WS_WGU); bf16* WD = (bf16*)(F.ws + WS_WD);
    bf16* W3T = (bf16*)(F.ws + WS_W3T + (size_t)(l & 1) * 512 * 1024);
    if (r < CV_S0) { const int kb = r / 288, nb = r % 288; d.src = inp(F, I_WIN) + (size_t)l * DM * NIN + (size_t)(64 * kb) * NIN + 32 * nb; d.N = NIN; d.dst = WIN + (size_t)(32 * nb) * DM + 64 * kb; d.dld = DM; return; } r -= CV_S0;
    if (r < CV_S7) { const int nb = r; d.src = inp(F, I_FW3) + (size_t)l * 64 * 4096 + 32 * nb; d.N = 4096; d.dst = W3T + (size_t)(32 * nb) * 64; d.dld = 64; return; } r -= CV_S7;
    if (r < CV_S1) { const int kb = r / 64, nb = r % 64; d.src = inp(F, I_WHY) + (size_t)l * HYW * DM + (size_t)(64 * kb) * DM + 32 * nb; d.N = DM; d.dst = PT + (size_t)(32 * nb) * DM + 64 * kb; d.dld = DM; return; } r -= CV_S1;
    if (r < CV_S1) { const int kb = r / 64, nb = r % 64; d.src = inp(F, I_WSG) + (size_t)l * SGW * DM + (size_t)(64 * kb) * DM + 32 * nb; d.N = DM; d.dst = PT + (size_t)(32 * nb) * DM + 1024 + 64 * kb; d.dld = DM; return; } r -= CV_S1;
    if (r < CV_S3) { const int kb = r / 64, nb = r % 64; d.src = inp(F, I_WOUT) + (size_t)l * DM * DM + (size_t)(64 * kb) * DM + 32 * nb; d.N = DM; d.dst = WOT + (size_t)(32 * nb) * DM + 64 * kb; d.dld = DM; return; } r -= CV_S3;
    if (r < 2 * CV_S4) { const int up = r / CV_S4; r -= up * CV_S4; const int e = r / 512, q = r % 512, kb = q / 16, nb = q % 16; const int n0 = 32 * nb, drow = 256 * (n0 / 128) + (n0 % 128) + 128 * up;
        d.src = (up ? inp(F, I_WUP) : inp(F, I_WGATE)) + ((size_t)l * NEXP + e) * DM * DEXP + (size_t)(64 * kb) * DEXP + n0; d.N = DEXP; d.dst = WGU + ((size_t)e * 1024 + drow) * DM + 64 * kb; d.dld = DM; return; } r -= 2 * CV_S4;
    { const int e = r / 512, q = r % 512, kb = q / 64, nb = q % 64;
        d.src = inp(F, I_WDOWN) + ((size_t)l * NEXP + e) * DEXP * DM + (size_t)(64 * kb) * DM + 32 * nb; d.N = DM; d.dst = WD + ((size_t)e * DM + 32 * nb) * DEXP + 64 * kb; d.dld = DEXP; }
}
__device__ __forceinline__ bool cv_decode(Frame& F, int set, int l, int it, CvItem& d) {
    if (set == 0) { if (it >= CV_SA) return false; cv_decode_layer(F, l, it, d); return true; }
    const int n1 = CV_NITEMS - CV_SA, n2 = (l + 1 < DEPTH) ? CV_SA : 0;
    if (it >= n1 + n2) return false;
    if (it < n1) cv_decode_layer(F, l, CV_SA + it, d); else cv_decode_layer(F, l + 1, it - n1, d);
    return true;
}
__device__ __forceinline__ void cv_load(const CvItem& d, int lane, float (&v)[32]) {
    const float* s = d.src + (size_t)(lane >> 5) * d.N + (lane & 31);
#pragma unroll
    for (int i = 0; i < 32; ++i) v[i] = s[(size_t)(2 * i) * d.N];
}
__device__ __forceinline__ void cv_store(const CvItem& d, int lane, const float (&v)[32], LAS float* scr) {
    const int n = lane >> 1, h = lane & 1;
#pragma unroll
    for (int s = 0; s < 4; ++s) {
#pragma unroll
        for (int i = 0; i < 8; ++i) scr[(2 * i + (lane >> 5)) * 33 + (lane & 31)] = v[8 * s + i];
        LDS_WAIT(); asm volatile("" ::: "memory");
        const LAS float* q = scr + (8 * h) * 33 + n;
        v4u o; o.x = pk2(q[0 * 33], q[1 * 33]); o.y = pk2(q[2 * 33], q[3 * 33]); o.z = pk2(q[4 * 33], q[5 * 33]); o.w = pk2(q[6 * 33], q[7 * 33]);
        *(GAS v4u*)(d.dst + (size_t)n * d.dld + 16 * s + 8 * h) = o;
        LDS_WAIT(); asm volatile("" ::: "memory");
    }
}
struct CvPipe { CvItem d; int it, set, l; bool have; };
#define CV_SCR(F) ((LAS float*)((F).lds + CVS_OFF + (F).wave * 2112))
#define CV_START(F, P, V, SET, L) do { (P).set = (SET); (P).l = (L); int _it = (F).vcu * NWAVES + (F).wave; asm volatile("" : "+s"(_it)); (P).it = _it; (P).have = cv_decode(F, SET, L, _it, (P).d); if ((P).have) cv_load((P).d, (F).lane, V); } while (0)
#define CV_STEP(F, P, V) do { if ((P).have) { cv_store((P).d, (F).lane, V, CV_SCR(F)); (P).it += (F).G * NWAVES; (P).have = cv_decode(F, (P).set, (P).l, (P).it, (P).d); if ((P).have) cv_load((P).d, (F).lane, V); } } while (0)
__device__ __forceinline__ void pa_convert(Frame& F, int l) {
    CvPipe P; float va[32];
    CV_START(F, P, va, 0, l);
    while (P.have) CV_STEP(F, P, va);
}
__device__ __forceinline__ void pa_features(Frame& F, int l) {
    LAS float* zf = (LAS float*)(F.lds);
    LAS float* a1 = zf + 8 * 40;
    const float* w1 = inp(F, I_FW1) + l * 33 * 64; const float* b1 = inp(F, I_FB1) + l * 64; const float* w2 = inp(F, I_FW2) + l * 64 * 64; const float* b2 = inp(F, I_FB2) + l * 64; const float* fq = inp(F, I_FFREQ) + l * 64;
    bf16* A2 = (bf16*)(F.ws + WS_A2);
    const int tl = F.tid >> 6, j = F.tid & 63;
    const float fr = fq[j];
    float w1c[33], w2c[64];
#pragma unroll
    for (int i = 0; i < 33; ++i) w1c[i] = w1[i * 64 + j];
#pragma unroll
    for (int i = 0; i < 64; ++i) w2c[i] = w2[i * 64 + j];
    for (int t0 = F.vcu * 8; t0 < SEQ; t0 += F.G * 8) {
        __syncthreads();
        if (F.tid < 8 * 33) { const int tt = F.tid / 33, i = F.tid % 33; const int t = t0 + tt; float v;
            const float w = 6.283185307179586f / (float)SEQ * (float)t;
            if (i == 0) v = (float)t / (float)(SEQ - 1);
            else { const int b = (i - 1) & 15; const float band = 1e-4f + (float)b * ((15.0f - 1e-4f) / 15.0f); const float a = band * w; v = (i <= 16) ? cosf(a) : -sinf(a); }
            zf[tt * 40 + i] = v; }
        __syncthreads();
        float s = b1[j];
#pragma unroll
        for (int i = 0; i < 33; ++i) s += zf[tl * 40 + i] * w1c[i];
        a1[tl * 64 + j] = sinf(fr * s);
        __syncthreads();
        float s2 = b2[j];
#pragma unroll
        for (int i = 0; i < 64; ++i) s2 += a1[tl * 64 + i] * w2c[i];
        A2[(size_t)(t0 + tl) * 64 + j] = (bf16)f2bf(sinf(fr * s2));
    }
    __syncthreads();
}
__device__ __forceinline__ void pa_router_t(Frame& F, int l) {
    float* WR = (float*)(F.ws + WS_WR);
    const float* wrg = inp(F, I_WRG) + (size_t)l * DM * 4; const float* wre = inp(F, I_WRE) + (size_t)l * 4 * DM * 4;
    for (int i = F.vcu * NTHR + F.tid; i < 20 * DM; i += F.G * NTHR) { const int o = i / DM, k = i % DM;
        WR[i] = (o < 4) ? wrg[k * 4 + o] : wre[((size_t)((o - 4) >> 2) * DM + k) * 4 + ((o - 4) & 3)]; }
}
__device__ __forceinline__ int moe_off(const gu32* cnt, int e) { int s = 0;
#pragma unroll
    for (int j = 0; j < 16; ++j) { const int c = (int)cnt[64 * j]; s += (j < e) ? c : 0; } return s; }
template <int MODE, bool OUTF, int NR>
__device__ __forceinline__ void norm_rows(Frame& F, int m0, int mstride, const float* xin, const float* g, const gu32* cntprev, float* outf) {
    float* XR = (float*)(F.ws + WS_XR); bf16* XN = (bf16*)(F.ws + WS_XN);
    f32x4 v[NR][8];
#pragma unroll
    for (int r = 0; r < NR; ++r) { const int m = m0 + r * mstride; const GAS f32x4* xr = (const GAS f32x4*)((MODE == 0 ? xin : XR) + (size_t)m * DM) + F.lane;
#pragma unroll
        for (int j = 0; j < 8; ++j) v[r][j] = xr[64 * j]; }
    if (MODE == 1) {
        const int* TOKPOS = (const int*)(F.ws + WS_LISTS + 1 * MiB); const bf16* MO = (const bf16*)(F.ws + WS_MOEOUT);
        int slot[NR][2];
#pragma unroll
        for (int r = 0; r < NR; ++r)
#pragma unroll
            for (int k = 0; k < 2; ++k) { const int tp = TOKPOS[(m0 + r * mstride) * 2 + k]; slot[r][k] = moe_off(cntprev, tp >> 13) + (tp & 8191); }
        v2u w[NR][2][8];
#pragma unroll
        for (int r = 0; r < NR; ++r)
#pragma unroll
            for (int k = 0; k < 2; ++k) { const GAS v2u* mr = (const GAS v2u*)(MO + (size_t)slot[r][k] * DM) + F.lane;
#pragma unroll
                for (int j = 0; j < 8; ++j) w[r][k][j] = mr[64 * j]; }
#pragma unroll
        for (int r = 0; r < NR; ++r) {
#pragma unroll
            for (int k = 0; k < 2; ++k)
#pragma unroll
                for (int j = 0; j < 8; ++j) { const v2u ww = w[r][k][j]; v[r][j].x += bfl(ww.x); v[r][j].y += bfh(ww.x); v[r][j].z += bfl(ww.y); v[r][j].w += bfh(ww.y); }
            if (!OUTF) { GAS f32x4* xw = (GAS f32x4*)(XR + (size_t)(m0 + r * mstride) * DM) + F.lane;
#pragma unroll
                for (int j = 0; j < 8; ++j) xw[64 * j] = v[r][j]; } }
    }
    const GAS f32x4* gp = (const GAS f32x4*)g + F.lane;
#pragma unroll
    for (int r = 0; r < NR; ++r) { const int m = m0 + r * mstride;
        float ss = 0.f;
#pragma unroll
        for (int j = 0; j < 8; ++j) ss += (v[r][j].x * v[r][j].x + v[r][j].y * v[r][j].y) + (v[r][j].z * v[r][j].z + v[r][j].w * v[r][j].w);
        const float rstd = 1.0f / sqrtf(wave_sum(ss, F.lane) * (1.0f / DM) + EPS);
        if (OUTF) { GAS f32x4* o = (GAS f32x4*)(outf + (size_t)m * DM) + F.lane;
#pragma unroll
            for (int j = 0; j < 8; ++j) { const f32x4 gg = gp[64 * j]; o[64 * j] = v[r][j] * rstd * gg; } }
        else { GAS v2u* o = (GAS v2u*)(XN + (size_t)m * DM) + F.lane;
#pragma unroll
            for (int j = 0; j < 8; ++j) { const f32x4 gg = gp[64 * j]; const f32x4 rr = v[r][j] * rstd * gg; v2u ww; ww.x = pk2(rr.x, rr.y); ww.y = pk2(rr.z, rr.w); o[64 * j] = ww; } } }
}

__device__ __forceinline__ void sgu_unit(Frame& F, int l, int ch, int g) {
    constexpr int RS = 136;
    LAS bf16* Wb = (LAS bf16*)(F.lds);
    LAS bf16* Vt = (LAS bf16*)(F.lds + 128 * RS * 2);
    LAS float* st = (LAS float*)(F.lds + 2 * 128 * RS * 2);
    const bf16* GV = (const bf16*)(F.ws + WS_GV); const bf16* U = (const bf16*)(F.ws + WS_U); bf16* Y = (bf16*)(F.ws + WS_Y);
    const float* lng = inp(F, I_LNG) + l * SGW; const float* lnb = inp(F, I_LNB) + l * SGW;
    const float* Wg = inp(F, I_SGW) + ((size_t)l * 8 + g) * 128 * 128; const float* bg = inp(F, I_SGB) + (l * 8 + g) * 128;
    const int t0 = ch * 128;
    __syncthreads();
    {
        const int row = F.tid >> 2, part = F.tid & 3; const GAS v4u* rp = (const GAS v4u*)(GV + (size_t)(t0 + row) * SGW);
        float s = 0.f, q = 0.f;
#pragma unroll 4
        for (int i = 0; i < 32; ++i) { const v4u w = rp[part + 4 * i]; const unsigned ww[4] = {w.x, w.y, w.z, w.w};
#pragma unroll
            for (int j = 0; j < 4; ++j) { const float a = bfl(ww[j]), b = bfh(ww[j]); s += a + b; q += a * a + b * b; } }
        s += shfl_xor_l(s, 1, F.lane); s += shfl_xor_l(s, 2, F.lane); q += shfl_xor_l(q, 1, F.lane); q += shfl_xor_l(q, 2, F.lane);
        const float mu = s * (1.0f / SGW); const float var = fmaxf(q * (1.0f / SGW) - mu * mu, 0.f);
        if (part == 0) { st[row] = mu; st[128 + row] = 1.0f / sqrtf(var + EPS); }
    }
    {
#pragma unroll
        for (int i = 0; i < 8; ++i) { const int idx = F.tid + NTHR * i; const int t = idx >> 5, s4 = (idx & 31) * 4; const f32x4 w = *(const GAS f32x4*)(Wg + t * 128 + s4);
            v2u o; o.x = pk2(w.x, w.y); o.y = pk2(w.z, w.w); *(LAS v2u*)(Wb + t * RS + s4) = o; }
    }
    __syncthreads();
    {
#pragma unroll
        for (int i = 0; i < 4; ++i) { const int chunk = F.tid + NTHR * i; const int s = chunk >> 4, kc = chunk & 15;
            const v4u w = *(const GAS v4u*)(GV + (size_t)(t0 + s) * SGW + g * 128 + 8 * kc); const unsigned ww[4] = {w.x, w.y, w.z, w.w};
            const float mu = st[s], rs = st[128 + s];
#pragma unroll
            for (int j = 0; j < 4; ++j) { const int k = 8 * kc + 2 * j; const float a = (bfl(ww[j]) - mu) * rs * lng[g * 128 + k] + lnb[g * 128 + k], b = (bfh(ww[j]) - mu) * rs * lng[g * 128 + k + 1] + lnb[g * 128 + k + 1];
                Vt[k * RS + s] = (bf16)f2bf(a); Vt[(k + 1) * RS + s] = (bf16)f2bf(b); } }
    }
    __syncthreads();
    {
        const int fr = F.lane & 15, fq = F.lane >> 4, tw = F.wave * 16;
        bf16x8 af[4];
#pragma unroll
        for (int ks = 0; ks < 4; ++ks) af[ks] = *(const LAS bf16x8*)(Wb + (tw + fr) * RS + ks * 32 + fq * 8);
        const int t = t0 + tw + fr; const float bias = bg[tw + fr];
#pragma unroll
        for (int kt = 0; kt < 8; ++kt) { f32x4 acc = (f32x4){0.f, 0.f, 0.f, 0.f};
#pragma unroll
            for (int ks = 0; ks < 4; ++ks) { const bf16x8 bfv = *(const LAS bf16x8*)(Vt + (kt * 16 + fr) * RS + ks * 32 + fq * 8);
                acc = __builtin_amdgcn_mfma_f32_16x16x32_bf16(bfv, af[ks], acc, 0, 0, 0); }
            const int kcol = g * 128 + kt * 16 + 4 * fq;
            const v2u uw = *(const GAS v2u*)(U + (size_t)t * SGW + kcol);
            v2u o; o.x = pk2(bfl(uw.x) * (acc[0] + bias), bfh(uw.x) * (acc[1] + bias)); o.y = pk2(bfl(uw.y) * (acc[2] + bias), bfh(uw.y) * (acc[3] + bias));
            *(GAS v2u*)(Y + (size_t)t * DM + 1024 + kcol) = o; }
    }
}

__device__ __forceinline__ void hy_filter_gen(Frame& F, int l, int c0, unsigned* FSP) {
    const bf16* A2 = (const bf16*)(F.ws + WS_A2); const bf16* W3T = (const bf16*)(F.ws + WS_W3T + (size_t)(l & 1) * 512 * 1024);
    int lane = F.lane; asm volatile("" : "+v"(lane));
    const int fr = lane & 15, fq = lane >> 4;
    const int chl = fr >> 2, o = (fr >> 1) & 1, dir = fr & 1, col = dir * 2048 + o * 1024 + c0 + chl;
    const bf16x8 b0 = *(const GAS bf16x8*)(W3T + (size_t)col * 64 + fq * 8), b1 = *(const GAS bf16x8*)(W3T + (size_t)col * 64 + 32 + fq * 8);
    const float delta = 3.0701134573253944f + (float)(c0 + chl) * (12.280453829301579f / 1023.0f);
    const float kdec = -delta * 1.4426950408889634f / (float)(SEQ - 1);
    unsigned* zk = FSP + (size_t)(chl * 2 + o) * 8192;
    const int rot = (c0 * 10) & 511;
#pragma unroll 1
    for (int ib = 0; ib < 8; ++ib) {
        bf16x8 a0[8], a1[8];
#pragma unroll
        for (int j = 0; j < 8; ++j) { const int t0 = ((F.wave + 8 * (ib * 8 + j) + rot) & 511) * 16;
            a0[j] = *(const GAS bf16x8*)(A2 + (size_t)(t0 + fr) * 64 + fq * 8); a1[j] = *(const GAS bf16x8*)(A2 + (size_t)(t0 + fr) * 64 + 32 + fq * 8); }
#pragma unroll
        for (int j = 0; j < 8; ++j) { const int tile = (F.wave + 8 * (ib * 8 + j) + rot) & 511, t0 = tile * 16;
            f32x4 acc = (f32x4){0.f, 0.f, 0.f, 0.f};
            acc = __builtin_amdgcn_mfma_f32_16x16x32_bf16(a0[j], b0, acc, 0, 0, 0);
            acc = __builtin_amdgcn_mfma_f32_16x16x32_bf16(a1[j], b1, acc, 0, 0, 0);
            const int tb = t0 + 4 * fq;
#pragma unroll
            for (int r = 0; r < 4; ++r) acc[r] *= __builtin_amdgcn_exp2f(kdec * (float)(tb + r));
            if (tile == 0) { const float nb = shfl_down1_l(acc[0], lane);
                if (tile == 0 && fq == 0 && dir == 0) acc[0] += nb; }
            hy_pack_store(zk, dir, tb, acc[0], acc[1], acc[2], acc[3]); }
    }
}
__device__ __forceinline__ unsigned pk_c32(c32 v) { return pk2(v.x, v.y); }
__device__ __forceinline__ c32 unpk_c32(unsigned u) { return cmk(bfl(u), bfh(u)); }
__device__ __forceinline__ void hyena_block(Frame& F, int l, int blk) {
    LAS c32* A = (LAS c32*)(F.lds); LAS c32* B = A + HY_LDS_C32;
    unsigned* FSP = (unsigned*)(F.ws + WS_FS) + (size_t)blk * 8 * 8192;
    const unsigned* ZT = (const unsigned*)(F.ws + WS_ZT); bf16* Y = (bf16*)(F.ws + WS_Y);
    const float* cw = inp(F, I_CONVW) + (size_t)l * 3 * NHY; const float* cb = inp(F, I_CONVB) + (size_t)l * NHY; const float* skp = inp(F, I_SKIP) + (size_t)l * 2 * HYW;
    const int c0 = blk * 4, tid = F.tid;
    __syncthreads();
    HPS(20); hy_filter_gen(F, l, c0, FSP);
    VM_WAIT(); __syncthreads(); HPE(20); HPS(21);
    CvPipe cvp; float cvv[32];
    CV_START(F, cvp, cvv, 1, l);
    unsigned yb0[8], yb1[8], yb2[8], yb3[8];
#pragma unroll
    for (int q = 0; q < 8; ++q) { yb0[q] = 0u; yb1[q] = 0u; yb2[q] = 0u; yb3[q] = 0u; }
#pragma unroll 1
    for (int chl = 0; chl < 4; ++chl) {
        const int c = c0 + chl; const unsigned* zk = FSP + (size_t)chl * 2 * 8192;
        c32 keep[8]; unsigned x1p[8], x2p[8];
        c32 s[16];
        {
            unsigned fw[16]; c32 fz[16];
            { int t2 = tid; HY_OPAQUE(t2);
#pragma unroll
              for (int q = 0; q < 16; ++q) fw[q] = zk[t2 + 512 * q]; }
            c32 xa[8], xb[8];
            hy_conv3_load(tid, ZT + (size_t)(2048 + c) * (SEQ / 2), cw[2048 + c], cw[NHY + 2048 + c], cw[2 * NHY + 2048 + c], cb[2048 + c], keep);
            hy_conv3_load(tid, ZT + (size_t)c * (SEQ / 2), cw[c], cw[NHY + c], cw[2 * NHY + c], cb[c], xa);
            hy_conv3_load(tid, ZT + (size_t)(1024 + c) * (SEQ / 2), cw[1024 + c], cw[NHY + 1024 + c], cw[2 * NHY + 1024 + c], cb[1024 + c], xb);
#pragma unroll
            for (int q = 0; q < 8; ++q) { x1p[q] = pk_c32(xa[q]); x2p[q] = pk_c32(xb[q]); }
#pragma unroll
            for (int q = 0; q < 16; ++q) fz[q] = cmk(bfl(fw[q]), bfh(fw[q]));
            fft_s1_fwd(tid, B, fz);
            hy_data_s1(tid, A, keep);
        }
        const float sk0 = skp[c], sk1 = skp[HYW + c];
#pragma unroll
        for (int ord = 0; ord < 2; ++ord) {
            __syncthreads();
            HPS(22); fft_s2_fwd(tid, A); fft_s2_fwd(tid, B);
            __syncthreads(); HPE(22); HPS(23);
            CV_STEP(F, cvp, cvv);
            fft_s3_read<-1>(tid, A, s); fft_s3_write(tid, A, s);
            fft_s3_read<-1>(tid, B, s); fft_s3_write(tid, B, s);
            unsigned fw[16];
            if (ord == 0) { int t2 = tid; HY_OPAQUE(t2);
#pragma unroll
                for (int q = 0; q < 16; ++q) fw[q] = zk[8192 + t2 + 512 * q]; }
            __syncthreads(); HPE(23); HPS(24);
            CV_STEP(F, cvp, cvv);
            pair_pass(tid, A, B);
            __syncthreads(); HPE(24); HPS(25);
            if (ord == 0) { c32 fz[16];
#pragma unroll
                for (int q = 0; q < 16; ++q) fz[q] = cmk(bfl(fw[q]), bfh(fw[q]));
                fft_s1_fwd(tid, B, fz); }
            fft_s3_read<1>(tid, A, s); fft_s3_write(tid, A, s);
            __syncthreads();
            CV_STEP(F, cvp, cvv);
            fft_s2_inv(tid, A);
            __syncthreads();
            fft_s1_inv(tid, A, s); HPE(25); HPS(26);
            if (ord == 0) {
#pragma unroll
                for (int q = 0; q < 8; ++q) { const c32 xv = unpk_c32(x1p[q]); keep[q] = cmk(FMUL(xv.x, FFMA(keep[q].x, sk0, s[q].x)), FMUL(xv.y, FFMA(keep[q].y, sk0, s[q].y))); }
                hy_data_s1(tid, A, keep);
            } else {
#pragma unroll
                for (int q = 0; q < 8; ++q) { const c32 xv = unpk_c32(x2p[q]); const unsigned yv = pk_c32(cmk(FMUL(xv.x, FFMA(keep[q].x, sk1, s[q].x)), FMUL(xv.y, FFMA(keep[q].y, sk1, s[q].y))));
                    yb0[q] = (chl == 0) ? yv : yb0[q]; yb1[q] = (chl == 1) ? yv : yb1[q]; yb2[q] = (chl == 2) ? yv : yb2[q]; yb3[q] = (chl == 3) ? yv : yb3[q]; }
            }
            HPE(26);
        }
        __syncthreads();
    }
    {
        int t2 = tid; HY_OPAQUE(t2);
#pragma unroll
        for (int q = 0; q < 8; ++q) { const int m = t2 + 512 * q;
            v2u lo, hi; lo.x = (yb0[q] & 0xffffu) | (yb1[q] << 16); lo.y = (yb2[q] & 0xffffu) | (yb3[q] << 16);
            hi.x = (yb0[q] >> 16) | (yb1[q] & 0xffff0000u); hi.y = (yb2[q] >> 16) | (yb3[q] & 0xffff0000u);
            *(GAS v2u*)(Y + (size_t)(2 * m) * DM + c0) = lo; *(GAS v2u*)(Y + (size_t)(2 * m + 1) * DM + c0) = hi; }
    }
    while (cvp.have) CV_STEP(F, cvp, cvv);
    HPE(21);
}

__device__ __forceinline__ void route_block(Frame& F, int l, int tb  ) {
    LAS int* lcnt = (LAS int*)(F.lds);
    LAS int* lbase = (LAS int*)(F.lds + 64);
    LAS int* le = (LAS int*)(F.lds + 128);
    LAS int* lp = (LAS int*)(F.lds + 128 + 256);
    LAS float* lw = (LAS float*)(F.lds + 128 + 512);
    LAS float* lr = (LAS float*)(F.lds + 128 + 768);
    const float* XR = (const float*)(F.ws + WS_XR); bf16* H = (bf16*)(F.ws + WS_XN); const float* WR = (const float*)(F.ws + WS_WR);
    const float* g = inp(F, I_GFFN) + (size_t)l * DM; const float* brg = inp(F, I_BRG) + l * 4; const float* bre = inp(F, I_BRE) + l * 16;
    int* TOKLIST = (int*)(F.ws + WS_LISTS); float* WLIST = (float*)(F.ws + WS_LISTS + 512 * 1024); int* TOKPOS = (int*)(F.ws + WS_LISTS + 1 * MiB); float* RSLIST = (float*)(F.ws + WS_LISTS + 1 * MiB + 512 * 1024);
    gu32* gcnt = F.ctl + CW_CNT + 64 * 16 * l;
    __syncthreads();
    if (F.tid < 16) lcnt[F.tid] = 0;
    const int ts = F.tid >> 4, part = F.tid & 15, tok = tb + ts;
    LAS float* WRc = (LAS float*)(F.lds + 2048);
    LAS float* Xc = WRc + 20 * 512;
    LAS float* Gc = Xc + 32 * 512;
    float acc[20], ss = 0.f;
#pragma unroll
    for (int o = 0; o < 20; ++o) acc[o] = 0.f;
    f32x4 rw[5], rx[8], rg = (f32x4){0.f, 0.f, 0.f, 0.f};
#define RT_LOAD(c) do { _Pragma("unroll") for (int i = 0; i < 5; ++i) { const int idx = F.tid + NTHR * i, o = idx >> 7, k4 = idx & 127; rw[i] = *(const GAS f32x4*)(WR + (size_t)o * DM + 512 * (c) + 4 * k4); } \
        _Pragma("unroll") for (int i = 0; i < 8; ++i) { const int idx = F.tid + NTHR * i, r = idx >> 7, k4 = idx & 127; rx[i] = *(const GAS f32x4*)(XR + (size_t)(tb + r) * DM + 512 * (c) + 4 * k4); } \
        if (F.tid < 128) rg = *(const GAS f32x4*)(g + 512 * (c) + 4 * F.tid); } while (0)
    RT_LOAD(0);
#pragma unroll 1
    for (int c = 0; c < 4; ++c) {
        __syncthreads();
#pragma unroll
        for (int i = 0; i < 5; ++i) { const int idx = F.tid + NTHR * i, o = idx >> 7, k4 = idx & 127; *(LAS f32x4*)(WRc + o * 512 + 4 * k4) = rw[i]; }
#pragma unroll
        for (int i = 0; i < 8; ++i) { const int idx = F.tid + NTHR * i, r = idx >> 7, k4 = idx & 127; *(LAS f32x4*)(Xc + r * 512 + 4 * k4) = rx[i]; }
        if (F.tid < 128) *(LAS f32x4*)(Gc + 4 * F.tid) = rg;
        __syncthreads();
        if (c < 3) RT_LOAD(c + 1);
#pragma unroll 2
        for (int i = 0; i < 8; ++i) { const int ko = 4 * (part + 16 * i);
            const f32x4 x = *(const LAS f32x4*)(Xc + ts * 512 + ko); const f32x4 gg = *(const LAS f32x4*)(Gc + ko); const f32x4 xg = x * gg;
            ss += (x.x * x.x + x.y * x.y) + (x.z * x.z + x.w * x.w);
            { v2u w; w.x = pk2(xg.x, xg.y); w.y = pk2(xg.z, xg.w); *(GAS v2u*)(H + (size_t)tok * DM + 512 * c + ko) = w; }
#pragma unroll
            for (int o = 0; o < 20; ++o) { const f32x4 w = *(const LAS f32x4*)(WRc + o * 512 + ko); acc[o] += (xg.x * w.x + xg.y * w.y) + (xg.z * w.z + xg.w * w.w); } }
    }
#undef RT_LOAD
#pragma unroll
    for (int sh = 1; sh < 16; sh <<= 1) { ss += shfl_xor_l(ss, sh, F.lane);
#pragma unroll
        for (int o = 0; o < 20; ++o) acc[o] += shfl_xor_l(acc[o], sh, F.lane); }
    const float rstd = 1.0f / sqrtf(ss * (1.0f / DM) + EPS);
    {
        float lg0 = acc[0] * rstd + brg[0], lg1 = acc[1] * rstd + brg[1], lg2 = acc[2] * rstd + brg[2], lg3 = acc[3] * rstd + brg[3];
        int grp = 0; float mx = lg0;
        if (lg1 > mx) { mx = lg1; grp = 1; } if (lg2 > mx) { mx = lg2; grp = 2; } if (lg3 > mx) { mx = lg3; grp = 3; }
        const float den = (__expf(lg0 - mx) + __expf(lg1 - mx)) + (__expf(lg2 - mx) + __expf(lg3 - mx));
        const float psel = 1.0f / den;
        const float m0 = (grp == 0) ? 1.f : 0.f, m1 = (grp == 1) ? 1.f : 0.f, m2 = (grp == 2) ? 1.f : 0.f, m3 = (grp == 3) ? 1.f : 0.f;
        float e0v = (m0 * acc[4] + m1 * acc[8]) + (m2 * acc[12] + m3 * acc[16]), e1v = (m0 * acc[5] + m1 * acc[9]) + (m2 * acc[13] + m3 * acc[17]);
        float e2v = (m0 * acc[6] + m1 * acc[10]) + (m2 * acc[14] + m3 * acc[18]), e3v = (m0 * acc[7] + m1 * acc[11]) + (m2 * acc[15] + m3 * acc[19]);
        e0v = e0v * rstd + bre[grp * 4 + 0]; e1v = e1v * rstd + bre[grp * 4 + 1]; e2v = e2v * rstd + bre[grp * 4 + 2]; e3v = e3v * rstd + bre[grp * 4 + 3];
        int i0 = 0; float v0 = e0v;
        if (e1v > v0) { v0 = e1v; i0 = 1; } if (e2v > v0) { v0 = e2v; i0 = 2; } if (e3v > v0) { v0 = e3v; i0 = 3; }
        int i1 = -1; float v1 = -3.0e38f;
        if (i0 != 0 && e0v > v1) { v1 = e0v; i1 = 0; } if (i0 != 1 && e1v > v1) { v1 = e1v; i1 = 1; } if (i0 != 2 && e2v > v1) { v1 = e2v; i1 = 2; } if (i0 != 3 && e3v > v1) { v1 = e3v; i1 = 3; }
        const float ex = __expf(v1 - v0); const float w0 = psel / (1.0f + ex), w1 = psel * ex / (1.0f + ex);
        if (part == 0) { const int ea = grp * 4 + i0, eb = grp * 4 + i1;
            le[ts * 2] = ea; le[ts * 2 + 1] = eb; lw[ts * 2] = w0; lw[ts * 2 + 1] = w1; lr[ts] = rstd;
            lp[ts * 2] = __hip_atomic_fetch_add(lcnt + ea, 1, __ATOMIC_RELAXED, __HIP_MEMORY_SCOPE_WORKGROUP); lp[ts * 2 + 1] = __hip_atomic_fetch_add(lcnt + eb, 1, __ATOMIC_RELAXED, __HIP_MEMORY_SCOPE_WORKGROUP); }
    }
    __syncthreads();
    if (F.tid < 16) lbase[F.tid] = (int)__hip_atomic_fetch_add(gcnt + 64 * F.tid, (unsigned)lcnt[F.tid], RLX_AGENT);
    __syncthreads();
    if (F.tid < 64) { const int t2 = F.tid >> 1; const int e = le[F.tid], pos = lbase[e] + lp[F.tid];
        TOKLIST[e * SEQ + pos] = tb + t2; WLIST[e * SEQ + pos] = lw[F.tid]; RSLIST[e * SEQ + pos] = lr[t2]; TOKPOS[(tb + t2) * 2 + (F.tid & 1)] = (e << 13) | pos; }
}
using pg8::Unit; using pg8::f32x2; using pg8::u32x4; using pg8::cvt_pk_bf16; using pg8::gelu_pk; using pg8::sigmoid_f;
__device__ __forceinline__ void tile_of(int idx, int nM, int nN, int& pm, int& pn) {
    const int nig = 8 * nN, gid = idx / nig, fm = gid * 8, gsz = (nM - fm) < 8 ? (nM - fm) : 8;
    pm = fm + ((idx % nig) % gsz); pn = (idx % nig) / gsz;
}
__device__ __forceinline__ int xcd_remap(int L, int nwg) { const int q = nwg / 8, r = nwg % 8, xcd = L % 8, off = L / 8; return (xcd < r ? xcd * (q + 1) : r * (q + 1) + (xcd - r) * q) + off; }

struct InProjSched {
    static constexpr bool GATHER = false;
    const char* XN; const char* WIN; int G, c;
    __device__ __forceinline__ bool next(int i, Unit& u) const {
        const int L = i * G + c; if (L >= 1152) return false;
        const int w = xcd_remap(L, 1152);
        if (w < 384) { u.kind = 0; tile_of(w, 12, 32, u.pm, u.pn); } else { u.kind = 1; tile_of(w - 384, 32, 24, u.pm, u.pn); }
        u.e = 0; u.row0 = 0; u.nvalid = 256; return true;
    }
    __device__ __forceinline__ const char* a_base(const Unit& u) const { return (u.kind == 0 ? WIN : XN) + (size_t)u.pm * (256 * DM * 2); }
    __device__ __forceinline__ const char* b_base(const Unit& u) const { return (u.kind == 0 ? XN : WIN + (size_t)NHY * DM * 2) + (size_t)u.pn * (256 * DM * 2); }
    __device__ __forceinline__ unsigned a_goff(const Unit&, int) const { return 0u; }
};
struct EpiInProj {
    static constexpr bool PERM = true, MIDK = false;
    bf16 *ZT, *U; const float* bin;
    __device__ __forceinline__ void operator()(const f32x4 (&acc)[2][2][4][2], const Unit& u, int wr, int wc, int fr, int fq) const {
        asm volatile("" : "+v"(fr), "+v"(fq));
        if (u.kind == 0) {
            const int row0 = u.pm * 256 + wr * 64 + fr, col0 = u.pn * 256 + wc * 32 + 8 * fq;
#pragma unroll
            for (int ai = 0; ai < 2; ++ai)
#pragma unroll
                for (int m = 0; m < 4; ++m) { const int row = row0 + ai * 128 + m * 16; const float b = bin[row]; bf16* rowp = ZT + (size_t)row * SEQ + col0;
#pragma unroll
                    for (int bj = 0; bj < 2; ++bj) { const f32x4 v0 = acc[ai][bj][m][0] + b, v1 = acc[ai][bj][m][1] + b;
                        u32x4 w; w.x = cvt_pk_bf16(v0[0], v0[1]); w.y = cvt_pk_bf16(v0[2], v0[3]); w.z = cvt_pk_bf16(v1[0], v1[1]); w.w = cvt_pk_bf16(v1[2], v1[3]);
                        *(u32x4*)(rowp + bj * 128) = w; } }
        } else {
            const int seg = (u.pn < 4) ? 0 : (u.pn < 8) ? 1 : (u.pn < 16) ? 2 : 3;
            const size_t boff = (seg == 0) ? 0 : (seg == 1) ? (WS_GV - WS_U) : (seg == 2) ? (WS_GH - WS_U) : (WS_GS - WS_U);
            bf16* base = (bf16*)((char*)U + boff);
            const int ldc = (seg < 2) ? 1024 : 2048, colt = (seg == 0) ? u.pn * 256 : (seg == 1) ? (u.pn - 4) * 256 : (seg == 2) ? (u.pn - 8) * 256 : (u.pn - 16) * 256;
            const int row0 = u.pm * 256 + wr * 64 + fr, col0 = colt + wc * 32 + 8 * fq, bcol0 = NHY + u.pn * 256 + wc * 32 + 8 * fq;
            f32x4 bv[2][2];
#pragma unroll
            for (int bj = 0; bj < 2; ++bj)
#pragma unroll
                for (int n = 0; n < 2; ++n) bv[bj][n] = *(const f32x4*)(bin + bcol0 + bj * 128 + 4 * n);
#pragma unroll
            for (int ai = 0; ai < 2; ++ai)
#pragma unroll
                for (int m = 0; m < 4; ++m) { bf16* rowp = base + (size_t)(row0 + ai * 128 + m * 16) * ldc + col0;
#pragma unroll
                    for (int bj = 0; bj < 2; ++bj) { f32x4 v0 = acc[ai][bj][m][0] + bv[bj][0], v1 = acc[ai][bj][m][1] + bv[bj][1];
                        if (seg < 2) { const f32x2 a = gelu_pk((f32x2){v0[0], v0[1]}), b = gelu_pk((f32x2){v0[2], v0[3]}), c = gelu_pk((f32x2){v1[0], v1[1]}), d = gelu_pk((f32x2){v1[2], v1[3]});
                            v0 = (f32x4){a.x, a.y, b.x, b.y}; v1 = (f32x4){c.x, c.y, d.x, d.y}; }
                        else {
#pragma unroll
                            for (int j = 0; j < 4; ++j) { v0[j] = sigmoid_f(v0[j]); v1[j] = sigmoid_f(v1[j]); } }
                        u32x4 w; w.x = cvt_pk_bf16(v0[0], v0[1]); w.y = cvt_pk_bf16(v0[2], v0[3]); w.z = cvt_pk_bf16(v1[0], v1[1]); w.w = cvt_pk_bf16(v1[2], v1[3]);
                        *(u32x4*)(rowp + bj * 128) = w; } }
        }
    }
    __device__ __forceinline__ void mid(f32x4 (&)[2][2][4][2], const Unit&, int, int, int, int) const {}
};
struct GridSched {
    static constexpr bool GATHER = false;
    const char* A; const char* Bt; int nM, nN, K, G, c;
    __device__ __forceinline__ bool next(int i, Unit& u) const {
        const int L = i * G + c, nwg = nM * nN; if (L >= nwg) return false;
        tile_of(xcd_remap(L, nwg), nM, nN, u.pm, u.pn); u.kind = 0; u.e = 0; u.row0 = 0; u.nvalid = 256; return true;
    }
    __device__ __forceinline__ const char* a_base(const Unit& u) const { return A + (size_t)u.pm * 512 * K; }
    __device__ __forceinline__ const char* b_base(const Unit& u) const { return Bt + (size_t)u.pn * 512 * K; }
    __device__ __forceinline__ unsigned a_goff(const Unit&, int) const { return 0u; }
};
struct EpiMerge {
    static constexpr bool PERM = true, MIDK = true;
    const bf16 *GH, *GS; bf16* O;
    __device__ __forceinline__ void mid(f32x4 (&acc)[2][2][4][2], const Unit& u, int wr, int wc, int fr, int fq) const {
        asm volatile("" : "+v"(fr), "+v"(fq));
        const int row0 = u.pm * 256 + wr * 64 + fr, col0 = u.pn * 256 + wc * 32 + 8 * fq;
#pragma unroll
        for (int ai = 0; ai < 2; ++ai)
#pragma unroll
            for (int m = 0; m < 4; ++m) { const size_t off = (size_t)(row0 + ai * 128 + m * 16) * DM + col0;
#pragma unroll
                for (int bj = 0; bj < 2; ++bj) { const u32x4 h = *(const u32x4*)(GH + off + bj * 128), s = *(const u32x4*)(GS + off + bj * 128);
                    const unsigned hh[4] = {h.x, h.y, h.z, h.w}, sv[4] = {s.x, s.y, s.z, s.w};
#pragma unroll
                    for (int j = 0; j < 4; ++j) { const float r0 = bfl(hh[j]) * __builtin_amdgcn_rcpf(bfl(sv[j])), r1 = bfh(hh[j]) * __builtin_amdgcn_rcpf(bfh(sv[j]));
                        acc[ai][bj][m][j >> 1][(j & 1) * 2] *= r0; acc[ai][bj][m][j >> 1][(j & 1) * 2 + 1] *= r1; } }
                asm volatile("" : "+v"(acc[ai][0][m][0]), "+v"(acc[ai][0][m][1]), "+v"(acc[ai][1][m][0]), "+v"(acc[ai][1][m][1]));
                asm volatile("" ::: "memory"); }
    }
    __device__ __forceinline__ void operator()(const f32x4 (&acc)[2][2][4][2], const Unit& u, int wr, int wc, int fr, int fq) const {
        asm volatile("" : "+v"(fr), "+v"(fq));
        const int row0 = u.pm * 256 + wr * 64 + fr, col0 = u.pn * 256 + wc * 32 + 8 * fq;
#pragma unroll
        for (int ai = 0; ai < 2; ++ai)
#pragma unroll
            for (int m = 0; m < 4; ++m) { const size_t off = (size_t)(row0 + ai * 128 + m * 16) * DM + col0;
#pragma unroll
                for (int bj = 0; bj < 2; ++bj) { const u32x4 s = *(const u32x4*)(GS + off + bj * 128); const unsigned sv[4] = {s.x, s.y, s.z, s.w};
                    const f32x4 v0 = acc[ai][bj][m][0], v1 = acc[ai][bj][m][1];
                    u32x4 w; w.x = cvt_pk_bf16(v0[0] * bfl(sv[0]), v0[1] * bfh(sv[0])); w.y = cvt_pk_bf16(v0[2] * bfl(sv[1]), v0[3] * bfh(sv[1]));
                    w.z = cvt_pk_bf16(v1[0] * bfl(sv[2]), v1[1] * bfh(sv[2])); w.w = cvt_pk_bf16(v1[2] * bfl(sv[3]), v1[3] * bfh(sv[3]));
                    *(u32x4*)(O + off + bj * 128) = w; }
                asm volatile("" ::: "memory"); }
    }
};
struct EpiResid {
    static constexpr bool PERM = false, MIDK = false;
    const float* base; float* out;
    __device__ __forceinline__ void operator()(const f32x4 (&acc)[2][2][4][2], const Unit& u, int wr, int wc, int fr, int fq) const {
        asm volatile("" : "+v"(fr), "+v"(fq));
        const int row0 = u.pm * 256 + wr * 64 + fr, col0 = u.pn * 256 + wc * 32 + 4 * fq;
#pragma unroll
        for (int ai = 0; ai < 2; ++ai)
#pragma unroll
            for (int m = 0; m < 4; ++m) { const size_t off = (size_t)(row0 + ai * 128 + m * 16) * DM + col0;
#pragma unroll
                for (int bj = 0; bj < 2; ++bj)
#pragma unroll
                    for (int n = 0; n < 2; ++n) { const f32x4 b = *(const f32x4*)(base + off + bj * 128 + n * 16); *(f32x4*)(out + off + bj * 128 + n * 16) = b + acc[ai][bj][m][n]; } }
    }
    __device__ __forceinline__ void mid(f32x4 (&)[2][2][4][2], const Unit&, int, int, int, int) const {}
};
struct MoeSched1 {
    static constexpr bool GATHER = true;
    const LAS int* tab; const char* H; const char* W; const int* toklist; int G, c;
    __device__ __forceinline__ bool next(int i, Unit& u) const {
        const int L = i * G + c; const int total = __builtin_amdgcn_readfirstlane(tab[16]) * 4; if (L >= total) return false;
        const int rt = L >> 2; int e = 0;
#pragma unroll
        for (int j = 1; j < 16; ++j) e += (__builtin_amdgcn_readfirstlane(tab[j]) <= rt) ? 1 : 0;
        const int j0 = rt - __builtin_amdgcn_readfirstlane(tab[e]);
        u.pm = j0; u.pn = L & 3; u.kind = 0; u.e = e; u.row0 = __builtin_amdgcn_readfirstlane(tab[17 + e]) + 256 * j0;
        const int rem = __builtin_amdgcn_readfirstlane(tab[34 + e]) - 256 * j0; u.nvalid = rem < 256 ? rem : 256; return true;
    }
    __device__ __forceinline__ const char* a_base(const Unit&) const { return H; }
    __device__ __forceinline__ const char* b_base(const Unit& u) const { return W + ((size_t)u.e * 1024 + (size_t)u.pn * 256) * DM * 2; }
    __device__ __forceinline__ unsigned a_goff(const Unit& u, int r) const { const int tok = (r < u.nvalid) ? toklist[u.e * SEQ + u.pm * 256 + r] : 0; return (unsigned)tok * (unsigned)(DM * 2); }
};
struct EpiMoe1 {
    static constexpr bool PERM = true, MIDK = false;
    bf16* ACT; const float* wlist; const float* rslist;
    __device__ __forceinline__ void operator()(const f32x4 (&acc)[2][2][4][2], const Unit& u, int wr, int wc, int fr, int fq) const {
        asm volatile("" : "+v"(fr), "+v"(fq));
        const int col0 = u.pn * 128 + wc * 32 + 8 * fq;
#pragma unroll
        for (int ai = 0; ai < 2; ++ai)
#pragma unroll
            for (int m = 0; m < 4; ++m) { const int rl = ai * 128 + wr * 64 + m * 16 + fr;
                if (rl < u.nvalid) { const float wt = wlist[u.e * SEQ + u.pm * 256 + rl], rs = rslist[u.e * SEQ + u.pm * 256 + rl];
                    const f32x4 g0 = acc[ai][0][m][0], g1 = acc[ai][0][m][1], u0 = acc[ai][1][m][0], u1 = acc[ai][1][m][1];
                    float o[8];
#pragma unroll
                    for (int j = 0; j < 4; ++j) { const float ga = g0[j] * rs, gb = g1[j] * rs; o[j] = ga * sigmoid_f(ga) * (u0[j] * rs) * wt; o[4 + j] = gb * sigmoid_f(gb) * (u1[j] * rs) * wt; }
                    u32x4 w; w.x = cvt_pk_bf16(o[0], o[1]); w.y = cvt_pk_bf16(o[2], o[3]); w.z = cvt_pk_bf16(o[4], o[5]); w.w = cvt_pk_bf16(o[6], o[7]);
                    *(u32x4*)(ACT + (size_t)(u.row0 + rl) * DEXP + col0) = w; } }
    }
    __device__ __forceinline__ void mid(f32x4 (&)[2][2][4][2], const Unit&, int, int, int, int) const {}
};
struct MoeSched2 {
    static constexpr bool GATHER = false;
    const LAS int* tab; const char* ACT; const char* W; int G, c;
    __device__ __forceinline__ bool next(int i, Unit& u) const {
        const int L = i * G + c; const int total = __builtin_amdgcn_readfirstlane(tab[16]) * 8; if (L >= total) return false;
        const int rt = L >> 3; int e = 0;
#pragma unroll
        for (int j = 1; j < 16; ++j) e += (__builtin_amdgcn_readfirstlane(tab[j]) <= rt) ? 1 : 0;
        const int j0 = rt - __builtin_amdgcn_readfirstlane(tab[e]);
        u.pm = j0; u.pn = L & 7; u.kind = 0; u.e = e; u.row0 = __builtin_amdgcn_readfirstlane(tab[17 + e]) + 256 * j0;
        const int rem = __builtin_amdgcn_readfirstlane(tab[34 + e]) - 256 * j0; u.nvalid = rem < 256 ? rem : 256; return true;
    }
    __device__ __forceinline__ const char* a_base(const Unit& u) const { return ACT + (size_t)u.row0 * DEXP * 2; }
    __device__ __forceinline__ const char* b_base(const Unit& u) const { return W + ((size_t)u.e * DM + (size_t)u.pn * 256) * DEXP * 2; }
    __device__ __forceinline__ unsigned a_goff(const Unit&, int) const { return 0u; }
};
struct EpiMoe2 {
    static constexpr bool PERM = true, MIDK = false;
    bf16* MO;
    __device__ __forceinline__ void operator()(const f32x4 (&acc)[2][2][4][2], const Unit& u, int wr, int wc, int fr, int fq) const {
        asm volatile("" : "+v"(fr), "+v"(fq));
        const int col0 = u.pn * 256 + wc * 32 + 8 * fq;
#pragma unroll
        for (int ai = 0; ai < 2; ++ai)
#pragma unroll
            for (int m = 0; m < 4; ++m) { const int rl = ai * 128 + wr * 64 + m * 16 + fr;
                if (rl < u.nvalid) { bf16* rowp = MO + (size_t)(u.row0 + rl) * DM + col0;
#pragma unroll
                    for (int bj = 0; bj < 2; ++bj) { const f32x4 v0 = acc[ai][bj][m][0], v1 = acc[ai][bj][m][1];
                        u32x4 w; w.x = cvt_pk_bf16(v0[0], v0[1]); w.y = cvt_pk_bf16(v0[2], v0[3]); w.z = cvt_pk_bf16(v1[0], v1[1]); w.w = cvt_pk_bf16(v1[2], v1[3]);
                        *(u32x4*)(rowp + bj * 128) = w; } } }
    }
    __device__ __forceinline__ void mid(f32x4 (&)[2][2][4][2], const Unit&, int, int, int, int) const {}
};
__device__ __forceinline__ void moe_tables(Frame& F, int l) {
    LAS int* tab = (LAS int*)(F.lds + MISC_OFF + 128);
    __syncthreads();
    if (F.tid == 0) { int tp = 0, off = 0;
        for (int e = 0; e < 16; ++e) { const int c = (int)__hip_atomic_load(F.ctl + CW_CNT + 64 * (16 * l + e), RLX_AGENT); tab[e] = tp; tab[17 + e] = off; tab[34 + e] = c; tp += (c + 255) >> 8; off += c; }
        tab[16] = tp; tab[33] = off; }
    __syncthreads();
}

struct Args { const float* in[29]; float* out; unsigned char* ws; int ph_lo, ph_hi; };
constexpr int NPHASE = 17;
__global__ void __launch_bounds__(NTHR, 2) fwd_kernel(Args args) {
    extern __shared__ __attribute__((aligned(16))) unsigned char lds[];
    Frame F;
    F.lds = (LAS unsigned char*)lds;
    F.MISC = (volatile LAS unsigned*)(F.lds + MISC_OFF);
    F.tid = threadIdx.x; F.lane = F.tid & 63; F.wave = __builtin_amdgcn_readfirstlane(F.tid >> 6);
    F.G = gridDim.x; { const int bx = blockIdx.x; F.vcu = (F.G % 8 == 0) ? (bx % 8) * (F.G / 8) + bx / 8 : bx; }
    F.ws = args.ws; F.out = args.out; F.ctl = (gu32*)(args.ws + WS_CTL);
    for (int u = F.tid; u < 256; u += NTHR) ((LAS unsigned*)(F.lds + MISC_OFF))[u] = 0u;
    F.inp = (const LAS unsigned long long*)(F.lds + MISC_OFF + 640);
    __syncthreads();
#pragma unroll
    for (int i = 0; i < 29; ++i) if (F.tid == i) ((LAS unsigned long long*)(F.lds + MISC_OFF + 640))[i] = (unsigned long long)args.in[i];
    __syncthreads();
    const int lo = args.ph_lo, hi = args.ph_hi;
    const bool multi = (hi - lo) > 1;
    XcdBarrier bar; bar.bar = (unsigned*)(F.ctl + CW_BAR); bar.x = 0; bar.st = nullptr;
    if (multi) bar = xcd_barrier_post((unsigned*)(F.ctl + CW_BAR), F.MISC + 8);
#ifndef PHASE_MASK
#define PHASE_MASK 0x7ff
#endif
#define IN(k) (lo <= (k) && (k) < hi)
#define ON(j) ((PHASE_MASK >> (j)) & 1)
#ifndef DUP_MASK
#define DUP_MASK 0
#endif
#define REP(j) for (int _rep = 0; _rep < (((DUP_MASK >> (j)) & 1) ? 2 : 1); ++_rep)
#define LAUNDER() do { int _l; asm volatile("v_mbcnt_lo_u32_b32 %0, -1, 0\n\tv_mbcnt_hi_u32_b32 %0, -1, %0" : "=v"(_l)); F.lane = _l; F.tid = F.wave * 64 + _l; { unsigned char* _w = F.ws; asm volatile("" : "+s"(_w)); F.ws = _w; } } while (0)
#ifndef PROBE_K
#define PROBE_K -1
#endif
#ifndef PROBE_PART
#define PROBE_PART 0
#endif
#ifndef PROBE_AMP
#define PROBE_AMP 8
#endif
    volatile LAS unsigned long long* pr = (volatile LAS unsigned long long*)(F.lds + MISC_OFF + 512);
#define PR_ME (blockIdx.x == 0 && threadIdx.x == 0)
#define PSTART(j) do { if (PROBE_K == (j) && PROBE_PART != 1 && PR_ME) pr[0] = __builtin_amdgcn_s_memrealtime(); } while (0)
#define PEND(j) do { if (PROBE_K == (j) && PR_ME) { const unsigned long long _n = __builtin_amdgcn_s_memrealtime(); if (PROBE_PART == 0 || (PROBE_PART == 2 && (j) == 8)) pr[1] += _n - pr[0]; else if (PROBE_PART == 1) pr[0] = _n; } } while (0)
#define PBAR(j) do { if (PROBE_K == (j) && PROBE_PART >= 1 && PR_ME) pr[1] += __builtin_amdgcn_s_memrealtime() - pr[0]; } while (0)
#define SEAM(k) do { if (IN(k) && IN((k) + 1)) xcd_barrier(bar); } while (0)
    const int gw = F.vcu * NWAVES + F.wave, NGW = F.G * NWAVES;
    for (int l = 0; l < DEPTH; ++l) {
        const int p0 = l * 8;
        if (ON(0) && IN(p0 + 0)) { LAUNDER(); PSTART(0);
            PSTART(10); if (l == 0) pa_convert(F, l); PEND(10);
            PSTART(11); pa_features(F, l); PEND(11);
            PSTART(12); pa_router_t(F, l); PEND(12);
            PSTART(13);
            const float* g = inp(F, I_GMIX) + (size_t)l * DM;
            if (l == 0) { for (int m = gw; m < SEQ; m += 4 * NGW) norm_rows<0, false, 4>(F, m, NGW, inp(F, I_X), g, nullptr, nullptr); }
            else { for (int m = gw; m < SEQ; m += 2 * NGW) norm_rows<1, false, 2>(F, m, NGW, nullptr, g, F.ctl + CW_CNT + 64 * 16 * (l - 1), nullptr); }
            PEND(13);
        }
        PEND(0); SEAM(p0 + 0); PBAR(0);
        if (ON(1) && IN(p0 + 1)) { LAUNDER(); PSTART(1);
            InProjSched S{(const char*)(F.ws + WS_XN), (const char*)(F.ws + ((l & 1) ? WS_WIN2 : WS_WIN)), F.G, (int)blockIdx.x};
            EpiInProj E{(bf16*)(F.ws + WS_ZT), (bf16*)(F.ws + WS_U), inp(F, I_BIN) + (size_t)l * NIN};
            REP(1) pg8::gemm_phase<EpiInProj, InProjSched>(F.lds, DM, S, E, F.tid);
        }
        PEND(1); SEAM(p0 + 1); PBAR(1);
        if (ON(2) && IN(p0 + 2)) { LAUNDER(); PSTART(2);
            if (ON(9)) REP(9) for (int u = F.vcu; u < 512; u += F.G) sgu_unit(F, l, u >> 3, u & 7);
            if (ON(10)) REP(10) for (int b = F.vcu; b < 256; b += F.G) hyena_block(F, l, b);
        }
        PEND(2); SEAM(p0 + 2); PBAR(2);
        if (ON(3) && IN(p0 + 3)) { LAUNDER(); PSTART(3);
            GridSched S{(const char*)(F.ws + WS_Y), (const char*)(F.ws + WS_PT), 32, 8, DM, F.G, (int)blockIdx.x};
            EpiMerge E{(const bf16*)(F.ws + WS_GH), (const bf16*)(F.ws + WS_GS), (bf16*)(F.ws + WS_MERGED)};
            REP(3) pg8::gemm_phase<EpiMerge, GridSched>(F.lds, DM, S, E, F.tid);
        }
        PEND(3); SEAM(p0 + 3); PBAR(3);
        if (ON(4) && IN(p0 + 4)) { LAUNDER(); PSTART(4);
            GridSched S{(const char*)(F.ws + WS_MERGED), (const char*)(F.ws + WS_WOT), 32, 8, DM, F.G, (int)blockIdx.x};
            EpiResid E{l == 0 ? inp(F, I_X) : (const float*)(F.ws + WS_XR), (float*)(F.ws + WS_XR)};
            pg8::gemm_phase<EpiResid, GridSched>(F.lds, DM, S, E, F.tid);
        }
        PEND(4); SEAM(p0 + 4); PBAR(4);
        if (ON(5) && IN(p0 + 5)) { LAUNDER(); PSTART(5); for (int tb = F.vcu * 32; tb < SEQ; tb += F.G * 32) route_block(F, l, tb); }
        PEND(5); SEAM(p0 + 5); PBAR(5);
        if (ON(6) && IN(p0 + 6)) { LAUNDER(); PSTART(6);
            moe_tables(F, l);
            MoeSched1 S{(const LAS int*)(F.lds + MISC_OFF + 128), (const char*)(F.ws + WS_XN), (const char*)(F.ws + WS_WGU), (const int*)(F.ws + WS_LISTS), F.G, F.vcu};
            EpiMoe1 E{(bf16*)(F.ws + WS_ACT), (const float*)(F.ws + WS_LISTS + 512 * 1024), (const float*)(F.ws + WS_LISTS + 1 * MiB + 512 * 1024)};
            REP(6) pg8::gemm_phase<EpiMoe1, MoeSched1>(F.lds, DM, S, E, F.tid);
        }
        PEND(6); SEAM(p0 + 6); PBAR(6);
        if (ON(7) && IN(p0 + 7)) { LAUNDER(); PSTART(7);
            moe_tables(F, l);
            MoeSched2 S{(const LAS int*)(F.lds + MISC_OFF + 128), (const char*)(F.ws + WS_ACT), (const char*)(F.ws + WS_WD), F.G, F.vcu};
            EpiMoe2 E{(bf16*)(F.ws + WS_MOEOUT)};
            REP(7) pg8::gemm_phase<EpiMoe2, MoeSched2>(F.lds, DEXP, S, E, F.tid);
        }
        PEND(7); SEAM(p0 + 7); PBAR(7);
    }
    if (ON(8) && IN(16)) { LAUNDER(); PSTART(8); for (int m = gw; m < SEQ; m += 2 * NGW) norm_rows<1, true, 2>(F, m, NGW, nullptr, inp(F, I_GFINAL), F.ctl + CW_CNT + 64 * 16 * (DEPTH - 1), F.out); }
    PEND(8);
    if (PROBE_K >= 0 && PR_ME) { const unsigned long long t0 = __builtin_amdgcn_s_memrealtime(), amt = pr[1] * PROBE_AMP; while (__builtin_amdgcn_s_memrealtime() - t0 < amt) __builtin_amdgcn_s_sleep(8); }
#undef IN
#undef SEAM
}

#ifndef MK_ONE_LAUNCH
#define MK_ONE_LAUNCH 0
#endif
extern "C" void kernel_launch(void* const* d_in, const int* in_sizes, int n_in, void* d_out, int out_size, void* d_ws, size_t ws_size, hipStream_t stream) {
    static int grid = 0;
    if (grid == 0) {
        if (n_in != 29 || ws_size < WS_END) { fprintf(stderr, "kernel_launch: unexpected n_in %d or ws %zu < %zu\n", n_in, ws_size, (size_t)WS_END); grid = -1; return; }
        int dev = 0, cus = 0, per_cu = 0;
        if (hipGetDevice(&dev) != hipSuccess || hipDeviceGetAttribute(&cus, hipDeviceAttributeMultiprocessorCount, dev) != hipSuccess) { grid = -1; return; }
        if (hipFuncSetAttribute((const void*)fwd_kernel, hipFuncAttributeMaxDynamicSharedMemorySize, LDS_BYTES) != hipSuccess) { fprintf(stderr, "kernel_launch: hipFuncSetAttribute failed\n"); grid = -1; return; }
        if (hipOccupancyMaxActiveBlocksPerMultiprocessor(&per_cu, (const void*)fwd_kernel, NTHR, LDS_BYTES) != hipSuccess || per_cu < 1) fprintf(stderr, "kernel_launch: occupancy query reports %d\n", per_cu);
        (void)hipGetLastError();
        grid = cus;
    }
    if (grid < 0) return;
    (void)hipMemsetAsync((char*)d_ws + WS_CTL, 0, CTL_ZERO_BYTES, stream);
    Args a{};
    for (int i = 0; i < 29; ++i) a.in[i] = (const float*)d_in[i];
    a.out = (float*)d_out; a.ws = (unsigned char*)d_ws;
#if MK_ONE_LAUNCH
    a.ph_lo = 0; a.ph_hi = NPHASE;
    hipLaunchKernelGGL(fwd_kernel, dim3(grid), dim3(NTHR), LDS_BYTES, stream, a);
#else
    for (int p = 0; p < NPHASE; ++p) { a.ph_lo = p; a.ph_hi = p + 1; hipLaunchKernelGGL(fwd_kernel, dim3(grid), dim3(NTHR), LDS_BYTES, stream, a); }
#endif
}
```

```cpp
#include <hip/hip_runtime.h>
#include <cstdio>
#include <cstdint>
#define MK_ONE_LAUNCH 1
#define DUP_MASK 0
#define PROBE_K -1
#define PROBE_PART 0
namespace pg8 {
#define PG8_LAS __attribute__((address_space(3)))
typedef unsigned short bf16_t;
typedef short bf16x8 __attribute__((ext_vector_type(8)));
typedef float f32x4 __attribute__((ext_vector_type(4)));
typedef float f32x2 __attribute__((ext_vector_type(2)));
typedef unsigned u32x4 __attribute__((ext_vector_type(4)));
typedef unsigned u32x2 __attribute__((ext_vector_type(2)));
constexpr int BM = 256, BK = 64, HALF = 128, HTB = HALF * BK * 2  , STAGE_BYTES = 8 * HTB;
constexpr int GATHER_SLOT_OFF = 2 * 8448 * 8 + 1024;

__host__ __device__ __forceinline__ int lds_byte(int r, int c) { const int st = (r >> 4) * 2 + (c >> 5), rr = r & 15, cc = c & 31, ob = rr * 64 + cc * 2; return st * 1024 + (ob ^ (((ob >> 9) & 1) << 5)); }
__host__ __device__ __forceinline__ void stage_rc(int b, int& R, int& C) { const int st = b / 1024, sb = b % 1024, swz = sb ^ (((sb >> 9) & 1) << 5); R = (st >> 1) * 16 + swz / 64; C = (st & 1) * 32 + (swz % 64) / 2; }
__host__ __device__ __forceinline__ int perm32(int rho) { const int n = rho >> 4, i = rho & 15; return 8 * (i >> 2) + 4 * n + (i & 3); }

struct Unit { int pm, pn, kind, e, row0, nvalid; };

__device__ __forceinline__ unsigned cvt_pk_bf16(float lo, float hi) { unsigned r; asm volatile("v_cvt_pk_bf16_f32 %0, %1, %2" : "=v"(r) : "v"(lo), "v"(hi)); return r; }
__device__ __forceinline__ f32x2 gelu_pk(f32x2 v) {
    const f32x2 av = __builtin_elementwise_abs(v), d = av * 0.2316418882f + 1.0f;
    f32x2 t; t.x = __builtin_amdgcn_rcpf(d.x); t.y = __builtin_amdgcn_rcpf(d.y);
    f32x2 q = t * 0.5307027145f + (-0.7265760135f); q = q * t + 0.7107068705f; q = q * t + (-0.142248368f); q = q * t + 0.127414796f; q = q * t;
    const f32x2 s = (v * v) * (-0.72134752044f);
    f32x2 e; e.x = __builtin_amdgcn_exp2f(s.x); e.y = __builtin_amdgcn_exp2f(s.y);
    const f32x2 m = v * (q * e), r = v - m;
    f32x2 o; o.x = v.x < 0.f ? m.x : r.x; o.y = v.y < 0.f ? m.y : r.y; return o;
}
__device__ __forceinline__ float sigmoid_f(float x) { return __builtin_amdgcn_rcpf(1.0f + __builtin_amdgcn_exp2f(-1.4426950408889634f * x)); }

template <class Epi, class Sched>
__device__ __forceinline__ void gemm_phase(PG8_LAS unsigned char* lds, const int K, const Sched& S, const Epi& E, int tid) {
    asm volatile("" : "+v"(tid));
    const int wid = __builtin_amdgcn_readfirstlane(tid >> 6), lane = tid & 63, wr = wid >> 2, wc = wid & 3, fr = lane & 15, fq = lane >> 4;
    const int nt = K / BK;
    unsigned voffA[2], voffB[2];
#pragma unroll
    for (int i = 0; i < 2; ++i) { int R, C; stage_rc(tid * 16 + i * 8192, R, C); const int Rb = Epi::PERM ? ((R & ~31) + perm32(R & 31)) : R;
        voffA[i] = Sched::GATHER ? 0u : (unsigned)(R * K + C) * 2u; voffB[i] = (unsigned)(Rb * K + C) * 2u; }
#define PG8_GOFF(u, h, i) ({ int _R, _C, _t = tid; asm volatile("" : "+v"(_t)); stage_rc(_t * 16 + (i) * 8192, _R, _C); S.a_goff((u), (h) * HALF + _R) + (unsigned)(_C * 2); })
    const size_t kstep = (size_t)(BK * 2);
    const size_t hstep = (size_t)HALF * K * 2;
    const unsigned ldsw = (unsigned)wid * 1024u;
    const int aoff = lds_byte(wr * 64 + fr, fq * 8), boff = lds_byte(wc * 32 + fr, fq * 8);
#define PG8_SA(b, h) (((b) * 2 + (h)) * HTB)
#define PG8_SB(b, h) ((4 + (b) * 2 + (h)) * HTB)
#define PG8_STAGE(bufoff, gbase, voff) do { _Pragma("unroll") for (int _i = 0; _i < 2; ++_i) \
        __builtin_amdgcn_global_load_lds((const unsigned*)((const char*)(gbase) + (voff)[_i]), (PG8_LAS unsigned*)(lds + (bufoff) + ldsw + _i * 8192), 16, 0, 0); } while (0)
#define PG8_STAGE_A(bufoff, gbase, h, GO) do { if constexpr (Sched::GATHER) { _Pragma("unroll") for (int _i = 0; _i < 2; ++_i) \
        __builtin_amdgcn_global_load_lds((const unsigned*)((const char*)(gbase) + (GO)[h][_i]), (PG8_LAS unsigned*)(lds + (bufoff) + ldsw + _i * 8192), 16, 0, 0); } \
        else { PG8_STAGE(bufoff, (gbase) + (h) * hstep, voffA); } } while (0)
#define PG8_LDA(dst, b, h) do { _Pragma("unroll") for (int m = 0; m < 4; ++m) _Pragma("unroll") for (int k = 0; k < 2; ++k) dst[m][k] = *(const PG8_LAS bf16x8*)(lds + PG8_SA(b, h) + aoff + m * 2048 + k * 1024); } while (0)
#define PG8_LDB(dst, b, h) do { _Pragma("unroll") for (int n = 0; n < 2; ++n) _Pragma("unroll") for (int k = 0; k < 2; ++k) dst[n][k] = *(const PG8_LAS bf16x8*)(lds + PG8_SB(b, h) + boff + n * 2048 + k * 1024); } while (0)
#define PG8_MMA(ai, bj, At, Bt) do { __builtin_amdgcn_s_setprio(1); _Pragma("unroll") for (int m = 0; m < 4; ++m) _Pragma("unroll") for (int n = 0; n < 2; ++n) _Pragma("unroll") for (int k = 0; k < 2; ++k) \
        acc[ai][bj][m][n] = __builtin_amdgcn_mfma_f32_16x16x32_bf16(Bt[n][k], At[m][k], acc[ai][bj][m][n], 0, 0, 0); __builtin_amdgcn_s_setprio(0); } while (0)
#define PG8_WAIT_V(n) asm volatile("s_waitcnt vmcnt(" #n ")" ::: "memory")
#define PG8_WAIT_L(n) asm volatile("s_waitcnt lgkmcnt(" #n ")" ::: "memory")
#define PG8_BAR __builtin_amdgcn_s_barrier()
#define PG8_SCHED __builtin_amdgcn_sched_barrier(0)
    Unit cur, nxt; int ui = 0;
    if (!S.next(0, cur)) return;
    f32x4 acc[2][2][4][2];
#pragma unroll
    for (int a = 0; a < 2; ++a)
#pragma unroll
        for (int b = 0; b < 2; ++b)
#pragma unroll
            for (int m = 0; m < 4; ++m)
#pragma unroll
                for (int n = 0; n < 2; ++n) acc[a][b][m][n] = (f32x4){0.f, 0.f, 0.f, 0.f};
    bf16x8 At[4][2], B0[2][2], B1[2][2];
    const char* cA = S.a_base(cur); const char* cB = S.b_base(cur);
    unsigned cgo[2][2];
    PG8_LAS u32x4* gslot = (PG8_LAS u32x4*)(lds + GATHER_SLOT_OFF) + tid;
    if constexpr (Sched::GATHER) {
#pragma unroll
        for (int h = 0; h < 2; ++h)
#pragma unroll
            for (int i = 0; i < 2; ++i) cgo[h][i] = PG8_GOFF(cur, h, i);
    }
    PG8_STAGE(PG8_SB(0, 0), cB, voffB); PG8_STAGE(PG8_SB(0, 1), cB + hstep, voffB); PG8_STAGE_A(PG8_SA(0, 0), cA, 0, cgo); PG8_STAGE_A(PG8_SA(0, 1), cA, 1, cgo);
    if (wr == 1) PG8_BAR;
    PG8_WAIT_V(2); PG8_BAR;
    PG8_STAGE(PG8_SB(1, 0), cB + kstep, voffB); PG8_STAGE_A(PG8_SA(1, 0), cA + kstep, 0, cgo); PG8_STAGE(PG8_SB(1, 1), cB + hstep + kstep, voffB);
    PG8_WAIT_V(6); PG8_BAR;
    for (;;) {
        const bool has_next = S.next(ui + 1, nxt);
        const char* nA = has_next ? S.a_base(nxt) : cA; const char* nB = has_next ? S.b_base(nxt) : cB;
        if constexpr (Sched::GATHER) {
            u32x4 nx = (u32x4){cgo[0][0], cgo[0][1], cgo[1][0], cgo[1][1]};
            if (has_next) { nx.x = PG8_GOFF(nxt, 0, 0); nx.y = PG8_GOFF(nxt, 0, 1); nx.z = PG8_GOFF(nxt, 1, 0); nx.w = PG8_GOFF(nxt, 1, 1); }
            *gslot = nx;
        }
        for (int t = 0; t < nt; t += 2) {
            const bool last = (t == nt - 2);
            if constexpr (Epi::MIDK) { if (t == (nt >> 1)) { int tl = tid; asm volatile("" : "+v"(tl)); E.mid(acc, cur, wr, wc, tl & 15, (tl >> 4) & 3); } }
            const char* a1 = cA + (size_t)(t + 1) * kstep;
            const char* a2 = last ? nA : cA + (size_t)(t + 2) * kstep; const char* b2 = last ? nB : cB + (size_t)(t + 2) * kstep;
            const char* a3 = a2 + kstep; const char* b3 = b2 + kstep;
            unsigned xgo[2][2];
            if constexpr (Sched::GATHER) {
                if (last) { const u32x4 nx = *gslot; xgo[0][0] = nx.x; xgo[0][1] = nx.y; xgo[1][0] = nx.z; xgo[1][1] = nx.w; }
                else { xgo[0][0] = cgo[0][0]; xgo[0][1] = cgo[0][1]; xgo[1][0] = cgo[1][0]; xgo[1][1] = cgo[1][1]; }
            }
            PG8_LDB(B0, 0, 0); PG8_LDB(B1, 0, 1); PG8_SCHED; PG8_LDA(At, 0, 0); PG8_STAGE_A(PG8_SA(1, 1), a1, 1, cgo);
            PG8_WAIT_V(8); PG8_WAIT_L(0); PG8_BAR; PG8_MMA(0, 0, At, B0); PG8_MMA(0, 1, At, B1); PG8_BAR; PG8_SCHED;
            PG8_LDA(At, 0, 1); PG8_STAGE(PG8_SB(0, 0), b2, voffB); PG8_STAGE(PG8_SB(0, 1), b2 + hstep, voffB); PG8_STAGE_A(PG8_SA(0, 0), a2, 0, xgo);
            PG8_WAIT_V(8); PG8_WAIT_L(0); PG8_BAR; PG8_MMA(1, 0, At, B0); PG8_MMA(1, 1, At, B1); PG8_BAR; PG8_SCHED;
            PG8_LDB(B0, 1, 0); PG8_LDB(B1, 1, 1); PG8_SCHED; PG8_LDA(At, 1, 0); PG8_STAGE_A(PG8_SA(0, 1), a2, 1, xgo);
            PG8_WAIT_V(8); PG8_WAIT_L(0); PG8_BAR; PG8_MMA(0, 0, At, B0); PG8_MMA(0, 1, At, B1); PG8_BAR; PG8_SCHED;
            PG8_LDA(At, 1, 1); PG8_STAGE(PG8_SB(1, 0), b3, voffB); PG8_STAGE(PG8_SB(1, 1), b3 + hstep, voffB); PG8_STAGE_A(PG8_SA(1, 0), a3, 0, xgo);
            PG8_WAIT_V(8); PG8_WAIT_L(0); PG8_BAR; PG8_MMA(1, 0, At, B0); PG8_MMA(1, 1, At, B1); PG8_BAR; PG8_SCHED;
        }
        if (wr == 0) PG8_BAR;
        { int tl = tid; asm volatile("" : "+v"(tl)); E(acc, cur, wr, wc, tl & 15, (tl >> 4) & 3); }
        if (!has_next) break;
#pragma unroll
        for (int a = 0; a < 2; ++a)
#pragma unroll
            for (int b = 0; b < 2; ++b)
#pragma unroll
                for (int m = 0; m < 4; ++m)
#pragma unroll
                    for (int n = 0; n < 2; ++n) acc[a][b][m][n] = (f32x4){0.f, 0.f, 0.f, 0.f};
        cur = nxt; cA = nA; cB = nB; ++ui;
        if constexpr (Sched::GATHER) { const u32x4 nx = *gslot; cgo[0][0] = nx.x; cgo[0][1] = nx.y; cgo[1][0] = nx.z; cgo[1][1] = nx.w; }
        if (wr == 1) PG8_BAR;
    }
    PG8_WAIT_V(0);
    PG8_BAR;
#undef PG8_SA
#undef PG8_SB
#undef PG8_STAGE
#undef PG8_STAGE_A
#undef PG8_GOFF
#undef PG8_LDA
#undef PG8_LDB
#undef PG8_MMA
#undef PG8_WAIT_V
#undef PG8_WAIT_L
#undef PG8_BAR
#undef PG8_SCHED
}
}
constexpr int NWAVES = 8, NTHR = 512;
constexpr int SEQ = 8192, DM = 2048, NIN = 9216, HYW = 1024, SGW = 1024, NHY = 3072, NEXP = 16, DEXP = 512, DEPTH = 2;
constexpr float EPS = 1e-6f;
constexpr size_t MiB = 1u << 20;
constexpr size_t WS_CTL = 0, CTL_ZERO_BYTES = 1 * MiB;
constexpr size_t WS_WIN = 1 * MiB;
constexpr size_t WS_WIN2 = WS_WIN + 36 * MiB;
constexpr size_t WS_PT = WS_WIN2 + 36 * MiB;
constexpr size_t WS_WOT = WS_PT + 8 * MiB;
constexpr size_t WS_WGU = WS_WOT + 8 * MiB;
constexpr size_t WS_WD = WS_WGU + 64 * MiB;
constexpr size_t WS_W3T = WS_WD + 32 * MiB;
constexpr size_t WS_A2 = WS_W3T + 1 * MiB;
constexpr size_t WS_WR = WS_A2 + 1 * MiB;
constexpr size_t WS_LISTS = WS_WR + 1 * MiB;
constexpr size_t WS_XR = WS_LISTS + 2 * MiB;
constexpr size_t WS_XN = WS_XR + 64 * MiB;
constexpr size_t WS_ZT = WS_XN + 32 * MiB;
constexpr size_t WS_U = WS_ZT + 48 * MiB;
constexpr size_t WS_GV = WS_U + 16 * MiB;
constexpr size_t WS_GH = WS_GV + 16 * MiB;
constexpr size_t WS_GS = WS_GH + 32 * MiB;
constexpr size_t WS_Y = WS_GS + 32 * MiB;
constexpr size_t WS_FS = WS_Y + 32 * MiB;
constexpr size_t WS_END = WS_FS + 64 * MiB;
constexpr size_t WS_MERGED = WS_ZT, WS_ACT = WS_U, WS_MOEOUT = WS_FS;
constexpr int CW_TMO = 0;
constexpr int CW_CNT = 8192;
constexpr int CW_BAR = 4096;
constexpr int SCRATCH_BYTES = 2 * 8448 * 8;
constexpr int MISC_OFF = SCRATCH_BYTES;
constexpr int CVS_OFF = MISC_OFF + 1024;
constexpr int LDS_BYTES = SCRATCH_BYTES + 1024 + 8 * 2112;
static_assert(pg8::GATHER_SLOT_OFF == MISC_OFF + 1024, "gather slots");
static_assert(SCRATCH_BYTES >= pg8::STAGE_BYTES, "lds");

#define GAS __attribute__((address_space(1)))
#define LAS __attribute__((address_space(3)))
typedef unsigned short bf16;
typedef unsigned v4u __attribute__((ext_vector_type(4)));
typedef unsigned v2u __attribute__((ext_vector_type(2)));
typedef float f32x4 __attribute__((ext_vector_type(4)));
typedef short bf16x8 __attribute__((ext_vector_type(8)));
typedef GAS unsigned gu32;
#define RLX_AGENT __ATOMIC_RELAXED, __HIP_MEMORY_SCOPE_AGENT
#define LDS_WAIT() asm volatile("s_waitcnt lgkmcnt(0)" ::: "memory")
#define VM_WAIT() asm volatile("s_waitcnt vmcnt(0)" ::: "memory")
__device__ __forceinline__ unsigned f2bf(float f) { unsigned u = __builtin_bit_cast(unsigned, f); return (u + 0x7fffu + ((u >> 16) & 1u)) >> 16; }
__device__ __forceinline__ unsigned pk2(float lo, float hi) { return f2bf(lo) | (f2bf(hi) << 16); }
__device__ __forceinline__ float bfl(unsigned u) { return __builtin_bit_cast(float, u << 16); }
__device__ __forceinline__ float bfh(unsigned u) { return __builtin_bit_cast(float, u & 0xffff0000u); }

#define XB_TMO      128
#define XB_XCNT(j)  (256  + 64 * (j))
#define XB_XSUB(j)  (1280 + 64 * (j))
#define XB_XGEN(j)  (2304 + 64 * (j))
#define XB_TOP      3328
#define XB_TOPGEN   3392
#define XCD_BAR_WORDS 3456
#define XB_SPIN_CAP (1u << 18)
__device__ __forceinline__ unsigned xb_ld(unsigned* p)              { return __hip_atomic_load(p, __ATOMIC_RELAXED, __HIP_MEMORY_SCOPE_AGENT); }
__device__ __forceinline__ unsigned xb_add(unsigned* p, unsigned v) { return __hip_atomic_fetch_add(p, v, __ATOMIC_RELAXED, __HIP_MEMORY_SCOPE_AGENT); }
__device__ __forceinline__ unsigned xb_xcc_id() { return (unsigned)__builtin_amdgcn_s_getreg((3 << 11) | 20) & 0xFu; }
#define XB_SPIN(cond, bar) do { unsigned _sp = 0; while (cond) { __builtin_amdgcn_s_sleep(1); \
    if ((++_sp & 255u) == 0u) { if (xb_ld(&(bar)[XB_TMO])) break; if (_sp > XB_SPIN_CAP) { atomicAdd(&(bar)[XB_TMO], 1u); break; } } } } while (0)
struct XcdBarrier { unsigned* bar; unsigned x; volatile LAS unsigned* st; };
__device__ __forceinline__ XcdBarrier xcd_barrier_post(unsigned* bar, volatile LAS unsigned* st) {
    XcdBarrier b; b.bar = bar; b.x = xb_xcc_id(); b.st = st;
    if (threadIdx.x == 0) (void)xb_add(&bar[XB_XCNT(b.x)], 1u);
    return b;
}
__device__ __forceinline__ void xcd_barrier_complete(unsigned* bar, unsigned x, unsigned& nloc, unsigned& nx) {
    const unsigned G = gridDim.x * gridDim.y * gridDim.z;
    unsigned sum, cnt, mine, sp = 0u;
    for (;;) {
        sum = 0u; cnt = 0u; mine = 0u;
#pragma unroll
        for (unsigned j = 0; j < 16; ++j) { const unsigned c = xb_ld(&bar[XB_XCNT(j)]); sum += c; cnt += (c > 0u) ? 1u : 0u; mine = (j == x) ? c : mine; }
        if (sum == G) break;
        __builtin_amdgcn_s_sleep(1);
        if ((++sp & 255u) == 0u) { if (xb_ld(&bar[XB_TMO])) break; if (sp > XB_SPIN_CAP) { atomicAdd(&bar[XB_TMO], 1u); break; } }
    }
    nloc = mine > 0u ? mine : 1u; nx = cnt > 0u ? cnt : 1u;
}
__device__ __forceinline__ void xcd_barrier(const XcdBarrier& b) {
    asm volatile("s_waitcnt vmcnt(0)" ::: "memory");
    __syncthreads();
    if (threadIdx.x == 0) {
        unsigned* bar = b.bar;
        __builtin_amdgcn_s_waitcnt(0);
        unsigned nloc = b.st[0], nx = b.st[1];
        if (nloc == 0u) { xcd_barrier_complete(bar, b.x, nloc, nx); b.st[0] = nloc; b.st[1] = nx; }
        const unsigned old = xb_add(&bar[XB_XSUB(b.x)], 1u);
        const unsigned gen = old / nloc;
        if (old + 1u == (gen + 1u) * nloc) {
            __builtin_amdgcn_fence(__ATOMIC_RELEASE, "agent");
            asm volatile("s_waitcnt vmcnt(0)" ::: "memory");
            const unsigned og = xb_add(&bar[XB_TOP], 1u);
            const unsigned tg = og / nx;
            if (og + 1u == (tg + 1u) * nx) xb_add(&bar[XB_TOPGEN], 1u);
            else XB_SPIN(xb_ld(&bar[XB_TOPGEN]) == tg, bar);
            __builtin_amdgcn_fence(__ATOMIC_ACQUIRE, "agent");
            xb_add(&bar[XB_XGEN(b.x)], 1u);
            asm volatile("s_waitcnt vmcnt(0)" ::: "memory");
        } else {
            XB_SPIN(xb_ld(&bar[XB_XGEN(b.x)]) == gen, bar);
            __builtin_amdgcn_fence(__ATOMIC_ACQUIRE, "agent");
            asm volatile("s_waitcnt vmcnt(0)" ::: "memory");
        }
    }
    __syncthreads();
}

struct Frame {
    LAS unsigned char* lds;
    volatile LAS unsigned* MISC;
    gu32* ctl;
    int tid, lane, wave;
    int vcu, G;
    const LAS unsigned long long* inp;
    float* out;
    unsigned char* ws;
};
enum { I_X = 0, I_GMIX, I_WIN, I_BIN, I_CONVW, I_CONVB, I_FW1, I_FB1, I_FW2, I_FB2, I_FW3, I_FFREQ, I_SKIP, I_LNG, I_LNB, I_SGW, I_SGB, I_WHY, I_WSG, I_WOUT, I_GFFN, I_WRG, I_BRG, I_WRE, I_BRE, I_WGATE, I_WUP, I_WDOWN, I_GFINAL };

__device__ __forceinline__ const float* inp(const Frame& F, int k) { const unsigned long long v = F.inp[k]; const unsigned lo = __builtin_amdgcn_readfirstlane((unsigned)v), hi = __builtin_amdgcn_readfirstlane((unsigned)(v >> 32));
    return (const float*)(((unsigned long long)hi << 32) | (unsigned long long)lo); }
__device__ __forceinline__ float shfl_xor_l(float v, int mask, int lane) { return __builtin_bit_cast(float, __builtin_amdgcn_ds_bpermute((lane ^ mask) << 2, __builtin_bit_cast(int, v))); }
__device__ __forceinline__ float shfl_down1_l(float v, int lane) { return __builtin_bit_cast(float, __builtin_amdgcn_ds_bpermute(((lane + 1) & 63) << 2, __builtin_bit_cast(int, v))); }
__device__ __forceinline__ float wave_sum(float v, int lane) {
#pragma unroll
    for (int o = 1; o < 64; o <<= 1) v += shfl_xor_l(v, o, lane);
    return v;
}

#ifndef PROBE_K
#define PROBE_K -1
#endif
#define HP_ME (blockIdx.x == 0 && threadIdx.x == 0)
#define HPS(j) do { if (PROBE_K == (j) && HP_ME) ((volatile LAS unsigned long long*)(F.lds + MISC_OFF + 512))[0] = __builtin_amdgcn_s_memrealtime(); } while (0)
#define HPE(j) do { if (PROBE_K == (j) && HP_ME) { volatile LAS unsigned long long* _p = (volatile LAS unsigned long long*)(F.lds + MISC_OFF + 512); _p[1] += __builtin_amdgcn_s_memrealtime() - _p[0]; } } while (0)
#define HD __device__ __forceinline__
#define HY_OPAQUE(x) asm volatile("" : "+v"(x))
typedef float hy_f2v __attribute__((ext_vector_type(2)));
#define LDC(p, i) ({ const hy_f2v _v = *(const LAS hy_f2v*)((p) + (i)); c32 _r; _r.x = _v.x; _r.y = _v.y; _r; })
#define STC(p, i, v) do { const c32 _s = (v); hy_f2v _w; _w.x = _s.x; _w.y = _s.y; *(LAS hy_f2v*)((p) + (i)) = _w; } while (0)
#define FADD(a, b) ({ float _r; asm("v_add_f32 %0, %1, %2" : "=v"(_r) : "v"((float)(a)), "v"((float)(b))); _r; })
#define FSUB(a, b) ({ float _r; asm("v_sub_f32 %0, %1, %2" : "=v"(_r) : "v"((float)(a)), "v"((float)(b))); _r; })
#define FMUL(a, b) ({ float _r; asm("v_mul_f32 %0, %1, %2" : "=v"(_r) : "v"((float)(a)), "v"((float)(b))); _r; })
#define FFMA(a, b, c) ({ float _r; asm("v_fma_f32 %0, %1, %2, %3" : "=v"(_r) : "v"((float)(a)), "v"((float)(b)), "v"((float)(c))); _r; })
#define FNMA(a, b, c) ({ float _r; asm("v_fma_f32 %0, -%1, %2, %3" : "=v"(_r) : "v"((float)(a)), "v"((float)(b)), "v"((float)(c))); _r; })
struct c32 { float x, y; };
HD c32 cmk(float x, float y) { c32 r; r.x = x; r.y = y; return r; }
HD c32 cadd(c32 a, c32 b) { return cmk(FADD(a.x, b.x), FADD(a.y, b.y)); }
HD c32 csub(c32 a, c32 b) { return cmk(FSUB(a.x, b.x), FSUB(a.y, b.y)); }
HD c32 cmul(c32 a, c32 b) { return cmk(FNMA(a.y, b.y, FMUL(a.x, b.x)), FFMA(a.y, b.x, FMUL(a.x, b.y))); }
HD c32 cmulc(c32 a, c32 b) { return cmk(FFMA(a.y, b.y, FMUL(a.x, b.x)), FNMA(a.x, b.y, FMUL(a.y, b.x))); }
HD c32 cscale(c32 a, float f) { return cmk(FMUL(a.x, f), FMUL(a.y, f)); }
HD c32 cadd_mi(c32 a, c32 b) { return cmk(FADD(a.x, b.y), FSUB(a.y, b.x)); }
HD c32 cadd_pi(c32 a, c32 b) { return cmk(FSUB(a.x, b.y), FADD(a.y, b.x)); }
#define HY_N 8192
#define HY_LDS_C32 (8192 + 256)

template <int SIGN> HD void dft4(c32& a, c32& b, c32& c, c32& d) {
    const c32 t0 = cadd(a, c), t1 = csub(a, c), t2 = cadd(b, d), t3 = csub(b, d);
    a = cadd(t0, t2); c = csub(t0, t2);
    if (SIGN < 0) { b = cadd_mi(t1, t3); d = cadd_pi(t1, t3); }
    else          { b = cadd_pi(t1, t3); d = cadd_mi(t1, t3); }
}
template <int SIGN> HD void dft16(c32 (&a)[16]) {
    const float C1 = 0.92387953251128674f, S1 = 0.38268343236508977f, R2 = 0.70710678118654752f;
#pragma unroll
    for (int n2 = 0; n2 < 4; ++n2) dft4<SIGN>(a[n2], a[4 + n2], a[8 + n2], a[12 + n2]);
    const float sg = (SIGN < 0) ? -1.f : 1.f;
    const c32 w1 = cmk(C1, sg * S1), w2 = cmk(R2, sg * R2), w3 = cmk(S1, sg * C1), w6 = cmk(-R2, sg * R2), w9 = cmk(-C1, -sg * S1);
    a[1 + 4] = cmul(a[1 + 4], w1); a[2 + 4] = cmul(a[2 + 4], w2); a[3 + 4] = cmul(a[3 + 4], w3);
    a[1 + 8] = cmul(a[1 + 8], w2); a[2 + 8] = (SIGN < 0) ? cmk(a[2 + 8].y, -a[2 + 8].x) : cmk(-a[2 + 8].y, a[2 + 8].x); a[3 + 8] = cmul(a[3 + 8], w6);
    a[1 + 12] = cmul(a[1 + 12], w3); a[2 + 12] = cmul(a[2 + 12], w6); a[3 + 12] = cmul(a[3 + 12], w9);
#pragma unroll
    for (int k1 = 0; k1 < 4; ++k1) dft4<SIGN>(a[4 * k1], a[4 * k1 + 1], a[4 * k1 + 2], a[4 * k1 + 3]);
    c32 t[16];
#pragma unroll
    for (int i = 0; i < 16; ++i) t[i] = a[i];
#pragma unroll
    for (int k1 = 0; k1 < 4; ++k1)
#pragma unroll
        for (int k2 = 0; k2 < 4; ++k2) a[k1 + 4 * k2] = t[4 * k1 + k2];
}
HD void twiddle_tree(c32 (&a)[16], c32 w1) {
    const c32 w2 = cmul(w1, w1), w3 = cmul(w2, w1), w4 = cmul(w2, w2), w5 = cmul(w4, w1), w6 = cmul(w4, w2), w7 = cmul(w4, w3), w8 = cmul(w4, w4);
    a[1] = cmul(a[1], w1); a[2] = cmul(a[2], w2); a[3] = cmul(a[3], w3); a[4] = cmul(a[4], w4); a[5] = cmul(a[5], w5); a[6] = cmul(a[6], w6); a[7] = cmul(a[7], w7); a[8] = cmul(a[8], w8);
    a[9] = cmul(a[9], cmul(w8, w1)); a[10] = cmul(a[10], cmul(w8, w2)); a[11] = cmul(a[11], cmul(w8, w3)); a[12] = cmul(a[12], cmul(w8, w4));
    a[13] = cmul(a[13], cmul(w8, w5)); a[14] = cmul(a[14], cmul(w8, w6)); a[15] = cmul(a[15], cmul(w8, w7));
}
HD c32 cis_pi(float x) { return cmk(cospif(x), sinpif(x)); }

HD void fft_s1_fwd(int tid, LAS c32* buf, c32 (&a)[16]) { HY_OPAQUE(tid);
    dft16<-1>(a);
    twiddle_tree(a, cis_pi(-2.0f * (float)tid / 8192.0f));
    LAS c32* p0 = buf + tid + (tid >> 5);
#pragma unroll
    for (int p = 0; p < 16; ++p) STC(p0, 528 * p, a[p]);
}
HD void fft_s2_fwd(int tid, LAS c32* buf) { HY_OPAQUE(tid);
    LAS c32* p0 = buf + (tid >> 5) * 528 + (tid & 31);
    c32 a[16];
#pragma unroll
    for (int q = 0; q < 16; ++q) a[q] = LDC(p0, 33 * q);
    dft16<-1>(a);
    twiddle_tree(a, cis_pi(-2.0f * (float)(tid & 31) / 512.0f));
#pragma unroll
    for (int p = 0; p < 16; ++p) STC(p0, 33 * p, a[p]);
}
HD float w32c(int q) { switch (q) { case 0: return 1.0f; case 1: return 0.98078528040323043f; case 2: return 0.92387953251128674f; case 3: return 0.83146961230254524f; case 4: return 0.70710678118654752f; case 5: return 0.55557023301960218f; case 6: return 0.38268343236508977f; case 7: return 0.19509032201612825f;
    case 8: return 0.0f; case 9: return -0.19509032201612825f; case 10: return -0.38268343236508977f; case 11: return -0.55557023301960218f; case 12: return -0.70710678118654752f; case 13: return -0.83146961230254524f; case 14: return -0.92387953251128674f; default: return -0.98078528040323043f; } }
HD float w32s(int q) { switch (q) { case 0: return 0.0f; case 1: return 0.19509032201612825f; case 2: return 0.38268343236508977f; case 3: return 0.55557023301960218f; case 4: return 0.70710678118654752f; case 5: return 0.83146961230254524f; case 6: return 0.92387953251128674f; case 7: return 0.98078528040323043f;
    case 8: return 1.0f; case 9: return 0.98078528040323043f; case 10: return 0.92387953251128674f; case 11: return 0.83146961230254524f; case 12: return 0.70710678118654752f; case 13: return 0.55557023301960218f; case 14: return 0.38268343236508977f; default: return 0.19509032201612825f; } }
template <int SIGN> HD void fft_s3_read(int tid, const LAS c32* buf, c32 (&s)[16]) { HY_OPAQUE(tid);
    const LAS c32* p0 = buf + (tid >> 1) * 33; const int h = tid & 1;
    const float sg = (SIGN < 0) ? -1.f : 1.f, hs = h ? -1.f : 1.f;
#pragma unroll
    for (int q = 0; q < 16; ++q) {
        const c32 u = LDC(p0, q), v = LDC(p0, q + 16);
        const c32 d = cmk(FFMA(v.x, hs, u.x), FFMA(v.y, hs, u.y));
        const c32 w = h ? cmk(w32c(q), sg * w32s(q)) : cmk(1.f, 0.f);
        s[q] = (q == 0) ? d : cmul(d, w);
    }
    dft16<SIGN>(s);
}
HD void fft_s3_write(int tid, LAS c32* buf, const c32 (&s)[16]) { HY_OPAQUE(tid);
    LAS c32* p0 = buf + (tid >> 1) * 33 + (tid & 1);
#pragma unroll
    for (int p = 0; p < 16; ++p) STC(p0, 2 * p, s[p]);
}
HD void fft_s2_inv(int tid, LAS c32* buf) { HY_OPAQUE(tid);
    LAS c32* p0 = buf + (tid >> 5) * 528 + (tid & 31);
    c32 a[16];
#pragma unroll
    for (int q = 0; q < 16; ++q) a[q] = LDC(p0, 33 * q);
    twiddle_tree(a, cis_pi(2.0f * (float)(tid & 31) / 512.0f));
    dft16<1>(a);
#pragma unroll
    for (int p = 0; p < 16; ++p) STC(p0, 33 * p, a[p]);
}
HD void fft_s1_inv(int tid, const LAS c32* buf, c32 (&a)[16]) { HY_OPAQUE(tid);
    const LAS c32* p0 = buf + tid + (tid >> 5);
#pragma unroll
    for (int p = 0; p < 16; ++p) a[p] = LDC(p0, 528 * p);
    twiddle_tree(a, cis_pi(2.0f * (float)tid / 8192.0f));
    dft16<1>(a);
}
HD void pair_pass(int tid, LAS c32* Z, const LAS c32* H) { HY_OPAQUE(tid);
    const int p3 = tid & 31;
    const c32 wp3 = cis_pi(-(float)p3 / 32.0f);
    const c32 wstep = cis_pi(-16.0f / 8192.0f);
    c32 wlow = cis_pi(-(float)(tid >> 5) / 8192.0f);
#pragma unroll 1
    for (int it = 0; it < 9; ++it) {
        const int low = it * 16 + (tid >> 5);
        const c32 Wk = cmul(wlow, wp3);
        wlow = cmul(wlow, wstep);
        if (low > 128) continue;
        bool act = true; int p3b = 31 - p3, lowb = 256 - low;
        if (low == 0) { act = p3 <= 16; p3b = (32 - p3) & 31; lowb = 0; }
        else if (low == 128) { act = p3 <= 15; lowb = 128; }
        if (!act) continue;
        const int pa = (low & 15) * 528 + (low >> 4) * 33 + p3, pb = (lowb & 15) * 528 + (lowb >> 4) * 33 + p3b;
        const c32 A = LDC(Z, pa), B = LDC(Z, pb), HA = LDC(H, pa), HB = LDC(H, pb);
        c32 E = cmk(FMUL(FADD(A.x, B.x), 0.5f), FMUL(FSUB(A.y, B.y), 0.5f)), O = cmk(FMUL(FADD(A.y, B.y), 0.5f), FMUL(FSUB(B.x, A.x), 0.5f));
        c32 T = cmul(Wk, O);
        const c32 X = cadd(E, T), Xm = csub(E, T);
        E = cmk(FMUL(FADD(HA.x, HB.x), 0.5f), FMUL(FSUB(HA.y, HB.y), 0.5f)); O = cmk(FMUL(FADD(HA.y, HB.y), 0.5f), FMUL(FSUB(HB.x, HA.x), 0.5f));
        T = cmul(Wk, O);
        const c32 Hk = cadd(E, T), Hm = csub(E, T);
        const c32 Y = cmul(X, Hk), Ypc = cmul(Xm, Hm);
        const float sc = 0.5f / 8192.0f;
        const c32 Ye = cscale(cadd(Y, Ypc), sc), Yd = cscale(csub(Y, Ypc), sc);
        const c32 Yo = cmulc(Yd, Wk);
        STC(Z, pa, cmk(FSUB(Ye.x, Yo.y), FADD(Ye.y, Yo.x)));
        if (pb != pa) STC(Z, pb, cmk(FADD(Ye.x, Yo.y), FSUB(Yo.x, Ye.y)));
    }
}
HD float bf_lo(unsigned u) { unsigned v = u << 16; return __builtin_bit_cast(float, v); }
HD float bf_hi(unsigned u) { unsigned v = u & 0xffff0000u; return __builtin_bit_cast(float, v); }
HD void hy_conv3_load(int tid, const unsigned* zrow, float c0, float c1, float c2, float cb, c32 (&out)[8]) { HY_OPAQUE(tid);
    unsigned wm[8], wl[8], wr[8];
#pragma unroll
    for (int q = 0; q < 8; ++q) { const int m = tid + 512 * q; wm[q] = zrow[m]; wl[q] = (m > 0) ? zrow[m - 1] : 0u; wr[q] = (m < 4095) ? zrow[m + 1] : 0u; }
#pragma unroll
    for (int q = 0; q < 8; ++q) {
        const float zm1 = bf_hi(wl[q]), z0 = bf_lo(wm[q]), z1 = bf_hi(wm[q]), z2 = bf_lo(wr[q]);
        out[q] = cmk(FFMA(c0, zm1, FFMA(c1, z0, FFMA(c2, z1, cb))), FFMA(c0, z0, FFMA(c1, z1, FFMA(c2, z2, cb))));
    }
}
HD void hy_filter_s1(int tid, LAS c32* buf, const unsigned* zk) { HY_OPAQUE(tid);
    unsigned w[16];
#pragma unroll
    for (int q = 0; q < 16; ++q) w[q] = zk[tid + 512 * q];
    c32 a[16];
#pragma unroll
    for (int q = 0; q < 16; ++q) a[q] = cmk(bf_lo(w[q]), bf_hi(w[q]));
    fft_s1_fwd(tid, buf, a);
}
HD void hy_data_s1(int tid, LAS c32* buf, const c32 (&v)[8]) { HY_OPAQUE(tid);
    c32 a[16];
#pragma unroll
    for (int q = 0; q < 8; ++q) a[q] = v[q];
#pragma unroll
    for (int q = 8; q < 16; ++q) a[q] = cmk(0.f, 0.f);
    fft_s1_fwd(tid, buf, a);
}
HD unsigned hy_bf(float f) { unsigned u = __builtin_bit_cast(unsigned, f); return (u + 0x7fffu + ((u >> 16) & 1u)) >> 16; }
HD void hy_pack_store(unsigned* zk, int dir, int a4, float t0, float t1, float t2, float t3) {
    if (dir == 0) { zk[a4 / 2] = hy_bf(t0) | (hy_bf(t1) << 16); zk[a4 / 2 + 1] = hy_bf(t2) | (hy_bf(t3) << 16); }
    else {
        const int m = 8192 - a4 / 2;
        if (a4 > 0) ((unsigned short*)(zk + m))[0] = (unsigned short)hy_bf(t0);
        zk[m - 1] = hy_bf(t2) | (hy_bf(t1) << 16);
        if (a4 == 8188) zk[m - 2] = hy_bf(t3) << 16; else ((unsigned short*)(zk + m - 2))[1] = (unsigned short)hy_bf(t3);
    }
}
struct CvItem { const float* src; int N; bf16* dst; size_t dld; };
constexpr int CV_S0 = 32 * 288, CV_S7 = 128, CV_SA = CV_S0 + CV_S7, CV_S1 = 16 * 64, CV_S3 = 32 * 64, CV_S4 = 16 * 32 * 16, CV_S6 = 16 * 8 * 64;
constexpr int CV_NITEMS = CV_SA + 2 * CV_S1 + CV_S3 + 2 * CV_S4 + CV_S6;
__device__ __forceinline__ void cv_decode_layer(Frame& F, int l, int r, CvItem& d) {
    bf16* WIN = (bf16*)(F.ws + ((l & 1) ? WS_WIN2 : WS_WIN)); bf16* PT = (bf16*)(F.ws + WS_PT); bf16* WOT = (bf16*)(F.ws + WS_WOT); bf16* WGU = (bf16*)(F.ws + WS_WGU); bf16* WD = (bf16*)(F.ws + WS_WD);
    bf16* W3T = (bf16*)(F.ws + WS_W3T + (size_t)(l & 1) * 512 * 1024);
    if (r < CV_S0) { const int kb = r / 288, nb = r % 288; d.src = inp(F, I_WIN) + (size_t)l * DM * NIN + (size_t)(64 * kb) * NIN + 32 * nb; d.N = NIN; d.dst = WIN + (size_t)(32 * nb) * DM + 64 * kb; d.dld = DM; return; } r -= CV_S0;
    if (r < CV_S7) { const int nb = r; d.src = inp(F, I_FW3) + (size_t)l * 64 * 4096 + 32 * nb; d.N = 4096; d.dst = W3T + (size_t)(32 * nb) * 64; d.dld = 64; return; } r -= CV_S7;
    if (r < CV_S1) { const int kb = r / 64, nb = r % 64; d.src = inp(F, I_WHY) + (size_t)l * HYW * DM + (size_t)(64 * kb) * DM + 32 * nb; d.N = DM; d.dst = PT + (size_t)(32 * nb) * DM + 64 * kb; d.dld = DM; return; } r -= CV_S1;
    if (r < CV_S1) { const int kb = r / 64, nb = r % 64; d.src = inp(F, I_WSG) + (size_t)l * SGW * DM + (size_t)(64 * kb) * DM + 32 * nb; d.N = DM; d.dst = PT + (size_t)(32 * nb) * DM + 1024 + 64 * kb; d.dld = DM; return; } r -= CV_S1;
    if (r < CV_S3) { const int kb = r / 64, nb = r % 64; d.src = inp(F, I_WOUT) + (size_t)l * DM * DM + (size_t)(64 * kb) * DM + 32 * nb; d.N = DM; d.dst = WOT + (size_t)(32 * nb) * DM + 64 * kb; d.dld = DM; return; } r -= CV_S3;
    if (r < 2 * CV_S4) { const int up = r / CV_S4; r -= up * CV_S4; const int e = r / 512, q = r % 512, kb = q / 16, nb = q % 16; const int n0 = 32 * nb, drow = 256 * (n0 / 128) + (n0 % 128) + 128 * up;
        d.src = (up ? inp(F, I_WUP) : inp(F, I_WGATE)) + ((size_t)l * NEXP + e) * DM * DEXP + (size_t)(64 * kb) * DEXP + n0; d.N = DEXP; d.dst = WGU + ((size_t)e * 1024 + drow) * DM + 64 * kb; d.dld = DM; return; } r -= 2 * CV_S4;
    { const int e = r / 512, q = r % 512, kb = q / 64, nb = q % 64;
        d.src = inp(F, I_WDOWN) + ((size_t)l * NEXP + e) * DEXP * DM + (size_t)(64 * kb) * DM + 32 * nb; d.N = DM; d.dst = WD + ((size_t)e * DM + 32 * nb) * DEXP + 64 * kb; d.dld = DEXP; }
}
__device__ __forceinline__ bool cv_decode(Frame& F, int set, int l, int it, CvItem& d) {
    if (set == 0) { if (it >= CV_SA) return false; cv_decode_layer(F, l, it, d); return true; }
    const int n1 = CV_NITEMS - CV_SA, n2 = (l + 1 < DEPTH) ? CV_SA : 0;
    if (it >= n1 + n2) return false;
    if (it < n1) cv_decode_layer(F, l, CV_SA + it, d); else cv_decode_layer(F, l + 1, it - n1, d);
    return true;
}
__device__ __forceinline__ void cv_load(const CvItem& d, int lane, float (&v)[32]) {
    const float* s = d.src + (size_t)(lane >> 5) * d.N + (lane & 31);
#pragma unroll
    for (int i = 0; i < 32; ++i) v[i] = s[(size_t)(2 * i) * d.N];
}
__device__ __forceinline__ void cv_store(const CvItem& d, int lane, const float (&v)[32], LAS float* scr) {
    const int n = lane >> 1, h = lane & 1;
#pragma unroll
    for (int s = 0; s < 4; ++s) {
#pragma unroll
        for (int i = 0; i < 8; ++i) scr[(2 * i + (lane >> 5)) * 33 + (lane & 31)] = v[8 * s + i];
        LDS_WAIT(); asm volatile("" ::: "memory");
        const LAS float* q = scr + (8 * h) * 33 + n;
        v4u o; o.x = pk2(q[0 * 33], q[1 * 33]); o.y = pk2(q[2 * 33], q[3 * 33]); o.z = pk2(q[4 * 33], q[5 * 33]); o.w = pk2(q[6 * 33], q[7 * 33]);
        *(GAS v4u*)(d.dst + (size_t)n * d.dld + 16 * s + 8 * h) = o;
        LDS_WAIT(); asm volatile("" ::: "memory");
    }
}
struct CvPipe { CvItem d; int it, set, l; bool have; };
#define CV_SCR(F) ((LAS float*)((F).lds + CVS_OFF + (F).wave * 2112))
#define CV_START(F, P, V, SET, L) do { (P).set = (SET); (P).l = (L); int _it = (F).vcu * NWAVES + (F).wave; asm volatile("" : "+s"(_it)); (P).it = _it; (P).have = cv_decode(F, SET, L, _it, (P).d); if ((P).have) cv_load((P).d, (F).lane, V); } while (0)
#define CV_STEP(F, P, V) do { if ((P).have) { cv_store((P).d, (F).lane, V, CV_SCR(F)); (P).it += (F).G * NWAVES; (P).have = cv_decode(F, (P).set, (P).l, (P).it, (P).d); if ((P).have) cv_load((P).d, (F).lane, V); } } while (0)
__device__ __forceinline__ void pa_convert(Frame& F, int l) {
    CvPipe P; float va[32];
    CV_START(F, P, va, 0, l);
    while (P.have) CV_STEP(F, P, va);
}
__device__ __forceinline__ void pa_features(Frame& F, int l) {
    LAS float* zf = (LAS float*)(F.lds);
    LAS float* a1 = zf + 8 * 40;
    const float* w1 = inp(F, I_FW1) + l * 33 * 64; const float* b1 = inp(F, I_FB1) + l * 64; const float* w2 = inp(F, I_FW2) + l * 64 * 64; const float* b2 = inp(F, I_FB2) + l * 64; const float* fq = inp(F, I_FFREQ) + l * 64;
    bf16* A2 = (bf16*)(F.ws + WS_A2);
    const int tl = F.tid >> 6, j = F.tid & 63;
    const float fr = fq[j];
    float w1c[33], w2c[64];
#pragma unroll
    for (int i = 0; i < 33; ++i) w1c[i] = w1[i * 64 + j];
#pragma unroll
    for (int i = 0; i < 64; ++i) w2c[i] = w2[i * 64 + j];
    for (int t0 = F.vcu * 8; t0 < SEQ; t0 += F.G * 8) {
        __syncthreads();
        if (F.tid < 8 * 33) { const int tt = F.tid / 33, i = F.tid % 33; const int t = t0 + tt; float v;
            const float w = 6.283185307179586f / (float)SEQ * (float)t;
            if (i == 0) v = (float)t / (float)(SEQ - 1);
            else { const int b = (i - 1) & 15; const float band = 1e-4f + (float)b * ((15.0f - 1e-4f) / 15.0f); const float a = band * w; v = (i <= 16) ? cosf(a) : -sinf(a); }
            zf[tt * 40 + i] = v; }
        __syncthreads();
        float s = b1[j];
#pragma unroll
        for (int i = 0; i < 33; ++i) s += zf[tl * 40 + i] * w1c[i];
        a1[tl * 64 + j] = sinf(fr * s);
        __syncthreads();
        float s2 = b2[j];
#pragma unroll
        for (int i = 0; i < 64; ++i) s2 += a1[tl * 64 + i] * w2c[i];
        A2[(size_t)(t0 + tl) * 64 + j] = (bf16)f2bf(sinf(fr * s2));
    }
    __syncthreads();
}
__device__ __forceinline__ void pa_router_t(Frame& F, int l) {
    float* WR = (float*)(F.ws + WS_WR);
    const float* wrg = inp(F, I_WRG) + (size_t)l * DM * 4; const float* wre = inp(F, I_WRE) + (size_t)l * 4 * DM * 4;
    for (int i = F.vcu * NTHR + F.tid; i < 20 * DM; i += F.G * NTHR) { const int o = i / DM, k = i % DM;
        WR[i] = (o < 4) ? wrg[k * 4 + o] : wre[((size_t)((o - 4) >> 2) * DM + k) * 4 + ((o - 4) & 3)]; }
}
__device__ __forceinline__ int moe_off(const gu32* cnt, int e) { int s = 0;
#pragma unroll
    for (int j = 0; j < 16; ++j) { const int c = (int)cnt[64 * j]; s += (j < e) ? c : 0; } return s; }
template <int MODE, bool OUTF, int NR>
__device__ __forceinline__ void norm_rows(Frame& F, int m0, int mstride, const float* xin, const float* g, const gu32* cntprev, float* outf) {
    float* XR = (float*)(F.ws + WS_XR); bf16* XN = (bf16*)(F.ws + WS_XN);
    f32x4 v[NR][8];
#pragma unroll
    for (int r = 0; r < NR; ++r) { const int m = m0 + r * mstride; const GAS f32x4* xr = (const GAS f32x4*)((MODE == 0 ? xin : XR) + (size_t)m * DM) + F.lane;
#pragma unroll
        for (int j = 0; j < 8; ++j) v[r][j] = xr[64 * j]; }
    if (MODE == 1) {
        const int* TOKPOS = (const int*)(F.ws + WS_LISTS + 1 * MiB); const bf16* MO = (const bf16*)(F.ws + WS_MOEOUT);
        int slot[NR][2];
#pragma unroll
        for (int r = 0; r < NR; ++r)
#pragma unroll
            for (int k = 0; k < 2; ++k) { const int tp = TOKPOS[(m0 + r * mstride) * 2 + k]; slot[r][k] = moe_off(cntprev, tp >> 13) + (tp & 8191); }
        v2u w[NR][2][8];
#pragma unroll
        for (int r = 0; r < NR; ++r)
#pragma unroll
            for (int k = 0; k < 2; ++k) { const GAS v2u* mr = (const GAS v2u*)(MO + (size_t)slot[r][k] * DM) + F.lane;
#pragma unroll
                for (int j = 0; j < 8; ++j) w[r][k][j] = mr[64 * j]; }
#pragma unroll
        for (int r = 0; r < NR; ++r) {
#pragma unroll
            for (int k = 0; k < 2; ++k)
#pragma unroll
                for (int j = 0; j < 8; ++j) { const v2u ww = w[r][k][j]; v[r][j].x += bfl(ww.x); v[r][j].y += bfh(ww.x); v[r][j].z += bfl(ww.y); v[r][j].w += bfh(ww.y); }
            if (!OUTF) { GAS f32x4* xw = (GAS f32x4*)(XR + (size_t)(m0 + r * mstride) * DM) + F.lane;
#pragma unroll
                for (int j = 0; j < 8; ++j) xw[64 * j] = v[r][j]; } }
    }
    const GAS f32x4* gp = (const GAS f32x4*)g + F.lane;
#pragma unroll
    for (int r = 0; r < NR; ++r) { const int m = m0 + r * mstride;
        float ss = 0.f;
#pragma unroll
        for (int j = 0; j < 8; ++j) ss += (v[r][j].x * v[r][j].x + v[r][j].y * v[r][j].y) + (v[r][j].z * v[r][j].z + v[r][j].w * v[r][j].w);
        const float rstd = 1.0f / sqrtf(wave_sum(ss, F.lane) * (1.0f / DM) + EPS);
        if (OUTF) { GAS f32x4* o = (GAS f32x4*)(outf + (size_t)m * DM) + F.lane;
#pragma unroll
            for (int j = 0; j < 8; ++j) { const f32x4 gg = gp[64 * j]; o[64 * j] = v[r][j] * rstd * gg; } }
        else { GAS v2u* o = (GAS v2u*)(XN + (size_t)m * DM) + F.lane;
#pragma unroll
            for (int j = 0; j < 8; ++j) { const f32x4 gg = gp[64 * j]; const f32x4 rr = v[r][j] * rstd * gg; v2u ww; ww.x = pk2(rr.x, rr.y); ww.y = pk2(rr.z, rr.w); o[64 * j] = ww; } } }
}

__device__ __forceinline__ void sgu_unit(Frame& F, int l, int ch, int g) {
    constexpr int RS = 136;
    LAS bf16* Wb = (LAS bf16*)(F.lds);
    LAS bf16* Vt = (LAS bf16*)(F.lds + 128 * RS * 2);
    LAS float* st = (LAS float*)(F.lds + 2 * 128 * RS * 2);
    const bf16* GV = (const bf16*)(F.ws + WS_GV); const bf16* U = (const bf16*)(F.ws + WS_U); bf16* Y = (bf16*)(F.ws + WS_Y);
    const float* lng = inp(F, I_LNG) + l * SGW; const float* lnb = inp(F, I_LNB) + l * SGW;
    const float* Wg = inp(F, I_SGW) + ((size_t)l * 8 + g) * 128 * 128; const float* bg = inp(F, I_SGB) + (l * 8 + g) * 128;
    const int t0 = ch * 128;
    __syncthreads();
    {
        const int row = F.tid >> 2, part = F.tid & 3; const GAS v4u* rp = (const GAS v4u*)(GV + (size_t)(t0 + row) * SGW);
        float s = 0.f, q = 0.f;
#pragma unroll 4
        for (int i = 0; i < 32; ++i) { const v4u w = rp[part + 4 * i]; const unsigned ww[4] = {w.x, w.y, w.z, w.w};
#pragma unroll
            for (int j = 0; j < 4; ++j) { const float a = bfl(ww[j]), b = bfh(ww[j]); s += a + b; q += a * a + b * b; } }
        s += shfl_xor_l(s, 1, F.lane); s += shfl_xor_l(s, 2, F.lane); q += shfl_xor_l(q, 1, F.lane); q += shfl_xor_l(q, 2, F.lane);
        const float mu = s * (1.0f / SGW); const float var = fmaxf(q * (1.0f / SGW) - mu * mu, 0.f);
        if (part == 0) { st[row] = mu; st[128 + row] = 1.0f / sqrtf(var + EPS); }
    }
    {
#pragma unroll
        for (int i = 0; i < 8; ++i) { const int idx = F.tid + NTHR * i; const int t = idx >> 5, s4 = (idx & 31) * 4; const f32x4 w = *(const GAS f32x4*)(Wg + t * 128 + s4);
            v2u o; o.x = pk2(w.x, w.y); o.y = pk2(w.z, w.w); *(LAS v2u*)(Wb + t * RS + s4) = o; }
    }
    __syncthreads();
    {
#pragma unroll
        for (int i = 0; i < 4; ++i) { const int chunk = F.tid + NTHR * i; const int s = chunk >> 4, kc = chunk & 15;
            const v4u w = *(const GAS v4u*)(GV + (size_t)(t0 + s) * SGW + g * 128 + 8 * kc); const unsigned ww[4] = {w.x, w.y, w.z, w.w};
            const float mu = st[s], rs = st[128 + s];
#pragma unroll
            for (int j = 0; j < 4; ++j) { const int k = 8 * kc + 2 * j; const float a = (bfl(ww[j]) - mu) * rs * lng[g * 128 + k] + lnb[g * 128 + k], b = (bfh(ww[j]) - mu) * rs * lng[g * 128 + k + 1] + lnb[g * 128 + k + 1];
                Vt[k * RS + s] = (bf16)f2bf(a); Vt[(k + 1) * RS + s] = (bf16)f2bf(b); } }
    }
    __syncthreads();
    {
        const int fr = F.lane & 15, fq = F.lane >> 4, tw = F.wave * 16;
        bf16x8 af[4];
#pragma unroll
        for (int ks = 0; ks < 4; ++ks) af[ks] = *(const LAS bf16x8*)(Wb + (tw + fr) * RS + ks * 32 + fq * 8);
        const int t = t0 + tw + fr; const float bias = bg[tw + fr];
#pragma unroll
        for (int kt = 0; kt < 8; ++kt) { f32x4 acc = (f32x4){0.f, 0.f, 0.f, 0.f};
#pragma unroll
            for (int ks = 0; ks < 4; ++ks) { const bf16x8 bfv = *(const LAS bf16x8*)(Vt + (kt * 16 + fr) * RS + ks * 32 + fq * 8);
                acc = __builtin_amdgcn_mfma_f32_16x16x32_bf16(bfv, af[ks], acc, 0, 0, 0); }
            const int kcol = g * 128 + kt * 16 + 4 * fq;
            const v2u uw = *(const GAS v2u*)(U + (size_t)t * SGW + kcol);
            v2u o; o.x = pk2(bfl(uw.x) * (acc[0] + bias), bfh(uw.x) * (acc[1] + bias)); o.y = pk2(bfl(uw.y) * (acc[2] + bias), bfh(uw.y) * (acc[3] + bias));
            *(GAS v2u*)(Y + (size_t)t * DM + 1024 + kcol) = o; }
    }
}

__device__ __forceinline__ void hy_filter_gen(Frame& F, int l, int c0, unsigned* FSP) {
    const bf16* A2 = (const bf16*)(F.ws + WS_A2); const bf16* W3T = (const bf16*)(F.ws + WS_W3T + (size_t)(l & 1) * 512 * 1024);
    int lane = F.lane; asm volatile("" : "+v"(lane));
    const int fr = lane & 15, fq = lane >> 4;
    const int chl = fr >> 2, o = (fr >> 1) & 1, dir = fr & 1, col = dir * 2048 + o * 1024 + c0 + chl;
    const bf16x8 b0 = *(const GAS bf16x8*)(W3T + (size_t)col * 64 + fq * 8), b1 = *(const GAS bf16x8*)(W3T + (size_t)col * 64 + 32 + fq * 8);
    const float delta = 3.0701134573253944f + (float)(c0 + chl) * (12.280453829301579f / 1023.0f);
    const float kdec = -delta * 1.4426950408889634f / (float)(SEQ - 1);
    constexpr int RS = 2056;
    LAS bf16* Ft = (LAS bf16*)(F.lds);
    LAS unsigned short* carry = (LAS unsigned short*)(F.lds + 16 * RS * 2);
    const int rot = (c0 * 10) & 127;
#pragma unroll 1
    for (int c = 0; c < 4; ++c) {
#pragma unroll 1
        for (int ib = 0; ib < 2; ++ib) {
            bf16x8 a0[8], a1[8]; int fr2 = fr, fq2 = fq; asm volatile("" : "+v"(fr2), "+v"(fq2));
#pragma unroll
            for (int j = 0; j < 8; ++j) { const int t0 = (128 * c + ((F.wave + 8 * (ib * 8 + j) + rot) & 127)) * 16;
                a0[j] = *(const GAS bf16x8*)(A2 + (size_t)(t0 + fr2) * 64 + fq2 * 8); a1[j] = *(const GAS bf16x8*)(A2 + (size_t)(t0 + fr2) * 64 + 32 + fq2 * 8); }
#pragma unroll
            for (int j = 0; j < 8; ++j) { const int tl = ((F.wave + 8 * (ib * 8 + j) + rot) & 127) * 16, tb = 2048 * c + tl + 4 * fq2;
                f32x4 acc = (f32x4){0.f, 0.f, 0.f, 0.f};
                acc = __builtin_amdgcn_mfma_f32_16x16x32_bf16(a0[j], b0, acc, 0, 0, 0);
                acc = __builtin_amdgcn_mfma_f32_16x16x32_bf16(a1[j], b1, acc, 0, 0, 0);
#pragma unroll
                for (int r = 0; r < 4; ++r) acc[r] *= __builtin_amdgcn_exp2f(kdec * (float)(tb + r));
                v2u w; w.x = pk2(acc[0], acc[1]); w.y = pk2(acc[2], acc[3]);
                *(LAS v2u*)(Ft + fr2 * RS + tl + 4 * fq2) = w; }
        }
        __syncthreads();
        int tid2 = F.tid; asm volatile("" : "+v"(tid2));
        {
#pragma unroll
            for (int i = 0; i < 4; ++i) { const int idx = tid2 + NTHR * i, r8 = idx >> 8, pc = idx & 255; const int f = (r8 >> 1) * 4 + (r8 & 1) * 2;
                v4u w = *(const LAS v4u*)(Ft + f * RS + 8 * pc);
                if (c == 0 && pc == 0) { const float s0 = bfl(w.x) + bfl((unsigned)Ft[(f + 1) * RS]); w.x = (w.x & 0xffff0000u) | f2bf(s0); }
                *(GAS v4u*)(FSP + (size_t)r8 * 8192 + 1024 * c + 4 * pc) = w; }
        }
        {
#pragma unroll 4
            for (int i = 0; i < 16; ++i) { const int idx = tid2 + NTHR * i, r8 = idx >> 10, il = idx & 1023; const int f = (r8 >> 1) * 4 + (r8 & 1) * 2 + 1;
                const unsigned lo = Ft[f * RS + 2 * il]; const unsigned hi = (il > 0) ? (unsigned)Ft[f * RS + 2 * il - 1] : (unsigned)carry[(c & 1) * 8 + r8];
                const int ig = 1024 * c + il;
                if (ig > 0) FSP[(size_t)r8 * 8192 + 8192 - ig] = lo | (hi << 16); }
            if (F.tid < 8) { const int f = (F.tid >> 1) * 4 + (F.tid & 1) * 2 + 1; const unsigned short last = Ft[f * RS + 2047];
                carry[((c + 1) & 1) * 8 + F.tid] = last;
                if (c == 3) FSP[(size_t)F.tid * 8192 + 4096] = (unsigned)last << 16; }
        }
        __syncthreads();
    }
}
__device__ __forceinline__ unsigned pk_c32(c32 v) { return pk2(v.x, v.y); }
__device__ __forceinline__ c32 unpk_c32(unsigned u) { return cmk(bfl(u), bfh(u)); }
__device__ __forceinline__ void hyena_block(Frame& F, int l, int blk) {
    LAS c32* A = (LAS c32*)(F.lds); LAS c32* B = A + HY_LDS_C32;
    unsigned* FSP = (unsigned*)(F.ws + WS_FS) + (size_t)blk * 8 * 8192;
    const unsigned* ZT = (const unsigned*)(F.ws + WS_ZT); bf16* Y = (bf16*)(F.ws + WS_Y);
    const float* cw = inp(F, I_CONVW) + (size_t)l * 3 * NHY; const float* cb = inp(F, I_CONVB) + (size_t)l * NHY; const float* skp = inp(F, I_SKIP) + (size_t)l * 2 * HYW;
    const int c0 = blk * 4, tid = F.tid;
    __syncthreads();
    HPS(20); hy_filter_gen(F, l, c0, FSP);
    VM_WAIT(); __syncthreads(); HPE(20); HPS(21);
    CvPipe cvp; float cvv[32];
    CV_START(F, cvp, cvv, 1, l);
    unsigned yb0[8], yb1[8], yb2[8], yb3[8];
#pragma unroll
    for (int q = 0; q < 8; ++q) { yb0[q] = 0u; yb1[q] = 0u; yb2[q] = 0u; yb3[q] = 0u; }
#pragma unroll 1
    for (int chl = 0; chl < 4; ++chl) {
        const int c = c0 + chl; const unsigned* zk = FSP + (size_t)chl * 2 * 8192;
        c32 keep[8]; unsigned x1p[8], x2p[8];
        c32 s[16];
        {
            unsigned fw[16]; c32 fz[16];
            { int t2 = tid; HY_OPAQUE(t2);
#pragma unroll
              for (int q = 0; q < 16; ++q) fw[q] = zk[t2 + 512 * q]; }
            c32 xa[8], xb[8];
            hy_conv3_load(tid, ZT + (size_t)(2048 + c) * (SEQ / 2), cw[2048 + c], cw[NHY + 2048 + c], cw[2 * NHY + 2048 + c], cb[2048 + c], keep);
            hy_conv3_load(tid, ZT + (size_t)c * (SEQ / 2), cw[c], cw[NHY + c], cw[2 * NHY + c], cb[c], xa);
            hy_conv3_load(tid, ZT + (size_t)(1024 + c) * (SEQ / 2), cw[1024 + c], cw[NHY + 1024 + c], cw[2 * NHY + 1024 + c], cb[1024 + c], xb);
#pragma unroll
            for (int q = 0; q < 8; ++q) { x1p[q] = pk_c32(xa[q]); x2p[q] = pk_c32(xb[q]); }
#pragma unroll
            for (int q = 0; q < 16; ++q) fz[q] = cmk(bfl(fw[q]), bfh(fw[q]));
            fft_s1_fwd(tid, B, fz);
            hy_data_s1(tid, A, keep);
        }
        const float sk0 = skp[c], sk1 = skp[HYW + c];
#pragma unroll
        for (int ord = 0; ord < 2; ++ord) {
            __syncthreads();
            HPS(22); fft_s2_fwd(tid, A); fft_s2_fwd(tid, B);
            __syncthreads(); HPE(22); HPS(23);
            CV_STEP(F, cvp, cvv);
            fft_s3_read<-1>(tid, A, s); fft_s3_write(tid, A, s);
            fft_s3_read<-1>(tid, B, s); fft_s3_write(tid, B, s);
            unsigned fw[16];
            if (ord == 0) { int t2 = tid; HY_OPAQUE(t2);
#pragma unroll
                for (int q = 0; q < 16; ++q) fw[q] = zk[8192 + t2 + 512 * q]; }
            __syncthreads(); HPE(23); HPS(24);
            CV_STEP(F, cvp, cvv);
            pair_pass(tid, A, B);
            __syncthreads(); HPE(24); HPS(25);
            if (ord == 0) { c32 fz[16];
#pragma unroll
                for (int q = 0; q < 16; ++q) fz[q] = cmk(bfl(fw[q]), bfh(fw[q]));
                fft_s1_fwd(tid, B, fz); }
            fft_s3_read<1>(tid, A, s); fft_s3_write(tid, A, s);
            __syncthreads();
            CV_STEP(F, cvp, cvv);
            fft_s2_inv(tid, A);
            __syncthreads();
            fft_s1_inv(tid, A, s); HPE(25); HPS(26);
            if (ord == 0) {
#pragma unroll
                for (int q = 0; q < 8; ++q) { const c32 xv = unpk_c32(x1p[q]); keep[q] = cmk(FMUL(xv.x, FFMA(keep[q].x, sk0, s[q].x)), FMUL(xv.y, FFMA(keep[q].y, sk0, s[q].y))); }
                hy_data_s1(tid, A, keep);
            } else {
#pragma unroll
                for (int q = 0; q < 8; ++q) { const c32 xv = unpk_c32(x2p[q]); const unsigned yv = pk_c32(cmk(FMUL(xv.x, FFMA(keep[q].x, sk1, s[q].x)), FMUL(xv.y, FFMA(keep[q].y, sk1, s[q].y))));
                    yb0[q] = (chl == 0) ? yv : yb0[q]; yb1[q] = (chl == 1) ? yv : yb1[q]; yb2[q] = (chl == 2) ? yv : yb2[q]; yb3[q] = (chl == 3) ? yv : yb3[q]; }
            }
            HPE(26);
        }
        __syncthreads();
    }
    {
        int t2 = tid; HY_OPAQUE(t2);
#pragma unroll
        for (int q = 0; q < 8; ++q) { const int m = t2 + 512 * q;
            v2u lo, hi; lo.x = (yb0[q] & 0xffffu) | (yb1[q] << 16); lo.y = (yb2[q] & 0xffffu) | (yb3[q] << 16);
            hi.x = (yb0[q] >> 16) | (yb1[q] & 0xffff0000u); hi.y = (yb2[q] >> 16) | (yb3[q] & 0xffff0000u);
            *(GAS v2u*)(Y + (size_t)(2 * m) * DM + c0) = lo; *(GAS v2u*)(Y + (size_t)(2 * m + 1) * DM + c0) = hi; }
    }
    while (cvp.have) CV_STEP(F, cvp, cvv);
    HPE(21);
}

__device__ __forceinline__ void route_block(Frame& F, int l, int tb  ) {
    LAS int* lcnt = (LAS int*)(F.lds);
    LAS int* lbase = (LAS int*)(F.lds + 64);
    LAS int* le = (LAS int*)(F.lds + 128);
    LAS int* lp = (LAS int*)(F.lds + 128 + 256);
    LAS float* lw = (LAS float*)(F.lds + 128 + 512);
    LAS float* lr = (LAS float*)(F.lds + 128 + 768);
    const float* XR = (const float*)(F.ws + WS_XR); bf16* H = (bf16*)(F.ws + WS_XN); const float* WR = (const float*)(F.ws + WS_WR);
    const float* g = inp(F, I_GFFN) + (size_t)l * DM; const float* brg = inp(F, I_BRG) + l * 4; const float* bre = inp(F, I_BRE) + l * 16;
    int* TOKLIST = (int*)(F.ws + WS_LISTS); float* WLIST = (float*)(F.ws + WS_LISTS + 512 * 1024); int* TOKPOS = (int*)(F.ws + WS_LISTS + 1 * MiB); float* RSLIST = (float*)(F.ws + WS_LISTS + 1 * MiB + 512 * 1024);
    gu32* gcnt = F.ctl + CW_CNT + 64 * 16 * l;
    __syncthreads();
    if (F.tid < 16) lcnt[F.tid] = 0;
    const int ts = F.tid >> 4, part = F.tid & 15, tok = tb + ts;
    LAS float* WRc = (LAS float*)(F.lds + 2048);
    LAS float* Xc = WRc + 20 * 512;
    LAS float* Gc = Xc + 32 * 512;
    float acc[20], ss = 0.f;
#pragma unroll
    for (int o = 0; o < 20; ++o) acc[o] = 0.f;
    f32x4 rw[5], rx[8], rg = (f32x4){0.f, 0.f, 0.f, 0.f};
#define RT_LOAD(c) do { _Pragma("unroll") for (int i = 0; i < 5; ++i) { const int idx = F.tid + NTHR * i, o = idx >> 7, k4 = idx & 127; rw[i] = *(const GAS f32x4*)(WR + (size_t)o * DM + 512 * (c) + 4 * k4); } \
        _Pragma("unroll") for (int i = 0; i < 8; ++i) { const int idx = F.tid + NTHR * i, r = idx >> 7, k4 = idx & 127; rx[i] = *(const GAS f32x4*)(XR + (size_t)(tb + r) * DM + 512 * (c) + 4 * k4); } \
        if (F.tid < 128) rg = *(const GAS f32x4*)(g + 512 * (c) + 4 * F.tid); } while (0)
    RT_LOAD(0);
#pragma unroll 1
    for (int c = 0; c < 4; ++c) {
        __syncthreads();
#pragma unroll
        for (int i = 0; i < 5; ++i) { const int idx = F.tid + NTHR * i, o = idx >> 7, k4 = idx & 127; *(LAS f32x4*)(WRc + o * 512 + 4 * k4) = rw[i]; }
#pragma unroll
        for (int i = 0; i < 8; ++i) { const int idx = F.tid + NTHR * i, r = idx >> 7, k4 = idx & 127; *(LAS f32x4*)(Xc + r * 512 + 4 * k4) = rx[i]; }
        if (F.tid < 128) *(LAS f32x4*)(Gc + 4 * F.tid) = rg;
        __syncthreads();
        if (c < 3) RT_LOAD(c + 1);
#pragma unroll 2
        for (int i = 0; i < 8; ++i) { const int ko = 4 * (part + 16 * i);
            const f32x4 x = *(const LAS f32x4*)(Xc + ts * 512 + ko); const f32x4 gg = *(const LAS f32x4*)(Gc + ko); const f32x4 xg = x * gg;
            ss += (x.x * x.x + x.y * x.y) + (x.z * x.z + x.w * x.w);
            { v2u w; w.x = pk2(xg.x, xg.y); w.y = pk2(xg.z, xg.w); *(GAS v2u*)(H + (size_t)tok * DM + 512 * c + ko) = w; }
#pragma unroll
            for (int o = 0; o < 20; ++o) { const f32x4 w = *(const LAS f32x4*)(WRc + o * 512 + ko); acc[o] += (xg.x * w.x + xg.y * w.y) + (xg.z * w.z + xg.w * w.w); } }
    }
#undef RT_LOAD
#pragma unroll
    for (int sh = 1; sh < 16; sh <<= 1) { ss += shfl_xor_l(ss, sh, F.lane);
#pragma unroll
        for (int o = 0; o < 20; ++o) acc[o] += shfl_xor_l(acc[o], sh, F.lane); }
    const float rstd = 1.0f / sqrtf(ss * (1.0f / DM) + EPS);
    {
        float lg0 = acc[0] * rstd + brg[0], lg1 = acc[1] * rstd + brg[1], lg2 = acc[2] * rstd + brg[2], lg3 = acc[3] * rstd + brg[3];
        int grp = 0; float mx = lg0;
        if (lg1 > mx) { mx = lg1; grp = 1; } if (lg2 > mx) { mx = lg2; grp = 2; } if (lg3 > mx) { mx = lg3; grp = 3; }
        const float den = (__expf(lg0 - mx) + __expf(lg1 - mx)) + (__expf(lg2 - mx) + __expf(lg3 - mx));
        const float psel = 1.0f / den;
        const float m0 = (grp == 0) ? 1.f : 0.f, m1 = (grp == 1) ? 1.f : 0.f, m2 = (grp == 2) ? 1.f : 0.f, m3 = (grp == 3) ? 1.f : 0.f;
        float e0v = (m0 * acc[4] + m1 * acc[8]) + (m2 * acc[12] + m3 * acc[16]), e1v = (m0 * acc[5] + m1 * acc[9]) + (m2 * acc[13] + m3 * acc[17]);
        float e2v = (m0 * acc[6] + m1 * acc[10]) + (m2 * acc[14] + m3 * acc[18]), e3v = (m0 * acc[7] + m1 * acc[11]) + (m2 * acc[15] + m3 * acc[19]);
        e0v = e0v * rstd + bre[grp * 4 + 0]; e1v = e1v * rstd + bre[grp * 4 + 1]; e2v = e2v * rstd + bre[grp * 4 + 2]; e3v = e3v * rstd + bre[grp * 4 + 3];
        int i0 = 0; float v0 = e0v;
        if (e1v > v0) { v0 = e1v; i0 = 1; } if (e2v > v0) { v0 = e2v; i0 = 2; } if (e3v > v0) { v0 = e3v; i0 = 3; }
        int i1 = -1; float v1 = -3.0e38f;
        if (i0 != 0 && e0v > v1) { v1 = e0v; i1 = 0; } if (i0 != 1 && e1v > v1) { v1 = e1v; i1 = 1; } if (i0 != 2 && e2v > v1) { v1 = e2v; i1 = 2; } if (i0 != 3 && e3v > v1) { v1 = e3v; i1 = 3; }
        const float ex = __expf(v1 - v0); const float w0 = psel / (1.0f + ex), w1 = psel * ex / (1.0f + ex);
        if (part == 0) { const int ea = grp * 4 + i0, eb = grp * 4 + i1;
            le[ts * 2] = ea; le[ts * 2 + 1] = eb; lw[ts * 2] = w0; lw[ts * 2 + 1] = w1; lr[ts] = rstd;
            lp[ts * 2] = __hip_atomic_fetch_add(lcnt + ea, 1, __ATOMIC_RELAXED, __HIP_MEMORY_SCOPE_WORKGROUP); lp[ts * 2 + 1] = __hip_atomic_fetch_add(lcnt + eb, 1, __ATOMIC_RELAXED, __HIP_MEMORY_SCOPE_WORKGROUP); }
    }
    __syncthreads();
    if (F.tid < 16) lbase[F.tid] = (int)__hip_atomic_fetch_add(gcnt + 64 * F.tid, (unsigned)lcnt[F.tid], RLX_AGENT);
    __syncthreads();
    if (F.tid < 64) { const int t2 = F.tid >> 1; const int e = le[F.tid], pos = lbase[e] + lp[F.tid];
        TOKLIST[e * SEQ + pos] = tb + t2; WLIST[e * SEQ + pos] = lw[F.tid]; RSLIST[e * SEQ + pos] = lr[t2]; TOKPOS[(tb + t2) * 2 + (F.tid & 1)] = (e << 13) | pos; }
}
using pg8::Unit; using pg8::f32x2; using pg8::u32x4; using pg8::cvt_pk_bf16; using pg8::gelu_pk; using pg8::sigmoid_f;
__device__ __forceinline__ void tile_of(int idx, int nM, int nN, int& pm, int& pn) {
    const int nig = 8 * nN, gid = idx / nig, fm = gid * 8, gsz = (nM - fm) < 8 ? (nM - fm) : 8;
    pm = fm + ((idx % nig) % gsz); pn = (idx % nig) / gsz;
}
__device__ __forceinline__ int xcd_remap(int L, int nwg) { const int q = nwg / 8, r = nwg % 8, xcd = L % 8, off = L / 8; return (xcd < r ? xcd * (q + 1) : r * (q + 1) + (xcd - r) * q) + off; }

struct InProjSched {
    static constexpr bool GATHER = false;
    const char* XN; const char* WIN; int G, c;
    __device__ __forceinline__ bool next(int i, Unit& u) const {
        const int L = i * G + c; if (L >= 1152) return false;
        const int w = xcd_remap(L, 1152);
        if (w < 384) { u.kind = 0; tile_of(w, 12, 32, u.pm, u.pn); } else { u.kind = 1; tile_of(w - 384, 32, 24, u.pm, u.pn); }
        u.e = 0; u.row0 = 0; u.nvalid = 256; return true;
    }
    __device__ __forceinline__ const char* a_base(const Unit& u) const { return (u.kind == 0 ? WIN : XN) + (size_t)u.pm * (256 * DM * 2); }
    __device__ __forceinline__ const char* b_base(const Unit& u) const { return (u.kind == 0 ? XN : WIN + (size_t)NHY * DM * 2) + (size_t)u.pn * (256 * DM * 2); }
    __device__ __forceinline__ unsigned a_goff(const Unit&, int) const { return 0u; }
};
struct EpiInProj {
    static constexpr bool PERM = true, MIDK = false;
    bf16 *ZT, *U; const float* bin;
    __device__ __forceinline__ void operator()(const f32x4 (&acc)[2][2][4][2], const Unit& u, int wr, int wc, int fr, int fq) const {
        asm volatile("" : "+v"(fr), "+v"(fq));
        if (u.kind == 0) {
            const int row0 = u.pm * 256 + wr * 64 + fr, col0 = u.pn * 256 + wc * 32 + 8 * fq;
#pragma unroll
            for (int ai = 0; ai < 2; ++ai)
#pragma unroll
                for (int m = 0; m < 4; ++m) { const int row = row0 + ai * 128 + m * 16; const float b = bin[row]; bf16* rowp = ZT + (size_t)row * SEQ + col0;
#pragma unroll
                    for (int bj = 0; bj < 2; ++bj) { const f32x4 v0 = acc[ai][bj][m][0] + b, v1 = acc[ai][bj][m][1] + b;
                        u32x4 w; w.x = cvt_pk_bf16(v0[0], v0[1]); w.y = cvt_pk_bf16(v0[2], v0[3]); w.z = cvt_pk_bf16(v1[0], v1[1]); w.w = cvt_pk_bf16(v1[2], v1[3]);
                        *(u32x4*)(rowp + bj * 128) = w; } }
        } else {
            const int seg = (u.pn < 4) ? 0 : (u.pn < 8) ? 1 : (u.pn < 16) ? 2 : 3;
            const size_t boff = (seg == 0) ? 0 : (seg == 1) ? (WS_GV - WS_U) : (seg == 2) ? (WS_GH - WS_U) : (WS_GS - WS_U);
            bf16* base = (bf16*)((char*)U + boff);
            const int ldc = (seg < 2) ? 1024 : 2048, colt = (seg == 0) ? u.pn * 256 : (seg == 1) ? (u.pn - 4) * 256 : (seg == 2) ? (u.pn - 8) * 256 : (u.pn - 16) * 256;
            const int row0 = u.pm * 256 + wr * 64 + fr, col0 = colt + wc * 32 + 8 * fq, bcol0 = NHY + u.pn * 256 + wc * 32 + 8 * fq;
            f32x4 bv[2][2];
#pragma unroll
            for (int bj = 0; bj < 2; ++bj)
#pragma unroll
                for (int n = 0; n < 2; ++n) bv[bj][n] = *(const f32x4*)(bin + bcol0 + bj * 128 + 4 * n);
#pragma unroll
            for (int ai = 0; ai < 2; ++ai)
#pragma unroll
                for (int m = 0; m < 4; ++m) { bf16* rowp = base + (size_t)(row0 + ai * 128 + m * 16) * ldc + col0;
#pragma unroll
                    for (int bj = 0; bj < 2; ++bj) { f32x4 v0 = acc[ai][bj][m][0] + bv[bj][0], v1 = acc[ai][bj][m][1] + bv[bj][1];
                        if (seg < 2) { const f32x2 a = gelu_pk((f32x2){v0[0], v0[1]}), b = gelu_pk((f32x2){v0[2], v0[3]}), c = gelu_pk((f32x2){v1[0], v1[1]}), d = gelu_pk((f32x2){v1[2], v1[3]});
                            v0 = (f32x4){a.x, a.y, b.x, b.y}; v1 = (f32x4){c.x, c.y, d.x, d.y}; }
                        else {
#pragma unroll
                            for (int j = 0; j < 4; ++j) { v0[j] = sigmoid_f(v0[j]); v1[j] = sigmoid_f(v1[j]); } }
                        u32x4 w; w.x = cvt_pk_bf16(v0[0], v0[1]); w.y = cvt_pk_bf16(v0[2], v0[3]); w.z = cvt_pk_bf16(v1[0], v1[1]); w.w = cvt_pk_bf16(v1[2], v1[3]);
                        *(u32x4*)(rowp + bj * 128) = w; } }
        }
    }
    __device__ __forceinline__ void mid(f32x4 (&)[2][2][4][2], const Unit&, int, int, int, int) const {}
};
struct GridSched {
    static constexpr bool GATHER = false;
    const char* A; const char* Bt; int nM, nN, K, G, c;
    __device__ __forceinline__ bool next(int i, Unit& u) const {
        const int L = i * G + c, nwg = nM * nN; if (L >= nwg) return false;
        tile_of(xcd_remap(L, nwg), nM, nN, u.pm, u.pn); u.kind = 0; u.e = 0; u.row0 = 0; u.nvalid = 256; return true;
    }
    __device__ __forceinline__ const char* a_base(const Unit& u) const { return A + (size_t)u.pm * 512 * K; }
    __device__ __forceinline__ const char* b_base(const Unit& u) const { return Bt + (size_t)u.pn * 512 * K; }
    __device__ __forceinline__ unsigned a_goff(const Unit&, int) const { return 0u; }
};
struct EpiMerge {
    static constexpr bool PERM = true, MIDK = true;
    const bf16 *GH, *GS; bf16* O;
    __device__ __forceinline__ void mid(f32x4 (&acc)[2][2][4][2], const Unit& u, int wr, int wc, int fr, int fq) const {
        asm volatile("" : "+v"(fr), "+v"(fq));
        const int row0 = u.pm * 256 + wr * 64 + fr, col0 = u.pn * 256 + wc * 32 + 8 * fq;
#pragma unroll
        for (int ai = 0; ai < 2; ++ai)
#pragma unroll
            for (int m = 0; m < 4; ++m) { const size_t off = (size_t)(row0 + ai * 128 + m * 16) * DM + col0;
#pragma unroll
                for (int bj = 0; bj < 2; ++bj) { const u32x4 h = *(const u32x4*)(GH + off + bj * 128), s = *(const u32x4*)(GS + off + bj * 128);
                    const unsigned hh[4] = {h.x, h.y, h.z, h.w}, sv[4] = {s.x, s.y, s.z, s.w};
#pragma unroll
                    for (int j = 0; j < 4; ++j) { const float r0 = bfl(hh[j]) * __builtin_amdgcn_rcpf(bfl(sv[j])), r1 = bfh(hh[j]) * __builtin_amdgcn_rcpf(bfh(sv[j]));
                        acc[ai][bj][m][j >> 1][(j & 1) * 2] *= r0; acc[ai][bj][m][j >> 1][(j & 1) * 2 + 1] *= r1; } }
                asm volatile("" : "+v"(acc[ai][0][m][0]), "+v"(acc[ai][0][m][1]), "+v"(acc[ai][1][m][0]), "+v"(acc[ai][1][m][1]));
                asm volatile("" ::: "memory"); }
    }
    __device__ __forceinline__ void operator()(const f32x4 (&acc)[2][2][4][2], const Unit& u, int wr, int wc, int fr, int fq) const {
        asm volatile("" : "+v"(fr), "+v"(fq));
        const int row0 = u.pm * 256 + wr * 64 + fr, col0 = u.pn * 256 + wc * 32 + 8 * fq;
#pragma unroll
        for (int ai = 0; ai < 2; ++ai)
#pragma unroll
            for (int m = 0; m < 4; ++m) { const size_t off = (size_t)(row0 + ai * 128 + m * 16) * DM + col0;
#pragma unroll
                for (int bj = 0; bj < 2; ++bj) { const u32x4 s = *(const u32x4*)(GS + off + bj * 128); const unsigned sv[4] = {s.x, s.y, s.z, s.w};
                    const f32x4 v0 = acc[ai][bj][m][0], v1 = acc[ai][bj][m][1];
                    u32x4 w; w.x = cvt_pk_bf16(v0[0] * bfl(sv[0]), v0[1] * bfh(sv[0])); w.y = cvt_pk_bf16(v0[2] * bfl(sv[1]), v0[3] * bfh(sv[1]));
                    w.z = cvt_pk_bf16(v1[0] * bfl(sv[2]), v1[1] * bfh(sv[2])); w.w = cvt_pk_bf16(v1[2] * bfl(sv[3]), v1[3] * bfh(sv[3]));
                    *(u32x4*)(O + off + bj * 128) = w; }
                asm volatile("" ::: "memory"); }
    }
};
struct EpiResid {
    static constexpr bool PERM = false, MIDK = false;
    const float* base; float* out;
    __device__ __forceinline__ void operator()(const f32x4 (&acc)[2][2][4][2], const Unit& u, int wr, int wc, int fr, int fq) const {
        asm volatile("" : "+v"(fr), "+v"(fq));
        const int row0 = u.pm * 256 + wr * 64 + fr, col0 = u.pn * 256 + wc * 32 + 4 * fq;
#pragma unroll
        for (int ai = 0; ai < 2; ++ai)
#pragma unroll
            for (int m = 0; m < 4; ++m) { const size_t off = (size_t)(row0 + ai * 128 + m * 16) * DM + col0;
#pragma unroll
                for (int bj = 0; bj < 2; ++bj)
#pragma unroll
                    for (int n = 0; n < 2; ++n) { const f32x4 b = *(const f32x4*)(base + off + bj * 128 + n * 16); *(f32x4*)(out + off + bj * 128 + n * 16) = b + acc[ai][bj][m][n]; } }
    }
    __device__ __forceinline__ void mid(f32x4 (&)[2][2][4][2], const Unit&, int, int, int, int) const {}
};
struct MoeSched1 {
    static constexpr bool GATHER = true;
    const LAS int* tab; const char* H; const char* W; const int* toklist; int G, c;
    __device__ __forceinline__ bool next(int i, Unit& u) const {
        const int L = i * G + c; const int total = __builtin_amdgcn_readfirstlane(tab[16]) * 4; if (L >= total) return false;
        const int rt = L >> 2; int e = 0;
#pragma unroll
        for (int j = 1; j < 16; ++j) e += (__builtin_amdgcn_readfirstlane(tab[j]) <= rt) ? 1 : 0;
        const int j0 = rt - __builtin_amdgcn_readfirstlane(tab[e]);
        u.pm = j0; u.pn = L & 3; u.kind = 0; u.e = e; u.row0 = __builtin_amdgcn_readfirstlane(tab[17 + e]) + 256 * j0;
        const int rem = __builtin_amdgcn_readfirstlane(tab[34 + e]) - 256 * j0; u.nvalid = rem < 256 ? rem : 256; return true;
    }
    __device__ __forceinline__ const char* a_base(const Unit&) const { return H; }
    __device__ __forceinline__ const char* b_base(const Unit& u) const { return W + ((size_t)u.e * 1024 + (size_t)u.pn * 256) * DM * 2; }
    __device__ __forceinline__ unsigned a_goff(const Unit& u, int r) const { const int tok = (r < u.nvalid) ? toklist[u.e * SEQ + u.pm * 256 + r] : 0; return (unsigned)tok * (unsigned)(DM * 2); }
};
struct EpiMoe1 {
    static constexpr bool PERM = true, MIDK = false;
    bf16* ACT; const float* wlist; const float* rslist;
    __device__ __forceinline__ void operator()(const f32x4 (&acc)[2][2][4][2], const Unit& u, int wr, int wc, int fr, int fq) const {
        asm volatile("" : "+v"(fr), "+v"(fq));
        const int col0 = u.pn * 128 + wc * 32 + 8 * fq;
#pragma unroll
        for (int ai = 0; ai < 2; ++ai)
#pragma unroll
            for (int m = 0; m < 4; ++m) { const int rl = ai * 128 + wr * 64 + m * 16 + fr;
                if (rl < u.nvalid) { const float wt = wlist[u.e * SEQ + u.pm * 256 + rl], rs = rslist[u.e * SEQ + u.pm * 256 + rl];
                    const f32x4 g0 = acc[ai][0][m][0], g1 = acc[ai][0][m][1], u0 = acc[ai][1][m][0], u1 = acc[ai][1][m][1];
                    float o[8];
#pragma unroll
                    for (int j = 0; j < 4; ++j) { const float ga = g0[j] * rs, gb = g1[j] * rs; o[j] = ga * sigmoid_f(ga) * (u0[j] * rs) * wt; o[4 + j] = gb * sigmoid_f(gb) * (u1[j] * rs) * wt; }
                    u32x4 w; w.x = cvt_pk_bf16(o[0], o[1]); w.y = cvt_pk_bf16(o[2], o[3]); w.z = cvt_pk_bf16(o[4], o[5]); w.w = cvt_pk_bf16(o[6], o[7]);
                    *(u32x4*)(ACT + (size_t)(u.row0 + rl) * DEXP + col0) = w; } }
    }
    __device__ __forceinline__ void mid(f32x4 (&)[2][2][4][2], const Unit&, int, int, int, int) const {}
};
struct MoeSched2 {
    static constexpr bool GATHER = false;
    const LAS int* tab; const char* ACT; const char* W; int G, c;
    __device__ __forceinline__ bool next(int i, Unit& u) const {
        const int L = i * G + c; const int total = __builtin_amdgcn_readfirstlane(tab[16]) * 8; if (L >= total) return false;
        const int rt = L >> 3; int e = 0;
#pragma unroll
        for (int j = 1; j < 16; ++j) e += (__builtin_amdgcn_readfirstlane(tab[j]) <= rt) ? 1 : 0;
        const int j0 = rt - __builtin_amdgcn_readfirstlane(tab[e]);
        u.pm = j0; u.pn = L & 7; u.kind = 0; u.e = e; u.row0 = __builtin_amdgcn_readfirstlane(tab[17 + e]) + 256 * j0;
        const int rem = __builtin_amdgcn_readfirstlane(tab[34 + e]) - 256 * j0; u.nvalid = rem < 256 ? rem : 256; return true;
    }
    __device__ __forceinline__ const char* a_base(const Unit& u) const { return ACT + (size_t)u.row0 * DEXP * 2; }
    __device__ __forceinline__ const char* b_base(const Unit& u) const { return W + ((size_t)u.e * DM + (size_t)u.pn * 256) * DEXP * 2; }
    __device__ __forceinline__ unsigned a_goff(const Unit&, int) const { return 0u; }
};
struct EpiMoe2 {
    static constexpr bool PERM = true, MIDK = false;
    bf16* MO;
    __device__ __forceinline__ void operator()(const f32x4 (&acc)[2][2][4][2], const Unit& u, int wr, int wc, int fr, int fq) const {
        asm volatile("" : "+v"(fr), "+v"(fq));
        const int col0 = u.pn * 256 + wc * 32 + 8 * fq;
#pragma unroll
        for (int ai = 0; ai < 2; ++ai)
#pragma unroll
            for (int m = 0; m < 4; ++m) { const int rl = ai * 128 + wr * 64 + m * 16 + fr;
                if (rl < u.nvalid) { bf16* rowp = MO + (size_t)(u.row0 + rl) * DM + col0;
#pragma unroll
                    for (int bj = 0; bj < 2; ++bj) { const f32x4 v0 = acc[ai][bj][m][0], v1 = acc[ai][bj][m][1];
                        u32x4 w; w.x = cvt_pk_bf16(v0[0], v0[1]); w.y = cvt_pk_bf16(v0[2], v0[3]); w.z = cvt_pk_bf16(v1[0], v1[1]); w.w = cvt_pk_bf16(v1[2], v1[3]);
                        *(u32x4*)(rowp + bj * 128) = w; } } }
    }
    __device__ __forceinline__ void mid(f32x4 (&)[2][2][4][2], const Unit&, int, int, int, int) const {}
};
__device__ __forceinline__ void moe_tables(Frame& F, int l) {
    LAS int* tab = (LAS int*)(F.lds + MISC_OFF + 128);
    __syncthreads();
    if (F.tid == 0) { int tp = 0, off = 0;
        for (int e = 0; e < 16; ++e) { const int c = (int)__hip_atomic_load(F.ctl + CW_CNT + 64 * (16 * l + e), RLX_AGENT); tab[e] = tp; tab[17 + e] = off; tab[34 + e] = c; tp += (c + 255) >> 8; off += c; }
        tab[16] = tp; tab[33] = off; }
    __syncthreads();
}

struct Args { const float* in[29]; float* out; unsigned char* ws; int ph_lo, ph_hi; };
constexpr int NPHASE = 17;
__global__ void __launch_bounds__(NTHR, 2) fwd_kernel(Args args) {
    extern __shared__ __attribute__((aligned(16))) unsigned char lds[];
    Frame F;
    F.lds = (LAS unsigned char*)lds;
    F.MISC = (volatile LAS unsigned*)(F.lds + MISC_OFF);
    F.tid = threadIdx.x; F.lane = F.tid & 63; F.wave = __builtin_amdgcn_readfirstlane(F.tid >> 6);
    F.G = gridDim.x; { const int bx = blockIdx.x; F.vcu = (F.G % 8 == 0) ? (bx % 8) * (F.G / 8) + bx / 8 : bx; }
    F.ws = args.ws; F.out = args.out; F.ctl = (gu32*)(args.ws + WS_CTL);
    for (int u = F.tid; u < 256; u += NTHR) ((LAS unsigned*)(F.lds + MISC_OFF))[u] = 0u;
    F.inp = (const LAS unsigned long long*)(F.lds + MISC_OFF + 640);
    __syncthreads();
#pragma unroll
    for (int i = 0; i < 29; ++i) if (F.tid == i) ((LAS unsigned long long*)(F.lds + MISC_OFF + 640))[i] = (unsigned long long)args.in[i];
    __syncthreads();
    const int lo = args.ph_lo, hi = args.ph_hi;
    const bool multi = (hi - lo) > 1;
    XcdBarrier bar; bar.bar = (unsigned*)(F.ctl + CW_BAR); bar.x = 0; bar.st = nullptr;
    if (multi) bar = xcd_barrier_post((unsigned*)(F.ctl + CW_BAR), F.MISC + 8);
#ifndef PHASE_MASK
#define PHASE_MASK 0x7ff
#endif
#define IN(k) (lo <= (k) && (k) < hi)
#define ON(j) ((PHASE_MASK >> (j)) & 1)
#ifndef DUP_MASK
#define DUP_MASK 0
#endif
#define REP(j) for (int _rep = 0; _rep < (((DUP_MASK >> (j)) & 1) ? 2 : 1); ++_rep)
#define LAUNDER() do { int _l; asm volatile("v_mbcnt_lo_u32_b32 %0, -1, 0\n\tv_mbcnt_hi_u32_b32 %0, -1, %0" : "=v"(_l)); F.lane = _l; F.tid = F.wave * 64 + _l; { unsigned char* _w = F.ws; asm volatile("" : "+s"(_w)); F.ws = _w; } } while (0)
#ifndef PROBE_K
#define PROBE_K -1
#endif
#ifndef PROBE_PART
#define PROBE_PART 0
#endif
#ifndef PROBE_AMP
#define PROBE_AMP 8
#endif
    volatile LAS unsigned long long* pr = (volatile LAS unsigned long long*)(F.lds + MISC_OFF + 512);
#define PR_ME (blockIdx.x == 0 && threadIdx.x == 0)
#define PSTART(j) do { if (PROBE_K == (j) && PROBE_PART != 1 && PR_ME) pr[0] = __builtin_amdgcn_s_memrealtime(); } while (0)
#define PEND(j) do { if (PROBE_K == (j) && PR_ME) { const unsigned long long _n = __builtin_amdgcn_s_memrealtime(); if (PROBE_PART == 0 || (PROBE_PART == 2 && (j) == 8)) pr[1] += _n - pr[0]; else if (PROBE_PART == 1) pr[0] = _n; } } while (0)
#define PBAR(j) do { if (PROBE_K == (j) && PROBE_PART >= 1 && PR_ME) pr[1] += __builtin_amdgcn_s_memrealtime() - pr[0]; } while (0)
#define SEAM(k) do { if (IN(k) && IN((k) + 1)) xcd_barrier(bar); } while (0)
    const int gw = F.vcu * NWAVES + F.wave, NGW = F.G * NWAVES;
    for (int l = 0; l < DEPTH; ++l) {
        const int p0 = l * 8;
        if (ON(0) && IN(p0 + 0)) { LAUNDER(); PSTART(0);
            PSTART(10); if (l == 0) pa_convert(F, l); PEND(10);
            PSTART(11); pa_features(F, l); PEND(11);
            PSTART(12); pa_router_t(F, l); PEND(12);
            PSTART(13);
            const float* g = inp(F, I_GMIX) + (size_t)l * DM;
            if (l == 0) { for (int m = gw; m < SEQ; m += 4 * NGW) norm_rows<0, false, 4>(F, m, NGW, inp(F, I_X), g, nullptr, nullptr); }
            else { for (int m = gw; m < SEQ; m += 2 * NGW) norm_rows<1, false, 2>(F, m, NGW, nullptr, g, F.ctl + CW_CNT + 64 * 16 * (l - 1), nullptr); }
            PEND(13);
        }
        PEND(0); SEAM(p0 + 0); PBAR(0);
        if (ON(1) && IN(p0 + 1)) { LAUNDER(); PSTART(1);
            InProjSched S{(const char*)(F.ws + WS_XN), (const char*)(F.ws + ((l & 1) ? WS_WIN2 : WS_WIN)), F.G, (int)blockIdx.x};
            EpiInProj E{(bf16*)(F.ws + WS_ZT), (bf16*)(F.ws + WS_U), inp(F, I_BIN) + (size_t)l * NIN};
            REP(1) pg8::gemm_phase<EpiInProj, InProjSched>(F.lds, DM, S, E, F.tid);
        }
        PEND(1); SEAM(p0 + 1); PBAR(1);
        if (ON(2) && IN(p0 + 2)) { LAUNDER(); PSTART(2);
            if (ON(9)) REP(9) for (int u = F.vcu; u < 512; u += F.G) sgu_unit(F, l, u >> 3, u & 7);
            if (ON(10)) REP(10) for (int b = F.vcu; b < 256; b += F.G) hyena_block(F, l, b);
        }
        PEND(2); SEAM(p0 + 2); PBAR(2);
        if (ON(3) && IN(p0 + 3)) { LAUNDER(); PSTART(3);
            GridSched S{(const char*)(F.ws + WS_Y), (const char*)(F.ws + WS_PT), 32, 8, DM, F.G, (int)blockIdx.x};
            EpiMerge E{(const bf16*)(F.ws + WS_GH), (const bf16*)(F.ws + WS_GS), (bf16*)(F.ws + WS_MERGED)};
            REP(3) pg8::gemm_phase<EpiMerge, GridSched>(F.lds, DM, S, E, F.tid);
        }
        PEND(3); SEAM(p0 + 3); PBAR(3);
        if (ON(4) && IN(p0 + 4)) { LAUNDER(); PSTART(4);
            GridSched S{(const char*)(F.ws + WS_MERGED), (const char*)(F.ws + WS_WOT), 32, 8, DM, F.G, (int)blockIdx.x};
            EpiResid E{l == 0 ? inp(F, I_X) : (const float*)(F.ws + WS_XR), (float*)(F.ws + WS_XR)};
            pg8::gemm_phase<EpiResid, GridSched>(F.lds, DM, S, E, F.tid);
        }
        PEND(4); SEAM(p0 + 4); PBAR(4);
        if (ON(5) && IN(p0 + 5)) { LAUNDER(); PSTART(5); for (int tb = F.vcu * 32; tb < SEQ; tb += F.G * 32) route_block(F, l, tb); }
        PEND(5); SEAM(p0 + 5); PBAR(5);
        if (ON(6) && IN(p0 + 6)) { LAUNDER(); PSTART(6);
            moe_tables(F, l);
            MoeSched1 S{(const LAS int*)(F.lds + MISC_OFF + 128), (const char*)(F.ws + WS_XN), (const char*)(F.ws + WS_WGU), (const int*)(F.ws + WS_LISTS), F.G, F.vcu};
            EpiMoe1 E{(bf16*)(F.ws + WS_ACT), (const float*)(F.ws + WS_LISTS + 512 * 1024), (const float*)(F.ws + WS_LISTS + 1 * MiB + 512 * 1024)};
            REP(6) pg8::gemm_phase<EpiMoe1, MoeSched1>(F.lds, DM, S, E, F.tid);
        }
        PEND(6); SEAM(p0 + 6); PBAR(6);
        if (ON(7) && IN(p0 + 7)) { LAUNDER(); PSTART(7);
            moe_tables(F, l);
            MoeSched2 S{(const LAS int*)(F.lds + MISC_OFF + 128), (const char*)(F.ws + WS_ACT), (const char*)(F.ws + WS_WD), F.G, F.vcu};
            EpiMoe2 E{(bf16*)(F.ws + WS_MOEOUT)};
            REP(7) pg8::gemm_phase<EpiMoe2, MoeSched2>(F.lds, DEXP, S, E, F.tid);
        }
        PEND(7); SEAM(p0 + 7); PBAR(7);
    }
    if (ON(8) && IN(16)) { LAUNDER(); PSTART(8); for (int m = gw; m < SEQ; m += 2 * NGW) norm_rows<1, true, 2>(F, m, NGW, nullptr, inp(F, I_GFINAL), F.ctl + CW_CNT + 64 * 16 * (DEPTH - 1), F.out); }
    PEND(8);
    if (PROBE_K >= 0 && PR_ME) { const unsigned long long t0 = __builtin_amdgcn_s_memrealtime(), amt = pr[1] * PROBE_AMP; while (__builtin_amdgcn_s_memrealtime() - t0 < amt) __builtin_amdgcn_s_sleep(8); }
#undef IN
#undef SEAM
}

#ifndef MK_ONE_LAUNCH
#define MK_ONE_LAUNCH 0
#endif
extern "C" void kernel_launch(void* const* d_in, const int* in_sizes, int n_in, void* d_out, int out_size, void* d_ws, size_t ws_size, hipStream_t stream) {
    static int grid = 0;
    if (grid == 0) {
        if (n_in != 29 || ws_size < WS_END) { fprintf(stderr, "kernel_launch: unexpected n_in %d or ws %zu < %zu\n", n_in, ws_size, (size_t)WS_END); grid = -1; return; }
        int dev = 0, cus = 0, per_cu = 0;
        if (hipGetDevice(&dev) != hipSuccess || hipDeviceGetAttribute(&cus, hipDeviceAttributeMultiprocessorCount, dev) != hipSuccess) { grid = -1; return; }
        if (hipFuncSetAttribute((const void*)fwd_kernel, hipFuncAttributeMaxDynamicSharedMemorySize, LDS_BYTES) != hipSuccess) { fprintf(stderr, "kernel_launch: hipFuncSetAttribute failed\n"); grid = -1; return; }
        if (hipOccupancyMaxActiveBlocksPerMultiprocessor(&per_cu, (const void*)fwd_kernel, NTHR, LDS_BYTES) != hipSuccess || per_cu < 1) fprintf(stderr, "kernel_launch: occupancy query reports %d\n", per_cu);
        (void)hipGetLastError();
        grid = cus;
    }
    if (grid < 0) return;
    (void)hipMemsetAsync((char*)d_ws + WS_CTL, 0, CTL_ZERO_BYTES, stream);
    Args a{};
    for (int i = 0; i < 29; ++i) a.in[i] = (const float*)d_in[i];
    a.out = (float*)d_out; a.ws = (unsigned char*)d_ws;
#if MK_ONE_LAUNCH
    a.ph_lo = 0; a.ph_hi = NPHASE;
    hipLaunchKernelGGL(fwd_kernel, dim3(grid), dim3(NTHR), LDS_BYTES, stream, a);
#else
    for (int p = 0; p < NPHASE; ++p) { a.ph_lo = p; a.ph_hi = p + 1; hipLaunchKernelGGL(fwd_kernel, dim3(grid), dim3(NTHR), LDS_BYTES, stream, a); }
#endif
}
```

```cpp
#include <hip/hip_runtime.h>
#include <cstdio>
#include <cstdint>
#define MK_ONE_LAUNCH 1
#define DUP_MASK 0
#define PROBE_K -1
#define PROBE_PART 0
namespace pg8 {
#define PG8_LAS __attribute__((address_space(3)))
typedef unsigned short bf16_t;
typedef short bf16x8 __attribute__((ext_vector_type(8)));
typedef float f32x4 __attribute__((ext_vector_type(4)));
typedef float f32x2 __attribute__((ext_vector_type(2)));
typedef unsigned u32x4 __attribute__((ext_vector_type(4)));
typedef unsigned u32x2 __attribute__((ext_vector_type(2)));
constexpr int BM = 256, BK = 64, HALF = 128, HTB = HALF * BK * 2  , STAGE_BYTES = 8 * HTB;
constexpr int GATHER_SLOT_OFF = 2 * 8448 * 8 + 1024;

__host__ __device__ __forceinline__ int lds_byte(int r, int c) { const int st = (r >> 4) * 2 + (c >> 5), rr = r & 15, cc = c & 31, ob = rr * 64 + cc * 2; return st * 1024 + (ob ^ (((ob >> 9) & 1) << 5)); }
__host__ __device__ __forceinline__ void stage_rc(int b, int& R, int& C) { const int st = b / 1024, sb = b % 1024, swz = sb ^ (((sb >> 9) & 1) << 5); R = (st >> 1) * 16 + swz / 64; C = (st & 1) * 32 + (swz % 64) / 2; }
__host__ __device__ __forceinline__ int perm32(int rho) { const int n = rho >> 4, i = rho & 15; return 8 * (i >> 2) + 4 * n + (i & 3); }

struct Unit { int pm, pn, kind, e, row0, nvalid; };

__device__ __forceinline__ unsigned cvt_pk_bf16(float lo, float hi) { unsigned r; asm volatile("v_cvt_pk_bf16_f32 %0, %1, %2" : "=v"(r) : "v"(lo), "v"(hi)); return r; }
__device__ __forceinline__ f32x2 gelu_pk(f32x2 v) {
    const f32x2 av = __builtin_elementwise_abs(v), d = av * 0.2316418882f + 1.0f;
    f32x2 t; t.x = __builtin_amdgcn_rcpf(d.x); t.y = __builtin_amdgcn_rcpf(d.y);
    f32x2 q = t * 0.5307027145f + (-0.7265760135f); q = q * t + 0.7107068705f; q = q * t + (-0.142248368f); q = q * t + 0.127414796f; q = q * t;
    const f32x2 s = (v * v) * (-0.72134752044f);
    f32x2 e; e.x = __builtin_amdgcn_exp2f(s.x); e.y = __builtin_amdgcn_exp2f(s.y);
    const f32x2 m = v * (q * e), r = v - m;
    f32x2 o; o.x = v.x < 0.f ? m.x : r.x; o.y = v.y < 0.f ? m.y : r.y; return o;
}
__device__ __forceinline__ float sigmoid_f(float x) { return __builtin_amdgcn_rcpf(1.0f + __builtin_amdgcn_exp2f(-1.4426950408889634f * x)); }

template <class Epi, class Sched>
__device__ __forceinline__ void gemm_phase(PG8_LAS unsigned char* lds, const int K, const Sched& S, const Epi& E, int tid) {
    asm volatile("" : "+v"(tid));
    const int wid = __builtin_amdgcn_readfirstlane(tid >> 6), lane = tid & 63, wr = wid >> 2, wc = wid & 3, fr = lane & 15, fq = lane >> 4;
    const int nt = K / BK;
    unsigned voffA[2], voffB[2];
#pragma unroll
    for (int i = 0; i < 2; ++i) { int R, C; stage_rc(tid * 16 + i * 8192, R, C); const int Rb = Epi::PERM ? ((R & ~31) + perm32(R & 31)) : R;
        voffA[i] = Sched::GATHER ? 0u : (unsigned)(R * K + C) * 2u; voffB[i] = (unsigned)(Rb * K + C) * 2u; }
#define PG8_GOFF(u, h, i) ({ int _R, _C, _t = tid; asm volatile("" : "+v"(_t)); stage_rc(_t * 16 + (i) * 8192, _R, _C); S.a_goff((u), (h) * HALF + _R) + (unsigned)(_C * 2); })
    const size_t kstep = (size_t)(BK * 2);
    const size_t hstep = (size_t)HALF * K * 2;
    const unsigned ldsw = (unsigned)wid * 1024u;
    const int aoff = lds_byte(wr * 64 + fr, fq * 8), boff = lds_byte(wc * 32 + fr, fq * 8);
#define PG8_SA(b, h) (((b) * 2 + (h)) * HTB)
#define PG8_SB(b, h) ((4 + (b) * 2 + (h)) * HTB)
#define PG8_STAGE(bufoff, gbase, voff) do { _Pragma("unroll") for (int _i = 0; _i < 2; ++_i) \
        __builtin_amdgcn_global_load_lds((const unsigned*)((const char*)(gbase) + (voff)[_i]), (PG8_LAS unsigned*)(lds + (bufoff) + ldsw + _i * 8192), 16, 0, 0); } while (0)
#define PG8_STAGE_A(bufoff, gbase, h, GO) do { if constexpr (Sched::GATHER) { _Pragma("unroll") for (int _i = 0; _i < 2; ++_i) \
        __builtin_amdgcn_global_load_lds((const unsigned*)((const char*)(gbase) + (GO)[h][_i]), (PG8_LAS unsigned*)(lds + (bufoff) + ldsw + _i * 8192), 16, 0, 0); } \
        else { PG8_STAGE(bufoff, (gbase) + (h) * hstep, voffA); } } while (0)
#define PG8_LDA(dst, b, h) do { _Pragma("unroll") for (int m = 0; m < 4; ++m) _Pragma("unroll") for (int k = 0; k < 2; ++k) dst[m][k] = *(const PG8_LAS bf16x8*)(lds + PG8_SA(b, h) + aoff + m * 2048 + k * 1024); } while (0)
#define PG8_LDB(dst, b, h) do { _Pragma("unroll") for (int n = 0; n < 2; ++n) _Pragma("unroll") for (int k = 0; k < 2; ++k) dst[n][k] = *(const PG8_LAS bf16x8*)(lds + PG8_SB(b, h) + boff + n * 2048 + k * 1024); } while (0)
#define PG8_MMA(ai, bj, At, Bt) do { __builtin_amdgcn_s_setprio(1); _Pragma("unroll") for (int m = 0; m < 4; ++m) _Pragma("unroll") for (int n = 0; n < 2; ++n) _Pragma("unroll") for (int k = 0; k < 2; ++k) \
        acc[ai][bj][m][n] = __builtin_amdgcn_mfma_f32_16x16x32_bf16(Bt[n][k], At[m][k], acc[ai][bj][m][n], 0, 0, 0); __builtin_amdgcn_s_setprio(0); } while (0)
#define PG8_WAIT_V(n) asm volatile("s_waitcnt vmcnt(" #n ")" ::: "memory")
#define PG8_WAIT_L(n) asm volatile("s_waitcnt lgkmcnt(" #n ")" ::: "memory")
#define PG8_BAR __builtin_amdgcn_s_barrier()
#define PG8_SCHED __builtin_amdgcn_sched_barrier(0)
    Unit cur, nxt; int ui = 0;
    if (!S.next(0, cur)) return;
    f32x4 acc[2][2][4][2];
#pragma unroll
    for (int a = 0; a < 2; ++a)
#pragma unroll
        for (int b = 0; b < 2; ++b)
#pragma unroll
            for (int m = 0; m < 4; ++m)
#pragma unroll
                for (int n = 0; n < 2; ++n) acc[a][b][m][n] = (f32x4){0.f, 0.f, 0.f, 0.f};
    bf16x8 At[4][2], B0[2][2], B1[2][2];
    const char* cA = S.a_base(cur); const char* cB = S.b_base(cur);
    unsigned cgo[2][2];
    PG8_LAS u32x4* gslot = (PG8_LAS u32x4*)(lds + GATHER_SLOT_OFF) + tid;
    if constexpr (Sched::GATHER) {
#pragma unroll
        for (int h = 0; h < 2; ++h)
#pragma unroll
            for (int i = 0; i < 2; ++i) cgo[h][i] = PG8_GOFF(cur, h, i);
    }
    PG8_STAGE(PG8_SB(0, 0), cB, voffB); PG8_STAGE(PG8_SB(0, 1), cB + hstep, voffB); PG8_STAGE_A(PG8_SA(0, 0), cA, 0, cgo); PG8_STAGE_A(PG8_SA(0, 1), cA, 1, cgo);
    if (wr == 1) PG8_BAR;
    PG8_WAIT_V(2); PG8_BAR;
    PG8_STAGE(PG8_SB(1, 0), cB + kstep, voffB); PG8_STAGE_A(PG8_SA(1, 0), cA + kstep, 0, cgo); PG8_STAGE(PG8_SB(1, 1), cB + hstep + kstep, voffB);
    PG8_WAIT_V(6); PG8_BAR;
    for (;;) {
        const bool has_next = S.next(ui + 1, nxt);
        const char* nA = has_next ? S.a_base(nxt) : cA; const char* nB = has_next ? S.b_base(nxt) : cB;
        if constexpr (Sched::GATHER) {
            u32x4 nx = (u32x4){cgo[0][0], cgo[0][1], cgo[1][0], cgo[1][1]};
            if (has_next) { nx.x = PG8_GOFF(nxt, 0, 0); nx.y = PG8_GOFF(nxt, 0, 1); nx.z = PG8_GOFF(nxt, 1, 0); nx.w = PG8_GOFF(nxt, 1, 1); }
            *gslot = nx;
        }
        for (int t = 0; t < nt; t += 2) {
            const bool last = (t == nt - 2);
            if constexpr (Epi::MIDK) { if (t == (nt >> 1)) { int tl = tid; asm volatile("" : "+v"(tl)); E.mid(acc, cur, wr, wc, tl & 15, (tl >> 4) & 3); } }
            const char* a1 = cA + (size_t)(t + 1) * kstep;
            const char* a2 = last ? nA : cA + (size_t)(t + 2) * kstep; const char* b2 = last ? nB : cB + (size_t)(t + 2) * kstep;
            const char* a3 = a2 + kstep; const char* b3 = b2 + kstep;
            unsigned xgo[2][2];
            if constexpr (Sched::GATHER) {
                if (last) { const u32x4 nx = *gslot; xgo[0][0] = nx.x; xgo[0][1] = nx.y; xgo[1][0] = nx.z; xgo[1][1] = nx.w; }
                else { xgo[0][0] = cgo[0][0]; xgo[0][1] = cgo[0][1]; xgo[1][0] = cgo[1][0]; xgo[1][1] = cgo[1][1]; }
            }
            PG8_LDB(B0, 0, 0); PG8_LDB(B1, 0, 1); PG8_SCHED; PG8_LDA(At, 0, 0); PG8_STAGE_A(PG8_SA(1, 1), a1, 1, cgo);
            PG8_WAIT_V(8); PG8_WAIT_L(0); PG8_BAR; PG8_MMA(0, 0, At, B0); PG8_MMA(0, 1, At, B1); PG8_BAR; PG8_SCHED;
            PG8_LDA(At, 0, 1); PG8_STAGE(PG8_SB(0, 0), b2, voffB); PG8_STAGE(PG8_SB(0, 1), b2 + hstep, voffB); PG8_STAGE_A(PG8_SA(0, 0), a2, 0, xgo);
            PG8_WAIT_V(8); PG8_WAIT_L(0); PG8_BAR; PG8_MMA(1, 0, At, B0); PG8_MMA(1, 1, At, B1); PG8_BAR; PG8_SCHED;
            PG8_LDB(B0, 1, 0); PG8_LDB(B1, 1, 1); PG8_SCHED; PG8_LDA(At, 1, 0); PG8_STAGE_A(PG8_SA(0, 1), a2, 1, xgo);
            PG8_WAIT_V(8); PG8_WAIT_L(0); PG8_BAR; PG8_MMA(0, 0, At, B0); PG8_MMA(0, 1, At, B1); PG8_BAR; PG8_SCHED;
            PG8_LDA(At, 1, 1); PG8_STAGE(PG8_SB(1, 0), b3, voffB); PG8_STAGE(PG8_SB(1, 1), b3 + hstep, voffB); PG8_STAGE_A(PG8_SA(1, 0), a3, 0, xgo);
            PG8_WAIT_V(8); PG8_WAIT_L(0); PG8_BAR; PG8_MMA(1, 0, At, B0); PG8_MMA(1, 1, At, B1); PG8_BAR; PG8_SCHED;
        }
        if (wr == 0) PG8_BAR;
        { int tl = tid; asm volatile("" : "+v"(tl)); E(acc, cur, wr, wc, tl & 15, (tl >> 4) & 3); }
        if (!has_next) break;
#pragma unroll
        for (int a = 0; a < 2; ++a)
#pragma unroll
            for (int b = 0; b < 2; ++b)
#pragma unroll
                for (int m = 0; m < 4; ++m)
#pragma unroll
                    for (int n = 0; n < 2; ++n) acc[a][b][m][n] = (f32x4){0.f, 0.f, 0.f, 0.f};
        cur = nxt; cA = nA; cB = nB; ++ui;
        if constexpr (Sched::GATHER) { const u32x4 nx = *gslot; cgo[0][0] = nx.x; cgo[0][1] = nx.y; cgo[1][0] = nx.z; cgo[1][1] = nx.w; }
        if (wr == 1) PG8_BAR;
    }
    PG8_WAIT_V(0);
    PG8_BAR;
#undef PG8_SA
#undef PG8_SB
#undef PG8_STAGE
#undef PG8_STAGE_A
#undef PG8_GOFF
#undef PG8_LDA
#undef PG8_LDB
#undef PG8_MMA
#undef PG8_WAIT_V
#undef PG8_WAIT_L
#undef PG8_BAR
#undef PG8_SCHED
}
}
constexpr int NWAVES = 8, NTHR = 512;
constexpr int SEQ = 8192, DM = 2048, NIN = 9216, HYW = 1024, SGW = 1024, NHY = 3072, NEXP = 16, DEXP = 512, DEPTH = 2;
constexpr float EPS = 1e-6f;
constexpr size_t MiB = 1u << 20;
constexpr size_t WS_CTL = 0, CTL_ZERO_BYTES = 1 * MiB;
constexpr size_t WS_WIN = 1 * MiB;
constexpr size_t WS_WIN2 = WS_WIN + 36 * MiB;
constexpr size_t WS_PT = WS_WIN2 + 36 * MiB;
constexpr size_t WS_WOT = WS_PT + 8 * MiB;
constexpr size_t WS_WGU = WS_WOT + 8 * MiB;
constexpr size_t WS_WD = WS_WGU + 64 * MiB;
constexpr size_t WS_W3T = WS_WD + 32 * MiB;
constexpr size_t WS_A2 = WS_W3T + 1 * MiB;
constexpr size_t WS_WR = WS_A2 + 1 * MiB;
constexpr size_t WS_LISTS = WS_WR + 1 * MiB;
constexpr size_t WS_XR = WS_LISTS + 2 * MiB;
constexpr size_t WS_XN = WS_XR + 64 * MiB;
constexpr size_t WS_ZT = WS_XN + 32 * MiB;
constexpr size_t WS_U = WS_ZT + 48 * MiB;
constexpr size_t WS_GV = WS_U + 16 * MiB;
constexpr size_t WS_GH = WS_GV + 16 * MiB;
constexpr size_t WS_GS = WS_GH + 32 * MiB;
constexpr size_t WS_Y = WS_GS + 32 * MiB;
constexpr size_t WS_FS = WS_Y + 32 * MiB;
constexpr size_t WS_END = WS_FS + 64 * MiB;
constexpr size_t WS_MERGED = WS_ZT, WS_ACT = WS_U, WS_MOEOUT = WS_FS;
constexpr int CW_TMO = 0;
constexpr int CW_CNT = 8192;
constexpr int CW_BAR = 4096;
constexpr int SCRATCH_BYTES = 2 * 8448 * 8;
constexpr int MISC_OFF = SCRATCH_BYTES;
constexpr int CVS_OFF = MISC_OFF + 1024;
constexpr int LDS_BYTES = SCRATCH_BYTES + 1024 + 8 * 2112;
static_assert(pg8::GATHER_SLOT_OFF == MISC_OFF + 1024, "gather slots");
static_assert(SCRATCH_BYTES >= pg8::STAGE_BYTES, "lds");

#define GAS __attribute__((address_space(1)))
#define LAS __attribute__((address_space(3)))
typedef unsigned short bf16;
typedef unsigned v4u __attribute__((ext_vector_type(4)));
typedef unsigned v2u __attribute__((ext_vector_type(2)));
typedef float f32x4 __attribute__((ext_vector_type(4)));
typedef short bf16x8 __attribute__((ext_vector_type(8)));
typedef GAS unsigned gu32;
#define RLX_AGENT __ATOMIC_RELAXED, __HIP_MEMORY_SCOPE_AGENT
#define LDS_WAIT() asm volatile("s_waitcnt lgkmcnt(0)" ::: "memory")
#define VM_WAIT() asm volatile("s_waitcnt vmcnt(0)" ::: "memory")
__device__ __forceinline__ unsigned f2bf(float f) { unsigned u = __builtin_bit_cast(unsigned, f); return (u + 0x7fffu + ((u >> 16) & 1u)) >> 16; }
__device__ __forceinline__ unsigned pk2(float lo, float hi) { return f2bf(lo) | (f2bf(hi) << 16); }
__device__ __forceinline__ float bfl(unsigned u) { return __builtin_bit_cast(float, u << 16); }
__device__ __forceinline__ float bfh(unsigned u) { return __builtin_bit_cast(float, u & 0xffff0000u); }

#define XB_TMO      128
#define XB_XCNT(j)  (256  + 64 * (j))
#define XB_XSUB(j)  (1280 + 64 * (j))
#define XB_XGEN(j)  (2304 + 64 * (j))
#define XB_TOP      3328
#define XB_TOPGEN   3392
#define XCD_BAR_WORDS 3456
#define XB_SPIN_CAP (1u << 18)
__device__ __forceinline__ unsigned xb_ld(unsigned* p)              { return __hip_atomic_load(p, __ATOMIC_RELAXED, __HIP_MEMORY_SCOPE_AGENT); }
__device__ __forceinline__ unsigned xb_add(unsigned* p, unsigned v) { return __hip_atomic_fetch_add(p, v, __ATOMIC_RELAXED, __HIP_MEMORY_SCOPE_AGENT); }
__device__ __forceinline__ unsigned xb_xcc_id() { return (unsigned)__builtin_amdgcn_s_getreg((3 << 11) | 20) & 0xFu; }
#define XB_SPIN(cond, bar) do { unsigned _sp = 0; while (cond) { __builtin_amdgcn_s_sleep(1); \
    if ((++_sp & 255u) == 0u) { if (xb_ld(&(bar)[XB_TMO])) break; if (_sp > XB_SPIN_CAP) { atomicAdd(&(bar)[XB_TMO], 1u); break; } } } } while (0)
struct XcdBarrier { unsigned* bar; unsigned x; volatile LAS unsigned* st; };
__device__ __forceinline__ XcdBarrier xcd_barrier_post(unsigned* bar, volatile LAS unsigned* st) {
    XcdBarrier b; b.bar = bar; b.x = xb_xcc_id(); b.st = st;
    if (threadIdx.x == 0) (void)xb_add(&bar[XB_XCNT(b.x)], 1u);
    return b;
}
__device__ __forceinline__ void xcd_barrier_complete(unsigned* bar, unsigned x, unsigned& nloc, unsigned& nx) {
    const unsigned G = gridDim.x * gridDim.y * gridDim.z;
    unsigned sum, cnt, mine, sp = 0u;
    for (;;) {
        sum = 0u; cnt = 0u; mine = 0u;
#pragma unroll
        for (unsigned j = 0; j < 16; ++j) { const unsigned c = xb_ld(&bar[XB_XCNT(j)]); sum += c; cnt += (c > 0u) ? 1u : 0u; mine = (j == x) ? c : mine; }
        if (sum == G) break;
        __builtin_amdgcn_s_sleep(1);
        if ((++sp & 255u) == 0u) { if (xb_ld(&bar[XB_TMO])) break; if (sp > XB_SPIN_CAP) { atomicAdd(&bar[XB_TMO], 1u); break; } }
    }
    nloc = mine > 0u ? mine : 1u; nx = cnt > 0u ? cnt : 1u;
}
__device__ __forceinline__ void xcd_barrier(const XcdBarrier& b) {
    asm volatile("s_waitcnt vmcnt(0)" ::: "memory");
    __syncthreads();
    if (threadIdx.x == 0) {
        unsigned* bar = b.bar;
        __builtin_amdgcn_s_waitcnt(0);
        unsigned nloc = b.st[0], nx = b.st[1];
        if (nloc == 0u) { xcd_barrier_complete(bar, b.x, nloc, nx); b.st[0] = nloc; b.st[1] = nx; }
        const unsigned old = xb_add(&bar[XB_XSUB(b.x)], 1u);
        const unsigned gen = old / nloc;
        if (old + 1u == (gen + 1u) * nloc) {
            __builtin_amdgcn_fence(__ATOMIC_RELEASE, "agent");
            asm volatile("s_waitcnt vmcnt(0)" ::: "memory");
            const unsigned og = xb_add(&bar[XB_TOP], 1u);
            const unsigned tg = og / nx;
            if (og + 1u == (tg + 1u) * nx) xb_add(&bar[XB_TOPGEN], 1u);
            else XB_SPIN(xb_ld(&bar[XB_TOPGEN]) == tg, bar);
            __builtin_amdgcn_fence(__ATOMIC_ACQUIRE, "agent");
            xb_add(&bar[XB_XGEN(b.x)], 1u);
            asm volatile("s_waitcnt vmcnt(0)" ::: "memory");
        } else {
            XB_SPIN(xb_ld(&bar[XB_XGEN(b.x)]) == gen, bar);
            __builtin_amdgcn_fence(__ATOMIC_ACQUIRE, "agent");
            asm volatile("s_waitcnt vmcnt(0)" ::: "memory");
        }
    }
    __syncthreads();
}

struct Frame {
    LAS unsigned char* lds;
    volatile LAS unsigned* MISC;
    gu32* ctl;
    int tid, lane, wave;
    int vcu, G;
    const LAS unsigned long long* inp;
    float* out;
    unsigned char* ws;
};
enum { I_X = 0, I_GMIX, I_WIN, I_BIN, I_CONVW, I_CONVB, I_FW1, I_FB1, I_FW2, I_FB2, I_FW3, I_FFREQ, I_SKIP, I_LNG, I_LNB, I_SGW, I_SGB, I_WHY, I_WSG, I_WOUT, I_GFFN, I_WRG, I_BRG, I_WRE, I_BRE, I_WGATE, I_WUP, I_WDOWN, I_GFINAL };

__device__ __forceinline__ const float* inp(const Frame& F, int k) { const unsigned long long v = F.inp[k]; const unsigned lo = __builtin_amdgcn_readfirstlane((unsigned)v), hi = __builtin_amdgcn_readfirstlane((unsigned)(v >> 32));
    return (const float*)(((unsigned long long)hi << 32) | (unsigned long long)lo); }
__device__ __forceinline__ float shfl_xor_l(float v, int mask, int lane) { return __builtin_bit_cast(float, __builtin_amdgcn_ds_bpermute((lane ^ mask) << 2, __builtin_bit_cast(int, v))); }
__device__ __forceinline__ float shfl_down1_l(float v, int lane) { return __builtin_bit_cast(float, __builtin_amdgcn_ds_bpermute(((lane + 1) & 63) << 2, __builtin_bit_cast(int, v))); }
__device__ __forceinline__ float wave_sum(float v, int lane) {
#pragma unroll
    for (int o = 1; o < 64; o <<= 1) v += shfl_xor_l(v, o, lane);
    return v;
}

#ifndef PROBE_K
#define PROBE_K -1
#endif
#define HP_ME (blockIdx.x == 0 && threadIdx.x == 0)
#define HPS(j) do { if (PROBE_K == (j) && HP_ME) ((volatile LAS unsigned long long*)(F.lds + MISC_OFF + 512))[0] = __builtin_amdgcn_s_memrealtime(); } while (0)
#define HPE(j) do { if (PROBE_K == (j) && HP_ME) { volatile LAS unsigned long long* _p = (volatile LAS unsigned long long*)(F.lds + MISC_OFF + 512); _p[1] += __builtin_amdgcn_s_memrealtime() - _p[0]; } } while (0)
#define HD __device__ __forceinline__
#define HY_OPAQUE(x) asm volatile("" : "+v"(x))
typedef float hy_f2v __attribute__((ext_vector_type(2)));
#define LDC(p, i) ({ const hy_f2v _v = *(const LAS hy_f2v*)((p) + (i)); c32 _r; _r.x = _v.x; _r.y = _v.y; _r; })
#define STC(p, i, v) do { const c32 _s = (v); hy_f2v _w; _w.x = _s.x; _w.y = _s.y; *(LAS hy_f2v*)((p) + (i)) = _w; } while (0)
#define FADD(a, b) ({ float _r; asm("v_add_f32 %0, %1, %2" : "=v"(_r) : "v"((float)(a)), "v"((float)(b))); _r; })
#define FSUB(a, b) ({ float _r; asm("v_sub_f32 %0, %1, %2" : "=v"(_r) : "v"((float)(a)), "v"((float)(b))); _r; })
#define FMUL(a, b) ({ float _r; asm("v_mul_f32 %0, %1, %2" : "=v"(_r) : "v"((float)(a)), "v"((float)(b))); _r; })
#define FFMA(a, b, c) ({ float _r; asm("v_fma_f32 %0, %1, %2, %3" : "=v"(_r) : "v"((float)(a)), "v"((float)(b)), "v"((float)(c))); _r; })
#define FNMA(a, b, c) ({ float _r; asm("v_fma_f32 %0, -%1, %2, %3" : "=v"(_r) : "v"((float)(a)), "v"((float)(b)), "v"((float)(c))); _r; })
struct c32 { float x, y; };
HD c32 cmk(float x, float y) { c32 r; r.x = x; r.y = y; return r; }
HD c32 cadd(c32 a, c32 b) { return cmk(FADD(a.x, b.x), FADD(a.y, b.y)); }
HD c32 csub(c32 a, c32 b) { return cmk(FSUB(a.x, b.x), FSUB(a.y, b.y)); }
HD c32 cmul(c32 a, c32 b) { return cmk(FNMA(a.y, b.y, FMUL(a.x, b.x)), FFMA(a.y, b.x, FMUL(a.x, b.y))); }
HD c32 cmulc(c32 a, c32 b) { return cmk(FFMA(a.y, b.y, FMUL(a.x, b.x)), FNMA(a.x, b.y, FMUL(a.y, b.x))); }
HD c32 cscale(c32 a, float f) { return cmk(FMUL(a.x, f), FMUL(a.y, f)); }
HD c32 cadd_mi(c32 a, c32 b) { return cmk(FADD(a.x, b.y), FSUB(a.y, b.x)); }
HD c32 cadd_pi(c32 a, c32 b) { return cmk(FSUB(a.x, b.y), FADD(a.y, b.x)); }
#define HY_N 8192
#define HY_LDS_C32 (8192 + 256)

template <int SIGN> HD void dft4(c32& a, c32& b, c32& c, c32& d) {
    const c32 t0 = cadd(a, c), t1 = csub(a, c), t2 = cadd(b, d), t3 = csub(b, d);
    a = cadd(t0, t2); c = csub(t0, t2);
    if (SIGN < 0) { b = cadd_mi(t1, t3); d = cadd_pi(t1, t3); }
    else          { b = cadd_pi(t1, t3); d = cadd_mi(t1, t3); }
}
template <int SIGN> HD void dft16(c32 (&a)[16]) {
    const float C1 = 0.92387953251128674f, S1 = 0.38268343236508977f, R2 = 0.70710678118654752f;
#pragma unroll
    for (int n2 = 0; n2 < 4; ++n2) dft4<SIGN>(a[n2], a[4 + n2], a[8 + n2], a[12 + n2]);
    const float sg = (SIGN < 0) ? -1.f : 1.f;
    const c32 w1 = cmk(C1, sg * S1), w2 = cmk(R2, sg * R2), w3 = cmk(S1, sg * C1), w6 = cmk(-R2, sg * R2), w9 = cmk(-C1, -sg * S1);
    a[1 + 4] = cmul(a[1 + 4], w1); a[2 + 4] = cmul(a[2 + 4], w2); a[3 + 4] = cmul(a[3 + 4], w3);
    a[1 + 8] = cmul(a[1 + 8], w2); a[2 + 8] = (SIGN < 0) ? cmk(a[2 + 8].y, -a[2 + 8].x) : cmk(-a[2 + 8].y, a[2 + 8].x); a[3 + 8] = cmul(a[3 + 8], w6);
    a[1 + 12] = cmul(a[1 + 12], w3); a[2 + 12] = cmul(a[2 + 12], w6); a[3 + 12] = cmul(a[3 + 12], w9);
#pragma unroll
    for (int k1 = 0; k1 < 4; ++k1) dft4<SIGN>(a[4 * k1], a[4 * k1 + 1], a[4 * k1 + 2], a[4 * k1 + 3]);
    c32 t[16];
#pragma unroll
    for (int i = 0; i < 16; ++i) t[i] = a[i];
#pragma unroll
    for (int k1 = 0; k1 < 4; ++k1)
#pragma unroll
        for (int k2 = 0; k2 < 4; ++k2) a[k1 + 4 * k2] = t[4 * k1 + k2];
}
HD void twiddle_tree(c32 (&a)[16], c32 w1) {
    const c32 w2 = cmul(w1, w1), w3 = cmul(w2, w1), w4 = cmul(w2, w2), w5 = cmul(w4, w1), w6 = cmul(w4, w2), w7 = cmul(w4, w3), w8 = cmul(w4, w4);
    a[1] = cmul(a[1], w1); a[2] = cmul(a[2], w2); a[3] = cmul(a[3], w3); a[4] = cmul(a[4], w4); a[5] = cmul(a[5], w5); a[6] = cmul(a[6], w6); a[7] = cmul(a[7], w7); a[8] = cmul(a[8], w8);
    a[9] = cmul(a[9], cmul(w8, w1)); a[10] = cmul(a[10], cmul(w8, w2)); a[11] = cmul(a[11], cmul(w8, w3)); a[12] = cmul(a[12], cmul(w8, w4));
    a[13] = cmul(a[13], cmul(w8, w5)); a[14] = cmul(a[14], cmul(w8, w6)); a[15] = cmul(a[15], cmul(w8, w7));
}
HD c32 cis_pi(float x) { return cmk(cospif(x), sinpif(x)); }

HD void fft_s1_fwd(int tid, LAS c32* buf, c32 (&a)[16]) { HY_OPAQUE(tid);
    dft16<-1>(a);
    twiddle_tree(a, cis_pi(-2.0f * (float)tid / 8192.0f));
    LAS c32* p0 = buf + tid + (tid >> 5);
#pragma unroll
    for (int p = 0; p < 16; ++p) STC(p0, 528 * p, a[p]);
}
HD void fft_s2_fwd(int tid, LAS c32* buf) { HY_OPAQUE(tid);
    LAS c32* p0 = buf + (tid >> 5) * 528 + (tid & 31);
    c32 a[16];
#pragma unroll
    for (int q = 0; q < 16; ++q) a[q] = LDC(p0, 33 * q);
    dft16<-1>(a);
    twiddle_tree(a, cis_pi(-2.0f * (float)(tid & 31) / 512.0f));
#pragma unroll
    for (int p = 0; p < 16; ++p) STC(p0, 33 * p, a[p]);
}
HD float w32c(int q) { switch (q) { case 0: return 1.0f; case 1: return 0.98078528040323043f; case 2: return 0.92387953251128674f; case 3: return 0.83146961230254524f; case 4: return 0.70710678118654752f; case 5: return 0.55557023301960218f; case 6: return 0.38268343236508977f; case 7: return 0.19509032201612825f;
    case 8: return 0.0f; case 9: return -0.19509032201612825f; case 10: return -0.38268343236508977f; case 11: return -0.55557023301960218f; case 12: return -0.70710678118654752f; case 13: return -0.83146961230254524f; case 14: return -0.92387953251128674f; default: return -0.98078528040323043f; } }
HD float w32s(int q) { switch (q) { case 0: return 0.0f; case 1: return 0.19509032201612825f; case 2: return 0.38268343236508977f; case 3: return 0.55557023301960218f; case 4: return 0.70710678118654752f; case 5: return 0.83146961230254524f; case 6: return 0.92387953251128674f; case 7: return 0.98078528040323043f;
    case 8: return 1.0f; case 9: return 0.98078528040323043f; case 10: return 0.92387953251128674f; case 11: return 0.83146961230254524f; case 12: return 0.70710678118654752f; case 13: return 0.55557023301960218f; case 14: return 0.38268343236508977f; default: return 0.19509032201612825f; } }
template <int SIGN> HD void fft_s3_read(int tid, const LAS c32* buf, c32 (&s)[16]) { HY_OPAQUE(tid);
    const LAS c32* p0 = buf + (tid >> 1) * 33; const int h = tid & 1;
    const float sg = (SIGN < 0) ? -1.f : 1.f, hs = h ? -1.f : 1.f;
#pragma unroll
    for (int q = 0; q < 16; ++q) {
        const c32 u = LDC(p0, q), v = LDC(p0, q + 16);
        const c32 d = cmk(FFMA(v.x, hs, u.x), FFMA(v.y, hs, u.y));
        const c32 w = h ? cmk(w32c(q), sg * w32s(q)) : cmk(1.f, 0.f);
        s[q] = (q == 0) ? d : cmul(d, w);
    }
    dft16<SIGN>(s);
}
HD void fft_s3_write(int tid, LAS c32* buf, const c32 (&s)[16]) { HY_OPAQUE(tid);
    LAS c32* p0 = buf + (tid >> 1) * 33 + (tid & 1);
#pragma unroll
    for (int p = 0; p < 16; ++p) STC(p0, 2 * p, s[p]);
}
HD void fft_s2_inv(int tid, LAS c32* buf) { HY_OPAQUE(tid);
    LAS c32* p0 = buf + (tid >> 5) * 528 + (tid & 31);
    c32 a[16];
#pragma unroll
    for (int q = 0; q < 16; ++q) a[q] = LDC(p0, 33 * q);
    twiddle_tree(a, cis_pi(2.0f * (float)(tid & 31) / 512.0f));
    dft16<1>(a);
#pragma unroll
    for (int p = 0; p < 16; ++p) STC(p0, 33 * p, a[p]);
}
HD void fft_s1_inv(int tid, const LAS c32* buf, c32 (&a)[16]) { HY_OPAQUE(tid);
    const LAS c32* p0 = buf + tid + (tid >> 5);
#pragma unroll
    for (int p = 0; p < 16; ++p) a[p] = LDC(p0, 528 * p);
    twiddle_tree(a, cis_pi(2.0f * (float)tid / 8192.0f));
    dft16<1>(a);
}
HD void pair_pass(int tid, LAS c32* Z, const LAS c32* H) { HY_OPAQUE(tid);
    const int p3 = tid & 31;
    const c32 wp3 = cis_pi(-(float)p3 / 32.0f);
    const c32 wstep = cis_pi(-16.0f / 8192.0f);
    c32 wlow = cis_pi(-(float)(tid >> 5) / 8192.0f);
#pragma unroll 1
    for (int it = 0; it < 9; ++it) {
        const int low = it * 16 + (tid >> 5);
        const c32 Wk = cmul(wlow, wp3);
        wlow = cmul(wlow, wstep);
        if (low > 128) continue;
        bool act = true; int p3b = 31 - p3, lowb = 256 - low;
        if (low == 0) { act = p3 <= 16; p3b = (32 - p3) & 31; lowb = 0; }
        else if (low == 128) { act = p3 <= 15; lowb = 128; }
        if (!act) continue;
        const int pa = (low & 15) * 528 + (low >> 4) * 33 + p3, pb = (lowb & 15) * 528 + (lowb >> 4) * 33 + p3b;
        const c32 A = LDC(Z, pa), B = LDC(Z, pb), HA = LDC(H, pa), HB = LDC(H, pb);
        c32 E = cmk(FMUL(FADD(A.x, B.x), 0.5f), FMUL(FSUB(A.y, B.y), 0.5f)), O = cmk(FMUL(FADD(A.y, B.y), 0.5f), FMUL(FSUB(B.x, A.x), 0.5f));
        c32 T = cmul(Wk, O);
        const c32 X = cadd(E, T), Xm = csub(E, T);
        E = cmk(FMUL(FADD(HA.x, HB.x), 0.5f), FMUL(FSUB(HA.y, HB.y), 0.5f)); O = cmk(FMUL(FADD(HA.y, HB.y), 0.5f), FMUL(FSUB(HB.x, HA.x), 0.5f));
        T = cmul(Wk, O);
        const c32 Hk = cadd(E, T), Hm = csub(E, T);
        const c32 Y = cmul(X, Hk), Ypc = cmul(Xm, Hm);
        const float sc = 0.5f / 8192.0f;
        const c32 Ye = cscale(cadd(Y, Ypc), sc), Yd = cscale(csub(Y, Ypc), sc);
        const c32 Yo = cmulc(Yd, Wk);
        STC(Z, pa, cmk(FSUB(Ye.x, Yo.y), FADD(Ye.y, Yo.x)));
        if (pb != pa) STC(Z, pb, cmk(FADD(Ye.x, Yo.y), FSUB(Yo.x, Ye.y)));
    }
}
HD float bf_lo(unsigned u) { unsigned v = u << 16; return __builtin_bit_cast(float, v); }
HD float bf_hi(unsigned u) { unsigned v = u & 0xffff0000u; return __builtin_bit_cast(float, v); }
HD void hy_conv3_load(int tid, const unsigned* zrow, float c0, float c1, float c2, float cb, c32 (&out)[8]) { HY_OPAQUE(tid);
    unsigned wm[8], wl[8], wr[8];
#pragma unroll
    for (int q = 0; q < 8; ++q) { const int m = tid + 512 * q; wm[q] = zrow[m]; wl[q] = (m > 0) ? zrow[m - 1] : 0u; wr[q] = (m < 4095) ? zrow[m + 1] : 0u; }
#pragma unroll
    for (int q = 0; q < 8; ++q) {
        const float zm1 = bf_hi(wl[q]), z0 = bf_lo(wm[q]), z1 = bf_hi(wm[q]), z2 = bf_lo(wr[q]);
        out[q] = cmk(FFMA(c0, zm1, FFMA(c1, z0, FFMA(c2, z1, cb))), FFMA(c0, z0, FFMA(c1, z1, FFMA(c2, z2, cb))));
    }
}
HD void hy_filter_s1(int tid, LAS c32* buf, const unsigned* zk) { HY_OPAQUE(tid);
    unsigned w[16];
#pragma unroll
    for (int q = 0; q < 16; ++q) w[q] = zk[tid + 512 * q];
    c32 a[16];
#pragma unroll
    for (int q = 0; q < 16; ++q) a[q] = cmk(bf_lo(w[q]), bf_hi(w[q]));
    fft_s1_fwd(tid, buf, a);
}
HD void hy_data_s1(int tid, LAS c32* buf, const c32 (&v)[8]) { HY_OPAQUE(tid);
    c32 a[16];
#pragma unroll
    for (int q = 0; q < 8; ++q) a[q] = v[q];
#pragma unroll
    for (int q = 8; q < 16; ++q) a[q] = cmk(0.f, 0.f);
    fft_s1_fwd(tid, buf, a);
}
HD unsigned hy_bf(float f) { unsigned u = __builtin_bit_cast(unsigned, f); return (u + 0x7fffu + ((u >> 16) & 1u)) >> 16; }
HD void hy_pack_store(unsigned* zk, int dir, int a4, float t0, float t1, float t2, float t3) {
    if (dir == 0) { zk[a4 / 2] = hy_bf(t0) | (hy_bf(t1) << 16); zk[a4 / 2 + 1] = hy_bf(t2) | (hy_bf(t3) << 16); }
    else {
        const int m = 8192 - a4 / 2;
        if (a4 > 0) ((unsigned short*)(zk + m))[0] = (unsigned short)hy_bf(t0);
        zk[m - 1] = hy_bf(t2) | (hy_bf(t1) << 16);
        if (a4 == 8188) zk[m - 2] = hy_bf(t3) << 16; else ((unsigned short*)(zk + m - 2))[1] = (unsigned short)hy_bf(t3);
    }
}
struct CvItem { const float* src; int N; bf16* dst; size_t dld; };
constexpr int CV_S0 = 32 * 288, CV_S7 = 128, CV_SA = CV_S0 + CV_S7, CV_S1 = 16 * 64, CV_S3 = 32 * 64, CV_S4 = 16 * 32 * 16, CV_S6 = 16 * 8 * 64;
constexpr int CV_NITEMS = CV_SA + 2 * CV_S1 + CV_S3 + 2 * CV_S4 + CV_S6;
__device__ __forceinline__ void cv_decode_layer(Frame& F, int l, int r, CvItem& d) {
    bf16* WIN = (bf16*)(F.ws + ((l & 1) ? WS_WIN2 : WS_WIN)); bf16* PT = (bf16*)(F.ws + WS_PT); bf16* WOT = (bf16*)(F.ws + WS_WOT); bf16* WGU = (bf16*)(F.ws + WS_WGU); bf16* WD = (bf16*)(F.ws + WS_WD);
    bf16* W3T = (bf16*)(F.ws + WS_W3T + (size_t)(l & 1) * 512 * 1024);
    if (r < CV_S0) { const int kb = r / 288, nb = r % 288; d.src = inp(F, I_WIN) + (size_t)l * DM * NIN + (size_t)(64 * kb) * NIN + 32 * nb; d.N = NIN; d.dst = WIN + (size_t)(32 * nb) * DM + 64 * kb; d.dld = DM; return; } r -= CV_S0;
    if (r < CV_S7) { const int nb = r; d.src = inp(F, I_FW3) + (size_t)l * 64 * 4096 + 32 * nb; d.N = 4096; d.dst = W3T + (size_t)(32 * nb) * 64; d.dld = 64; return; } r -= CV_S7;
    if (r < CV_S1) { const int kb = r / 64, nb = r % 64; d.src = inp(F, I_WHY) + (size_t)l * HYW * DM + (size_t)(64 * kb) * DM + 32 * nb; d.N = DM; d.dst = PT + (size_t)(32 * nb) * DM + 64 * kb; d.dld = DM; return; } r -= CV_S1;
    if (r < CV_S1) { const int kb = r / 64, nb = r % 64; d.src = inp(F, I_WSG) + (size_t)l * SGW * DM + (size_t)(64 * kb) * DM + 32 * nb; d.N = DM; d.dst = PT + (size_t)(32 * nb) * DM + 1024 + 64 * kb; d.dld = DM; return; } r -= CV_S1;
    if (r < CV_S3) { const int kb = r / 64, nb = r % 64; d.src = inp(F, I_WOUT) + (size_t)l * DM * DM + (size_t)(64 * kb) * DM + 32 * nb; d.N = DM; d.dst = WOT + (size_t)(32 * nb) * DM + 64 * kb; d.dld = DM; return; } r -= CV_S3;
    if (r < 2 * CV_S4) { const int up = r / CV_S4; r -= up * CV_S4; const int e = r / 512, q = r % 512, kb = q / 16, nb = q % 16; const int n0 = 32 * nb, drow = 256 * (n0 / 128) + (n0 % 128) + 128 * up;
        d.src = (up ? inp(F, I_WUP) : inp(F, I_WGATE)) + ((size_t)l * NEXP + e) * DM * DEXP + (size_t)(64 * kb) * DEXP + n0; d.N = DEXP; d.dst = WGU + ((size_t)e * 1024 + drow) * DM + 64 * kb; d.dld = DM; return; } r -= 2 * CV_S4;
    { const int e = r / 512, q = r % 512, kb = q / 64, nb = q % 64;
        d.src = inp(F, I_WDOWN) + ((size_t)l * NEXP + e) * DEXP * DM + (size_t)(64 * kb) * DM + 32 * nb; d.N = DM; d.dst = WD + ((size_t)e * DM + 32 * nb) * DEXP + 64 * kb; d.dld = DEXP; }
}
__device__ __forceinline__ bool cv_decode(Frame& F, int set, int l, int it, CvItem& d) {
    if (set == 0) { if (it >= CV_SA) return false; cv_decode_layer(F, l, it, d); return true; }
    const int n1 = CV_NITEMS - CV_SA, n2 = (l + 1 < DEPTH) ? CV_SA : 0;
    if (it >= n1 + n2) return false;
    if (it < n1) cv_decode_layer(F, l, CV_SA + it, d); else cv_decode_layer(F, l + 1, it - n1, d);
    return true;
}
__device__ __forceinline__ void cv_load(const CvItem& d, int lane, float (&v)[32]) {
    const float* s = d.src + (size_t)(lane >> 5) * d.N + (lane & 31);
#pragma unroll
    for (int i = 0; i < 32; ++i) v[i] = s[(size_t)(2 * i) * d.N];
}
__device__ __forceinline__ void cv_store(const CvItem& d, int lane, const float (&v)[32], LAS float* scr) {
    const int n = lane >> 1, h = lane & 1;
#pragma unroll
    for (int s = 0; s < 4; ++s) {
#pragma unroll
        for (int i = 0; i < 8; ++i) scr[(2 * i + (lane >> 5)) * 33 + (lane & 31)] = v[8 * s + i];
        LDS_WAIT(); asm volatile("" ::: "memory");
        const LAS float* q = scr + (8 * h) * 33 + n;
        v4u o; o.x = pk2(q[0 * 33], q[1 * 33]); o.y = pk2(q[2 * 33], q[3 * 33]); o.z = pk2(q[4 * 33], q[5 * 33]); o.w = pk2(q[6 * 33], q[7 * 33]);
        *(GAS v4u*)(d.dst + (size_t)n * d.dld + 16 * s + 8 * h) = o;
        LDS_WAIT(); asm volatile("" ::: "memory");
    }
}
struct CvPipe { CvItem d; int it, set, l; bool have; };
#define CV_SCR(F) ((LAS float*)((F).lds + CVS_OFF + (F).wave * 2112))
#define CV_START(F, P, V, SET, L) do { (P).set = (SET); (P).l = (L); int _it = (F).vcu * NWAVES + (F).wave; asm volatile("" : "+s"(_it)); (P).it = _it; (P).have = cv_decode(F, SET, L, _it, (P).d); if ((P).have) cv_load((P).d, (F).lane, V); } while (0)
#define CV_STEP(F, P, V) do { if ((P).have) { cv_store((P).d, (F).lane, V, CV_SCR(F)); (P).it += (F).G * NWAVES; (P).have = cv_decode(F, (P).set, (P).l, (P).it, (P).d); if ((P).have) cv_load((P).d, (F).lane, V); } } while (0)
__device__ __forceinline__ void pa_convert(Frame& F, int l) {
    CvPipe P; float va[32];
    CV_START(F, P, va, 0, l);
    while (P.have) CV_STEP(F, P, va);
}
__device__ __forceinline__ void pa_features(Frame& F, int l) {
    LAS float* zf = (LAS float*)(F.lds);
    LAS float* a1 = zf + 8 * 40;
    const float* w1 = inp(F, I_FW1) + l * 33 * 64; const float* b1 = inp(F, I_FB1) + l * 64; const float* w2 = inp(F, I_FW2) + l * 64 * 64; const float* b2 = inp(F, I_FB2) + l * 64; const float* fq = inp(F, I_FFREQ) + l * 64;
    bf16* A2 = (bf16*)(F.ws + WS_A2);
    const int tl = F.tid >> 6, j = F.tid & 63;
    const float fr = fq[j];
    float w1c[33], w2c[64];
#pragma unroll
    for (int i = 0; i < 33; ++i) w1c[i] = w1[i * 64 + j];
#pragma unroll
    for (int i = 0; i < 64; ++i) w2c[i] = w2[i * 64 + j];
    for (int t0 = F.vcu * 8; t0 < SEQ; t0 += F.G * 8) {
        __syncthreads();
        if (F.tid < 8 * 33) { const int tt = F.tid / 33, i = F.tid % 33; const int t = t0 + tt; float v;
            const float w = 6.283185307179586f / (float)SEQ * (float)t;
            if (i == 0) v = (float)t / (float)(SEQ - 1);
            else { const int b = (i - 1) & 15; const float band = 1e-4f + (float)b * ((15.0f - 1e-4f) / 15.0f); const float a = band * w; v = (i <= 16) ? cosf(a) : -sinf(a); }
            zf[tt * 40 + i] = v; }
        __syncthreads();
        float s = b1[j];
#pragma unroll
        for (int i = 0; i < 33; ++i) s += zf[tl * 40 + i] * w1c[i];
        a1[tl * 64 + j] = sinf(fr * s);
        __syncthreads();
        float s2 = b2[j];
#pragma unroll
        for (int i = 0; i < 64; ++i) s2 += a1[tl * 64 + i] * w2c[i];
        A2[(size_t)(t0 + tl) * 64 + j] = (bf16)f2bf(sinf(fr * s2));
    }
    __syncthreads();
}
__device__ __forceinline__ void pa_router_t(Frame& F, int l) {
    float* WR = (float*)(F.ws + WS_WR);
    const float* wrg = inp(F, I_WRG) + (size_t)l * DM * 4; const float* wre = inp(F, I_WRE) + (size_t)l * 4 * DM * 4;
    for (int i = F.vcu * NTHR + F.tid; i < 20 * DM; i += F.G * NTHR) { const int o = i / DM, k = i % DM;
        WR[i] = (o < 4) ? wrg[k * 4 + o] : wre[((size_t)((o - 4) >> 2) * DM + k) * 4 + ((o - 4) & 3)]; }
}
__device__ __forceinline__ int moe_off(const gu32* cnt, int e) { int s = 0;
#pragma unroll
    for (int j = 0; j < 16; ++j) { const int c = (int)cnt[64 * j]; s += (j < e) ? c : 0; } return s; }
template <int MODE, bool OUTF, int NR>
__device__ __forceinline__ void norm_rows(Frame& F, int m0, int mstride, const float* xin, const float* g, const gu32* cntprev, float* outf) {
    float* XR = (float*)(F.ws + WS_XR); bf16* XN = (bf16*)(F.ws + WS_XN);
    f32x4 v[NR][8];
#pragma unroll
    for (int r = 0; r < NR; ++r) { const int m = m0 + r * mstride; const GAS f32x4* xr = (const GAS f32x4*)((MODE == 0 ? xin : XR) + (size_t)m * DM) + F.lane;
#pragma unroll
        for (int j = 0; j < 8; ++j) v[r][j] = xr[64 * j]; }
    if (MODE == 1) {
        const int* TOKPOS = (const int*)(F.ws + WS_LISTS + 1 * MiB); const bf16* MO = (const bf16*)(F.ws + WS_MOEOUT);
        int slot[NR][2];
#pragma unroll
        for (int r = 0; r < NR; ++r)
#pragma unroll
            for (int k = 0; k < 2; ++k) { const int tp = TOKPOS[(m0 + r * mstride) * 2 + k]; slot[r][k] = moe_off(cntprev, tp >> 13) + (tp & 8191); }
        v2u w[NR][2][8];
#pragma unroll
        for (int r = 0; r < NR; ++r)
#pragma unroll
            for (int k = 0; k < 2; ++k) { const GAS v2u* mr = (const GAS v2u*)(MO + (size_t)slot[r][k] * DM) + F.lane;
#pragma unroll
                for (int j = 0; j < 8; ++j) w[r][k][j] = mr[64 * j]; }
#pragma unroll
        for (int r = 0; r < NR; ++r) {
#pragma unroll
            for (int k = 0; k < 2; ++k)
#pragma unroll
                for (int j = 0; j < 8; ++j) { const v2u ww = w[r][k][j]; v[r][j].x += bfl(ww.x); v[r][j].y += bfh(ww.x); v[r][j].z += bfl(ww.y); v[r][j].w += bfh(ww.y); }
            if (!OUTF) { GAS f32x4* xw = (GAS f32x4*)(XR + (size_t)(m0 + r * mstride) * DM) + F.lane;
#pragma unroll
                for (int j = 0; j < 8; ++j) xw[64 * j] = v[r][j]; } }
    }
    const GAS f32x4* gp = (const GAS f32x4*)g + F.lane;
#pragma unroll
    for (int r = 0; r < NR; ++r) { const int m = m0 + r * mstride;
        float ss = 0.f;
#pragma unroll
        for (int j = 0; j < 8; ++j) ss += (v[r][j].x * v[r][j].x + v[r][j].y * v[r][j].y) + (v[r][j].z * v[r][j].z + v[r][j].w * v[r][j].w);
        const float rstd = 1.0f / sqrtf(wave_sum(ss, F.lane) * (1.0f / DM) + EPS);
        if (OUTF) { GAS f32x4* o = (GAS f32x4*)(outf + (size_t)m * DM) + F.lane;
#pragma unroll
            for (int j = 0; j < 8; ++j) { const f32x4 gg = gp[64 * j]; o[64 * j] = v[r][j] * rstd * gg; } }
        else { GAS v2u* o = (GAS v2u*)(XN + (size_t)m * DM) + F.lane;
#pragma unroll
            for (int j = 0; j < 8; ++j) { const f32x4 gg = gp[64 * j]; const f32x4 rr = v[r][j] * rstd * gg; v2u ww; ww.x = pk2(rr.x, rr.y); ww.y = pk2(rr.z, rr.w); o[64 * j] = ww; } } }
}

__device__ __forceinline__ void sgu_unit(Frame& F, int l, int ch, int g) {
    constexpr int RS = 136;
    LAS bf16* Wb = (LAS bf16*)(F.lds);
    LAS bf16* Vt = (LAS bf16*)(F.lds + 128 * RS * 2);
    LAS float* st = (LAS float*)(F.lds + 2 * 128 * RS * 2);
    const bf16* GV = (const bf16*)(F.ws + WS_GV); const bf16* U = (const bf16*)(F.ws + WS_U); bf16* Y = (bf16*)(F.ws + WS_Y);
    const float* lng = inp(F, I_LNG) + l * SGW; const float* lnb = inp(F, I_LNB) + l * SGW;
    const float* Wg = inp(F, I_SGW) + ((size_t)l * 8 + g) * 128 * 128; const float* bg = inp(F, I_SGB) + (l * 8 + g) * 128;
    const int t0 = ch * 128;
    __syncthreads();
    {
        const int row = F.tid >> 2, part = F.tid & 3; const GAS v4u* rp = (const GAS v4u*)(GV + (size_t)(t0 + row) * SGW);
        float s = 0.f, q = 0.f;
#pragma unroll 4
        for (int i = 0; i < 32; ++i) { const v4u w = rp[part + 4 * i]; const unsigned ww[4] = {w.x, w.y, w.z, w.w};
#pragma unroll
            for (int j = 0; j < 4; ++j) { const float a = bfl(ww[j]), b = bfh(ww[j]); s += a + b; q += a * a + b * b; } }
        s += shfl_xor_l(s, 1, F.lane); s += shfl_xor_l(s, 2, F.lane); q += shfl_xor_l(q, 1, F.lane); q += shfl_xor_l(q, 2, F.lane);
        const float mu = s * (1.0f / SGW); const float var = fmaxf(q * (1.0f / SGW) - mu * mu, 0.f);
        if (part == 0) { st[row] = mu; st[128 + row] = 1.0f / sqrtf(var + EPS); }
    }
    {
#pragma unroll
        for (int i = 0; i < 8; ++i) { const int idx = F.tid + NTHR * i; const int t = idx >> 5, s4 = (idx & 31) * 4; const f32x4 w = *(const GAS f32x4*)(Wg + t * 128 + s4);
            v2u o; o.x = pk2(w.x, w.y); o.y = pk2(w.z, w.w); *(LAS v2u*)(Wb + t * RS + s4) = o; }
    }
    __syncthreads();
    {
#pragma unroll
        for (int i = 0; i < 4; ++i) { const int chunk = F.tid + NTHR * i; const int s = chunk >> 4, kc = chunk & 15;
            const v4u w = *(const GAS v4u*)(GV + (size_t)(t0 + s) * SGW + g * 128 + 8 * kc); const unsigned ww[4] = {w.x, w.y, w.z, w.w};
            const float mu = st[s], rs = st[128 + s];
#pragma unroll
            for (int j = 0; j < 4; ++j) { const int k = 8 * kc + 2 * j; const float a = (bfl(ww[j]) - mu) * rs * lng[g * 128 + k] + lnb[g * 128 + k], b = (bfh(ww[j]) - mu) * rs * lng[g * 128 + k + 1] + lnb[g * 128 + k + 1];
                Vt[k * RS + s] = (bf16)f2bf(a); Vt[(k + 1) * RS + s] = (bf16)f2bf(b); } }
    }
    __syncthreads();
    {
        const int fr = F.lane & 15, fq = F.lane >> 4, tw = F.wave * 16;
        bf16x8 af[4];
#pragma unroll
        for (int ks = 0; ks < 4; ++ks) af[ks] = *(const LAS bf16x8*)(Wb + (tw + fr) * RS + ks * 32 + fq * 8);
        const int t = t0 + tw + fr; const float bias = bg[tw + fr];
#pragma unroll
        for (int kt = 0; kt < 8; ++kt) { f32x4 acc = (f32x4){0.f, 0.f, 0.f, 0.f};
#pragma unroll
            for (int ks = 0; ks < 4; ++ks) { const bf16x8 bfv = *(const LAS bf16x8*)(Vt + (kt * 16 + fr) * RS + ks * 32 + fq * 8);
                acc = __builtin_amdgcn_mfma_f32_16x16x32_bf16(bfv, af[ks], acc, 0, 0, 0); }
            const int kcol = g * 128 + kt * 16 + 4 * fq;
            const v2u uw = *(const GAS v2u*)(U + (size_t)t * SGW + kcol);
            v2u o; o.x = pk2(bfl(uw.x) * (acc[0] + bias), bfh(uw.x) * (acc[1] + bias)); o.y = pk2(bfl(uw.y) * (acc[2] + bias), bfh(uw.y) * (acc[3] + bias));
            *(GAS v2u*)(Y + (size_t)t * DM + 1024 + kcol) = o; }
    }
}

__device__ __forceinline__ void hy_filter_gen(Frame& F, int l, int c0, unsigned* FSP) {
    const bf16* A2 = (const bf16*)(F.ws + WS_A2); const bf16* W3T = (const bf16*)(F.ws + WS_W3T + (size_t)(l & 1) * 512 * 1024);
    int lane = F.lane; asm volatile("" : "+v"(lane));
    const int fr = lane & 15, fq = lane >> 4;
    const int chl = fr >> 2, o = (fr >> 1) & 1, dir = fr & 1, col = dir * 2048 + o * 1024 + c0 + chl;
    const bf16x8 b0 = *(const GAS bf16x8*)(W3T + (size_t)col * 64 + fq * 8), b1 = *(const GAS bf16x8*)(W3T + (size_t)col * 64 + 32 + fq * 8);
    const float delta = 3.0701134573253944f + (float)(c0 + chl) * (12.280453829301579f / 1023.0f);
    const float kdec = -delta * 1.4426950408889634f / (float)(SEQ - 1);
    constexpr int RS = 2056;
    LAS bf16* Ft = (LAS bf16*)(F.lds);
    LAS unsigned short* carry = (LAS unsigned short*)(F.lds + 16 * RS * 2);
    const int rot = (c0 * 10) & 127;
#pragma unroll 1
    for (int c = 0; c < 4; ++c) {
#pragma unroll 1
        for (int ib = 0; ib < 2; ++ib) {
            bf16x8 a0[8], a1[8]; int fr2 = fr, fq2 = fq; asm volatile("" : "+v"(fr2), "+v"(fq2));
#pragma unroll
            for (int j = 0; j < 8; ++j) { const int t0 = (128 * c + ((F.wave + 8 * (ib * 8 + j) + rot) & 127)) * 16;
                a0[j] = *(const GAS bf16x8*)(A2 + (size_t)(t0 + fr2) * 64 + fq2 * 8); a1[j] = *(const GAS bf16x8*)(A2 + (size_t)(t0 + fr2) * 64 + 32 + fq2 * 8); }
#pragma unroll
            for (int j = 0; j < 8; ++j) { const int tl = ((F.wave + 8 * (ib * 8 + j) + rot) & 127) * 16, tb = 2048 * c + tl + 4 * fq2;
                f32x4 acc = (f32x4){0.f, 0.f, 0.f, 0.f};
                acc = __builtin_amdgcn_mfma_f32_16x16x32_bf16(a0[j], b0, acc, 0, 0, 0);
                acc = __builtin_amdgcn_mfma_f32_16x16x32_bf16(a1[j], b1, acc, 0, 0, 0);
#pragma unroll
                for (int r = 0; r < 4; ++r) acc[r] *= __builtin_amdgcn_exp2f(kdec * (float)(tb + r));
                v2u w; w.x = pk2(acc[0], acc[1]); w.y = pk2(acc[2], acc[3]);
                *(LAS v2u*)(Ft + fr2 * RS + tl + 4 * fq2) = w; }
        }
        __syncthreads();
        int tid2 = F.tid; asm volatile("" : "+v"(tid2));
        {
#pragma unroll
            for (int i = 0; i < 4; ++i) { const int idx = tid2 + NTHR * i, r8 = idx >> 8, pc = idx & 255; const int f = (r8 >> 1) * 4 + (r8 & 1) * 2;
                v4u w = *(const LAS v4u*)(Ft + f * RS + 8 * pc);
                if (c == 0 && pc == 0) { const float s0 = bfl(w.x) + bfl((unsigned)Ft[(f + 1) * RS]); w.x = (w.x & 0xffff0000u) | f2bf(s0); }
                *(GAS v4u*)(FSP + (size_t)r8 * 8192 + 1024 * c + 4 * pc) = w; }
        }
        {
#pragma unroll 4
            for (int i = 0; i < 16; ++i) { const int idx = tid2 + NTHR * i, r8 = idx >> 10, il = idx & 1023; const int f = (r8 >> 1) * 4 + (r8 & 1) * 2 + 1;
                const unsigned lo = Ft[f * RS + 2 * il]; const unsigned hi = (il > 0) ? (unsigned)Ft[f * RS + 2 * il - 1] : (unsigned)carry[(c & 1) * 8 + r8];
                const int ig = 1024 * c + il;
                if (ig > 0) FSP[(size_t)r8 * 8192 + 8192 - ig] = lo | (hi << 16); }
            if (F.tid < 8) { const int f = (F.tid >> 1) * 4 + (F.tid & 1) * 2 + 1; const unsigned short last = Ft[f * RS + 2047];
                carry[((c + 1) & 1) * 8 + F.tid] = last;
                if (c == 3) FSP[(size_t)F.tid * 8192 + 4096] = (unsigned)last << 16; }
        }
        __syncthreads();
    }
}
__device__ __forceinline__ unsigned pk_c32(c32 v) { return pk2(v.x, v.y); }
__device__ __forceinline__ c32 unpk_c32(unsigned u) { return cmk(bfl(u), bfh(u)); }
__device__ __forceinline__ void hyena_block(Frame& F, int l, int blk) {
    LAS c32* A = (LAS c32*)(F.lds); LAS c32* B = A + HY_LDS_C32;
    unsigned* FSP = (unsigned*)(F.ws + WS_FS) + (size_t)blk * 8 * 8192;
    const unsigned* ZT = (const unsigned*)(F.ws + WS_ZT); bf16* Y = (bf16*)(F.ws + WS_Y);
    const float* cw = inp(F, I_CONVW) + (size_t)l * 3 * NHY; const float* cb = inp(F, I_CONVB) + (size_t)l * NHY; const float* skp = inp(F, I_SKIP) + (size_t)l * 2 * HYW;
    const int c0 = blk * 4, tid = F.tid;
    __syncthreads();
    HPS(20); hy_filter_gen(F, l, c0, FSP);
    VM_WAIT(); __syncthreads(); HPE(20); HPS(21);
    CvPipe cvp; float cvv[32];
    CV_START(F, cvp, cvv, 1, l);
    unsigned yb0[8], yb1[8], yb2[8], yb3[8];
#pragma unroll
    for (int q = 0; q < 8; ++q) { yb0[q] = 0u; yb1[q] = 0u; yb2[q] = 0u; yb3[q] = 0u; }
#pragma unroll 1
    for (int chl = 0; chl < 4; ++chl) {
        const int c = c0 + chl; const unsigned* zk = FSP + (size_t)chl * 2 * 8192;
        c32 keep[8]; unsigned x1p[8], x2p[8];
        c32 s[16];
        {
            unsigned fw[16]; c32 fz[16];
            { int t2 = tid; HY_OPAQUE(t2);
#pragma unroll
              for (int q = 0; q < 16; ++q) fw[q] = zk[t2 + 512 * q]; }
            c32 xa[8], xb[8];
            hy_conv3_load(tid, ZT + (size_t)(2048 + c) * (SEQ / 2), cw[2048 + c], cw[NHY + 2048 + c], cw[2 * NHY + 2048 + c], cb[2048 + c], keep);
            hy_conv3_load(tid, ZT + (size_t)c * (SEQ / 2), cw[c], cw[NHY + c], cw[2 * NHY + c], cb[c], xa);
            hy_conv3_load(tid, ZT + (size_t)(1024 + c) * (SEQ / 2), cw[1024 + c], cw[NHY + 1024 + c], cw[2 * NHY + 1024 + c], cb[1024 + c], xb);
#pragma unroll
            for (int q = 0; q < 8; ++q) { x1p[q] = pk_c32(xa[q]); x2p[q] = pk_c32(xb[q]); }
#pragma unroll
            for (int q = 0; q < 16; ++q) fz[q] = cmk(bfl(fw[q]), bfh(fw[q]));
            fft_s1_fwd(tid, B, fz);
            hy_data_s1(tid, A, keep);
        }
        const float sk0 = skp[c], sk1 = skp[HYW + c];
#pragma unroll
        for (int ord = 0; ord < 2; ++ord) {
            __syncthreads();
            HPS(22); fft_s2_fwd(tid, A); fft_s2_fwd(tid, B);
            __syncthreads(); HPE(22); HPS(23);
            CV_STEP(F, cvp, cvv);
            fft_s3_read<-1>(tid, A, s); fft_s3_write(tid, A, s);
            fft_s3_read<-1>(tid, B, s); fft_s3_write(tid, B, s);
            unsigned fw[16];
            if (ord == 0) { int t2 = tid; HY_OPAQUE(t2);
#pragma unroll
                for (int q = 0; q < 16; ++q) fw[q] = zk[8192 + t2 + 512 * q]; }
            __syncthreads(); HPE(23); HPS(24);
            CV_STEP(F, cvp, cvv);
            pair_pass(tid, A, B);
            __syncthreads(); HPE(24); HPS(25);
            if (ord == 0) { c32 fz[16];
#pragma unroll
                for (int q = 0; q < 16; ++q) fz[q] = cmk(bfl(fw[q]), bfh(fw[q]));
                fft_s1_fwd(tid, B, fz); }
            fft_s3_read<1>(tid, A, s); fft_s3_write(tid, A, s);
            __syncthreads();
            CV_STEP(F, cvp, cvv);
            fft_s2_inv(tid, A);
            __syncthreads();
            fft_s1_inv(tid, A, s); HPE(25); HPS(26);
            if (ord == 0) {
#pragma unroll
                for (int q = 0; q < 8; ++q) { const c32 xv = unpk_c32(x1p[q]); keep[q] = cmk(FMUL(xv.x, FFMA(keep[q].x, sk0, s[q].x)), FMUL(xv.y, FFMA(keep[q].y, sk0, s[q].y))); }
                hy_data_s1(tid, A, keep);
            } else {
#pragma unroll
                for (int q = 0; q < 8; ++q) { const c32 xv = unpk_c32(x2p[q]); const unsigned yv = pk_c32(cmk(FMUL(xv.x, FFMA(keep[q].x, sk1, s[q].x)), FMUL(xv.y, FFMA(keep[q].y, sk1, s[q].y))));
                    yb0[q] = (chl == 0) ? yv : yb0[q]; yb1[q] = (chl == 1) ? yv : yb1[q]; yb2[q] = (chl == 2) ? yv : yb2[q]; yb3[q] = (chl == 3) ? yv : yb3[q]; }
            }
            HPE(26);
        }
        __syncthreads();
    }
    {
        int t2 = tid; HY_OPAQUE(t2);
#pragma unroll
        for (int q = 0; q < 8; ++q) { const int m = t2 + 512 * q;
            v2u lo, hi; lo.x = (yb0[q] & 0xffffu) | (yb1[q] << 16); lo.y = (yb2[q] & 0xffffu) | (yb3[q] << 16);
            hi.x = (yb0[q] >> 16) | (yb1[q] & 0xffff0000u); hi.y = (yb2[q] >> 16) | (yb3[q] & 0xffff0000u);
            *(GAS v2u*)(Y + (size_t)(2 * m) * DM + c0) = lo; *(GAS v2u*)(Y + (size_t)(2 * m + 1) * DM + c0) = hi; }
    }
    while (cvp.have) CV_STEP(F, cvp, cvv);
    HPE(21);
}

__device__ __forceinline__ void rt_split8(const f32x4 a, const f32x4 b, bf16x8& hi, bf16x8& lo) {
    const float v[8] = {a.x, a.y, a.z, a.w, b.x, b.y, b.z, b.w}; unsigned h[8], l[8];
#pragma unroll
    for (int j = 0; j < 8; ++j) { h[j] = f2bf(v[j]); l[j] = f2bf(v[j] - bfl(h[j])); }
    v4u hw, lw; hw.x = h[0] | (h[1] << 16); hw.y = h[2] | (h[3] << 16); hw.z = h[4] | (h[5] << 16); hw.w = h[6] | (h[7] << 16);
    lw.x = l[0] | (l[1] << 16); lw.y = l[2] | (l[3] << 16); lw.z = l[4] | (l[5] << 16); lw.w = l[6] | (l[7] << 16);
    hi = __builtin_bit_cast(bf16x8, hw); lo = __builtin_bit_cast(bf16x8, lw);
}
__device__ __forceinline__ void route_block(Frame& F, int l, int tb  ) {
    LAS int* lcnt = (LAS int*)(F.lds);
    LAS int* lbase = (LAS int*)(F.lds + 64);
    LAS int* le = (LAS int*)(F.lds + 128);
    LAS int* lp = (LAS int*)(F.lds + 128 + 256);
    LAS float* lw = (LAS float*)(F.lds + 128 + 512);
    LAS float* lr = (LAS float*)(F.lds + 128 + 768);
    LAS float* SS = (LAS float*)(F.lds + 1024);
    LAS float* PL = (LAS float*)(F.lds + 2048);
    const float* XR = (const float*)(F.ws + WS_XR); bf16* H = (bf16*)(F.ws + WS_XN); const float* WR = (const float*)(F.ws + WS_WR);
    const float* g = inp(F, I_GFFN) + (size_t)l * DM; const float* brg = inp(F, I_BRG) + l * 4; const float* bre = inp(F, I_BRE) + l * 16;
    int* TOKLIST = (int*)(F.ws + WS_LISTS); float* WLIST = (float*)(F.ws + WS_LISTS + 512 * 1024); int* TOKPOS = (int*)(F.ws + WS_LISTS + 1 * MiB); float* RSLIST = (float*)(F.ws + WS_LISTS + 1 * MiB + 512 * 1024);
    gu32* gcnt = F.ctl + CW_CNT + 64 * 16 * l;
    __syncthreads();
    if (F.tid < 16) lcnt[F.tid] = 0;
    const int ts = F.tid >> 4, part = F.tid & 15;
    {
        const int fr = F.lane & 15, fq = F.lane >> 4, kw = 256 * F.wave + 8 * fq;
        f32x4 acc[2][2];
#pragma unroll
        for (int a = 0; a < 2; ++a)
#pragma unroll
            for (int b = 0; b < 2; ++b) acc[a][b] = (f32x4){0.f, 0.f, 0.f, 0.f};
        float ssl[2] = {0.f, 0.f};
        const float* x0 = XR + (size_t)(tb + fr) * DM + kw; const float* x1 = x0 + (size_t)16 * DM;
        const float* w0 = WR + (size_t)fr * DM + kw; const float* w1 = WR + (size_t)(16 + (fr & 3)) * DM + kw;
        f32x4 xa[2][2], wa[2][2], ga[2];
#define RT_LD(ks) do { const int _k = 32 * (ks); xa[0][0] = *(const GAS f32x4*)(x0 + _k); xa[0][1] = *(const GAS f32x4*)(x0 + _k + 4); xa[1][0] = *(const GAS f32x4*)(x1 + _k); xa[1][1] = *(const GAS f32x4*)(x1 + _k + 4); \
            wa[0][0] = *(const GAS f32x4*)(w0 + _k); wa[0][1] = *(const GAS f32x4*)(w0 + _k + 4); wa[1][0] = *(const GAS f32x4*)(w1 + _k); wa[1][1] = *(const GAS f32x4*)(w1 + _k + 4); \
            ga[0] = *(const GAS f32x4*)(g + kw + _k); ga[1] = *(const GAS f32x4*)(g + kw + _k + 4); } while (0)
        RT_LD(0);
#pragma unroll 1
        for (int ks = 0; ks < 8; ++ks) {
            bf16x8 ah[2], al[2], bh[2], bl[2];
#pragma unroll
            for (int mt = 0; mt < 2; ++mt) { const f32x4 p = xa[mt][0], q = xa[mt][1];
                ssl[mt] += ((p.x * p.x + p.y * p.y) + (p.z * p.z + p.w * p.w)) + ((q.x * q.x + q.y * q.y) + (q.z * q.z + q.w * q.w));
                rt_split8(p * ga[0], q * ga[1], ah[mt], al[mt]);
                *(GAS bf16x8*)(H + (size_t)(tb + 16 * mt + fr) * DM + kw + 32 * ks) = ah[mt]; }
            rt_split8(wa[0][0], wa[0][1], bh[0], bl[0]);
            { const float z = (fr < 4) ? 1.f : 0.f; rt_split8(wa[1][0] * z, wa[1][1] * z, bh[1], bl[1]); }
            if (ks < 7) RT_LD(ks + 1);
#pragma unroll
            for (int mt = 0; mt < 2; ++mt)
#pragma unroll
                for (int nt = 0; nt < 2; ++nt) { acc[mt][nt] = __builtin_amdgcn_mfma_f32_16x16x32_bf16(ah[mt], bh[nt], acc[mt][nt], 0, 0, 0);
                    acc[mt][nt] = __builtin_amdgcn_mfma_f32_16x16x32_bf16(al[mt], bh[nt], acc[mt][nt], 0, 0, 0);
                    acc[mt][nt] = __builtin_amdgcn_mfma_f32_16x16x32_bf16(ah[mt], bl[nt], acc[mt][nt], 0, 0, 0); }
        }
#undef RT_LD
#pragma unroll
        for (int mt = 0; mt < 2; ++mt) { float s = ssl[mt]; s += shfl_xor_l(s, 16, F.lane); s += shfl_xor_l(s, 32, F.lane); if (fq == 0) SS[F.wave * 32 + 16 * mt + fr] = s;
#pragma unroll
            for (int nt = 0; nt < 2; ++nt)
#pragma unroll
                for (int r = 0; r < 4; ++r) PL[(F.wave * 32 + 16 * mt + 4 * fq + r) * 32 + 16 * nt + fr] = acc[mt][nt][r]; }
    }
    __syncthreads();
    float acc[20], ss = 0.f;
#pragma unroll
    for (int o = 0; o < 20; ++o) acc[o] = 0.f;
#pragma unroll
    for (int w = 0; w < 8; ++w) { ss += SS[w * 32 + ts];
#pragma unroll
        for (int o = 0; o < 20; ++o) acc[o] += PL[(w * 32 + ts) * 32 + o]; }
    const float rstd = 1.0f / sqrtf(ss * (1.0f / DM) + EPS);
    {
        float lg0 = acc[0] * rstd + brg[0], lg1 = acc[1] * rstd + brg[1], lg2 = acc[2] * rstd + brg[2], lg3 = acc[3] * rstd + brg[3];
        int grp = 0; float mx = lg0;
        if (lg1 > mx) { mx = lg1; grp = 1; } if (lg2 > mx) { mx = lg2; grp = 2; } if (lg3 > mx) { mx = lg3; grp = 3; }
        const float den = (__expf(lg0 - mx) + __expf(lg1 - mx)) + (__expf(lg2 - mx) + __expf(lg3 - mx));
        const float psel = 1.0f / den;
        const float m0 = (grp == 0) ? 1.f : 0.f, m1 = (grp == 1) ? 1.f : 0.f, m2 = (grp == 2) ? 1.f : 0.f, m3 = (grp == 3) ? 1.f : 0.f;
        float e0v = (m0 * acc[4] + m1 * acc[8]) + (m2 * acc[12] + m3 * acc[16]), e1v = (m0 * acc[5] + m1 * acc[9]) + (m2 * acc[13] + m3 * acc[17]);
        float e2v = (m0 * acc[6] + m1 * acc[10]) + (m2 * acc[14] + m3 * acc[18]), e3v = (m0 * acc[7] + m1 * acc[11]) + (m2 * acc[15] + m3 * acc[19]);
        e0v = e0v * rstd + bre[grp * 4 + 0]; e1v = e1v * rstd + bre[grp * 4 + 1]; e2v = e2v * rstd + bre[grp * 4 + 2]; e3v = e3v * rstd + bre[grp * 4 + 3];
        int i0 = 0; float v0 = e0v;
        if (e1v > v0) { v0 = e1v; i0 = 1; } if (e2v > v0) { v0 = e2v; i0 = 2; } if (e3v > v0) { v0 = e3v; i0 = 3; }
        int i1 = -1; float v1 = -3.0e38f;
        if (i0 != 0 && e0v > v1) { v1 = e0v; i1 = 0; } if (i0 != 1 && e1v > v1) { v1 = e1v; i1 = 1; } if (i0 != 2 && e2v > v1) { v1 = e2v; i1 = 2; } if (i0 != 3 && e3v > v1) { v1 = e3v; i1 = 3; }
        const float ex = __expf(v1 - v0); const float w0 = psel / (1.0f + ex), w1 = psel * ex / (1.0f + ex);
        if (part == 0) { const int ea = grp * 4 + i0, eb = grp * 4 + i1;
            le[ts * 2] = ea; le[ts * 2 + 1] = eb; lw[ts * 2] = w0; lw[ts * 2 + 1] = w1; lr[ts] = rstd;
            lp[ts * 2] = __hip_atomic_fetch_add(lcnt + ea, 1, __ATOMIC_RELAXED, __HIP_MEMORY_SCOPE_WORKGROUP); lp[ts * 2 + 1] = __hip_atomic_fetch_add(lcnt + eb, 1, __ATOMIC_RELAXED, __HIP_MEMORY_SCOPE_WORKGROUP); }
    }
    __syncthreads();
    if (F.tid < 16) lbase[F.tid] = (int)__hip_atomic_fetch_add(gcnt + 64 * F.tid, (unsigned)lcnt[F.tid], RLX_AGENT);
    __syncthreads();
    if (F.tid < 64) { const int t2 = F.tid >> 1; const int e = le[F.tid], pos = lbase[e] + lp[F.tid];
        TOKLIST[e * SEQ + pos] = tb + t2; WLIST[e * SEQ + pos] = lw[F.tid]; RSLIST[e * SEQ + pos] = lr[t2]; TOKPOS[(tb + t2) * 2 + (F.tid & 1)] = (e << 13) | pos; }
}
using pg8::Unit; using pg8::f32x2; using pg8::u32x4; using pg8::cvt_pk_bf16; using pg8::gelu_pk; using pg8::sigmoid_f;
__device__ __forceinline__ void tile_of(int idx, int nM, int nN, int& pm, int& pn) {
    const int nig = 8 * nN, gid = idx / nig, fm = gid * 8, gsz = (nM - fm) < 8 ? (nM - fm) : 8;
    pm = fm + ((idx % nig) % gsz); pn = (idx % nig) / gsz;
}
__device__ __forceinline__ int xcd_remap(int L, int nwg) { const int q = nwg / 8, r = nwg % 8, xcd = L % 8, off = L / 8; return (xcd < r ? xcd * (q + 1) : r * (q + 1) + (xcd - r) * q) + off; }

struct InProjSched {
    static constexpr bool GATHER = false;
    const char* XN; const char* WIN; int G, c;
    __device__ __forceinline__ bool next(int i, Unit& u) const {
        const int L = i * G + c; if (L >= 1152) return false;
        const int w = xcd_remap(L, 1152);
        if (w < 384) { u.kind = 0; tile_of(w, 12, 32, u.pm, u.pn); } else { u.kind = 1; tile_of(w - 384, 32, 24, u.pm, u.pn); }
        u.e = 0; u.row0 = 0; u.nvalid = 256; return true;
    }
    __device__ __forceinline__ const char* a_base(const Unit& u) const { return (u.kind == 0 ? WIN : XN) + (size_t)u.pm * (256 * DM * 2); }
    __device__ __forceinline__ const char* b_base(const Unit& u) const { return (u.kind == 0 ? XN : WIN + (size_t)NHY * DM * 2) + (size_t)u.pn * (256 * DM * 2); }
    __device__ __forceinline__ unsigned a_goff(const Unit&, int) const { return 0u; }
};
struct EpiInProj {
    static constexpr bool PERM = true, MIDK = false;
    bf16 *ZT, *U; const float* bin;
    __device__ __forceinline__ void operator()(const f32x4 (&acc)[2][2][4][2], const Unit& u, int wr, int wc, int fr, int fq) const {
        asm volatile("" : "+v"(fr), "+v"(fq));
        if (u.kind == 0) {
            const int row0 = u.pm * 256 + wr * 64 + fr, col0 = u.pn * 256 + wc * 32 + 8 * fq;
#pragma unroll
            for (int ai = 0; ai < 2; ++ai)
#pragma unroll
                for (int m = 0; m < 4; ++m) { const int row = row0 + ai * 128 + m * 16; const float b = bin[row]; bf16* rowp = ZT + (size_t)row * SEQ + col0;
#pragma unroll
                    for (int bj = 0; bj < 2; ++bj) { const f32x4 v0 = acc[ai][bj][m][0] + b, v1 = acc[ai][bj][m][1] + b;
                        u32x4 w; w.x = cvt_pk_bf16(v0[0], v0[1]); w.y = cvt_pk_bf16(v0[2], v0[3]); w.z = cvt_pk_bf16(v1[0], v1[1]); w.w = cvt_pk_bf16(v1[2], v1[3]);
                        *(u32x4*)(rowp + bj * 128) = w; } }
        } else {
            const int seg = (u.pn < 4) ? 0 : (u.pn < 8) ? 1 : (u.pn < 16) ? 2 : 3;
            const size_t boff = (seg == 0) ? 0 : (seg == 1) ? (WS_GV - WS_U) : (seg == 2) ? (WS_GH - WS_U) : (WS_GS - WS_U);
            bf16* base = (bf16*)((char*)U + boff);
            const int ldc = (seg < 2) ? 1024 : 2048, colt = (seg == 0) ? u.pn * 256 : (seg == 1) ? (u.pn - 4) * 256 : (seg == 2) ? (u.pn - 8) * 256 : (u.pn - 16) * 256;
            const int row0 = u.pm * 256 + wr * 64 + fr, col0 = colt + wc * 32 + 8 * fq, bcol0 = NHY + u.pn * 256 + wc * 32 + 8 * fq;
            f32x4 bv[2][2];
#pragma unroll
            for (int bj = 0; bj < 2; ++bj)
#pragma unroll
                for (int n = 0; n < 2; ++n) bv[bj][n] = *(const f32x4*)(bin + bcol0 + bj * 128 + 4 * n);
#pragma unroll
            for (int ai = 0; ai < 2; ++ai)
#pragma unroll
                for (int m = 0; m < 4; ++m) { bf16* rowp = base + (size_t)(row0 + ai * 128 + m * 16) * ldc + col0;
#pragma unroll
                    for (int bj = 0; bj < 2; ++bj) { f32x4 v0 = acc[ai][bj][m][0] + bv[bj][0], v1 = acc[ai][bj][m][1] + bv[bj][1];
                        if (seg < 2) { const f32x2 a = gelu_pk((f32x2){v0[0], v0[1]}), b = gelu_pk((f32x2){v0[2], v0[3]}), c = gelu_pk((f32x2){v1[0], v1[1]}), d = gelu_pk((f32x2){v1[2], v1[3]});
                            v0 = (f32x4){a.x, a.y, b.x, b.y}; v1 = (f32x4){c.x, c.y, d.x, d.y}; }
                        else {
#pragma unroll
                            for (int j = 0; j < 4; ++j) { v0[j] = sigmoid_f(v0[j]); v1[j] = sigmoid_f(v1[j]); } }
                        u32x4 w; w.x = cvt_pk_bf16(v0[0], v0[1]); w.y = cvt_pk_bf16(v0[2], v0[3]); w.z = cvt_pk_bf16(v1[0], v1[1]); w.w = cvt_pk_bf16(v1[2], v1[3]);
                        *(u32x4*)(rowp + bj * 128) = w; } }
        }
    }
    __device__ __forceinline__ void mid(f32x4 (&)[2][2][4][2], const Unit&, int, int, int, int) const {}
};
struct GridSched {
    static constexpr bool GATHER = false;
    const char* A; const char* Bt; int nM, nN, K, G, c;
    __device__ __forceinline__ bool next(int i, Unit& u) const {
        const int L = i * G + c, nwg = nM * nN; if (L >= nwg) return false;
        tile_of(xcd_remap(L, nwg), nM, nN, u.pm, u.pn); u.kind = 0; u.e = 0; u.row0 = 0; u.nvalid = 256; return true;
    }
    __device__ __forceinline__ const char* a_base(const Unit& u) const { return A + (size_t)u.pm * 512 * K; }
    __device__ __forceinline__ const char* b_base(const Unit& u) const { return Bt + (size_t)u.pn * 512 * K; }
    __device__ __forceinline__ unsigned a_goff(const Unit&, int) const { return 0u; }
};
struct EpiMerge {
    static constexpr bool PERM = true, MIDK = true;
    const bf16 *GH, *GS; bf16* O;
    __device__ __forceinline__ void mid(f32x4 (&acc)[2][2][4][2], const Unit& u, int wr, int wc, int fr, int fq) const {
        asm volatile("" : "+v"(fr), "+v"(fq));
        const int row0 = u.pm * 256 + wr * 64 + fr, col0 = u.pn * 256 + wc * 32 + 8 * fq;
        u32x4 hb[2][2], sb[2][2];
#define EM_LOAD(g, par) do { const size_t _o = (size_t)(row0 + ((g) >> 2) * 128 + ((g) & 3) * 16) * DM + col0; \
            hb[par][0] = *(const u32x4*)(GH + _o); hb[par][1] = *(const u32x4*)(GH + _o + 128); sb[par][0] = *(const u32x4*)(GS + _o); sb[par][1] = *(const u32x4*)(GS + _o + 128); } while (0)
        EM_LOAD(0, 0);
#pragma unroll
        for (int g = 0; g < 8; ++g) { const int ai = g >> 2, m = g & 3, par = g & 1;
            if (g + 1 < 8) EM_LOAD(g + 1, (g + 1) & 1);
            asm volatile("" ::: "memory");
#pragma unroll
            for (int bj = 0; bj < 2; ++bj) { const unsigned hh[4] = {hb[par][bj].x, hb[par][bj].y, hb[par][bj].z, hb[par][bj].w}, sv[4] = {sb[par][bj].x, sb[par][bj].y, sb[par][bj].z, sb[par][bj].w};
#pragma unroll
                for (int j = 0; j < 4; ++j) { const float r0 = bfl(hh[j]) * __builtin_amdgcn_rcpf(bfl(sv[j])), r1 = bfh(hh[j]) * __builtin_amdgcn_rcpf(bfh(sv[j]));
                    acc[ai][bj][m][j >> 1][(j & 1) * 2] *= r0; acc[ai][bj][m][j >> 1][(j & 1) * 2 + 1] *= r1; } }
            asm volatile("" : "+v"(acc[ai][0][m][0]), "+v"(acc[ai][0][m][1]), "+v"(acc[ai][1][m][0]), "+v"(acc[ai][1][m][1])); }
#undef EM_LOAD
    }
    __device__ __forceinline__ void operator()(const f32x4 (&acc)[2][2][4][2], const Unit& u, int wr, int wc, int fr, int fq) const {
        asm volatile("" : "+v"(fr), "+v"(fq));
        const int row0 = u.pm * 256 + wr * 64 + fr, col0 = u.pn * 256 + wc * 32 + 8 * fq;
        u32x4 sb[2][2];
#define EM_LOAD(g, par) do { const size_t _o = (size_t)(row0 + ((g) >> 2) * 128 + ((g) & 3) * 16) * DM + col0; sb[par][0] = *(const u32x4*)(GS + _o); sb[par][1] = *(const u32x4*)(GS + _o + 128); } while (0)
        EM_LOAD(0, 0); EM_LOAD(1, 1);
#pragma unroll
        for (int g = 0; g < 8; ++g) { const int ai = g >> 2, m = g & 3, par = g & 1; const size_t off = (size_t)(row0 + ai * 128 + m * 16) * DM + col0;
            u32x4 w[2];
#pragma unroll
            for (int bj = 0; bj < 2; ++bj) { const unsigned sv[4] = {sb[par][bj].x, sb[par][bj].y, sb[par][bj].z, sb[par][bj].w};
                const f32x4 v0 = acc[ai][bj][m][0], v1 = acc[ai][bj][m][1];
                w[bj].x = cvt_pk_bf16(v0[0] * bfl(sv[0]), v0[1] * bfh(sv[0])); w[bj].y = cvt_pk_bf16(v0[2] * bfl(sv[1]), v0[3] * bfh(sv[1]));
                w[bj].z = cvt_pk_bf16(v1[0] * bfl(sv[2]), v1[1] * bfh(sv[2])); w[bj].w = cvt_pk_bf16(v1[2] * bfl(sv[3]), v1[3] * bfh(sv[3])); }
            if (g + 2 < 8) EM_LOAD(g + 2, par);
            *(u32x4*)(O + off) = w[0]; *(u32x4*)(O + off + 128) = w[1];
            asm volatile("" ::: "memory"); }
#undef EM_LOAD
    }
};
struct EpiResid {
    static constexpr bool PERM = false, MIDK = false;
    const float* base; float* out;
    __device__ __forceinline__ void operator()(const f32x4 (&acc)[2][2][4][2], const Unit& u, int wr, int wc, int fr, int fq) const {
        asm volatile("" : "+v"(fr), "+v"(fq));
        const int row0 = u.pm * 256 + wr * 64 + fr, col0 = u.pn * 256 + wc * 32 + 4 * fq;
        f32x4 bb[2][4];
#define ER_LOAD(g, par) do { const size_t _o = (size_t)(row0 + ((g) >> 2) * 128 + ((g) & 3) * 16) * DM + col0; \
            bb[par][0] = *(const f32x4*)(base + _o); bb[par][1] = *(const f32x4*)(base + _o + 16); bb[par][2] = *(const f32x4*)(base + _o + 128); bb[par][3] = *(const f32x4*)(base + _o + 144); } while (0)
        ER_LOAD(0, 0); ER_LOAD(1, 1);
#pragma unroll
        for (int g = 0; g < 8; ++g) { const int ai = g >> 2, m = g & 3, par = g & 1; const size_t off = (size_t)(row0 + ai * 128 + m * 16) * DM + col0;
            const f32x4 o0 = bb[par][0] + acc[ai][0][m][0], o1 = bb[par][1] + acc[ai][0][m][1], o2 = bb[par][2] + acc[ai][1][m][0], o3 = bb[par][3] + acc[ai][1][m][1];
            if (g + 2 < 8) ER_LOAD(g + 2, par);
            *(f32x4*)(out + off) = o0; *(f32x4*)(out + off + 16) = o1; *(f32x4*)(out + off + 128) = o2; *(f32x4*)(out + off + 144) = o3;
            asm volatile("" ::: "memory"); }
#undef ER_LOAD
    }
    __device__ __forceinline__ void mid(f32x4 (&)[2][2][4][2], const Unit&, int, int, int, int) const {}
};
struct MoeSched1 {
    static constexpr bool GATHER = true;
    const LAS int* tab; const char* H; const char* W; const int* toklist; int G, c;
    __device__ __forceinline__ bool next(int i, Unit& u) const {
        const int L = i * G + c; const int total = __builtin_amdgcn_readfirstlane(tab[16]) * 4; if (L >= total) return false;
        const int rt = L >> 2; int e = 0;
#pragma unroll
        for (int j = 1; j < 16; ++j) e += (__builtin_amdgcn_readfirstlane(tab[j]) <= rt) ? 1 : 0;
        const int j0 = rt - __builtin_amdgcn_readfirstlane(tab[e]);
        u.pm = j0; u.pn = L & 3; u.kind = 0; u.e = e; u.row0 = __builtin_amdgcn_readfirstlane(tab[17 + e]) + 256 * j0;
        const int rem = __builtin_amdgcn_readfirstlane(tab[34 + e]) - 256 * j0; u.nvalid = rem < 256 ? rem : 256; return true;
    }
    __device__ __forceinline__ const char* a_base(const Unit&) const { return H; }
    __device__ __forceinline__ const char* b_base(const Unit& u) const { return W + ((size_t)u.e * 1024 + (size_t)u.pn * 256) * DM * 2; }
    __device__ __forceinline__ unsigned a_goff(const Unit& u, int r) const { const int tok = (r < u.nvalid) ? toklist[u.e * SEQ + u.pm * 256 + r] : 0; return (unsigned)tok * (unsigned)(DM * 2); }
};
struct EpiMoe1 {
    static constexpr bool PERM = true, MIDK = false;
    bf16* ACT; const float* wlist; const float* rslist;
    __device__ __forceinline__ void operator()(const f32x4 (&acc)[2][2][4][2], const Unit& u, int wr, int wc, int fr, int fq) const {
        asm volatile("" : "+v"(fr), "+v"(fq));
        const int col0 = u.pn * 128 + wc * 32 + 8 * fq;
#pragma unroll
        for (int ai = 0; ai < 2; ++ai)
#pragma unroll
            for (int m = 0; m < 4; ++m) { const int rl = ai * 128 + wr * 64 + m * 16 + fr;
                if (rl < u.nvalid) { const float wt = wlist[u.e * SEQ + u.pm * 256 + rl], rs = rslist[u.e * SEQ + u.pm * 256 + rl];
                    const f32x4 g0 = acc[ai][0][m][0], g1 = acc[ai][0][m][1], u0 = acc[ai][1][m][0], u1 = acc[ai][1][m][1];
                    float o[8];
#pragma unroll
                    for (int j = 0; j < 4; ++j) { const float ga = g0[j] * rs, gb = g1[j] * rs; o[j] = ga * sigmoid_f(ga) * (u0[j] * rs) * wt; o[4 + j] = gb * sigmoid_f(gb) * (u1[j] * rs) * wt; }
                    u32x4 w; w.x = cvt_pk_bf16(o[0], o[1]); w.y = cvt_pk_bf16(o[2], o[3]); w.z = cvt_pk_bf16(o[4], o[5]); w.w = cvt_pk_bf16(o[6], o[7]);
                    *(u32x4*)(ACT + (size_t)(u.row0 + rl) * DEXP + col0) = w; } }
    }
    __device__ __forceinline__ void mid(f32x4 (&)[2][2][4][2], const Unit&, int, int, int, int) const {}
};
struct MoeSched2 {
    static constexpr bool GATHER = false;
    const LAS int* tab; const char* ACT; const char* W; int G, c;
    __device__ __forceinline__ bool next(int i, Unit& u) const {
        const int L = i * G + c; const int total = __builtin_amdgcn_readfirstlane(tab[16]) * 8; if (L >= total) return false;
        const int rt = L >> 3; int e = 0;
#pragma unroll
        for (int j = 1; j < 16; ++j) e += (__builtin_amdgcn_readfirstlane(tab[j]) <= rt) ? 1 : 0;
        const int j0 = rt - __builtin_amdgcn_readfirstlane(tab[e]);
        u.pm = j0; u.pn = L & 7; u.kind = 0; u.e = e; u.row0 = __builtin_amdgcn_readfirstlane(tab[17 + e]) + 256 * j0;
        const int rem = __builtin_amdgcn_readfirstlane(tab[34 + e]) - 256 * j0; u.nvalid = rem < 256 ? rem : 256; return true;
    }
    __device__ __forceinline__ const char* a_base(const Unit& u) const { return ACT + (size_t)u.row0 * DEXP * 2; }
    __device__ __forceinline__ const char* b_base(const Unit& u) const { return W + ((size_t)u.e * DM + (size_t)u.pn * 256) * DEXP * 2; }
    __device__ __forceinline__ unsigned a_goff(const Unit&, int) const { return 0u; }
};
struct EpiMoe2 {
    static constexpr bool PERM = true, MIDK = false;
    bf16* MO;
    __device__ __forceinline__ void operator()(const f32x4 (&acc)[2][2][4][2], const Unit& u, int wr, int wc, int fr, int fq) const {
        asm volatile("" : "+v"(fr), "+v"(fq));
        const int col0 = u.pn * 256 + wc * 32 + 8 * fq;
#pragma unroll
        for (int ai = 0; ai < 2; ++ai)
#pragma unroll
            for (int m = 0; m < 4; ++m) { const int rl = ai * 128 + wr * 64 + m * 16 + fr;
                if (rl < u.nvalid) { bf16* rowp = MO + (size_t)(u.row0 + rl) * DM + col0;
#pragma unroll
                    for (int bj = 0; bj < 2; ++bj) { const f32x4 v0 = acc[ai][bj][m][0], v1 = acc[ai][bj][m][1];
                        u32x4 w; w.x = cvt_pk_bf16(v0[0], v0[1]); w.y = cvt_pk_bf16(v0[2], v0[3]); w.z = cvt_pk_bf16(v1[0], v1[1]); w.w = cvt_pk_bf16(v1[2], v1[3]);
                        *(u32x4*)(rowp + bj * 128) = w; } } }
    }
    __device__ __forceinline__ void mid(f32x4 (&)[2][2][4][2], const Unit&, int, int, int, int) const {}
};
__device__ __forceinline__ void moe_tables(Frame& F, int l) {
    LAS int* tab = (LAS int*)(F.lds + MISC_OFF + 128);
    __syncthreads();
    if (F.tid == 0) { int tp = 0, off = 0;
        for (int e = 0; e < 16; ++e) { const int c = (int)__hip_atomic_load(F.ctl + CW_CNT + 64 * (16 * l + e), RLX_AGENT); tab[e] = tp; tab[17 + e] = off; tab[34 + e] = c; tp += (c + 255) >> 8; off += c; }
        tab[16] = tp; tab[33] = off; }
    __syncthreads();
}

struct Args { const float* in[29]; float* out; unsigned char* ws; int ph_lo, ph_hi; };
constexpr int NPHASE = 17;
__global__ void __launch_bounds__(NTHR, 2) fwd_kernel(Args args) {
    extern __shared__ __attribute__((aligned(16))) unsigned char lds[];
    Frame F;
    F.lds = (LAS unsigned char*)lds;
    F.MISC = (volatile LAS unsigned*)(F.lds + MISC_OFF);
    F.tid = threadIdx.x; F.lane = F.tid & 63; F.wave = __builtin_amdgcn_readfirstlane(F.tid >> 6);
    F.G = gridDim.x; { const int bx = blockIdx.x; F.vcu = (F.G % 8 == 0) ? (bx % 8) * (F.G / 8) + bx / 8 : bx; }
    F.ws = args.ws; F.out = args.out; F.ctl = (gu32*)(args.ws + WS_CTL);
    for (int u = F.tid; u < 256; u += NTHR) ((LAS unsigned*)(F.lds + MISC_OFF))[u] = 0u;
    F.inp = (const LAS unsigned long long*)(F.lds + MISC_OFF + 640);
    __syncthreads();
#pragma unroll
    for (int i = 0; i < 29; ++i) if (F.tid == i) ((LAS unsigned long long*)(F.lds + MISC_OFF + 640))[i] = (unsigned long long)args.in[i];
    __syncthreads();
    const int lo = args.ph_lo, hi = args.ph_hi;
    const bool multi = (hi - lo) > 1;
    XcdBarrier bar; bar.bar = (unsigned*)(F.ctl + CW_BAR); bar.x = 0; bar.st = nullptr;
    if (multi) bar = xcd_barrier_post((unsigned*)(F.ctl + CW_BAR), F.MISC + 8);
#ifndef PHASE_MASK
#define PHASE_MASK 0x7ff
#endif
#define IN(k) (lo <= (k) && (k) < hi)
#define ON(j) ((PHASE_MASK >> (j)) & 1)
#ifndef DUP_MASK
#define DUP_MASK 0
#endif
#define REP(j) for (int _rep = 0; _rep < (((DUP_MASK >> (j)) & 1) ? 2 : 1); ++_rep)
#define LAUNDER() do { int _l; asm volatile("v_mbcnt_lo_u32_b32 %0, -1, 0\n\tv_mbcnt_hi_u32_b32 %0, -1, %0" : "=v"(_l)); F.lane = _l; F.tid = F.wave * 64 + _l; { unsigned char* _w = F.ws; asm volatile("" : "+s"(_w)); F.ws = _w; } } while (0)
#ifndef PROBE_K
#define PROBE_K -1
#endif
#ifndef PROBE_PART
#define PROBE_PART 0
#endif
#ifndef PROBE_AMP
#define PROBE_AMP 8
#endif
    volatile LAS unsigned long long* pr = (volatile LAS unsigned long long*)(F.lds + MISC_OFF + 512);
#define PR_ME (blockIdx.x == 0 && threadIdx.x == 0)
#define PSTART(j) do { if (PROBE_K == (j) && PROBE_PART != 1 && PR_ME) pr[0] = __builtin_amdgcn_s_memrealtime(); } while (0)
#define PEND(j) do { if (PROBE_K == (j) && PR_ME) { const unsigned long long _n = __builtin_amdgcn_s_memrealtime(); if (PROBE_PART == 0 || (PROBE_PART == 2 && (j) == 8)) pr[1] += _n - pr[0]; else if (PROBE_PART == 1) pr[0] = _n; } } while (0)
#define PBAR(j) do { if (PROBE_K == (j) && PROBE_PART >= 1 && PR_ME) pr[1] += __builtin_amdgcn_s_memrealtime() - pr[0]; } while (0)
#define SEAM(k) do { if (IN(k) && IN((k) + 1)) xcd_barrier(bar); } while (0)
    const int gw = F.vcu * NWAVES + F.wave, NGW = F.G * NWAVES;
    for (int l = 0; l < DEPTH; ++l) {
        const int p0 = l * 8;
        if (ON(0) && IN(p0 + 0)) { LAUNDER(); PSTART(0);
            PSTART(10); if (l == 0) pa_convert(F, l); PEND(10);
            PSTART(11); pa_features(F, l); PEND(11);
            PSTART(12); pa_router_t(F, l); PEND(12);
            PSTART(13);
            const float* g = inp(F, I_GMIX) + (size_t)l * DM;
            if (l == 0) { for (int m = gw; m < SEQ; m += 4 * NGW) norm_rows<0, false, 4>(F, m, NGW, inp(F, I_X), g, nullptr, nullptr); }
            else { for (int m = gw; m < SEQ; m += 2 * NGW) norm_rows<1, false, 2>(F, m, NGW, nullptr, g, F.ctl + CW_CNT + 64 * 16 * (l - 1), nullptr); }
            PEND(13);
        }
        PEND(0); SEAM(p0 + 0); PBAR(0);
        if (ON(1) && IN(p0 + 1)) { LAUNDER(); PSTART(1);
            InProjSched S{(const char*)(F.ws + WS_XN), (const char*)(F.ws + ((l & 1) ? WS_WIN2 : WS_WIN)), F.G, (int)blockIdx.x};
            EpiInProj E{(bf16*)(F.ws + WS_ZT), (bf16*)(F.ws + WS_U), inp(F, I_BIN) + (size_t)l * NIN};
            REP(1) pg8::gemm_phase<EpiInProj, InProjSched>(F.lds, DM, S, E, F.tid);
        }
        PEND(1); SEAM(p0 + 1); PBAR(1);
        if (ON(2) && IN(p0 + 2)) { LAUNDER(); PSTART(2);
            if (ON(9)) REP(9) for (int u = F.vcu; u < 512; u += F.G) sgu_unit(F, l, u >> 3, u & 7);
            if (ON(10)) REP(10) for (int b = F.vcu; b < 256; b += F.G) hyena_block(F, l, b);
        }
        PEND(2); SEAM(p0 + 2); PBAR(2);
        if (ON(3) && IN(p0 + 3)) { LAUNDER(); PSTART(3);
            GridSched S{(const char*)(F.ws + WS_Y), (const char*)(F.ws + WS_PT), 32, 8, DM, F.G, (int)blockIdx.x};
            EpiMerge E{(const bf16*)(F.ws + WS_GH), (const bf16*)(F.ws + WS_GS), (bf16*)(F.ws + WS_MERGED)};
            REP(3) pg8::gemm_phase<EpiMerge, GridSched>(F.lds, DM, S, E, F.tid);
        }
        PEND(3); SEAM(p0 + 3); PBAR(3);
        if (ON(4) && IN(p0 + 4)) { LAUNDER(); PSTART(4);
            GridSched S{(const char*)(F.ws + WS_MERGED), (const char*)(F.ws + WS_WOT), 32, 8, DM, F.G, (int)blockIdx.x};
            EpiResid E{l == 0 ? inp(F, I_X) : (const float*)(F.ws + WS_XR), (float*)(F.ws + WS_XR)};
            pg8::gemm_phase<EpiResid, GridSched>(F.lds, DM, S, E, F.tid);
        }
        PEND(4); SEAM(p0 + 4); PBAR(4);
        if (ON(5) && IN(p0 + 5)) { LAUNDER(); PSTART(5); for (int tb = F.vcu * 32; tb < SEQ; tb += F.G * 32) route_block(F, l, tb); }
        PEND(5); SEAM(p0 + 5); PBAR(5);
        if (ON(6) && IN(p0 + 6)) { LAUNDER(); PSTART(6);
            moe_tables(F, l);
            MoeSched1 S{(const LAS int*)(F.lds + MISC_OFF + 128), (const char*)(F.ws + WS_XN), (const char*)(F.ws + WS_WGU), (const int*)(F.ws + WS_LISTS), F.G, F.vcu};
            EpiMoe1 E{(bf16*)(F.ws + WS_ACT), (const float*)(F.ws + WS_LISTS + 512 * 1024), (const float*)(F.ws + WS_LISTS + 1 * MiB + 512 * 1024)};
            REP(6) pg8::gemm_phase<EpiMoe1, MoeSched1>(F.lds, DM, S, E, F.tid);
        }
        PEND(6); SEAM(p0 + 6); PBAR(6);
        if (ON(7) && IN(p0 + 7)) { LAUNDER(); PSTART(7);
            moe_tables(F, l);
            MoeSched2 S{(const LAS int*)(F.lds + MISC_OFF + 128), (const char*)(F.ws + WS_ACT), (const char*)(F.ws + WS_WD), F.G, F.vcu};
            EpiMoe2 E{(bf16*)(F.ws + WS_MOEOUT)};
            REP(7) pg8::gemm_phase<EpiMoe2, MoeSched2>(F.lds, DEXP, S, E, F.tid);
        }
        PEND(7); SEAM(p0 + 7); PBAR(7);
    }
    if (ON(8) && IN(16)) { LAUNDER(); PSTART(8); for (int m = gw; m < SEQ; m += 2 * NGW) norm_rows<1, true, 2>(F, m, NGW, nullptr, inp(F, I_GFINAL), F.ctl + CW_CNT + 64 * 16 * (DEPTH - 1), F.out); }
    PEND(8);
    if (PROBE_K >= 0 && PR_ME) { const unsigned long long t0 = __builtin_amdgcn_s_memrealtime(), amt = pr[1] * PROBE_AMP; while (__builtin_amdgcn_s_memrealtime() - t0 < amt) __builtin_amdgcn_s_sleep(8); }
#undef IN
#undef SEAM
}

#ifndef MK_ONE_LAUNCH
#define MK_ONE_LAUNCH 0
#endif
extern "C" void kernel_launch(void* const* d_in, const int* in_sizes, int n_in, void* d_out, int out_size, void* d_ws, size_t ws_size, hipStream_t stream) {
    static int grid = 0;
    if (grid == 0) {
        if (n_in != 29 || ws_size < WS_END) { fprintf(stderr, "kernel_launch: unexpected n_in %d or ws %zu < %zu\n", n_in, ws_size, (size_t)WS_END); grid = -1; return; }
        int dev = 0, cus = 0, per_cu = 0;
        if (hipGetDevice(&dev) != hipSuccess || hipDeviceGetAttribute(&cus, hipDeviceAttributeMultiprocessorCount, dev) != hipSuccess) { grid = -1; return; }
        if (hipFuncSetAttribute((const void*)fwd_kernel, hipFuncAttributeMaxDynamicSharedMemorySize, LDS_BYTES) != hipSuccess) { fprintf(stderr, "kernel_launch: hipFuncSetAttribute failed\n"); grid = -1; return; }
        if (hipOccupancyMaxActiveBlocksPerMultiprocessor(&per_cu, (const void*)fwd_kernel, NTHR, LDS_BYTES) != hipSuccess || per_cu < 1) fprintf(stderr, "kernel_launch: occupancy query reports %d\n", per_cu);
        (void)hipGetLastError();
        grid = cus;
    }
    if (grid < 0) return;
    (void)hipMemsetAsync((char*)d_ws + WS_CTL, 0, CTL_ZERO_BYTES, stream);
    Args a{};
    for (int i = 0; i < 29; ++i) a.in[i] = (const float*)d_in[i];
    a.out = (float*)d_out; a.ws = (unsigned char*)d_ws;
#if MK_ONE_LAUNCH
    a.ph_lo = 0; a.ph_hi = NPHASE;
    hipLaunchKernelGGL(fwd_kernel, dim3(grid), dim3(NTHR), LDS_BYTES, stream, a);
#else
    for (int p = 0; p < NPHASE; ++p) { a.ph_lo = p; a.ph_hi = p + 1; hipLaunchKernelGGL(fwd_kernel, dim3(grid), dim3(NTHR), LDS_BYTES, stream, a); }
#endif
}
```

```cpp
#include <hip/hip_runtime.h>
#include <cstdio>
#include <cstdint>
#define MK_ONE_LAUNCH 1
#define DUP_MASK 0
#define PROBE_K -1
#define PROBE_PART 0
namespace pg8 {
#define PG8_LAS __attribute__((address_space(3)))
typedef unsigned short bf16_t;
typedef short bf16x8 __attribute__((ext_vector_type(8)));
typedef float f32x4 __attribute__((ext_vector_type(4)));
typedef float f32x2 __attribute__((ext_vector_type(2)));
typedef unsigned u32x4 __attribute__((ext_vector_type(4)));
typedef unsigned u32x2 __attribute__((ext_vector_type(2)));
constexpr int BM = 256, BK = 64, HALF = 128, HTB = HALF * BK * 2  , STAGE_BYTES = 8 * HTB;
constexpr int GATHER_SLOT_OFF = 2 * 8448 * 8 + 1024;

__host__ __device__ __forceinline__ int lds_byte(int r, int c) { const int st = (r >> 4) * 2 + (c >> 5), rr = r & 15, cc = c & 31, ob = rr * 64 + cc * 2; return st * 1024 + (ob ^ (((ob >> 9) & 1) << 5)); }
__host__ __device__ __forceinline__ void stage_rc(int b, int& R, int& C) { const int st = b / 1024, sb = b % 1024, swz = sb ^ (((sb >> 9) & 1) << 5); R = (st >> 1) * 16 + swz / 64; C = (st & 1) * 32 + (swz % 64) / 2; }
__host__ __device__ __forceinline__ int perm32(int rho) { const int n = rho >> 4, i = rho & 15; return 8 * (i >> 2) + 4 * n + (i & 3); }

struct Unit { int pm, pn, kind, e, row0, nvalid; };

__device__ __forceinline__ unsigned cvt_pk_bf16(float lo, float hi) { unsigned r; asm volatile("v_cvt_pk_bf16_f32 %0, %1, %2" : "=v"(r) : "v"(lo), "v"(hi)); return r; }
__device__ __forceinline__ f32x2 gelu_pk(f32x2 v) {
    const f32x2 av = __builtin_elementwise_abs(v), d = av * 0.2316418882f + 1.0f;
    f32x2 t; t.x = __builtin_amdgcn_rcpf(d.x); t.y = __builtin_amdgcn_rcpf(d.y);
    f32x2 q = t * 0.5307027145f + (-0.7265760135f); q = q * t + 0.7107068705f; q = q * t + (-0.142248368f); q = q * t + 0.127414796f; q = q * t;
    const f32x2 s = (v * v) * (-0.72134752044f);
    f32x2 e; e.x = __builtin_amdgcn_exp2f(s.x); e.y = __builtin_amdgcn_exp2f(s.y);
    const f32x2 m = v * (q * e), r = v - m;
    f32x2 o; o.x = v.x < 0.f ? m.x : r.x; o.y = v.y < 0.f ? m.y : r.y; return o;
}
__device__ __forceinline__ float sigmoid_f(float x) { return __builtin_amdgcn_rcpf(1.0f + __builtin_amdgcn_exp2f(-1.4426950408889634f * x)); }

template <class Epi, class Sched>
__device__ __forceinline__ void gemm_phase(PG8_LAS unsigned char* lds, const int K, const Sched& S, const Epi& E, int tid) {
    asm volatile("" : "+v"(tid));
    const int wid = __builtin_amdgcn_readfirstlane(tid >> 6), lane = tid & 63, wr = wid >> 2, wc = wid & 3, fr = lane & 15, fq = lane >> 4;
    const int nt = K / BK;
    unsigned voffA[2], voffB[2];
#pragma unroll
    for (int i = 0; i < 2; ++i) { int R, C; stage_rc(tid * 16 + i * 8192, R, C); const int Rb = Epi::PERM ? ((R & ~31) + perm32(R & 31)) : R;
        voffA[i] = Sched::GATHER ? 0u : (unsigned)(R * K + C) * 2u; voffB[i] = (unsigned)(Rb * K + C) * 2u; }
#define PG8_GOFF(u, h, i) ({ int _R, _C, _t = tid; asm volatile("" : "+v"(_t)); stage_rc(_t * 16 + (i) * 8192, _R, _C); S.a_goff((u), (h) * HALF + _R) + (unsigned)(_C * 2); })
    const size_t kstep = (size_t)(BK * 2);
    const size_t hstep = (size_t)HALF * K * 2;
    const unsigned ldsw = (unsigned)wid * 1024u;
    const int aoff = lds_byte(wr * 64 + fr, fq * 8), boff = lds_byte(wc * 32 + fr, fq * 8);
#define PG8_SA(b, h) (((b) * 2 + (h)) * HTB)
#define PG8_SB(b, h) ((4 + (b) * 2 + (h)) * HTB)
#define PG8_STAGE(bufoff, gbase, voff) do { _Pragma("unroll") for (int _i = 0; _i < 2; ++_i) \
        __builtin_amdgcn_global_load_lds((const unsigned*)((const char*)(gbase) + (voff)[_i]), (PG8_LAS unsigned*)(lds + (bufoff) + ldsw + _i * 8192), 16, 0, 0); } while (0)
#define PG8_STAGE_A(bufoff, gbase, h, GO) do { if constexpr (Sched::GATHER) { _Pragma("unroll") for (int _i = 0; _i < 2; ++_i) \
        __builtin_amdgcn_global_load_lds((const unsigned*)((const char*)(gbase) + (GO)[h][_i]), (PG8_LAS unsigned*)(lds + (bufoff) + ldsw + _i * 8192), 16, 0, 0); } \
        else { PG8_STAGE(bufoff, (gbase) + (h) * hstep, voffA); } } while (0)
#define PG8_LDA(dst, b, h) do { _Pragma("unroll") for (int m = 0; m < 4; ++m) _Pragma("unroll") for (int k = 0; k < 2; ++k) dst[m][k] = *(const PG8_LAS bf16x8*)(lds + PG8_SA(b, h) + aoff + m * 2048 + k * 1024); } while (0)
#define PG8_LDB(dst, b, h) do { _Pragma("unroll") for (int n = 0; n < 2; ++n) _Pragma("unroll") for (int k = 0; k < 2; ++k) dst[n][k] = *(const PG8_LAS bf16x8*)(lds + PG8_SB(b, h) + boff + n * 2048 + k * 1024); } while (0)
#define PG8_MMA(ai, bj, At, Bt) do { __builtin_amdgcn_s_setprio(1); _Pragma("unroll") for (int m = 0; m < 4; ++m) _Pragma("unroll") for (int n = 0; n < 2; ++n) _Pragma("unroll") for (int k = 0; k < 2; ++k) \
        acc[ai][bj][m][n] = __builtin_amdgcn_mfma_f32_16x16x32_bf16(Bt[n][k], At[m][k], acc[ai][bj][m][n], 0, 0, 0); __builtin_amdgcn_s_setprio(0); } while (0)
#define PG8_WAIT_V(n) asm volatile("s_waitcnt vmcnt(" #n ")" ::: "memory")
#define PG8_WAIT_L(n) asm volatile("s_waitcnt lgkmcnt(" #n ")" ::: "memory")
#define PG8_BAR __builtin_amdgcn_s_barrier()
#define PG8_SCHED __builtin_amdgcn_sched_barrier(0)
    Unit cur, nxt; int ui = 0;
    if (!S.next(0, cur)) return;
    f32x4 acc[2][2][4][2];
#pragma unroll
    for (int a = 0; a < 2; ++a)
#pragma unroll
        for (int b = 0; b < 2; ++b)
#pragma unroll
            for (int m = 0; m < 4; ++m)
#pragma unroll
                for (int n = 0; n < 2; ++n) acc[a][b][m][n] = (f32x4){0.f, 0.f, 0.f, 0.f};
    bf16x8 At[4][2], B0[2][2], B1[2][2];
    const char* cA = S.a_base(cur); const char* cB = S.b_base(cur);
    unsigned cgo[2][2];
    PG8_LAS u32x4* gslot = (PG8_LAS u32x4*)(lds + GATHER_SLOT_OFF) + tid;
    if constexpr (Sched::GATHER) {
#pragma unroll
        for (int h = 0; h < 2; ++h)
#pragma unroll
            for (int i = 0; i < 2; ++i) cgo[h][i] = PG8_GOFF(cur, h, i);
    }
    PG8_STAGE(PG8_SB(0, 0), cB, voffB); PG8_STAGE(PG8_SB(0, 1), cB + hstep, voffB); PG8_STAGE_A(PG8_SA(0, 0), cA, 0, cgo); PG8_STAGE_A(PG8_SA(0, 1), cA, 1, cgo);
    if (wr == 1) PG8_BAR;
    PG8_WAIT_V(2); PG8_BAR;
    PG8_STAGE(PG8_SB(1, 0), cB + kstep, voffB); PG8_STAGE_A(PG8_SA(1, 0), cA + kstep, 0, cgo); PG8_STAGE(PG8_SB(1, 1), cB + hstep + kstep, voffB);
    PG8_WAIT_V(6); PG8_BAR;
    for (;;) {
        const bool has_next = S.next(ui + 1, nxt);
        const char* nA = has_next ? S.a_base(nxt) : cA; const char* nB = has_next ? S.b_base(nxt) : cB;
        if constexpr (Sched::GATHER) {
            u32x4 nx = (u32x4){cgo[0][0], cgo[0][1], cgo[1][0], cgo[1][1]};
            if (has_next) { nx.x = PG8_GOFF(nxt, 0, 0); nx.y = PG8_GOFF(nxt, 0, 1); nx.z = PG8_GOFF(nxt, 1, 0); nx.w = PG8_GOFF(nxt, 1, 1); }
            *gslot = nx;
        }
        for (int t = 0; t < nt; t += 2) {
            const bool last = (t == nt - 2);
            if constexpr (Epi::MIDK) { if (t == (nt >> 1)) { int tl = tid; asm volatile("" : "+v"(tl)); E.mid(acc, cur, wr, wc, tl & 15, (tl >> 4) & 3); } }
            const char* a1 = cA + (size_t)(t + 1) * kstep;
            const char* a2 = last ? nA : cA + (size_t)(t + 2) * kstep; const char* b2 = last ? nB : cB + (size_t)(t + 2) * kstep;
            const char* a3 = a2 + kstep; const char* b3 = b2 + kstep;
            unsigned xgo[2][2];
            if constexpr (Sched::GATHER) {
                if (last) { const u32x4 nx = *gslot; xgo[0][0] = nx.x; xgo[0][1] = nx.y; xgo[1][0] = nx.z; xgo[1][1] = nx.w; }
                else { xgo[0][0] = cgo[0][0]; xgo[0][1] = cgo[0][1]; xgo[1][0] = cgo[1][0]; xgo[1][1] = cgo[1][1]; }
            }
            PG8_LDB(B0, 0, 0); PG8_LDB(B1, 0, 1); PG8_SCHED; PG8_LDA(At, 0, 0); PG8_STAGE_A(PG8_SA(1, 1), a1, 1, cgo);
            PG8_WAIT_V(8); PG8_WAIT_L(0); PG8_BAR; PG8_MMA(0, 0, At, B0); PG8_MMA(0, 1, At, B1); PG8_BAR; PG8_SCHED;
            PG8_LDA(At, 0, 1); PG8_STAGE(PG8_SB(0, 0), b2, voffB); PG8_STAGE(PG8_SB(0, 1), b2 + hstep, voffB); PG8_STAGE_A(PG8_SA(0, 0), a2, 0, xgo);
            PG8_WAIT_V(8); PG8_WAIT_L(0); PG8_BAR; PG8_MMA(1, 0, At, B0); PG8_MMA(1, 1, At, B1); PG8_BAR; PG8_SCHED;
            PG8_LDB(B0, 1, 0); PG8_LDB(B1, 1, 1); PG8_SCHED; PG8_LDA(At, 1, 0); PG8_STAGE_A(PG8_SA(0, 1), a2, 1, xgo);
            PG8_WAIT_V(8); PG8_WAIT_L(0); PG8_BAR; PG8_MMA(0, 0, At, B0); PG8_MMA(0, 1, At, B1); PG8_BAR; PG8_SCHED;
            PG8_LDA(At, 1, 1); PG8_STAGE(PG8_SB(1, 0), b3, voffB); PG8_STAGE(PG8_SB(1, 1), b3 + hstep, voffB); PG8_STAGE_A(PG8_SA(1, 0), a3, 0, xgo);
            PG8_WAIT_V(8); PG8_WAIT_L(0); PG8_BAR; PG8_MMA(1, 0, At, B0); PG8_MMA(1, 1, At, B1); PG8_BAR; PG8_SCHED;
        }
        if (wr == 0) PG8_BAR;
        { int tl = tid; asm volatile("" : "+v"(tl)); E(acc, cur, wr, wc, tl & 15, (tl >> 4) & 3); }
        if (!has_next) break;
#pragma unroll
        for (int a = 0; a < 2; ++a)
#pragma unroll
            for (int b = 0; b < 2; ++b)
#pragma unroll
                for (int m = 0; m < 4; ++m)
#pragma unroll
                    for (int n = 0; n < 2; ++n) acc[a][b][m][n] = (f32x4){0.f, 0.f, 0.f, 0.f};
        cur = nxt; cA = nA; cB = nB; ++ui;
        if constexpr (Sched::GATHER) { const u32x4 nx = *gslot; cgo[0][0] = nx.x; cgo[0][1] = nx.y; cgo[1][0] = nx.z; cgo[1][1] = nx.w; }
        if (wr == 1) PG8_BAR;
    }
    PG8_WAIT_V(0);
    PG8_BAR;
#undef PG8_SA
#undef PG8_SB
#undef PG8_STAGE
#undef PG8_STAGE_A
#undef PG8_GOFF
#undef PG8_LDA
#undef PG8_LDB
#undef PG8_MMA
#undef PG8_WAIT_V
#undef PG8_WAIT_L
#undef PG8_BAR
#undef PG8_SCHED
}
}
constexpr int NWAVES = 8, NTHR = 512;
constexpr int SEQ = 8192, DM = 2048, NIN = 9216, HYW = 1024, SGW = 1024, NHY = 3072, NEXP = 16, DEXP = 512, DEPTH = 2;
constexpr float EPS = 1e-6f;
constexpr size_t MiB = 1u << 20;
constexpr size_t WS_CTL = 0, CTL_ZERO_BYTES = 1 * MiB;
constexpr size_t WS_WIN = 1 * MiB;
constexpr size_t WS_WIN2 = WS_WIN + 36 * MiB;
constexpr size_t WS_PT = WS_WIN2 + 36 * MiB;
constexpr size_t WS_WOT = WS_PT + 8 * MiB;
constexpr size_t WS_WGU = WS_WOT + 8 * MiB;
constexpr size_t WS_WD = WS_WGU + 64 * MiB;
constexpr size_t WS_W3T = WS_WD + 32 * MiB;
constexpr size_t WS_A2 = WS_W3T + 1 * MiB;
constexpr size_t WS_WR = WS_A2 + 2 * MiB;
constexpr size_t WS_LISTS = WS_WR + 1 * MiB;
constexpr size_t WS_XR = WS_LISTS + 2 * MiB;
constexpr size_t WS_XN = WS_XR + 64 * MiB;
constexpr size_t WS_ZT = WS_XN + 32 * MiB;
constexpr size_t WS_U = WS_ZT + 48 * MiB;
constexpr size_t WS_GV = WS_U + 16 * MiB;
constexpr size_t WS_GH = WS_GV + 16 * MiB;
constexpr size_t WS_GS = WS_GH + 32 * MiB;
constexpr size_t WS_Y = WS_GS + 32 * MiB;
constexpr size_t WS_FS = WS_Y + 32 * MiB;
constexpr size_t WS_END = WS_FS + 64 * MiB;
constexpr size_t WS_MERGED = WS_ZT, WS_ACT = WS_U, WS_MOEOUT = WS_FS;
constexpr int CW_TMO = 0;
constexpr int CW_CNT = 8192;
constexpr int CW_BAR = 4096;
constexpr int SCRATCH_BYTES = 2 * 8448 * 8;
constexpr int MISC_OFF = SCRATCH_BYTES;
constexpr int CVS_OFF = MISC_OFF + 1024;
constexpr int LDS_BYTES = SCRATCH_BYTES + 1024 + 8 * 2112;
static_assert(pg8::GATHER_SLOT_OFF == MISC_OFF + 1024, "gather slots");
static_assert(SCRATCH_BYTES >= pg8::STAGE_BYTES, "lds");

#define GAS __attribute__((address_space(1)))
#define LAS __attribute__((address_space(3)))
typedef unsigned short bf16;
typedef unsigned v4u __attribute__((ext_vector_type(4)));
typedef unsigned v2u __attribute__((ext_vector_type(2)));
typedef float f32x4 __attribute__((ext_vector_type(4)));
typedef short bf16x8 __attribute__((ext_vector_type(8)));
typedef GAS unsigned gu32;
#define RLX_AGENT __ATOMIC_RELAXED, __HIP_MEMORY_SCOPE_AGENT
#define LDS_WAIT() asm volatile("s_waitcnt lgkmcnt(0)" ::: "memory")
#define VM_WAIT() asm volatile("s_waitcnt vmcnt(0)" ::: "memory")
__device__ __forceinline__ unsigned f2bf(float f) { unsigned u = __builtin_bit_cast(unsigned, f); return (u + 0x7fffu + ((u >> 16) & 1u)) >> 16; }
__device__ __forceinline__ unsigned pk2(float lo, float hi) { return f2bf(lo) | (f2bf(hi) << 16); }
__device__ __forceinline__ unsigned pk2h(float lo, float hi) { unsigned r; asm("v_cvt_pk_bf16_f32 %0, %1, %2" : "=v"(r) : "v"(lo), "v"(hi)); return r; }
__device__ __forceinline__ float bfl(unsigned u) { return __builtin_bit_cast(float, u << 16); }
__device__ __forceinline__ float bfh(unsigned u) { return __builtin_bit_cast(float, u & 0xffff0000u); }

#define XB_TMO      128
#define XB_XCNT(j)  (256  + 64 * (j))
#define XB_XSUB(j)  (1280 + 64 * (j))
#define XB_XGEN(j)  (2304 + 64 * (j))
#define XB_TOP      3328
#define XB_TOPGEN   3392
#define XCD_BAR_WORDS 3456
#define XB_SPIN_CAP (1u << 18)
__device__ __forceinline__ unsigned xb_ld(unsigned* p)              { return __hip_atomic_load(p, __ATOMIC_RELAXED, __HIP_MEMORY_SCOPE_AGENT); }
__device__ __forceinline__ unsigned xb_add(unsigned* p, unsigned v) { return __hip_atomic_fetch_add(p, v, __ATOMIC_RELAXED, __HIP_MEMORY_SCOPE_AGENT); }
__device__ __forceinline__ unsigned xb_xcc_id() { return (unsigned)__builtin_amdgcn_s_getreg((3 << 11) | 20) & 0xFu; }
#define XB_SPIN(cond, bar) do { unsigned _sp = 0; while (cond) { __builtin_amdgcn_s_sleep(1); \
    if ((++_sp & 255u) == 0u) { if (xb_ld(&(bar)[XB_TMO])) break; if (_sp > XB_SPIN_CAP) { atomicAdd(&(bar)[XB_TMO], 1u); break; } } } } while (0)
struct XcdBarrier { unsigned* bar; unsigned x; volatile LAS unsigned* st; };
__device__ __forceinline__ XcdBarrier xcd_barrier_post(unsigned* bar, volatile LAS unsigned* st) {
    XcdBarrier b; b.bar = bar; b.x = xb_xcc_id(); b.st = st;
    if (threadIdx.x == 0) (void)xb_add(&bar[XB_XCNT(b.x)], 1u);
    return b;
}
__device__ __forceinline__ void xcd_barrier_complete(unsigned* bar, unsigned x, unsigned& nloc, unsigned& nx) {
    const unsigned G = gridDim.x * gridDim.y * gridDim.z;
    unsigned sum, cnt, mine, sp = 0u;
    for (;;) {
        sum = 0u; cnt = 0u; mine = 0u;
#pragma unroll
        for (unsigned j = 0; j < 16; ++j) { const unsigned c = xb_ld(&bar[XB_XCNT(j)]); sum += c; cnt += (c > 0u) ? 1u : 0u; mine = (j == x) ? c : mine; }
        if (sum == G) break;
        __builtin_amdgcn_s_sleep(1);
        if ((++sp & 255u) == 0u) { if (xb_ld(&bar[XB_TMO])) break; if (sp > XB_SPIN_CAP) { atomicAdd(&bar[XB_TMO], 1u); break; } }
    }
    nloc = mine > 0u ? mine : 1u; nx = cnt > 0u ? cnt : 1u;
}
__device__ __forceinline__ void xcd_barrier(const XcdBarrier& b) {
    asm volatile("s_waitcnt vmcnt(0)" ::: "memory");
    __syncthreads();
    if (threadIdx.x == 0) {
        unsigned* bar = b.bar;
        __builtin_amdgcn_s_waitcnt(0);
        unsigned nloc = b.st[0], nx = b.st[1];
        if (nloc == 0u) { xcd_barrier_complete(bar, b.x, nloc, nx); b.st[0] = nloc; b.st[1] = nx; }
        const unsigned old = xb_add(&bar[XB_XSUB(b.x)], 1u);
        const unsigned gen = old / nloc;
        if (old + 1u == (gen + 1u) * nloc) {
            __builtin_amdgcn_fence(__ATOMIC_RELEASE, "agent");
            asm volatile("s_waitcnt vmcnt(0)" ::: "memory");
            const unsigned og = xb_add(&bar[XB_TOP], 1u);
            const unsigned tg = og / nx;
            if (og + 1u == (tg + 1u) * nx) xb_add(&bar[XB_TOPGEN], 1u);
            else XB_SPIN(xb_ld(&bar[XB_TOPGEN]) == tg, bar);
            __builtin_amdgcn_fence(__ATOMIC_ACQUIRE, "agent");
            xb_add(&bar[XB_XGEN(b.x)], 1u);
            asm volatile("s_waitcnt vmcnt(0)" ::: "memory");
        } else {
            XB_SPIN(xb_ld(&bar[XB_XGEN(b.x)]) == gen, bar);
            __builtin_amdgcn_fence(__ATOMIC_ACQUIRE, "agent");
            asm volatile("s_waitcnt vmcnt(0)" ::: "memory");
        }
    }
    __syncthreads();
}

struct Frame {
    LAS unsigned char* lds;
    volatile LAS unsigned* MISC;
    gu32* ctl;
    int tid, lane, wave;
    int vcu, G;
    const LAS unsigned long long* inp;
    float* out;
    unsigned char* ws;
};
enum { I_X = 0, I_GMIX, I_WIN, I_BIN, I_CONVW, I_CONVB, I_FW1, I_FB1, I_FW2, I_FB2, I_FW3, I_FFREQ, I_SKIP, I_LNG, I_LNB, I_SGW, I_SGB, I_WHY, I_WSG, I_WOUT, I_GFFN, I_WRG, I_BRG, I_WRE, I_BRE, I_WGATE, I_WUP, I_WDOWN, I_GFINAL };

__device__ __forceinline__ const float* inp(const Frame& F, int k) { const unsigned long long v = F.inp[k]; const unsigned lo = __builtin_amdgcn_readfirstlane((unsigned)v), hi = __builtin_amdgcn_readfirstlane((unsigned)(v >> 32));
    return (const float*)(((unsigned long long)hi << 32) | (unsigned long long)lo); }
__device__ __forceinline__ float shfl_xor_l(float v, int mask, int lane) { return __builtin_bit_cast(float, __builtin_amdgcn_ds_bpermute((lane ^ mask) << 2, __builtin_bit_cast(int, v))); }
__device__ __forceinline__ float shfl_down1_l(float v, int lane) { return __builtin_bit_cast(float, __builtin_amdgcn_ds_bpermute(((lane + 1) & 63) << 2, __builtin_bit_cast(int, v))); }
__device__ __forceinline__ float wave_sum(float v, int lane) {
#pragma unroll
    for (int o = 1; o < 64; o <<= 1) v += shfl_xor_l(v, o, lane);
    return v;
}

#ifndef PROBE_K
#define PROBE_K -1
#endif
#define HP_ME (blockIdx.x == 0 && threadIdx.x == 0)
#define HPS(j) do { if (PROBE_K == (j) && HP_ME) ((volatile LAS unsigned long long*)(F.lds + MISC_OFF + 512))[0] = __builtin_amdgcn_s_memrealtime(); } while (0)
#define HPE(j) do { if (PROBE_K == (j) && HP_ME) { volatile LAS unsigned long long* _p = (volatile LAS unsigned long long*)(F.lds + MISC_OFF + 512); _p[1] += __builtin_amdgcn_s_memrealtime() - _p[0]; } } while (0)
#define HD __device__ __forceinline__
#define HY_OPAQUE(x) asm volatile("" : "+v"(x))
typedef float hy_f2v __attribute__((ext_vector_type(2)));
#define LDC(p, i) ({ const hy_f2v _v = *(const LAS hy_f2v*)((p) + (i)); c32 _r; _r.x = _v.x; _r.y = _v.y; _r; })
#define STC(p, i, v) do { const c32 _s = (v); hy_f2v _w; _w.x = _s.x; _w.y = _s.y; *(LAS hy_f2v*)((p) + (i)) = _w; } while (0)
#define FADD(a, b) ({ float _r; asm("v_add_f32 %0, %1, %2" : "=v"(_r) : "v"((float)(a)), "v"((float)(b))); _r; })
#define FSUB(a, b) ({ float _r; asm("v_sub_f32 %0, %1, %2" : "=v"(_r) : "v"((float)(a)), "v"((float)(b))); _r; })
#define FMUL(a, b) ({ float _r; asm("v_mul_f32 %0, %1, %2" : "=v"(_r) : "v"((float)(a)), "v"((float)(b))); _r; })
#define FFMA(a, b, c) ({ float _r; asm("v_fma_f32 %0, %1, %2, %3" : "=v"(_r) : "v"((float)(a)), "v"((float)(b)), "v"((float)(c))); _r; })
#define FNMA(a, b, c) ({ float _r; asm("v_fma_f32 %0, -%1, %2, %3" : "=v"(_r) : "v"((float)(a)), "v"((float)(b)), "v"((float)(c))); _r; })
struct c32 { float x, y; };
HD c32 cmk(float x, float y) { c32 r; r.x = x; r.y = y; return r; }
HD c32 cadd(c32 a, c32 b) { return cmk(FADD(a.x, b.x), FADD(a.y, b.y)); }
HD c32 csub(c32 a, c32 b) { return cmk(FSUB(a.x, b.x), FSUB(a.y, b.y)); }
HD c32 cmul(c32 a, c32 b) { return cmk(FNMA(a.y, b.y, FMUL(a.x, b.x)), FFMA(a.y, b.x, FMUL(a.x, b.y))); }
HD c32 cmulc(c32 a, c32 b) { return cmk(FFMA(a.y, b.y, FMUL(a.x, b.x)), FNMA(a.x, b.y, FMUL(a.y, b.x))); }
HD c32 cscale(c32 a, float f) { return cmk(FMUL(a.x, f), FMUL(a.y, f)); }
HD c32 cadd_mi(c32 a, c32 b) { return cmk(FADD(a.x, b.y), FSUB(a.y, b.x)); }
HD c32 cadd_pi(c32 a, c32 b) { return cmk(FSUB(a.x, b.y), FADD(a.y, b.x)); }
#define HY_N 8192
#define HY_LDS_C32 (8192 + 256)

template <int SIGN> HD void dft4(c32& a, c32& b, c32& c, c32& d) {
    const c32 t0 = cadd(a, c), t1 = csub(a, c), t2 = cadd(b, d), t3 = csub(b, d);
    a = cadd(t0, t2); c = csub(t0, t2);
    if (SIGN < 0) { b = cadd_mi(t1, t3); d = cadd_pi(t1, t3); }
    else          { b = cadd_pi(t1, t3); d = cadd_mi(t1, t3); }
}
template <int SIGN> HD void dft16(c32 (&a)[16]) {
    const float C1 = 0.92387953251128674f, S1 = 0.38268343236508977f, R2 = 0.70710678118654752f;
#pragma unroll
    for (int n2 = 0; n2 < 4; ++n2) dft4<SIGN>(a[n2], a[4 + n2], a[8 + n2], a[12 + n2]);
    const float sg = (SIGN < 0) ? -1.f : 1.f;
    const c32 w1 = cmk(C1, sg * S1), w2 = cmk(R2, sg * R2), w3 = cmk(S1, sg * C1), w6 = cmk(-R2, sg * R2), w9 = cmk(-C1, -sg * S1);
    a[1 + 4] = cmul(a[1 + 4], w1); a[2 + 4] = cmul(a[2 + 4], w2); a[3 + 4] = cmul(a[3 + 4], w3);
    a[1 + 8] = cmul(a[1 + 8], w2); a[2 + 8] = (SIGN < 0) ? cmk(a[2 + 8].y, -a[2 + 8].x) : cmk(-a[2 + 8].y, a[2 + 8].x); a[3 + 8] = cmul(a[3 + 8], w6);
    a[1 + 12] = cmul(a[1 + 12], w3); a[2 + 12] = cmul(a[2 + 12], w6); a[3 + 12] = cmul(a[3 + 12], w9);
#pragma unroll
    for (int k1 = 0; k1 < 4; ++k1) dft4<SIGN>(a[4 * k1], a[4 * k1 + 1], a[4 * k1 + 2], a[4 * k1 + 3]);
    c32 t[16];
#pragma unroll
    for (int i = 0; i < 16; ++i) t[i] = a[i];
#pragma unroll
    for (int k1 = 0; k1 < 4; ++k1)
#pragma unroll
        for (int k2 = 0; k2 < 4; ++k2) a[k1 + 4 * k2] = t[4 * k1 + k2];
}
HD void twiddle_tree(c32 (&a)[16], c32 w1) {
    const c32 w2 = cmul(w1, w1), w3 = cmul(w2, w1), w4 = cmul(w2, w2), w5 = cmul(w4, w1), w6 = cmul(w4, w2), w7 = cmul(w4, w3), w8 = cmul(w4, w4);
    a[1] = cmul(a[1], w1); a[2] = cmul(a[2], w2); a[3] = cmul(a[3], w3); a[4] = cmul(a[4], w4); a[5] = cmul(a[5], w5); a[6] = cmul(a[6], w6); a[7] = cmul(a[7], w7); a[8] = cmul(a[8], w8);
    a[9] = cmul(a[9], cmul(w8, w1)); a[10] = cmul(a[10], cmul(w8, w2)); a[11] = cmul(a[11], cmul(w8, w3)); a[12] = cmul(a[12], cmul(w8, w4));
    a[13] = cmul(a[13], cmul(w8, w5)); a[14] = cmul(a[14], cmul(w8, w6)); a[15] = cmul(a[15], cmul(w8, w7));
}
HD c32 cis_pi(float x) { return cmk(cospif(x), sinpif(x)); }

HD void fft_s1_fwd(int tid, LAS c32* buf, c32 (&a)[16]) { HY_OPAQUE(tid);
    dft16<-1>(a);
    twiddle_tree(a, cis_pi(-2.0f * (float)tid / 8192.0f));
    LAS c32* p0 = buf + tid + (tid >> 5);
#pragma unroll
    for (int p = 0; p < 16; ++p) STC(p0, 528 * p, a[p]);
}
HD void fft_s2_fwd(int tid, LAS c32* buf) { HY_OPAQUE(tid);
    LAS c32* p0 = buf + (tid >> 5) * 528 + (tid & 31);
    c32 a[16];
#pragma unroll
    for (int q = 0; q < 16; ++q) a[q] = LDC(p0, 33 * q);
    dft16<-1>(a);
    twiddle_tree(a, cis_pi(-2.0f * (float)(tid & 31) / 512.0f));
#pragma unroll
    for (int p = 0; p < 16; ++p) STC(p0, 33 * p, a[p]);
}
HD float w32c(int q) { switch (q) { case 0: return 1.0f; case 1: return 0.98078528040323043f; case 2: return 0.92387953251128674f; case 3: return 0.83146961230254524f; case 4: return 0.70710678118654752f; case 5: return 0.55557023301960218f; case 6: return 0.38268343236508977f; case 7: return 0.19509032201612825f;
    case 8: return 0.0f; case 9: return -0.19509032201612825f; case 10: return -0.38268343236508977f; case 11: return -0.55557023301960218f; case 12: return -0.70710678118654752f; case 13: return -0.83146961230254524f; case 14: return -0.92387953251128674f; default: return -0.98078528040323043f; } }
HD float w32s(int q) { switch (q) { case 0: return 0.0f; case 1: return 0.19509032201612825f; case 2: return 0.38268343236508977f; case 3: return 0.55557023301960218f; case 4: return 0.70710678118654752f; case 5: return 0.83146961230254524f; case 6: return 0.92387953251128674f; case 7: return 0.98078528040323043f;
    case 8: return 1.0f; case 9: return 0.98078528040323043f; case 10: return 0.92387953251128674f; case 11: return 0.83146961230254524f; case 12: return 0.70710678118654752f; case 13: return 0.55557023301960218f; case 14: return 0.38268343236508977f; default: return 0.19509032201612825f; } }
template <int SIGN> HD void fft_s3_read(int tid, const LAS c32* buf, c32 (&s)[16]) { HY_OPAQUE(tid);
    const LAS c32* p0 = buf + (tid >> 1) * 33; const int h = tid & 1;
    const float sg = (SIGN < 0) ? -1.f : 1.f, hs = h ? -1.f : 1.f;
#pragma unroll
    for (int q = 0; q < 16; ++q) {
        const c32 u = LDC(p0, q), v = LDC(p0, q + 16);
        const c32 d = cmk(FFMA(v.x, hs, u.x), FFMA(v.y, hs, u.y));
        const c32 w = h ? cmk(w32c(q), sg * w32s(q)) : cmk(1.f, 0.f);
        s[q] = (q == 0) ? d : cmul(d, w);
    }
    dft16<SIGN>(s);
}
HD void fft_s3_write(int tid, LAS c32* buf, const c32 (&s)[16]) { HY_OPAQUE(tid);
    LAS c32* p0 = buf + (tid >> 1) * 33 + (tid & 1);
#pragma unroll
    for (int p = 0; p < 16; ++p) STC(p0, 2 * p, s[p]);
}
HD void fft_s2_inv(int tid, LAS c32* buf) { HY_OPAQUE(tid);
    LAS c32* p0 = buf + (tid >> 5) * 528 + (tid & 31);
    c32 a[16];
#pragma unroll
    for (int q = 0; q < 16; ++q) a[q] = LDC(p0, 33 * q);
    twiddle_tree(a, cis_pi(2.0f * (float)(tid & 31) / 512.0f));
    dft16<1>(a);
#pragma unroll
    for (int p = 0; p < 16; ++p) STC(p0, 33 * p, a[p]);
}
HD void fft_s1_inv(int tid, const LAS c32* buf, c32 (&a)[16]) { HY_OPAQUE(tid);
    const LAS c32* p0 = buf + tid + (tid >> 5);
#pragma unroll
    for (int p = 0; p < 16; ++p) a[p] = LDC(p0, 528 * p);
    twiddle_tree(a, cis_pi(2.0f * (float)tid / 8192.0f));
    dft16<1>(a);
}
HD void pair_pass(int tid, LAS c32* Z, const LAS c32* H) { HY_OPAQUE(tid);
    const int p3 = tid & 31;
    const c32 wp3 = cis_pi(-(float)p3 / 32.0f);
    const c32 wstep = cis_pi(-16.0f / 8192.0f);
    c32 wlow = cis_pi(-(float)(tid >> 5) / 8192.0f);
#pragma unroll 1
    for (int it = 0; it < 9; ++it) {
        const int low = it * 16 + (tid >> 5);
        const c32 Wk = cmul(wlow, wp3);
        wlow = cmul(wlow, wstep);
        if (low > 128) continue;
        bool act = true; int p3b = 31 - p3, lowb = 256 - low;
        if (low == 0) { act = p3 <= 16; p3b = (32 - p3) & 31; lowb = 0; }
        else if (low == 128) { act = p3 <= 15; lowb = 128; }
        if (!act) continue;
        const int pa = (low & 15) * 528 + (low >> 4) * 33 + p3, pb = (lowb & 15) * 528 + (lowb >> 4) * 33 + p3b;
        const c32 A = LDC(Z, pa), B = LDC(Z, pb), HA = LDC(H, pa), HB = LDC(H, pb);
        c32 E = cmk(FMUL(FADD(A.x, B.x), 0.5f), FMUL(FSUB(A.y, B.y), 0.5f)), O = cmk(FMUL(FADD(A.y, B.y), 0.5f), FMUL(FSUB(B.x, A.x), 0.5f));
        c32 T = cmul(Wk, O);
        const c32 X = cadd(E, T), Xm = csub(E, T);
        E = cmk(FMUL(FADD(HA.x, HB.x), 0.5f), FMUL(FSUB(HA.y, HB.y), 0.5f)); O = cmk(FMUL(FADD(HA.y, HB.y), 0.5f), FMUL(FSUB(HB.x, HA.x), 0.5f));
        T = cmul(Wk, O);
        const c32 Hk = cadd(E, T), Hm = csub(E, T);
        const c32 Y = cmul(X, Hk), Ypc = cmul(Xm, Hm);
        const float sc = 0.5f / 8192.0f;
        const c32 Ye = cscale(cadd(Y, Ypc), sc), Yd = cscale(csub(Y, Ypc), sc);
        const c32 Yo = cmulc(Yd, Wk);
        STC(Z, pa, cmk(FSUB(Ye.x, Yo.y), FADD(Ye.y, Yo.x)));
        if (pb != pa) STC(Z, pb, cmk(FADD(Ye.x, Yo.y), FSUB(Yo.x, Ye.y)));
    }
}
HD float bf_lo(unsigned u) { unsigned v = u << 16; return __builtin_bit_cast(float, v); }
HD float bf_hi(unsigned u) { unsigned v = u & 0xffff0000u; return __builtin_bit_cast(float, v); }
HD void hy_conv3_load(int tid, const unsigned* zrow, float c0, float c1, float c2, float cb, c32 (&out)[8]) { HY_OPAQUE(tid);
    unsigned wm[8], wl[8], wr[8];
#pragma unroll
    for (int q = 0; q < 8; ++q) { const int m = tid + 512 * q; wm[q] = zrow[m]; wl[q] = (m > 0) ? zrow[m - 1] : 0u; wr[q] = (m < 4095) ? zrow[m + 1] : 0u; }
#pragma unroll
    for (int q = 0; q < 8; ++q) {
        const float zm1 = bf_hi(wl[q]), z0 = bf_lo(wm[q]), z1 = bf_hi(wm[q]), z2 = bf_lo(wr[q]);
        out[q] = cmk(FFMA(c0, zm1, FFMA(c1, z0, FFMA(c2, z1, cb))), FFMA(c0, z0, FFMA(c1, z1, FFMA(c2, z2, cb))));
    }
}
HD void hy_filter_s1(int tid, LAS c32* buf, const unsigned* zk) { HY_OPAQUE(tid);
    unsigned w[16];
#pragma unroll
    for (int q = 0; q < 16; ++q) w[q] = zk[tid + 512 * q];
    c32 a[16];
#pragma unroll
    for (int q = 0; q < 16; ++q) a[q] = cmk(bf_lo(w[q]), bf_hi(w[q]));
    fft_s1_fwd(tid, buf, a);
}
HD void hy_data_s1(int tid, LAS c32* buf, const c32 (&v)[8]) { HY_OPAQUE(tid);
    c32 a[16];
#pragma unroll
    for (int q = 0; q < 8; ++q) a[q] = v[q];
#pragma unroll
    for (int q = 8; q < 16; ++q) a[q] = cmk(0.f, 0.f);
    fft_s1_fwd(tid, buf, a);
}
HD unsigned hy_bf(float f) { unsigned u = __builtin_bit_cast(unsigned, f); return (u + 0x7fffu + ((u >> 16) & 1u)) >> 16; }
HD void hy_pack_store(unsigned* zk, int dir, int a4, float t0, float t1, float t2, float t3) {
    if (dir == 0) { zk[a4 / 2] = hy_bf(t0) | (hy_bf(t1) << 16); zk[a4 / 2 + 1] = hy_bf(t2) | (hy_bf(t3) << 16); }
    else {
        const int m = 8192 - a4 / 2;
        if (a4 > 0) ((unsigned short*)(zk + m))[0] = (unsigned short)hy_bf(t0);
        zk[m - 1] = hy_bf(t2) | (hy_bf(t1) << 16);
        if (a4 == 8188) zk[m - 2] = hy_bf(t3) << 16; else ((unsigned short*)(zk + m - 2))[1] = (unsigned short)hy_bf(t3);
    }
}
struct CvItem { const float* src; int N; bf16* dst; size_t dld; };
constexpr int CV_S0 = 32 * 288, CV_S7 = 128, CV_SA = CV_S0 + CV_S7, CV_S1 = 16 * 64, CV_S3 = 32 * 64, CV_S4 = 16 * 32 * 16, CV_S6 = 16 * 8 * 64;
constexpr int CV_NITEMS = CV_SA + 2 * CV_S1 + CV_S3 + 2 * CV_S4 + CV_S6;
__device__ __forceinline__ void cv_decode_layer(Frame& F, int l, int r, CvItem& d) {
    bf16* WIN = (bf16*)(F.ws + ((l & 1) ? WS_WIN2 : WS_WIN)); bf16* PT = (bf16*)(F.ws + WS_PT); bf16* WOT = (bf16*)(F.ws + WS_WOT); bf16* WGU = (bf16*)(F.ws + WS_WGU); bf16* WD = (bf16*)(F.ws + WS_WD);
    bf16* W3T = (bf16*)(F.ws + WS_W3T + (size_t)(l & 1) * 512 * 1024);
    if (r < CV_S0) { const int kb = r / 288, nb = r % 288; d.src = inp(F, I_WIN) + (size_t)l * DM * NIN + (size_t)(64 * kb) * NIN + 32 * nb; d.N = NIN; d.dst = WIN + (size_t)(32 * nb) * DM + 64 * kb; d.dld = DM; return; } r -= CV_S0;
    if (r < CV_S7) { const int nb = r; d.src = inp(F, I_FW3) + (size_t)l * 64 * 4096 + 32 * nb; d.N = 4096; d.dst = W3T + (size_t)(32 * nb) * 64; d.dld = 64; return; } r -= CV_S7;
    if (r < CV_S1) { const int kb = r / 64, nb = r % 64; d.src = inp(F, I_WHY) + (size_t)l * HYW * DM + (size_t)(64 * kb) * DM + 32 * nb; d.N = DM; d.dst = PT + (size_t)(32 * nb) * DM + 64 * kb; d.dld = DM; return; } r -= CV_S1;
    if (r < CV_S1) { const int kb = r / 64, nb = r % 64; d.src = inp(F, I_WSG) + (size_t)l * SGW * DM + (size_t)(64 * kb) * DM + 32 * nb; d.N = DM; d.dst = PT + (size_t)(32 * nb) * DM + 1024 + 64 * kb; d.dld = DM; return; } r -= CV_S1;
    if (r < CV_S3) { const int kb = r / 64, nb = r % 64; d.src = inp(F, I_WOUT) + (size_t)l * DM * DM + (size_t)(64 * kb) * DM + 32 * nb; d.N = DM; d.dst = WOT + (size_t)(32 * nb) * DM + 64 * kb; d.dld = DM; return; } r -= CV_S3;
    if (r < 2 * CV_S4) { const int up = r / CV_S4; r -= up * CV_S4; const int e = r / 512, q = r % 512, kb = q / 16, nb = q % 16; const int n0 = 32 * nb, drow = 256 * (n0 / 128) + (n0 % 128) + 128 * up;
        d.src = (up ? inp(F, I_WUP) : inp(F, I_WGATE)) + ((size_t)l * NEXP + e) * DM * DEXP + (size_t)(64 * kb) * DEXP + n0; d.N = DEXP; d.dst = WGU + ((size_t)e * 1024 + drow) * DM + 64 * kb; d.dld = DM; return; } r -= 2 * CV_S4;
    { const int e = r / 512, q = r % 512, kb = q / 64, nb = q % 64;
        d.src = inp(F, I_WDOWN) + ((size_t)l * NEXP + e) * DEXP * DM + (size_t)(64 * kb) * DM + 32 * nb; d.N = DM; d.dst = WD + ((size_t)e * DM + 32 * nb) * DEXP + 64 * kb; d.dld = DEXP; }
}
__device__ __forceinline__ bool cv_decode(Frame& F, int set, int l, int it, CvItem& d) {
    if (set == 0) { if (it >= CV_SA) return false; cv_decode_layer(F, l, it, d); return true; }
    const int n1 = CV_NITEMS - CV_SA, n2 = (l + 1 < DEPTH) ? CV_SA : 0;
    if (it >= n1 + n2) return false;
    if (it < n1) cv_decode_layer(F, l, CV_SA + it, d); else cv_decode_layer(F, l + 1, it - n1, d);
    return true;
}
__device__ __forceinline__ void cv_load(const CvItem& d, int lane, float (&v)[32]) {
    const float* s = d.src + (size_t)(lane >> 5) * d.N + (lane & 31);
#pragma unroll
    for (int i = 0; i < 32; ++i) v[i] = s[(size_t)(2 * i) * d.N];
}
__device__ __forceinline__ void cv_store(const CvItem& d, int lane, const float (&v)[32], LAS float* scr) {
    const int n = lane >> 1, h = lane & 1;
#pragma unroll
    for (int s = 0; s < 4; ++s) {
#pragma unroll
        for (int i = 0; i < 8; ++i) scr[(2 * i + (lane >> 5)) * 33 + (lane & 31)] = v[8 * s + i];
        LDS_WAIT(); asm volatile("" ::: "memory");
        const LAS float* q = scr + (8 * h) * 33 + n;
        v4u o; o.x = pk2h(q[0 * 33], q[1 * 33]); o.y = pk2h(q[2 * 33], q[3 * 33]); o.z = pk2h(q[4 * 33], q[5 * 33]); o.w = pk2h(q[6 * 33], q[7 * 33]);
        *(GAS v4u*)(d.dst + (size_t)n * d.dld + 16 * s + 8 * h) = o;
        LDS_WAIT(); asm volatile("" ::: "memory");
    }
}
struct CvPipe { CvItem d; int it, set, l; bool have; };
#define CV_SCR(F) ((LAS float*)((F).lds + CVS_OFF + (F).wave * 2112))
#define CV_START(F, P, V, SET, L) do { (P).set = (SET); (P).l = (L); int _it = (F).vcu * NWAVES + (F).wave; asm volatile("" : "+s"(_it)); (P).it = _it; (P).have = cv_decode(F, SET, L, _it, (P).d); if ((P).have) cv_load((P).d, (F).lane, V); } while (0)
#define CV_STEP(F, P, V) do { if ((P).have) { cv_store((P).d, (F).lane, V, CV_SCR(F)); (P).it += (F).G * NWAVES; (P).have = cv_decode(F, (P).set, (P).l, (P).it, (P).d); if ((P).have) cv_load((P).d, (F).lane, V); } } while (0)
__device__ __forceinline__ void pa_convert(Frame& F, int l) {
    CvPipe P; float va[32];
    CV_START(F, P, va, 0, l);
    while (P.have) CV_STEP(F, P, va);
}
__device__ __forceinline__ void pa_features(Frame& F, int l) {
    LAS float* zf = (LAS float*)(F.lds);
    LAS float* a1 = zf + 8 * 40;
    const float* w1 = inp(F, I_FW1) + l * 33 * 64; const float* b1 = inp(F, I_FB1) + l * 64; const float* w2 = inp(F, I_FW2) + l * 64 * 64; const float* b2 = inp(F, I_FB2) + l * 64; const float* fq = inp(F, I_FFREQ) + l * 64;
    bf16* A2 = (bf16*)(F.ws + WS_A2 + (size_t)l * MiB);
    const int tl = F.tid >> 6, j = F.tid & 63;
    const float fr = fq[j];
    float w1c[33], w2c[64];
#pragma unroll
    for (int i = 0; i < 33; ++i) w1c[i] = w1[i * 64 + j];
#pragma unroll
    for (int i = 0; i < 64; ++i) w2c[i] = w2[i * 64 + j];
    for (int t0 = F.vcu * 8; t0 < SEQ; t0 += F.G * 8) {
        __syncthreads();
        if (F.tid < 8 * 33) { const int tt = F.tid / 33, i = F.tid % 33; const int t = t0 + tt; float v;
            const float w = 6.283185307179586f / (float)SEQ * (float)t;
            if (i == 0) v = (float)t / (float)(SEQ - 1);
            else { const int b = (i - 1) & 15; const float band = 1e-4f + (float)b * ((15.0f - 1e-4f) / 15.0f); const float a = band * w; v = (i <= 16) ? cosf(a) : -sinf(a); }
            zf[tt * 40 + i] = v; }
        __syncthreads();
        float s = b1[j];
#pragma unroll
        for (int i = 0; i < 33; ++i) s += zf[tl * 40 + i] * w1c[i];
        a1[tl * 64 + j] = sinf(fr * s);
        __syncthreads();
        float s2 = b2[j];
#pragma unroll
        for (int i = 0; i < 64; ++i) s2 += a1[tl * 64 + i] * w2c[i];
        A2[(size_t)(t0 + tl) * 64 + j] = (bf16)f2bf(sinf(fr * s2));
    }
    __syncthreads();
}
__device__ __forceinline__ void pa_router_t(Frame& F, int l) {
    float* WR = (float*)(F.ws + WS_WR + (size_t)l * 256 * 1024);
    const float* wrg = inp(F, I_WRG) + (size_t)l * DM * 4; const float* wre = inp(F, I_WRE) + (size_t)l * 4 * DM * 4;
    for (int i = F.vcu * NTHR + F.tid; i < 20 * DM; i += F.G * NTHR) { const int o = i / DM, k = i % DM;
        WR[i] = (o < 4) ? wrg[k * 4 + o] : wre[((size_t)((o - 4) >> 2) * DM + k) * 4 + ((o - 4) & 3)]; }
}
__device__ __forceinline__ int moe_off(const gu32* cnt, int e) { int s = 0;
#pragma unroll
    for (int j = 0; j < 16; ++j) { const int c = (int)cnt[64 * j]; s += (j < e) ? c : 0; } return s; }
template <int MODE, bool OUTF, int NR>
__device__ __forceinline__ void norm_rows(Frame& F, int m0, int mstride, const float* xin, const float* g, const gu32* cntprev, float* outf) {
    bf16* XR = (bf16*)(F.ws + WS_XR); bf16* XN = (bf16*)(F.ws + WS_XN);
    f32x4 v[NR][8];
    if (MODE == 0) {
#pragma unroll
        for (int r = 0; r < NR; ++r) { const int m = m0 + r * mstride; const GAS f32x4* xr = (const GAS f32x4*)(xin + (size_t)m * DM) + F.lane;
#pragma unroll
            for (int j = 0; j < 8; ++j) v[r][j] = xr[64 * j]; }
    } else {
        const int* TOKPOS = (const int*)(F.ws + WS_LISTS + 1 * MiB); const bf16* MO = (const bf16*)(F.ws + WS_MOEOUT);
        int slot[NR][2];
#pragma unroll
        for (int r = 0; r < NR; ++r)
#pragma unroll
            for (int k = 0; k < 2; ++k) { const int tp = TOKPOS[(m0 + r * mstride) * 2 + k]; slot[r][k] = moe_off(cntprev, tp >> 13) + (tp & 8191); }
        v2u w[NR][3][8];
#pragma unroll
        for (int r = 0; r < NR; ++r) { const GAS v2u* xr = (const GAS v2u*)(XR + (size_t)(m0 + r * mstride) * DM) + F.lane;
#pragma unroll
            for (int j = 0; j < 8; ++j) w[r][2][j] = xr[64 * j];
#pragma unroll
            for (int k = 0; k < 2; ++k) { const GAS v2u* mr = (const GAS v2u*)(MO + (size_t)slot[r][k] * DM) + F.lane;
#pragma unroll
                for (int j = 0; j < 8; ++j) w[r][k][j] = mr[64 * j]; } }
#pragma unroll
        for (int r = 0; r < NR; ++r) {
#pragma unroll
            for (int j = 0; j < 8; ++j) { const v2u a = w[r][2][j], b = w[r][0][j], c = w[r][1][j];
                v[r][j] = (f32x4){bfl(a.x) + bfl(b.x) + bfl(c.x), bfh(a.x) + bfh(b.x) + bfh(c.x), bfl(a.y) + bfl(b.y) + bfl(c.y), bfh(a.y) + bfh(b.y) + bfh(c.y)}; }
            if (!OUTF) { GAS v2u* xw = (GAS v2u*)(XR + (size_t)(m0 + r * mstride) * DM) + F.lane;
#pragma unroll
                for (int j = 0; j < 8; ++j) { v2u o; o.x = pk2h(v[r][j].x, v[r][j].y); o.y = pk2h(v[r][j].z, v[r][j].w); xw[64 * j] = o; } } }
    }
    const GAS f32x4* gp = (const GAS f32x4*)g + F.lane;
#pragma unroll
    for (int r = 0; r < NR; ++r) { const int m = m0 + r * mstride;
        float ss = 0.f;
#pragma unroll
        for (int j = 0; j < 8; ++j) ss += (v[r][j].x * v[r][j].x + v[r][j].y * v[r][j].y) + (v[r][j].z * v[r][j].z + v[r][j].w * v[r][j].w);
        const float rstd = 1.0f / sqrtf(wave_sum(ss, F.lane) * (1.0f / DM) + EPS);
        if (OUTF) { GAS f32x4* o = (GAS f32x4*)(outf + (size_t)m * DM) + F.lane;
#pragma unroll
            for (int j = 0; j < 8; ++j) { const f32x4 gg = gp[64 * j]; o[64 * j] = v[r][j] * rstd * gg; } }
        else { GAS v2u* o = (GAS v2u*)(XN + (size_t)m * DM) + F.lane;
#pragma unroll
            for (int j = 0; j < 8; ++j) { const f32x4 gg = gp[64 * j]; const f32x4 rr = v[r][j] * rstd * gg; v2u ww; ww.x = pk2h(rr.x, rr.y); ww.y = pk2h(rr.z, rr.w); o[64 * j] = ww; } } }
}

__device__ __forceinline__ void sgu_pair(Frame& F, int l, int ch, int gp) {
    constexpr int RS = 136;
    LAS bf16* Wb = (LAS bf16*)(F.lds);
    LAS bf16* Vt = (LAS bf16*)(F.lds + 128 * RS * 2);
    LAS float* st = (LAS float*)(F.lds + 2 * 128 * RS * 2);
    const bf16* GV = (const bf16*)(F.ws + WS_GV); const bf16* U = (const bf16*)(F.ws + WS_U); bf16* Y = (bf16*)(F.ws + WS_Y);
    const float* lng = inp(F, I_LNG) + l * SGW; const float* lnb = inp(F, I_LNB) + l * SGW;
    const int t0 = ch * 128;
    __syncthreads();
    {
        const int row = F.tid >> 2, part = F.tid & 3; const GAS v4u* rp = (const GAS v4u*)(GV + (size_t)(t0 + row) * SGW);
        float s = 0.f, q = 0.f;
#pragma unroll 16
        for (int i = 0; i < 32; ++i) { const v4u w = rp[part + 4 * i]; const unsigned ww[4] = {w.x, w.y, w.z, w.w};
#pragma unroll
            for (int j = 0; j < 4; ++j) { const float a = bfl(ww[j]), b = bfh(ww[j]); s += a + b; q += a * a + b * b; } }
        s += shfl_xor_l(s, 1, F.lane); s += shfl_xor_l(s, 2, F.lane); q += shfl_xor_l(q, 1, F.lane); q += shfl_xor_l(q, 2, F.lane);
        const float mu = s * (1.0f / SGW); const float var = fmaxf(q * (1.0f / SGW) - mu * mu, 0.f);
        if (part == 0) { st[row] = mu; st[128 + row] = 1.0f / sqrtf(var + EPS); }
    }
#pragma unroll 1
    for (int gi = 0; gi < 2; ++gi) {
        const int g = 2 * gp + gi;
        const float* Wg = inp(F, I_SGW) + ((size_t)l * 8 + g) * 128 * 128; const float* bg = inp(F, I_SGB) + (l * 8 + g) * 128;
        {
#pragma unroll
            for (int i = 0; i < 8; ++i) { const int idx = F.tid + NTHR * i; const int t = idx >> 5, s4 = (idx & 31) * 4; const f32x4 w = *(const GAS f32x4*)(Wg + t * 128 + s4);
                v2u o; o.x = pk2h(w.x, w.y); o.y = pk2h(w.z, w.w); *(LAS v2u*)(Wb + t * RS + s4) = o; }
        }
        if (gi == 0) __syncthreads();
        {
#pragma unroll
            for (int i = 0; i < 2; ++i) { const int idx = F.tid + NTHR * i, sp = idx & 63, kc = idx >> 6;
                const v4u wa = *(const GAS v4u*)(GV + (size_t)(t0 + 2 * sp) * SGW + g * 128 + 8 * kc), wb = *(const GAS v4u*)(GV + (size_t)(t0 + 2 * sp + 1) * SGW + g * 128 + 8 * kc);
                const unsigned aw[4] = {wa.x, wa.y, wa.z, wa.w}, bw[4] = {wb.x, wb.y, wb.z, wb.w};
                const float mua = st[2 * sp], rsa = st[128 + 2 * sp], mub = st[2 * sp + 1], rsb = st[128 + 2 * sp + 1];
#pragma unroll
                for (int j = 0; j < 4; ++j) { const int k = 8 * kc + 2 * j; const float g0 = lng[g * 128 + k], g1 = lng[g * 128 + k + 1], b0 = lnb[g * 128 + k], b1 = lnb[g * 128 + k + 1];
                    *(LAS unsigned*)(Vt + k * RS + 2 * sp) = pk2h((bfl(aw[j]) - mua) * rsa * g0 + b0, (bfl(bw[j]) - mub) * rsb * g0 + b0);
                    *(LAS unsigned*)(Vt + (k + 1) * RS + 2 * sp) = pk2h((bfh(aw[j]) - mua) * rsa * g1 + b1, (bfh(bw[j]) - mub) * rsb * g1 + b1); } }
        }
        __syncthreads();
        {
            const int fr = F.lane & 15, fq = F.lane >> 4, tw = F.wave * 16;
            bf16x8 af[4];
#pragma unroll
            for (int ks = 0; ks < 4; ++ks) af[ks] = *(const LAS bf16x8*)(Wb + (tw + fr) * RS + ks * 32 + fq * 8);
            const int t = t0 + tw + fr; const float bias = bg[tw + fr];
            v2u uw[8];
#pragma unroll
            for (int kt = 0; kt < 8; ++kt) uw[kt] = *(const GAS v2u*)(U + (size_t)t * SGW + g * 128 + kt * 16 + 4 * fq);
#pragma unroll
            for (int kt = 0; kt < 8; ++kt) { f32x4 acc = (f32x4){0.f, 0.f, 0.f, 0.f};
#pragma unroll
                for (int ks = 0; ks < 4; ++ks) { const bf16x8 bfv = *(const LAS bf16x8*)(Vt + (kt * 16 + fr) * RS + ks * 32 + fq * 8);
                    acc = __builtin_amdgcn_mfma_f32_16x16x32_bf16(bfv, af[ks], acc, 0, 0, 0); }
                const int kcol = g * 128 + kt * 16 + 4 * fq;
                v2u o; o.x = pk2h(bfl(uw[kt].x) * (acc[0] + bias), bfh(uw[kt].x) * (acc[1] + bias)); o.y = pk2h(bfl(uw[kt].y) * (acc[2] + bias), bfh(uw[kt].y) * (acc[3] + bias));
                *(GAS v2u*)(Y + (size_t)t * DM + 1024 + kcol) = o; }
        }
        __syncthreads();
    }
}

__device__ __forceinline__ void hy_filter_gen(Frame& F, int l, int c0, unsigned* FSP) {
    const bf16* A2 = (const bf16*)(F.ws + WS_A2 + (size_t)l * MiB); const bf16* W3T = (const bf16*)(F.ws + WS_W3T + (size_t)(l & 1) * 512 * 1024);
    int lane = F.lane; asm volatile("" : "+v"(lane));
    const int fr = lane & 15, fq = lane >> 4;
    const int chl = fr >> 2, o = (fr >> 1) & 1, dir = fr & 1, col = dir * 2048 + o * 1024 + c0 + chl;
    const bf16x8 b0 = *(const GAS bf16x8*)(W3T + (size_t)col * 64 + fq * 8), b1 = *(const GAS bf16x8*)(W3T + (size_t)col * 64 + 32 + fq * 8);
    const float delta = 3.0701134573253944f + (float)(c0 + chl) * (12.280453829301579f / 1023.0f);
    const float kdec = -delta * 1.4426950408889634f / (float)(SEQ - 1);
    constexpr int RS = 2056;
    LAS bf16* Ft = (LAS bf16*)(F.lds);
    LAS unsigned short* carry = (LAS unsigned short*)(F.lds + 16 * RS * 2);
    const int rot = (c0 * 10) & 127;
#pragma unroll 1
    for (int c = 0; c < 4; ++c) {
#pragma unroll 1
        for (int ib = 0; ib < 2; ++ib) {
            bf16x8 a0[8], a1[8]; int fr2 = fr, fq2 = fq; asm volatile("" : "+v"(fr2), "+v"(fq2));
#pragma unroll
            for (int j = 0; j < 8; ++j) { const int t0 = (128 * c + ((F.wave + 8 * (ib * 8 + j) + rot) & 127)) * 16;
                a0[j] = *(const GAS bf16x8*)(A2 + (size_t)(t0 + fr2) * 64 + fq2 * 8); a1[j] = *(const GAS bf16x8*)(A2 + (size_t)(t0 + fr2) * 64 + 32 + fq2 * 8); }
#pragma unroll
            for (int j = 0; j < 8; ++j) { const int tl = ((F.wave + 8 * (ib * 8 + j) + rot) & 127) * 16, tb = 2048 * c + tl + 4 * fq2;
                f32x4 acc = (f32x4){0.f, 0.f, 0.f, 0.f};
                acc = __builtin_amdgcn_mfma_f32_16x16x32_bf16(a0[j], b0, acc, 0, 0, 0);
                acc = __builtin_amdgcn_mfma_f32_16x16x32_bf16(a1[j], b1, acc, 0, 0, 0);
#pragma unroll
                for (int r = 0; r < 4; ++r) acc[r] *= __builtin_amdgcn_exp2f(kdec * (float)(tb + r));
                v2u w; w.x = pk2h(acc[0], acc[1]); w.y = pk2h(acc[2], acc[3]);
                *(LAS v2u*)(Ft + fr2 * RS + tl + 4 * fq2) = w; }
        }
        __syncthreads();
        int tid2 = F.tid; asm volatile("" : "+v"(tid2));
        {
#pragma unroll
            for (int i = 0; i < 4; ++i) { const int idx = tid2 + NTHR * i, r8 = idx >> 8, pc = idx & 255; const int f = (r8 >> 1) * 4 + (r8 & 1) * 2;
                v4u w = *(const LAS v4u*)(Ft + f * RS + 8 * pc);
                if (c == 0 && pc == 0) { const float s0 = bfl(w.x) + bfl((unsigned)Ft[(f + 1) * RS]); w.x = (w.x & 0xffff0000u) | f2bf(s0); }
                *(GAS v4u*)(FSP + (size_t)r8 * 8192 + 1024 * c + 4 * pc) = w; }
        }
        {
#pragma unroll 4
            for (int i = 0; i < 16; ++i) { const int idx = tid2 + NTHR * i, r8 = idx >> 10, il = idx & 1023; const int f = (r8 >> 1) * 4 + (r8 & 1) * 2 + 1;
                const unsigned lo = Ft[f * RS + 2 * il]; const unsigned hi = (il > 0) ? (unsigned)Ft[f * RS + 2 * il - 1] : (unsigned)carry[(c & 1) * 8 + r8];
                const int ig = 1024 * c + il;
                if (ig > 0) FSP[(size_t)r8 * 8192 + 8192 - ig] = lo | (hi << 16); }
            if (F.tid < 8) { const int f = (F.tid >> 1) * 4 + (F.tid & 1) * 2 + 1; const unsigned short last = Ft[f * RS + 2047];
                carry[((c + 1) & 1) * 8 + F.tid] = last;
                if (c == 3) FSP[(size_t)F.tid * 8192 + 4096] = (unsigned)last << 16; }
        }
        __syncthreads();
    }
}
__device__ __forceinline__ unsigned pk_c32(c32 v) { return pk2h(v.x, v.y); }
__device__ __forceinline__ c32 unpk_c32(unsigned u) { return cmk(bfl(u), bfh(u)); }
__device__ __forceinline__ void hyena_block(Frame& F, int l, int blk) {
    LAS c32* A = (LAS c32*)(F.lds); LAS c32* B = A + HY_LDS_C32;
    unsigned* FSP = (unsigned*)(F.ws + WS_FS) + (size_t)blk * 8 * 8192;
    const unsigned* ZT = (const unsigned*)(F.ws + WS_ZT); bf16* Y = (bf16*)(F.ws + WS_Y);
    const float* cw = inp(F, I_CONVW) + (size_t)l * 3 * NHY; const float* cb = inp(F, I_CONVB) + (size_t)l * NHY; const float* skp = inp(F, I_SKIP) + (size_t)l * 2 * HYW;
    const int c0 = blk * 4, tid = F.tid;
    __syncthreads();
    HPS(20); hy_filter_gen(F, l, c0, FSP);
    VM_WAIT(); __syncthreads(); HPE(20); HPS(21);
    CvPipe cvp; float cvv[32];
    CV_START(F, cvp, cvv, 1, l);
    unsigned yb0[8], yb1[8], yb2[8], yb3[8];
#pragma unroll
    for (int q = 0; q < 8; ++q) { yb0[q] = 0u; yb1[q] = 0u; yb2[q] = 0u; yb3[q] = 0u; }
#pragma unroll 1
    for (int chl = 0; chl < 4; ++chl) {
        const int c = c0 + chl; const unsigned* zk = FSP + (size_t)chl * 2 * 8192;
        c32 keep[8]; unsigned x1p[8], x2p[8];
        c32 s[16];
        {
            unsigned fw[16]; c32 fz[16];
            { int t2 = tid; HY_OPAQUE(t2);
#pragma unroll
              for (int q = 0; q < 16; ++q) fw[q] = zk[t2 + 512 * q]; }
            c32 xa[8], xb[8];
            hy_conv3_load(tid, ZT + (size_t)(2048 + c) * (SEQ / 2), cw[2048 + c], cw[NHY + 2048 + c], cw[2 * NHY + 2048 + c], cb[2048 + c], keep);
            hy_conv3_load(tid, ZT + (size_t)c * (SEQ / 2), cw[c], cw[NHY + c], cw[2 * NHY + c], cb[c], xa);
            hy_conv3_load(tid, ZT + (size_t)(1024 + c) * (SEQ / 2), cw[1024 + c], cw[NHY + 1024 + c], cw[2 * NHY + 1024 + c], cb[1024 + c], xb);
#pragma unroll
            for (int q = 0; q < 8; ++q) { x1p[q] = pk_c32(xa[q]); x2p[q] = pk_c32(xb[q]); }
#pragma unroll
            for (int q = 0; q < 16; ++q) fz[q] = cmk(bfl(fw[q]), bfh(fw[q]));
            fft_s1_fwd(tid, B, fz);
            hy_data_s1(tid, A, keep);
        }
        const float sk0 = skp[c], sk1 = skp[HYW + c];
#pragma unroll
        for (int ord = 0; ord < 2; ++ord) {
            __syncthreads();
            HPS(22); fft_s2_fwd(tid, A); fft_s2_fwd(tid, B);
            __syncthreads(); HPE(22); HPS(23);
            CV_STEP(F, cvp, cvv);
            fft_s3_read<-1>(tid, A, s); fft_s3_write(tid, A, s);
            fft_s3_read<-1>(tid, B, s); fft_s3_write(tid, B, s);
            unsigned fw[16];
            if (ord == 0) { int t2 = tid; HY_OPAQUE(t2);
#pragma unroll
                for (int q = 0; q < 16; ++q) fw[q] = zk[8192 + t2 + 512 * q]; }
            __syncthreads(); HPE(23); HPS(24);
            CV_STEP(F, cvp, cvv);
            pair_pass(tid, A, B);
            __syncthreads(); HPE(24); HPS(25);
            if (ord == 0) { c32 fz[16];
#pragma unroll
                for (int q = 0; q < 16; ++q) fz[q] = cmk(bfl(fw[q]), bfh(fw[q]));
                fft_s1_fwd(tid, B, fz); }
            fft_s3_read<1>(tid, A, s); fft_s3_write(tid, A, s);
            __syncthreads();
            CV_STEP(F, cvp, cvv);
            fft_s2_inv(tid, A);
            __syncthreads();
            fft_s1_inv(tid, A, s); HPE(25); HPS(26);
            if (ord == 0) {
#pragma unroll
                for (int q = 0; q < 8; ++q) { const c32 xv = unpk_c32(x1p[q]); keep[q] = cmk(FMUL(xv.x, FFMA(keep[q].x, sk0, s[q].x)), FMUL(xv.y, FFMA(keep[q].y, sk0, s[q].y))); }
                hy_data_s1(tid, A, keep);
            } else {
#pragma unroll
                for (int q = 0; q < 8; ++q) { const c32 xv = unpk_c32(x2p[q]); const unsigned yv = pk_c32(cmk(FMUL(xv.x, FFMA(keep[q].x, sk1, s[q].x)), FMUL(xv.y, FFMA(keep[q].y, sk1, s[q].y))));
                    yb0[q] = (chl == 0) ? yv : yb0[q]; yb1[q] = (chl == 1) ? yv : yb1[q]; yb2[q] = (chl == 2) ? yv : yb2[q]; yb3[q] = (chl == 3) ? yv : yb3[q]; }
            }
            HPE(26);
        }
        __syncthreads();
    }
    {
        int t2 = tid; HY_OPAQUE(t2);
#pragma unroll
        for (int q = 0; q < 8; ++q) { const int m = t2 + 512 * q;
            v2u lo, hi; lo.x = (yb0[q] & 0xffffu) | (yb1[q] << 16); lo.y = (yb2[q] & 0xffffu) | (yb3[q] << 16);
            hi.x = (yb0[q] >> 16) | (yb1[q] & 0xffff0000u); hi.y = (yb2[q] >> 16) | (yb3[q] & 0xffff0000u);
            *(GAS v2u*)(Y + (size_t)(2 * m) * DM + c0) = lo; *(GAS v2u*)(Y + (size_t)(2 * m + 1) * DM + c0) = hi; }
    }
    while (cvp.have) CV_STEP(F, cvp, cvv);
    HPE(21);
}

__device__ __forceinline__ void rt_split8(const f32x4 a, const f32x4 b, bf16x8& hi, bf16x8& lo) {
    const float v[8] = {a.x, a.y, a.z, a.w, b.x, b.y, b.z, b.w}; v4u hw, lw;
#pragma unroll
    for (int j = 0; j < 4; ++j) { const unsigned h = pk2h(v[2 * j], v[2 * j + 1]); const unsigned lo2 = pk2h(v[2 * j] - bfl(h), v[2 * j + 1] - bfh(h)); hw[j] = h; lw[j] = lo2; }
    hi = __builtin_bit_cast(bf16x8, hw); lo = __builtin_bit_cast(bf16x8, lw);
}
__device__ __forceinline__ void route_block(Frame& F, int l, int tb  ) {
    LAS int* lcnt = (LAS int*)(F.lds);
    LAS int* lbase = (LAS int*)(F.lds + 64);
    LAS int* le = (LAS int*)(F.lds + 128);
    LAS int* lp = (LAS int*)(F.lds + 128 + 256);
    LAS float* lw = (LAS float*)(F.lds + 128 + 512);
    LAS float* lr = (LAS float*)(F.lds + 128 + 768);
    LAS float* SS = (LAS float*)(F.lds + 1024);
    LAS float* PL = (LAS float*)(F.lds + 2048);
    const bf16* XR = (const bf16*)(F.ws + WS_XR); bf16* H = (bf16*)(F.ws + WS_XN); const float* WR = (const float*)(F.ws + WS_WR + (size_t)l * 256 * 1024);
    const float* g = inp(F, I_GFFN) + (size_t)l * DM; const float* brg = inp(F, I_BRG) + l * 4; const float* bre = inp(F, I_BRE) + l * 16;
    int* TOKLIST = (int*)(F.ws + WS_LISTS); float* WLIST = (float*)(F.ws + WS_LISTS + 512 * 1024); int* TOKPOS = (int*)(F.ws + WS_LISTS + 1 * MiB); float* RSLIST = (float*)(F.ws + WS_LISTS + 1 * MiB + 512 * 1024);
    gu32* gcnt = F.ctl + CW_CNT + 64 * 16 * l;
    __syncthreads();
    if (F.tid < 16) lcnt[F.tid] = 0;
    const int ts = F.tid >> 4, part = F.tid & 15;
    {
        const int fr = F.lane & 15, fq = F.lane >> 4, kw = 256 * F.wave + 8 * fq;
        f32x4 acc[2][2];
#pragma unroll
        for (int a = 0; a < 2; ++a)
#pragma unroll
            for (int b = 0; b < 2; ++b) acc[a][b] = (f32x4){0.f, 0.f, 0.f, 0.f};
        float ssl[2] = {0.f, 0.f};
        const bf16* x0 = XR + (size_t)(tb + fr) * DM + kw; const bf16* x1 = x0 + (size_t)16 * DM;
        const float* w0 = WR + (size_t)fr * DM + kw; const float* w1 = WR + (size_t)(16 + (fr & 3)) * DM + kw;
        v4u xb[2]; f32x4 wa[2][2], ga[2];
#define RT_LD(ks) do { const int _k = 32 * (ks); xb[0] = *(const GAS v4u*)(x0 + _k); xb[1] = *(const GAS v4u*)(x1 + _k); \
            wa[0][0] = *(const GAS f32x4*)(w0 + _k); wa[0][1] = *(const GAS f32x4*)(w0 + _k + 4); wa[1][0] = *(const GAS f32x4*)(w1 + _k); wa[1][1] = *(const GAS f32x4*)(w1 + _k + 4); \
            ga[0] = *(const GAS f32x4*)(g + kw + _k); ga[1] = *(const GAS f32x4*)(g + kw + _k + 4); } while (0)
        RT_LD(0);
#pragma unroll 1
        for (int ks = 0; ks < 8; ++ks) {
            bf16x8 ah[2], al[2], bh[2], bl[2];
#pragma unroll
            for (int mt = 0; mt < 2; ++mt) { const v4u xw = xb[mt]; const f32x4 p = (f32x4){bfl(xw.x), bfh(xw.x), bfl(xw.y), bfh(xw.y)}, q = (f32x4){bfl(xw.z), bfh(xw.z), bfl(xw.w), bfh(xw.w)};
                ssl[mt] += ((p.x * p.x + p.y * p.y) + (p.z * p.z + p.w * p.w)) + ((q.x * q.x + q.y * q.y) + (q.z * q.z + q.w * q.w));
                rt_split8(p * ga[0], q * ga[1], ah[mt], al[mt]);
                *(GAS bf16x8*)(H + (size_t)(tb + 16 * mt + fr) * DM + kw + 32 * ks) = ah[mt]; }
            rt_split8(wa[0][0], wa[0][1], bh[0], bl[0]);
            { const float z = (fr < 4) ? 1.f : 0.f; rt_split8(wa[1][0] * z, wa[1][1] * z, bh[1], bl[1]); }
            if (ks < 7) RT_LD(ks + 1);
#pragma unroll
            for (int mt = 0; mt < 2; ++mt)
#pragma unroll
                for (int nt = 0; nt < 2; ++nt) { acc[mt][nt] = __builtin_amdgcn_mfma_f32_16x16x32_bf16(ah[mt], bh[nt], acc[mt][nt], 0, 0, 0);
                    acc[mt][nt] = __builtin_amdgcn_mfma_f32_16x16x32_bf16(al[mt], bh[nt], acc[mt][nt], 0, 0, 0);
                    acc[mt][nt] = __builtin_amdgcn_mfma_f32_16x16x32_bf16(ah[mt], bl[nt], acc[mt][nt], 0, 0, 0); }
        }
#undef RT_LD
#pragma unroll
        for (int mt = 0; mt < 2; ++mt) { float s = ssl[mt]; s += shfl_xor_l(s, 16, F.lane); s += shfl_xor_l(s, 32, F.lane); if (fq == 0) SS[F.wave * 32 + 16 * mt + fr] = s;
#pragma unroll
            for (int nt = 0; nt < 2; ++nt)
#pragma unroll
                for (int r = 0; r < 4; ++r) PL[(F.wave * 32 + 16 * mt + 4 * fq + r) * 32 + 16 * nt + fr] = acc[mt][nt][r]; }
    }
    __syncthreads();
    float acc[20], ss = 0.f;
#pragma unroll
    for (int o = 0; o < 20; ++o) acc[o] = 0.f;
#pragma unroll
    for (int w = 0; w < 8; ++w) { ss += SS[w * 32 + ts];
#pragma unroll
        for (int o = 0; o < 20; ++o) acc[o] += PL[(w * 32 + ts) * 32 + o]; }
    const float rstd = 1.0f / sqrtf(ss * (1.0f / DM) + EPS);
    {
        float lg0 = acc[0] * rstd + brg[0], lg1 = acc[1] * rstd + brg[1], lg2 = acc[2] * rstd + brg[2], lg3 = acc[3] * rstd + brg[3];
        int grp = 0; float mx = lg0;
        if (lg1 > mx) { mx = lg1; grp = 1; } if (lg2 > mx) { mx = lg2; grp = 2; } if (lg3 > mx) { mx = lg3; grp = 3; }
        const float den = (__expf(lg0 - mx) + __expf(lg1 - mx)) + (__expf(lg2 - mx) + __expf(lg3 - mx));
        const float psel = 1.0f / den;
        const float m0 = (grp == 0) ? 1.f : 0.f, m1 = (grp == 1) ? 1.f : 0.f, m2 = (grp == 2) ? 1.f : 0.f, m3 = (grp == 3) ? 1.f : 0.f;
        float e0v = (m0 * acc[4] + m1 * acc[8]) + (m2 * acc[12] + m3 * acc[16]), e1v = (m0 * acc[5] + m1 * acc[9]) + (m2 * acc[13] + m3 * acc[17]);
        float e2v = (m0 * acc[6] + m1 * acc[10]) + (m2 * acc[14] + m3 * acc[18]), e3v = (m0 * acc[7] + m1 * acc[11]) + (m2 * acc[15] + m3 * acc[19]);
        e0v = e0v * rstd + bre[grp * 4 + 0]; e1v = e1v * rstd + bre[grp * 4 + 1]; e2v = e2v * rstd + bre[grp * 4 + 2]; e3v = e3v * rstd + bre[grp * 4 + 3];
        int i0 = 0; float v0 = e0v;
        if (e1v > v0) { v0 = e1v; i0 = 1; } if (e2v > v0) { v0 = e2v; i0 = 2; } if (e3v > v0) { v0 = e3v; i0 = 3; }
        int i1 = -1; float v1 = -3.0e38f;
        if (i0 != 0 && e0v > v1) { v1 = e0v; i1 = 0; } if (i0 != 1 && e1v > v1) { v1 = e1v; i1 = 1; } if (i0 != 2 && e2v > v1) { v1 = e2v; i1 = 2; } if (i0 != 3 && e3v > v1) { v1 = e3v; i1 = 3; }
        const float ex = __expf(v1 - v0); const float w0 = psel / (1.0f + ex), w1 = psel * ex / (1.0f + ex);
        if (part == 0) { const int ea = grp * 4 + i0, eb = grp * 4 + i1;
            le[ts * 2] = ea; le[ts * 2 + 1] = eb; lw[ts * 2] = w0; lw[ts * 2 + 1] = w1; lr[ts] = rstd;
            lp[ts * 2] = __hip_atomic_fetch_add(lcnt + ea, 1, __ATOMIC_RELAXED, __HIP_MEMORY_SCOPE_WORKGROUP); lp[ts * 2 + 1] = __hip_atomic_fetch_add(lcnt + eb, 1, __ATOMIC_RELAXED, __HIP_MEMORY_SCOPE_WORKGROUP); }
    }
    __syncthreads();
    if (F.tid < 16) lbase[F.tid] = (int)__hip_atomic_fetch_add(gcnt + 64 * F.tid, (unsigned)lcnt[F.tid], RLX_AGENT);
    __syncthreads();
    if (F.tid < 64) { const int t2 = F.tid >> 1; const int e = le[F.tid], pos = lbase[e] + lp[F.tid];
        TOKLIST[e * SEQ + pos] = tb + t2; WLIST[e * SEQ + pos] = lw[F.tid]; RSLIST[e * SEQ + pos] = lr[t2]; TOKPOS[(tb + t2) * 2 + (F.tid & 1)] = (e << 13) | pos; }
}
using pg8::Unit; using pg8::f32x2; using pg8::u32x4; using pg8::u32x2; using pg8::cvt_pk_bf16; using pg8::gelu_pk; using pg8::sigmoid_f;
__device__ __forceinline__ void tile_of(int idx, int nM, int nN, int& pm, int& pn) {
    const int nig = 8 * nN, gid = idx / nig, fm = gid * 8, gsz = (nM - fm) < 8 ? (nM - fm) : 8;
    pm = fm + ((idx % nig) % gsz); pn = (idx % nig) / gsz;
}
__device__ __forceinline__ int xcd_remap(int L, int nwg) { const int q = nwg / 8, r = nwg % 8, xcd = L % 8, off = L / 8; return (xcd < r ? xcd * (q + 1) : r * (q + 1) + (xcd - r) * q) + off; }

struct InProjSched {
    static constexpr bool GATHER = false;
    const char* XN; const char* WIN; int G, c;
    __device__ __forceinline__ bool next(int i, Unit& u) const {
        const int L = i * G + c; if (L >= 1152) return false;
        const int w = xcd_remap(L, 1152);
        if (w < 384) { u.kind = 0; tile_of(w, 12, 32, u.pm, u.pn); } else { u.kind = 1; tile_of(w - 384, 32, 24, u.pm, u.pn); }
        u.e = 0; u.row0 = 0; u.nvalid = 256; return true;
    }
    __device__ __forceinline__ const char* a_base(const Unit& u) const { return (u.kind == 0 ? WIN : XN) + (size_t)u.pm * (256 * DM * 2); }
    __device__ __forceinline__ const char* b_base(const Unit& u) const { return (u.kind == 0 ? XN : WIN + (size_t)NHY * DM * 2) + (size_t)u.pn * (256 * DM * 2); }
    __device__ __forceinline__ unsigned a_goff(const Unit&, int) const { return 0u; }
};
struct EpiInProj {
    static constexpr bool PERM = true, MIDK = false;
    bf16 *ZT, *U; const float* bin;
    __device__ __forceinline__ void operator()(const f32x4 (&acc)[2][2][4][2], const Unit& u, int wr, int wc, int fr, int fq) const {
        asm volatile("" : "+v"(fr), "+v"(fq));
        if (u.kind == 0) {
            const int row0 = u.pm * 256 + wr * 64 + fr, col0 = u.pn * 256 + wc * 32 + 8 * fq;
#pragma unroll
            for (int ai = 0; ai < 2; ++ai)
#pragma unroll
                for (int m = 0; m < 4; ++m) { const int row = row0 + ai * 128 + m * 16; const float b = bin[row]; bf16* rowp = ZT + (size_t)row * SEQ + col0;
#pragma unroll
                    for (int bj = 0; bj < 2; ++bj) { const f32x4 v0 = acc[ai][bj][m][0] + b, v1 = acc[ai][bj][m][1] + b;
                        u32x4 w; w.x = cvt_pk_bf16(v0[0], v0[1]); w.y = cvt_pk_bf16(v0[2], v0[3]); w.z = cvt_pk_bf16(v1[0], v1[1]); w.w = cvt_pk_bf16(v1[2], v1[3]);
                        *(u32x4*)(rowp + bj * 128) = w; } }
        } else {
            const int seg = (u.pn < 4) ? 0 : (u.pn < 8) ? 1 : (u.pn < 16) ? 2 : 3;
            const int colt = (seg == 0) ? u.pn * 256 : (seg == 1) ? (u.pn - 4) * 256 : (seg == 2) ? (u.pn - 8) * 256 : (u.pn - 16) * 256;
            const int row0 = u.pm * 256 + wr * 64 + fr, col0 = colt + wc * 32 + 8 * fq, bcol0 = NHY + u.pn * 256 + wc * 32 + 8 * fq;
            f32x4 bv[2][2];
#pragma unroll
            for (int bj = 0; bj < 2; ++bj)
#pragma unroll
                for (int n = 0; n < 2; ++n) bv[bj][n] = *(const f32x4*)(bin + bcol0 + bj * 128 + 4 * n);
            if (seg < 2) {
                bf16* base = (bf16*)((char*)U + ((seg == 0) ? (size_t)0 : (size_t)(WS_GV - WS_U)));
#pragma unroll
                for (int ai = 0; ai < 2; ++ai)
#pragma unroll
                    for (int m = 0; m < 4; ++m) { bf16* rowp = base + (size_t)(row0 + ai * 128 + m * 16) * 1024 + col0;
#pragma unroll
                        for (int bj = 0; bj < 2; ++bj) { f32x4 v0 = acc[ai][bj][m][0] + bv[bj][0], v1 = acc[ai][bj][m][1] + bv[bj][1];
                            const f32x2 a = gelu_pk((f32x2){v0[0], v0[1]}), b = gelu_pk((f32x2){v0[2], v0[3]}), c = gelu_pk((f32x2){v1[0], v1[1]}), d = gelu_pk((f32x2){v1[2], v1[3]});
                            u32x4 w; w.x = cvt_pk_bf16(a.x, a.y); w.y = cvt_pk_bf16(b.x, b.y); w.z = cvt_pk_bf16(c.x, c.y); w.w = cvt_pk_bf16(d.x, d.y);
                            *(u32x4*)(rowp + bj * 128) = w; } }
            } else {
                unsigned char* base = (unsigned char*)U + ((seg == 2) ? (size_t)(WS_GH - WS_U) : (size_t)(WS_GS - WS_U));
#pragma unroll
                for (int ai = 0; ai < 2; ++ai)
#pragma unroll
                    for (int m = 0; m < 4; ++m) { unsigned char* rowp = base + (size_t)(row0 + ai * 128 + m * 16) * DM + col0;
#pragma unroll
                        for (int bj = 0; bj < 2; ++bj) { const f32x4 v0 = acc[ai][bj][m][0] + bv[bj][0], v1 = acc[ai][bj][m][1] + bv[bj][1];
                            unsigned w0 = 0u, w1 = 0u;
#pragma unroll
                            for (int j = 0; j < 4; ++j) { w0 = __builtin_amdgcn_cvt_pk_u8_f32(fmaxf(sigmoid_f(v0[j]) * 255.0f, 1.0f), j, w0); w1 = __builtin_amdgcn_cvt_pk_u8_f32(fmaxf(sigmoid_f(v1[j]) * 255.0f, 1.0f), j, w1); }
                            u32x2 w; w.x = w0; w.y = w1; *(u32x2*)(rowp + bj * 128) = w; } }
            }
        }
    }
    __device__ __forceinline__ void mid(f32x4 (&)[2][2][4][2], const Unit&, int, int, int, int) const {}
};
struct GridSched {
    static constexpr bool GATHER = false;
    const char* A; const char* Bt; int nM, nN, K, G, c;
    __device__ __forceinline__ bool next(int i, Unit& u) const {
        const int L = i * G + c, nwg = nM * nN; if (L >= nwg) return false;
        tile_of(xcd_remap(L, nwg), nM, nN, u.pm, u.pn); u.kind = 0; u.e = 0; u.row0 = 0; u.nvalid = 256; return true;
    }
    __device__ __forceinline__ const char* a_base(const Unit& u) const { return A + (size_t)u.pm * 512 * K; }
    __device__ __forceinline__ const char* b_base(const Unit& u) const { return Bt + (size_t)u.pn * 512 * K; }
    __device__ __forceinline__ unsigned a_goff(const Unit&, int) const { return 0u; }
};
struct EpiMerge {
    static constexpr bool PERM = true, MIDK = true;
    const unsigned char *GH, *GS; bf16* O;
    __device__ __forceinline__ void mid(f32x4 (&acc)[2][2][4][2], const Unit& u, int wr, int wc, int fr, int fq) const {
        asm volatile("" : "+v"(fr), "+v"(fq));
        const int row0 = u.pm * 256 + wr * 64 + fr, col0 = u.pn * 256 + wc * 32 + 8 * fq;
        u32x2 hb[2][2], sb[2][2];
#define EM_LOAD(g, par) do { const size_t _o = (size_t)(row0 + ((g) >> 2) * 128 + ((g) & 3) * 16) * DM + col0; \
            hb[par][0] = *(const u32x2*)(GH + _o); hb[par][1] = *(const u32x2*)(GH + _o + 128); sb[par][0] = *(const u32x2*)(GS + _o); sb[par][1] = *(const u32x2*)(GS + _o + 128); } while (0)
        EM_LOAD(0, 0);
#pragma unroll
        for (int g = 0; g < 8; ++g) { const int ai = g >> 2, m = g & 3, par = g & 1;
            if (g + 1 < 8) EM_LOAD(g + 1, (g + 1) & 1);
            asm volatile("" ::: "memory");
#pragma unroll
            for (int bj = 0; bj < 2; ++bj) { const unsigned hh[2] = {hb[par][bj].x, hb[par][bj].y}, sv[2] = {sb[par][bj].x, sb[par][bj].y};
#pragma unroll
                for (int n = 0; n < 2; ++n)
#pragma unroll
                    for (int j = 0; j < 4; ++j) acc[ai][bj][m][n][j] *= (float)((hh[n] >> (8 * j)) & 0xffu) * __builtin_amdgcn_rcpf((float)((sv[n] >> (8 * j)) & 0xffu)); }
            asm volatile("" : "+v"(acc[ai][0][m][0]), "+v"(acc[ai][0][m][1]), "+v"(acc[ai][1][m][0]), "+v"(acc[ai][1][m][1])); }
#undef EM_LOAD
    }
    __device__ __forceinline__ void operator()(const f32x4 (&acc)[2][2][4][2], const Unit& u, int wr, int wc, int fr, int fq) const {
        asm volatile("" : "+v"(fr), "+v"(fq));
        const int row0 = u.pm * 256 + wr * 64 + fr, col0 = u.pn * 256 + wc * 32 + 8 * fq;
        u32x2 sb[2][2];
#define EM_LOAD(g, par) do { const size_t _o = (size_t)(row0 + ((g) >> 2) * 128 + ((g) & 3) * 16) * DM + col0; sb[par][0] = *(const u32x2*)(GS + _o); sb[par][1] = *(const u32x2*)(GS + _o + 128); } while (0)
        EM_LOAD(0, 0); EM_LOAD(1, 1);
#pragma unroll
        for (int g = 0; g < 8; ++g) { const int ai = g >> 2, m = g & 3, par = g & 1; const size_t off = (size_t)(row0 + ai * 128 + m * 16) * DM + col0;
            u32x4 w[2];
#pragma unroll
            for (int bj = 0; bj < 2; ++bj) { const unsigned sv[2] = {sb[par][bj].x, sb[par][bj].y}; float o[8];
#pragma unroll
                for (int n = 0; n < 2; ++n)
#pragma unroll
                    for (int j = 0; j < 4; ++j) o[4 * n + j] = acc[ai][bj][m][n][j] * ((float)((sv[n] >> (8 * j)) & 0xffu) * (1.0f / 255.0f));
                w[bj].x = cvt_pk_bf16(o[0], o[1]); w[bj].y = cvt_pk_bf16(o[2], o[3]); w[bj].z = cvt_pk_bf16(o[4], o[5]); w[bj].w = cvt_pk_bf16(o[6], o[7]); }
            if (g + 2 < 8) EM_LOAD(g + 2, par);
            *(u32x4*)(O + off) = w[0]; *(u32x4*)(O + off + 128) = w[1];
            asm volatile("" ::: "memory"); }
#undef EM_LOAD
    }
};
struct EpiResid {
    static constexpr bool PERM = true, MIDK = false;
    const float* basef; const bf16* baseh; bf16* out;
    __device__ __forceinline__ void operator()(const f32x4 (&acc)[2][2][4][2], const Unit& u, int wr, int wc, int fr, int fq) const {
        asm volatile("" : "+v"(fr), "+v"(fq));
        const int row0 = u.pm * 256 + wr * 64 + fr, col0 = u.pn * 256 + wc * 32 + 8 * fq;
        if (basef) {
            f32x4 bb[2][4];
#define ER_LOAD(g, par) do { const size_t _o = (size_t)(row0 + ((g) >> 2) * 128 + ((g) & 3) * 16) * DM + col0; \
                bb[par][0] = *(const f32x4*)(basef + _o); bb[par][1] = *(const f32x4*)(basef + _o + 4); bb[par][2] = *(const f32x4*)(basef + _o + 128); bb[par][3] = *(const f32x4*)(basef + _o + 132); } while (0)
            ER_LOAD(0, 0); ER_LOAD(1, 1);
#pragma unroll
            for (int g = 0; g < 8; ++g) { const int ai = g >> 2, m = g & 3, par = g & 1; const size_t off = (size_t)(row0 + ai * 128 + m * 16) * DM + col0;
                const f32x4 o0 = bb[par][0] + acc[ai][0][m][0], o1 = bb[par][1] + acc[ai][0][m][1], o2 = bb[par][2] + acc[ai][1][m][0], o3 = bb[par][3] + acc[ai][1][m][1];
                if (g + 2 < 8) ER_LOAD(g + 2, par);
                u32x4 w0, w1; w0.x = cvt_pk_bf16(o0[0], o0[1]); w0.y = cvt_pk_bf16(o0[2], o0[3]); w0.z = cvt_pk_bf16(o1[0], o1[1]); w0.w = cvt_pk_bf16(o1[2], o1[3]);
                w1.x = cvt_pk_bf16(o2[0], o2[1]); w1.y = cvt_pk_bf16(o2[2], o2[3]); w1.z = cvt_pk_bf16(o3[0], o3[1]); w1.w = cvt_pk_bf16(o3[2], o3[3]);
                *(u32x4*)(out + off) = w0; *(u32x4*)(out + off + 128) = w1;
                asm volatile("" ::: "memory"); }
#undef ER_LOAD
        } else {
            u32x4 hb[2][2];
#define ER_LOAD(g, par) do { const size_t _o = (size_t)(row0 + ((g) >> 2) * 128 + ((g) & 3) * 16) * DM + col0; hb[par][0] = *(const u32x4*)(baseh + _o); hb[par][1] = *(const u32x4*)(baseh + _o + 128); } while (0)
            ER_LOAD(0, 0); ER_LOAD(1, 1);
#pragma unroll
            for (int g = 0; g < 8; ++g) { const int ai = g >> 2, m = g & 3, par = g & 1; const size_t off = (size_t)(row0 + ai * 128 + m * 16) * DM + col0;
                u32x4 w[2];
#pragma unroll
                for (int bj = 0; bj < 2; ++bj) { const unsigned hv[4] = {hb[par][bj].x, hb[par][bj].y, hb[par][bj].z, hb[par][bj].w}; const f32x4 v0 = acc[ai][bj][m][0], v1 = acc[ai][bj][m][1];
                    w[bj].x = cvt_pk_bf16(bfl(hv[0]) + v0[0], bfh(hv[0]) + v0[1]); w[bj].y = cvt_pk_bf16(bfl(hv[1]) + v0[2], bfh(hv[1]) + v0[3]);
                    w[bj].z = cvt_pk_bf16(bfl(hv[2]) + v1[0], bfh(hv[2]) + v1[1]); w[bj].w = cvt_pk_bf16(bfl(hv[3]) + v1[2], bfh(hv[3]) + v1[3]); }
                if (g + 2 < 8) ER_LOAD(g + 2, par);
                *(u32x4*)(out + off) = w[0]; *(u32x4*)(out + off + 128) = w[1];
                asm volatile("" ::: "memory"); }
#undef ER_LOAD
        }
    }
    __device__ __forceinline__ void mid(f32x4 (&)[2][2][4][2], const Unit&, int, int, int, int) const {}
};
struct MoeSched1 {
    static constexpr bool GATHER = true;
    const LAS int* tab; const char* H; const char* W; const int* toklist; int G, c;
    __device__ __forceinline__ bool next(int i, Unit& u) const {
        const int L = i * G + c; const int total = __builtin_amdgcn_readfirstlane(tab[16]) * 4; if (L >= total) return false;
        const int rt = L >> 2; int e = 0;
#pragma unroll
        for (int j = 1; j < 16; ++j) e += (__builtin_amdgcn_readfirstlane(tab[j]) <= rt) ? 1 : 0;
        const int j0 = rt - __builtin_amdgcn_readfirstlane(tab[e]);
        u.pm = j0; u.pn = L & 3; u.kind = 0; u.e = e; u.row0 = __builtin_amdgcn_readfirstlane(tab[17 + e]) + 256 * j0;
        const int rem = __builtin_amdgcn_readfirstlane(tab[34 + e]) - 256 * j0; u.nvalid = rem < 256 ? rem : 256; return true;
    }
    __device__ __forceinline__ const char* a_base(const Unit&) const { return H; }
    __device__ __forceinline__ const char* b_base(const Unit& u) const { return W + ((size_t)u.e * 1024 + (size_t)u.pn * 256) * DM * 2; }
    __device__ __forceinline__ unsigned a_goff(const Unit& u, int r) const { const int tok = (r < u.nvalid) ? toklist[u.e * SEQ + u.pm * 256 + r] : 0; return (unsigned)tok * (unsigned)(DM * 2); }
};
struct EpiMoe1 {
    static constexpr bool PERM = true, MIDK = false;
    bf16* ACT; const float* wlist; const float* rslist;
    __device__ __forceinline__ void operator()(const f32x4 (&acc)[2][2][4][2], const Unit& u, int wr, int wc, int fr, int fq) const {
        asm volatile("" : "+v"(fr), "+v"(fq));
        const int col0 = u.pn * 128 + wc * 32 + 8 * fq;
#pragma unroll
        for (int ai = 0; ai < 2; ++ai)
#pragma unroll
            for (int m = 0; m < 4; ++m) { const int rl = ai * 128 + wr * 64 + m * 16 + fr;
                if (rl < u.nvalid) { const float wt = wlist[u.e * SEQ + u.pm * 256 + rl], rs = rslist[u.e * SEQ + u.pm * 256 + rl];
                    const f32x4 g0 = acc[ai][0][m][0], g1 = acc[ai][0][m][1], u0 = acc[ai][1][m][0], u1 = acc[ai][1][m][1];
                    float o[8];
#pragma unroll
                    for (int j = 0; j < 4; ++j) { const float ga = g0[j] * rs, gb = g1[j] * rs; o[j] = ga * sigmoid_f(ga) * (u0[j] * rs) * wt; o[4 + j] = gb * sigmoid_f(gb) * (u1[j] * rs) * wt; }
                    u32x4 w; w.x = cvt_pk_bf16(o[0], o[1]); w.y = cvt_pk_bf16(o[2], o[3]); w.z = cvt_pk_bf16(o[4], o[5]); w.w = cvt_pk_bf16(o[6], o[7]);
                    *(u32x4*)(ACT + (size_t)(u.row0 + rl) * DEXP + col0) = w; } }
    }
    __device__ __forceinline__ void mid(f32x4 (&)[2][2][4][2], const Unit&, int, int, int, int) const {}
};
struct MoeSched2 {
    static constexpr bool GATHER = false;
    const LAS int* tab; const char* ACT; const char* W; int G, c;
    __device__ __forceinline__ bool next(int i, Unit& u) const {
        const int L = i * G + c; const int total = __builtin_amdgcn_readfirstlane(tab[16]) * 8; if (L >= total) return false;
        const int rt = L >> 3; int e = 0;
#pragma unroll
        for (int j = 1; j < 16; ++j) e += (__builtin_amdgcn_readfirstlane(tab[j]) <= rt) ? 1 : 0;
        const int j0 = rt - __builtin_amdgcn_readfirstlane(tab[e]);
        u.pm = j0; u.pn = L & 7; u.kind = 0; u.e = e; u.row0 = __builtin_amdgcn_readfirstlane(tab[17 + e]) + 256 * j0;
        const int rem = __builtin_amdgcn_readfirstlane(tab[34 + e]) - 256 * j0; u.nvalid = rem < 256 ? rem : 256; return true;
    }
    __device__ __forceinline__ const char* a_base(const Unit& u) const { return ACT + (size_t)u.row0 * DEXP * 2; }
    __device__ __forceinline__ const char* b_base(const Unit& u) const { return W + ((size_t)u.e * DM + (size_t)u.pn * 256) * DEXP * 2; }
    __device__ __forceinline__ unsigned a_goff(const Unit&, int) const { return 0u; }
};
struct EpiMoe2 {
    static constexpr bool PERM = true, MIDK = false;
    bf16* MO;
    __device__ __forceinline__ void operator()(const f32x4 (&acc)[2][2][4][2], const Unit& u, int wr, int wc, int fr, int fq) const {
        asm volatile("" : "+v"(fr), "+v"(fq));
        const int col0 = u.pn * 256 + wc * 32 + 8 * fq;
#pragma unroll
        for (int ai = 0; ai < 2; ++ai)
#pragma unroll
            for (int m = 0; m < 4; ++m) { const int rl = ai * 128 + wr * 64 + m * 16 + fr;
                if (rl < u.nvalid) { bf16* rowp = MO + (size_t)(u.row0 + rl) * DM + col0;
#pragma unroll
                    for (int bj = 0; bj < 2; ++bj) { const f32x4 v0 = acc[ai][bj][m][0], v1 = acc[ai][bj][m][1];
                        u32x4 w; w.x = cvt_pk_bf16(v0[0], v0[1]); w.y = cvt_pk_bf16(v0[2], v0[3]); w.z = cvt_pk_bf16(v1[0], v1[1]); w.w = cvt_pk_bf16(v1[2], v1[3]);
                        *(u32x4*)(rowp + bj * 128) = w; } } }
    }
    __device__ __forceinline__ void mid(f32x4 (&)[2][2][4][2], const Unit&, int, int, int, int) const {}
};
__device__ __forceinline__ void moe_tables(Frame& F, int l) {
    LAS int* tab = (LAS int*)(F.lds + MISC_OFF + 128);
    __syncthreads();
    if (F.tid == 0) { int tp = 0, off = 0;
        for (int e = 0; e < 16; ++e) { const int c = (int)__hip_atomic_load(F.ctl + CW_CNT + 64 * (16 * l + e), RLX_AGENT); tab[e] = tp; tab[17 + e] = off; tab[34 + e] = c; tp += (c + 255) >> 8; off += c; }
        tab[16] = tp; tab[33] = off; }
    __syncthreads();
}

struct Args { const float* in[29]; float* out; unsigned char* ws; int ph_lo, ph_hi; };
constexpr int NPHASE = 17;
__global__ void __launch_bounds__(NTHR, 2) fwd_kernel(Args args) {
    extern __shared__ __attribute__((aligned(16))) unsigned char lds[];
    Frame F;
    F.lds = (LAS unsigned char*)lds;
    F.MISC = (volatile LAS unsigned*)(F.lds + MISC_OFF);
    F.tid = threadIdx.x; F.lane = F.tid & 63; F.wave = __builtin_amdgcn_readfirstlane(F.tid >> 6);
    F.G = gridDim.x; { const int bx = blockIdx.x; F.vcu = (F.G % 8 == 0) ? (bx % 8) * (F.G / 8) + bx / 8 : bx; }
    F.ws = args.ws; F.out = args.out; F.ctl = (gu32*)(args.ws + WS_CTL);
    for (int u = F.tid; u < 256; u += NTHR) ((LAS unsigned*)(F.lds + MISC_OFF))[u] = 0u;
    F.inp = (const LAS unsigned long long*)(F.lds + MISC_OFF + 640);
    __syncthreads();
#pragma unroll
    for (int i = 0; i < 29; ++i) if (F.tid == i) ((LAS unsigned long long*)(F.lds + MISC_OFF + 640))[i] = (unsigned long long)args.in[i];
    __syncthreads();
    const int lo = args.ph_lo, hi = args.ph_hi;
    const bool multi = (hi - lo) > 1;
    XcdBarrier bar; bar.bar = (unsigned*)(F.ctl + CW_BAR); bar.x = 0; bar.st = nullptr;
    if (multi) bar = xcd_barrier_post((unsigned*)(F.ctl + CW_BAR), F.MISC + 8);
#ifndef PHASE_MASK
#define PHASE_MASK 0x7ff
#endif
#define IN(k) (lo <= (k) && (k) < hi)
#define ON(j) ((PHASE_MASK >> (j)) & 1)
#ifndef DUP_MASK
#define DUP_MASK 0
#endif
#define REP(j) for (int _rep = 0; _rep < (((DUP_MASK >> (j)) & 1) ? 2 : 1); ++_rep)
#define LAUNDER() do { int _l; asm volatile("v_mbcnt_lo_u32_b32 %0, -1, 0\n\tv_mbcnt_hi_u32_b32 %0, -1, %0" : "=v"(_l)); F.lane = _l; F.tid = F.wave * 64 + _l; { unsigned char* _w = F.ws; asm volatile("" : "+s"(_w)); F.ws = _w; } } while (0)
#ifndef PROBE_K
#define PROBE_K -1
#endif
#ifndef PROBE_PART
#define PROBE_PART 0
#endif
#ifndef PROBE_AMP
#define PROBE_AMP 8
#endif
    volatile LAS unsigned long long* pr = (volatile LAS unsigned long long*)(F.lds + MISC_OFF + 512);
#define PR_ME (blockIdx.x == 0 && threadIdx.x == 0)
#define PSTART(j) do { if (PROBE_K == (j) && PROBE_PART != 1 && PR_ME) pr[0] = __builtin_amdgcn_s_memrealtime(); } while (0)
#define PEND(j) do { if (PROBE_K == (j) && PR_ME) { const unsigned long long _n = __builtin_amdgcn_s_memrealtime(); if (PROBE_PART == 0 || (PROBE_PART == 2 && (j) == 8)) pr[1] += _n - pr[0]; else if (PROBE_PART == 1) pr[0] = _n; } } while (0)
#define PBAR(j) do { if (PROBE_K == (j) && PROBE_PART >= 1 && PR_ME) pr[1] += __builtin_amdgcn_s_memrealtime() - pr[0]; } while (0)
#define SEAM(k) do { if (IN(k) && IN((k) + 1)) xcd_barrier(bar); } while (0)
    const int gw = F.vcu * NWAVES + F.wave, NGW = F.G * NWAVES;
    for (int l = 0; l < DEPTH; ++l) {
        const int p0 = l * 8;
        if (ON(0) && IN(p0 + 0)) { LAUNDER(); PSTART(0);
            PSTART(10); if (l == 0) pa_convert(F, l); PEND(10);
            PSTART(11); if (l == 0) { for (int ll = 0; ll < DEPTH; ++ll) { pa_features(F, ll); pa_router_t(F, ll); } } PEND(11);
            PSTART(13);
            const float* g = inp(F, I_GMIX) + (size_t)l * DM;
            if (l == 0) { for (int m = gw; m < SEQ; m += 4 * NGW) norm_rows<0, false, 4>(F, m, NGW, inp(F, I_X), g, nullptr, nullptr); }
            else { for (int m = gw; m < SEQ; m += 2 * NGW) norm_rows<1, false, 2>(F, m, NGW, nullptr, g, F.ctl + CW_CNT + 64 * 16 * (l - 1), nullptr); }
            PEND(13);
        }
        PEND(0); SEAM(p0 + 0); PBAR(0);
        if (ON(1) && IN(p0 + 1)) { LAUNDER(); PSTART(1);
            InProjSched S{(const char*)(F.ws + WS_XN), (const char*)(F.ws + ((l & 1) ? WS_WIN2 : WS_WIN)), F.G, (int)blockIdx.x};
            EpiInProj E{(bf16*)(F.ws + WS_ZT), (bf16*)(F.ws + WS_U), inp(F, I_BIN) + (size_t)l * NIN};
            REP(1) pg8::gemm_phase<EpiInProj, InProjSched>(F.lds, DM, S, E, F.tid);
        }
        PEND(1); SEAM(p0 + 1); PBAR(1);
        if (ON(2) && IN(p0 + 2)) { LAUNDER(); PSTART(2);
            if (ON(9)) REP(9) for (int u = F.vcu; u < 256; u += F.G) sgu_pair(F, l, u >> 2, u & 3);
            if (ON(10)) REP(10) for (int b = F.vcu; b < 256; b += F.G) hyena_block(F, l, b);
        }
        PEND(2); SEAM(p0 + 2); PBAR(2);
        if (ON(3) && IN(p0 + 3)) { LAUNDER(); PSTART(3);
            GridSched S{(const char*)(F.ws + WS_Y), (const char*)(F.ws + WS_PT), 32, 8, DM, F.G, (int)blockIdx.x};
            EpiMerge E{(const unsigned char*)(F.ws + WS_GH), (const unsigned char*)(F.ws + WS_GS), (bf16*)(F.ws + WS_MERGED)};
            REP(3) pg8::gemm_phase<EpiMerge, GridSched>(F.lds, DM, S, E, F.tid);
        }
        PEND(3); SEAM(p0 + 3); PBAR(3);
        if (ON(4) && IN(p0 + 4)) { LAUNDER(); PSTART(4);
            GridSched S{(const char*)(F.ws + WS_MERGED), (const char*)(F.ws + WS_WOT), 32, 8, DM, F.G, (int)blockIdx.x};
            EpiResid E{l == 0 ? inp(F, I_X) : nullptr, (const bf16*)(F.ws + WS_XR), (bf16*)(F.ws + WS_XR)};
            pg8::gemm_phase<EpiResid, GridSched>(F.lds, DM, S, E, F.tid);
        }
        PEND(4); SEAM(p0 + 4); PBAR(4);
        if (ON(5) && IN(p0 + 5)) { LAUNDER(); PSTART(5); for (int tb = F.vcu * 32; tb < SEQ; tb += F.G * 32) route_block(F, l, tb); }
        PEND(5); SEAM(p0 + 5); PBAR(5);
        if (ON(6) && IN(p0 + 6)) { LAUNDER(); PSTART(6);
            moe_tables(F, l);
            MoeSched1 S{(const LAS int*)(F.lds + MISC_OFF + 128), (const char*)(F.ws + WS_XN), (const char*)(F.ws + WS_WGU), (const int*)(F.ws + WS_LISTS), F.G, F.vcu};
            EpiMoe1 E{(bf16*)(F.ws + WS_ACT), (const float*)(F.ws + WS_LISTS + 512 * 1024), (const float*)(F.ws + WS_LISTS + 1 * MiB + 512 * 1024)};
            REP(6) pg8::gemm_phase<EpiMoe1, MoeSched1>(F.lds, DM, S, E, F.tid);
        }
        PEND(6); SEAM(p0 + 6); PBAR(6);
        if (ON(7) && IN(p0 + 7)) { LAUNDER(); PSTART(7);
            moe_tables(F, l);
            MoeSched2 S{(const LAS int*)(F.lds + MISC_OFF + 128), (const char*)(F.ws + WS_ACT), (const char*)(F.ws + WS_WD), F.G, F.vcu};
            EpiMoe2 E{(bf16*)(F.ws + WS_MOEOUT)};
            REP(7) pg8::gemm_phase<EpiMoe2, MoeSched2>(F.lds, DEXP, S, E, F.tid);
        }
        PEND(7); SEAM(p0 + 7); PBAR(7);
    }
    if (ON(8) && IN(16)) { LAUNDER(); PSTART(8); for (int m = gw; m < SEQ; m += 2 * NGW) norm_rows<1, true, 2>(F, m, NGW, nullptr, inp(F, I_GFINAL), F.ctl + CW_CNT + 64 * 16 * (DEPTH - 1), F.out); }
    PEND(8);
    if (PROBE_K >= 0 && PR_ME) { const unsigned long long t0 = __builtin_amdgcn_s_memrealtime(), amt = pr[1] * PROBE_AMP; while (__builtin_amdgcn_s_memrealtime() - t0 < amt) __builtin_amdgcn_s_sleep(8); }
#undef IN
#undef SEAM
}

#ifndef MK_ONE_LAUNCH
#define MK_ONE_LAUNCH 0
#endif
extern "C" void kernel_launch(void* const* d_in, const int* in_sizes, int n_in, void* d_out, int out_size, void* d_ws, size_t ws_size, hipStream_t stream) {
    static int grid = 0;
    if (grid == 0) {
        if (n_in != 29 || ws_size < WS_END) { fprintf(stderr, "kernel_launch: unexpected n_in %d or ws %zu < %zu\n", n_in, ws_size, (size_t)WS_END); grid = -1; return; }
        int dev = 0, cus = 0, per_cu = 0;
        if (hipGetDevice(&dev) != hipSuccess || hipDeviceGetAttribute(&cus, hipDeviceAttributeMultiprocessorCount, dev) != hipSuccess) { grid = -1; return; }
        if (hipFuncSetAttribute((const void*)fwd_kernel, hipFuncAttributeMaxDynamicSharedMemorySize, LDS_BYTES) != hipSuccess) { fprintf(stderr, "kernel_launch: hipFuncSetAttribute failed\n"); grid = -1; return; }
        if (hipOccupancyMaxActiveBlocksPerMultiprocessor(&per_cu, (const void*)fwd_kernel, NTHR, LDS_BYTES) != hipSuccess || per_cu < 1) fprintf(stderr, "kernel_launch: occupancy query reports %d\n", per_cu);
        (void)hipGetLastError();
        grid = cus;
    }
    if (grid < 0) return;
    (void)hipMemsetAsync((char*)d_ws + WS_CTL, 0, CTL_ZERO_BYTES, stream);
    Args a{};
    for (int i = 0; i < 29; ++i) a.in[i] = (const float*)d_in[i];
    a.out = (float*)d_out; a.ws = (unsigned char*)d_ws;
#if MK_ONE_LAUNCH
    a.ph_lo = 0; a.ph_hi = NPHASE;
    hipLaunchKernelGGL(fwd_kernel, dim3(grid), dim3(NTHR), LDS_BYTES, stream, a);
#else
    for (int p = 0; p < NPHASE; ++p) { a.ph_lo = p; a.ph_hi = p + 1; hipLaunchKernelGGL(fwd_kernel, dim3(grid), dim3(NTHR), LDS_BYTES, stream, a); }
#endif
}
```

```cpp
#include <hip/hip_runtime.h>
#include <cstdio>
#include <cstdint>
#define MK_ONE_LAUNCH 1
#define DUP_MASK 0
#define PROBE_K -1
#define PROBE_PART 0
#define PROBE_BLK 0
namespace pg8 {
#define PG8_LAS __attribute__((address_space(3)))
typedef unsigned short bf16_t;
typedef short bf16x8 __attribute__((ext_vector_type(8)));
typedef float f32x4 __attribute__((ext_vector_type(4)));
typedef float f32x2 __attribute__((ext_vector_type(2)));
typedef unsigned u32x4 __attribute__((ext_vector_type(4)));
typedef unsigned u32x2 __attribute__((ext_vector_type(2)));
typedef int v4i __attribute__((ext_vector_type(4)));
typedef int v8i __attribute__((ext_vector_type(8)));
typedef int v32i __attribute__((ext_vector_type(32)));
constexpr int BM = 256, BK = 64, HALF = 128, HTB = HALF * BK * 2  , STAGE_BYTES = 8 * HTB;
constexpr int GATHER_SLOT_OFF = 2 * 8448 * 8 + 1024;

__host__ __device__ __forceinline__ int lds_byte(int r, int c) { const int st = (r >> 4) * 2 + (c >> 5), rr = r & 15, cc = c & 31, ob = rr * 64 + cc * 2; return st * 1024 + (ob ^ (((ob >> 9) & 1) << 5)); }
__host__ __device__ __forceinline__ void stage_rc(int b, int& R, int& C) { const int st = b / 1024, sb = b % 1024, swz = sb ^ (((sb >> 9) & 1) << 5); R = (st >> 1) * 16 + swz / 64; C = (st & 1) * 32 + (swz % 64) / 2; }
__host__ __device__ __forceinline__ int perm32(int rho) { const int n = rho >> 4, i = rho & 15; return 8 * (i >> 2) + 4 * n + (i & 3); }

struct Unit { int pm, pn, kind, e, row0, nvalid, rt, half; };

__device__ __forceinline__ unsigned cvt_pk_bf16(float lo, float hi) { unsigned r; asm volatile("v_cvt_pk_bf16_f32 %0, %1, %2" : "=v"(r) : "v"(lo), "v"(hi)); return r; }
__device__ __forceinline__ f32x2 gelu_pk(f32x2 v) {
    const f32x2 av = __builtin_elementwise_abs(v), d = av * 0.2316418882f + 1.0f;
    f32x2 t; t.x = __builtin_amdgcn_rcpf(d.x); t.y = __builtin_amdgcn_rcpf(d.y);
    f32x2 q = t * 0.5307027145f + (-0.7265760135f); q = q * t + 0.7107068705f; q = q * t + (-0.142248368f); q = q * t + 0.127414796f; q = q * t;
    const f32x2 s = (v * v) * (-0.72134752044f);
    f32x2 e; e.x = __builtin_amdgcn_exp2f(s.x); e.y = __builtin_amdgcn_exp2f(s.y);
    const f32x2 m = v * (q * e), r = v - m;
    f32x2 o; o.x = v.x < 0.f ? m.x : r.x; o.y = v.y < 0.f ? m.y : r.y; return o;
}
__device__ __forceinline__ float sigmoid_f(float x) { return __builtin_amdgcn_rcpf(1.0f + __builtin_amdgcn_exp2f(-1.4426950408889634f * x)); }

__device__ __forceinline__ int fresh_tid(int wid) { int l; asm volatile("v_mbcnt_lo_u32_b32 %0, -1, 0\n\tv_mbcnt_hi_u32_b32 %0, -1, %0" : "=v"(l)); return wid * 64 + l; }
__device__ __forceinline__ const char* uni_ptr(const char* p) { const unsigned long long v = (unsigned long long)p; const unsigned lo = __builtin_amdgcn_readfirstlane((unsigned)v), hi = __builtin_amdgcn_readfirstlane((unsigned)(v >> 32)); return (const char*)(((unsigned long long)hi << 32) | lo); }
template <class Epi, class Sched>
__device__ __forceinline__ void gemm_phase(PG8_LAS unsigned char* lds, const int K, const Sched& S, const Epi& E, int tid) {
    asm volatile("" : "+v"(tid));
    const int wid = __builtin_amdgcn_readfirstlane(tid >> 6), lane = tid & 63, wr = wid >> 2, wc = wid & 3, fr = lane & 15, fq = lane >> 4;
    const int nt = K / BK;
    unsigned voffA[2], voffB[2];
#pragma unroll
    for (int i = 0; i < 2; ++i) { int R, C; stage_rc(tid * 16 + i * 8192, R, C); const int Rb = Epi::PERM ? ((R & ~31) + perm32(R & 31)) : R;
        voffA[i] = Sched::GATHER ? 0u : (unsigned)(R * K + C) * 2u; voffB[i] = (unsigned)(Rb * K + C) * 2u; }
#define PG8_GOFF(u, h, i) ({ int _R, _C, _t = fresh_tid(wid); stage_rc(_t * 16 + (i) * 8192, _R, _C); S.a_goff((u), (h) * HALF + _R) + (unsigned)(_C * 2); })
    const size_t kstep = (size_t)(BK * 2);
    const size_t hstep = (size_t)HALF * K * 2;
    const unsigned ldsw = (unsigned)wid * 1024u;
    const int aoff = lds_byte(wr * 64 + fr, fq * 8);
    int boff = lds_byte(wc * 32 + fr, fq * 8) + 4 * HTB; asm volatile("" : "+v"(boff));
#define PG8_SA(b, h) (((b) * 2 + (h)) * HTB)
#define PG8_SB(b, h) ((4 + (b) * 2 + (h)) * HTB)
#define PG8_STAGE(bufoff, gbase, voff) do { _Pragma("unroll") for (int _i = 0; _i < 2; ++_i) { unsigned _v = (voff)[_i]; asm volatile("" : "+v"(_v)); \
        __builtin_amdgcn_global_load_lds((const unsigned*)((const char*)(gbase) + _v), (PG8_LAS unsigned*)(lds + (bufoff) + ldsw + _i * 8192), 16, 0, 0); } } while (0)
#define PG8_STAGE_A(bufoff, gbase, h, GO) do { if constexpr (Sched::GATHER) { _Pragma("unroll") for (int _i = 0; _i < 2; ++_i) { unsigned _v = (GO)[h][_i]; asm volatile("" : "+v"(_v)); \
        __builtin_amdgcn_global_load_lds((const unsigned*)((const char*)(gbase) + _v), (PG8_LAS unsigned*)(lds + (bufoff) + ldsw + _i * 8192), 16, 0, 0); } } \
        else { PG8_STAGE(bufoff, (gbase) + (h) * hstep, voffA); } } while (0)
#define PG8_LD16(off) (*(const PG8_LAS v4i*)(lds + (off)))
#define PG8_INS4(V, pos, val) do { const v4i _q = (val); (V)[(pos)] = _q[0]; (V)[(pos) + 1] = _q[1]; (V)[(pos) + 2] = _q[2]; (V)[(pos) + 3] = _q[3]; } while (0)
#define PG8_LDA(dst, b, h) do { if constexpr (Epi::FP8) { _Pragma("unroll") for (int m = 0; m < 4; ++m) { PG8_INS4(At8, 8 * m, PG8_LD16(PG8_SA(b, h) + aoff + m * 2048)); PG8_INS4(At8, 8 * m + 4, PG8_LD16(PG8_SA(b, h) + aoff + m * 2048 + 1024)); } } \
        else { _Pragma("unroll") for (int m = 0; m < 4; ++m) _Pragma("unroll") for (int k = 0; k < 2; ++k) dst[m][k] = *(const PG8_LAS bf16x8*)(lds + PG8_SA(b, h) + aoff + m * 2048 + k * 1024); } } while (0)
#define PG8_LDB(dst, b, h) do { if constexpr (Epi::FP8) { _Pragma("unroll") for (int n = 0; n < 2; ++n) { PG8_INS4(Bq8, 16 * (h) + 8 * n, PG8_LD16(PG8_SB(b, h) - 4 * HTB + boff + n * 2048)); PG8_INS4(Bq8, 16 * (h) + 8 * n + 4, PG8_LD16(PG8_SB(b, h) - 4 * HTB + boff + n * 2048 + 1024)); } } \
        else { _Pragma("unroll") for (int n = 0; n < 2; ++n) _Pragma("unroll") for (int k = 0; k < 2; ++k) dst[n][k] = *(const PG8_LAS bf16x8*)(lds + boff + (PG8_SB(b, h) - 4 * HTB + n * 2048 + k * 1024)); } } while (0)
#define PG8_SUB8(V, p) (v8i{(V)[(p)], (V)[(p) + 1], (V)[(p) + 2], (V)[(p) + 3], (V)[(p) + 4], (V)[(p) + 5], (V)[(p) + 6], (V)[(p) + 7]})
#define PG8_MMA(ai, bj, At, Bt) do { __builtin_amdgcn_s_setprio(1); _Pragma("unroll") for (int m = 0; m < 4; ++m) _Pragma("unroll") for (int n = 0; n < 2; ++n) { \
        if constexpr (Epi::FP8) { acc[ai][bj][m][n] = __builtin_amdgcn_mfma_scale_f32_16x16x128_f8f6f4(PG8_SUB8(Bq8, 16 * (bj) + 8 * n), PG8_SUB8(At8, 8 * m), acc[ai][bj][m][n], 0, 0, 0, 0, 0, 0); } \
        else { _Pragma("unroll") for (int k = 0; k < 2; ++k) acc[ai][bj][m][n] = __builtin_amdgcn_mfma_f32_16x16x32_bf16(Bt[n][k], At[m][k], acc[ai][bj][m][n], 0, 0, 0); } } \
        __builtin_amdgcn_s_setprio(0); } while (0)
#define PG8_WAIT_V(n) asm volatile("s_waitcnt vmcnt(" #n ")" ::: "memory")
#define PG8_WAIT_L(n) asm volatile("s_waitcnt lgkmcnt(" #n ")" ::: "memory")
#define PG8_BAR __builtin_amdgcn_s_barrier()
#define PG8_SCHED __builtin_amdgcn_sched_barrier(0)
    Unit cur, nxt; int ui = 0;
    if (!S.next(0, cur)) return;
    f32x4 acc[2][2][4][2];
#pragma unroll
    for (int a = 0; a < 2; ++a)
#pragma unroll
        for (int b = 0; b < 2; ++b)
#pragma unroll
            for (int m = 0; m < 4; ++m)
#pragma unroll
                for (int n = 0; n < 2; ++n) acc[a][b][m][n] = (f32x4){0.f, 0.f, 0.f, 0.f};
    bf16x8 At[4][2], B0[2][2], B1[2][2];
    v32i At8, Bq8;
    const char* cA = uni_ptr(S.a_base(cur)); const char* cB = uni_ptr(S.b_base(cur));
    if constexpr (Sched::WAIT) S.a_ready(cur, wid);
    unsigned cgo[2][2];
#define PG8_GSLOT ((PG8_LAS u32x4*)(lds + GATHER_SLOT_OFF) + fresh_tid(wid))
    if constexpr (Sched::GATHER) {
#pragma unroll
        for (int h = 0; h < 2; ++h)
#pragma unroll
            for (int i = 0; i < 2; ++i) cgo[h][i] = PG8_GOFF(cur, h, i);
    }
    PG8_STAGE(PG8_SB(0, 0), cB, voffB); PG8_STAGE(PG8_SB(0, 1), cB + hstep, voffB); PG8_STAGE_A(PG8_SA(0, 0), cA, 0, cgo); PG8_STAGE_A(PG8_SA(0, 1), cA, 1, cgo);
    if (wr == 1) PG8_BAR;
    PG8_WAIT_V(2); PG8_BAR;
    PG8_STAGE(PG8_SB(1, 0), cB + kstep, voffB); PG8_STAGE_A(PG8_SA(1, 0), cA + kstep, 0, cgo); PG8_STAGE(PG8_SB(1, 1), cB + hstep + kstep, voffB);
    PG8_WAIT_V(6); PG8_BAR;
    for (;;) {
        const bool has_next = S.next(ui + 1, nxt);
        const char* nA = uni_ptr(has_next ? S.a_base(nxt) : cA); const char* nB = uni_ptr(has_next ? S.b_base(nxt) : cB);
        if constexpr (Sched::GATHER) {
            u32x4 nx = (u32x4){cgo[0][0], cgo[0][1], cgo[1][0], cgo[1][1]};
            if (has_next) { nx.x = PG8_GOFF(nxt, 0, 0); nx.y = PG8_GOFF(nxt, 0, 1); nx.z = PG8_GOFF(nxt, 1, 0); nx.w = PG8_GOFF(nxt, 1, 1); }
            *PG8_GSLOT = nx;
        }
#pragma nounroll
        for (int t = 0; t < nt; t += 2) {
            const bool last = (t == nt - 2);
            if constexpr (Sched::WAIT) { if (last && has_next) S.a_ready(nxt, wid); }
            if constexpr (Epi::MIDK) { if (t == (nt >> 1)) { const int tl = fresh_tid(wid); E.mid(acc, cur, wr, wc, tl & 15, (tl >> 4) & 3); } }
            const char* a1 = cA + (size_t)(t + 1) * kstep;
            const char* a2 = last ? nA : cA + (size_t)(t + 2) * kstep; const char* b2 = last ? nB : cB + (size_t)(t + 2) * kstep;
            const char* a3 = a2 + kstep; const char* b3 = b2 + kstep;
            unsigned xgo[2][2];
            if constexpr (Sched::GATHER) {
                if (last) { const u32x4 nx = *PG8_GSLOT; xgo[0][0] = nx.x; xgo[0][1] = nx.y; xgo[1][0] = nx.z; xgo[1][1] = nx.w; }
                else { xgo[0][0] = cgo[0][0]; xgo[0][1] = cgo[0][1]; xgo[1][0] = cgo[1][0]; xgo[1][1] = cgo[1][1]; }
            }
            PG8_LDB(B0, 0, 0); PG8_LDB(B1, 0, 1); PG8_SCHED; PG8_LDA(At, 0, 0); PG8_STAGE_A(PG8_SA(1, 1), a1, 1, cgo);
            PG8_WAIT_V(8); PG8_WAIT_L(0); PG8_BAR; PG8_MMA(0, 0, At, B0); PG8_MMA(0, 1, At, B1); PG8_BAR; PG8_SCHED;
            PG8_LDA(At, 0, 1); PG8_STAGE(PG8_SB(0, 0), b2, voffB); PG8_STAGE(PG8_SB(0, 1), b2 + hstep, voffB); PG8_STAGE_A(PG8_SA(0, 0), a2, 0, xgo);
            PG8_WAIT_V(8); PG8_WAIT_L(0); PG8_BAR; if (!Sched::HALF || !cur.half) { PG8_MMA(1, 0, At, B0); PG8_MMA(1, 1, At, B1); } PG8_BAR; PG8_SCHED;
            PG8_LDB(B0, 1, 0); PG8_LDB(B1, 1, 1); PG8_SCHED; PG8_LDA(At, 1, 0); PG8_STAGE_A(PG8_SA(0, 1), a2, 1, xgo);
            PG8_WAIT_V(8); PG8_WAIT_L(0); PG8_BAR; PG8_MMA(0, 0, At, B0); PG8_MMA(0, 1, At, B1); PG8_BAR; PG8_SCHED;
            PG8_LDA(At, 1, 1); PG8_STAGE(PG8_SB(1, 0), b3, voffB); PG8_STAGE(PG8_SB(1, 1), b3 + hstep, voffB); PG8_STAGE_A(PG8_SA(1, 0), a3, 0, xgo);
            PG8_WAIT_V(8); PG8_WAIT_L(0); PG8_BAR; if (!Sched::HALF || !cur.half) { PG8_MMA(1, 0, At, B0); PG8_MMA(1, 1, At, B1); } PG8_BAR; PG8_SCHED;
        }
        if (wr == 0) PG8_BAR;
        { const int tl = fresh_tid(wid); E(acc, cur, wr, wc, tl & 15, (tl >> 4) & 3); }
        if (!has_next) break;
#pragma unroll
        for (int a = 0; a < 2; ++a)
#pragma unroll
            for (int b = 0; b < 2; ++b)
#pragma unroll
                for (int m = 0; m < 4; ++m)
#pragma unroll
                    for (int n = 0; n < 2; ++n) acc[a][b][m][n] = (f32x4){0.f, 0.f, 0.f, 0.f};
        cur = nxt; cA = nA; cB = nB; ++ui;
        if constexpr (Sched::GATHER) { const u32x4 nx = *PG8_GSLOT; cgo[0][0] = nx.x; cgo[0][1] = nx.y; cgo[1][0] = nx.z; cgo[1][1] = nx.w; }
        if (wr == 1) PG8_BAR;
    }
    PG8_WAIT_V(0);
    PG8_BAR;
#undef PG8_SA
#undef PG8_SB
#undef PG8_STAGE
#undef PG8_STAGE_A
#undef PG8_GOFF
#undef PG8_GSLOT
#undef PG8_LDA
#undef PG8_LDB
#undef PG8_MMA
#undef PG8_WAIT_V
#undef PG8_WAIT_L
#undef PG8_BAR
#undef PG8_SCHED
}
}
constexpr int NWAVES = 8, NTHR = 512;
constexpr int SEQ = 8192, DM = 2048, NIN = 9216, HYW = 1024, SGW = 1024, NHY = 3072, NEXP = 16, DEXP = 512, DEPTH = 2;
constexpr float EPS = 1e-6f;
constexpr size_t MiB = 1u << 20;
constexpr size_t WS_CTL = 0, CTL_ZERO_BYTES = 1 * MiB;
constexpr size_t WS_WIN = 1 * MiB;
constexpr size_t WS_WIN2 = WS_WIN + 36 * MiB;
constexpr size_t WS_PT = WS_WIN2 + 36 * MiB;
constexpr size_t WS_WOT = WS_PT + 8 * MiB;
constexpr size_t WS_WGU = WS_WOT + 8 * MiB;
constexpr size_t WS_WD = WS_WGU + 64 * MiB;
constexpr size_t WS_W3T = WS_WD + 32 * MiB;
constexpr size_t WS_A2 = WS_W3T + 1 * MiB;
constexpr size_t WS_WR = WS_A2 + 2 * MiB;
constexpr size_t WS_LISTS = WS_WR + 1 * MiB;
constexpr size_t WS_XR = WS_LISTS + 2 * MiB;
constexpr size_t WS_XN = WS_XR + 64 * MiB;
constexpr size_t WS_ZT = WS_XN + 32 * MiB;
constexpr size_t WS_U = WS_ZT + 48 * MiB;
constexpr size_t WS_GV = WS_U + 16 * MiB;
constexpr size_t WS_GH = WS_GV + 16 * MiB;
constexpr size_t WS_GS = WS_GH + 32 * MiB;
constexpr size_t WS_Y = WS_GS + 32 * MiB;
constexpr size_t WS_FS = WS_Y + 32 * MiB;
constexpr size_t WS_END = WS_FS + 64 * MiB;
constexpr size_t WS_MERGED = WS_ZT, WS_ACT = WS_U, WS_MOEOUT = WS_FS;
constexpr size_t WS_XN8 = WS_END;
constexpr size_t WS_WIN8 = WS_XN8 + 16 * MiB;
constexpr int CW_TMO = 0;
constexpr int CW_CNT = 8192;
constexpr int CW_BAR = 4096;
constexpr int CW_ZT = 32768;
constexpr int CW_UG = 36864;
constexpr int CW_MG = 49152;
constexpr int CW_XR = 53248;
constexpr int CW_SGUQ = 45056;
constexpr int CW_PANEL = 16384;
constexpr int SCRATCH_BYTES = 2 * 8448 * 8;
constexpr int MISC_OFF = SCRATCH_BYTES;
constexpr int CVS_OFF = MISC_OFF + 1024;
constexpr int LDS_BYTES = SCRATCH_BYTES + 1024 + 8 * 2304;
static_assert(pg8::GATHER_SLOT_OFF == MISC_OFF + 1024, "gather slots");
static_assert(SCRATCH_BYTES >= pg8::STAGE_BYTES, "lds");

#define GAS __attribute__((address_space(1)))
#define LAS __attribute__((address_space(3)))
typedef unsigned short bf16;
typedef unsigned v4u __attribute__((ext_vector_type(4)));
typedef unsigned v2u __attribute__((ext_vector_type(2)));
typedef float f32x4 __attribute__((ext_vector_type(4)));
typedef short bf16x8 __attribute__((ext_vector_type(8)));
typedef GAS unsigned gu32;
#define RLX_AGENT __ATOMIC_RELAXED, __HIP_MEMORY_SCOPE_AGENT
#define LDS_WAIT() asm volatile("s_waitcnt lgkmcnt(0)" ::: "memory")
#define VM_WAIT() asm volatile("s_waitcnt vmcnt(0)" ::: "memory")
__device__ __forceinline__ unsigned f2bf(float f) { unsigned u = __builtin_bit_cast(unsigned, f); return (u + 0x7fffu + ((u >> 16) & 1u)) >> 16; }
__device__ __forceinline__ unsigned pk2(float lo, float hi) { return f2bf(lo) | (f2bf(hi) << 16); }
__device__ __forceinline__ unsigned pk2h(float lo, float hi) { unsigned r; asm("v_cvt_pk_bf16_f32 %0, %1, %2" : "=v"(r) : "v"(lo), "v"(hi)); return r; }
__device__ __forceinline__ float bfl(unsigned u) { return __builtin_bit_cast(float, u << 16); }
__device__ __forceinline__ float bfh(unsigned u) { return __builtin_bit_cast(float, u & 0xffff0000u); }

#define XB_TMO      128
#define XB_XCNT(j)  (256  + 64 * (j))
#define XB_XSUB(j)  (1280 + 64 * (j))
#define XB_XGEN(j)  (2304 + 64 * (j))
#define XB_TOP      3328
#define XB_TOPGEN   3392
#define XCD_BAR_WORDS 3456
#define XB_SPIN_CAP (1u << 18)
__device__ __forceinline__ unsigned xb_ld(unsigned* p)              { return __hip_atomic_load(p, __ATOMIC_RELAXED, __HIP_MEMORY_SCOPE_AGENT); }
__device__ __forceinline__ unsigned xb_add(unsigned* p, unsigned v) { return __hip_atomic_fetch_add(p, v, __ATOMIC_RELAXED, __HIP_MEMORY_SCOPE_AGENT); }
__device__ __forceinline__ unsigned xb_xcc_id() { return (unsigned)__builtin_amdgcn_s_getreg((3 << 11) | 20) & 0xFu; }
#define XB_SPIN(cond, bar) do { unsigned _sp = 0; while (cond) { __builtin_amdgcn_s_sleep(1); \
    if ((++_sp & 255u) == 0u) { if (xb_ld(&(bar)[XB_TMO])) break; if (_sp > XB_SPIN_CAP) { atomicAdd(&(bar)[XB_TMO], 1u); break; } } } } while (0)
struct XcdBarrier { unsigned* bar; unsigned x; volatile LAS unsigned* st; };
__device__ __forceinline__ XcdBarrier xcd_barrier_post(unsigned* bar, volatile LAS unsigned* st) {
    XcdBarrier b; b.bar = bar; b.x = xb_xcc_id(); b.st = st;
    if (threadIdx.x == 0) (void)xb_add(&bar[XB_XCNT(b.x)], 1u);
    return b;
}
__device__ __forceinline__ void xcd_barrier_complete(unsigned* bar, unsigned x, unsigned& nloc, unsigned& nx) {
    const unsigned G = gridDim.x * gridDim.y * gridDim.z;
    unsigned sum, cnt, mine, sp = 0u;
    for (;;) {
        sum = 0u; cnt = 0u; mine = 0u;
#pragma unroll
        for (unsigned j = 0; j < 16; ++j) { const unsigned c = xb_ld(&bar[XB_XCNT(j)]); sum += c; cnt += (c > 0u) ? 1u : 0u; mine = (j == x) ? c : mine; }
        if (sum == G) break;
        __builtin_amdgcn_s_sleep(1);
        if ((++sp & 255u) == 0u) { if (xb_ld(&bar[XB_TMO])) break; if (sp > XB_SPIN_CAP) { atomicAdd(&bar[XB_TMO], 1u); break; } }
    }
    nloc = mine > 0u ? mine : 1u; nx = cnt > 0u ? cnt : 1u;
}
__device__ __forceinline__ void xcd_barrier(const XcdBarrier& b) {
    asm volatile("s_waitcnt vmcnt(0)" ::: "memory");
    __syncthreads();
    if (threadIdx.x == 0) {
        unsigned* bar = b.bar;
        __builtin_amdgcn_s_waitcnt(0);
        unsigned nloc = b.st[0], nx = b.st[1];
        if (nloc == 0u) { xcd_barrier_complete(bar, b.x, nloc, nx); b.st[0] = nloc; b.st[1] = nx; }
        const unsigned old = xb_add(&bar[XB_XSUB(b.x)], 1u);
        const unsigned gen = old / nloc;
        if (old + 1u == (gen + 1u) * nloc) {
            __builtin_amdgcn_fence(__ATOMIC_RELEASE, "agent");
            asm volatile("s_waitcnt vmcnt(0)" ::: "memory");
            const unsigned og = xb_add(&bar[XB_TOP], 1u);
            const unsigned tg = og / nx;
            if (og + 1u == (tg + 1u) * nx) xb_add(&bar[XB_TOPGEN], 1u);
            else XB_SPIN(xb_ld(&bar[XB_TOPGEN]) == tg, bar);
            __builtin_amdgcn_fence(__ATOMIC_ACQUIRE, "agent");
            xb_add(&bar[XB_XGEN(b.x)], 1u);
            asm volatile("s_waitcnt vmcnt(0)" ::: "memory");
        } else {
            XB_SPIN(xb_ld(&bar[XB_XGEN(b.x)]) == gen, bar);
            __builtin_amdgcn_fence(__ATOMIC_ACQUIRE, "agent");
            asm volatile("s_waitcnt vmcnt(0)" ::: "memory");
        }
    }
    __syncthreads();
}

struct Frame {
    LAS unsigned char* lds;
    volatile LAS unsigned* MISC;
    gu32* ctl;
    int tid, lane, wave;
    int vcu, G;
    const LAS unsigned long long* inp;
    float* out;
    unsigned char* ws;
};
enum { I_X = 0, I_GMIX, I_WIN, I_BIN, I_CONVW, I_CONVB, I_FW1, I_FB1, I_FW2, I_FB2, I_FW3, I_FFREQ, I_SKIP, I_LNG, I_LNB, I_SGW, I_SGB, I_WHY, I_WSG, I_WOUT, I_GFFN, I_WRG, I_BRG, I_WRE, I_BRE, I_WGATE, I_WUP, I_WDOWN, I_GFINAL };

__device__ __forceinline__ const float* inp(const Frame& F, int k) { const unsigned long long v = F.inp[k]; const unsigned lo = __builtin_amdgcn_readfirstlane((unsigned)v), hi = __builtin_amdgcn_readfirstlane((unsigned)(v >> 32));
    return (const float*)(((unsigned long long)hi << 32) | (unsigned long long)lo); }
__device__ __forceinline__ void wait_ge(gu32* p, unsigned need, gu32* tmo) {
    unsigned polls = 0;
    while ((unsigned)__builtin_amdgcn_readfirstlane(__hip_atomic_load(p, RLX_AGENT)) < need) {
        if (++polls > (1u << 22)) { if ((threadIdx.x & 63) == 0) __hip_atomic_store(tmo, 1u, RLX_AGENT); break; }
        __builtin_amdgcn_s_sleep(2); }
}
__device__ __forceinline__ float shfl_xor_l(float v, int mask, int lane) { return __builtin_bit_cast(float, __builtin_amdgcn_ds_bpermute((lane ^ mask) << 2, __builtin_bit_cast(int, v))); }
__device__ __forceinline__ float shfl_down1_l(float v, int lane) { return __builtin_bit_cast(float, __builtin_amdgcn_ds_bpermute(((lane + 1) & 63) << 2, __builtin_bit_cast(int, v))); }
__device__ __forceinline__ float wave_sum(float v, int lane) {
#pragma unroll
    for (int o = 1; o < 64; o <<= 1) v += shfl_xor_l(v, o, lane);
    return v;
}

#ifndef PROBE_K
#define PROBE_K -1
#endif
#ifndef PROBE_BLK
#define PROBE_BLK 0
#endif
#define HP_ME (blockIdx.x == PROBE_BLK && threadIdx.x == 0)
#define HPS(j) do { if (PROBE_K == (j) && HP_ME) ((volatile LAS unsigned long long*)(F.lds + MISC_OFF + 512))[0] = __builtin_amdgcn_s_memrealtime(); } while (0)
#define HPE(j) do { if (PROBE_K == (j) && HP_ME) { volatile LAS unsigned long long* _p = (volatile LAS unsigned long long*)(F.lds + MISC_OFF + 512); _p[1] += __builtin_amdgcn_s_memrealtime() - _p[0]; } } while (0)
#define HD __device__ __forceinline__
#define HY_OPAQUE(x) asm volatile("" : "+v"(x))
typedef float hy_f2v __attribute__((ext_vector_type(2)));
#define LDC(p, i) ({ const hy_f2v _v = *(const LAS hy_f2v*)((p) + (i)); c32 _r; _r.x = _v.x; _r.y = _v.y; _r; })
#define STC(p, i, v) do { const c32 _s = (v); hy_f2v _w; _w.x = _s.x; _w.y = _s.y; *(LAS hy_f2v*)((p) + (i)) = _w; } while (0)
#define FADD(a, b) ({ float _r; asm("v_add_f32 %0, %1, %2" : "=v"(_r) : "v"((float)(a)), "v"((float)(b))); _r; })
#define FSUB(a, b) ({ float _r; asm("v_sub_f32 %0, %1, %2" : "=v"(_r) : "v"((float)(a)), "v"((float)(b))); _r; })
#define FMUL(a, b) ({ float _r; asm("v_mul_f32 %0, %1, %2" : "=v"(_r) : "v"((float)(a)), "v"((float)(b))); _r; })
#define FFMA(a, b, c) ({ float _r; asm("v_fma_f32 %0, %1, %2, %3" : "=v"(_r) : "v"((float)(a)), "v"((float)(b)), "v"((float)(c))); _r; })
#define FNMA(a, b, c) ({ float _r; asm("v_fma_f32 %0, -%1, %2, %3" : "=v"(_r) : "v"((float)(a)), "v"((float)(b)), "v"((float)(c))); _r; })
struct c32 { float x, y; };
HD c32 cmk(float x, float y) { c32 r; r.x = x; r.y = y; return r; }
HD c32 cadd(c32 a, c32 b) { return cmk(FADD(a.x, b.x), FADD(a.y, b.y)); }
HD c32 csub(c32 a, c32 b) { return cmk(FSUB(a.x, b.x), FSUB(a.y, b.y)); }
HD c32 cmul(c32 a, c32 b) { return cmk(FNMA(a.y, b.y, FMUL(a.x, b.x)), FFMA(a.y, b.x, FMUL(a.x, b.y))); }
HD c32 cmulc(c32 a, c32 b) { return cmk(FFMA(a.y, b.y, FMUL(a.x, b.x)), FNMA(a.x, b.y, FMUL(a.y, b.x))); }
HD c32 cscale(c32 a, float f) { return cmk(FMUL(a.x, f), FMUL(a.y, f)); }
HD c32 cadd_mi(c32 a, c32 b) { return cmk(FADD(a.x, b.y), FSUB(a.y, b.x)); }
HD c32 cadd_pi(c32 a, c32 b) { return cmk(FSUB(a.x, b.y), FADD(a.y, b.x)); }
#define HY_N 8192
#define HY_LDS_C32 (8192 + 256)

template <int SIGN> HD void dft4(c32& a, c32& b, c32& c, c32& d) {
    const c32 t0 = cadd(a, c), t1 = csub(a, c), t2 = cadd(b, d), t3 = csub(b, d);
    a = cadd(t0, t2); c = csub(t0, t2);
    if (SIGN < 0) { b = cadd_mi(t1, t3); d = cadd_pi(t1, t3); }
    else          { b = cadd_pi(t1, t3); d = cadd_mi(t1, t3); }
}
template <int SIGN> HD void dft16(c32 (&a)[16]) {
    const float C1 = 0.92387953251128674f, S1 = 0.38268343236508977f, R2 = 0.70710678118654752f;
#pragma unroll
    for (int n2 = 0; n2 < 4; ++n2) dft4<SIGN>(a[n2], a[4 + n2], a[8 + n2], a[12 + n2]);
    const float sg = (SIGN < 0) ? -1.f : 1.f;
    const c32 w1 = cmk(C1, sg * S1), w2 = cmk(R2, sg * R2), w3 = cmk(S1, sg * C1), w6 = cmk(-R2, sg * R2), w9 = cmk(-C1, -sg * S1);
    a[1 + 4] = cmul(a[1 + 4], w1); a[2 + 4] = cmul(a[2 + 4], w2); a[3 + 4] = cmul(a[3 + 4], w3);
    a[1 + 8] = cmul(a[1 + 8], w2); a[2 + 8] = (SIGN < 0) ? cmk(a[2 + 8].y, -a[2 + 8].x) : cmk(-a[2 + 8].y, a[2 + 8].x); a[3 + 8] = cmul(a[3 + 8], w6);
    a[1 + 12] = cmul(a[1 + 12], w3); a[2 + 12] = cmul(a[2 + 12], w6); a[3 + 12] = cmul(a[3 + 12], w9);
#pragma unroll
    for (int k1 = 0; k1 < 4; ++k1) dft4<SIGN>(a[4 * k1], a[4 * k1 + 1], a[4 * k1 + 2], a[4 * k1 + 3]);
    c32 t[16];
#pragma unroll
    for (int i = 0; i < 16; ++i) t[i] = a[i];
#pragma unroll
    for (int k1 = 0; k1 < 4; ++k1)
#pragma unroll
        for (int k2 = 0; k2 < 4; ++k2) a[k1 + 4 * k2] = t[4 * k1 + k2];
}
HD void twiddle_tree(c32 (&a)[16], c32 w1) {
    const c32 w2 = cmul(w1, w1), w3 = cmul(w2, w1), w4 = cmul(w2, w2), w5 = cmul(w4, w1), w6 = cmul(w4, w2), w7 = cmul(w4, w3), w8 = cmul(w4, w4);
    a[1] = cmul(a[1], w1); a[2] = cmul(a[2], w2); a[3] = cmul(a[3], w3); a[4] = cmul(a[4], w4); a[5] = cmul(a[5], w5); a[6] = cmul(a[6], w6); a[7] = cmul(a[7], w7); a[8] = cmul(a[8], w8);
    a[9] = cmul(a[9], cmul(w8, w1)); a[10] = cmul(a[10], cmul(w8, w2)); a[11] = cmul(a[11], cmul(w8, w3)); a[12] = cmul(a[12], cmul(w8, w4));
    a[13] = cmul(a[13], cmul(w8, w5)); a[14] = cmul(a[14], cmul(w8, w6)); a[15] = cmul(a[15], cmul(w8, w7));
}
HD c32 cis_pi(float x) { return cmk(cospif(x), sinpif(x)); }

HD void fft_s1_fwd(int tid, LAS c32* buf, c32 (&a)[16], c32 w1) { HY_OPAQUE(tid); HY_OPAQUE(w1.x); HY_OPAQUE(w1.y);
    dft16<-1>(a);
    twiddle_tree(a, w1);
    LAS c32* p0 = buf + tid + (tid >> 5);
#pragma unroll
    for (int p = 0; p < 16; ++p) STC(p0, 528 * p, a[p]);
}
HD void fft_s2_fwd(int tid, LAS c32* buf, c32 w2) { HY_OPAQUE(tid); HY_OPAQUE(w2.x); HY_OPAQUE(w2.y);
    LAS c32* p0 = buf + (tid >> 5) * 528 + (tid & 31);
    c32 a[16];
#pragma unroll
    for (int q = 0; q < 16; ++q) a[q] = LDC(p0, 33 * q);
    dft16<-1>(a);
    twiddle_tree(a, w2);
#pragma unroll
    for (int p = 0; p < 16; ++p) STC(p0, 33 * p, a[p]);
}
HD float w32c(int q) { switch (q) { case 0: return 1.0f; case 1: return 0.98078528040323043f; case 2: return 0.92387953251128674f; case 3: return 0.83146961230254524f; case 4: return 0.70710678118654752f; case 5: return 0.55557023301960218f; case 6: return 0.38268343236508977f; case 7: return 0.19509032201612825f;
    case 8: return 0.0f; case 9: return -0.19509032201612825f; case 10: return -0.38268343236508977f; case 11: return -0.55557023301960218f; case 12: return -0.70710678118654752f; case 13: return -0.83146961230254524f; case 14: return -0.92387953251128674f; default: return -0.98078528040323043f; } }
HD float w32s(int q) { switch (q) { case 0: return 0.0f; case 1: return 0.19509032201612825f; case 2: return 0.38268343236508977f; case 3: return 0.55557023301960218f; case 4: return 0.70710678118654752f; case 5: return 0.83146961230254524f; case 6: return 0.92387953251128674f; case 7: return 0.98078528040323043f;
    case 8: return 1.0f; case 9: return 0.98078528040323043f; case 10: return 0.92387953251128674f; case 11: return 0.83146961230254524f; case 12: return 0.70710678118654752f; case 13: return 0.55557023301960218f; case 14: return 0.38268343236508977f; default: return 0.19509032201612825f; } }
template <int SIGN> HD void fft_s3_read(int tid, const LAS c32* buf, c32 (&s)[16]) { HY_OPAQUE(tid);
    const LAS c32* p0 = buf + (tid >> 1) * 33; const int h = tid & 1;
    const float sg = (SIGN < 0) ? -1.f : 1.f, hs = h ? -1.f : 1.f;
#pragma unroll
    for (int q = 0; q < 16; ++q) {
        const c32 u = LDC(p0, q), v = LDC(p0, q + 16);
        const c32 d = cmk(FFMA(v.x, hs, u.x), FFMA(v.y, hs, u.y));
        const c32 w = h ? cmk(w32c(q), sg * w32s(q)) : cmk(1.f, 0.f);
        s[q] = (q == 0) ? d : cmul(d, w);
    }
    dft16<SIGN>(s);
}
HD void fft_s3_write(int tid, LAS c32* buf, const c32 (&s)[16]) { HY_OPAQUE(tid);
    LAS c32* p0 = buf + (tid >> 1) * 33 + (tid & 1);
#pragma unroll
    for (int p = 0; p < 16; ++p) STC(p0, 2 * p, s[p]);
}
HD void fft_s2_inv(int tid, LAS c32* buf, c32 w2) { HY_OPAQUE(tid); HY_OPAQUE(w2.x); HY_OPAQUE(w2.y);
    LAS c32* p0 = buf + (tid >> 5) * 528 + (tid & 31);
    c32 a[16];
#pragma unroll
    for (int q = 0; q < 16; ++q) a[q] = LDC(p0, 33 * q);
    twiddle_tree(a, cmk(w2.x, -w2.y));
    dft16<1>(a);
#pragma unroll
    for (int p = 0; p < 16; ++p) STC(p0, 33 * p, a[p]);
}
HD void fft_s1_inv(int tid, const LAS c32* buf, c32 (&a)[16], c32 w1) { HY_OPAQUE(tid); HY_OPAQUE(w1.x); HY_OPAQUE(w1.y);
    const LAS c32* p0 = buf + tid + (tid >> 5);
#pragma unroll
    for (int p = 0; p < 16; ++p) a[p] = LDC(p0, 528 * p);
    twiddle_tree(a, cmk(w1.x, -w1.y));
    dft16<1>(a);
}
HD void pair_pass(int tid, LAS c32* Z, const LAS c32* H, c32 wp3, c32 wlow) { HY_OPAQUE(tid); HY_OPAQUE(wp3.x); HY_OPAQUE(wp3.y); HY_OPAQUE(wlow.x); HY_OPAQUE(wlow.y);
    const int p3 = tid & 31;
    const c32 wstep = cmk(0.99998117528260111f, -0.0061358846491544753f);
#pragma unroll 1
    for (int it = 0; it < 9; ++it) {
        const int low = it * 16 + (tid >> 5);
        const c32 Wk = cmul(wlow, wp3);
        wlow = cmul(wlow, wstep);
        if (low > 128) continue;
        bool act = true; int p3b = 31 - p3, lowb = 256 - low;
        if (low == 0) { act = p3 <= 16; p3b = (32 - p3) & 31; lowb = 0; }
        else if (low == 128) { act = p3 <= 15; lowb = 128; }
        if (!act) continue;
        const int pa = (low & 15) * 528 + (low >> 4) * 33 + p3, pb = (lowb & 15) * 528 + (lowb >> 4) * 33 + p3b;
        const c32 A = LDC(Z, pa), B = LDC(Z, pb), HA = LDC(H, pa), HB = LDC(H, pb);
        c32 E = cmk(FMUL(FADD(A.x, B.x), 0.5f), FMUL(FSUB(A.y, B.y), 0.5f)), O = cmk(FMUL(FADD(A.y, B.y), 0.5f), FMUL(FSUB(B.x, A.x), 0.5f));
        c32 T = cmul(Wk, O);
        const c32 X = cadd(E, T), Xm = csub(E, T);
        E = cmk(FMUL(FADD(HA.x, HB.x), 0.5f), FMUL(FSUB(HA.y, HB.y), 0.5f)); O = cmk(FMUL(FADD(HA.y, HB.y), 0.5f), FMUL(FSUB(HB.x, HA.x), 0.5f));
        T = cmul(Wk, O);
        const c32 Hk = cadd(E, T), Hm = csub(E, T);
        const c32 Y = cmul(X, Hk), Ypc = cmul(Xm, Hm);
        const float sc = 0.5f / 8192.0f;
        const c32 Ye = cscale(cadd(Y, Ypc), sc), Yd = cscale(csub(Y, Ypc), sc);
        const c32 Yo = cmulc(Yd, Wk);
        STC(Z, pa, cmk(FSUB(Ye.x, Yo.y), FADD(Ye.y, Yo.x)));
        if (pb != pa) STC(Z, pb, cmk(FADD(Ye.x, Yo.y), FSUB(Yo.x, Ye.y)));
    }
}
HD float bf_lo(unsigned u) { unsigned v = u << 16; return __builtin_bit_cast(float, v); }
HD float bf_hi(unsigned u) { unsigned v = u & 0xffff0000u; return __builtin_bit_cast(float, v); }
HD void hy_conv3_load(int tid, const unsigned* zrow, float c0, float c1, float c2, float cb, c32 (&out)[8]) { HY_OPAQUE(tid);
    unsigned wm[8], wl[8], wr[8];
#pragma unroll
    for (int q = 0; q < 8; ++q) { const int m = tid + 512 * q; wm[q] = zrow[m]; wl[q] = (m > 0) ? zrow[m - 1] : 0u; wr[q] = (m < 4095) ? zrow[m + 1] : 0u; }
#pragma unroll
    for (int q = 0; q < 8; ++q) {
        const float zm1 = bf_hi(wl[q]), z0 = bf_lo(wm[q]), z1 = bf_hi(wm[q]), z2 = bf_lo(wr[q]);
        out[q] = cmk(FFMA(c0, zm1, FFMA(c1, z0, FFMA(c2, z1, cb))), FFMA(c0, z0, FFMA(c1, z1, FFMA(c2, z2, cb))));
    }
}
HD void hy_filter_s1(int tid, LAS c32* buf, const unsigned* zk) { HY_OPAQUE(tid);
    unsigned w[16];
#pragma unroll
    for (int q = 0; q < 16; ++q) w[q] = zk[tid + 512 * q];
    c32 a[16];
#pragma unroll
    for (int q = 0; q < 16; ++q) a[q] = cmk(bf_lo(w[q]), bf_hi(w[q]));
    fft_s1_fwd(tid, buf, a, cmk(1.f, 0.f));
}
HD void hy_data_s1(int tid, LAS c32* buf, const c32 (&v)[8], c32 w1) { HY_OPAQUE(tid);
    c32 a[16];
#pragma unroll
    for (int q = 0; q < 8; ++q) a[q] = v[q];
#pragma unroll
    for (int q = 8; q < 16; ++q) a[q] = cmk(0.f, 0.f);
    fft_s1_fwd(tid, buf, a, w1);
}
HD unsigned hy_bf(float f) { unsigned u = __builtin_bit_cast(unsigned, f); return (u + 0x7fffu + ((u >> 16) & 1u)) >> 16; }
HD void hy_pack_store(unsigned* zk, int dir, int a4, float t0, float t1, float t2, float t3) {
    if (dir == 0) { zk[a4 / 2] = hy_bf(t0) | (hy_bf(t1) << 16); zk[a4 / 2 + 1] = hy_bf(t2) | (hy_bf(t3) << 16); }
    else {
        const int m = 8192 - a4 / 2;
        if (a4 > 0) ((unsigned short*)(zk + m))[0] = (unsigned short)hy_bf(t0);
        zk[m - 1] = hy_bf(t2) | (hy_bf(t1) << 16);
        if (a4 == 8188) zk[m - 2] = hy_bf(t3) << 16; else ((unsigned short*)(zk + m - 2))[1] = (unsigned short)hy_bf(t3);
    }
}
struct CvItem { const float* src; int N; bf16* dst; size_t dld; int f8; };
constexpr int CV_S0 = 32 * 288, CV_S7 = 128, CV_SA = CV_S0 + CV_S7, CV_S1 = 16 * 64, CV_S3 = 32 * 64, CV_S4 = 16 * 32 * 16, CV_S6 = 16 * 8 * 64;
constexpr int CV_NITEMS = CV_SA + 2 * CV_S1 + CV_S3 + 2 * CV_S4 + CV_S6;
__device__ __forceinline__ void cv_decode_layer(Frame& F, int l, int r, CvItem& d) {
    bf16* WIN = (bf16*)(F.ws + ((l & 1) ? WS_WIN2 : WS_WIN)); bf16* PT = (bf16*)(F.ws + WS_PT); bf16* WOT = (bf16*)(F.ws + WS_WOT); bf16* WGU = (bf16*)(F.ws + WS_WGU); bf16* WD = (bf16*)(F.ws + WS_WD);
    bf16* W3T = (bf16*)(F.ws + WS_W3T + (size_t)(l & 1) * 512 * 1024);
    d.f8 = 0;
    if (r < CV_S0) { const int kb = r / 288, nb = r % 288; d.src = inp(F, I_WIN) + (size_t)l * DM * NIN + (size_t)(64 * kb) * NIN + 32 * nb; d.N = NIN;
        if (nb >= 160) { d.dst = (bf16*)(F.ws + WS_WIN8 + (size_t)(l & 1) * 8 * MiB) + (size_t)(32 * nb - 5120) * (DM / 2) + 32 * kb; d.dld = DM / 2; d.f8 = 1; }
        else { d.dst = WIN + (size_t)(32 * nb) * DM + 64 * kb; d.dld = DM; }
        return; } r -= CV_S0;
    if (r < CV_S7) { const int nb = r; d.src = inp(F, I_FW3) + (size_t)l * 64 * 4096 + 32 * nb; d.N = 4096; d.dst = W3T + (size_t)(32 * nb) * 64; d.dld = 64; return; } r -= CV_S7;
    if (r < CV_S1) { const int kb = r / 64, nb = r % 64; d.src = inp(F, I_WHY) + (size_t)l * HYW * DM + (size_t)(64 * kb) * DM + 32 * nb; d.N = DM; d.dst = PT + (size_t)(32 * nb) * DM + 64 * kb; d.dld = DM; return; } r -= CV_S1;
    if (r < CV_S1) { const int kb = r / 64, nb = r % 64; d.src = inp(F, I_WSG) + (size_t)l * SGW * DM + (size_t)(64 * kb) * DM + 32 * nb; d.N = DM; d.dst = PT + (size_t)(32 * nb) * DM + 1024 + 64 * kb; d.dld = DM; return; } r -= CV_S1;
    if (r < CV_S3) { const int kb = r / 64, nb = r % 64; d.src = inp(F, I_WOUT) + (size_t)l * DM * DM + (size_t)(64 * kb) * DM + 32 * nb; d.N = DM; d.dst = WOT + (size_t)(32 * nb) * DM + 64 * kb; d.dld = DM; return; } r -= CV_S3;
    if (r < 2 * CV_S4) { const int up = r / CV_S4; r -= up * CV_S4; const int e = r / 512, q = r % 512, kb = q / 16, nb = q % 16; const int n0 = 32 * nb, drow = 256 * (n0 / 128) + (n0 % 128) + 128 * up;
        d.src = (up ? inp(F, I_WUP) : inp(F, I_WGATE)) + ((size_t)l * NEXP + e) * DM * DEXP + (size_t)(64 * kb) * DEXP + n0; d.N = DEXP; d.dst = WGU + ((size_t)e * 1024 + drow) * (DM / 2) + 32 * kb; d.dld = DM / 2; d.f8 = 1; return; } r -= 2 * CV_S4;
    { const int e = r / 512, q = r % 512, kb = q / 64, nb = q % 64;
        d.src = inp(F, I_WDOWN) + ((size_t)l * NEXP + e) * DEXP * DM + (size_t)(64 * kb) * DM + 32 * nb; d.N = DM; d.dst = WD + ((size_t)e * DM + 32 * nb) * (DEXP / 2) + 32 * kb; d.dld = DEXP / 2; d.f8 = 1; }
}
__device__ __forceinline__ bool cv_decode(Frame& F, int set, int l, int it, CvItem& d) {
    if (set == 0) { if (it >= CV_SA) return false; cv_decode_layer(F, l, it, d); return true; }
    const int n1 = CV_NITEMS - CV_SA, n2 = (l + 1 < DEPTH) ? CV_SA : 0;
    if (it >= n1 + n2) return false;
    if (it < n1) cv_decode_layer(F, l, CV_SA + it, d); else cv_decode_layer(F, l + 1, it - n1, d);
    return true;
}
__device__ __forceinline__ void cv_load(const CvItem& d, int lane, float (&v)[32]) {
    const float* s = d.src + (size_t)(lane >> 3) * d.N + 4 * (lane & 7);
#pragma unroll
    for (int i = 0; i < 8; ++i) { const f32x4 w = *(const GAS f32x4*)(s + (size_t)(8 * i) * d.N); v[4 * i] = w.x; v[4 * i + 1] = w.y; v[4 * i + 2] = w.z; v[4 * i + 3] = w.w; }
}
__device__ __forceinline__ void cv_store(const CvItem& d, int lane, const float (&v)[32], LAS float* scr) {
    const int n = lane >> 1, h = lane & 1, kr = lane >> 3, nq = lane & 7;
#pragma unroll
    for (int s = 0; s < 4; ++s) {
        *(LAS f32x4*)(scr + kr * 36 + 4 * nq) = (f32x4){v[8 * s], v[8 * s + 1], v[8 * s + 2], v[8 * s + 3]};
        *(LAS f32x4*)(scr + (8 + kr) * 36 + 4 * nq) = (f32x4){v[8 * s + 4], v[8 * s + 5], v[8 * s + 6], v[8 * s + 7]};
        LDS_WAIT(); asm volatile("" ::: "memory");
        const LAS float* q = scr + (8 * h) * 36 + n;
        if (d.f8) { int a = __builtin_amdgcn_cvt_pk_fp8_f32(q[0 * 36] * 64.f, q[1 * 36] * 64.f, 0, false); a = __builtin_amdgcn_cvt_pk_fp8_f32(q[2 * 36] * 64.f, q[3 * 36] * 64.f, a, true);
            int b = __builtin_amdgcn_cvt_pk_fp8_f32(q[4 * 36] * 64.f, q[5 * 36] * 64.f, 0, false); b = __builtin_amdgcn_cvt_pk_fp8_f32(q[6 * 36] * 64.f, q[7 * 36] * 64.f, b, true);
            *(GAS v2u*)((char*)d.dst + (size_t)n * d.dld * 2 + 16 * s + 8 * h) = (v2u){(unsigned)a, (unsigned)b}; }
        else { v4u o; o.x = pk2h(q[0 * 36], q[1 * 36]); o.y = pk2h(q[2 * 36], q[3 * 36]); o.z = pk2h(q[4 * 36], q[5 * 36]); o.w = pk2h(q[6 * 36], q[7 * 36]);
            *(GAS v4u*)(d.dst + (size_t)n * d.dld + 16 * s + 8 * h) = o; }
        LDS_WAIT(); asm volatile("" ::: "memory");
    }
}
struct CvPipe { CvItem d; int n, wi, nw, cls, set, l; bool have; };
__device__ __forceinline__ int cv_index(const CvPipe& P) {
    if (P.cls == 0) return P.wi + P.nw * P.n;
    if (P.cls == 1) { const int ch = P.n / 3, j = P.n - 3 * ch; return ch * 4 * P.nw + j * P.nw + P.wi; }
    return P.n * 4 * P.nw + 3 * P.nw + P.wi;
}
#define CV_SCR(F) ((LAS float*)((F).lds + CVS_OFF + (F).wave * 2304))
#define CV_START(F, P, V, SET, L, CLS, WI, NW) do { (P).set = (SET); (P).l = (L); (P).cls = (CLS); (P).nw = (NW); int _wi = (WI); asm volatile("" : "+s"(_wi)); (P).wi = _wi; (P).n = 0; \
        (P).have = cv_decode(F, SET, L, cv_index(P), (P).d); if ((P).have) cv_load((P).d, (F).lane, V); } while (0)
#define CV_STEP(F, P, V) do { if ((P).have) { cv_store((P).d, (F).lane, V, CV_SCR(F)); (P).n += 1; (P).have = cv_decode(F, (P).set, (P).l, cv_index(P), (P).d); if ((P).have) cv_load((P).d, (F).lane, V); } } while (0)
__device__ __forceinline__ void pa_convert(Frame& F, int l) {
    CvPipe P; float va[32];
    CV_START(F, P, va, 0, l, 0, F.vcu * NWAVES + F.wave, F.G * NWAVES);
    while (P.have) CV_STEP(F, P, va);
}
__device__ __forceinline__ void pa_features(Frame& F, int l) {
    LAS float* zf = (LAS float*)(F.lds);
    LAS float* a1 = zf + 8 * 40;
    const float* w1 = inp(F, I_FW1) + l * 33 * 64; const float* b1 = inp(F, I_FB1) + l * 64; const float* w2 = inp(F, I_FW2) + l * 64 * 64; const float* b2 = inp(F, I_FB2) + l * 64; const float* fq = inp(F, I_FFREQ) + l * 64;
    bf16* A2 = (bf16*)(F.ws + WS_A2 + (size_t)l * MiB);
    const int tl = F.tid >> 6, j = F.tid & 63;
    const float fr = fq[j];
    float w1c[33], w2c[64];
#pragma unroll
    for (int i = 0; i < 33; ++i) w1c[i] = w1[i * 64 + j];
#pragma unroll
    for (int i = 0; i < 64; ++i) w2c[i] = w2[i * 64 + j];
    for (int t0 = F.vcu * 8; t0 < SEQ; t0 += F.G * 8) {
        __syncthreads();
        if (F.tid < 8 * 33) { const int tt = F.tid / 33, i = F.tid % 33; const int t = t0 + tt; float v;
            const float w = 6.283185307179586f / (float)SEQ * (float)t;
            if (i == 0) v = (float)t / (float)(SEQ - 1);
            else { const int b = (i - 1) & 15; const float band = 1e-4f + (float)b * ((15.0f - 1e-4f) / 15.0f); const float a = band * w; v = (i <= 16) ? cosf(a) : -sinf(a); }
            zf[tt * 40 + i] = v; }
        __syncthreads();
        float s = b1[j];
#pragma unroll
        for (int i = 0; i < 33; ++i) s += zf[tl * 40 + i] * w1c[i];
        a1[tl * 64 + j] = sinf(fr * s);
        __syncthreads();
        float s2 = b2[j];
#pragma unroll
        for (int i = 0; i < 64; ++i) s2 += a1[tl * 64 + i] * w2c[i];
        A2[(size_t)(t0 + tl) * 64 + j] = (bf16)f2bf(sinf(fr * s2));
    }
    __syncthreads();
}
__device__ __forceinline__ void feat_token(Frame& F, int t, const float (&w1c)[33], const float (&w2c)[64], float b1j, float b2j, float frj, bf16* A2) {
    LAS float* zf = (LAS float*)(F.lds + F.wave * 512);
    LAS float* a1 = zf + 40;
    const int i = F.lane;
    if (i < 33) { float v; const float w = 6.283185307179586f / (float)SEQ * (float)t;
        if (i == 0) v = (float)t / (float)(SEQ - 1);
        else { const int b = (i - 1) & 15; const float band = 1e-4f + (float)b * ((15.0f - 1e-4f) / 15.0f); const float a = band * w; v = (i <= 16) ? cosf(a) : -sinf(a); }
        zf[i] = v; }
    LDS_WAIT(); asm volatile("" ::: "memory");
    float s = b1j;
#pragma unroll
    for (int k = 0; k < 33; ++k) s += zf[k] * w1c[k];
    a1[i] = sinf(frj * s);
    LDS_WAIT(); asm volatile("" ::: "memory");
    float s2 = b2j;
#pragma unroll
    for (int k = 0; k < 64; ++k) s2 += a1[k] * w2c[k];
    A2[(size_t)t * 64 + i] = (bf16)f2bf(sinf(frj * s2));
    LDS_WAIT(); asm volatile("" ::: "memory");
}
__device__ __forceinline__ void pa_convert_features(Frame& F) {
    CvPipe P; float va[32];
    CV_START(F, P, va, 0, 0, 0, F.vcu * NWAVES + F.wave, F.G * NWAVES);
    for (int ll = 0; ll < DEPTH; ++ll) {
        const float* w1 = inp(F, I_FW1) + ll * 33 * 64; const float* w2 = inp(F, I_FW2) + ll * 64 * 64;
        const int j = F.lane;
        const float b1j = (inp(F, I_FB1) + ll * 64)[j], b2j = (inp(F, I_FB2) + ll * 64)[j], frj = (inp(F, I_FFREQ) + ll * 64)[j];
        bf16* A2 = (bf16*)(F.ws + WS_A2 + (size_t)ll * MiB);
        float w1c[33], w2c[64];
#pragma unroll
        for (int i = 0; i < 33; ++i) w1c[i] = w1[i * 64 + j];
#pragma unroll
        for (int i = 0; i < 64; ++i) w2c[i] = w2[i * 64 + j];
        for (int t = F.vcu * NWAVES + F.wave; t < SEQ; t += F.G * NWAVES) { feat_token(F, t, w1c, w2c, b1j, b2j, frj, A2); CV_STEP(F, P, va); }
    }
    while (P.have) CV_STEP(F, P, va);
}
__device__ __forceinline__ void pa_router_t(Frame& F, int l) {
    float* WR = (float*)(F.ws + WS_WR + (size_t)l * 256 * 1024);
    const float* wrg = inp(F, I_WRG) + (size_t)l * DM * 4; const float* wre = inp(F, I_WRE) + (size_t)l * 4 * DM * 4;
    for (int i = F.vcu * NTHR + F.tid; i < 20 * DM; i += F.G * NTHR) { const int o = i / DM, k = i % DM;
        WR[i] = (o < 4) ? wrg[k * 4 + o] : wre[((size_t)((o - 4) >> 2) * DM + k) * 4 + ((o - 4) & 3)]; }
}
__device__ __forceinline__ int moe_off(const gu32* cnt, int e) { int s = 0;
#pragma unroll
    for (int j = 0; j < 16; ++j) { const int c = (int)cnt[64 * j]; s += (j < e) ? c : 0; } return s; }
template <int MODE, bool OUTF, int NR>
__device__ __forceinline__ void norm_rows(Frame& F, int m0, int mstride, const float* xin, const float* g, const gu32* cntprev, float* outf) {
    bf16* XR = (bf16*)(F.ws + WS_XR); bf16* XN = (bf16*)(F.ws + WS_XN);
    f32x4 v[NR][8];
    if (MODE == 0) {
#pragma unroll
        for (int r = 0; r < NR; ++r) { const int m = m0 + r * mstride; const GAS f32x4* xr = (const GAS f32x4*)(xin + (size_t)m * DM) + F.lane;
#pragma unroll
            for (int j = 0; j < 8; ++j) v[r][j] = xr[64 * j]; }
    } else {
        const int* TOKPOS = (const int*)(F.ws + WS_LISTS + 1 * MiB); const bf16* MO = (const bf16*)(F.ws + WS_MOEOUT);
        int slot[NR][2];
#pragma unroll
        for (int r = 0; r < NR; ++r)
#pragma unroll
            for (int k = 0; k < 2; ++k) { const int tp = TOKPOS[(m0 + r * mstride) * 2 + k]; slot[r][k] = moe_off(cntprev, tp >> 13) + (tp & 8191); }
        v2u w[NR][3][8];
#pragma unroll
        for (int r = 0; r < NR; ++r) { const GAS v2u* xr = (const GAS v2u*)(XR + (size_t)(m0 + r * mstride) * DM) + F.lane;
#pragma unroll
            for (int j = 0; j < 8; ++j) w[r][2][j] = xr[64 * j];
#pragma unroll
            for (int k = 0; k < 2; ++k) { const GAS v2u* mr = (const GAS v2u*)(MO + (size_t)slot[r][k] * DM) + F.lane;
#pragma unroll
                for (int j = 0; j < 8; ++j) w[r][k][j] = mr[64 * j]; } }
#pragma unroll
        for (int r = 0; r < NR; ++r) {
#pragma unroll
            for (int j = 0; j < 8; ++j) { const v2u a = w[r][2][j], b = w[r][0][j], c = w[r][1][j];
                v[r][j] = (f32x4){bfl(a.x) + bfl(b.x) + bfl(c.x), bfh(a.x) + bfh(b.x) + bfh(c.x), bfl(a.y) + bfl(b.y) + bfl(c.y), bfh(a.y) + bfh(b.y) + bfh(c.y)}; }
            if (!OUTF) { GAS v2u* xw = (GAS v2u*)(XR + (size_t)(m0 + r * mstride) * DM) + F.lane;
#pragma unroll
                for (int j = 0; j < 8; ++j) { v2u o; o.x = pk2h(v[r][j].x, v[r][j].y); o.y = pk2h(v[r][j].z, v[r][j].w); xw[64 * j] = o; } } }
    }
    const GAS f32x4* gp = (const GAS f32x4*)g + F.lane;
#pragma unroll
    for (int r = 0; r < NR; ++r) { const int m = m0 + r * mstride;
        float ss = 0.f;
#pragma unroll
        for (int j = 0; j < 8; ++j) ss += (v[r][j].x * v[r][j].x + v[r][j].y * v[r][j].y) + (v[r][j].z * v[r][j].z + v[r][j].w * v[r][j].w);
        const float rstd = 1.0f / sqrtf(wave_sum(ss, F.lane) * (1.0f / DM) + EPS);
        if (OUTF) { GAS f32x4* o = (GAS f32x4*)(outf + (size_t)m * DM) + F.lane;
#pragma unroll
            for (int j = 0; j < 8; ++j) { const f32x4 gg = gp[64 * j]; o[64 * j] = v[r][j] * rstd * gg; } }
        else { GAS v2u* o = (GAS v2u*)(XN + (size_t)m * DM) + F.lane; GAS unsigned* o8 = (GAS unsigned*)(F.ws + WS_XN8 + (size_t)m * DM) + F.lane;
#pragma unroll
            for (int j = 0; j < 8; ++j) { const f32x4 gg = gp[64 * j]; const f32x4 rr = v[r][j] * rstd * gg; v2u ww; ww.x = pk2h(rr.x, rr.y); ww.y = pk2h(rr.z, rr.w); o[64 * j] = ww;
                int q = __builtin_amdgcn_cvt_pk_fp8_f32(rr.x, rr.y, 0, false); q = __builtin_amdgcn_cvt_pk_fp8_f32(rr.z, rr.w, q, true); o8[64 * j] = (unsigned)q; } } }
}

__device__ __forceinline__ void sgu_pair(Frame& F, int l, int ch, int gp) {
    constexpr int RS = 136;
    LAS bf16* Wb = (LAS bf16*)(F.lds);
    LAS bf16* Vt = (LAS bf16*)(F.lds + 128 * RS * 2);
    LAS float* st = (LAS float*)(F.lds + 2 * 128 * RS * 2);
    const bf16* GV = (const bf16*)(F.ws + WS_GV); const bf16* U = (const bf16*)(F.ws + WS_U); bf16* Y = (bf16*)(F.ws + WS_Y);
    const float* lng = inp(F, I_LNG) + l * SGW; const float* lnb = inp(F, I_LNB) + l * SGW;
    const int t0 = ch * 128, g0 = 2 * gp;
    if (F.wave == 0) { wait_ge(F.ctl + CW_UG + 64 * (32 * l + (ch >> 1)), 64u, F.ctl + CW_TMO); __builtin_amdgcn_fence(__ATOMIC_ACQUIRE, "agent"); asm volatile("s_waitcnt vmcnt(0)" ::: "memory"); }
    __syncthreads();
    const float* Wg = inp(F, I_SGW) + ((size_t)l * 8 + g0) * 128 * 128;
    const int fr = F.lane & 15, fq = F.lane >> 4, tw = F.wave * 16, tq = t0 + tw + fr;
    f32x4 wq[2][8]; v4u va[2][2], vb[2][2]; v2u uw[2][8];
#pragma unroll
    for (int gi = 0; gi < 2; ++gi)
#pragma unroll
        for (int i = 0; i < 8; ++i) { const int idx = F.tid + NTHR * i; wq[gi][i] = *(const GAS f32x4*)(Wg + gi * 128 * 128 + (idx >> 5) * 128 + (idx & 31) * 4); }
#pragma unroll
    for (int gi = 0; gi < 2; ++gi)
#pragma unroll
        for (int i = 0; i < 2; ++i) { const int idx = F.tid + NTHR * i, sp = idx & 63, kc = idx >> 6;
            va[gi][i] = *(const GAS v4u*)(GV + (size_t)(t0 + 2 * sp) * SGW + (g0 + gi) * 128 + 8 * kc); vb[gi][i] = *(const GAS v4u*)(GV + (size_t)(t0 + 2 * sp + 1) * SGW + (g0 + gi) * 128 + 8 * kc); }
#pragma unroll
    for (int gi = 0; gi < 2; ++gi)
#pragma unroll
        for (int kt = 0; kt < 8; ++kt) uw[gi][kt] = *(const GAS v2u*)(U + (size_t)tq * SGW + (g0 + gi) * 128 + kt * 16 + 4 * fq);
    {
        const int row = F.tid >> 2, part = F.tid & 3; const GAS v4u* rp = (const GAS v4u*)(GV + (size_t)(t0 + row) * SGW);
        float s = 0.f, q = 0.f;
#pragma unroll 16
        for (int i = 0; i < 32; ++i) { const v4u w = rp[part + 4 * i]; const unsigned ww[4] = {w.x, w.y, w.z, w.w};
#pragma unroll
            for (int j = 0; j < 4; ++j) { const float a = bfl(ww[j]), b = bfh(ww[j]); s += a + b; q += a * a + b * b; } }
        s += shfl_xor_l(s, 1, F.lane); s += shfl_xor_l(s, 2, F.lane); q += shfl_xor_l(q, 1, F.lane); q += shfl_xor_l(q, 2, F.lane);
        const float mu = s * (1.0f / SGW); const float var = fmaxf(q * (1.0f / SGW) - mu * mu, 0.f);
        if (part == 0) { st[row] = mu; st[128 + row] = 1.0f / sqrtf(var + EPS); }
    }
#pragma unroll
    for (int gi = 0; gi < 2; ++gi) {
        const int g = g0 + gi;
#pragma unroll
        for (int i = 0; i < 8; ++i) { const int idx = F.tid + NTHR * i; const int t = idx >> 5, s4 = (idx & 31) * 4; const f32x4 w = wq[gi][i];
            v2u o; o.x = pk2h(w.x, w.y); o.y = pk2h(w.z, w.w); *(LAS v2u*)(Wb + t * RS + s4) = o; }
        if (gi == 0) __syncthreads();
#pragma unroll
        for (int i = 0; i < 2; ++i) { const int idx = F.tid + NTHR * i, sp = idx & 63, kc = idx >> 6;
            const unsigned aw[4] = {va[gi][i].x, va[gi][i].y, va[gi][i].z, va[gi][i].w}, bw[4] = {vb[gi][i].x, vb[gi][i].y, vb[gi][i].z, vb[gi][i].w};
            const float mua = st[2 * sp], rsa = st[128 + 2 * sp], mub = st[2 * sp + 1], rsb = st[128 + 2 * sp + 1];
#pragma unroll
            for (int j = 0; j < 4; ++j) { const int k = 8 * kc + 2 * j; const float ga = lng[g * 128 + k], gb = lng[g * 128 + k + 1], ba = lnb[g * 128 + k], bb = lnb[g * 128 + k + 1];
                *(LAS unsigned*)(Vt + k * RS + 2 * sp) = pk2h((bfl(aw[j]) - mua) * rsa * ga + ba, (bfl(bw[j]) - mub) * rsb * ga + ba);
                *(LAS unsigned*)(Vt + (k + 1) * RS + 2 * sp) = pk2h((bfh(aw[j]) - mua) * rsa * gb + bb, (bfh(bw[j]) - mub) * rsb * gb + bb); } }
        __syncthreads();
        {
            const float bias = (inp(F, I_SGB) + (l * 8 + g) * 128)[tw + fr];
            bf16x8 af[4];
#pragma unroll
            for (int ks = 0; ks < 4; ++ks) af[ks] = *(const LAS bf16x8*)(Wb + (tw + fr) * RS + ks * 32 + fq * 8);
#pragma unroll
            for (int kt = 0; kt < 8; ++kt) { f32x4 acc = (f32x4){0.f, 0.f, 0.f, 0.f};
#pragma unroll
                for (int ks = 0; ks < 4; ++ks) { const bf16x8 bfv = *(const LAS bf16x8*)(Vt + (kt * 16 + fr) * RS + ks * 32 + fq * 8);
                    acc = __builtin_amdgcn_mfma_f32_16x16x32_bf16(bfv, af[ks], acc, 0, 0, 0); }
                const int kcol = g * 128 + kt * 16 + 4 * fq;
                v2u o; o.x = pk2h(bfl(uw[gi][kt].x) * (acc[0] + bias), bfh(uw[gi][kt].x) * (acc[1] + bias)); o.y = pk2h(bfl(uw[gi][kt].y) * (acc[2] + bias), bfh(uw[gi][kt].y) * (acc[3] + bias));
                *(GAS v2u*)(Y + (size_t)tq * DM + 1024 + kcol) = o; }
        }
        __syncthreads();
    }
}

__device__ __forceinline__ void hy_filter_gen(Frame& F, int l, int c0, unsigned* FSP) {
    const bf16* A2 = (const bf16*)(F.ws + WS_A2 + (size_t)l * MiB); const bf16* W3T = (const bf16*)(F.ws + WS_W3T + (size_t)(l & 1) * 512 * 1024);
    int lane = F.lane; asm volatile("" : "+v"(lane));
    const int fr = lane & 15, fq = lane >> 4;
    const int chl = fr >> 2, o = (fr >> 1) & 1, dir = fr & 1, col = dir * 2048 + o * 1024 + c0 + chl;
    const bf16x8 b0 = *(const GAS bf16x8*)(W3T + (size_t)col * 64 + fq * 8), b1 = *(const GAS bf16x8*)(W3T + (size_t)col * 64 + 32 + fq * 8);
    const float delta = 3.0701134573253944f + (float)(c0 + chl) * (12.280453829301579f / 1023.0f);
    const float kdec = -delta * 1.4426950408889634f / (float)(SEQ - 1);
    constexpr int RS = 2056;
    LAS bf16* Ft = (LAS bf16*)(F.lds);
    LAS unsigned short* carry = (LAS unsigned short*)(F.lds + 16 * RS * 2);
    const int rot = (c0 * 10) & 127;
#define FG_LOAD(c_, ib_, A0, A1) do { int _fr = fr, _fq = fq; asm volatile("" : "+v"(_fr), "+v"(_fq)); \
        _Pragma("unroll") for (int j = 0; j < 8; ++j) { const int t0 = (128 * (c_) + ((F.wave + 8 * ((ib_) * 8 + j) + rot) & 127)) * 16; \
            A0[j] = *(const GAS bf16x8*)(A2 + (size_t)(t0 + _fr) * 64 + _fq * 8); A1[j] = *(const GAS bf16x8*)(A2 + (size_t)(t0 + _fr) * 64 + 32 + _fq * 8); } } while (0)
#define FG_COMP(c_, ib_, A0, A1) do { int _fr = fr, _fq = fq; asm volatile("" : "+v"(_fr), "+v"(_fq)); \
        _Pragma("unroll") for (int j = 0; j < 8; ++j) { const int tl = ((F.wave + 8 * ((ib_) * 8 + j) + rot) & 127) * 16, tb = 2048 * (c_) + tl + 4 * _fq; \
            f32x4 acc = (f32x4){0.f, 0.f, 0.f, 0.f}; \
            acc = __builtin_amdgcn_mfma_f32_16x16x32_bf16(A0[j], b0, acc, 0, 0, 0); \
            acc = __builtin_amdgcn_mfma_f32_16x16x32_bf16(A1[j], b1, acc, 0, 0, 0); \
            _Pragma("unroll") for (int r = 0; r < 4; ++r) acc[r] *= __builtin_amdgcn_exp2f(kdec * (float)(tb + r)); \
            v2u w; w.x = pk2h(acc[0], acc[1]); w.y = pk2h(acc[2], acc[3]); \
            *(LAS v2u*)(Ft + _fr * RS + tl + 4 * _fq) = w; } } while (0)
    bf16x8 xa0[8], xa1[8], ya0[8], ya1[8];
    FG_LOAD(0, 0, xa0, xa1);
#pragma unroll 1
    for (int c = 0; c < 4; ++c) {
        FG_LOAD(c, 1, ya0, ya1);
        FG_COMP(c, 0, xa0, xa1);
        if (c < 3) FG_LOAD(c + 1, 0, xa0, xa1);
        FG_COMP(c, 1, ya0, ya1);
        __syncthreads();
        int tid2 = F.tid; asm volatile("" : "+v"(tid2));
        {
#pragma unroll
            for (int i = 0; i < 4; ++i) { const int idx = tid2 + NTHR * i, r8 = idx >> 8, pc = idx & 255; const int f = (r8 >> 1) * 4 + (r8 & 1) * 2;
                v4u w = *(const LAS v4u*)(Ft + f * RS + 8 * pc);
                if (c == 0 && pc == 0) { const float s0 = bfl(w.x) + bfl((unsigned)Ft[(f + 1) * RS]); w.x = (w.x & 0xffff0000u) | f2bf(s0); }
                *(GAS v4u*)(FSP + (size_t)r8 * 8192 + 1024 * c + 4 * pc) = w; }
        }
        {
#pragma unroll 4
            for (int i = 0; i < 16; ++i) { const int idx = tid2 + NTHR * i, r8 = idx >> 10, il = idx & 1023; const int f = (r8 >> 1) * 4 + (r8 & 1) * 2 + 1;
                const unsigned lo = Ft[f * RS + 2 * il]; const unsigned hi = (il > 0) ? (unsigned)Ft[f * RS + 2 * il - 1] : (unsigned)carry[(c & 1) * 8 + r8];
                const int ig = 1024 * c + il;
                if (ig > 0) FSP[(size_t)r8 * 8192 + 8192 - ig] = lo | (hi << 16); }
            if (F.tid < 8) { const int f = (F.tid >> 1) * 4 + (F.tid & 1) * 2 + 1; const unsigned short last = Ft[f * RS + 2047];
                carry[((c + 1) & 1) * 8 + F.tid] = last;
                if (c == 3) FSP[(size_t)F.tid * 8192 + 4096] = (unsigned)last << 16; }
        }
        __syncthreads();
    }
}
#undef FG_LOAD
#undef FG_COMP
__device__ __forceinline__ unsigned pk_c32(c32 v) { return pk2h(v.x, v.y); }
__device__ __forceinline__ c32 unpk_c32(unsigned u) { return cmk(bfl(u), bfh(u)); }
__device__ __forceinline__ void hyena_block(Frame& F, int l, int blk) {
    LAS c32* A = (LAS c32*)(F.lds); LAS c32* B = A + HY_LDS_C32;
    unsigned* FSP = (unsigned*)(F.ws + WS_FS) + (size_t)blk * 8 * 8192;
    const unsigned* ZT = (const unsigned*)(F.ws + WS_ZT); bf16* Y = (bf16*)(F.ws + WS_Y);
    const float* cw = inp(F, I_CONVW) + (size_t)l * 3 * NHY; const float* cb = inp(F, I_CONVB) + (size_t)l * NHY; const float* skp = inp(F, I_SKIP) + (size_t)l * 2 * HYW;
    const int c0 = blk * 4, tid = F.tid;
    __syncthreads();
    HPS(20); hy_filter_gen(F, l, c0, FSP);
    if (F.wave == 0) { const int pz = c0 >> 8; gu32* cz = F.ctl + CW_ZT + 64 * 16 * l;
        wait_ge(cz + 64 * pz, 256u, F.ctl + CW_TMO); wait_ge(cz + 64 * (4 + pz), 256u, F.ctl + CW_TMO); wait_ge(cz + 64 * (8 + pz), 256u, F.ctl + CW_TMO);
        __builtin_amdgcn_fence(__ATOMIC_ACQUIRE, "agent"); }
    VM_WAIT(); __syncthreads(); HPE(20); HPS(21);
    CvPipe cvp; float cvv[32];
    {
        const int nlate = 1152 - 4 * F.G, bx = (int)blockIdx.x;
        if (false && F.G == 256 && nlate == 128) { if (bx >= nlate) CV_START(F, cvp, cvv, 1, l, 2, (bx - nlate) * NWAVES + F.wave, 128 * NWAVES); else CV_START(F, cvp, cvv, 1, l, 1, bx * NWAVES + F.wave, 128 * NWAVES); }
        else CV_START(F, cvp, cvv, 1, l, 0, F.vcu * NWAVES + F.wave, F.G * NWAVES);
    }
    unsigned yb0[8], yb1[8], yb2[8], yb3[8];
#pragma unroll
    for (int q = 0; q < 8; ++q) { yb0[q] = 0u; yb1[q] = 0u; yb2[q] = 0u; yb3[q] = 0u; }
    const c32 tw1 = cis_pi(-2.0f * (float)tid / 8192.0f), tw2 = cis_pi(-2.0f * (float)(tid & 31) / 512.0f), twp = cis_pi(-(float)(tid & 31) / 32.0f), twl = cis_pi(-(float)(tid >> 5) / 8192.0f);
#pragma unroll 1
    for (int chl = 0; chl < 4; ++chl) {
        const int c = c0 + chl; const unsigned* zk = FSP + (size_t)chl * 2 * 8192;
        c32 keep[8]; unsigned x1p[8], x2p[8];
        c32 s[16];
        {
            unsigned fw[16]; c32 fz[16];
            { int t2 = tid; HY_OPAQUE(t2);
#pragma unroll
              for (int q = 0; q < 16; ++q) fw[q] = zk[t2 + 512 * q]; }
            c32 xa[8], xb[8];
            hy_conv3_load(tid, ZT + (size_t)(2048 + c) * (SEQ / 2), cw[2048 + c], cw[NHY + 2048 + c], cw[2 * NHY + 2048 + c], cb[2048 + c], keep);
            hy_conv3_load(tid, ZT + (size_t)c * (SEQ / 2), cw[c], cw[NHY + c], cw[2 * NHY + c], cb[c], xa);
            hy_conv3_load(tid, ZT + (size_t)(1024 + c) * (SEQ / 2), cw[1024 + c], cw[NHY + 1024 + c], cw[2 * NHY + 1024 + c], cb[1024 + c], xb);
#pragma unroll
            for (int q = 0; q < 8; ++q) { x1p[q] = pk_c32(xa[q]); x2p[q] = pk_c32(xb[q]); }
#pragma unroll
            for (int q = 0; q < 16; ++q) fz[q] = cmk(bfl(fw[q]), bfh(fw[q]));
            fft_s1_fwd(tid, B, fz, tw1);
            hy_data_s1(tid, A, keep, tw1);
        }
        const float sk0 = skp[c], sk1 = skp[HYW + c];
#pragma unroll
        for (int ord = 0; ord < 2; ++ord) {
            __syncthreads();
            HPS(22); fft_s2_fwd(tid, A, tw2); fft_s2_fwd(tid, B, tw2);
            __syncthreads(); HPE(22); HPS(23);
            CV_STEP(F, cvp, cvv);
            fft_s3_read<-1>(tid, A, s); fft_s3_write(tid, A, s);
            fft_s3_read<-1>(tid, B, s); fft_s3_write(tid, B, s);
            __syncthreads(); HPE(23); HPS(24);
            CV_STEP(F, cvp, cvv);
            unsigned fw[16];
            if (ord == 0) { int t2 = tid; HY_OPAQUE(t2);
#pragma unroll
                for (int q = 0; q < 16; ++q) fw[q] = zk[8192 + t2 + 512 * q]; }
            pair_pass(tid, A, B, twp, twl);
            __syncthreads(); HPE(24); HPS(25);
            if (ord == 0) { c32 fz[16];
#pragma unroll
                for (int q = 0; q < 16; ++q) fz[q] = cmk(bfl(fw[q]), bfh(fw[q]));
                fft_s1_fwd(tid, B, fz, tw1); }
            fft_s3_read<1>(tid, A, s); fft_s3_write(tid, A, s);
            __syncthreads();
            CV_STEP(F, cvp, cvv);
            fft_s2_inv(tid, A, tw2);
            __syncthreads();
            fft_s1_inv(tid, A, s, tw1); HPE(25); HPS(26);
            if (ord == 0) {
#pragma unroll
                for (int q = 0; q < 8; ++q) { const c32 xv = unpk_c32(x1p[q]); keep[q] = cmk(FMUL(xv.x, FFMA(keep[q].x, sk0, s[q].x)), FMUL(xv.y, FFMA(keep[q].y, sk0, s[q].y))); }
                hy_data_s1(tid, A, keep, tw1);
            } else {
#pragma unroll
                for (int q = 0; q < 8; ++q) { const c32 xv = unpk_c32(x2p[q]); const unsigned yv = pk_c32(cmk(FMUL(xv.x, FFMA(keep[q].x, sk1, s[q].x)), FMUL(xv.y, FFMA(keep[q].y, sk1, s[q].y))));
                    yb0[q] = (chl == 0) ? yv : yb0[q]; yb1[q] = (chl == 1) ? yv : yb1[q]; yb2[q] = (chl == 2) ? yv : yb2[q]; yb3[q] = (chl == 3) ? yv : yb3[q]; }
            }
            HPE(26);
        }
        __syncthreads();
    }
    {
        int t2 = tid; HY_OPAQUE(t2);
#pragma unroll
        for (int q = 0; q < 8; ++q) { const int m = t2 + 512 * q;
            v2u lo, hi; lo.x = (yb0[q] & 0xffffu) | (yb1[q] << 16); lo.y = (yb2[q] & 0xffffu) | (yb3[q] << 16);
            hi.x = (yb0[q] >> 16) | (yb1[q] & 0xffff0000u); hi.y = (yb2[q] >> 16) | (yb3[q] & 0xffff0000u);
            *(GAS v2u*)(Y + (size_t)(2 * m) * DM + c0) = lo; *(GAS v2u*)(Y + (size_t)(2 * m + 1) * DM + c0) = hi; }
    }
    while (cvp.have) CV_STEP(F, cvp, cvv);
    HPE(21);
}

__device__ __forceinline__ void rt_split8(const f32x4 a, const f32x4 b, bf16x8& hi, bf16x8& lo) {
    const float v[8] = {a.x, a.y, a.z, a.w, b.x, b.y, b.z, b.w}; v4u hw, lw;
#pragma unroll
    for (int j = 0; j < 4; ++j) { const unsigned h = pk2h(v[2 * j], v[2 * j + 1]); const unsigned lo2 = pk2h(v[2 * j] - bfl(h), v[2 * j + 1] - bfh(h)); hw[j] = h; lw[j] = lo2; }
    hi = __builtin_bit_cast(bf16x8, hw); lo = __builtin_bit_cast(bf16x8, lw);
}
__device__ __forceinline__ void route_block(Frame& F, int l, int tb  ) {
    LAS int* lcnt = (LAS int*)(F.lds);
    LAS int* lbase = (LAS int*)(F.lds + 64);
    LAS int* le = (LAS int*)(F.lds + 128);
    LAS int* lp = (LAS int*)(F.lds + 128 + 256);
    LAS float* lw = (LAS float*)(F.lds + 128 + 512);
    LAS float* lr = (LAS float*)(F.lds + 128 + 768);
    LAS float* SS = (LAS float*)(F.lds + 1024);
    LAS float* PL = (LAS float*)(F.lds + 2048);
    const bf16* XR = (const bf16*)(F.ws + WS_XR); unsigned char* H8 = (unsigned char*)(F.ws + WS_XN); const float* WR = (const float*)(F.ws + WS_WR + (size_t)l * 256 * 1024);
    const float* g = inp(F, I_GFFN) + (size_t)l * DM; const float* brg = inp(F, I_BRG) + l * 4; const float* bre = inp(F, I_BRE) + l * 16;
    int* TOKLIST = (int*)(F.ws + WS_LISTS); float* WLIST = (float*)(F.ws + WS_LISTS + 512 * 1024); int* TOKPOS = (int*)(F.ws + WS_LISTS + 1 * MiB); float* RSLIST = (float*)(F.ws + WS_LISTS + 1 * MiB + 512 * 1024);
    gu32* gcnt = F.ctl + CW_CNT + 64 * 16 * l;
    if (F.wave == 0) { wait_ge(F.ctl + CW_XR + 64 * (32 * l + (tb >> 8)), 64u, F.ctl + CW_TMO); __builtin_amdgcn_fence(__ATOMIC_ACQUIRE, "agent"); asm volatile("s_waitcnt vmcnt(0)" ::: "memory"); }
    __syncthreads();
    if (F.tid < 16) lcnt[F.tid] = 0;
    const int ts = F.tid >> 4, part = F.tid & 15;
    {
        const int fr = F.lane & 15, fq = F.lane >> 4, kw = 256 * F.wave + 8 * fq;
        f32x4 acc[2][2];
#pragma unroll
        for (int a = 0; a < 2; ++a)
#pragma unroll
            for (int b = 0; b < 2; ++b) acc[a][b] = (f32x4){0.f, 0.f, 0.f, 0.f};
        float ssl[2] = {0.f, 0.f};
        const bf16* x0 = XR + (size_t)(tb + fr) * DM + kw; const bf16* x1 = x0 + (size_t)16 * DM;
        const float* w0 = WR + (size_t)fr * DM + kw; const float* w1 = WR + (size_t)(16 + (fr & 3)) * DM + kw;
        v4u xb[2]; f32x4 wa[2][2], ga[2];
#define RT_LD(ks) do { const int _k = 32 * (ks); xb[0] = *(const GAS v4u*)(x0 + _k); xb[1] = *(const GAS v4u*)(x1 + _k); \
            wa[0][0] = *(const GAS f32x4*)(w0 + _k); wa[0][1] = *(const GAS f32x4*)(w0 + _k + 4); wa[1][0] = *(const GAS f32x4*)(w1 + _k); wa[1][1] = *(const GAS f32x4*)(w1 + _k + 4); \
            ga[0] = *(const GAS f32x4*)(g + kw + _k); ga[1] = *(const GAS f32x4*)(g + kw + _k + 4); } while (0)
        RT_LD(0);
#pragma unroll 1
        for (int ks = 0; ks < 8; ++ks) {
            bf16x8 ah[2], al[2], bh[2], bl[2];
#pragma unroll
            for (int mt = 0; mt < 2; ++mt) { const v4u xw = xb[mt]; const f32x4 p = (f32x4){bfl(xw.x), bfh(xw.x), bfl(xw.y), bfh(xw.y)}, q = (f32x4){bfl(xw.z), bfh(xw.z), bfl(xw.w), bfh(xw.w)};
                ssl[mt] += ((p.x * p.x + p.y * p.y) + (p.z * p.z + p.w * p.w)) + ((q.x * q.x + q.y * q.y) + (q.z * q.z + q.w * q.w));
                const f32x4 pg = p * ga[0], qg = q * ga[1];
                rt_split8(pg, qg, ah[mt], al[mt]);
                int ha = __builtin_amdgcn_cvt_pk_fp8_f32(pg.x, pg.y, 0, false); ha = __builtin_amdgcn_cvt_pk_fp8_f32(pg.z, pg.w, ha, true);
                int hb = __builtin_amdgcn_cvt_pk_fp8_f32(qg.x, qg.y, 0, false); hb = __builtin_amdgcn_cvt_pk_fp8_f32(qg.z, qg.w, hb, true);
                *(GAS v2u*)(H8 + (size_t)(tb + 16 * mt + fr) * DM + kw + 32 * ks) = (v2u){(unsigned)ha, (unsigned)hb}; }
            rt_split8(wa[0][0], wa[0][1], bh[0], bl[0]);
            { const float z = (fr < 4) ? 1.f : 0.f; rt_split8(wa[1][0] * z, wa[1][1] * z, bh[1], bl[1]); }
            if (ks < 7) RT_LD(ks + 1);
#pragma unroll
            for (int mt = 0; mt < 2; ++mt)
#pragma unroll
                for (int nt = 0; nt < 2; ++nt) { acc[mt][nt] = __builtin_amdgcn_mfma_f32_16x16x32_bf16(ah[mt], bh[nt], acc[mt][nt], 0, 0, 0);
                    acc[mt][nt] = __builtin_amdgcn_mfma_f32_16x16x32_bf16(al[mt], bh[nt], acc[mt][nt], 0, 0, 0);
                    acc[mt][nt] = __builtin_amdgcn_mfma_f32_16x16x32_bf16(ah[mt], bl[nt], acc[mt][nt], 0, 0, 0); }
        }
#undef RT_LD
#pragma unroll
        for (int mt = 0; mt < 2; ++mt) { float s = ssl[mt]; s += shfl_xor_l(s, 16, F.lane); s += shfl_xor_l(s, 32, F.lane); if (fq == 0) SS[F.wave * 32 + 16 * mt + fr] = s;
#pragma unroll
            for (int nt = 0; nt < 2; ++nt)
#pragma unroll
                for (int r = 0; r < 4; ++r) PL[(F.wave * 32 + 16 * mt + 4 * fq + r) * 32 + 16 * nt + fr] = acc[mt][nt][r]; }
    }
    __syncthreads();
    float acc[20], ss = 0.f;
#pragma unroll
    for (int o = 0; o < 20; ++o) acc[o] = 0.f;
#pragma unroll
    for (int w = 0; w < 8; ++w) { ss += SS[w * 32 + ts];
#pragma unroll
        for (int o = 0; o < 20; ++o) acc[o] += PL[(w * 32 + ts) * 32 + o]; }
    const float rstd = 1.0f / sqrtf(ss * (1.0f / DM) + EPS);
    {
        float lg0 = acc[0] * rstd + brg[0], lg1 = acc[1] * rstd + brg[1], lg2 = acc[2] * rstd + brg[2], lg3 = acc[3] * rstd + brg[3];
        int grp = 0; float mx = lg0;
        if (lg1 > mx) { mx = lg1; grp = 1; } if (lg2 > mx) { mx = lg2; grp = 2; } if (lg3 > mx) { mx = lg3; grp = 3; }
        const float den = (__expf(lg0 - mx) + __expf(lg1 - mx)) + (__expf(lg2 - mx) + __expf(lg3 - mx));
        const float psel = 1.0f / den;
        const float m0 = (grp == 0) ? 1.f : 0.f, m1 = (grp == 1) ? 1.f : 0.f, m2 = (grp == 2) ? 1.f : 0.f, m3 = (grp == 3) ? 1.f : 0.f;
        float e0v = (m0 * acc[4] + m1 * acc[8]) + (m2 * acc[12] + m3 * acc[16]), e1v = (m0 * acc[5] + m1 * acc[9]) + (m2 * acc[13] + m3 * acc[17]);
        float e2v = (m0 * acc[6] + m1 * acc[10]) + (m2 * acc[14] + m3 * acc[18]), e3v = (m0 * acc[7] + m1 * acc[11]) + (m2 * acc[15] + m3 * acc[19]);
        e0v = e0v * rstd + bre[grp * 4 + 0]; e1v = e1v * rstd + bre[grp * 4 + 1]; e2v = e2v * rstd + bre[grp * 4 + 2]; e3v = e3v * rstd + bre[grp * 4 + 3];
        int i0 = 0; float v0 = e0v;
        if (e1v > v0) { v0 = e1v; i0 = 1; } if (e2v > v0) { v0 = e2v; i0 = 2; } if (e3v > v0) { v0 = e3v; i0 = 3; }
        int i1 = -1; float v1 = -3.0e38f;
        if (i0 != 0 && e0v > v1) { v1 = e0v; i1 = 0; } if (i0 != 1 && e1v > v1) { v1 = e1v; i1 = 1; } if (i0 != 2 && e2v > v1) { v1 = e2v; i1 = 2; } if (i0 != 3 && e3v > v1) { v1 = e3v; i1 = 3; }
        const float ex = __expf(v1 - v0); const float w0 = psel / (1.0f + ex), w1 = psel * ex / (1.0f + ex);
        if (part == 0) { const int ea = grp * 4 + i0, eb = grp * 4 + i1;
            le[ts * 2] = ea; le[ts * 2 + 1] = eb; lw[ts * 2] = w0; lw[ts * 2 + 1] = w1; lr[ts] = rstd;
            lp[ts * 2] = __hip_atomic_fetch_add(lcnt + ea, 1, __ATOMIC_RELAXED, __HIP_MEMORY_SCOPE_WORKGROUP); lp[ts * 2 + 1] = __hip_atomic_fetch_add(lcnt + eb, 1, __ATOMIC_RELAXED, __HIP_MEMORY_SCOPE_WORKGROUP); }
    }
    __syncthreads();
    if (F.tid < 16) lbase[F.tid] = (int)__hip_atomic_fetch_add(gcnt + 64 * F.tid, (unsigned)lcnt[F.tid], RLX_AGENT);
    __syncthreads();
    if (F.tid < 64) { const int t2 = F.tid >> 1; const int e = le[F.tid], pos = lbase[e] + lp[F.tid];
        TOKLIST[e * SEQ + pos] = tb + t2; WLIST[e * SEQ + pos] = lw[F.tid]; RSLIST[e * SEQ + pos] = lr[t2]; TOKPOS[(tb + t2) * 2 + (F.tid & 1)] = (e << 13) | pos; }
}
using pg8::Unit; using pg8::f32x2; using pg8::u32x4; using pg8::u32x2; using pg8::cvt_pk_bf16; using pg8::gelu_pk; using pg8::sigmoid_f;
__device__ __forceinline__ void tile_of(int idx, int nM, int nN, int& pm, int& pn) {
    const int nig = 8 * nN, gid = idx / nig, fm = gid * 8, gsz = (nM - fm) < 8 ? (nM - fm) : 8;
    pm = fm + ((idx % nig) % gsz); pn = (idx % nig) / gsz;
}
__device__ __forceinline__ int xcd_remap(int L, int nwg) { const int q = nwg / 8, r = nwg % 8, xcd = L % 8, off = L / 8; return (xcd < r ? xcd * (q + 1) : r * (q + 1) + (xcd - r) * q) + off; }

struct InProjSched {
    static constexpr bool GATHER = false, WAIT = false, HALF = false;
    const char* XN; const char* WIN; int G, c;
    __device__ __forceinline__ bool next(int i, Unit& u) const {
        const int L = i * G + c; if (L >= 640) return false;
        if (L < 384) { u.kind = 0; tile_of((L & 7) * 48 + (L >> 3), 12, 32, u.pm, u.pn); }
        else if (L < 640) { const int L1 = L - 384; u.kind = 1; tile_of((L1 & 7) * 32 + (L1 >> 3), 32, 8, u.pm, u.pn); }
        else { const int L2 = L - 640; u.kind = 1; tile_of((L2 & 7) * 64 + (L2 >> 3), 32, 16, u.pm, u.pn); u.pn += 8; }
        u.e = 0; u.row0 = 0; u.nvalid = 256; u.rt = 0; u.half = 0; return true;
    }
    __device__ __forceinline__ const char* a_base(const Unit& u) const { return (u.kind == 0 ? WIN : XN) + (size_t)u.pm * (256 * DM * 2); }
    __device__ __forceinline__ const char* b_base(const Unit& u) const { return (u.kind == 0 ? XN : WIN + (size_t)NHY * DM * 2) + (size_t)u.pn * (256 * DM * 2); }
    __device__ __forceinline__ unsigned a_goff(const Unit&, int) const { return 0u; }
};
struct EpiInProj {
    static constexpr bool PERM = true, MIDK = false, FP8 = false;
    bf16 *ZT, *U; const float* bin; gu32 *cz, *cu;
    __device__ __forceinline__ void operator()(const f32x4 (&acc)[2][2][4][2], const Unit& u, int wr, int wc, int fr, int fq) const {
        asm volatile("" : "+v"(fr), "+v"(fq));
        if (u.kind == 0) {
            const __amdgpu_buffer_rsrc_t rz = __builtin_amdgcn_make_buffer_rsrc(ZT, 0, NHY * SEQ * 2, 0x00020000);
            const int row0 = u.pm * 256 + wr * 64 + fr, col0 = u.pn * 256 + wc * 32 + 8 * fq;
#pragma unroll
            for (int ai = 0; ai < 2; ++ai)
#pragma unroll
                for (int m = 0; m < 4; ++m) { const int row = row0 + ai * 128 + m * 16; const float b = bin[row]; bf16* rowp = ZT + (size_t)row * SEQ + col0;
#pragma unroll
                    for (int bj = 0; bj < 2; ++bj) { const f32x4 v0 = acc[ai][bj][m][0] + b, v1 = acc[ai][bj][m][1] + b;
                        u32x4 w; w.x = cvt_pk_bf16(v0[0], v0[1]); w.y = cvt_pk_bf16(v0[2], v0[3]); w.z = cvt_pk_bf16(v1[0], v1[1]); w.w = cvt_pk_bf16(v1[2], v1[3]);
                        __builtin_amdgcn_raw_buffer_store_b128(w, rz, (int)((rowp + bj * 128 - ZT) * 2), 0, 16); } }
            asm volatile("s_waitcnt vmcnt(0)" ::: "memory");
            if (fr == 0 && fq == 0) __hip_atomic_fetch_add(cz + 64 * u.pm, 1u, RLX_AGENT);
        } else {
            const int seg = (u.pn < 4) ? 0 : (u.pn < 8) ? 1 : (u.pn < 16) ? 2 : 3;
            const int colt = (seg == 0) ? u.pn * 256 : (seg == 1) ? (u.pn - 4) * 256 : (seg == 2) ? (u.pn - 8) * 256 : (u.pn - 16) * 256;
            const int row0 = u.pm * 256 + wr * 64 + fr, col0 = colt + wc * 32 + 8 * fq, bcol0 = NHY + u.pn * 256 + wc * 32 + 8 * fq;
            f32x4 bv[2][2];
#pragma unroll
            for (int bj = 0; bj < 2; ++bj)
#pragma unroll
                for (int n = 0; n < 2; ++n) bv[bj][n] = *(const f32x4*)(bin + bcol0 + bj * 128 + 4 * n);
            if (seg < 2) {
                const __amdgpu_buffer_rsrc_t ru = __builtin_amdgcn_make_buffer_rsrc(U, 0, 2 * SEQ * SGW * 2, 0x00020000);
                bf16* base = (bf16*)((char*)U + ((seg == 0) ? (size_t)0 : (size_t)(WS_GV - WS_U)));
#pragma unroll
                for (int ai = 0; ai < 2; ++ai)
#pragma unroll
                    for (int m = 0; m < 4; ++m) { bf16* rowp = base + (size_t)(row0 + ai * 128 + m * 16) * 1024 + col0;
#pragma unroll
                        for (int bj = 0; bj < 2; ++bj) { f32x4 v0 = acc[ai][bj][m][0] + bv[bj][0], v1 = acc[ai][bj][m][1] + bv[bj][1];
                            const f32x2 a = gelu_pk((f32x2){v0[0], v0[1]}), b = gelu_pk((f32x2){v0[2], v0[3]}), c = gelu_pk((f32x2){v1[0], v1[1]}), d = gelu_pk((f32x2){v1[2], v1[3]});
                            u32x4 w; w.x = cvt_pk_bf16(a.x, a.y); w.y = cvt_pk_bf16(b.x, b.y); w.z = cvt_pk_bf16(c.x, c.y); w.w = cvt_pk_bf16(d.x, d.y);
                            __builtin_amdgcn_raw_buffer_store_b128(w, ru, (int)((rowp + bj * 128 - U) * 2), 0, 16); } }
                asm volatile("s_waitcnt vmcnt(0)" ::: "memory");
                if (fr == 0 && fq == 0) __hip_atomic_fetch_add(cu + 64 * u.pm, 1u, RLX_AGENT);
            } else {
                unsigned char* base = (unsigned char*)U + ((seg == 2) ? (size_t)(WS_GH - WS_U) : (size_t)(WS_GS - WS_U));
#pragma unroll
                for (int ai = 0; ai < 2; ++ai)
#pragma unroll
                    for (int m = 0; m < 4; ++m) { unsigned char* rowp = base + (size_t)(row0 + ai * 128 + m * 16) * DM + col0;
#pragma unroll
                        for (int bj = 0; bj < 2; ++bj) { const f32x4 v0 = acc[ai][bj][m][0] + bv[bj][0], v1 = acc[ai][bj][m][1] + bv[bj][1];
                            unsigned w0 = 0u, w1 = 0u;
#pragma unroll
                            for (int j = 0; j < 4; ++j) { w0 = __builtin_amdgcn_cvt_pk_u8_f32(fmaxf(sigmoid_f(v0[j]) * 255.0f, 1.0f), j, w0); w1 = __builtin_amdgcn_cvt_pk_u8_f32(fmaxf(sigmoid_f(v1[j]) * 255.0f, 1.0f), j, w1); }
                            u32x2 w; w.x = w0; w.y = w1; *(u32x2*)(rowp + bj * 128) = w; } }
            }
        }
    }
    __device__ __forceinline__ void mid(f32x4 (&)[2][2][4][2], const Unit&, int, int, int, int) const {}
};
struct GateSched8 {
    static constexpr bool GATHER = false, WAIT = false, HALF = false;
    const char* XN8; const char* W8; int G, c;
    __device__ __forceinline__ bool next(int i, Unit& u) const {
        int idx;
        if (G == 256) { const int x = c & 7, q = c >> 3; if (q < 16) { if (i >= 1) return false; idx = x * 64 + q; } else { if (i >= 3) return false; idx = x * 64 + 16 + 3 * (q - 16) + i; } }
        else { idx = i * G + c; if (idx >= 512) return false; }
        tile_of(idx, 32, 16, u.pm, u.pn); u.kind = 1; u.e = 0; u.row0 = 0; u.nvalid = 256; u.rt = 0; u.half = 0; return true;
    }
    __device__ __forceinline__ const char* a_base(const Unit& u) const { return XN8 + (size_t)u.pm * (256 * DM); }
    __device__ __forceinline__ const char* b_base(const Unit& u) const { return W8 + (size_t)u.pn * (256 * DM); }
    __device__ __forceinline__ unsigned a_goff(const Unit&, int) const { return 0u; }
};
struct EpiGate8 {
    static constexpr bool PERM = true, MIDK = false, FP8 = true;
    unsigned char *GH, *GS; const float* bin;
    __device__ __forceinline__ void operator()(const f32x4 (&acc)[2][2][4][2], const Unit& u, int wr, int wc, int fr, int fq) const {
        asm volatile("" : "+v"(fr), "+v"(fq));
        const int row0 = u.pm * 256 + wr * 64 + fr, col0 = (u.pn & 7) * 256 + wc * 32 + 8 * fq, bcol0 = NHY + (u.pn + 8) * 256 + wc * 32 + 8 * fq;
        f32x4 bv[2][2];
#pragma unroll
        for (int bj = 0; bj < 2; ++bj)
#pragma unroll
            for (int n = 0; n < 2; ++n) bv[bj][n] = *(const f32x4*)(bin + bcol0 + bj * 128 + 4 * n);
        unsigned char* base = (u.pn < 8) ? GH : GS;
#pragma unroll
        for (int ai = 0; ai < 2; ++ai)
#pragma unroll
            for (int m = 0; m < 4; ++m) { unsigned char* rowp = base + (size_t)(row0 + ai * 128 + m * 16) * DM + col0;
#pragma unroll
                for (int bj = 0; bj < 2; ++bj) { const f32x4 v0 = acc[ai][bj][m][0] * (1.0f / 64.0f) + bv[bj][0], v1 = acc[ai][bj][m][1] * (1.0f / 64.0f) + bv[bj][1];
                    unsigned w0 = 0u, w1 = 0u;
#pragma unroll
                    for (int j = 0; j < 4; ++j) { w0 = __builtin_amdgcn_cvt_pk_u8_f32(fmaxf(sigmoid_f(v0[j]) * 255.0f, 1.0f), j, w0); w1 = __builtin_amdgcn_cvt_pk_u8_f32(fmaxf(sigmoid_f(v1[j]) * 255.0f, 1.0f), j, w1); }
                    u32x2 w; w.x = w0; w.y = w1; *(u32x2*)(rowp + bj * 128) = w; } }
    }
    __device__ __forceinline__ void mid(f32x4 (&)[2][2][4][2], const Unit&, int, int, int, int) const {}
};
struct GridSched {
    static constexpr bool GATHER = false, WAIT = false, HALF = false;
    const char* A; const char* Bt; int nM, nN, K, G, c;
    __device__ __forceinline__ bool next(int i, Unit& u) const {
        const int L = i * G + c, nwg = nM * nN; if (L >= nwg) return false;
        tile_of(xcd_remap(L, nwg), nM, nN, u.pm, u.pn); u.kind = 0; u.e = 0; u.row0 = 0; u.nvalid = 256; u.rt = 0; u.half = 0; return true;
    }
    __device__ __forceinline__ const char* a_base(const Unit& u) const { return A + (size_t)u.pm * 512 * K; }
    __device__ __forceinline__ const char* b_base(const Unit& u) const { return Bt + (size_t)u.pn * 512 * K; }
    __device__ __forceinline__ unsigned a_goff(const Unit&, int) const { return 0u; }
};
struct GridSchedW : GridSched {
    static constexpr bool WAIT = true;
    gu32* pcnt; unsigned need; gu32* tmo;
    __device__ __forceinline__ void a_ready(const Unit& u, int wid) const {
        if (wid == 0) { wait_ge(pcnt + 64 * u.pm, need, tmo); __builtin_amdgcn_fence(__ATOMIC_ACQUIRE, "agent"); asm volatile("s_waitcnt vmcnt(0)" ::: "memory"); }
        asm volatile("" ::: "memory"); __builtin_amdgcn_s_barrier(); asm volatile("" ::: "memory");
    }
};
struct EpiMerge {
    static constexpr bool PERM = true, MIDK = true, FP8 = false;
    const unsigned char *GH, *GS; bf16* O; gu32* pcnt;
    __device__ __forceinline__ void mid(f32x4 (&acc)[2][2][4][2], const Unit& u, int wr, int wc, int fr, int fq) const {
        asm volatile("" : "+v"(fr), "+v"(fq));
        const int row0 = u.pm * 256 + wr * 64 + fr, col0 = u.pn * 256 + wc * 32 + 8 * fq;
        u32x2 hb[2][2], sb[2][2];
#define EM_LOAD(g, par) do { const size_t _o = (size_t)(row0 + ((g) >> 2) * 128 + ((g) & 3) * 16) * DM + col0; \
            hb[par][0] = *(const u32x2*)(GH + _o); hb[par][1] = *(const u32x2*)(GH + _o + 128); sb[par][0] = *(const u32x2*)(GS + _o); sb[par][1] = *(const u32x2*)(GS + _o + 128); } while (0)
        EM_LOAD(0, 0);
#pragma unroll
        for (int g = 0; g < 8; ++g) { const int ai = g >> 2, m = g & 3, par = g & 1;
            if (g + 1 < 8) EM_LOAD(g + 1, (g + 1) & 1);
            asm volatile("" ::: "memory");
#pragma unroll
            for (int bj = 0; bj < 2; ++bj) { const unsigned hh[2] = {hb[par][bj].x, hb[par][bj].y}, sv[2] = {sb[par][bj].x, sb[par][bj].y};
#pragma unroll
                for (int n = 0; n < 2; ++n)
#pragma unroll
                    for (int j = 0; j < 4; ++j) acc[ai][bj][m][n][j] *= (float)((hh[n] >> (8 * j)) & 0xffu) * __builtin_amdgcn_rcpf((float)((sv[n] >> (8 * j)) & 0xffu)); }
            asm volatile("" : "+v"(acc[ai][0][m][0]), "+v"(acc[ai][0][m][1]), "+v"(acc[ai][1][m][0]), "+v"(acc[ai][1][m][1])); }
#undef EM_LOAD
    }
    __device__ __forceinline__ void operator()(const f32x4 (&acc)[2][2][4][2], const Unit& u, int wr, int wc, int fr, int fq) const {
        asm volatile("" : "+v"(fr), "+v"(fq));
        const int row0 = u.pm * 256 + wr * 64 + fr, col0 = u.pn * 256 + wc * 32 + 8 * fq;
        u32x2 sb[2][2]; const __amdgpu_buffer_rsrc_t ro = __builtin_amdgcn_make_buffer_rsrc(O, 0, SEQ * DM * 2, 0x00020000);
#define EM_LOAD(g, par) do { const size_t _o = (size_t)(row0 + ((g) >> 2) * 128 + ((g) & 3) * 16) * DM + col0; sb[par][0] = *(const u32x2*)(GS + _o); sb[par][1] = *(const u32x2*)(GS + _o + 128); } while (0)
        EM_LOAD(0, 0); EM_LOAD(1, 1);
#pragma unroll
        for (int g = 0; g < 8; ++g) { const int ai = g >> 2, m = g & 3, par = g & 1; const size_t off = (size_t)(row0 + ai * 128 + m * 16) * DM + col0;
            u32x4 w[2];
#pragma unroll
            for (int bj = 0; bj < 2; ++bj) { const unsigned sv[2] = {sb[par][bj].x, sb[par][bj].y}; float o[8];
#pragma unroll
                for (int n = 0; n < 2; ++n)
#pragma unroll
                    for (int j = 0; j < 4; ++j) o[4 * n + j] = acc[ai][bj][m][n][j] * ((float)((sv[n] >> (8 * j)) & 0xffu) * (1.0f / 255.0f));
                w[bj].x = cvt_pk_bf16(o[0], o[1]); w[bj].y = cvt_pk_bf16(o[2], o[3]); w[bj].z = cvt_pk_bf16(o[4], o[5]); w[bj].w = cvt_pk_bf16(o[6], o[7]); }
            if (g + 2 < 8) EM_LOAD(g + 2, par);
            __builtin_amdgcn_raw_buffer_store_b128(w[0], ro, (int)(off * 2), 0, 16); __builtin_amdgcn_raw_buffer_store_b128(w[1], ro, (int)((off + 128) * 2), 0, 16);
            asm volatile("" ::: "memory"); }
#undef EM_LOAD
        asm volatile("s_waitcnt vmcnt(0)" ::: "memory");
        if (fr == 0 && fq == 0) __hip_atomic_fetch_add(pcnt + 64 * u.pm, 1u, RLX_AGENT);
    }
};
struct EpiResid {
    static constexpr bool PERM = true, MIDK = false, FP8 = false;
    const float* basef; const bf16* baseh; bf16* out; gu32* pcnt;
    __device__ __forceinline__ void operator()(const f32x4 (&acc)[2][2][4][2], const Unit& u, int wr, int wc, int fr, int fq) const {
        asm volatile("" : "+v"(fr), "+v"(fq));
        const int row0 = u.pm * 256 + wr * 64 + fr, col0 = u.pn * 256 + wc * 32 + 8 * fq;
        const __amdgpu_buffer_rsrc_t rx = __builtin_amdgcn_make_buffer_rsrc(out, 0, SEQ * DM * 2, 0x00020000);
        if (basef) {
            f32x4 bb[2][4];
#define ER_LOAD(g, par) do { const size_t _o = (size_t)(row0 + ((g) >> 2) * 128 + ((g) & 3) * 16) * DM + col0; \
                bb[par][0] = *(const f32x4*)(basef + _o); bb[par][1] = *(const f32x4*)(basef + _o + 4); bb[par][2] = *(const f32x4*)(basef + _o + 128); bb[par][3] = *(const f32x4*)(basef + _o + 132); } while (0)
            ER_LOAD(0, 0); ER_LOAD(1, 1);
#pragma unroll
            for (int g = 0; g < 8; ++g) { const int ai = g >> 2, m = g & 3, par = g & 1; const size_t off = (size_t)(row0 + ai * 128 + m * 16) * DM + col0;
                const f32x4 o0 = bb[par][0] + acc[ai][0][m][0], o1 = bb[par][1] + acc[ai][0][m][1], o2 = bb[par][2] + acc[ai][1][m][0], o3 = bb[par][3] + acc[ai][1][m][1];
                if (g + 2 < 8) ER_LOAD(g + 2, par);
                u32x4 w0, w1; w0.x = cvt_pk_bf16(o0[0], o0[1]); w0.y = cvt_pk_bf16(o0[2], o0[3]); w0.z = cvt_pk_bf16(o1[0], o1[1]); w0.w = cvt_pk_bf16(o1[2], o1[3]);
                w1.x = cvt_pk_bf16(o2[0], o2[1]); w1.y = cvt_pk_bf16(o2[2], o2[3]); w1.z = cvt_pk_bf16(o3[0], o3[1]); w1.w = cvt_pk_bf16(o3[2], o3[3]);
                __builtin_amdgcn_raw_buffer_store_b128(w0, rx, (int)(off * 2), 0, 16); __builtin_amdgcn_raw_buffer_store_b128(w1, rx, (int)((off + 128) * 2), 0, 16);
                asm volatile("" ::: "memory"); }
#undef ER_LOAD
        } else {
            u32x4 hb[2][2];
#define ER_LOAD(g, par) do { const size_t _o = (size_t)(row0 + ((g) >> 2) * 128 + ((g) & 3) * 16) * DM + col0; hb[par][0] = *(const u32x4*)(baseh + _o); hb[par][1] = *(const u32x4*)(baseh + _o + 128); } while (0)
            ER_LOAD(0, 0); ER_LOAD(1, 1);
#pragma unroll
            for (int g = 0; g < 8; ++g) { const int ai = g >> 2, m = g & 3, par = g & 1; const size_t off = (size_t)(row0 + ai * 128 + m * 16) * DM + col0;
                u32x4 w[2];
#pragma unroll
                for (int bj = 0; bj < 2; ++bj) { const unsigned hv[4] = {hb[par][bj].x, hb[par][bj].y, hb[par][bj].z, hb[par][bj].w}; const f32x4 v0 = acc[ai][bj][m][0], v1 = acc[ai][bj][m][1];
                    w[bj].x = cvt_pk_bf16(bfl(hv[0]) + v0[0], bfh(hv[0]) + v0[1]); w[bj].y = cvt_pk_bf16(bfl(hv[1]) + v0[2], bfh(hv[1]) + v0[3]);
                    w[bj].z = cvt_pk_bf16(bfl(hv[2]) + v1[0], bfh(hv[2]) + v1[1]); w[bj].w = cvt_pk_bf16(bfl(hv[3]) + v1[2], bfh(hv[3]) + v1[3]); }
                if (g + 2 < 8) ER_LOAD(g + 2, par);
                __builtin_amdgcn_raw_buffer_store_b128(w[0], rx, (int)(off * 2), 0, 16); __builtin_amdgcn_raw_buffer_store_b128(w[1], rx, (int)((off + 128) * 2), 0, 16);
                asm volatile("" ::: "memory"); }
#undef ER_LOAD
        }
        asm volatile("s_waitcnt vmcnt(0)" ::: "memory");
        if (fr == 0 && fq == 0) __hip_atomic_fetch_add(pcnt + 64 * u.pm, 1u, RLX_AGENT);
    }
    __device__ __forceinline__ void mid(f32x4 (&)[2][2][4][2], const Unit&, int, int, int, int) const {}
};
__device__ __forceinline__ void moe_tile_of(const LAS int* tab, int s, int& e, int& j0) {
    const int nfull = __builtin_amdgcn_readfirstlane(tab[68]);
    e = 0;
    if (s < nfull) {
#pragma unroll
        for (int j = 1; j < 16; ++j) e += (__builtin_amdgcn_readfirstlane(tab[52 + j]) <= s) ? 1 : 0;
        j0 = s - __builtin_amdgcn_readfirstlane(tab[52 + e]);
    } else { const int p = s - nfull;
#pragma unroll
        for (int j = 1; j < 16; ++j) e += (__builtin_amdgcn_readfirstlane(tab[70 + j]) <= p) ? 1 : 0;
        j0 = __builtin_amdgcn_readfirstlane(tab[e + 1]) - __builtin_amdgcn_readfirstlane(tab[e]) - 1; }
    e = __builtin_amdgcn_readfirstlane(e); j0 = __builtin_amdgcn_readfirstlane(j0);
}
struct MoeSched1 {
    static constexpr bool GATHER = true, WAIT = false, HALF = true;
    const LAS int* tab; const char* H; const char* W; const int* toklist; int G, c;
    __device__ __forceinline__ bool next(int i, Unit& u) const {
        const int L = i * G + c; const int total = __builtin_amdgcn_readfirstlane(tab[16]) * 4; if (L >= total) return false;
        int e, j0; moe_tile_of(tab, L >> 2, e, j0); const int rt = __builtin_amdgcn_readfirstlane(tab[e]) + j0;
        u.pm = j0; u.pn = L & 3; u.kind = 0; u.e = e; u.rt = rt; u.row0 = __builtin_amdgcn_readfirstlane(tab[17 + e]) + 256 * j0;
        const int rem = __builtin_amdgcn_readfirstlane(tab[34 + e]) - 256 * j0; u.nvalid = rem < 256 ? rem : 256; u.half = __builtin_amdgcn_readfirstlane((rem <= 128) ? 1 : 0); return true;
    }
    __device__ __forceinline__ const char* a_base(const Unit&) const { return H; }
    __device__ __forceinline__ const char* b_base(const Unit& u) const { return W + ((size_t)u.e * 1024 + (size_t)u.pn * 256) * DM; }
    __device__ __forceinline__ unsigned a_goff(const Unit& u, int r) const { const int tok = (r < u.nvalid) ? toklist[u.e * SEQ + u.pm * 256 + r] : 0; return (unsigned)tok * (unsigned)DM; }
};
struct EpiMoe1 {
    static constexpr bool PERM = true, MIDK = false, FP8 = true;
    bf16* ACT; const float* wlist; const float* rslist; gu32* pcnt;
    __device__ __forceinline__ void operator()(const f32x4 (&acc)[2][2][4][2], const Unit& u, int wr, int wc, int fr, int fq) const {
        asm volatile("" : "+v"(fr), "+v"(fq));
        const int col0 = u.pn * 128 + wc * 32 + 8 * fq;
        const __amdgpu_buffer_rsrc_t ra = __builtin_amdgcn_make_buffer_rsrc(ACT, 0, 16640 * DEXP, 0x00020000);
#pragma unroll
        for (int ai = 0; ai < 2; ++ai)
#pragma unroll
            for (int m = 0; m < 4; ++m) { const int rl = ai * 128 + wr * 64 + m * 16 + fr;
                if (rl < u.nvalid) { const float wt = wlist[u.e * SEQ + u.pm * 256 + rl], rs = rslist[u.e * SEQ + u.pm * 256 + rl] * (1.0f / 64.0f);
                    const f32x4 g0 = acc[ai][0][m][0], g1 = acc[ai][0][m][1], u0 = acc[ai][1][m][0], u1 = acc[ai][1][m][1];
                    float o[8];
#pragma unroll
                    for (int j = 0; j < 4; ++j) { const float ga = g0[j] * rs, gb = g1[j] * rs; o[j] = ga * sigmoid_f(ga) * (u0[j] * rs) * wt; o[4 + j] = gb * sigmoid_f(gb) * (u1[j] * rs) * wt; }
#pragma unroll
                    for (int j = 0; j < 8; ++j) o[j] = __builtin_amdgcn_fmed3f(o[j] * 8.0f, -440.0f, 440.0f);
                    int wa = __builtin_amdgcn_cvt_pk_fp8_f32(o[0], o[1], 0, false); wa = __builtin_amdgcn_cvt_pk_fp8_f32(o[2], o[3], wa, true);
                    int wb = __builtin_amdgcn_cvt_pk_fp8_f32(o[4], o[5], 0, false); wb = __builtin_amdgcn_cvt_pk_fp8_f32(o[6], o[7], wb, true);
                    __builtin_amdgcn_raw_buffer_store_b64((u32x2){(unsigned)wa, (unsigned)wb}, ra, (int)((size_t)(u.row0 + rl) * DEXP + col0), 0, 16); } }
        asm volatile("s_waitcnt vmcnt(0)" ::: "memory");
        if (fr == 0 && fq == 0) __hip_atomic_fetch_add(pcnt + 64 * u.rt, 1u, RLX_AGENT);
    }
    __device__ __forceinline__ void mid(f32x4 (&)[2][2][4][2], const Unit&, int, int, int, int) const {}
};
struct MoeSched2 {
    static constexpr bool GATHER = false, WAIT = true, HALF = false;
    const LAS int* tab; const char* ACT; const char* W; int G, c; gu32* pcnt; gu32* tmo;
    __device__ __forceinline__ bool next(int i, Unit& u) const {
        if (c < 0) return false;
        const int L = i * G + c; const int total = __builtin_amdgcn_readfirstlane(tab[16]) * 8; if (L >= total) return false;
        int e, j0; moe_tile_of(tab, L >> 3, e, j0); const int rt = __builtin_amdgcn_readfirstlane(tab[e]) + j0;
        u.pm = j0; u.pn = L & 7; u.kind = 0; u.e = e; u.rt = rt; u.row0 = __builtin_amdgcn_readfirstlane(tab[17 + e]) + 256 * j0;
        const int rem = __builtin_amdgcn_readfirstlane(tab[34 + e]) - 256 * j0; u.nvalid = rem < 256 ? rem : 256; u.half = 0; return true;
    }
    __device__ __forceinline__ const char* a_base(const Unit& u) const { return ACT + (size_t)u.row0 * DEXP; }
    __device__ __forceinline__ const char* b_base(const Unit& u) const { return W + ((size_t)u.e * DM + (size_t)u.pn * 256) * DEXP; }
    __device__ __forceinline__ unsigned a_goff(const Unit&, int) const { return 0u; }
    __device__ __forceinline__ void a_ready(const Unit& u, int wid) const {
        if (wid == 0) {
            gu32* p = pcnt + 64 * u.rt; unsigned polls = 0;
            while ((unsigned)__builtin_amdgcn_readfirstlane(__hip_atomic_load(p, RLX_AGENT)) < 32u) {
                if (++polls > (1u << 22)) { if (threadIdx.x == 0) __hip_atomic_store(tmo, 1u, RLX_AGENT); break; }
                __builtin_amdgcn_s_sleep(2); }
            __builtin_amdgcn_fence(__ATOMIC_ACQUIRE, "agent");
            asm volatile("s_waitcnt vmcnt(0)" ::: "memory");
        }
        asm volatile("" ::: "memory"); __builtin_amdgcn_s_barrier(); asm volatile("" ::: "memory");
    }
};
struct EpiMoe2 {
    static constexpr bool PERM = true, MIDK = false, FP8 = true;
    bf16* MO;
    __device__ __forceinline__ void operator()(const f32x4 (&acc)[2][2][4][2], const Unit& u, int wr, int wc, int fr, int fq) const {
        asm volatile("" : "+v"(fr), "+v"(fq));
        const int col0 = u.pn * 256 + wc * 32 + 8 * fq;
#pragma unroll
        for (int ai = 0; ai < 2; ++ai)
#pragma unroll
            for (int m = 0; m < 4; ++m) { const int rl = ai * 128 + wr * 64 + m * 16 + fr;
                if (rl < u.nvalid) { bf16* rowp = MO + (size_t)(u.row0 + rl) * DM + col0;
#pragma unroll
                    for (int bj = 0; bj < 2; ++bj) { const f32x4 v0 = acc[ai][bj][m][0] * (1.0f / 512.0f), v1 = acc[ai][bj][m][1] * (1.0f / 512.0f);
                        u32x4 w; w.x = cvt_pk_bf16(v0[0], v0[1]); w.y = cvt_pk_bf16(v0[2], v0[3]); w.z = cvt_pk_bf16(v1[0], v1[1]); w.w = cvt_pk_bf16(v1[2], v1[3]);
                        *(u32x4*)(rowp + bj * 128) = w; } } }
    }
    __device__ __forceinline__ void mid(f32x4 (&)[2][2][4][2], const Unit&, int, int, int, int) const {}
};
__device__ __forceinline__ void moe_tables(Frame& F, int l) {
    LAS int* tab = (LAS int*)(F.lds + MISC_OFF + 128);
    __syncthreads();
    if (F.tid < 16) tab[34 + F.tid] = (int)__hip_atomic_load(F.ctl + CW_CNT + 64 * (16 * l + F.tid), RLX_AGENT);
    __syncthreads();
    if (F.tid == 0) { int tp = 0, off = 0, fp = 0, pp = 0;
        for (int e = 0; e < 16; ++e) { const int c = tab[34 + e]; tab[e] = tp; tab[17 + e] = off; tab[52 + e] = fp; tab[70 + e] = pp;
            const int nt = (c + 255) >> 8, part = (nt > 0 && (c - 256 * (nt - 1)) <= 128) ? 1 : 0; tp += nt; off += c; fp += nt - part; pp += part; }
        tab[68] = fp; tab[86] = pp;
        tab[16] = tp; tab[33] = off; }
    __syncthreads();
}

struct Args { const float* in[29]; float* out; unsigned char* ws; int ph_lo, ph_hi; };
constexpr int NPHASE = 17;
__global__ void __launch_bounds__(NTHR, 2) fwd_kernel(Args args) {
    extern __shared__ __attribute__((aligned(16))) unsigned char lds[];
    Frame F;
    F.lds = (LAS unsigned char*)lds;
    F.MISC = (volatile LAS unsigned*)(F.lds + MISC_OFF);
    F.tid = threadIdx.x; F.lane = F.tid & 63; F.wave = __builtin_amdgcn_readfirstlane(F.tid >> 6);
    F.G = gridDim.x; { const int bx = blockIdx.x; F.vcu = (F.G % 8 == 0) ? (bx % 8) * (F.G / 8) + bx / 8 : bx; }
    F.ws = args.ws; F.out = args.out; F.ctl = (gu32*)(args.ws + WS_CTL);
    for (int u = F.tid; u < 256; u += NTHR) ((LAS unsigned*)(F.lds + MISC_OFF))[u] = 0u;
    F.inp = (const LAS unsigned long long*)(F.lds + MISC_OFF + 640);
    __syncthreads();
#pragma unroll
    for (int i = 0; i < 29; ++i) if (F.tid == i) ((LAS unsigned long long*)(F.lds + MISC_OFF + 640))[i] = (unsigned long long)args.in[i];
    __syncthreads();
    const int lo = args.ph_lo, hi = args.ph_hi;
    const bool multi = (hi - lo) > 1;
    XcdBarrier bar; bar.bar = (unsigned*)(F.ctl + CW_BAR); bar.x = 0; bar.st = nullptr;
    if (multi) bar = xcd_barrier_post((unsigned*)(F.ctl + CW_BAR), F.MISC + 8);
#ifndef PHASE_MASK
#define PHASE_MASK 0x7ff
#endif
#define IN(k) (lo <= (k) && (k) < hi)
#define ON(j) ((PHASE_MASK >> (j)) & 1)
#ifndef DUP_MASK
#define DUP_MASK 0
#endif
#define REP(j) for (int _rep = 0; _rep < (((DUP_MASK >> (j)) & 1) ? 2 : 1); ++_rep)
#define LAUNDER() do { int _l; asm volatile("v_mbcnt_lo_u32_b32 %0, -1, 0\n\tv_mbcnt_hi_u32_b32 %0, -1, %0" : "=v"(_l)); F.lane = _l; F.tid = F.wave * 64 + _l; { unsigned char* _w = F.ws; asm volatile("" : "+s"(_w)); F.ws = _w; } } while (0)
#ifndef PROBE_K
#define PROBE_K -1
#endif
#ifndef PROBE_PART
#define PROBE_PART 0
#endif
#ifndef PROBE_AMP
#define PROBE_AMP 8
#endif
    volatile LAS unsigned long long* pr = (volatile LAS unsigned long long*)(F.lds + MISC_OFF + 512);
#ifndef PROBE_BLK
#define PROBE_BLK 0
#endif
#define PR_ME (blockIdx.x == PROBE_BLK && threadIdx.x == 0)
#define PSTART(j) do { if (PROBE_K == (j) && PROBE_PART != 1 && PR_ME) pr[0] = __builtin_amdgcn_s_memrealtime(); } while (0)
#define PEND(j) do { if (PROBE_K == (j) && PR_ME) { const unsigned long long _n = __builtin_amdgcn_s_memrealtime(); if (PROBE_PART == 0 || (PROBE_PART == 2 && (j) == 8)) pr[1] += _n - pr[0]; else if (PROBE_PART == 1) pr[0] = _n; } } while (0)
#define PBAR(j) do { if (PROBE_K == (j) && PROBE_PART >= 1 && PR_ME) pr[1] += __builtin_amdgcn_s_memrealtime() - pr[0]; } while (0)
#define SEAM(k) do { if (IN(k) && IN((k) + 1)) xcd_barrier(bar); } while (0)
    const int gw = F.vcu * NWAVES + F.wave, NGW = F.G * NWAVES;
    for (int l = 0; l < DEPTH; ++l) {
        const int p0 = l * 8;
        if (ON(0) && IN(p0 + 0)) { LAUNDER(); PSTART(0);
            PSTART(10); if (l == 0) pa_convert_features(F); PEND(10);
            PSTART(11); if (l == 0) { for (int ll = 0; ll < DEPTH; ++ll) pa_router_t(F, ll); } PEND(11);
            PSTART(13);
            const float* g = inp(F, I_GMIX) + (size_t)l * DM;
            if (l == 0) { for (int m = gw; m < SEQ; m += 4 * NGW) norm_rows<0, false, 4>(F, m, NGW, inp(F, I_X), g, nullptr, nullptr); }
            else { for (int m = gw; m < SEQ; m += 2 * NGW) norm_rows<1, false, 2>(F, m, NGW, nullptr, g, F.ctl + CW_CNT + 64 * 16 * (l - 1), nullptr); }
            PEND(13);
        }
        PEND(0); SEAM(p0 + 0); PBAR(0);
        if (ON(1) && IN(p0 + 1)) { LAUNDER(); PSTART(1);
            InProjSched S{(const char*)(F.ws + WS_XN), (const char*)(F.ws + ((l & 1) ? WS_WIN2 : WS_WIN)), F.G, (int)blockIdx.x};
            EpiInProj E{(bf16*)(F.ws + WS_ZT), (bf16*)(F.ws + WS_U), inp(F, I_BIN) + (size_t)l * NIN, F.ctl + CW_ZT + 64 * 16 * l, F.ctl + CW_UG + 64 * 32 * l};
            REP(1) pg8::gemm_phase<EpiInProj, InProjSched>(F.lds, DM, S, E, F.tid);
            LAUNDER();
            GateSched8 S8{(const char*)(F.ws + WS_XN8), (const char*)(F.ws + WS_WIN8 + (size_t)(l & 1) * 8 * MiB), F.G, (int)blockIdx.x};
            EpiGate8 E8{(unsigned char*)(F.ws + WS_GH), (unsigned char*)(F.ws + WS_GS), inp(F, I_BIN) + (size_t)l * NIN};
            REP(1) pg8::gemm_phase<EpiGate8, GateSched8>(F.lds, DM / 2, S8, E8, F.tid);
        }
        PEND(1); PBAR(1);
        if (ON(2) && IN(p0 + 2)) { LAUNDER(); PSTART(2);
            if (ON(9)) {
                volatile LAS int* qs = (volatile LAS int*)(F.lds + MISC_OFF + 96);
                for (;;) { __syncthreads();
                    if (F.tid == 0) qs[0] = (int)__hip_atomic_fetch_add(F.ctl + CW_SGUQ + 64 * l, 1u, RLX_AGENT);
                    __syncthreads();
                    const int u = __builtin_amdgcn_readfirstlane(qs[0]); if (u >= 256) break;
                    sgu_pair(F, l, u >> 2, u & 3); } }
            if (ON(10)) REP(10) for (int b = F.vcu; b < 256; b += F.G) hyena_block(F, l, b);
        }
        PEND(2); SEAM(p0 + 2); PBAR(2);
        if (ON(3) && IN(p0 + 3)) { LAUNDER(); PSTART(3);
            GridSched S{(const char*)(F.ws + WS_Y), (const char*)(F.ws + WS_PT), 32, 8, DM, F.G, (int)blockIdx.x};
            EpiMerge E{(const unsigned char*)(F.ws + WS_GH), (const unsigned char*)(F.ws + WS_GS), (bf16*)(F.ws + WS_MERGED), F.ctl + CW_MG + 64 * 32 * l};
            REP(3) pg8::gemm_phase<EpiMerge, GridSched>(F.lds, DM, S, E, F.tid);
        }
        PEND(3); PBAR(3);
        if (ON(4) && IN(p0 + 4)) { LAUNDER(); PSTART(4);
            GridSchedW S; S.A = (const char*)(F.ws + WS_MERGED); S.Bt = (const char*)(F.ws + WS_WOT); S.nM = 32; S.nN = 8; S.K = DM; S.G = F.G; S.c = (int)blockIdx.x;
            S.pcnt = F.ctl + CW_MG + 64 * 32 * l; S.need = 64u; S.tmo = F.ctl + CW_TMO;
            EpiResid E{l == 0 ? inp(F, I_X) : nullptr, (const bf16*)(F.ws + WS_XR), (bf16*)(F.ws + WS_XR), F.ctl + CW_XR + 64 * 32 * l};
            REP(4) pg8::gemm_phase<EpiResid, GridSchedW>(F.lds, DM, S, E, F.tid);
        }
        PEND(4); PBAR(4);
        if (ON(5) && IN(p0 + 5)) { LAUNDER(); PSTART(5); for (int tb = F.vcu * 32; tb < SEQ; tb += F.G * 32) route_block(F, l, tb); }
        PEND(5); SEAM(p0 + 5); PBAR(5);
        if (ON(6) && IN(p0 + 6)) { LAUNDER(); PSTART(6);
            moe_tables(F, l);
            gu32* pc = F.ctl + CW_PANEL + 64 * 128 * l;
            {
                MoeSched1 S{(const LAS int*)(F.lds + MISC_OFF + 128), (const char*)(F.ws + WS_XN), (const char*)(F.ws + WS_WGU), (const int*)(F.ws + WS_LISTS), F.G, F.vcu};
                EpiMoe1 E{(bf16*)(F.ws + WS_ACT), (const float*)(F.ws + WS_LISTS + 512 * 1024), (const float*)(F.ws + WS_LISTS + 1 * MiB + 512 * 1024), pc};
                pg8::gemm_phase<EpiMoe1, MoeSched1>(F.lds, DM / 2, S, E, F.tid);
            }
            {
                LAUNDER();
                const int ng = __builtin_amdgcn_readfirstlane(((const LAS int*)(F.lds + MISC_OFF + 128))[16]) * 4;
                int n2 = ng - F.G; n2 = n2 < 0 ? 0 : n2; if (n2 >= F.G) n2 = 0;
                MoeSched2 S{(const LAS int*)(F.lds + MISC_OFF + 128), (const char*)(F.ws + WS_ACT), (const char*)(F.ws + WS_WD), F.G - n2, F.vcu - n2, pc, F.ctl + CW_TMO};
                EpiMoe2 E{(bf16*)(F.ws + WS_MOEOUT)};
                pg8::gemm_phase<EpiMoe2, MoeSched2>(F.lds, DEXP / 2, S, E, F.tid);
            }
        }
        PEND(6); SEAM(p0 + 6); PBAR(6);
    }
    if (ON(8) && IN(16)) { LAUNDER(); PSTART(8); for (int m = gw; m < SEQ; m += 2 * NGW) norm_rows<1, true, 2>(F, m, NGW, nullptr, inp(F, I_GFINAL), F.ctl + CW_CNT + 64 * 16 * (DEPTH - 1), F.out); }
    PEND(8);
    if (PROBE_K >= 0 && PR_ME) { const unsigned long long t0 = __builtin_amdgcn_s_memrealtime(), amt = pr[1] * PROBE_AMP; while (__builtin_amdgcn_s_memrealtime() - t0 < amt) __builtin_amdgcn_s_sleep(8); }
#undef IN
#undef SEAM
}

#ifndef MK_ONE_LAUNCH
#define MK_ONE_LAUNCH 0
#endif
extern "C" void kernel_launch(void* const* d_in, const int* in_sizes, int n_in, void* d_out, int out_size, void* d_ws, size_t ws_size, hipStream_t stream) {
    static int grid = 0;
    if (grid == 0) {
        if (n_in != 29 || ws_size < WS_END) { fprintf(stderr, "kernel_launch: unexpected n_in %d or ws %zu < %zu\n", n_in, ws_size, (size_t)WS_END); grid = -1; return; }
        int dev = 0, cus = 0, per_cu = 0;
        if (hipGetDevice(&dev) != hipSuccess || hipDeviceGetAttribute(&cus, hipDeviceAttributeMultiprocessorCount, dev) != hipSuccess) { grid = -1; return; }
        if (hipFuncSetAttribute((const void*)fwd_kernel, hipFuncAttributeMaxDynamicSharedMemorySize, LDS_BYTES) != hipSuccess) { fprintf(stderr, "kernel_launch: hipFuncSetAttribute failed\n"); grid = -1; return; }
        if (hipOccupancyMaxActiveBlocksPerMultiprocessor(&per_cu, (const void*)fwd_kernel, NTHR, LDS_BYTES) != hipSuccess || per_cu < 1) fprintf(stderr, "kernel_launch: occupancy query reports %d\n", per_cu);
        (void)hipGetLastError();
        grid = cus;
    }
    if (grid < 0) return;
    (void)hipMemsetAsync((char*)d_ws + WS_CTL, 0, CTL_ZERO_BYTES, stream);
    Args a{};
    for (int i = 0; i < 29; ++i) a.in[i] = (const float*)d_in[i];
    a.out = (float*)d_out; a.ws = (unsigned char*)d_ws;
#if MK_ONE_LAUNCH
    a.ph_lo = 0; a.ph_hi = NPHASE;
    hipLaunchKernelGGL(fwd_kernel, dim3(grid), dim3(NTHR), LDS_BYTES, stream, a);
#else
    for (int p = 0; p < NPHASE; ++p) { a.ph_lo = p; a.ph_hi = p + 1; hipLaunchKernelGGL(fwd_kernel, dim3(grid), dim3(NTHR), LDS_BYTES, stream, a); }
#endif
}
```

```cpp
#include <hip/hip_runtime.h>
#include <cstdio>
#include <cstdint>
#define MK_ONE_LAUNCH 1
#define DUP_MASK 0
#define PROBE_K -1
#define PROBE_PART 0
#define PROBE_BLK 0
namespace pg8 {
#define PG8_LAS __attribute__((address_space(3)))
typedef unsigned short bf16_t;
typedef short bf16x8 __attribute__((ext_vector_type(8)));
typedef float f32x4 __attribute__((ext_vector_type(4)));
typedef float f32x2 __attribute__((ext_vector_type(2)));
typedef unsigned u32x4 __attribute__((ext_vector_type(4)));
typedef unsigned u32x2 __attribute__((ext_vector_type(2)));
typedef int v4i __attribute__((ext_vector_type(4)));
typedef int v8i __attribute__((ext_vector_type(8)));
typedef int v32i __attribute__((ext_vector_type(32)));
constexpr int BM = 256, BK = 64, HALF = 128, HTB = HALF * BK * 2  , STAGE_BYTES = 8 * HTB;
constexpr int GATHER_SLOT_OFF = 2 * 8448 * 8 + 1024;

__host__ __device__ __forceinline__ int lds_byte(int r, int c) { const int st = (r >> 4) * 2 + (c >> 5), rr = r & 15, cc = c & 31, ob = rr * 64 + cc * 2; return st * 1024 + (ob ^ (((ob >> 9) & 1) << 5)); }
__host__ __device__ __forceinline__ void stage_rc(int b, int& R, int& C) { const int st = b / 1024, sb = b % 1024, swz = sb ^ (((sb >> 9) & 1) << 5); R = (st >> 1) * 16 + swz / 64; C = (st & 1) * 32 + (swz % 64) / 2; }
__host__ __device__ __forceinline__ int perm32(int rho) { const int n = rho >> 4, i = rho & 15; return 8 * (i >> 2) + 4 * n + (i & 3); }

struct Unit { int pm, pn, kind, e, row0, nvalid, rt, half; };

__device__ __forceinline__ unsigned cvt_pk_bf16(float lo, float hi) { unsigned r; asm volatile("v_cvt_pk_bf16_f32 %0, %1, %2" : "=v"(r) : "v"(lo), "v"(hi)); return r; }
__device__ __forceinline__ f32x2 gelu_pk(f32x2 v) {
    const f32x2 av = __builtin_elementwise_abs(v), d = av * 0.2316418882f + 1.0f;
    f32x2 t; t.x = __builtin_amdgcn_rcpf(d.x); t.y = __builtin_amdgcn_rcpf(d.y);
    f32x2 q = t * 0.5307027145f + (-0.7265760135f); q = q * t + 0.7107068705f; q = q * t + (-0.142248368f); q = q * t + 0.127414796f; q = q * t;
    const f32x2 s = (v * v) * (-0.72134752044f);
    f32x2 e; e.x = __builtin_amdgcn_exp2f(s.x); e.y = __builtin_amdgcn_exp2f(s.y);
    const f32x2 m = v * (q * e), r = v - m;
    f32x2 o; o.x = v.x < 0.f ? m.x : r.x; o.y = v.y < 0.f ? m.y : r.y; return o;
}
__device__ __forceinline__ float sigmoid_f(float x) { return __builtin_amdgcn_rcpf(1.0f + __builtin_amdgcn_exp2f(-1.4426950408889634f * x)); }

__device__ __forceinline__ int fresh_tid(int wid) { int l; asm volatile("v_mbcnt_lo_u32_b32 %0, -1, 0\n\tv_mbcnt_hi_u32_b32 %0, -1, %0" : "=v"(l)); return wid * 64 + l; }
__device__ __forceinline__ const char* uni_ptr(const char* p) { const unsigned long long v = (unsigned long long)p; const unsigned lo = __builtin_amdgcn_readfirstlane((unsigned)v), hi = __builtin_amdgcn_readfirstlane((unsigned)(v >> 32)); return (const char*)(((unsigned long long)hi << 32) | lo); }
template <class Epi, class Sched>
__device__ __forceinline__ void gemm_phase(PG8_LAS unsigned char* lds, const int K, const Sched& S, const Epi& E, int tid) {
    asm volatile("" : "+v"(tid));
    const int wid = __builtin_amdgcn_readfirstlane(tid >> 6), lane = tid & 63, wr = wid >> 2, wc = wid & 3, fr = lane & 15, fq = lane >> 4;
    const int nt = K / BK;
    unsigned voffA[2], voffB[2];
#pragma unroll
    for (int i = 0; i < 2; ++i) { int R, C; stage_rc(tid * 16 + i * 8192, R, C); const int Rb = Epi::PERM ? ((R & ~31) + perm32(R & 31)) : R;
        voffA[i] = Sched::GATHER ? 0u : (unsigned)(R * K + C) * 2u; voffB[i] = (unsigned)(Rb * K + C) * 2u; }
#define PG8_GOFF(u, h, i) ({ int _R, _C, _t = fresh_tid(wid); stage_rc(_t * 16 + (i) * 8192, _R, _C); S.a_goff((u), (h) * HALF + _R) + (unsigned)(_C * 2); })
    const size_t kstep = (size_t)(BK * 2);
    const size_t hstep = (size_t)HALF * K * 2;
    const unsigned ldsw = (unsigned)wid * 1024u;
    const int aoff = lds_byte(wr * 64 + fr, fq * 8);
    int boff = lds_byte(wc * 32 + fr, fq * 8) + 4 * HTB; asm volatile("" : "+v"(boff));
#define PG8_SA(b, h) (((b) * 2 + (h)) * HTB)
#define PG8_SB(b, h) ((4 + (b) * 2 + (h)) * HTB)
#define PG8_STAGE(bufoff, gbase, voff) do { _Pragma("unroll") for (int _i = 0; _i < 2; ++_i) { unsigned _v = (voff)[_i]; asm volatile("" : "+v"(_v)); \
        __builtin_amdgcn_global_load_lds((const unsigned*)((const char*)(gbase) + _v), (PG8_LAS unsigned*)(lds + (bufoff) + ldsw + _i * 8192), 16, 0, 0); } } while (0)
#define PG8_STAGE_A(bufoff, gbase, h, GO) do { if constexpr (Sched::GATHER) { _Pragma("unroll") for (int _i = 0; _i < 2; ++_i) { unsigned _v = (GO)[h][_i]; asm volatile("" : "+v"(_v)); \
        __builtin_amdgcn_global_load_lds((const unsigned*)((const char*)(gbase) + _v), (PG8_LAS unsigned*)(lds + (bufoff) + ldsw + _i * 8192), 16, 0, 0); } } \
        else { PG8_STAGE(bufoff, (gbase) + (h) * hstep, voffA); } } while (0)
#define PG8_LD16(off) (*(const PG8_LAS v4i*)(lds + (off)))
#define PG8_INS4(V, pos, val) do { const v4i _q = (val); (V)[(pos)] = _q[0]; (V)[(pos) + 1] = _q[1]; (V)[(pos) + 2] = _q[2]; (V)[(pos) + 3] = _q[3]; } while (0)
#define PG8_LDA(dst, b, h) do { if constexpr (Epi::FP8) { _Pragma("unroll") for (int m = 0; m < 4; ++m) { PG8_INS4(At8, 8 * m, PG8_LD16(PG8_SA(b, h) + aoff + m * 2048)); PG8_INS4(At8, 8 * m + 4, PG8_LD16(PG8_SA(b, h) + aoff + m * 2048 + 1024)); } } \
        else { _Pragma("unroll") for (int m = 0; m < 4; ++m) _Pragma("unroll") for (int k = 0; k < 2; ++k) dst[m][k] = *(const PG8_LAS bf16x8*)(lds + PG8_SA(b, h) + aoff + m * 2048 + k * 1024); } } while (0)
#define PG8_LDB(dst, b, h) do { if constexpr (Epi::FP8) { _Pragma("unroll") for (int n = 0; n < 2; ++n) { PG8_INS4(Bq8, 16 * (h) + 8 * n, PG8_LD16(PG8_SB(b, h) - 4 * HTB + boff + n * 2048)); PG8_INS4(Bq8, 16 * (h) + 8 * n + 4, PG8_LD16(PG8_SB(b, h) - 4 * HTB + boff + n * 2048 + 1024)); } } \
        else { _Pragma("unroll") for (int n = 0; n < 2; ++n) _Pragma("unroll") for (int k = 0; k < 2; ++k) dst[n][k] = *(const PG8_LAS bf16x8*)(lds + boff + (PG8_SB(b, h) - 4 * HTB + n * 2048 + k * 1024)); } } while (0)
#define PG8_SUB8(V, p) (v8i{(V)[(p)], (V)[(p) + 1], (V)[(p) + 2], (V)[(p) + 3], (V)[(p) + 4], (V)[(p) + 5], (V)[(p) + 6], (V)[(p) + 7]})
#define PG8_MMA(ai, bj, At, Bt) do { __builtin_amdgcn_s_setprio(1); _Pragma("unroll") for (int m = 0; m < 4; ++m) _Pragma("unroll") for (int n = 0; n < 2; ++n) { \
        if constexpr (Epi::FP8) { acc[ai][bj][m][n] = __builtin_amdgcn_mfma_scale_f32_16x16x128_f8f6f4(PG8_SUB8(Bq8, 16 * (bj) + 8 * n), PG8_SUB8(At8, 8 * m), acc[ai][bj][m][n], 0, 0, 0, 0, 0, 0); } \
        else { _Pragma("unroll") for (int k = 0; k < 2; ++k) acc[ai][bj][m][n] = __builtin_amdgcn_mfma_f32_16x16x32_bf16(Bt[n][k], At[m][k], acc[ai][bj][m][n], 0, 0, 0); } } \
        __builtin_amdgcn_s_setprio(0); } while (0)
#define PG8_WAIT_V(n) asm volatile("s_waitcnt vmcnt(" #n ")" ::: "memory")
#define PG8_WAIT_L(n) asm volatile("s_waitcnt lgkmcnt(" #n ")" ::: "memory")
#define PG8_BAR __builtin_amdgcn_s_barrier()
#define PG8_SCHED __builtin_amdgcn_sched_barrier(0)
    Unit cur, nxt; int ui = 0;
    if (!S.next(0, cur)) return;
    f32x4 acc[2][2][4][2];
#pragma unroll
    for (int a = 0; a < 2; ++a)
#pragma unroll
        for (int b = 0; b < 2; ++b)
#pragma unroll
            for (int m = 0; m < 4; ++m)
#pragma unroll
                for (int n = 0; n < 2; ++n) acc[a][b][m][n] = (f32x4){0.f, 0.f, 0.f, 0.f};
    bf16x8 At[4][2], B0[2][2], B1[2][2];
    v32i At8, Bq8;
    const char* cA = uni_ptr(S.a_base(cur)); const char* cB = uni_ptr(S.b_base(cur));
    if constexpr (Sched::WAIT) S.a_ready(cur, wid);
    unsigned cgo[2][2];
#define PG8_GSLOT ((PG8_LAS u32x4*)(lds + GATHER_SLOT_OFF) + fresh_tid(wid))
    if constexpr (Sched::GATHER) {
#pragma unroll
        for (int h = 0; h < 2; ++h)
#pragma unroll
            for (int i = 0; i < 2; ++i) cgo[h][i] = PG8_GOFF(cur, h, i);
    }
    PG8_STAGE(PG8_SB(0, 0), cB, voffB); PG8_STAGE(PG8_SB(0, 1), cB + hstep, voffB); PG8_STAGE_A(PG8_SA(0, 0), cA, 0, cgo); PG8_STAGE_A(PG8_SA(0, 1), cA, 1, cgo);
    if (wr == 1) PG8_BAR;
    PG8_WAIT_V(2); PG8_BAR;
    PG8_STAGE(PG8_SB(1, 0), cB + kstep, voffB); PG8_STAGE_A(PG8_SA(1, 0), cA + kstep, 0, cgo); PG8_STAGE(PG8_SB(1, 1), cB + hstep + kstep, voffB);
    PG8_WAIT_V(6); PG8_BAR;
    for (;;) {
        const bool has_next = S.next(ui + 1, nxt);
        const char* nA = uni_ptr(has_next ? S.a_base(nxt) : cA); const char* nB = uni_ptr(has_next ? S.b_base(nxt) : cB);
        if constexpr (Sched::GATHER) {
            u32x4 nx = (u32x4){cgo[0][0], cgo[0][1], cgo[1][0], cgo[1][1]};
            if (has_next) { nx.x = PG8_GOFF(nxt, 0, 0); nx.y = PG8_GOFF(nxt, 0, 1); nx.z = PG8_GOFF(nxt, 1, 0); nx.w = PG8_GOFF(nxt, 1, 1); }
            *PG8_GSLOT = nx;
        }
#pragma nounroll
        for (int t = 0; t < nt; t += 2) {
            const bool last = (t == nt - 2);
            if constexpr (Sched::WAIT) { if (last && has_next) S.a_ready(nxt, wid); }
            if constexpr (Epi::MIDK) { if (t == (nt >> 1)) { const int tl = fresh_tid(wid); E.mid(acc, cur, wr, wc, tl & 15, (tl >> 4) & 3); } }
            const char* a1 = cA + (size_t)(t + 1) * kstep;
            const char* a2 = last ? nA : cA + (size_t)(t + 2) * kstep; const char* b2 = last ? nB : cB + (size_t)(t + 2) * kstep;
            const char* a3 = a2 + kstep; const char* b3 = b2 + kstep;
            unsigned xgo[2][2];
            if constexpr (Sched::GATHER) {
                if (last) { const u32x4 nx = *PG8_GSLOT; xgo[0][0] = nx.x; xgo[0][1] = nx.y; xgo[1][0] = nx.z; xgo[1][1] = nx.w; }
                else { xgo[0][0] = cgo[0][0]; xgo[0][1] = cgo[0][1]; xgo[1][0] = cgo[1][0]; xgo[1][1] = cgo[1][1]; }
            }
            PG8_LDB(B0, 0, 0); PG8_LDB(B1, 0, 1); PG8_SCHED; PG8_LDA(At, 0, 0); PG8_STAGE_A(PG8_SA(1, 1), a1, 1, cgo);
            PG8_WAIT_V(8); PG8_WAIT_L(0); PG8_BAR; PG8_MMA(0, 0, At, B0); PG8_MMA(0, 1, At, B1); PG8_BAR; PG8_SCHED;
            PG8_LDA(At, 0, 1); PG8_STAGE(PG8_SB(0, 0), b2, voffB); PG8_STAGE(PG8_SB(0, 1), b2 + hstep, voffB); PG8_STAGE_A(PG8_SA(0, 0), a2, 0, xgo);
            PG8_WAIT_V(8); PG8_WAIT_L(0); PG8_BAR; if (!Sched::HALF || !cur.half) { PG8_MMA(1, 0, At, B0); PG8_MMA(1, 1, At, B1); } PG8_BAR; PG8_SCHED;
            PG8_LDB(B0, 1, 0); PG8_LDB(B1, 1, 1); PG8_SCHED; PG8_LDA(At, 1, 0); PG8_STAGE_A(PG8_SA(0, 1), a2, 1, xgo);
            PG8_WAIT_V(8); PG8_WAIT_L(0); PG8_BAR; PG8_MMA(0, 0, At, B0); PG8_MMA(0, 1, At, B1); PG8_BAR; PG8_SCHED;
            PG8_LDA(At, 1, 1); PG8_STAGE(PG8_SB(1, 0), b3, voffB); PG8_STAGE(PG8_SB(1, 1), b3 + hstep, voffB); PG8_STAGE_A(PG8_SA(1, 0), a3, 0, xgo);
            PG8_WAIT_V(8); PG8_WAIT_L(0); PG8_BAR; if (!Sched::HALF || !cur.half) { PG8_MMA(1, 0, At, B0); PG8_MMA(1, 1, At, B1); } PG8_BAR; PG8_SCHED;
        }
        if (wr == 0) PG8_BAR;
        { const int tl = fresh_tid(wid); E(acc, cur, wr, wc, tl & 15, (tl >> 4) & 3); }
        if (!has_next) break;
#pragma unroll
        for (int a = 0; a < 2; ++a)
#pragma unroll
            for (int b = 0; b < 2; ++b)
#pragma unroll
                for (int m = 0; m < 4; ++m)
#pragma unroll
                    for (int n = 0; n < 2; ++n) acc[a][b][m][n] = (f32x4){0.f, 0.f, 0.f, 0.f};
        cur = nxt; cA = nA; cB = nB; ++ui;
        if constexpr (Sched::GATHER) { const u32x4 nx = *PG8_GSLOT; cgo[0][0] = nx.x; cgo[0][1] = nx.y; cgo[1][0] = nx.z; cgo[1][1] = nx.w; }
        if (wr == 1) PG8_BAR;
    }
    PG8_WAIT_V(0);
    PG8_BAR;
#undef PG8_SA
#undef PG8_SB
#undef PG8_STAGE
#undef PG8_STAGE_A
#undef PG8_GOFF
#undef PG8_GSLOT
#undef PG8_LDA
#undef PG8_LDB
#undef PG8_MMA
#undef PG8_WAIT_V
#undef PG8_WAIT_L
#undef PG8_BAR
#undef PG8_SCHED
}
}
constexpr int NWAVES = 8, NTHR = 512;
constexpr int SEQ = 8192, DM = 2048, NIN = 9216, HYW = 1024, SGW = 1024, NHY = 3072, NEXP = 16, DEXP = 512, DEPTH = 2;
constexpr float EPS = 1e-6f;
constexpr size_t MiB = 1u << 20;
constexpr size_t WS_CTL = 0, CTL_ZERO_BYTES = 1 * MiB;
constexpr size_t WS_WIN = 1 * MiB;
constexpr size_t WS_WIN2 = WS_WIN + 36 * MiB;
constexpr size_t WS_PT = WS_WIN2 + 36 * MiB;
constexpr size_t WS_WOT = WS_PT + 8 * MiB;
constexpr size_t WS_WGU = WS_WOT + 8 * MiB;
constexpr size_t WS_WD = WS_WGU + 64 * MiB;
constexpr size_t WS_W3T = WS_WD + 32 * MiB;
constexpr size_t WS_A2 = WS_W3T + 1 * MiB;
constexpr size_t WS_WR = WS_A2 + 2 * MiB;
constexpr size_t WS_LISTS = WS_WR + 1 * MiB;
constexpr size_t WS_XR = WS_LISTS + 2 * MiB;
constexpr size_t WS_XN = WS_XR + 64 * MiB;
constexpr size_t WS_ZT = WS_XN + 32 * MiB;
constexpr size_t WS_U = WS_ZT + 48 * MiB;
constexpr size_t WS_GV = WS_U + 16 * MiB;
constexpr size_t WS_GH = WS_GV + 16 * MiB;
constexpr size_t WS_GS = WS_GH + 32 * MiB;
constexpr size_t WS_Y = WS_GS + 32 * MiB;
constexpr size_t WS_FS = WS_Y + 32 * MiB;
constexpr size_t WS_END = WS_FS + 64 * MiB;
constexpr size_t WS_MERGED = WS_ZT, WS_ACT = WS_U, WS_MOEOUT = WS_FS;
constexpr size_t WS_XN8 = WS_END;
constexpr size_t WS_WIN8 = WS_XN8 + 16 * MiB;
constexpr int CW_TMO = 0;
constexpr int CW_CNT = 8192;
constexpr int CW_BAR = 4096;
constexpr int CW_ZT = 32768;
constexpr int CW_UG = 36864;
constexpr int CW_MG = 49152;
constexpr int CW_XR = 53248;
constexpr int CW_SGUQ = 45056;
constexpr int CW_PANEL = 16384;
constexpr int SCRATCH_BYTES = 2 * 8448 * 8;
constexpr int MISC_OFF = SCRATCH_BYTES;
constexpr int CVS_OFF = MISC_OFF + 1024;
constexpr int LDS_BYTES = SCRATCH_BYTES + 1024 + 8 * 2304;
static_assert(pg8::GATHER_SLOT_OFF == MISC_OFF + 1024, "gather slots");
static_assert(SCRATCH_BYTES >= pg8::STAGE_BYTES, "lds");

#define GAS __attribute__((address_space(1)))
#define LAS __attribute__((address_space(3)))
typedef unsigned short bf16;
typedef unsigned v4u __attribute__((ext_vector_type(4)));
typedef unsigned v2u __attribute__((ext_vector_type(2)));
typedef float f32x4 __attribute__((ext_vector_type(4)));
typedef short bf16x8 __attribute__((ext_vector_type(8)));
typedef GAS unsigned gu32;
#define RLX_AGENT __ATOMIC_RELAXED, __HIP_MEMORY_SCOPE_AGENT
#define LDS_WAIT() asm volatile("s_waitcnt lgkmcnt(0)" ::: "memory")
#define VM_WAIT() asm volatile("s_waitcnt vmcnt(0)" ::: "memory")
__device__ __forceinline__ unsigned f2bf(float f) { unsigned u = __builtin_bit_cast(unsigned, f); return (u + 0x7fffu + ((u >> 16) & 1u)) >> 16; }
__device__ __forceinline__ unsigned pk2(float lo, float hi) { return f2bf(lo) | (f2bf(hi) << 16); }
__device__ __forceinline__ unsigned pk2h(float lo, float hi) { unsigned r; asm("v_cvt_pk_bf16_f32 %0, %1, %2" : "=v"(r) : "v"(lo), "v"(hi)); return r; }
__device__ __forceinline__ float bfl(unsigned u) { return __builtin_bit_cast(float, u << 16); }
__device__ __forceinline__ float bfh(unsigned u) { return __builtin_bit_cast(float, u & 0xffff0000u); }

#define XB_TMO      128
#define XB_XCNT(j)  (256  + 64 * (j))
#define XB_XSUB(j)  (1280 + 64 * (j))
#define XB_XGEN(j)  (2304 + 64 * (j))
#define XB_TOP      3328
#define XB_TOPGEN   3392
#define XCD_BAR_WORDS 3456
#define XB_SPIN_CAP (1u << 18)
__device__ __forceinline__ unsigned xb_ld(unsigned* p)              { return __hip_atomic_load(p, __ATOMIC_RELAXED, __HIP_MEMORY_SCOPE_AGENT); }
__device__ __forceinline__ unsigned xb_add(unsigned* p, unsigned v) { return __hip_atomic_fetch_add(p, v, __ATOMIC_RELAXED, __HIP_MEMORY_SCOPE_AGENT); }
__device__ __forceinline__ unsigned xb_xcc_id() { return (unsigned)__builtin_amdgcn_s_getreg((3 << 11) | 20) & 0xFu; }
#define XB_SPIN(cond, bar) do { unsigned _sp = 0; while (cond) { __builtin_amdgcn_s_sleep(1); \
    if ((++_sp & 255u) == 0u) { if (xb_ld(&(bar)[XB_TMO])) break; if (_sp > XB_SPIN_CAP) { atomicAdd(&(bar)[XB_TMO], 1u); break; } } } } while (0)
struct XcdBarrier { unsigned* bar; unsigned x; volatile LAS unsigned* st; };
__device__ __forceinline__ XcdBarrier xcd_barrier_post(unsigned* bar, volatile LAS unsigned* st) {
    XcdBarrier b; b.bar = bar; b.x = xb_xcc_id(); b.st = st;
    if (threadIdx.x == 0) (void)xb_add(&bar[XB_XCNT(b.x)], 1u);
    return b;
}
__device__ __forceinline__ void xcd_barrier_complete(unsigned* bar, unsigned x, unsigned& nloc, unsigned& nx) {
    const unsigned G = gridDim.x * gridDim.y * gridDim.z;
    unsigned sum, cnt, mine, sp = 0u;
    for (;;) {
        sum = 0u; cnt = 0u; mine = 0u;
#pragma unroll
        for (unsigned j = 0; j < 16; ++j) { const unsigned c = xb_ld(&bar[XB_XCNT(j)]); sum += c; cnt += (c > 0u) ? 1u : 0u; mine = (j == x) ? c : mine; }
        if (sum == G) break;
        __builtin_amdgcn_s_sleep(1);
        if ((++sp & 255u) == 0u) { if (xb_ld(&bar[XB_TMO])) break; if (sp > XB_SPIN_CAP) { atomicAdd(&bar[XB_TMO], 1u); break; } }
    }
    nloc = mine > 0u ? mine : 1u; nx = cnt > 0u ? cnt : 1u;
}
__device__ __forceinline__ void xcd_barrier(const XcdBarrier& b) {
    asm volatile("s_waitcnt vmcnt(0)" ::: "memory");
    __syncthreads();
    if (threadIdx.x == 0) {
        unsigned* bar = b.bar;
        __builtin_amdgcn_s_waitcnt(0);
        unsigned nloc = b.st[0], nx = b.st[1];
        if (nloc == 0u) { xcd_barrier_complete(bar, b.x, nloc, nx); b.st[0] = nloc; b.st[1] = nx; }
        const unsigned old = xb_add(&bar[XB_XSUB(b.x)], 1u);
        const unsigned gen = old / nloc;
        if (old + 1u == (gen + 1u) * nloc) {
            __builtin_amdgcn_fence(__ATOMIC_RELEASE, "agent");
            asm volatile("s_waitcnt vmcnt(0)" ::: "memory");
            const unsigned og = xb_add(&bar[XB_TOP], 1u);
            const unsigned tg = og / nx;
            if (og + 1u == (tg + 1u) * nx) xb_add(&bar[XB_TOPGEN], 1u);
            else XB_SPIN(xb_ld(&bar[XB_TOPGEN]) == tg, bar);
            __builtin_amdgcn_fence(__ATOMIC_ACQUIRE, "agent");
            xb_add(&bar[XB_XGEN(b.x)], 1u);
            asm volatile("s_waitcnt vmcnt(0)" ::: "memory");
        } else {
            XB_SPIN(xb_ld(&bar[XB_XGEN(b.x)]) == gen, bar);
            __builtin_amdgcn_fence(__ATOMIC_ACQUIRE, "agent");
            asm volatile("s_waitcnt vmcnt(0)" ::: "memory");
        }
    }
    __syncthreads();
}

struct Frame {
    LAS unsigned char* lds;
    volatile LAS unsigned* MISC;
    gu32* ctl;
    int tid, lane, wave;
    int vcu, G;
    const LAS unsigned long long* inp;
    float* out;
    unsigned char* ws;
};
enum { I_X = 0, I_GMIX, I_WIN, I_BIN, I_CONVW, I_CONVB, I_FW1, I_FB1, I_FW2, I_FB2, I_FW3, I_FFREQ, I_SKIP, I_LNG, I_LNB, I_SGW, I_SGB, I_WHY, I_WSG, I_WOUT, I_GFFN, I_WRG, I_BRG, I_WRE, I_BRE, I_WGATE, I_WUP, I_WDOWN, I_GFINAL };

__device__ __forceinline__ const float* inp(const Frame& F, int k) { const unsigned long long v = F.inp[k]; const unsigned lo = __builtin_amdgcn_readfirstlane((unsigned)v), hi = __builtin_amdgcn_readfirstlane((unsigned)(v >> 32));
    return (const float*)(((unsigned long long)hi << 32) | (unsigned long long)lo); }
__device__ __forceinline__ void wait_ge(gu32* p, unsigned need, gu32* tmo) {
    unsigned polls = 0;
    while ((unsigned)__builtin_amdgcn_readfirstlane(__hip_atomic_load(p, RLX_AGENT)) < need) {
        if (++polls > (1u << 22)) { if ((threadIdx.x & 63) == 0) __hip_atomic_store(tmo, 1u, RLX_AGENT); break; }
        __builtin_amdgcn_s_sleep(2); }
}
__device__ __forceinline__ float shfl_xor_l(float v, int mask, int lane) { return __builtin_bit_cast(float, __builtin_amdgcn_ds_bpermute((lane ^ mask) << 2, __builtin_bit_cast(int, v))); }
__device__ __forceinline__ float shfl_down1_l(float v, int lane) { return __builtin_bit_cast(float, __builtin_amdgcn_ds_bpermute(((lane + 1) & 63) << 2, __builtin_bit_cast(int, v))); }
__device__ __forceinline__ float wave_sum(float v, int lane) {
#pragma unroll
    for (int o = 1; o < 64; o <<= 1) v += shfl_xor_l(v, o, lane);
    return v;
}

#ifndef PROBE_K
#define PROBE_K -1
#endif
#ifndef PROBE_BLK
#define PROBE_BLK 0
#endif
#define HP_ME (blockIdx.x == PROBE_BLK && threadIdx.x == 0)
#define HPS(j) do { if (PROBE_K == (j) && HP_ME) ((volatile LAS unsigned long long*)(F.lds + MISC_OFF + 512))[0] = __builtin_amdgcn_s_memrealtime(); } while (0)
#define HPE(j) do { if (PROBE_K == (j) && HP_ME) { volatile LAS unsigned long long* _p = (volatile LAS unsigned long long*)(F.lds + MISC_OFF + 512); _p[1] += __builtin_amdgcn_s_memrealtime() - _p[0]; } } while (0)
#define HD __device__ __forceinline__
#define HY_OPAQUE(x) asm volatile("" : "+v"(x))
#define HY_GLD(p, i) (((const GAS unsigned*)(p))[i])
typedef float hy_f2v __attribute__((ext_vector_type(2)));
#define LDC(p, i) ({ const hy_f2v _v = *(const LAS hy_f2v*)((p) + (i)); c32 _r; _r.x = _v.x; _r.y = _v.y; _r; })
#define STC(p, i, v) do { const c32 _s = (v); hy_f2v _w; _w.x = _s.x; _w.y = _s.y; *(LAS hy_f2v*)((p) + (i)) = _w; } while (0)
#define FADD(a, b) ({ float _r; asm("v_add_f32 %0, %1, %2" : "=v"(_r) : "v"((float)(a)), "v"((float)(b))); _r; })
#define FSUB(a, b) ({ float _r; asm("v_sub_f32 %0, %1, %2" : "=v"(_r) : "v"((float)(a)), "v"((float)(b))); _r; })
#define FMUL(a, b) ({ float _r; asm("v_mul_f32 %0, %1, %2" : "=v"(_r) : "v"((float)(a)), "v"((float)(b))); _r; })
#define FFMA(a, b, c) ({ float _r; asm("v_fma_f32 %0, %1, %2, %3" : "=v"(_r) : "v"((float)(a)), "v"((float)(b)), "v"((float)(c))); _r; })
#define FNMA(a, b, c) ({ float _r; asm("v_fma_f32 %0, -%1, %2, %3" : "=v"(_r) : "v"((float)(a)), "v"((float)(b)), "v"((float)(c))); _r; })
struct c32 { float x, y; };
HD c32 cmk(float x, float y) { c32 r; r.x = x; r.y = y; return r; }
HD c32 cadd(c32 a, c32 b) { return cmk(FADD(a.x, b.x), FADD(a.y, b.y)); }
HD c32 csub(c32 a, c32 b) { return cmk(FSUB(a.x, b.x), FSUB(a.y, b.y)); }
HD c32 cmul(c32 a, c32 b) { return cmk(FNMA(a.y, b.y, FMUL(a.x, b.x)), FFMA(a.y, b.x, FMUL(a.x, b.y))); }
HD c32 cmulc(c32 a, c32 b) { return cmk(FFMA(a.y, b.y, FMUL(a.x, b.x)), FNMA(a.x, b.y, FMUL(a.y, b.x))); }
HD c32 cscale(c32 a, float f) { return cmk(FMUL(a.x, f), FMUL(a.y, f)); }
HD c32 cadd_mi(c32 a, c32 b) { return cmk(FADD(a.x, b.y), FSUB(a.y, b.x)); }
HD c32 cadd_pi(c32 a, c32 b) { return cmk(FSUB(a.x, b.y), FADD(a.y, b.x)); }
#define HY_N 8192
#define HY_LDS_C32 (8192 + 256)

template <int SIGN> HD void dft4(c32& a, c32& b, c32& c, c32& d) {
    const c32 t0 = cadd(a, c), t1 = csub(a, c), t2 = cadd(b, d), t3 = csub(b, d);
    a = cadd(t0, t2); c = csub(t0, t2);
    if (SIGN < 0) { b = cadd_mi(t1, t3); d = cadd_pi(t1, t3); }
    else          { b = cadd_pi(t1, t3); d = cadd_mi(t1, t3); }
}
template <int SIGN> HD void dft16(c32 (&a)[16]) {
    const float C1 = 0.92387953251128674f, S1 = 0.38268343236508977f, R2 = 0.70710678118654752f;
#pragma unroll
    for (int n2 = 0; n2 < 4; ++n2) dft4<SIGN>(a[n2], a[4 + n2], a[8 + n2], a[12 + n2]);
    const float sg = (SIGN < 0) ? -1.f : 1.f;
    const c32 w1 = cmk(C1, sg * S1), w2 = cmk(R2, sg * R2), w3 = cmk(S1, sg * C1), w6 = cmk(-R2, sg * R2), w9 = cmk(-C1, -sg * S1);
    a[1 + 4] = cmul(a[1 + 4], w1); a[2 + 4] = cmul(a[2 + 4], w2); a[3 + 4] = cmul(a[3 + 4], w3);
    a[1 + 8] = cmul(a[1 + 8], w2); a[2 + 8] = (SIGN < 0) ? cmk(a[2 + 8].y, -a[2 + 8].x) : cmk(-a[2 + 8].y, a[2 + 8].x); a[3 + 8] = cmul(a[3 + 8], w6);
    a[1 + 12] = cmul(a[1 + 12], w3); a[2 + 12] = cmul(a[2 + 12], w6); a[3 + 12] = cmul(a[3 + 12], w9);
#pragma unroll
    for (int k1 = 0; k1 < 4; ++k1) dft4<SIGN>(a[4 * k1], a[4 * k1 + 1], a[4 * k1 + 2], a[4 * k1 + 3]);
    c32 t[16];
#pragma unroll
    for (int i = 0; i < 16; ++i) t[i] = a[i];
#pragma unroll
    for (int k1 = 0; k1 < 4; ++k1)
#pragma unroll
        for (int k2 = 0; k2 < 4; ++k2) a[k1 + 4 * k2] = t[4 * k1 + k2];
}
HD void twiddle_tree(c32 (&a)[16], c32 w1) {
    const c32 w2 = cmul(w1, w1), w3 = cmul(w2, w1), w4 = cmul(w2, w2), w5 = cmul(w4, w1), w6 = cmul(w4, w2), w7 = cmul(w4, w3), w8 = cmul(w4, w4);
    a[1] = cmul(a[1], w1); a[2] = cmul(a[2], w2); a[3] = cmul(a[3], w3); a[4] = cmul(a[4], w4); a[5] = cmul(a[5], w5); a[6] = cmul(a[6], w6); a[7] = cmul(a[7], w7); a[8] = cmul(a[8], w8);
    a[9] = cmul(a[9], cmul(w8, w1)); a[10] = cmul(a[10], cmul(w8, w2)); a[11] = cmul(a[11], cmul(w8, w3)); a[12] = cmul(a[12], cmul(w8, w4));
    a[13] = cmul(a[13], cmul(w8, w5)); a[14] = cmul(a[14], cmul(w8, w6)); a[15] = cmul(a[15], cmul(w8, w7));
}
HD c32 cis_pi(float x) { return cmk(cospif(x), sinpif(x)); }

HD void fft_s1_fwd(int tid, LAS c32* buf, c32 (&a)[16], c32 w1) { HY_OPAQUE(tid); HY_OPAQUE(w1.x); HY_OPAQUE(w1.y);
    dft16<-1>(a);
    twiddle_tree(a, w1);
    LAS c32* p0 = buf + tid + (tid >> 5);
#pragma unroll
    for (int p = 0; p < 16; ++p) STC(p0, 528 * p, a[p]);
}
HD void fft_s2_fwd(int tid, LAS c32* buf, c32 w2) { HY_OPAQUE(tid); HY_OPAQUE(w2.x); HY_OPAQUE(w2.y);
    LAS c32* p0 = buf + (tid >> 5) * 528 + (tid & 31);
    c32 a[16];
#pragma unroll
    for (int q = 0; q < 16; ++q) a[q] = LDC(p0, 33 * q);
    dft16<-1>(a);
    twiddle_tree(a, w2);
#pragma unroll
    for (int p = 0; p < 16; ++p) STC(p0, 33 * p, a[p]);
}
HD float w32c(int q) { switch (q) { case 0: return 1.0f; case 1: return 0.98078528040323043f; case 2: return 0.92387953251128674f; case 3: return 0.83146961230254524f; case 4: return 0.70710678118654752f; case 5: return 0.55557023301960218f; case 6: return 0.38268343236508977f; case 7: return 0.19509032201612825f;
    case 8: return 0.0f; case 9: return -0.19509032201612825f; case 10: return -0.38268343236508977f; case 11: return -0.55557023301960218f; case 12: return -0.70710678118654752f; case 13: return -0.83146961230254524f; case 14: return -0.92387953251128674f; default: return -0.98078528040323043f; } }
HD float w32s(int q) { switch (q) { case 0: return 0.0f; case 1: return 0.19509032201612825f; case 2: return 0.38268343236508977f; case 3: return 0.55557023301960218f; case 4: return 0.70710678118654752f; case 5: return 0.83146961230254524f; case 6: return 0.92387953251128674f; case 7: return 0.98078528040323043f;
    case 8: return 1.0f; case 9: return 0.98078528040323043f; case 10: return 0.92387953251128674f; case 11: return 0.83146961230254524f; case 12: return 0.70710678118654752f; case 13: return 0.55557023301960218f; case 14: return 0.38268343236508977f; default: return 0.19509032201612825f; } }
template <int SIGN> HD void fft_s3_read(int tid, const LAS c32* buf, c32 (&s)[16]) { HY_OPAQUE(tid);
    const LAS c32* p0 = buf + (tid >> 1) * 33; const int h = tid & 1;
    const float sg = (SIGN < 0) ? -1.f : 1.f, hs = h ? -1.f : 1.f;
#pragma unroll
    for (int q = 0; q < 16; ++q) {
        const c32 u = LDC(p0, q), v = LDC(p0, q + 16);
        const c32 d = cmk(FFMA(v.x, hs, u.x), FFMA(v.y, hs, u.y));
        const c32 w = h ? cmk(w32c(q), sg * w32s(q)) : cmk(1.f, 0.f);
        s[q] = (q == 0) ? d : cmul(d, w);
    }
    dft16<SIGN>(s);
}
HD void fft_s3_write(int tid, LAS c32* buf, const c32 (&s)[16]) { HY_OPAQUE(tid);
    LAS c32* p0 = buf + (tid >> 1) * 33 + (tid & 1);
#pragma unroll
    for (int p = 0; p < 16; ++p) STC(p0, 2 * p, s[p]);
}
HD void fft_s2_inv(int tid, LAS c32* buf, c32 w2) { HY_OPAQUE(tid); HY_OPAQUE(w2.x); HY_OPAQUE(w2.y);
    LAS c32* p0 = buf + (tid >> 5) * 528 + (tid & 31);
    c32 a[16];
#pragma unroll
    for (int q = 0; q < 16; ++q) a[q] = LDC(p0, 33 * q);
    twiddle_tree(a, cmk(w2.x, -w2.y));
    dft16<1>(a);
#pragma unroll
    for (int p = 0; p < 16; ++p) STC(p0, 33 * p, a[p]);
}
HD void fft_s1_inv(int tid, const LAS c32* buf, c32 (&a)[16], c32 w1) { HY_OPAQUE(tid); HY_OPAQUE(w1.x); HY_OPAQUE(w1.y);
    const LAS c32* p0 = buf + tid + (tid >> 5);
#pragma unroll
    for (int p = 0; p < 16; ++p) a[p] = LDC(p0, 528 * p);
    twiddle_tree(a, cmk(w1.x, -w1.y));
    dft16<1>(a);
}
HD void pair_pass(int tid, LAS c32* Z, const LAS c32* H, c32 wp3, c32 wlow) { HY_OPAQUE(tid); HY_OPAQUE(wp3.x); HY_OPAQUE(wp3.y); HY_OPAQUE(wlow.x); HY_OPAQUE(wlow.y);
    const int p3 = tid & 31;
    const c32 wstep = cmk(0.99998117528260111f, -0.0061358846491544753f);
#pragma unroll 1
    for (int it = 0; it < 9; ++it) {
        const int low = it * 16 + (tid >> 5);
        const c32 Wk = cmul(wlow, wp3);
        wlow = cmul(wlow, wstep);
        if (low > 128) continue;
        bool act = true; int p3b = 31 - p3, lowb = 256 - low;
        if (low == 0) { act = p3 <= 16; p3b = (32 - p3) & 31; lowb = 0; }
        else if (low == 128) { act = p3 <= 15; lowb = 128; }
        if (!act) continue;
        const int pa = (low & 15) * 528 + (low >> 4) * 33 + p3, pb = (lowb & 15) * 528 + (lowb >> 4) * 33 + p3b;
        const c32 A = LDC(Z, pa), B = LDC(Z, pb), HA = LDC(H, pa), HB = LDC(H, pb);
        c32 E = cmk(FMUL(FADD(A.x, B.x), 0.5f), FMUL(FSUB(A.y, B.y), 0.5f)), O = cmk(FMUL(FADD(A.y, B.y), 0.5f), FMUL(FSUB(B.x, A.x), 0.5f));
        c32 T = cmul(Wk, O);
        const c32 X = cadd(E, T), Xm = csub(E, T);
        E = cmk(FMUL(FADD(HA.x, HB.x), 0.5f), FMUL(FSUB(HA.y, HB.y), 0.5f)); O = cmk(FMUL(FADD(HA.y, HB.y), 0.5f), FMUL(FSUB(HB.x, HA.x), 0.5f));
        T = cmul(Wk, O);
        const c32 Hk = cadd(E, T), Hm = csub(E, T);
        const c32 Y = cmul(X, Hk), Ypc = cmul(Xm, Hm);
        const float sc = 0.5f / 8192.0f;
        const c32 Ye = cscale(cadd(Y, Ypc), sc), Yd = cscale(csub(Y, Ypc), sc);
        const c32 Yo = cmulc(Yd, Wk);
        STC(Z, pa, cmk(FSUB(Ye.x, Yo.y), FADD(Ye.y, Yo.x)));
        if (pb != pa) STC(Z, pb, cmk(FADD(Ye.x, Yo.y), FSUB(Yo.x, Ye.y)));
    }
}
HD float bf_lo(unsigned u) { unsigned v = u << 16; return __builtin_bit_cast(float, v); }
HD float bf_hi(unsigned u) { unsigned v = u & 0xffff0000u; return __builtin_bit_cast(float, v); }
HD void hy_conv3_load(int tid, const unsigned* zrow, float c0, float c1, float c2, float cb, c32 (&out)[8]) { HY_OPAQUE(tid);
    unsigned wm[8], wl[8], wr[8];
#pragma unroll
    for (int q = 0; q < 8; ++q) { const int m = tid + 512 * q, ml = (m > 0) ? m - 1 : 0, mr = (m < 4095) ? m + 1 : 4095;
        wm[q] = HY_GLD(zrow, m); wl[q] = HY_GLD(zrow, ml); wr[q] = HY_GLD(zrow, mr); }
#pragma unroll
    for (int q = 0; q < 8; ++q) { const int m = tid + 512 * q; wl[q] = (m > 0) ? wl[q] : 0u; wr[q] = (m < 4095) ? wr[q] : 0u; }
#pragma unroll
    for (int q = 0; q < 8; ++q) {
        const float zm1 = bf_hi(wl[q]), z0 = bf_lo(wm[q]), z1 = bf_hi(wm[q]), z2 = bf_lo(wr[q]);
        out[q] = cmk(FFMA(c0, zm1, FFMA(c1, z0, FFMA(c2, z1, cb))), FFMA(c0, z0, FFMA(c1, z1, FFMA(c2, z2, cb))));
    }
}
HD void hy_filter_s1(int tid, LAS c32* buf, const unsigned* zk) { HY_OPAQUE(tid);
    unsigned w[16];
#pragma unroll
    for (int q = 0; q < 16; ++q) w[q] = zk[tid + 512 * q];
    c32 a[16];
#pragma unroll
    for (int q = 0; q < 16; ++q) a[q] = cmk(bf_lo(w[q]), bf_hi(w[q]));
    fft_s1_fwd(tid, buf, a, cmk(1.f, 0.f));
}
HD void hy_data_s1(int tid, LAS c32* buf, const c32 (&v)[8], c32 w1) { HY_OPAQUE(tid);
    c32 a[16];
#pragma unroll
    for (int q = 0; q < 8; ++q) a[q] = v[q];
#pragma unroll
    for (int q = 8; q < 16; ++q) a[q] = cmk(0.f, 0.f);
    fft_s1_fwd(tid, buf, a, w1);
}
HD unsigned hy_bf(float f) { unsigned u = __builtin_bit_cast(unsigned, f); return (u + 0x7fffu + ((u >> 16) & 1u)) >> 16; }
HD void hy_pack_store(unsigned* zk, int dir, int a4, float t0, float t1, float t2, float t3) {
    if (dir == 0) { zk[a4 / 2] = hy_bf(t0) | (hy_bf(t1) << 16); zk[a4 / 2 + 1] = hy_bf(t2) | (hy_bf(t3) << 16); }
    else {
        const int m = 8192 - a4 / 2;
        if (a4 > 0) ((unsigned short*)(zk + m))[0] = (unsigned short)hy_bf(t0);
        zk[m - 1] = hy_bf(t2) | (hy_bf(t1) << 16);
        if (a4 == 8188) zk[m - 2] = hy_bf(t3) << 16; else ((unsigned short*)(zk + m - 2))[1] = (unsigned short)hy_bf(t3);
    }
}
struct CvItem { const float* src; int N; bf16* dst; size_t dld; int f8; };
constexpr int CV_S0 = 32 * 288, CV_S7 = 128, CV_SA = CV_S0 + CV_S7, CV_S1 = 16 * 64, CV_S3 = 32 * 64, CV_S4 = 16 * 32 * 16, CV_S6 = 16 * 8 * 64;
constexpr int CV_NITEMS = CV_SA + 2 * CV_S1 + CV_S3 + 2 * CV_S4 + CV_S6;
__device__ __forceinline__ void cv_decode_layer(Frame& F, int l, int r, CvItem& d) {
    bf16* WIN = (bf16*)(F.ws + ((l & 1) ? WS_WIN2 : WS_WIN)); bf16* PT = (bf16*)(F.ws + WS_PT); bf16* WOT = (bf16*)(F.ws + WS_WOT); bf16* WGU = (bf16*)(F.ws + WS_WGU); bf16* WD = (bf16*)(F.ws + WS_WD);
    bf16* W3T = (bf16*)(F.ws + WS_W3T + (size_t)(l & 1) * 512 * 1024);
    d.f8 = 0;
    if (r < CV_S0) { const int kb = r / 288, nb = r % 288; d.src = inp(F, I_WIN) + (size_t)l * DM * NIN + (size_t)(64 * kb) * NIN + 32 * nb; d.N = NIN;
        if (nb >= 160) { d.dst = (bf16*)(F.ws + WS_WIN8 + (size_t)(l & 1) * 8 * MiB) + (size_t)(32 * nb - 5120) * (DM / 2) + 32 * kb; d.dld = DM / 2; d.f8 = 1; }
        else { d.dst = WIN + (size_t)(32 * nb) * DM + 64 * kb; d.dld = DM; }
        return; } r -= CV_S0;
    if (r < CV_S7) { const int nb = r; d.src = inp(F, I_FW3) + (size_t)l * 64 * 4096 + 32 * nb; d.N = 4096; d.dst = W3T + (size_t)(32 * nb) * 64; d.dld = 64; return; } r -= CV_S7;
    if (r < CV_S1) { const int kb = r / 64, nb = r % 64; d.src = inp(F, I_WHY) + (size_t)l * HYW * DM + (size_t)(64 * kb) * DM + 32 * nb; d.N = DM; d.dst = PT + (size_t)(32 * nb) * DM + 64 * kb; d.dld = DM; return; } r -= CV_S1;
    if (r < CV_S1) { const int kb = r / 64, nb = r % 64; d.src = inp(F, I_WSG) + (size_t)l * SGW * DM + (size_t)(64 * kb) * DM + 32 * nb; d.N = DM; d.dst = PT + (size_t)(32 * nb) * DM + 1024 + 64 * kb; d.dld = DM; return; } r -= CV_S1;
    if (r < CV_S3) { const int kb = r / 64, nb = r % 64; d.src = inp(F, I_WOUT) + (size_t)l * DM * DM + (size_t)(64 * kb) * DM + 32 * nb; d.N = DM; d.dst = WOT + (size_t)(32 * nb) * DM + 64 * kb; d.dld = DM; return; } r -= CV_S3;
    if (r < 2 * CV_S4) { const int up = r / CV_S4; r -= up * CV_S4; const int e = r / 512, q = r % 512, kb = q / 16, nb = q % 16; const int n0 = 32 * nb, drow = 256 * (n0 / 128) + (n0 % 128) + 128 * up;
        d.src = (up ? inp(F, I_WUP) : inp(F, I_WGATE)) + ((size_t)l * NEXP + e) * DM * DEXP + (size_t)(64 * kb) * DEXP + n0; d.N = DEXP; d.dst = WGU + ((size_t)e * 1024 + drow) * (DM / 2) + 32 * kb; d.dld = DM / 2; d.f8 = 1; return; } r -= 2 * CV_S4;
    { const int e = r / 512, q = r % 512, kb = q / 64, nb = q % 64;
        d.src = inp(F, I_WDOWN) + ((size_t)l * NEXP + e) * DEXP * DM + (size_t)(64 * kb) * DM + 32 * nb; d.N = DM; d.dst = WD + ((size_t)e * DM + 32 * nb) * (DEXP / 2) + 32 * kb; d.dld = DEXP / 2; d.f8 = 1; }
}
__device__ __forceinline__ bool cv_decode(Frame& F, int set, int l, int it, CvItem& d) {
    if (set == 0) { if (it >= CV_SA) return false; cv_decode_layer(F, l, it, d); return true; }
    const int n1 = CV_NITEMS - CV_SA, n2 = (l + 1 < DEPTH) ? CV_SA : 0;
    if (it >= n1 + n2) return false;
    if (it < n1) cv_decode_layer(F, l, CV_SA + it, d); else cv_decode_layer(F, l + 1, it - n1, d);
    return true;
}
__device__ __forceinline__ void cv_load(const CvItem& d, int lane, float (&v)[32]) {
    const float* s = d.src + (size_t)(lane >> 3) * d.N + 4 * (lane & 7);
#pragma unroll
    for (int i = 0; i < 8; ++i) { const f32x4 w = *(const GAS f32x4*)(s + (size_t)(8 * i) * d.N); v[4 * i] = w.x; v[4 * i + 1] = w.y; v[4 * i + 2] = w.z; v[4 * i + 3] = w.w; }
}
__device__ __forceinline__ void cv_store(const CvItem& d, int lane, const float (&v)[32], LAS float* scr) {
    const int n = lane >> 1, h = lane & 1, kr = lane >> 3, nq = lane & 7;
#pragma unroll
    for (int s = 0; s < 4; ++s) {
        *(LAS f32x4*)(scr + kr * 36 + 4 * nq) = (f32x4){v[8 * s], v[8 * s + 1], v[8 * s + 2], v[8 * s + 3]};
        *(LAS f32x4*)(scr + (8 + kr) * 36 + 4 * nq) = (f32x4){v[8 * s + 4], v[8 * s + 5], v[8 * s + 6], v[8 * s + 7]};
        LDS_WAIT(); asm volatile("" ::: "memory");
        const LAS float* q = scr + (8 * h) * 36 + n;
        if (d.f8) { int a = __builtin_amdgcn_cvt_pk_fp8_f32(q[0 * 36] * 64.f, q[1 * 36] * 64.f, 0, false); a = __builtin_amdgcn_cvt_pk_fp8_f32(q[2 * 36] * 64.f, q[3 * 36] * 64.f, a, true);
            int b = __builtin_amdgcn_cvt_pk_fp8_f32(q[4 * 36] * 64.f, q[5 * 36] * 64.f, 0, false); b = __builtin_amdgcn_cvt_pk_fp8_f32(q[6 * 36] * 64.f, q[7 * 36] * 64.f, b, true);
            *(GAS v2u*)((char*)d.dst + (size_t)n * d.dld * 2 + 16 * s + 8 * h) = (v2u){(unsigned)a, (unsigned)b}; }
        else { v4u o; o.x = pk2h(q[0 * 36], q[1 * 36]); o.y = pk2h(q[2 * 36], q[3 * 36]); o.z = pk2h(q[4 * 36], q[5 * 36]); o.w = pk2h(q[6 * 36], q[7 * 36]);
            *(GAS v4u*)(d.dst + (size_t)n * d.dld + 16 * s + 8 * h) = o; }
        LDS_WAIT(); asm volatile("" ::: "memory");
    }
}
struct CvPipe { CvItem d; int n, wi, nw, cls, set, l; bool have; };
__device__ __forceinline__ int cv_index(const CvPipe& P) {
    if (P.cls == 0) return P.wi + P.nw * P.n;
    if (P.cls == 1) { const int ch = P.n / 3, j = P.n - 3 * ch; return ch * 4 * P.nw + j * P.nw + P.wi; }
    return P.n * 4 * P.nw + 3 * P.nw + P.wi;
}
#define CV_SCR(F) ((LAS float*)((F).lds + CVS_OFF + (F).wave * 2304))
#define CV_START(F, P, V, SET, L, CLS, WI, NW) do { (P).set = (SET); (P).l = (L); (P).cls = (CLS); (P).nw = (NW); int _wi = (WI); asm volatile("" : "+s"(_wi)); (P).wi = _wi; (P).n = 0; \
        (P).have = cv_decode(F, SET, L, cv_index(P), (P).d); if ((P).have) cv_load((P).d, (F).lane, V); } while (0)
#define CV_STEP(F, P, V) do { if ((P).have) { cv_store((P).d, (F).lane, V, CV_SCR(F)); (P).n += 1; (P).have = cv_decode(F, (P).set, (P).l, cv_index(P), (P).d); if ((P).have) cv_load((P).d, (F).lane, V); } } while (0)
__device__ __forceinline__ void pa_convert(Frame& F, int l) {
    CvPipe P; float va[32];
    CV_START(F, P, va, 0, l, 0, F.vcu * NWAVES + F.wave, F.G * NWAVES);
    while (P.have) CV_STEP(F, P, va);
}
__device__ __forceinline__ void pa_features(Frame& F, int l) {
    LAS float* zf = (LAS float*)(F.lds);
    LAS float* a1 = zf + 8 * 40;
    const float* w1 = inp(F, I_FW1) + l * 33 * 64; const float* b1 = inp(F, I_FB1) + l * 64; const float* w2 = inp(F, I_FW2) + l * 64 * 64; const float* b2 = inp(F, I_FB2) + l * 64; const float* fq = inp(F, I_FFREQ) + l * 64;
    bf16* A2 = (bf16*)(F.ws + WS_A2 + (size_t)l * MiB);
    const int tl = F.tid >> 6, j = F.tid & 63;
    const float fr = fq[j];
    float w1c[33], w2c[64];
#pragma unroll
    for (int i = 0; i < 33; ++i) w1c[i] = w1[i * 64 + j];
#pragma unroll
    for (int i = 0; i < 64; ++i) w2c[i] = w2[i * 64 + j];
    for (int t0 = F.vcu * 8; t0 < SEQ; t0 += F.G * 8) {
        __syncthreads();
        if (F.tid < 8 * 33) { const int tt = F.tid / 33, i = F.tid % 33; const int t = t0 + tt; float v;
            const float w = 6.283185307179586f / (float)SEQ * (float)t;
            if (i == 0) v = (float)t / (float)(SEQ - 1);
            else { const int b = (i - 1) & 15; const float band = 1e-4f + (float)b * ((15.0f - 1e-4f) / 15.0f); const float a = band * w; v = (i <= 16) ? cosf(a) : -sinf(a); }
            zf[tt * 40 + i] = v; }
        __syncthreads();
        float s = b1[j];
#pragma unroll
        for (int i = 0; i < 33; ++i) s += zf[tl * 40 + i] * w1c[i];
        a1[tl * 64 + j] = sinf(fr * s);
        __syncthreads();
        float s2 = b2[j];
#pragma unroll
        for (int i = 0; i < 64; ++i) s2 += a1[tl * 64 + i] * w2c[i];
        A2[(size_t)(t0 + tl) * 64 + j] = (bf16)f2bf(sinf(fr * s2));
    }
    __syncthreads();
}
__device__ __forceinline__ void feat_token(Frame& F, int t, const float (&w1c)[33], const float (&w2c)[64], float b1j, float b2j, float frj, bf16* A2) {
    LAS float* zf = (LAS float*)(F.lds + F.wave * 512);
    LAS float* a1 = zf + 40;
    const int i = F.lane;
    if (i < 33) { float v; const float w = 6.283185307179586f / (float)SEQ * (float)t;
        if (i == 0) v = (float)t / (float)(SEQ - 1);
        else { const int b = (i - 1) & 15; const float band = 1e-4f + (float)b * ((15.0f - 1e-4f) / 15.0f); const float a = band * w; v = (i <= 16) ? cosf(a) : -sinf(a); }
        zf[i] = v; }
    LDS_WAIT(); asm volatile("" ::: "memory");
    float s = b1j;
#pragma unroll
    for (int k = 0; k < 33; ++k) s += zf[k] * w1c[k];
    a1[i] = sinf(frj * s);
    LDS_WAIT(); asm volatile("" ::: "memory");
    float s2 = b2j;
#pragma unroll
    for (int k = 0; k < 64; ++k) s2 += a1[k] * w2c[k];
    A2[(size_t)t * 64 + i] = (bf16)f2bf(sinf(frj * s2));
    LDS_WAIT(); asm volatile("" ::: "memory");
}
__device__ __forceinline__ void pa_convert_features(Frame& F) {
    CvPipe P; float va[32];
    CV_START(F, P, va, 0, 0, 0, F.vcu * NWAVES + F.wave, F.G * NWAVES);
    for (int ll = 0; ll < DEPTH; ++ll) {
        const float* w1 = inp(F, I_FW1) + ll * 33 * 64; const float* w2 = inp(F, I_FW2) + ll * 64 * 64;
        const int j = F.lane;
        const float b1j = (inp(F, I_FB1) + ll * 64)[j], b2j = (inp(F, I_FB2) + ll * 64)[j], frj = (inp(F, I_FFREQ) + ll * 64)[j];
        bf16* A2 = (bf16*)(F.ws + WS_A2 + (size_t)ll * MiB);
        float w1c[33], w2c[64];
#pragma unroll
        for (int i = 0; i < 33; ++i) w1c[i] = w1[i * 64 + j];
#pragma unroll
        for (int i = 0; i < 64; ++i) w2c[i] = w2[i * 64 + j];
        for (int t = F.vcu * NWAVES + F.wave; t < SEQ; t += F.G * NWAVES) { feat_token(F, t, w1c, w2c, b1j, b2j, frj, A2); CV_STEP(F, P, va); }
    }
    while (P.have) CV_STEP(F, P, va);
}
__device__ __forceinline__ void pa_router_t(Frame& F, int l) {
    float* WR = (float*)(F.ws + WS_WR + (size_t)l * 256 * 1024);
    const float* wrg = inp(F, I_WRG) + (size_t)l * DM * 4; const float* wre = inp(F, I_WRE) + (size_t)l * 4 * DM * 4;
    for (int i = F.vcu * NTHR + F.tid; i < 20 * DM; i += F.G * NTHR) { const int o = i / DM, k = i % DM;
        WR[i] = (o < 4) ? wrg[k * 4 + o] : wre[((size_t)((o - 4) >> 2) * DM + k) * 4 + ((o - 4) & 3)]; }
}
__device__ __forceinline__ int moe_off(const gu32* cnt, int e) { int s = 0;
#pragma unroll
    for (int j = 0; j < 16; ++j) { const int c = (int)cnt[64 * j]; s += (j < e) ? c : 0; } return s; }
template <int MODE, bool OUTF, int NR>
__device__ __forceinline__ void norm_rows(Frame& F, int m0, int mstride, const float* xin, const float* g, const gu32* cntprev, float* outf) {
    bf16* XR = (bf16*)(F.ws + WS_XR); bf16* XN = (bf16*)(F.ws + WS_XN);
    f32x4 v[NR][8];
    if (MODE == 0) {
#pragma unroll
        for (int r = 0; r < NR; ++r) { const int m = m0 + r * mstride; const GAS f32x4* xr = (const GAS f32x4*)(xin + (size_t)m * DM) + F.lane;
#pragma unroll
            for (int j = 0; j < 8; ++j) v[r][j] = xr[64 * j]; }
    } else {
        const int* TOKPOS = (const int*)(F.ws + WS_LISTS + 1 * MiB); const bf16* MO = (const bf16*)(F.ws + WS_MOEOUT);
        int slot[NR][2];
#pragma unroll
        for (int r = 0; r < NR; ++r)
#pragma unroll
            for (int k = 0; k < 2; ++k) { const int tp = TOKPOS[(m0 + r * mstride) * 2 + k]; slot[r][k] = moe_off(cntprev, tp >> 13) + (tp & 8191); }
        v2u w[NR][3][8];
#pragma unroll
        for (int r = 0; r < NR; ++r) { const GAS v2u* xr = (const GAS v2u*)(XR + (size_t)(m0 + r * mstride) * DM) + F.lane;
#pragma unroll
            for (int j = 0; j < 8; ++j) w[r][2][j] = xr[64 * j];
#pragma unroll
            for (int k = 0; k < 2; ++k) { const GAS v2u* mr = (const GAS v2u*)(MO + (size_t)slot[r][k] * DM) + F.lane;
#pragma unroll
                for (int j = 0; j < 8; ++j) w[r][k][j] = mr[64 * j]; } }
#pragma unroll
        for (int r = 0; r < NR; ++r) {
#pragma unroll
            for (int j = 0; j < 8; ++j) { const v2u a = w[r][2][j], b = w[r][0][j], c = w[r][1][j];
                v[r][j] = (f32x4){bfl(a.x) + bfl(b.x) + bfl(c.x), bfh(a.x) + bfh(b.x) + bfh(c.x), bfl(a.y) + bfl(b.y) + bfl(c.y), bfh(a.y) + bfh(b.y) + bfh(c.y)}; }
            if (!OUTF) { GAS v2u* xw = (GAS v2u*)(XR + (size_t)(m0 + r * mstride) * DM) + F.lane;
#pragma unroll
                for (int j = 0; j < 8; ++j) { v2u o; o.x = pk2h(v[r][j].x, v[r][j].y); o.y = pk2h(v[r][j].z, v[r][j].w); xw[64 * j] = o; } } }
    }
    const GAS f32x4* gp = (const GAS f32x4*)g + F.lane;
#pragma unroll
    for (int r = 0; r < NR; ++r) { const int m = m0 + r * mstride;
        float ss = 0.f;
#pragma unroll
        for (int j = 0; j < 8; ++j) ss += (v[r][j].x * v[r][j].x + v[r][j].y * v[r][j].y) + (v[r][j].z * v[r][j].z + v[r][j].w * v[r][j].w);
        const float rstd = 1.0f / sqrtf(wave_sum(ss, F.lane) * (1.0f / DM) + EPS);
        if (OUTF) { GAS f32x4* o = (GAS f32x4*)(outf + (size_t)m * DM) + F.lane;
#pragma unroll
            for (int j = 0; j < 8; ++j) { const f32x4 gg = gp[64 * j]; o[64 * j] = v[r][j] * rstd * gg; } }
        else { GAS v2u* o = (GAS v2u*)(XN + (size_t)m * DM) + F.lane; GAS unsigned* o8 = (GAS unsigned*)(F.ws + WS_XN8 + (size_t)m * DM) + F.lane;
#pragma unroll
            for (int j = 0; j < 8; ++j) { const f32x4 gg = gp[64 * j]; const f32x4 rr = v[r][j] * rstd * gg; v2u ww; ww.x = pk2h(rr.x, rr.y); ww.y = pk2h(rr.z, rr.w); o[64 * j] = ww;
                int q = __builtin_amdgcn_cvt_pk_fp8_f32(rr.x, rr.y, 0, false); q = __builtin_amdgcn_cvt_pk_fp8_f32(rr.z, rr.w, q, true); o8[64 * j] = (unsigned)q; } } }
}

__device__ __forceinline__ void sgu_pair(Frame& F, int l, int ch, int gp) {
    constexpr int RS = 136;
    LAS bf16* Wb = (LAS bf16*)(F.lds);
    LAS bf16* Vt = (LAS bf16*)(F.lds + 128 * RS * 2);
    LAS float* st = (LAS float*)(F.lds + 2 * 128 * RS * 2);
    const bf16* GV = (const bf16*)(F.ws + WS_GV); const bf16* U = (const bf16*)(F.ws + WS_U); bf16* Y = (bf16*)(F.ws + WS_Y);
    const float* lng = inp(F, I_LNG) + l * SGW; const float* lnb = inp(F, I_LNB) + l * SGW;
    const int t0 = ch * 128, g0 = 2 * gp;
    if (F.wave == 0) { wait_ge(F.ctl + CW_UG + 64 * (32 * l + (ch >> 1)), 64u, F.ctl + CW_TMO); __builtin_amdgcn_fence(__ATOMIC_ACQUIRE, "agent"); asm volatile("s_waitcnt vmcnt(0)" ::: "memory"); }
    __syncthreads();
    const float* Wg = inp(F, I_SGW) + ((size_t)l * 8 + g0) * 128 * 128;
    const int fr = F.lane & 15, fq = F.lane >> 4, tw = F.wave * 16, tq = t0 + tw + fr;
    f32x4 wq[2][8]; v4u va[2][2], vb[2][2]; v2u uw[2][8];
#pragma unroll
    for (int gi = 0; gi < 2; ++gi)
#pragma unroll
        for (int i = 0; i < 8; ++i) { const int idx = F.tid + NTHR * i; wq[gi][i] = *(const GAS f32x4*)(Wg + gi * 128 * 128 + (idx >> 5) * 128 + (idx & 31) * 4); }
#pragma unroll
    for (int gi = 0; gi < 2; ++gi)
#pragma unroll
        for (int i = 0; i < 2; ++i) { const int idx = F.tid + NTHR * i, sp = idx & 63, kc = idx >> 6;
            va[gi][i] = *(const GAS v4u*)(GV + (size_t)(t0 + 2 * sp) * SGW + (g0 + gi) * 128 + 8 * kc); vb[gi][i] = *(const GAS v4u*)(GV + (size_t)(t0 + 2 * sp + 1) * SGW + (g0 + gi) * 128 + 8 * kc); }
#pragma unroll
    for (int gi = 0; gi < 2; ++gi)
#pragma unroll
        for (int kt = 0; kt < 8; ++kt) uw[gi][kt] = *(const GAS v2u*)(U + (size_t)tq * SGW + (g0 + gi) * 128 + kt * 16 + 4 * fq);
    {
        const int row = F.tid >> 2, part = F.tid & 3; const GAS v4u* rp = (const GAS v4u*)(GV + (size_t)(t0 + row) * SGW);
        float s = 0.f, q = 0.f;
#pragma unroll 16
        for (int i = 0; i < 32; ++i) { const v4u w = rp[part + 4 * i]; const unsigned ww[4] = {w.x, w.y, w.z, w.w};
#pragma unroll
            for (int j = 0; j < 4; ++j) { const float a = bfl(ww[j]), b = bfh(ww[j]); s += a + b; q += a * a + b * b; } }
        s += shfl_xor_l(s, 1, F.lane); s += shfl_xor_l(s, 2, F.lane); q += shfl_xor_l(q, 1, F.lane); q += shfl_xor_l(q, 2, F.lane);
        const float mu = s * (1.0f / SGW); const float var = fmaxf(q * (1.0f / SGW) - mu * mu, 0.f);
        if (part == 0) { st[row] = mu; st[128 + row] = 1.0f / sqrtf(var + EPS); }
    }
#pragma unroll
    for (int gi = 0; gi < 2; ++gi) {
        const int g = g0 + gi;
#pragma unroll
        for (int i = 0; i < 8; ++i) { const int idx = F.tid + NTHR * i; const int t = idx >> 5, s4 = (idx & 31) * 4; const f32x4 w = wq[gi][i];
            v2u o; o.x = pk2h(w.x, w.y); o.y = pk2h(w.z, w.w); *(LAS v2u*)(Wb + t * RS + s4) = o; }
        if (gi == 0) __syncthreads();
#pragma unroll
        for (int i = 0; i < 2; ++i) { const int idx = F.tid + NTHR * i, sp = idx & 63, kc = idx >> 6;
            const unsigned aw[4] = {va[gi][i].x, va[gi][i].y, va[gi][i].z, va[gi][i].w}, bw[4] = {vb[gi][i].x, vb[gi][i].y, vb[gi][i].z, vb[gi][i].w};
            const float mua = st[2 * sp], rsa = st[128 + 2 * sp], mub = st[2 * sp + 1], rsb = st[128 + 2 * sp + 1];
#pragma unroll
            for (int j = 0; j < 4; ++j) { const int k = 8 * kc + 2 * j; const float ga = lng[g * 128 + k], gb = lng[g * 128 + k + 1], ba = lnb[g * 128 + k], bb = lnb[g * 128 + k + 1];
                *(LAS unsigned*)(Vt + k * RS + 2 * sp) = pk2h((bfl(aw[j]) - mua) * rsa * ga + ba, (bfl(bw[j]) - mub) * rsb * ga + ba);
                *(LAS unsigned*)(Vt + (k + 1) * RS + 2 * sp) = pk2h((bfh(aw[j]) - mua) * rsa * gb + bb, (bfh(bw[j]) - mub) * rsb * gb + bb); } }
        __syncthreads();
        {
            const float bias = (inp(F, I_SGB) + (l * 8 + g) * 128)[tw + fr];
            bf16x8 af[4];
#pragma unroll
            for (int ks = 0; ks < 4; ++ks) af[ks] = *(const LAS bf16x8*)(Wb + (tw + fr) * RS + ks * 32 + fq * 8);
#pragma unroll
            for (int kt = 0; kt < 8; ++kt) { f32x4 acc = (f32x4){0.f, 0.f, 0.f, 0.f};
#pragma unroll
                for (int ks = 0; ks < 4; ++ks) { const bf16x8 bfv = *(const LAS bf16x8*)(Vt + (kt * 16 + fr) * RS + ks * 32 + fq * 8);
                    acc = __builtin_amdgcn_mfma_f32_16x16x32_bf16(bfv, af[ks], acc, 0, 0, 0); }
                const int kcol = g * 128 + kt * 16 + 4 * fq;
                v2u o; o.x = pk2h(bfl(uw[gi][kt].x) * (acc[0] + bias), bfh(uw[gi][kt].x) * (acc[1] + bias)); o.y = pk2h(bfl(uw[gi][kt].y) * (acc[2] + bias), bfh(uw[gi][kt].y) * (acc[3] + bias));
                *(GAS v2u*)(Y + (size_t)tq * DM + 1024 + kcol) = o; }
        }
        __syncthreads();
    }
}

__device__ __forceinline__ void hy_filter_gen(Frame& F, int l, int c0, unsigned* FSP) {
    const bf16* A2 = (const bf16*)(F.ws + WS_A2 + (size_t)l * MiB); const bf16* W3T = (const bf16*)(F.ws + WS_W3T + (size_t)(l & 1) * 512 * 1024);
    int lane = F.lane; asm volatile("" : "+v"(lane));
    const int fr = lane & 15, fq = lane >> 4;
    const int chl = fr >> 2, o = (fr >> 1) & 1, dir = fr & 1, col = dir * 2048 + o * 1024 + c0 + chl;
    const bf16x8 b0 = *(const GAS bf16x8*)(W3T + (size_t)col * 64 + fq * 8), b1 = *(const GAS bf16x8*)(W3T + (size_t)col * 64 + 32 + fq * 8);
    const float delta = 3.0701134573253944f + (float)(c0 + chl) * (12.280453829301579f / 1023.0f);
    const float kdec = -delta * 1.4426950408889634f / (float)(SEQ - 1);
    constexpr int RS = 2056;
    LAS bf16* Ft = (LAS bf16*)(F.lds);
    LAS unsigned short* carry = (LAS unsigned short*)(F.lds + 16 * RS * 2);
    const int rot = (c0 * 10) & 127;
#define FG_LOAD(c_, ib_, A0, A1) do { int _fr = fr, _fq = fq; asm volatile("" : "+v"(_fr), "+v"(_fq)); \
        _Pragma("unroll") for (int j = 0; j < 8; ++j) { const int t0 = (128 * (c_) + ((F.wave + 8 * ((ib_) * 8 + j) + rot) & 127)) * 16; \
            A0[j] = *(const GAS bf16x8*)(A2 + (size_t)(t0 + _fr) * 64 + _fq * 8); A1[j] = *(const GAS bf16x8*)(A2 + (size_t)(t0 + _fr) * 64 + 32 + _fq * 8); } } while (0)
#define FG_COMP(c_, ib_, A0, A1) do { int _fr = fr, _fq = fq; asm volatile("" : "+v"(_fr), "+v"(_fq)); \
        _Pragma("unroll") for (int j = 0; j < 8; ++j) { const int tl = ((F.wave + 8 * ((ib_) * 8 + j) + rot) & 127) * 16, tb = 2048 * (c_) + tl + 4 * _fq; \
            f32x4 acc = (f32x4){0.f, 0.f, 0.f, 0.f}; \
            acc = __builtin_amdgcn_mfma_f32_16x16x32_bf16(A0[j], b0, acc, 0, 0, 0); \
            acc = __builtin_amdgcn_mfma_f32_16x16x32_bf16(A1[j], b1, acc, 0, 0, 0); \
            _Pragma("unroll") for (int r = 0; r < 4; ++r) acc[r] *= __builtin_amdgcn_exp2f(kdec * (float)(tb + r)); \
            v2u w; w.x = pk2h(acc[0], acc[1]); w.y = pk2h(acc[2], acc[3]); \
            *(LAS v2u*)(Ft + _fr * RS + tl + 4 * _fq) = w; } } while (0)
    bf16x8 xa0[8], xa1[8], ya0[8], ya1[8];
    FG_LOAD(0, 0, xa0, xa1);
#pragma unroll 1
    for (int c = 0; c < 4; ++c) {
        FG_LOAD(c, 1, ya0, ya1);
        FG_COMP(c, 0, xa0, xa1);
        if (c < 3) FG_LOAD(c + 1, 0, xa0, xa1);
        FG_COMP(c, 1, ya0, ya1);
        __syncthreads();
        int tid2 = F.tid; asm volatile("" : "+v"(tid2));
        {
#pragma unroll
            for (int i = 0; i < 4; ++i) { const int idx = tid2 + NTHR * i, r8 = idx >> 8, pc = idx & 255; const int f = (r8 >> 1) * 4 + (r8 & 1) * 2;
                v4u w = *(const LAS v4u*)(Ft + f * RS + 8 * pc);
                if (c == 0 && pc == 0) { const float s0 = bfl(w.x) + bfl((unsigned)Ft[(f + 1) * RS]); w.x = (w.x & 0xffff0000u) | f2bf(s0); }
                *(GAS v4u*)(FSP + (size_t)r8 * 8192 + 1024 * c + 4 * pc) = w; }
        }
        {
#pragma unroll 4
            for (int i = 0; i < 16; ++i) { const int idx = tid2 + NTHR * i, r8 = idx >> 10, il = idx & 1023; const int f = (r8 >> 1) * 4 + (r8 & 1) * 2 + 1;
                const unsigned lo = Ft[f * RS + 2 * il]; const unsigned hi = (il > 0) ? (unsigned)Ft[f * RS + 2 * il - 1] : (unsigned)carry[(c & 1) * 8 + r8];
                const int ig = 1024 * c + il;
                if (ig > 0) FSP[(size_t)r8 * 8192 + 8192 - ig] = lo | (hi << 16); }
            if (F.tid < 8) { const int f = (F.tid >> 1) * 4 + (F.tid & 1) * 2 + 1; const unsigned short last = Ft[f * RS + 2047];
                carry[((c + 1) & 1) * 8 + F.tid] = last;
                if (c == 3) FSP[(size_t)F.tid * 8192 + 4096] = (unsigned)last << 16; }
        }
        __syncthreads();
    }
}
#undef FG_LOAD
#undef FG_COMP
__device__ __forceinline__ unsigned pk_c32(c32 v) { return pk2h(v.x, v.y); }
__device__ __forceinline__ c32 unpk_c32(unsigned u) { return cmk(bfl(u), bfh(u)); }
__device__ __forceinline__ void hyena_block(Frame& F, int l, int blk) {
    LAS c32* A = (LAS c32*)(F.lds); LAS c32* B = A + HY_LDS_C32;
    unsigned* FSP = (unsigned*)(F.ws + WS_FS) + (size_t)blk * 8 * 8192;
    const unsigned* ZT = (const unsigned*)(F.ws + WS_ZT); bf16* Y = (bf16*)(F.ws + WS_Y);
    const GAS float* cw = (const GAS float*)(inp(F, I_CONVW) + (size_t)l * 3 * NHY); const GAS float* cb = (const GAS float*)(inp(F, I_CONVB) + (size_t)l * NHY); const GAS float* skp = (const GAS float*)(inp(F, I_SKIP) + (size_t)l * 2 * HYW);
    const int c0 = blk * 4, tid = F.tid;
    __syncthreads();
    HPS(20); hy_filter_gen(F, l, c0, FSP);
    if (F.wave == 0) { const int pz = c0 >> 8; gu32* cz = F.ctl + CW_ZT + 64 * 16 * l;
        wait_ge(cz + 64 * pz, 256u, F.ctl + CW_TMO); wait_ge(cz + 64 * (4 + pz), 256u, F.ctl + CW_TMO); wait_ge(cz + 64 * (8 + pz), 256u, F.ctl + CW_TMO);
        __builtin_amdgcn_fence(__ATOMIC_ACQUIRE, "agent"); }
    VM_WAIT(); __syncthreads(); HPE(20); HPS(21);
    CvPipe cvp; float cvv[32];
    {
        const int nlate = 1152 - 4 * F.G, bx = (int)blockIdx.x;
        if (false && F.G == 256 && nlate == 128) { if (bx >= nlate) CV_START(F, cvp, cvv, 1, l, 2, (bx - nlate) * NWAVES + F.wave, 128 * NWAVES); else CV_START(F, cvp, cvv, 1, l, 1, bx * NWAVES + F.wave, 128 * NWAVES); }
        else CV_START(F, cvp, cvv, 1, l, 0, F.vcu * NWAVES + F.wave, F.G * NWAVES);
    }
    unsigned yb0[8], yb1[8], yb2[8], yb3[8];
#pragma unroll
    for (int q = 0; q < 8; ++q) { yb0[q] = 0u; yb1[q] = 0u; yb2[q] = 0u; yb3[q] = 0u; }
    const c32 tw1 = cis_pi(-2.0f * (float)tid / 8192.0f), tw2 = cis_pi(-2.0f * (float)(tid & 31) / 512.0f), twp = cis_pi(-(float)(tid & 31) / 32.0f), twl = cis_pi(-(float)(tid >> 5) / 8192.0f);
#pragma unroll 1
    for (int chl = 0; chl < 4; ++chl) {
        const int c = c0 + chl; const GAS unsigned* zk = (const GAS unsigned*)(FSP + (size_t)chl * 2 * 8192);
        c32 keep[8]; unsigned x1p[8], x2p[8];
        c32 s[16];
        {
            unsigned fw[16]; c32 fz[16];
            { int t2 = tid; HY_OPAQUE(t2);
#pragma unroll
              for (int q = 0; q < 16; ++q) fw[q] = zk[t2 + 512 * q]; }
            c32 xa[8], xb[8];
            hy_conv3_load(tid, ZT + (size_t)(2048 + c) * (SEQ / 2), cw[2048 + c], cw[NHY + 2048 + c], cw[2 * NHY + 2048 + c], cb[2048 + c], keep);
            hy_conv3_load(tid, ZT + (size_t)c * (SEQ / 2), cw[c], cw[NHY + c], cw[2 * NHY + c], cb[c], xa);
            hy_conv3_load(tid, ZT + (size_t)(1024 + c) * (SEQ / 2), cw[1024 + c], cw[NHY + 1024 + c], cw[2 * NHY + 1024 + c], cb[1024 + c], xb);
#pragma unroll
            for (int q = 0; q < 8; ++q) { x1p[q] = pk_c32(xa[q]); x2p[q] = pk_c32(xb[q]); }
#pragma unroll
            for (int q = 0; q < 16; ++q) fz[q] = cmk(bfl(fw[q]), bfh(fw[q]));
            fft_s1_fwd(tid, B, fz, tw1);
            hy_data_s1(tid, A, keep, tw1);
        }
        const float sk0 = skp[c], sk1 = skp[HYW + c];
#pragma unroll
        for (int ord = 0; ord < 2; ++ord) {
            __syncthreads();
            HPS(22); fft_s2_fwd(tid, A, tw2); fft_s2_fwd(tid, B, tw2);
            __syncthreads(); HPE(22); HPS(23);
            CV_STEP(F, cvp, cvv);
            fft_s3_read<-1>(tid, A, s); fft_s3_write(tid, A, s);
            fft_s3_read<-1>(tid, B, s); fft_s3_write(tid, B, s);
            unsigned fw[16];
            if (ord == 0) { int t2 = tid; HY_OPAQUE(t2);
#pragma unroll
                for (int q = 0; q < 16; ++q) fw[q] = zk[8192 + t2 + 512 * q]; }
            __syncthreads(); HPE(23); HPS(24);
            CV_STEP(F, cvp, cvv);
            pair_pass(tid, A, B, twp, twl);
            __syncthreads(); HPE(24); HPS(25);
            if (ord == 0) { c32 fz[16];
#pragma unroll
                for (int q = 0; q < 16; ++q) fz[q] = cmk(bfl(fw[q]), bfh(fw[q]));
                fft_s1_fwd(tid, B, fz, tw1); }
            fft_s3_read<1>(tid, A, s); fft_s3_write(tid, A, s);
            __syncthreads();
            CV_STEP(F, cvp, cvv);
            fft_s2_inv(tid, A, tw2);
            __syncthreads();
            fft_s1_inv(tid, A, s, tw1); HPE(25); HPS(26);
            if (ord == 0) {
#pragma unroll
                for (int q = 0; q < 8; ++q) { const c32 xv = unpk_c32(x1p[q]); keep[q] = cmk(FMUL(xv.x, FFMA(keep[q].x, sk0, s[q].x)), FMUL(xv.y, FFMA(keep[q].y, sk0, s[q].y))); }
                hy_data_s1(tid, A, keep, tw1);
            } else {
#pragma unroll
                for (int q = 0; q < 8; ++q) { const c32 xv = unpk_c32(x2p[q]); const unsigned yv = pk_c32(cmk(FMUL(xv.x, FFMA(keep[q].x, sk1, s[q].x)), FMUL(xv.y, FFMA(keep[q].y, sk1, s[q].y))));
                    yb0[q] = (chl == 0) ? yv : yb0[q]; yb1[q] = (chl == 1) ? yv : yb1[q]; yb2[q] = (chl == 2) ? yv : yb2[q]; yb3[q] = (chl == 3) ? yv : yb3[q]; }
            }
            HPE(26);
        }
        __syncthreads();
    }
    {
        int t2 = tid; HY_OPAQUE(t2);
#pragma unroll
        for (int q = 0; q < 8; ++q) { const int m = t2 + 512 * q;
            v2u lo, hi; lo.x = (yb0[q] & 0xffffu) | (yb1[q] << 16); lo.y = (yb2[q] & 0xffffu) | (yb3[q] << 16);
            hi.x = (yb0[q] >> 16) | (yb1[q] & 0xffff0000u); hi.y = (yb2[q] >> 16) | (yb3[q] & 0xffff0000u);
            *(GAS v2u*)(Y + (size_t)(2 * m) * DM + c0) = lo; *(GAS v2u*)(Y + (size_t)(2 * m + 1) * DM + c0) = hi; }
    }
    while (cvp.have) CV_STEP(F, cvp, cvv);
    HPE(21);
}

__device__ __forceinline__ void rt_split8(const f32x4 a, const f32x4 b, bf16x8& hi, bf16x8& lo) {
    const float v[8] = {a.x, a.y, a.z, a.w, b.x, b.y, b.z, b.w}; v4u hw, lw;
#pragma unroll
    for (int j = 0; j < 4; ++j) { const unsigned h = pk2h(v[2 * j], v[2 * j + 1]); const unsigned lo2 = pk2h(v[2 * j] - bfl(h), v[2 * j + 1] - bfh(h)); hw[j] = h; lw[j] = lo2; }
    hi = __builtin_bit_cast(bf16x8, hw); lo = __builtin_bit_cast(bf16x8, lw);
}
__device__ __forceinline__ void route_block(Frame& F, int l, int tb  ) {
    LAS int* lcnt = (LAS int*)(F.lds);
    LAS int* lbase = (LAS int*)(F.lds + 64);
    LAS int* le = (LAS int*)(F.lds + 128);
    LAS int* lp = (LAS int*)(F.lds + 128 + 256);
    LAS float* lw = (LAS float*)(F.lds + 128 + 512);
    LAS float* lr = (LAS float*)(F.lds + 128 + 768);
    LAS float* SS = (LAS float*)(F.lds + 1024);
    LAS float* PL = (LAS float*)(F.lds + 2048);
    const bf16* XR = (const bf16*)(F.ws + WS_XR); unsigned char* H8 = (unsigned char*)(F.ws + WS_XN); const float* WR = (const float*)(F.ws + WS_WR + (size_t)l * 256 * 1024);
    const float* g = inp(F, I_GFFN) + (size_t)l * DM; const float* brg = inp(F, I_BRG) + l * 4; const float* bre = inp(F, I_BRE) + l * 16;
    int* TOKLIST = (int*)(F.ws + WS_LISTS); float* WLIST = (float*)(F.ws + WS_LISTS + 512 * 1024); int* TOKPOS = (int*)(F.ws + WS_LISTS + 1 * MiB); float* RSLIST = (float*)(F.ws + WS_LISTS + 1 * MiB + 512 * 1024);
    gu32* gcnt = F.ctl + CW_CNT + 64 * 16 * l;
    if (F.wave == 0) { wait_ge(F.ctl + CW_XR + 64 * (32 * l + (tb >> 8)), 64u, F.ctl + CW_TMO); __builtin_amdgcn_fence(__ATOMIC_ACQUIRE, "agent"); asm volatile("s_waitcnt vmcnt(0)" ::: "memory"); }
    __syncthreads();
    if (F.tid < 16) lcnt[F.tid] = 0;
    const int ts = F.tid >> 4, part = F.tid & 15;
    {
        const int fr = F.lane & 15, fq = F.lane >> 4, kw = 256 * F.wave + 8 * fq;
        f32x4 acc[2][2];
#pragma unroll
        for (int a = 0; a < 2; ++a)
#pragma unroll
            for (int b = 0; b < 2; ++b) acc[a][b] = (f32x4){0.f, 0.f, 0.f, 0.f};
        float ssl[2] = {0.f, 0.f};
        const bf16* x0 = XR + (size_t)(tb + fr) * DM + kw; const bf16* x1 = x0 + (size_t)16 * DM;
        const float* w0 = WR + (size_t)fr * DM + kw; const float* w1 = WR + (size_t)(16 + (fr & 3)) * DM + kw;
        v4u xb[2]; f32x4 wa[2][2], ga[2];
#define RT_LD(ks) do { const int _k = 32 * (ks); xb[0] = *(const GAS v4u*)(x0 + _k); xb[1] = *(const GAS v4u*)(x1 + _k); \
            wa[0][0] = *(const GAS f32x4*)(w0 + _k); wa[0][1] = *(const GAS f32x4*)(w0 + _k + 4); wa[1][0] = *(const GAS f32x4*)(w1 + _k); wa[1][1] = *(const GAS f32x4*)(w1 + _k + 4); \
            ga[0] = *(const GAS f32x4*)(g + kw + _k); ga[1] = *(const GAS f32x4*)(g + kw + _k + 4); } while (0)
        RT_LD(0);
#pragma unroll 1
        for (int ks = 0; ks < 8; ++ks) {
            bf16x8 ah[2], al[2], bh[2], bl[2];
#pragma unroll
            for (int mt = 0; mt < 2; ++mt) { const v4u xw = xb[mt]; const f32x4 p = (f32x4){bfl(xw.x), bfh(xw.x), bfl(xw.y), bfh(xw.y)}, q = (f32x4){bfl(xw.z), bfh(xw.z), bfl(xw.w), bfh(xw.w)};
                ssl[mt] += ((p.x * p.x + p.y * p.y) + (p.z * p.z + p.w * p.w)) + ((q.x * q.x + q.y * q.y) + (q.z * q.z + q.w * q.w));
                const f32x4 pg = p * ga[0], qg = q * ga[1];
                rt_split8(pg, qg, ah[mt], al[mt]);
                int ha = __builtin_amdgcn_cvt_pk_fp8_f32(pg.x, pg.y, 0, false); ha = __builtin_amdgcn_cvt_pk_fp8_f32(pg.z, pg.w, ha, true);
                int hb = __builtin_amdgcn_cvt_pk_fp8_f32(qg.x, qg.y, 0, false); hb = __builtin_amdgcn_cvt_pk_fp8_f32(qg.z, qg.w, hb, true);
                *(GAS v2u*)(H8 + (size_t)(tb + 16 * mt + fr) * DM + kw + 32 * ks) = (v2u){(unsigned)ha, (unsigned)hb}; }
            rt_split8(wa[0][0], wa[0][1], bh[0], bl[0]);
            { const float z = (fr < 4) ? 1.f : 0.f; rt_split8(wa[1][0] * z, wa[1][1] * z, bh[1], bl[1]); }
            if (ks < 7) RT_LD(ks + 1);
#pragma unroll
            for (int mt = 0; mt < 2; ++mt)
#pragma unroll
                for (int nt = 0; nt < 2; ++nt) { acc[mt][nt] = __builtin_amdgcn_mfma_f32_16x16x32_bf16(ah[mt], bh[nt], acc[mt][nt], 0, 0, 0);
                    acc[mt][nt] = __builtin_amdgcn_mfma_f32_16x16x32_bf16(al[mt], bh[nt], acc[mt][nt], 0, 0, 0);
                    acc[mt][nt] = __builtin_amdgcn_mfma_f32_16x16x32_bf16(ah[mt], bl[nt], acc[mt][nt], 0, 0, 0); }
        }
#undef RT_LD
#pragma unroll
        for (int mt = 0; mt < 2; ++mt) { float s = ssl[mt]; s += shfl_xor_l(s, 16, F.lane); s += shfl_xor_l(s, 32, F.lane); if (fq == 0) SS[F.wave * 32 + 16 * mt + fr] = s;
#pragma unroll
            for (int nt = 0; nt < 2; ++nt)
#pragma unroll
                for (int r = 0; r < 4; ++r) PL[(F.wave * 32 + 16 * mt + 4 * fq + r) * 32 + 16 * nt + fr] = acc[mt][nt][r]; }
    }
    __syncthreads();
    float acc[20], ss = 0.f;
#pragma unroll
    for (int o = 0; o < 20; ++o) acc[o] = 0.f;
#pragma unroll
    for (int w = 0; w < 8; ++w) { ss += SS[w * 32 + ts];
#pragma unroll
        for (int o = 0; o < 20; ++o) acc[o] += PL[(w * 32 + ts) * 32 + o]; }
    const float rstd = 1.0f / sqrtf(ss * (1.0f / DM) + EPS);
    {
        float lg0 = acc[0] * rstd + brg[0], lg1 = acc[1] * rstd + brg[1], lg2 = acc[2] * rstd + brg[2], lg3 = acc[3] * rstd + brg[3];
        int grp = 0; float mx = lg0;
        if (lg1 > mx) { mx = lg1; grp = 1; } if (lg2 > mx) { mx = lg2; grp = 2; } if (lg3 > mx) { mx = lg3; grp = 3; }
        const float den = (__expf(lg0 - mx) + __expf(lg1 - mx)) + (__expf(lg2 - mx) + __expf(lg3 - mx));
        const float psel = 1.0f / den;
        const float m0 = (grp == 0) ? 1.f : 0.f, m1 = (grp == 1) ? 1.f : 0.f, m2 = (grp == 2) ? 1.f : 0.f, m3 = (grp == 3) ? 1.f : 0.f;
        float e0v = (m0 * acc[4] + m1 * acc[8]) + (m2 * acc[12] + m3 * acc[16]), e1v = (m0 * acc[5] + m1 * acc[9]) + (m2 * acc[13] + m3 * acc[17]);
        float e2v = (m0 * acc[6] + m1 * acc[10]) + (m2 * acc[14] + m3 * acc[18]), e3v = (m0 * acc[7] + m1 * acc[11]) + (m2 * acc[15] + m3 * acc[19]);
        e0v = e0v * rstd + bre[grp * 4 + 0]; e1v = e1v * rstd + bre[grp * 4 + 1]; e2v = e2v * rstd + bre[grp * 4 + 2]; e3v = e3v * rstd + bre[grp * 4 + 3];
        int i0 = 0; float v0 = e0v;
        if (e1v > v0) { v0 = e1v; i0 = 1; } if (e2v > v0) { v0 = e2v; i0 = 2; } if (e3v > v0) { v0 = e3v; i0 = 3; }
        int i1 = -1; float v1 = -3.0e38f;
        if (i0 != 0 && e0v > v1) { v1 = e0v; i1 = 0; } if (i0 != 1 && e1v > v1) { v1 = e1v; i1 = 1; } if (i0 != 2 && e2v > v1) { v1 = e2v; i1 = 2; } if (i0 != 3 && e3v > v1) { v1 = e3v; i1 = 3; }
        const float ex = __expf(v1 - v0); const float w0 = psel / (1.0f + ex), w1 = psel * ex / (1.0f + ex);
        if (part == 0) { const int ea = grp * 4 + i0, eb = grp * 4 + i1;
            le[ts * 2] = ea; le[ts * 2 + 1] = eb; lw[ts * 2] = w0; lw[ts * 2 + 1] = w1; lr[ts] = rstd;
            lp[ts * 2] = __hip_atomic_fetch_add(lcnt + ea, 1, __ATOMIC_RELAXED, __HIP_MEMORY_SCOPE_WORKGROUP); lp[ts * 2 + 1] = __hip_atomic_fetch_add(lcnt + eb, 1, __ATOMIC_RELAXED, __HIP_MEMORY_SCOPE_WORKGROUP); }
    }
    __syncthreads();
    if (F.tid < 16) lbase[F.tid] = (int)__hip_atomic_fetch_add(gcnt + 64 * F.tid, (unsigned)lcnt[F.tid], RLX_AGENT);
    __syncthreads();
    if (F.tid < 64) { const int t2 = F.tid >> 1; const int e = le[F.tid], pos = lbase[e] + lp[F.tid];
        TOKLIST[e * SEQ + pos] = tb + t2; WLIST[e * SEQ + pos] = lw[F.tid]; RSLIST[e * SEQ + pos] = lr[t2]; TOKPOS[(tb + t2) * 2 + (F.tid & 1)] = (e << 13) | pos; }
}
using pg8::Unit; using pg8::f32x2; using pg8::u32x4; using pg8::u32x2; using pg8::cvt_pk_bf16; using pg8::gelu_pk; using pg8::sigmoid_f;
__device__ __forceinline__ void tile_of(int idx, int nM, int nN, int& pm, int& pn) {
    const int nig = 8 * nN, gid = idx / nig, fm = gid * 8, gsz = (nM - fm) < 8 ? (nM - fm) : 8;
    pm = fm + ((idx % nig) % gsz); pn = (idx % nig) / gsz;
}
__device__ __forceinline__ int xcd_remap(int L, int nwg) { const int q = nwg / 8, r = nwg % 8, xcd = L % 8, off = L / 8; return (xcd < r ? xcd * (q + 1) : r * (q + 1) + (xcd - r) * q) + off; }

struct InProjSched {
    static constexpr bool GATHER = false, WAIT = false, HALF = false;
    const char* XN; const char* WIN; int G, c;
    __device__ __forceinline__ bool next(int i, Unit& u) const {
        const int L = i * G + c; if (L >= 640) return false;
        if (L < 384) { u.kind = 0; tile_of((L & 7) * 48 + (L >> 3), 12, 32, u.pm, u.pn); }
        else if (L < 640) { const int L1 = L - 384; u.kind = 1; tile_of((L1 & 7) * 32 + (L1 >> 3), 32, 8, u.pm, u.pn); }
        else { const int L2 = L - 640; u.kind = 1; tile_of((L2 & 7) * 64 + (L2 >> 3), 32, 16, u.pm, u.pn); u.pn += 8; }
        u.e = 0; u.row0 = 0; u.nvalid = 256; u.rt = 0; u.half = 0; return true;
    }
    __device__ __forceinline__ const char* a_base(const Unit& u) const { return (u.kind == 0 ? WIN : XN) + (size_t)u.pm * (256 * DM * 2); }
    __device__ __forceinline__ const char* b_base(const Unit& u) const { return (u.kind == 0 ? XN : WIN + (size_t)NHY * DM * 2) + (size_t)u.pn * (256 * DM * 2); }
    __device__ __forceinline__ unsigned a_goff(const Unit&, int) const { return 0u; }
};
struct EpiInProj {
    static constexpr bool PERM = true, MIDK = false, FP8 = false;
    bf16 *ZT, *U; const float* bin; gu32 *cz, *cu;
    __device__ __forceinline__ void operator()(const f32x4 (&acc)[2][2][4][2], const Unit& u, int wr, int wc, int fr, int fq) const {
        asm volatile("" : "+v"(fr), "+v"(fq));
        if (u.kind == 0) {
            const __amdgpu_buffer_rsrc_t rz = __builtin_amdgcn_make_buffer_rsrc(ZT, 0, NHY * SEQ * 2, 0x00020000);
            const int row0 = u.pm * 256 + wr * 64 + fr, col0 = u.pn * 256 + wc * 32 + 8 * fq;
#pragma unroll
            for (int ai = 0; ai < 2; ++ai)
#pragma unroll
                for (int m = 0; m < 4; ++m) { const int row = row0 + ai * 128 + m * 16; const float b = bin[row]; bf16* rowp = ZT + (size_t)row * SEQ + col0;
#pragma unroll
                    for (int bj = 0; bj < 2; ++bj) { const f32x4 v0 = acc[ai][bj][m][0] + b, v1 = acc[ai][bj][m][1] + b;
                        u32x4 w; w.x = cvt_pk_bf16(v0[0], v0[1]); w.y = cvt_pk_bf16(v0[2], v0[3]); w.z = cvt_pk_bf16(v1[0], v1[1]); w.w = cvt_pk_bf16(v1[2], v1[3]);
                        __builtin_amdgcn_raw_buffer_store_b128(w, rz, (int)((rowp + bj * 128 - ZT) * 2), 0, 16); } }
            asm volatile("s_waitcnt vmcnt(0)" ::: "memory");
            if (fr == 0 && fq == 0) __hip_atomic_fetch_add(cz + 64 * u.pm, 1u, RLX_AGENT);
        } else {
            const int seg = (u.pn < 4) ? 0 : (u.pn < 8) ? 1 : (u.pn < 16) ? 2 : 3;
            const int colt = (seg == 0) ? u.pn * 256 : (seg == 1) ? (u.pn - 4) * 256 : (seg == 2) ? (u.pn - 8) * 256 : (u.pn - 16) * 256;
            const int row0 = u.pm * 256 + wr * 64 + fr, col0 = colt + wc * 32 + 8 * fq, bcol0 = NHY + u.pn * 256 + wc * 32 + 8 * fq;
            f32x4 bv[2][2];
#pragma unroll
            for (int bj = 0; bj < 2; ++bj)
#pragma unroll
                for (int n = 0; n < 2; ++n) bv[bj][n] = *(const f32x4*)(bin + bcol0 + bj * 128 + 4 * n);
            if (seg < 2) {
                const __amdgpu_buffer_rsrc_t ru = __builtin_amdgcn_make_buffer_rsrc(U, 0, 2 * SEQ * SGW * 2, 0x00020000);
                bf16* base = (bf16*)((char*)U + ((seg == 0) ? (size_t)0 : (size_t)(WS_GV - WS_U)));
#pragma unroll
                for (int ai = 0; ai < 2; ++ai)
#pragma unroll
                    for (int m = 0; m < 4; ++m) { bf16* rowp = base + (size_t)(row0 + ai * 128 + m * 16) * 1024 + col0;
#pragma unroll
                        for (int bj = 0; bj < 2; ++bj) { f32x4 v0 = acc[ai][bj][m][0] + bv[bj][0], v1 = acc[ai][bj][m][1] + bv[bj][1];
                            const f32x2 a = gelu_pk((f32x2){v0[0], v0[1]}), b = gelu_pk((f32x2){v0[2], v0[3]}), c = gelu_pk((f32x2){v1[0], v1[1]}), d = gelu_pk((f32x2){v1[2], v1[3]});
                            u32x4 w; w.x = cvt_pk_bf16(a.x, a.y); w.y = cvt_pk_bf16(b.x, b.y); w.z = cvt_pk_bf16(c.x, c.y); w.w = cvt_pk_bf16(d.x, d.y);
                            __builtin_amdgcn_raw_buffer_store_b128(w, ru, (int)((rowp + bj * 128 - U) * 2), 0, 16); } }
                asm volatile("s_waitcnt vmcnt(0)" ::: "memory");
                if (fr == 0 && fq == 0) __hip_atomic_fetch_add(cu + 64 * u.pm, 1u, RLX_AGENT);
            } else {
                unsigned char* base = (unsigned char*)U + ((seg == 2) ? (size_t)(WS_GH - WS_U) : (size_t)(WS_GS - WS_U));
#pragma unroll
                for (int ai = 0; ai < 2; ++ai)
#pragma unroll
                    for (int m = 0; m < 4; ++m) { unsigned char* rowp = base + (size_t)(row0 + ai * 128 + m * 16) * DM + col0;
#pragma unroll
                        for (int bj = 0; bj < 2; ++bj) { const f32x4 v0 = acc[ai][bj][m][0] + bv[bj][0], v1 = acc[ai][bj][m][1] + bv[bj][1];
                            unsigned w0 = 0u, w1 = 0u;
#pragma unroll
                            for (int j = 0; j < 4; ++j) { w0 = __builtin_amdgcn_cvt_pk_u8_f32(fmaxf(sigmoid_f(v0[j]) * 255.0f, 1.0f), j, w0); w1 = __builtin_amdgcn_cvt_pk_u8_f32(fmaxf(sigmoid_f(v1[j]) * 255.0f, 1.0f), j, w1); }
                            u32x2 w; w.x = w0; w.y = w1; *(u32x2*)(rowp + bj * 128) = w; } }
            }
        }
    }
    __device__ __forceinline__ void mid(f32x4 (&)[2][2][4][2], const Unit&, int, int, int, int) const {}
};
struct GateSched8 {
    static constexpr bool GATHER = false, WAIT = false, HALF = false;
    const char* XN8; const char* W8; int G, c;
    __device__ __forceinline__ bool next(int i, Unit& u) const {
        int idx;
        if (G == 256) { const int x = c & 7, q = c >> 3; if (q < 16) { if (i >= 1) return false; idx = x * 64 + q; } else { if (i >= 3) return false; idx = x * 64 + 16 + 3 * (q - 16) + i; } }
        else { idx = i * G + c; if (idx >= 512) return false; }
        tile_of(idx, 32, 16, u.pm, u.pn); u.kind = 1; u.e = 0; u.row0 = 0; u.nvalid = 256; u.rt = 0; u.half = 0; return true;
    }
    __device__ __forceinline__ const char* a_base(const Unit& u) const { return XN8 + (size_t)u.pm * (256 * DM); }
    __device__ __forceinline__ const char* b_base(const Unit& u) const { return W8 + (size_t)u.pn * (256 * DM); }
    __device__ __forceinline__ unsigned a_goff(const Unit&, int) const { return 0u; }
};
struct EpiGate8 {
    static constexpr bool PERM = true, MIDK = false, FP8 = true;
    unsigned char *GH, *GS; const float* bin;
    __device__ __forceinline__ void operator()(const f32x4 (&acc)[2][2][4][2], const Unit& u, int wr, int wc, int fr, int fq) const {
        asm volatile("" : "+v"(fr), "+v"(fq));
        const int row0 = u.pm * 256 + wr * 64 + fr, col0 = (u.pn & 7) * 256 + wc * 32 + 8 * fq, bcol0 = NHY + (u.pn + 8) * 256 + wc * 32 + 8 * fq;
        f32x4 bv[2][2];
#pragma unroll
        for (int bj = 0; bj < 2; ++bj)
#pragma unroll
            for (int n = 0; n < 2; ++n) bv[bj][n] = *(const f32x4*)(bin + bcol0 + bj * 128 + 4 * n);
        unsigned char* base = (u.pn < 8) ? GH : GS;
#pragma unroll
        for (int ai = 0; ai < 2; ++ai)
#pragma unroll
            for (int m = 0; m < 4; ++m) { unsigned char* rowp = base + (size_t)(row0 + ai * 128 + m * 16) * DM + col0;
#pragma unroll
                for (int bj = 0; bj < 2; ++bj) { const f32x4 v0 = acc[ai][bj][m][0] * (1.0f / 64.0f) + bv[bj][0], v1 = acc[ai][bj][m][1] * (1.0f / 64.0f) + bv[bj][1];
                    unsigned w0 = 0u, w1 = 0u;
#pragma unroll
                    for (int j = 0; j < 4; ++j) { w0 = __builtin_amdgcn_cvt_pk_u8_f32(fmaxf(sigmoid_f(v0[j]) * 255.0f, 1.0f), j, w0); w1 = __builtin_amdgcn_cvt_pk_u8_f32(fmaxf(sigmoid_f(v1[j]) * 255.0f, 1.0f), j, w1); }
                    u32x2 w; w.x = w0; w.y = w1; *(u32x2*)(rowp + bj * 128) = w; } }
    }
    __device__ __forceinline__ void mid(f32x4 (&)[2][2][4][2], const Unit&, int, int, int, int) const {}
};
struct GridSched {
    static constexpr bool GATHER = false, WAIT = false, HALF = false;
    const char* A; const char* Bt; int nM, nN, K, G, c;
    __device__ __forceinline__ bool next(int i, Unit& u) const {
        const int L = i * G + c, nwg = nM * nN; if (L >= nwg) return false;
        tile_of(xcd_remap(L, nwg), nM, nN, u.pm, u.pn); u.kind = 0; u.e = 0; u.row0 = 0; u.nvalid = 256; u.rt = 0; u.half = 0; return true;
    }
    __device__ __forceinline__ const char* a_base(const Unit& u) const { return A + (size_t)u.pm * 512 * K; }
    __device__ __forceinline__ const char* b_base(const Unit& u) const { return Bt + (size_t)u.pn * 512 * K; }
    __device__ __forceinline__ unsigned a_goff(const Unit&, int) const { return 0u; }
};
struct GridSchedW : GridSched {
    static constexpr bool WAIT = true;
    gu32* pcnt; unsigned need; gu32* tmo;
    __device__ __forceinline__ void a_ready(const Unit& u, int wid) const {
        if (wid == 0) { wait_ge(pcnt + 64 * u.pm, need, tmo); __builtin_amdgcn_fence(__ATOMIC_ACQUIRE, "agent"); asm volatile("s_waitcnt vmcnt(0)" ::: "memory"); }
        asm volatile("" ::: "memory"); __builtin_amdgcn_s_barrier(); asm volatile("" ::: "memory");
    }
};
struct EpiMerge {
    static constexpr bool PERM = true, MIDK = true, FP8 = false;
    const unsigned char *GH, *GS; bf16* O; gu32* pcnt;
    __device__ __forceinline__ void mid(f32x4 (&acc)[2][2][4][2], const Unit& u, int wr, int wc, int fr, int fq) const {
        asm volatile("" : "+v"(fr), "+v"(fq));
        const int row0 = u.pm * 256 + wr * 64 + fr, col0 = u.pn * 256 + wc * 32 + 8 * fq;
        u32x2 hb[2][2], sb[2][2];
#define EM_LOAD(g, par) do { const size_t _o = (size_t)(row0 + ((g) >> 2) * 128 + ((g) & 3) * 16) * DM + col0; \
            hb[par][0] = *(const u32x2*)(GH + _o); hb[par][1] = *(const u32x2*)(GH + _o + 128); sb[par][0] = *(const u32x2*)(GS + _o); sb[par][1] = *(const u32x2*)(GS + _o + 128); } while (0)
        EM_LOAD(0, 0);
#pragma unroll
        for (int g = 0; g < 8; ++g) { const int ai = g >> 2, m = g & 3, par = g & 1;
            if (g + 1 < 8) EM_LOAD(g + 1, (g + 1) & 1);
            asm volatile("" ::: "memory");
#pragma unroll
            for (int bj = 0; bj < 2; ++bj) { const unsigned hh[2] = {hb[par][bj].x, hb[par][bj].y}, sv[2] = {sb[par][bj].x, sb[par][bj].y};
#pragma unroll
                for (int n = 0; n < 2; ++n)
#pragma unroll
                    for (int j = 0; j < 4; ++j) acc[ai][bj][m][n][j] *= (float)((hh[n] >> (8 * j)) & 0xffu) * __builtin_amdgcn_rcpf((float)((sv[n] >> (8 * j)) & 0xffu)); }
            asm volatile("" : "+v"(acc[ai][0][m][0]), "+v"(acc[ai][0][m][1]), "+v"(acc[ai][1][m][0]), "+v"(acc[ai][1][m][1])); }
#undef EM_LOAD
    }
    __device__ __forceinline__ void operator()(const f32x4 (&acc)[2][2][4][2], const Unit& u, int wr, int wc, int fr, int fq) const {
        asm volatile("" : "+v"(fr), "+v"(fq));
        const int row0 = u.pm * 256 + wr * 64 + fr, col0 = u.pn * 256 + wc * 32 + 8 * fq;
        u32x2 sb[2][2]; const __amdgpu_buffer_rsrc_t ro = __builtin_amdgcn_make_buffer_rsrc(O, 0, SEQ * DM * 2, 0x00020000);
#define EM_LOAD(g, par) do { const size_t _o = (size_t)(row0 + ((g) >> 2) * 128 + ((g) & 3) * 16) * DM + col0; sb[par][0] = *(const u32x2*)(GS + _o); sb[par][1] = *(const u32x2*)(GS + _o + 128); } while (0)
        EM_LOAD(0, 0); EM_LOAD(1, 1);
#pragma unroll
        for (int g = 0; g < 8; ++g) { const int ai = g >> 2, m = g & 3, par = g & 1; const size_t off = (size_t)(row0 + ai * 128 + m * 16) * DM + col0;
            u32x4 w[2];
#pragma unroll
            for (int bj = 0; bj < 2; ++bj) { const unsigned sv[2] = {sb[par][bj].x, sb[par][bj].y}; float o[8];
#pragma unroll
                for (int n = 0; n < 2; ++n)
#pragma unroll
                    for (int j = 0; j < 4; ++j) o[4 * n + j] = acc[ai][bj][m][n][j] * ((float)((sv[n] >> (8 * j)) & 0xffu) * (1.0f / 255.0f));
                w[bj].x = cvt_pk_bf16(o[0], o[1]); w[bj].y = cvt_pk_bf16(o[2], o[3]); w[bj].z = cvt_pk_bf16(o[4], o[5]); w[bj].w = cvt_pk_bf16(o[6], o[7]); }
            if (g + 2 < 8) EM_LOAD(g + 2, par);
            __builtin_amdgcn_raw_buffer_store_b128(w[0], ro, (int)(off * 2), 0, 16); __builtin_amdgcn_raw_buffer_store_b128(w[1], ro, (int)((off + 128) * 2), 0, 16);
            asm volatile("" ::: "memory"); }
#undef EM_LOAD
        asm volatile("s_waitcnt vmcnt(0)" ::: "memory");
        if (fr == 0 && fq == 0) __hip_atomic_fetch_add(pcnt + 64 * u.pm, 1u, RLX_AGENT);
    }
};
struct EpiResid {
    static constexpr bool PERM = true, MIDK = false, FP8 = false;
    const float* basef; const bf16* baseh; bf16* out; gu32* pcnt;
    __device__ __forceinline__ void operator()(const f32x4 (&acc)[2][2][4][2], const Unit& u, int wr, int wc, int fr, int fq) const {
        asm volatile("" : "+v"(fr), "+v"(fq));
        const int row0 = u.pm * 256 + wr * 64 + fr, col0 = u.pn * 256 + wc * 32 + 8 * fq;
        const __amdgpu_buffer_rsrc_t rx = __builtin_amdgcn_make_buffer_rsrc(out, 0, SEQ * DM * 2, 0x00020000);
        if (basef) {
            f32x4 bb[2][4];
#define ER_LOAD(g, par) do { const size_t _o = (size_t)(row0 + ((g) >> 2) * 128 + ((g) & 3) * 16) * DM + col0; \
                bb[par][0] = *(const f32x4*)(basef + _o); bb[par][1] = *(const f32x4*)(basef + _o + 4); bb[par][2] = *(const f32x4*)(basef + _o + 128); bb[par][3] = *(const f32x4*)(basef + _o + 132); } while (0)
            ER_LOAD(0, 0); ER_LOAD(1, 1);
#pragma unroll
            for (int g = 0; g < 8; ++g) { const int ai = g >> 2, m = g & 3, par = g & 1; const size_t off = (size_t)(row0 + ai * 128 + m * 16) * DM + col0;
                const f32x4 o0 = bb[par][0] + acc[ai][0][m][0], o1 = bb[par][1] + acc[ai][0][m][1], o2 = bb[par][2] + acc[ai][1][m][0], o3 = bb[par][3] + acc[ai][1][m][1];
                if (g + 2 < 8) ER_LOAD(g + 2, par);
                u32x4 w0, w1; w0.x = cvt_pk_bf16(o0[0], o0[1]); w0.y = cvt_pk_bf16(o0[2], o0[3]); w0.z = cvt_pk_bf16(o1[0], o1[1]); w0.w = cvt_pk_bf16(o1[2], o1[3]);
                w1.x = cvt_pk_bf16(o2[0], o2[1]); w1.y = cvt_pk_bf16(o2[2], o2[3]); w1.z = cvt_pk_bf16(o3[0], o3[1]); w1.w = cvt_pk_bf16(o3[2], o3[3]);
                __builtin_amdgcn_raw_buffer_store_b128(w0, rx, (int)(off * 2), 0, 16); __builtin_amdgcn_raw_buffer_store_b128(w1, rx, (int)((off + 128) * 2), 0, 16);
                asm volatile("" ::: "memory"); }
#undef ER_LOAD
        } else {
            u32x4 hb[2][2];
#define ER_LOAD(g, par) do { const size_t _o = (size_t)(row0 + ((g) >> 2) * 128 + ((g) & 3) * 16) * DM + col0; hb[par][0] = *(const u32x4*)(baseh + _o); hb[par][1] = *(const u32x4*)(baseh + _o + 128); } while (0)
            ER_LOAD(0, 0); ER_LOAD(1, 1);
#pragma unroll
            for (int g = 0; g < 8; ++g) { const int ai = g >> 2, m = g & 3, par = g & 1; const size_t off = (size_t)(row0 + ai * 128 + m * 16) * DM + col0;
                u32x4 w[2];
#pragma unroll
                for (int bj = 0; bj < 2; ++bj) { const unsigned hv[4] = {hb[par][bj].x, hb[par][bj].y, hb[par][bj].z, hb[par][bj].w}; const f32x4 v0 = acc[ai][bj][m][0], v1 = acc[ai][bj][m][1];
                    w[bj].x = cvt_pk_bf16(bfl(hv[0]) + v0[0], bfh(hv[0]) + v0[1]); w[bj].y = cvt_pk_bf16(bfl(hv[1]) + v0[2], bfh(hv[1]) + v0[3]);
                    w[bj].z = cvt_pk_bf16(bfl(hv[2]) + v1[0], bfh(hv[2]) + v1[1]); w[bj].w = cvt_pk_bf16(bfl(hv[3]) + v1[2], bfh(hv[3]) + v1[3]); }
                if (g + 2 < 8) ER_LOAD(g + 2, par);
                __builtin_amdgcn_raw_buffer_store_b128(w[0], rx, (int)(off * 2), 0, 16); __builtin_amdgcn_raw_buffer_store_b128(w[1], rx, (int)((off + 128) * 2), 0, 16);
                asm volatile("" ::: "memory"); }
#undef ER_LOAD
        }
        asm volatile("s_waitcnt vmcnt(0)" ::: "memory");
        if (fr == 0 && fq == 0) __hip_atomic_fetch_add(pcnt + 64 * u.pm, 1u, RLX_AGENT);
    }
    __device__ __forceinline__ void mid(f32x4 (&)[2][2][4][2], const Unit&, int, int, int, int) const {}
};
__device__ __forceinline__ void moe_tile_of(const LAS int* tab, int s, int& e, int& j0) {
    const int nfull = __builtin_amdgcn_readfirstlane(tab[68]);
    e = 0;
    if (s < nfull) {
#pragma unroll
        for (int j = 1; j < 16; ++j) e += (__builtin_amdgcn_readfirstlane(tab[52 + j]) <= s) ? 1 : 0;
        j0 = s - __builtin_amdgcn_readfirstlane(tab[52 + e]);
    } else { const int p = s - nfull;
#pragma unroll
        for (int j = 1; j < 16; ++j) e += (__builtin_amdgcn_readfirstlane(tab[70 + j]) <= p) ? 1 : 0;
        j0 = __builtin_amdgcn_readfirstlane(tab[e + 1]) - __builtin_amdgcn_readfirstlane(tab[e]) - 1; }
    e = __builtin_amdgcn_readfirstlane(e); j0 = __builtin_amdgcn_readfirstlane(j0);
}
struct MoeSched1 {
    static constexpr bool GATHER = true, WAIT = false, HALF = true;
    const LAS int* tab; const char* H; const char* W; const int* toklist; int G, c;
    __device__ __forceinline__ bool next(int i, Unit& u) const {
        const int L = i * G + c; const int total = __builtin_amdgcn_readfirstlane(tab[16]) * 4; if (L >= total) return false;
        int e, j0; moe_tile_of(tab, L >> 2, e, j0); const int rt = __builtin_amdgcn_readfirstlane(tab[e]) + j0;
        u.pm = j0; u.pn = L & 3; u.kind = 0; u.e = e; u.rt = rt; u.row0 = __builtin_amdgcn_readfirstlane(tab[17 + e]) + 256 * j0;
        const int rem = __builtin_amdgcn_readfirstlane(tab[34 + e]) - 256 * j0; u.nvalid = rem < 256 ? rem : 256; u.half = __builtin_amdgcn_readfirstlane((rem <= 128) ? 1 : 0); return true;
    }
    __device__ __forceinline__ const char* a_base(const Unit&) const { return H; }
    __device__ __forceinline__ const char* b_base(const Unit& u) const { return W + ((size_t)u.e * 1024 + (size_t)u.pn * 256) * DM; }
    __device__ __forceinline__ unsigned a_goff(const Unit& u, int r) const { const int tok = (r < u.nvalid) ? toklist[u.e * SEQ + u.pm * 256 + r] : 0; return (unsigned)tok * (unsigned)DM; }
};
struct EpiMoe1 {
    static constexpr bool PERM = true, MIDK = false, FP8 = true;
    bf16* ACT; const float* wlist; const float* rslist; gu32* pcnt;
    __device__ __forceinline__ void operator()(const f32x4 (&acc)[2][2][4][2], const Unit& u, int wr, int wc, int fr, int fq) const {
        asm volatile("" : "+v"(fr), "+v"(fq));
        const int col0 = u.pn * 128 + wc * 32 + 8 * fq;
        const __amdgpu_buffer_rsrc_t ra = __builtin_amdgcn_make_buffer_rsrc(ACT, 0, 16640 * DEXP, 0x00020000);
#pragma unroll
        for (int ai = 0; ai < 2; ++ai)
#pragma unroll
            for (int m = 0; m < 4; ++m) { const int rl = ai * 128 + wr * 64 + m * 16 + fr;
                if (rl < u.nvalid) { const float wt = wlist[u.e * SEQ + u.pm * 256 + rl], rs = rslist[u.e * SEQ + u.pm * 256 + rl] * (1.0f / 64.0f);
                    const f32x4 g0 = acc[ai][0][m][0], g1 = acc[ai][0][m][1], u0 = acc[ai][1][m][0], u1 = acc[ai][1][m][1];
                    float o[8];
#pragma unroll
                    for (int j = 0; j < 4; ++j) { const float ga = g0[j] * rs, gb = g1[j] * rs; o[j] = ga * sigmoid_f(ga) * (u0[j] * rs) * wt; o[4 + j] = gb * sigmoid_f(gb) * (u1[j] * rs) * wt; }
#pragma unroll
                    for (int j = 0; j < 8; ++j) o[j] = __builtin_amdgcn_fmed3f(o[j] * 8.0f, -440.0f, 440.0f);
                    int wa = __builtin_amdgcn_cvt_pk_fp8_f32(o[0], o[1], 0, false); wa = __builtin_amdgcn_cvt_pk_fp8_f32(o[2], o[3], wa, true);
                    int wb = __builtin_amdgcn_cvt_pk_fp8_f32(o[4], o[5], 0, false); wb = __builtin_amdgcn_cvt_pk_fp8_f32(o[6], o[7], wb, true);
                    __builtin_amdgcn_raw_buffer_store_b64((u32x2){(unsigned)wa, (unsigned)wb}, ra, (int)((size_t)(u.row0 + rl) * DEXP + col0), 0, 16); } }
        asm volatile("s_waitcnt vmcnt(0)" ::: "memory");
        if (fr == 0 && fq == 0) __hip_atomic_fetch_add(pcnt + 64 * u.rt, 1u, RLX_AGENT);
    }
    __device__ __forceinline__ void mid(f32x4 (&)[2][2][4][2], const Unit&, int, int, int, int) const {}
};
struct MoeSched2 {
    static constexpr bool GATHER = false, WAIT = true, HALF = false;
    const LAS int* tab; const char* ACT; const char* W; int G, c; gu32* pcnt; gu32* tmo;
    __device__ __forceinline__ bool next(int i, Unit& u) const {
        if (c < 0) return false;
        const int L = i * G + c; const int total = __builtin_amdgcn_readfirstlane(tab[16]) * 8; if (L >= total) return false;
        int e, j0; moe_tile_of(tab, L >> 3, e, j0); const int rt = __builtin_amdgcn_readfirstlane(tab[e]) + j0;
        u.pm = j0; u.pn = L & 7; u.kind = 0; u.e = e; u.rt = rt; u.row0 = __builtin_amdgcn_readfirstlane(tab[17 + e]) + 256 * j0;
        const int rem = __builtin_amdgcn_readfirstlane(tab[34 + e]) - 256 * j0; u.nvalid = rem < 256 ? rem : 256; u.half = 0; return true;
    }
    __device__ __forceinline__ const char* a_base(const Unit& u) const { return ACT + (size_t)u.row0 * DEXP; }
    __device__ __forceinline__ const char* b_base(const Unit& u) const { return W + ((size_t)u.e * DM + (size_t)u.pn * 256) * DEXP; }
    __device__ __forceinline__ unsigned a_goff(const Unit&, int) const { return 0u; }
    __device__ __forceinline__ void a_ready(const Unit& u, int wid) const {
        if (wid == 0) {
            gu32* p = pcnt + 64 * u.rt; unsigned polls = 0;
            while ((unsigned)__builtin_amdgcn_readfirstlane(__hip_atomic_load(p, RLX_AGENT)) < 32u) {
                if (++polls > (1u << 22)) { if (threadIdx.x == 0) __hip_atomic_store(tmo, 1u, RLX_AGENT); break; }
                __builtin_amdgcn_s_sleep(2); }
            __builtin_amdgcn_fence(__ATOMIC_ACQUIRE, "agent");
            asm volatile("s_waitcnt vmcnt(0)" ::: "memory");
        }
        asm volatile("" ::: "memory"); __builtin_amdgcn_s_barrier(); asm volatile("" ::: "memory");
    }
};
struct EpiMoe2 {
    static constexpr bool PERM = true, MIDK = false, FP8 = true;
    bf16* MO;
    __device__ __forceinline__ void operator()(const f32x4 (&acc)[2][2][4][2], const Unit& u, int wr, int wc, int fr, int fq) const {
        asm volatile("" : "+v"(fr), "+v"(fq));
        const int col0 = u.pn * 256 + wc * 32 + 8 * fq;
#pragma unroll
        for (int ai = 0; ai < 2; ++ai)
#pragma unroll
            for (int m = 0; m < 4; ++m) { const int rl = ai * 128 + wr * 64 + m * 16 + fr;
                if (rl < u.nvalid) { bf16* rowp = MO + (size_t)(u.row0 + rl) * DM + col0;
#pragma unroll
                    for (int bj = 0; bj < 2; ++bj) { const f32x4 v0 = acc[ai][bj][m][0] * (1.0f / 512.0f), v1 = acc[ai][bj][m][1] * (1.0f / 512.0f);
                        u32x4 w; w.x = cvt_pk_bf16(v0[0], v0[1]); w.y = cvt_pk_bf16(v0[2], v0[3]); w.z = cvt_pk_bf16(v1[0], v1[1]); w.w = cvt_pk_bf16(v1[2], v1[3]);
                        *(u32x4*)(rowp + bj * 128) = w; } } }
    }
    __device__ __forceinline__ void mid(f32x4 (&)[2][2][4][2], const Unit&, int, int, int, int) const {}
};
__device__ __forceinline__ void moe_tables(Frame& F, int l) {
    LAS int* tab = (LAS int*)(F.lds + MISC_OFF + 128);
    __syncthreads();
    if (F.tid < 16) tab[34 + F.tid] = (int)__hip_atomic_load(F.ctl + CW_CNT + 64 * (16 * l + F.tid), RLX_AGENT);
    __syncthreads();
    if (F.tid == 0) { int tp = 0, off = 0, fp = 0, pp = 0;
        for (int e = 0; e < 16; ++e) { const int c = tab[34 + e]; tab[e] = tp; tab[17 + e] = off; tab[52 + e] = fp; tab[70 + e] = pp;
            const int nt = (c + 255) >> 8, part = (nt > 0 && (c - 256 * (nt - 1)) <= 128) ? 1 : 0; tp += nt; off += c; fp += nt - part; pp += part; }
        tab[68] = fp; tab[86] = pp;
        tab[16] = tp; tab[33] = off; }
    __syncthreads();
}

struct Args { const float* in[29]; float* out; unsigned char* ws; int ph_lo, ph_hi; };
constexpr int NPHASE = 17;
__global__ void __launch_bounds__(NTHR, 2) fwd_kernel(Args args) {
    extern __shared__ __attribute__((aligned(16))) unsigned char lds[];
    Frame F;
    F.lds = (LAS unsigned char*)lds;
    F.MISC = (volatile LAS unsigned*)(F.lds + MISC_OFF);
    F.tid = threadIdx.x; F.lane = F.tid & 63; F.wave = __builtin_amdgcn_readfirstlane(F.tid >> 6);
    F.G = gridDim.x; { const int bx = blockIdx.x; F.vcu = (F.G % 8 == 0) ? (bx % 8) * (F.G / 8) + bx / 8 : bx; }
    F.ws = args.ws; F.out = args.out; F.ctl = (gu32*)(args.ws + WS_CTL);
    for (int u = F.tid; u < 256; u += NTHR) ((LAS unsigned*)(F.lds + MISC_OFF))[u] = 0u;
    F.inp = (const LAS unsigned long long*)(F.lds + MISC_OFF + 640);
    __syncthreads();
#pragma unroll
    for (int i = 0; i < 29; ++i) if (F.tid == i) ((LAS unsigned long long*)(F.lds + MISC_OFF + 640))[i] = (unsigned long long)args.in[i];
    __syncthreads();
    const int lo = args.ph_lo, hi = args.ph_hi;
    const bool multi = (hi - lo) > 1;
    XcdBarrier bar; bar.bar = (unsigned*)(F.ctl + CW_BAR); bar.x = 0; bar.st = nullptr;
    if (multi) bar = xcd_barrier_post((unsigned*)(F.ctl + CW_BAR), F.MISC + 8);
#ifndef PHASE_MASK
#define PHASE_MASK 0x7ff
#endif
#define IN(k) (lo <= (k) && (k) < hi)
#define ON(j) ((PHASE_MASK >> (j)) & 1)
#ifndef DUP_MASK
#define DUP_MASK 0
#endif
#define REP(j) for (int _rep = 0; _rep < (((DUP_MASK >> (j)) & 1) ? 2 : 1); ++_rep)
#define LAUNDER() do { int _l; asm volatile("v_mbcnt_lo_u32_b32 %0, -1, 0\n\tv_mbcnt_hi_u32_b32 %0, -1, %0" : "=v"(_l)); F.lane = _l; F.tid = F.wave * 64 + _l; { unsigned char* _w = F.ws; asm volatile("" : "+s"(_w)); F.ws = _w; } } while (0)
#ifndef PROBE_K
#define PROBE_K -1
#endif
#ifndef PROBE_PART
#define PROBE_PART 0
#endif
#ifndef PROBE_AMP
#define PROBE_AMP 8
#endif
    volatile LAS unsigned long long* pr = (volatile LAS unsigned long long*)(F.lds + MISC_OFF + 512);
#ifndef PROBE_BLK
#define PROBE_BLK 0
#endif
#define PR_ME (blockIdx.x == PROBE_BLK && threadIdx.x == 0)
#define PSTART(j) do { if (PROBE_K == (j) && PROBE_PART != 1 && PR_ME) pr[0] = __builtin_amdgcn_s_memrealtime(); } while (0)
#define PEND(j) do { if (PROBE_K == (j) && PR_ME) { const unsigned long long _n = __builtin_amdgcn_s_memrealtime(); if (PROBE_PART == 0 || (PROBE_PART == 2 && (j) == 8)) pr[1] += _n - pr[0]; else if (PROBE_PART == 1) pr[0] = _n; } } while (0)
#define PBAR(j) do { if (PROBE_K == (j) && PROBE_PART >= 1 && PR_ME) pr[1] += __builtin_amdgcn_s_memrealtime() - pr[0]; } while (0)
#define SEAM(k) do { if (IN(k) && IN((k) + 1)) xcd_barrier(bar); } while (0)
    const int gw = F.vcu * NWAVES + F.wave, NGW = F.G * NWAVES;
    for (int l = 0; l < DEPTH; ++l) {
        const int p0 = l * 8;
        if (ON(0) && IN(p0 + 0)) { LAUNDER(); PSTART(0);
            PSTART(10); if (l == 0) pa_convert_features(F); PEND(10);
            PSTART(11); if (l == 0) { for (int ll = 0; ll < DEPTH; ++ll) pa_router_t(F, ll); } PEND(11);
            PSTART(13);
            const float* g = inp(F, I_GMIX) + (size_t)l * DM;
            if (l == 0) { for (int m = gw; m < SEQ; m += 4 * NGW) norm_rows<0, false, 4>(F, m, NGW, inp(F, I_X), g, nullptr, nullptr); }
            else { for (int m = gw; m < SEQ; m += 2 * NGW) norm_rows<1, false, 2>(F, m, NGW, nullptr, g, F.ctl + CW_CNT + 64 * 16 * (l - 1), nullptr); }
            PEND(13);
        }
        PEND(0); SEAM(p0 + 0); PBAR(0);
        if (ON(1) && IN(p0 + 1)) { LAUNDER(); PSTART(1);
            InProjSched S{(const char*)(F.ws + WS_XN), (const char*)(F.ws + ((l & 1) ? WS_WIN2 : WS_WIN)), F.G, (int)blockIdx.x};
            EpiInProj E{(bf16*)(F.ws + WS_ZT), (bf16*)(F.ws + WS_U), inp(F, I_BIN) + (size_t)l * NIN, F.ctl + CW_ZT + 64 * 16 * l, F.ctl + CW_UG + 64 * 32 * l};
            REP(1) pg8::gemm_phase<EpiInProj, InProjSched>(F.lds, DM, S, E, F.tid);
            LAUNDER();
            GateSched8 S8{(const char*)(F.ws + WS_XN8), (const char*)(F.ws + WS_WIN8 + (size_t)(l & 1) * 8 * MiB), F.G, (int)blockIdx.x};
            EpiGate8 E8{(unsigned char*)(F.ws + WS_GH), (unsigned char*)(F.ws + WS_GS), inp(F, I_BIN) + (size_t)l * NIN};
            REP(1) pg8::gemm_phase<EpiGate8, GateSched8>(F.lds, DM / 2, S8, E8, F.tid);
        }
        PEND(1); PBAR(1);
        if (ON(2) && IN(p0 + 2)) { LAUNDER(); PSTART(2);
            if (ON(9)) {
                volatile LAS int* qs = (volatile LAS int*)(F.lds + MISC_OFF + 96);
                for (;;) { __syncthreads();
                    if (F.tid == 0) qs[0] = (int)__hip_atomic_fetch_add(F.ctl + CW_SGUQ + 64 * l, 1u, RLX_AGENT);
                    __syncthreads();
                    const int u = __builtin_amdgcn_readfirstlane(qs[0]); if (u >= 256) break;
                    sgu_pair(F, l, u >> 2, u & 3); } }
            if (ON(10)) REP(10) for (int b = F.vcu; b < 256; b += F.G) hyena_block(F, l, b);
        }
        PEND(2); SEAM(p0 + 2); PBAR(2);
        if (ON(3) && IN(p0 + 3)) { LAUNDER(); PSTART(3);
            GridSched S{(const char*)(F.ws + WS_Y), (const char*)(F.ws + WS_PT), 32, 8, DM, F.G, (int)blockIdx.x};
            EpiMerge E{(const unsigned char*)(F.ws + WS_GH), (const unsigned char*)(F.ws + WS_GS), (bf16*)(F.ws + WS_MERGED), F.ctl + CW_MG + 64 * 32 * l};
            REP(3) pg8::gemm_phase<EpiMerge, GridSched>(F.lds, DM, S, E, F.tid);
        }
        PEND(3); PBAR(3);
        if (ON(4) && IN(p0 + 4)) { LAUNDER(); PSTART(4);
            GridSchedW S; S.A = (const char*)(F.ws + WS_MERGED); S.Bt = (const char*)(F.ws + WS_WOT); S.nM = 32; S.nN = 8; S.K = DM; S.G = F.G; S.c = (int)blockIdx.x;
            S.pcnt = F.ctl + CW_MG + 64 * 32 * l; S.need = 64u; S.tmo = F.ctl + CW_TMO;
            EpiResid E{l == 0 ? inp(F, I_X) : nullptr, (const bf16*)(F.ws + WS_XR), (bf16*)(F.ws + WS_XR), F.ctl + CW_XR + 64 * 32 * l};
            REP(4) pg8::gemm_phase<EpiResid, GridSchedW>(F.lds, DM, S, E, F.tid);
        }
        PEND(4); PBAR(4);
        if (ON(5) && IN(p0 + 5)) { LAUNDER(); PSTART(5); for (int tb = F.vcu * 32; tb < SEQ; tb += F.G * 32) route_block(F, l, tb); }
        PEND(5); SEAM(p0 + 5); PBAR(5);
        if (ON(6) && IN(p0 + 6)) { LAUNDER(); PSTART(6);
            moe_tables(F, l);
            gu32* pc = F.ctl + CW_PANEL + 64 * 128 * l;
            {
                MoeSched1 S{(const LAS int*)(F.lds + MISC_OFF + 128), (const char*)(F.ws + WS_XN), (const char*)(F.ws + WS_WGU), (const int*)(F.ws + WS_LISTS), F.G, F.vcu};
                EpiMoe1 E{(bf16*)(F.ws + WS_ACT), (const float*)(F.ws + WS_LISTS + 512 * 1024), (const float*)(F.ws + WS_LISTS + 1 * MiB + 512 * 1024), pc};
                pg8::gemm_phase<EpiMoe1, MoeSched1>(F.lds, DM / 2, S, E, F.tid);
            }
            {
                LAUNDER();
                const int ng = __builtin_amdgcn_readfirstlane(((const LAS int*)(F.lds + MISC_OFF + 128))[16]) * 4;
                int n2 = ng - F.G; n2 = n2 < 0 ? 0 : n2; if (n2 >= F.G) n2 = 0;
                MoeSched2 S{(const LAS int*)(F.lds + MISC_OFF + 128), (const char*)(F.ws + WS_ACT), (const char*)(F.ws + WS_WD), F.G - n2, F.vcu - n2, pc, F.ctl + CW_TMO};
                EpiMoe2 E{(bf16*)(F.ws + WS_MOEOUT)};
                pg8::gemm_phase<EpiMoe2, MoeSched2>(F.lds, DEXP / 2, S, E, F.tid);
            }
        }
        PEND(6); SEAM(p0 + 6); PBAR(6);
    }
    if (ON(8) && IN(16)) { LAUNDER(); PSTART(8); for (int m = gw; m < SEQ; m += 2 * NGW) norm_rows<1, true, 2>(F, m, NGW, nullptr, inp(F, I_GFINAL), F.ctl + CW_CNT + 64 * 16 * (DEPTH - 1), F.out); }
    PEND(8);
    if (PROBE_K >= 0 && PR_ME) { const unsigned long long t0 = __builtin_amdgcn_s_memrealtime(), amt = pr[1] * PROBE_AMP; while (__builtin_amdgcn_s_memrealtime() - t0 < amt) __builtin_amdgcn_s_sleep(8); }
#undef IN
#undef SEAM
}

#ifndef MK_ONE_LAUNCH
#define MK_ONE_LAUNCH 0
#endif
extern "C" void kernel_launch(void* const* d_in, const int* in_sizes, int n_in, void* d_out, int out_size, void* d_ws, size_t ws_size, hipStream_t stream) {
    static int grid = 0;
    if (grid == 0) {
        if (n_in != 29 || ws_size < WS_END) { fprintf(stderr, "kernel_launch: unexpected n_in %d or ws %zu < %zu\n", n_in, ws_size, (size_t)WS_END); grid = -1; return; }
        int dev = 0, cus = 0, per_cu = 0;
        if (hipGetDevice(&dev) != hipSuccess || hipDeviceGetAttribute(&cus, hipDeviceAttributeMultiprocessorCount, dev) != hipSuccess) { grid = -1; return; }
        if (hipFuncSetAttribute((const void*)fwd_kernel, hipFuncAttributeMaxDynamicSharedMemorySize, LDS_BYTES) != hipSuccess) { fprintf(stderr, "kernel_launch: hipFuncSetAttribute failed\n"); grid = -1; return; }
        if (hipOccupancyMaxActiveBlocksPerMultiprocessor(&per_cu, (const void*)fwd_kernel, NTHR, LDS_BYTES) != hipSuccess || per_cu < 1) fprintf(stderr, "kernel_launch: occupancy query reports %d\n", per_cu);
        (void)hipGetLastError();
        grid = cus;
    }
    if (grid < 0) return;
    (void)hipMemsetAsync((char*)d_ws + WS_CTL, 0, CTL_ZERO_BYTES, stream);
    Args a{};
    for (int i = 0; i < 29; ++i) a.in[i] = (const float*)d_in[i];
    a.out = (float*)d_out; a.ws = (unsigned char*)d_ws;
#if MK_ONE_LAUNCH
    a.ph_lo = 0; a.ph_hi = NPHASE;
    hipLaunchKernelGGL(fwd_kernel, dim3(grid), dim3(NTHR), LDS_BYTES, stream, a);
#else
    for (int p = 0; p < NPHASE; ++p) { a.ph_lo = p; a.ph_hi = p + 1; hipLaunchKernelGGL(fwd_kernel, dim3(grid), dim3(NTHR), LDS_BYTES, stream, a); }
#endif
}
```

```cpp
#include <hip/hip_runtime.h>
#include <cstdio>
#include <cstdint>
#define MK_ONE_LAUNCH 1
#define DUP_MASK 0
#define PROBE_K -1
#define PROBE_PART 0
#define PROBE_BLK 0
namespace pg8 {
#define PG8_LAS __attribute__((address_space(3)))
typedef unsigned short bf16_t;
typedef short bf16x8 __attribute__((ext_vector_type(8)));
typedef float f32x4 __attribute__((ext_vector_type(4)));
typedef float f32x2 __attribute__((ext_vector_type(2)));
typedef unsigned u32x4 __attribute__((ext_vector_type(4)));
typedef unsigned u32x2 __attribute__((ext_vector_type(2)));
typedef int v4i __attribute__((ext_vector_type(4)));
typedef int v8i __attribute__((ext_vector_type(8)));
typedef int v32i __attribute__((ext_vector_type(32)));
constexpr int BM = 256, BK = 64, HALF = 128, HTB = HALF * BK * 2  , STAGE_BYTES = 8 * HTB;
constexpr int GATHER_SLOT_OFF = 2 * 8448 * 8 + 1024;

__host__ __device__ __forceinline__ int lds_byte(int r, int c) { const int st = (r >> 4) * 2 + (c >> 5), rr = r & 15, cc = c & 31, ob = rr * 64 + cc * 2; return st * 1024 + (ob ^ (((ob >> 9) & 1) << 5)); }
__host__ __device__ __forceinline__ void stage_rc(int b, int& R, int& C) { const int st = b / 1024, sb = b % 1024, swz = sb ^ (((sb >> 9) & 1) << 5); R = (st >> 1) * 16 + swz / 64; C = (st & 1) * 32 + (swz % 64) / 2; }
__host__ __device__ __forceinline__ int perm32(int rho) { const int n = rho >> 4, i = rho & 15; return 8 * (i >> 2) + 4 * n + (i & 3); }

struct Unit { int pm, pn, kind, e, row0, nvalid, rt, half; };

__device__ __forceinline__ unsigned cvt_pk_bf16(float lo, float hi) { unsigned r; asm volatile("v_cvt_pk_bf16_f32 %0, %1, %2" : "=v"(r) : "v"(lo), "v"(hi)); return r; }
__device__ __forceinline__ f32x2 gelu_pk(f32x2 v) {
    const f32x2 av = __builtin_elementwise_abs(v), d = av * 0.2316418882f + 1.0f;
    f32x2 t; t.x = __builtin_amdgcn_rcpf(d.x); t.y = __builtin_amdgcn_rcpf(d.y);
    f32x2 q = t * 0.5307027145f + (-0.7265760135f); q = q * t + 0.7107068705f; q = q * t + (-0.142248368f); q = q * t + 0.127414796f; q = q * t;
    const f32x2 s = (v * v) * (-0.72134752044f);
    f32x2 e; e.x = __builtin_amdgcn_exp2f(s.x); e.y = __builtin_amdgcn_exp2f(s.y);
    const f32x2 m = v * (q * e), r = v - m;
    f32x2 o; o.x = v.x < 0.f ? m.x : r.x; o.y = v.y < 0.f ? m.y : r.y; return o;
}
__device__ __forceinline__ float sigmoid_f(float x) { return __builtin_amdgcn_rcpf(1.0f + __builtin_amdgcn_exp2f(-1.4426950408889634f * x)); }

__device__ __forceinline__ int fresh_tid(int wid) { int l; asm volatile("v_mbcnt_lo_u32_b32 %0, -1, 0\n\tv_mbcnt_hi_u32_b32 %0, -1, %0" : "=v"(l)); return wid * 64 + l; }
__device__ __forceinline__ const char* uni_ptr(const char* p) { const unsigned long long v = (unsigned long long)p; const unsigned lo = __builtin_amdgcn_readfirstlane((unsigned)v), hi = __builtin_amdgcn_readfirstlane((unsigned)(v >> 32)); return (const char*)(((unsigned long long)hi << 32) | lo); }
template <class Epi, class Sched>
__device__ __forceinline__ void gemm_phase(PG8_LAS unsigned char* lds, const int K, const Sched& S, const Epi& E, int tid) {
    asm volatile("" : "+v"(tid));
    const int wid = __builtin_amdgcn_readfirstlane(tid >> 6), lane = tid & 63, wr = wid >> 2, wc = wid & 3, fr = lane & 15, fq = lane >> 4;
    const int nt = K / BK;
    unsigned voffA[2], voffB[2];
#pragma unroll
    for (int i = 0; i < 2; ++i) { int R, C; stage_rc(tid * 16 + i * 8192, R, C); const int Rb = Epi::PERM ? ((R & ~31) + perm32(R & 31)) : R;
        voffA[i] = Sched::GATHER ? 0u : (unsigned)(R * K + C) * 2u; voffB[i] = (unsigned)(Rb * K + C) * 2u; }
#define PG8_GOFF(u, h, i) ({ int _R, _C, _t = fresh_tid(wid); stage_rc(_t * 16 + (i) * 8192, _R, _C); S.a_goff((u), (h) * HALF + _R) + (unsigned)(_C * 2); })
    const size_t kstep = (size_t)(BK * 2);
    const size_t hstep = (size_t)HALF * K * 2;
    const unsigned ldsw = (unsigned)wid * 1024u;
    const int aoff = lds_byte(wr * 64 + fr, fq * 8);
    int boff = lds_byte(wc * 32 + fr, fq * 8) + 4 * HTB; asm volatile("" : "+v"(boff));
#define PG8_SA(b, h) (((b) * 2 + (h)) * HTB)
#define PG8_SB(b, h) ((4 + (b) * 2 + (h)) * HTB)
#define PG8_STAGE(bufoff, gbase, voff) do { _Pragma("unroll") for (int _i = 0; _i < 2; ++_i) { unsigned _v = (voff)[_i]; asm volatile("" : "+v"(_v)); \
        __builtin_amdgcn_global_load_lds((const unsigned*)((const char*)(gbase) + _v), (PG8_LAS unsigned*)(lds + (bufoff) + ldsw + _i * 8192), 16, 0, 0); } } while (0)
#define PG8_STAGE_A(bufoff, gbase, h, GO) do { if constexpr (Sched::GATHER) { _Pragma("unroll") for (int _i = 0; _i < 2; ++_i) { unsigned _v = (GO)[h][_i]; asm volatile("" : "+v"(_v)); \
        __builtin_amdgcn_global_load_lds((const unsigned*)((const char*)(gbase) + _v), (PG8_LAS unsigned*)(lds + (bufoff) + ldsw + _i * 8192), 16, 0, 0); } } \
        else { PG8_STAGE(bufoff, (gbase) + (h) * hstep, voffA); } } while (0)
#define PG8_LD16(off) (*(const PG8_LAS v4i*)(lds + (off)))
#define PG8_INS4(V, pos, val) do { const v4i _q = (val); (V)[(pos)] = _q[0]; (V)[(pos) + 1] = _q[1]; (V)[(pos) + 2] = _q[2]; (V)[(pos) + 3] = _q[3]; } while (0)
#define PG8_LDA(dst, b, h) do { if constexpr (Epi::FP8) { _Pragma("unroll") for (int m = 0; m < 4; ++m) { PG8_INS4(At8, 8 * m, PG8_LD16(PG8_SA(b, h) + aoff + m * 2048)); PG8_INS4(At8, 8 * m + 4, PG8_LD16(PG8_SA(b, h) + aoff + m * 2048 + 1024)); } } \
        else { _Pragma("unroll") for (int m = 0; m < 4; ++m) _Pragma("unroll") for (int k = 0; k < 2; ++k) dst[m][k] = *(const PG8_LAS bf16x8*)(lds + PG8_SA(b, h) + aoff + m * 2048 + k * 1024); } } while (0)
#define PG8_LDB(dst, b, h) do { if constexpr (Epi::FP8) { _Pragma("unroll") for (int n = 0; n < 2; ++n) { PG8_INS4(Bq8, 16 * (h) + 8 * n, PG8_LD16(PG8_SB(b, h) - 4 * HTB + boff + n * 2048)); PG8_INS4(Bq8, 16 * (h) + 8 * n + 4, PG8_LD16(PG8_SB(b, h) - 4 * HTB + boff + n * 2048 + 1024)); } } \
        else { _Pragma("unroll") for (int n = 0; n < 2; ++n) _Pragma("unroll") for (int k = 0; k < 2; ++k) dst[n][k] = *(const PG8_LAS bf16x8*)(lds + boff + (PG8_SB(b, h) - 4 * HTB + n * 2048 + k * 1024)); } } while (0)
#define PG8_SUB8(V, p) (v8i{(V)[(p)], (V)[(p) + 1], (V)[(p) + 2], (V)[(p) + 3], (V)[(p) + 4], (V)[(p) + 5], (V)[(p) + 6], (V)[(p) + 7]})
#define PG8_MMA(ai, bj, At, Bt) do { __builtin_amdgcn_s_setprio(1); _Pragma("unroll") for (int m = 0; m < 4; ++m) _Pragma("unroll") for (int n = 0; n < 2; ++n) { \
        if constexpr (Epi::FP8) { acc[ai][bj][m][n] = __builtin_amdgcn_mfma_scale_f32_16x16x128_f8f6f4(PG8_SUB8(Bq8, 16 * (bj) + 8 * n), PG8_SUB8(At8, 8 * m), acc[ai][bj][m][n], 0, 0, 0, 0, 0, 0); } \
        else { _Pragma("unroll") for (int k = 0; k < 2; ++k) acc[ai][bj][m][n] = __builtin_amdgcn_mfma_f32_16x16x32_bf16(Bt[n][k], At[m][k], acc[ai][bj][m][n], 0, 0, 0); } } \
        __builtin_amdgcn_s_setprio(0); } while (0)
#define PG8_WAIT_V(n) asm volatile("s_waitcnt vmcnt(" #n ")" ::: "memory")
#define PG8_WAIT_L(n) asm volatile("s_waitcnt lgkmcnt(" #n ")" ::: "memory")
#define PG8_BAR __builtin_amdgcn_s_barrier()
#define PG8_SCHED __builtin_amdgcn_sched_barrier(0)
    Unit cur, nxt; int ui = 0;
    if (!S.next(0, cur)) return;
    f32x4 acc[2][2][4][2];
#pragma unroll
    for (int a = 0; a < 2; ++a)
#pragma unroll
        for (int b = 0; b < 2; ++b)
#pragma unroll
            for (int m = 0; m < 4; ++m)
#pragma unroll
                for (int n = 0; n < 2; ++n) acc[a][b][m][n] = (f32x4){0.f, 0.f, 0.f, 0.f};
    bf16x8 At[4][2], B0[2][2], B1[2][2];
    v32i At8, Bq8;
    const char* cA = uni_ptr(S.a_base(cur)); const char* cB = uni_ptr(S.b_base(cur));
    if constexpr (Sched::WAIT) S.a_ready(cur, wid);
    unsigned cgo[2][2];
#define PG8_GSLOT ((PG8_LAS u32x4*)(lds + GATHER_SLOT_OFF) + fresh_tid(wid))
    if constexpr (Sched::GATHER) {
#pragma unroll
        for (int h = 0; h < 2; ++h)
#pragma unroll
            for (int i = 0; i < 2; ++i) cgo[h][i] = PG8_GOFF(cur, h, i);
    }
    PG8_STAGE(PG8_SB(0, 0), cB, voffB); PG8_STAGE(PG8_SB(0, 1), cB + hstep, voffB); PG8_STAGE_A(PG8_SA(0, 0), cA, 0, cgo); PG8_STAGE_A(PG8_SA(0, 1), cA, 1, cgo);
    if (wr == 1) PG8_BAR;
    PG8_WAIT_V(2); PG8_BAR;
    PG8_STAGE(PG8_SB(1, 0), cB + kstep, voffB); PG8_STAGE_A(PG8_SA(1, 0), cA + kstep, 0, cgo); PG8_STAGE(PG8_SB(1, 1), cB + hstep + kstep, voffB);
    PG8_WAIT_V(6); PG8_BAR;
    for (;;) {
        const bool has_next = S.next(ui + 1, nxt);
        const char* nA = uni_ptr(has_next ? S.a_base(nxt) : cA); const char* nB = uni_ptr(has_next ? S.b_base(nxt) : cB);
        if constexpr (Sched::GATHER) {
            u32x4 nx = (u32x4){cgo[0][0], cgo[0][1], cgo[1][0], cgo[1][1]};
            if (has_next) { nx.x = PG8_GOFF(nxt, 0, 0); nx.y = PG8_GOFF(nxt, 0, 1); nx.z = PG8_GOFF(nxt, 1, 0); nx.w = PG8_GOFF(nxt, 1, 1); }
            *PG8_GSLOT = nx;
        }
#pragma nounroll
        for (int t = 0; t < nt; t += 2) {
            const bool last = (t == nt - 2);
            if constexpr (Sched::WAIT) { if (last && has_next) S.a_ready(nxt, wid); }
            if constexpr (Epi::MIDK) { if (t == (nt >> 1)) { const int tl = fresh_tid(wid); E.mid(acc, cur, wr, wc, tl & 15, (tl >> 4) & 3); } }
            const char* a1 = cA + (size_t)(t + 1) * kstep;
            const char* a2 = last ? nA : cA + (size_t)(t + 2) * kstep; const char* b2 = last ? nB : cB + (size_t)(t + 2) * kstep;
            const char* a3 = a2 + kstep; const char* b3 = b2 + kstep;
            unsigned xgo[2][2];
            if constexpr (Sched::GATHER) {
                if (last) { const u32x4 nx = *PG8_GSLOT; xgo[0][0] = nx.x; xgo[0][1] = nx.y; xgo[1][0] = nx.z; xgo[1][1] = nx.w; }
                else { xgo[0][0] = cgo[0][0]; xgo[0][1] = cgo[0][1]; xgo[1][0] = cgo[1][0]; xgo[1][1] = cgo[1][1]; }
            }
            PG8_LDB(B0, 0, 0); PG8_LDB(B1, 0, 1); PG8_SCHED; PG8_LDA(At, 0, 0); PG8_STAGE_A(PG8_SA(1, 1), a1, 1, cgo);
            PG8_WAIT_V(8); PG8_WAIT_L(0); PG8_BAR; PG8_MMA(0, 0, At, B0); PG8_MMA(0, 1, At, B1); PG8_BAR; PG8_SCHED;
            PG8_LDA(At, 0, 1); PG8_STAGE(PG8_SB(0, 0), b2, voffB); PG8_STAGE(PG8_SB(0, 1), b2 + hstep, voffB); PG8_STAGE_A(PG8_SA(0, 0), a2, 0, xgo);
            PG8_WAIT_V(8); PG8_WAIT_L(0); PG8_BAR; if (!Sched::HALF || !cur.half) { PG8_MMA(1, 0, At, B0); PG8_MMA(1, 1, At, B1); } PG8_BAR; PG8_SCHED;
            PG8_LDB(B0, 1, 0); PG8_LDB(B1, 1, 1); PG8_SCHED; PG8_LDA(At, 1, 0); PG8_STAGE_A(PG8_SA(0, 1), a2, 1, xgo);
            PG8_WAIT_V(8); PG8_WAIT_L(0); PG8_BAR; PG8_MMA(0, 0, At, B0); PG8_MMA(0, 1, At, B1); PG8_BAR; PG8_SCHED;
            PG8_LDA(At, 1, 1); PG8_STAGE(PG8_SB(1, 0), b3, voffB); PG8_STAGE(PG8_SB(1, 1), b3 + hstep, voffB); PG8_STAGE_A(PG8_SA(1, 0), a3, 0, xgo);
            PG8_WAIT_V(8); PG8_WAIT_L(0); PG8_BAR; if (!Sched::HALF || !cur.half) { PG8_MMA(1, 0, At, B0); PG8_MMA(1, 1, At, B1); } PG8_BAR; PG8_SCHED;
        }
        if (wr == 0) PG8_BAR;
        { const int tl = fresh_tid(wid); E(acc, cur, wr, wc, tl & 15, (tl >> 4) & 3); }
        if (!has_next) break;
#pragma unroll
        for (int a = 0; a < 2; ++a)
#pragma unroll
            for (int b = 0; b < 2; ++b)
#pragma unroll
                for (int m = 0; m < 4; ++m)
#pragma unroll
                    for (int n = 0; n < 2; ++n) acc[a][b][m][n] = (f32x4){0.f, 0.f, 0.f, 0.f};
        cur = nxt; cA = nA; cB = nB; ++ui;
        if constexpr (Sched::GATHER) { const u32x4 nx = *PG8_GSLOT; cgo[0][0] = nx.x; cgo[0][1] = nx.y; cgo[1][0] = nx.z; cgo[1][1] = nx.w; }
        if (wr == 1) PG8_BAR;
    }
    PG8_WAIT_V(0);
    PG8_BAR;
#undef PG8_SA
#undef PG8_SB
#undef PG8_STAGE
#undef PG8_STAGE_A
#undef PG8_GOFF
#undef PG8_GSLOT
#undef PG8_LDA
#undef PG8_LDB
#undef PG8_MMA
#undef PG8_WAIT_V
#undef PG8_WAIT_L
#undef PG8_BAR
#undef PG8_SCHED
}
}
constexpr int NWAVES = 8, NTHR = 512;
constexpr int SEQ = 8192, DM = 2048, NIN = 9216, HYW = 1024, SGW = 1024, NHY = 3072, NEXP = 16, DEXP = 512, DEPTH = 2;
constexpr float EPS = 1e-6f;
constexpr size_t MiB = 1u << 20;
constexpr size_t WS_CTL = 0, CTL_ZERO_BYTES = 1 * MiB;
constexpr size_t WS_WIN = 1 * MiB;
constexpr size_t WS_WIN2 = WS_WIN + 36 * MiB;
constexpr size_t WS_PT = WS_WIN2 + 36 * MiB;
constexpr size_t WS_WOT = WS_PT + 8 * MiB;
constexpr size_t WS_WGU = WS_WOT + 8 * MiB;
constexpr size_t WS_WD = WS_WGU + 64 * MiB;
constexpr size_t WS_W3T = WS_WD + 32 * MiB;
constexpr size_t WS_A2 = WS_W3T + 1 * MiB;
constexpr size_t WS_WR = WS_A2 + 2 * MiB;
constexpr size_t WS_LISTS = WS_WR + 1 * MiB;
constexpr size_t WS_XR = WS_LISTS + 2 * MiB;
constexpr size_t WS_XN = WS_XR + 64 * MiB;
constexpr size_t WS_ZT = WS_XN + 32 * MiB;
constexpr size_t WS_U = WS_ZT + 48 * MiB;
constexpr size_t WS_GV = WS_U + 16 * MiB;
constexpr size_t WS_GH = WS_GV + 16 * MiB;
constexpr size_t WS_GS = WS_GH + 32 * MiB;
constexpr size_t WS_Y = WS_GS + 32 * MiB;
constexpr size_t WS_FS = WS_Y + 32 * MiB;
constexpr size_t WS_END = WS_FS + 64 * MiB;
constexpr size_t WS_MERGED = WS_ZT, WS_ACT = WS_U, WS_MOEOUT = WS_FS;
constexpr size_t WS_XN8 = WS_END;
constexpr size_t WS_WIN8 = WS_XN8 + 16 * MiB;
constexpr int CW_TMO = 0;
constexpr int CW_CNT = 8192;
constexpr int CW_BAR = 4096;
constexpr int CW_ZT = 32768;
constexpr int CW_UG = 36864;
constexpr int CW_MG = 49152;
constexpr int CW_XR = 53248;
constexpr int CW_SGUQ = 45056;
constexpr int CW_PANEL = 16384;
constexpr int SCRATCH_BYTES = 2 * 8448 * 8;
constexpr int MISC_OFF = SCRATCH_BYTES;
constexpr int CVS_OFF = MISC_OFF + 1024;
constexpr int LDS_BYTES = SCRATCH_BYTES + 1024 + 8 * 2304;
static_assert(pg8::GATHER_SLOT_OFF == MISC_OFF + 1024, "gather slots");
static_assert(SCRATCH_BYTES >= pg8::STAGE_BYTES, "lds");

#define GAS __attribute__((address_space(1)))
#define LAS __attribute__((address_space(3)))
typedef unsigned short bf16;
typedef unsigned v4u __attribute__((ext_vector_type(4)));
typedef unsigned v2u __attribute__((ext_vector_type(2)));
typedef float f32x4 __attribute__((ext_vector_type(4)));
typedef short bf16x8 __attribute__((ext_vector_type(8)));
typedef GAS unsigned gu32;
#define RLX_AGENT __ATOMIC_RELAXED, __HIP_MEMORY_SCOPE_AGENT
#define LDS_WAIT() asm volatile("s_waitcnt lgkmcnt(0)" ::: "memory")
#define VM_WAIT() asm volatile("s_waitcnt vmcnt(0)" ::: "memory")
__device__ __forceinline__ unsigned f2bf(float f) { unsigned u = __builtin_bit_cast(unsigned, f); return (u + 0x7fffu + ((u >> 16) & 1u)) >> 16; }
__device__ __forceinline__ unsigned pk2(float lo, float hi) { return f2bf(lo) | (f2bf(hi) << 16); }
__device__ __forceinline__ unsigned pk2h(float lo, float hi) { unsigned r; asm("v_cvt_pk_bf16_f32 %0, %1, %2" : "=v"(r) : "v"(lo), "v"(hi)); return r; }
__device__ __forceinline__ float bfl(unsigned u) { return __builtin_bit_cast(float, u << 16); }
__device__ __forceinline__ float bfh(unsigned u) { return __builtin_bit_cast(float, u & 0xffff0000u); }

#define XB_TMO      128
#define XB_XCNT(j)  (256  + 64 * (j))
#define XB_XSUB(j)  (1280 + 64 * (j))
#define XB_XGEN(j)  (2304 + 64 * (j))
#define XB_TOP      3328
#define XB_TOPGEN   3392
#define XCD_BAR_WORDS 3456
#define XB_SPIN_CAP (1u << 18)
__device__ __forceinline__ unsigned xb_ld(unsigned* p)              { return __hip_atomic_load(p, __ATOMIC_RELAXED, __HIP_MEMORY_SCOPE_AGENT); }
__device__ __forceinline__ unsigned xb_add(unsigned* p, unsigned v) { return __hip_atomic_fetch_add(p, v, __ATOMIC_RELAXED, __HIP_MEMORY_SCOPE_AGENT); }
__device__ __forceinline__ unsigned xb_xcc_id() { return (unsigned)__builtin_amdgcn_s_getreg((3 << 11) | 20) & 0xFu; }
#define XB_SPIN(cond, bar) do { unsigned _sp = 0; while (cond) { __builtin_amdgcn_s_sleep(1); \
    if ((++_sp & 255u) == 0u) { if (xb_ld(&(bar)[XB_TMO])) break; if (_sp > XB_SPIN_CAP) { atomicAdd(&(bar)[XB_TMO], 1u); break; } } } } while (0)
struct XcdBarrier { unsigned* bar; unsigned x; volatile LAS unsigned* st; };
__device__ __forceinline__ XcdBarrier xcd_barrier_post(unsigned* bar, volatile LAS unsigned* st) {
    XcdBarrier b; b.bar = bar; b.x = xb_xcc_id(); b.st = st;
    if (threadIdx.x == 0) (void)xb_add(&bar[XB_XCNT(b.x)], 1u);
    return b;
}
__device__ __forceinline__ void xcd_barrier_complete(unsigned* bar, unsigned x, unsigned& nloc, unsigned& nx) {
    const unsigned G = gridDim.x * gridDim.y * gridDim.z;
    unsigned sum, cnt, mine, sp = 0u;
    for (;;) {
        sum = 0u; cnt = 0u; mine = 0u;
#pragma unroll
        for (unsigned j = 0; j < 16; ++j) { const unsigned c = xb_ld(&bar[XB_XCNT(j)]); sum += c; cnt += (c > 0u) ? 1u : 0u; mine = (j == x) ? c : mine; }
        if (sum == G) break;
        __builtin_amdgcn_s_sleep(1);
        if ((++sp & 255u) == 0u) { if (xb_ld(&bar[XB_TMO])) break; if (sp > XB_SPIN_CAP) { atomicAdd(&bar[XB_TMO], 1u); break; } }
    }
    nloc = mine > 0u ? mine : 1u; nx = cnt > 0u ? cnt : 1u;
}
__device__ __forceinline__ void xcd_barrier(const XcdBarrier& b) {
    asm volatile("s_waitcnt vmcnt(0)" ::: "memory");
    __syncthreads();
    if (threadIdx.x == 0) {
        unsigned* bar = b.bar;
        __builtin_amdgcn_s_waitcnt(0);
        unsigned nloc = b.st[0], nx = b.st[1];
        if (nloc == 0u) { xcd_barrier_complete(bar, b.x, nloc, nx); b.st[0] = nloc; b.st[1] = nx; }
        const unsigned old = xb_add(&bar[XB_XSUB(b.x)], 1u);
        const unsigned gen = old / nloc;
        if (old + 1u == (gen + 1u) * nloc) {
            __builtin_amdgcn_fence(__ATOMIC_RELEASE, "agent");
            asm volatile("s_waitcnt vmcnt(0)" ::: "memory");
            const unsigned og = xb_add(&bar[XB_TOP], 1u);
            const unsigned tg = og / nx;
            if (og + 1u == (tg + 1u) * nx) xb_add(&bar[XB_TOPGEN], 1u);
            else XB_SPIN(xb_ld(&bar[XB_TOPGEN]) == tg, bar);
            __builtin_amdgcn_fence(__ATOMIC_ACQUIRE, "agent");
            xb_add(&bar[XB_XGEN(b.x)], 1u);
            asm volatile("s_waitcnt vmcnt(0)" ::: "memory");
        } else {
            XB_SPIN(xb_ld(&bar[XB_XGEN(b.x)]) == gen, bar);
            __builtin_amdgcn_fence(__ATOMIC_ACQUIRE, "agent");
            asm volatile("s_waitcnt vmcnt(0)" ::: "memory");
        }
    }
    __syncthreads();
}

struct Frame {
    LAS unsigned char* lds;
    volatile LAS unsigned* MISC;
    gu32* ctl;
    int tid, lane, wave;
    int vcu, G;
    const LAS unsigned long long* inp;
    float* out;
    unsigned char* ws;
};
enum { I_X = 0, I_GMIX, I_WIN, I_BIN, I_CONVW, I_CONVB, I_FW1, I_FB1, I_FW2, I_FB2, I_FW3, I_FFREQ, I_SKIP, I_LNG, I_LNB, I_SGW, I_SGB, I_WHY, I_WSG, I_WOUT, I_GFFN, I_WRG, I_BRG, I_WRE, I_BRE, I_WGATE, I_WUP, I_WDOWN, I_GFINAL };

__device__ __forceinline__ const float* inp(const Frame& F, int k) { const unsigned long long v = F.inp[k]; const unsigned lo = __builtin_amdgcn_readfirstlane((unsigned)v), hi = __builtin_amdgcn_readfirstlane((unsigned)(v >> 32));
    return (const float*)(((unsigned long long)hi << 32) | (unsigned long long)lo); }
__device__ __forceinline__ void wait_ge(gu32* p, unsigned need, gu32* tmo) {
    unsigned polls = 0;
    while ((unsigned)__builtin_amdgcn_readfirstlane(__hip_atomic_load(p, RLX_AGENT)) < need) {
        if (++polls > (1u << 22)) { if ((threadIdx.x & 63) == 0) __hip_atomic_store(tmo, 1u, RLX_AGENT); break; }
        __builtin_amdgcn_s_sleep(2); }
}
__device__ __forceinline__ float shfl_xor_l(float v, int mask, int lane) { return __builtin_bit_cast(float, __builtin_amdgcn_ds_bpermute((lane ^ mask) << 2, __builtin_bit_cast(int, v))); }
__device__ __forceinline__ float shfl_down1_l(float v, int lane) { return __builtin_bit_cast(float, __builtin_amdgcn_ds_bpermute(((lane + 1) & 63) << 2, __builtin_bit_cast(int, v))); }
__device__ __forceinline__ float wave_sum(float v, int lane) {
#pragma unroll
    for (int o = 1; o < 64; o <<= 1) v += shfl_xor_l(v, o, lane);
    return v;
}

#ifndef PROBE_K
#define PROBE_K -1
#endif
#ifndef PROBE_BLK
#define PROBE_BLK 0
#endif
#define HP_ME (blockIdx.x == PROBE_BLK && threadIdx.x == 0)
#define HPS(j) do { if (PROBE_K == (j) && HP_ME) ((volatile LAS unsigned long long*)(F.lds + MISC_OFF + 512))[0] = __builtin_amdgcn_s_memrealtime(); } while (0)
#define HPE(j) do { if (PROBE_K == (j) && HP_ME) { volatile LAS unsigned long long* _p = (volatile LAS unsigned long long*)(F.lds + MISC_OFF + 512); _p[1] += __builtin_amdgcn_s_memrealtime() - _p[0]; } } while (0)
#define HD __device__ __forceinline__
#define HY_OPAQUE(x) asm volatile("" : "+v"(x))
#define HY_GLD(p, i) (((const GAS unsigned*)(p))[i])
typedef float hy_f2v __attribute__((ext_vector_type(2)));
#define LDC(p, i) ({ const hy_f2v _v = *(const LAS hy_f2v*)((p) + (i)); c32 _r; _r.x = _v.x; _r.y = _v.y; _r; })
#define STC(p, i, v) do { const c32 _s = (v); hy_f2v _w; _w.x = _s.x; _w.y = _s.y; *(LAS hy_f2v*)((p) + (i)) = _w; } while (0)
#define FADD(a, b) ({ float _r; asm("v_add_f32 %0, %1, %2" : "=v"(_r) : "v"((float)(a)), "v"((float)(b))); _r; })
#define FSUB(a, b) ({ float _r; asm("v_sub_f32 %0, %1, %2" : "=v"(_r) : "v"((float)(a)), "v"((float)(b))); _r; })
#define FMUL(a, b) ({ float _r; asm("v_mul_f32 %0, %1, %2" : "=v"(_r) : "v"((float)(a)), "v"((float)(b))); _r; })
#define FFMA(a, b, c) ({ float _r; asm("v_fma_f32 %0, %1, %2, %3" : "=v"(_r) : "v"((float)(a)), "v"((float)(b)), "v"((float)(c))); _r; })
#define FNMA(a, b, c) ({ float _r; asm("v_fma_f32 %0, -%1, %2, %3" : "=v"(_r) : "v"((float)(a)), "v"((float)(b)), "v"((float)(c))); _r; })
struct c32 { float x, y; };
HD c32 cmk(float x, float y) { c32 r; r.x = x; r.y = y; return r; }
HD c32 cadd(c32 a, c32 b) { return cmk(FADD(a.x, b.x), FADD(a.y, b.y)); }
HD c32 csub(c32 a, c32 b) { return cmk(FSUB(a.x, b.x), FSUB(a.y, b.y)); }
HD c32 cmul(c32 a, c32 b) { return cmk(FNMA(a.y, b.y, FMUL(a.x, b.x)), FFMA(a.y, b.x, FMUL(a.x, b.y))); }
HD c32 cmulc(c32 a, c32 b) { return cmk(FFMA(a.y, b.y, FMUL(a.x, b.x)), FNMA(a.x, b.y, FMUL(a.y, b.x))); }
HD c32 cscale(c32 a, float f) { return cmk(FMUL(a.x, f), FMUL(a.y, f)); }
HD c32 cadd_mi(c32 a, c32 b) { return cmk(FADD(a.x, b.y), FSUB(a.y, b.x)); }
HD c32 cadd_pi(c32 a, c32 b) { return cmk(FSUB(a.x, b.y), FADD(a.y, b.x)); }
#define HY_N 8192
#define HY_LDS_C32 (8192 + 256)

template <int SIGN> HD void dft4(c32& a, c32& b, c32& c, c32& d) {
    const c32 t0 = cadd(a, c), t1 = csub(a, c), t2 = cadd(b, d), t3 = csub(b, d);
    a = cadd(t0, t2); c = csub(t0, t2);
    if (SIGN < 0) { b = cadd_mi(t1, t3); d = cadd_pi(t1, t3); }
    else          { b = cadd_pi(t1, t3); d = cadd_mi(t1, t3); }
}
template <int SIGN> HD void dft16(c32 (&a)[16]) {
    const float C1 = 0.92387953251128674f, S1 = 0.38268343236508977f, R2 = 0.70710678118654752f;
#pragma unroll
    for (int n2 = 0; n2 < 4; ++n2) dft4<SIGN>(a[n2], a[4 + n2], a[8 + n2], a[12 + n2]);
    const float sg = (SIGN < 0) ? -1.f : 1.f;
    const c32 w1 = cmk(C1, sg * S1), w2 = cmk(R2, sg * R2), w3 = cmk(S1, sg * C1), w6 = cmk(-R2, sg * R2), w9 = cmk(-C1, -sg * S1);
    a[1 + 4] = cmul(a[1 + 4], w1); a[2 + 4] = cmul(a[2 + 4], w2); a[3 + 4] = cmul(a[3 + 4], w3);
    a[1 + 8] = cmul(a[1 + 8], w2); a[2 + 8] = (SIGN < 0) ? cmk(a[2 + 8].y, -a[2 + 8].x) : cmk(-a[2 + 8].y, a[2 + 8].x); a[3 + 8] = cmul(a[3 + 8], w6);
    a[1 + 12] = cmul(a[1 + 12], w3); a[2 + 12] = cmul(a[2 + 12], w6); a[3 + 12] = cmul(a[3 + 12], w9);
#pragma unroll
    for (int k1 = 0; k1 < 4; ++k1) dft4<SIGN>(a[4 * k1], a[4 * k1 + 1], a[4 * k1 + 2], a[4 * k1 + 3]);
    c32 t[16];
#pragma unroll
    for (int i = 0; i < 16; ++i) t[i] = a[i];
#pragma unroll
    for (int k1 = 0; k1 < 4; ++k1)
#pragma unroll
        for (int k2 = 0; k2 < 4; ++k2) a[k1 + 4 * k2] = t[4 * k1 + k2];
}
HD void twiddle_tree(c32 (&a)[16], c32 w1) {
    const c32 w2 = cmul(w1, w1), w3 = cmul(w2, w1), w4 = cmul(w2, w2), w5 = cmul(w4, w1), w6 = cmul(w4, w2), w7 = cmul(w4, w3), w8 = cmul(w4, w4);
    a[1] = cmul(a[1], w1); a[2] = cmul(a[2], w2); a[3] = cmul(a[3], w3); a[4] = cmul(a[4], w4); a[5] = cmul(a[5], w5); a[6] = cmul(a[6], w6); a[7] = cmul(a[7], w7); a[8] = cmul(a[8], w8);
    a[9] = cmul(a[9], cmul(w8, w1)); a[10] = cmul(a[10], cmul(w8, w2)); a[11] = cmul(a[11], cmul(w8, w3)); a[12] = cmul(a[12], cmul(w8, w4));
    a[13] = cmul(a[13], cmul(w8, w5)); a[14] = cmul(a[14], cmul(w8, w6)); a[15] = cmul(a[15], cmul(w8, w7));
}
HD c32 cis_pi(float x) { return cmk(cospif(x), sinpif(x)); }

HD void fft_s1_fwd(int tid, LAS c32* buf, c32 (&a)[16], c32 w1) { HY_OPAQUE(tid); HY_OPAQUE(w1.x); HY_OPAQUE(w1.y);
    dft16<-1>(a);
    twiddle_tree(a, w1);
    LAS c32* p0 = buf + tid + (tid >> 5);
#pragma unroll
    for (int p = 0; p < 16; ++p) STC(p0, 528 * p, a[p]);
}
HD void fft_s2_fwd(int tid, LAS c32* buf, c32 w2) { HY_OPAQUE(tid); HY_OPAQUE(w2.x); HY_OPAQUE(w2.y);
    LAS c32* p0 = buf + (tid >> 5) * 528 + (tid & 31);
    c32 a[16];
#pragma unroll
    for (int q = 0; q < 16; ++q) a[q] = LDC(p0, 33 * q);
    dft16<-1>(a);
    twiddle_tree(a, w2);
#pragma unroll
    for (int p = 0; p < 16; ++p) STC(p0, 33 * p, a[p]);
}
HD float w32c(int q) { switch (q) { case 0: return 1.0f; case 1: return 0.98078528040323043f; case 2: return 0.92387953251128674f; case 3: return 0.83146961230254524f; case 4: return 0.70710678118654752f; case 5: return 0.55557023301960218f; case 6: return 0.38268343236508977f; case 7: return 0.19509032201612825f;
    case 8: return 0.0f; case 9: return -0.19509032201612825f; case 10: return -0.38268343236508977f; case 11: return -0.55557023301960218f; case 12: return -0.70710678118654752f; case 13: return -0.83146961230254524f; case 14: return -0.92387953251128674f; default: return -0.98078528040323043f; } }
HD float w32s(int q) { switch (q) { case 0: return 0.0f; case 1: return 0.19509032201612825f; case 2: return 0.38268343236508977f; case 3: return 0.55557023301960218f; case 4: return 0.70710678118654752f; case 5: return 0.83146961230254524f; case 6: return 0.92387953251128674f; case 7: return 0.98078528040323043f;
    case 8: return 1.0f; case 9: return 0.98078528040323043f; case 10: return 0.92387953251128674f; case 11: return 0.83146961230254524f; case 12: return 0.70710678118654752f; case 13: return 0.55557023301960218f; case 14: return 0.38268343236508977f; default: return 0.19509032201612825f; } }
template <int SIGN> HD void fft_s3_read(int tid, const LAS c32* buf, c32 (&s)[16]) { HY_OPAQUE(tid);
    const LAS c32* p0 = buf + (tid >> 1) * 33; const int h = tid & 1;
    const float sg = (SIGN < 0) ? -1.f : 1.f, hs = h ? -1.f : 1.f;
#pragma unroll
    for (int q = 0; q < 16; ++q) {
        const c32 u = LDC(p0, q), v = LDC(p0, q + 16);
        const c32 d = cmk(FFMA(v.x, hs, u.x), FFMA(v.y, hs, u.y));
        const c32 w = h ? cmk(w32c(q), sg * w32s(q)) : cmk(1.f, 0.f);
        s[q] = (q == 0) ? d : cmul(d, w);
    }
    dft16<SIGN>(s);
}
HD void fft_s3_write(int tid, LAS c32* buf, const c32 (&s)[16]) { HY_OPAQUE(tid);
    LAS c32* p0 = buf + (tid >> 1) * 33 + (tid & 1);
#pragma unroll
    for (int p = 0; p < 16; ++p) STC(p0, 2 * p, s[p]);
}
HD void fft_s2_inv(int tid, LAS c32* buf, c32 w2) { HY_OPAQUE(tid); HY_OPAQUE(w2.x); HY_OPAQUE(w2.y);
    LAS c32* p0 = buf + (tid >> 5) * 528 + (tid & 31);
    c32 a[16];
#pragma unroll
    for (int q = 0; q < 16; ++q) a[q] = LDC(p0, 33 * q);
    twiddle_tree(a, cmk(w2.x, -w2.y));
    dft16<1>(a);
#pragma unroll
    for (int p = 0; p < 16; ++p) STC(p0, 33 * p, a[p]);
}
HD void fft_s1_inv(int tid, const LAS c32* buf, c32 (&a)[16], c32 w1) { HY_OPAQUE(tid); HY_OPAQUE(w1.x); HY_OPAQUE(w1.y);
    const LAS c32* p0 = buf + tid + (tid >> 5);
#pragma unroll
    for (int p = 0; p < 16; ++p) a[p] = LDC(p0, 528 * p);
    twiddle_tree(a, cmk(w1.x, -w1.y));
    dft16<1>(a);
}
HD void pair_pass(int tid, LAS c32* Z, const LAS c32* H, c32 wp3, c32 wlow) { HY_OPAQUE(tid); HY_OPAQUE(wp3.x); HY_OPAQUE(wp3.y); HY_OPAQUE(wlow.x); HY_OPAQUE(wlow.y);
    const int p3 = tid & 31;
    const c32 wstep = cmk(0.99998117528260111f, -0.0061358846491544753f);
#pragma unroll 1
    for (int it = 0; it < 9; ++it) {
        const int low = it * 16 + (tid >> 5);
        const c32 Wk = cmul(wlow, wp3);
        wlow = cmul(wlow, wstep);
        if (low > 128) continue;
        bool act = true; int p3b = 31 - p3, lowb = 256 - low;
        if (low == 0) { act = p3 <= 16; p3b = (32 - p3) & 31; lowb = 0; }
        else if (low == 128) { act = p3 <= 15; lowb = 128; }
        if (!act) continue;
        const int pa = (low & 15) * 528 + (low >> 4) * 33 + p3, pb = (lowb & 15) * 528 + (lowb >> 4) * 33 + p3b;
        const c32 A = LDC(Z, pa), B = LDC(Z, pb), HA = LDC(H, pa), HB = LDC(H, pb);
        c32 E = cmk(FMUL(FADD(A.x, B.x), 0.5f), FMUL(FSUB(A.y, B.y), 0.5f)), O = cmk(FMUL(FADD(A.y, B.y), 0.5f), FMUL(FSUB(B.x, A.x), 0.5f));
        c32 T = cmul(Wk, O);
        const c32 X = cadd(E, T), Xm = csub(E, T);
        E = cmk(FMUL(FADD(HA.x, HB.x), 0.5f), FMUL(FSUB(HA.y, HB.y), 0.5f)); O = cmk(FMUL(FADD(HA.y, HB.y), 0.5f), FMUL(FSUB(HB.x, HA.x), 0.5f));
        T = cmul(Wk, O);
        const c32 Hk = cadd(E, T), Hm = csub(E, T);
        const c32 Y = cmul(X, Hk), Ypc = cmul(Xm, Hm);
        const float sc = 0.5f / 8192.0f;
        const c32 Ye = cscale(cadd(Y, Ypc), sc), Yd = cscale(csub(Y, Ypc), sc);
        const c32 Yo = cmulc(Yd, Wk);
        STC(Z, pa, cmk(FSUB(Ye.x, Yo.y), FADD(Ye.y, Yo.x)));
        if (pb != pa) STC(Z, pb, cmk(FADD(Ye.x, Yo.y), FSUB(Yo.x, Ye.y)));
    }
}
HD float bf_lo(unsigned u) { unsigned v = u << 16; return __builtin_bit_cast(float, v); }
HD float bf_hi(unsigned u) { unsigned v = u & 0xffff0000u; return __builtin_bit_cast(float, v); }
HD void hy_conv3_load(int tid, const unsigned* zrow, float c0, float c1, float c2, float cb, c32 (&out)[8]) { HY_OPAQUE(tid);
    unsigned wm[8], wl[8], wr[8];
#pragma unroll
    for (int q = 0; q < 8; ++q) { const int m = tid + 512 * q, ml = (m > 0) ? m - 1 : 0, mr = (m < 4095) ? m + 1 : 4095;
        wm[q] = HY_GLD(zrow, m); wl[q] = HY_GLD(zrow, ml); wr[q] = HY_GLD(zrow, mr); }
#pragma unroll
    for (int q = 0; q < 8; ++q) { const int m = tid + 512 * q; wl[q] = (m > 0) ? wl[q] : 0u; wr[q] = (m < 4095) ? wr[q] : 0u; }
#pragma unroll
    for (int q = 0; q < 8; ++q) {
        const float zm1 = bf_hi(wl[q]), z0 = bf_lo(wm[q]), z1 = bf_hi(wm[q]), z2 = bf_lo(wr[q]);
        out[q] = cmk(FFMA(c0, zm1, FFMA(c1, z0, FFMA(c2, z1, cb))), FFMA(c0, z0, FFMA(c1, z1, FFMA(c2, z2, cb))));
    }
}
HD void hy_filter_s1(int tid, LAS c32* buf, const unsigned* zk) { HY_OPAQUE(tid);
    unsigned w[16];
#pragma unroll
    for (int q = 0; q < 16; ++q) w[q] = zk[tid + 512 * q];
    c32 a[16];
#pragma unroll
    for (int q = 0; q < 16; ++q) a[q] = cmk(bf_lo(w[q]), bf_hi(w[q]));
    fft_s1_fwd(tid, buf, a, cmk(1.f, 0.f));
}
HD void hy_data_s1(int tid, LAS c32* buf, const c32 (&v)[8], c32 w1) { HY_OPAQUE(tid);
    c32 a[16];
#pragma unroll
    for (int q = 0; q < 8; ++q) a[q] = v[q];
#pragma unroll
    for (int q = 8; q < 16; ++q) a[q] = cmk(0.f, 0.f);
    fft_s1_fwd(tid, buf, a, w1);
}
HD unsigned hy_bf(float f) { unsigned u = __builtin_bit_cast(unsigned, f); return (u + 0x7fffu + ((u >> 16) & 1u)) >> 16; }
HD void hy_pack_store(unsigned* zk, int dir, int a4, float t0, float t1, float t2, float t3) {
    if (dir == 0) { zk[a4 / 2] = hy_bf(t0) | (hy_bf(t1) << 16); zk[a4 / 2 + 1] = hy_bf(t2) | (hy_bf(t3) << 16); }
    else {
        const int m = 8192 - a4 / 2;
        if (a4 > 0) ((unsigned short*)(zk + m))[0] = (unsigned short)hy_bf(t0);
        zk[m - 1] = hy_bf(t2) | (hy_bf(t1) << 16);
        if (a4 == 8188) zk[m - 2] = hy_bf(t3) << 16; else ((unsigned short*)(zk + m - 2))[1] = (unsigned short)hy_bf(t3);
    }
}
struct CvItem { const float* src; int N; bf16* dst; size_t dld; int f8; };
constexpr int CV_S0 = 32 * 288, CV_S7 = 128, CV_SA = CV_S0 + CV_S7, CV_S1 = 16 * 64, CV_S3 = 32 * 64, CV_S4 = 16 * 32 * 16, CV_S6 = 16 * 8 * 64;
constexpr int CV_NITEMS = CV_SA + 2 * CV_S1 + CV_S3 + 2 * CV_S4 + CV_S6;
__device__ __forceinline__ void cv_decode_layer(Frame& F, int l, int r, CvItem& d) {
    bf16* WIN = (bf16*)(F.ws + ((l & 1) ? WS_WIN2 : WS_WIN)); bf16* PT = (bf16*)(F.ws + WS_PT); bf16* WOT = (bf16*)(F.ws + WS_WOT); bf16* WGU = (bf16*)(F.ws + WS_WGU); bf16* WD = (bf16*)(F.ws + WS_WD);
    bf16* W3T = (bf16*)(F.ws + WS_W3T + (size_t)(l & 1) * 512 * 1024);
    d.f8 = 0;
    if (r < CV_S0) { const int kb = r / 288, nb = r % 288; d.src = inp(F, I_WIN) + (size_t)l * DM * NIN + (size_t)(64 * kb) * NIN + 32 * nb; d.N = NIN;
        if (nb >= 160) { d.dst = (bf16*)(F.ws + WS_WIN8 + (size_t)(l & 1) * 8 * MiB) + (size_t)(32 * nb - 5120) * (DM / 2) + 32 * kb; d.dld = DM / 2; d.f8 = 1; }
        else { d.dst = WIN + (size_t)(32 * nb) * DM + 64 * kb; d.dld = DM; }
        return; } r -= CV_S0;
    if (r < CV_S7) { const int nb = r; d.src = inp(F, I_FW3) + (size_t)l * 64 * 4096 + 32 * nb; d.N = 4096; d.dst = W3T + (size_t)(32 * nb) * 64; d.dld = 64; return; } r -= CV_S7;
    if (r < CV_S1) { const int kb = r / 64, nb = r % 64; d.src = inp(F, I_WHY) + (size_t)l * HYW * DM + (size_t)(64 * kb) * DM + 32 * nb; d.N = DM; d.dst = PT + (size_t)(32 * nb) * DM + 64 * kb; d.dld = DM; return; } r -= CV_S1;
    if (r < CV_S1) { const int kb = r / 64, nb = r % 64; d.src = inp(F, I_WSG) + (size_t)l * SGW * DM + (size_t)(64 * kb) * DM + 32 * nb; d.N = DM; d.dst = PT + (size_t)(32 * nb) * DM + 1024 + 64 * kb; d.dld = DM; return; } r -= CV_S1;
    if (r < CV_S3) { const int kb = r / 64, nb = r % 64; d.src = inp(F, I_WOUT) + (size_t)l * DM * DM + (size_t)(64 * kb) * DM + 32 * nb; d.N = DM; d.dst = WOT + (size_t)(32 * nb) * DM + 64 * kb; d.dld = DM; return; } r -= CV_S3;
    if (r < 2 * CV_S4) { const int up = r / CV_S4; r -= up * CV_S4; const int e = r / 512, q = r % 512, kb = q / 16, nb = q % 16; const int n0 = 32 * nb, drow = 256 * (n0 / 128) + (n0 % 128) + 128 * up;
        d.src = (up ? inp(F, I_WUP) : inp(F, I_WGATE)) + ((size_t)l * NEXP + e) * DM * DEXP + (size_t)(64 * kb) * DEXP + n0; d.N = DEXP; d.dst = WGU + ((size_t)e * 1024 + drow) * (DM / 2) + 32 * kb; d.dld = DM / 2; d.f8 = 1; return; } r -= 2 * CV_S4;
    { const int e = r / 512, q = r % 512, kb = q / 64, nb = q % 64;
        d.src = inp(F, I_WDOWN) + ((size_t)l * NEXP + e) * DEXP * DM + (size_t)(64 * kb) * DM + 32 * nb; d.N = DM; d.dst = WD + ((size_t)e * DM + 32 * nb) * (DEXP / 2) + 32 * kb; d.dld = DEXP / 2; d.f8 = 1; }
}
__device__ __forceinline__ bool cv_decode(Frame& F, int set, int l, int it, CvItem& d) {
    if (set == 0) { if (it >= CV_SA) return false; cv_decode_layer(F, l, it, d); return true; }
    const int n1 = CV_NITEMS - CV_SA, n2 = (l + 1 < DEPTH) ? CV_SA : 0;
    if (it >= n1 + n2) return false;
    if (it < n1) cv_decode_layer(F, l, CV_SA + it, d); else cv_decode_layer(F, l + 1, it - n1, d);
    return true;
}
__device__ __forceinline__ void cv_load(const CvItem& d, int lane, float (&v)[32]) {
    const float* s = d.src + (size_t)(lane >> 3) * d.N + 4 * (lane & 7);
#pragma unroll
    for (int i = 0; i < 8; ++i) { const f32x4 w = *(const GAS f32x4*)(s + (size_t)(8 * i) * d.N); v[4 * i] = w.x; v[4 * i + 1] = w.y; v[4 * i + 2] = w.z; v[4 * i + 3] = w.w; }
}
__device__ __forceinline__ void cv_store(const CvItem& d, int lane, const float (&v)[32], LAS float* scr) {
    const int n = lane >> 1, h = lane & 1, kr = lane >> 3, nq = lane & 7;
#pragma unroll
    for (int s = 0; s < 4; ++s) {
        *(LAS f32x4*)(scr + kr * 36 + 4 * nq) = (f32x4){v[8 * s], v[8 * s + 1], v[8 * s + 2], v[8 * s + 3]};
        *(LAS f32x4*)(scr + (8 + kr) * 36 + 4 * nq) = (f32x4){v[8 * s + 4], v[8 * s + 5], v[8 * s + 6], v[8 * s + 7]};
        LDS_WAIT(); asm volatile("" ::: "memory");
        const LAS float* q = scr + (8 * h) * 36 + n;
        if (d.f8) { int a = __builtin_amdgcn_cvt_pk_fp8_f32(q[0 * 36] * 64.f, q[1 * 36] * 64.f, 0, false); a = __builtin_amdgcn_cvt_pk_fp8_f32(q[2 * 36] * 64.f, q[3 * 36] * 64.f, a, true);
            int b = __builtin_amdgcn_cvt_pk_fp8_f32(q[4 * 36] * 64.f, q[5 * 36] * 64.f, 0, false); b = __builtin_amdgcn_cvt_pk_fp8_f32(q[6 * 36] * 64.f, q[7 * 36] * 64.f, b, true);
            *(GAS v2u*)((char*)d.dst + (size_t)n * d.dld * 2 + 16 * s + 8 * h) = (v2u){(unsigned)a, (unsigned)b}; }
        else { v4u o; o.x = pk2h(q[0 * 36], q[1 * 36]); o.y = pk2h(q[2 * 36], q[3 * 36]); o.z = pk2h(q[4 * 36], q[5 * 36]); o.w = pk2h(q[6 * 36], q[7 * 36]);
            *(GAS v4u*)(d.dst + (size_t)n * d.dld + 16 * s + 8 * h) = o; }
        LDS_WAIT(); asm volatile("" ::: "memory");
    }
}
struct CvPipe { CvItem d; int n, wi, nw, cls, set, l; bool have; };
__device__ __forceinline__ int cv_index(const CvPipe& P) {
    if (P.cls == 0) return P.wi + P.nw * P.n;
    if (P.cls == 1) { const int ch = P.n / 3, j = P.n - 3 * ch; return ch * 4 * P.nw + j * P.nw + P.wi; }
    return P.n * 4 * P.nw + 3 * P.nw + P.wi;
}
#define CV_SCR(F) ((LAS float*)((F).lds + CVS_OFF + (F).wave * 2304))
#define CV_START(F, P, V, SET, L, CLS, WI, NW) do { (P).set = (SET); (P).l = (L); (P).cls = (CLS); (P).nw = (NW); int _wi = (WI); asm volatile("" : "+s"(_wi)); (P).wi = _wi; (P).n = 0; \
        (P).have = cv_decode(F, SET, L, cv_index(P), (P).d); if ((P).have) cv_load((P).d, (F).lane, V); } while (0)
#define CV_STEP(F, P, V) do { if ((P).have) { cv_store((P).d, (F).lane, V, CV_SCR(F)); (P).n += 1; (P).have = cv_decode(F, (P).set, (P).l, cv_index(P), (P).d); if ((P).have) cv_load((P).d, (F).lane, V); } } while (0)
__device__ __forceinline__ void pa_convert(Frame& F, int l) {
    CvPipe P; float va[32];
    CV_START(F, P, va, 0, l, 0, F.vcu * NWAVES + F.wave, F.G * NWAVES);
    while (P.have) CV_STEP(F, P, va);
}
__device__ __forceinline__ void pa_features(Frame& F, int l) {
    LAS float* zf = (LAS float*)(F.lds);
    LAS float* a1 = zf + 8 * 40;
    const float* w1 = inp(F, I_FW1) + l * 33 * 64; const float* b1 = inp(F, I_FB1) + l * 64; const float* w2 = inp(F, I_FW2) + l * 64 * 64; const float* b2 = inp(F, I_FB2) + l * 64; const float* fq = inp(F, I_FFREQ) + l * 64;
    bf16* A2 = (bf16*)(F.ws + WS_A2 + (size_t)l * MiB);
    const int tl = F.tid >> 6, j = F.tid & 63;
    const float fr = fq[j];
    float w1c[33], w2c[64];
#pragma unroll
    for (int i = 0; i < 33; ++i) w1c[i] = w1[i * 64 + j];
#pragma unroll
    for (int i = 0; i < 64; ++i) w2c[i] = w2[i * 64 + j];
    for (int t0 = F.vcu * 8; t0 < SEQ; t0 += F.G * 8) {
        __syncthreads();
        if (F.tid < 8 * 33) { const int tt = F.tid / 33, i = F.tid % 33; const int t = t0 + tt; float v;
            const float w = 6.283185307179586f / (float)SEQ * (float)t;
            if (i == 0) v = (float)t / (float)(SEQ - 1);
            else { const int b = (i - 1) & 15; const float band = 1e-4f + (float)b * ((15.0f - 1e-4f) / 15.0f); const float a = band * w; v = (i <= 16) ? cosf(a) : -sinf(a); }
            zf[tt * 40 + i] = v; }
        __syncthreads();
        float s = b1[j];
#pragma unroll
        for (int i = 0; i < 33; ++i) s += zf[tl * 40 + i] * w1c[i];
        a1[tl * 64 + j] = sinf(fr * s);
        __syncthreads();
        float s2 = b2[j];
#pragma unroll
        for (int i = 0; i < 64; ++i) s2 += a1[tl * 64 + i] * w2c[i];
        A2[(size_t)(t0 + tl) * 64 + j] = (bf16)f2bf(sinf(fr * s2));
    }
    __syncthreads();
}
__device__ __forceinline__ void feat_token(Frame& F, int t, const float (&w1c)[33], const float (&w2c)[64], float b1j, float b2j, float frj, bf16* A2) {
    LAS float* zf = (LAS float*)(F.lds + F.wave * 512);
    LAS float* a1 = zf + 40;
    const int i = F.lane;
    if (i < 33) { float v; const float w = 6.283185307179586f / (float)SEQ * (float)t;
        if (i == 0) v = (float)t / (float)(SEQ - 1);
        else { const int b = (i - 1) & 15; const float band = 1e-4f + (float)b * ((15.0f - 1e-4f) / 15.0f); const float a = band * w; v = (i <= 16) ? cosf(a) : -sinf(a); }
        zf[i] = v; }
    LDS_WAIT(); asm volatile("" ::: "memory");
    float s = b1j;
#pragma unroll
    for (int k = 0; k < 33; ++k) s += zf[k] * w1c[k];
    a1[i] = sinf(frj * s);
    LDS_WAIT(); asm volatile("" ::: "memory");
    float s2 = b2j;
#pragma unroll
    for (int k = 0; k < 64; ++k) s2 += a1[k] * w2c[k];
    A2[(size_t)t * 64 + i] = (bf16)f2bf(sinf(frj * s2));
    LDS_WAIT(); asm volatile("" ::: "memory");
}
__device__ __forceinline__ void pa_convert_features(Frame& F) {
    CvPipe P; float va[32];
    CV_START(F, P, va, 0, 0, 0, F.vcu * NWAVES + F.wave, F.G * NWAVES);
    for (int ll = 0; ll < DEPTH; ++ll) {
        const float* w1 = inp(F, I_FW1) + ll * 33 * 64; const float* w2 = inp(F, I_FW2) + ll * 64 * 64;
        const int j = F.lane;
        const float b1j = (inp(F, I_FB1) + ll * 64)[j], b2j = (inp(F, I_FB2) + ll * 64)[j], frj = (inp(F, I_FFREQ) + ll * 64)[j];
        bf16* A2 = (bf16*)(F.ws + WS_A2 + (size_t)ll * MiB);
        float w1c[33], w2c[64];
#pragma unroll
        for (int i = 0; i < 33; ++i) w1c[i] = w1[i * 64 + j];
#pragma unroll
        for (int i = 0; i < 64; ++i) w2c[i] = w2[i * 64 + j];
        for (int t = F.vcu * NWAVES + F.wave; t < SEQ; t += F.G * NWAVES) { feat_token(F, t, w1c, w2c, b1j, b2j, frj, A2); CV_STEP(F, P, va); }
    }
    while (P.have) CV_STEP(F, P, va);
}
__device__ __forceinline__ void pa_router_t(Frame& F, int l) {
    float* WR = (float*)(F.ws + WS_WR + (size_t)l * 256 * 1024);
    const float* wrg = inp(F, I_WRG) + (size_t)l * DM * 4; const float* wre = inp(F, I_WRE) + (size_t)l * 4 * DM * 4;
    for (int i = F.vcu * NTHR + F.tid; i < 20 * DM; i += F.G * NTHR) { const int o = i / DM, k = i % DM;
        WR[i] = (o < 4) ? wrg[k * 4 + o] : wre[((size_t)((o - 4) >> 2) * DM + k) * 4 + ((o - 4) & 3)]; }
}
__device__ __forceinline__ int moe_off(const gu32* cnt, int e) { int s = 0;
#pragma unroll
    for (int j = 0; j < 16; ++j) { const int c = (int)cnt[64 * j]; s += (j < e) ? c : 0; } return s; }
template <int MODE, bool OUTF, int NR>
__device__ __forceinline__ void norm_rows(Frame& F, int m0, int mstride, const float* xin, const float* g, const gu32* cntprev, float* outf) {
    bf16* XR = (bf16*)(F.ws + WS_XR); bf16* XN = (bf16*)(F.ws + WS_XN);
    f32x4 v[NR][8];
    if (MODE == 0) {
#pragma unroll
        for (int r = 0; r < NR; ++r) { const int m = m0 + r * mstride; const GAS f32x4* xr = (const GAS f32x4*)(xin + (size_t)m * DM) + F.lane;
#pragma unroll
            for (int j = 0; j < 8; ++j) v[r][j] = xr[64 * j]; }
    } else {
        const int* TOKPOS = (const int*)(F.ws + WS_LISTS + 1 * MiB); const bf16* MO = (const bf16*)(F.ws + WS_MOEOUT);
        int slot[NR][2];
#pragma unroll
        for (int r = 0; r < NR; ++r)
#pragma unroll
            for (int k = 0; k < 2; ++k) { const int tp = TOKPOS[(m0 + r * mstride) * 2 + k]; slot[r][k] = moe_off(cntprev, tp >> 13) + (tp & 8191); }
        v2u w[NR][3][8];
#pragma unroll
        for (int r = 0; r < NR; ++r) { const GAS v2u* xr = (const GAS v2u*)(XR + (size_t)(m0 + r * mstride) * DM) + F.lane;
#pragma unroll
            for (int j = 0; j < 8; ++j) w[r][2][j] = xr[64 * j];
#pragma unroll
            for (int k = 0; k < 2; ++k) { const GAS v2u* mr = (const GAS v2u*)(MO + (size_t)slot[r][k] * DM) + F.lane;
#pragma unroll
                for (int j = 0; j < 8; ++j) w[r][k][j] = mr[64 * j]; } }
#pragma unroll
        for (int r = 0; r < NR; ++r) {
#pragma unroll
            for (int j = 0; j < 8; ++j) { const v2u a = w[r][2][j], b = w[r][0][j], c = w[r][1][j];
                v[r][j] = (f32x4){bfl(a.x) + bfl(b.x) + bfl(c.x), bfh(a.x) + bfh(b.x) + bfh(c.x), bfl(a.y) + bfl(b.y) + bfl(c.y), bfh(a.y) + bfh(b.y) + bfh(c.y)}; }
            if (!OUTF) { GAS v2u* xw = (GAS v2u*)(XR + (size_t)(m0 + r * mstride) * DM) + F.lane;
#pragma unroll
                for (int j = 0; j < 8; ++j) { v2u o; o.x = pk2h(v[r][j].x, v[r][j].y); o.y = pk2h(v[r][j].z, v[r][j].w); xw[64 * j] = o; } } }
    }
    const GAS f32x4* gp = (const GAS f32x4*)g + F.lane;
#pragma unroll
    for (int r = 0; r < NR; ++r) { const int m = m0 + r * mstride;
        float ss = 0.f;
#pragma unroll
        for (int j = 0; j < 8; ++j) ss += (v[r][j].x * v[r][j].x + v[r][j].y * v[r][j].y) + (v[r][j].z * v[r][j].z + v[r][j].w * v[r][j].w);
        const float rstd = 1.0f / sqrtf(wave_sum(ss, F.lane) * (1.0f / DM) + EPS);
        if (OUTF) { GAS f32x4* o = (GAS f32x4*)(outf + (size_t)m * DM) + F.lane;
#pragma unroll
            for (int j = 0; j < 8; ++j) { const f32x4 gg = gp[64 * j]; o[64 * j] = v[r][j] * rstd * gg; } }
        else { GAS v2u* o = (GAS v2u*)(XN + (size_t)m * DM) + F.lane; GAS unsigned* o8 = (GAS unsigned*)(F.ws + WS_XN8 + (size_t)m * DM) + F.lane;
#pragma unroll
            for (int j = 0; j < 8; ++j) { const f32x4 gg = gp[64 * j]; const f32x4 rr = v[r][j] * rstd * gg; v2u ww; ww.x = pk2h(rr.x, rr.y); ww.y = pk2h(rr.z, rr.w); o[64 * j] = ww;
                int q = __builtin_amdgcn_cvt_pk_fp8_f32(rr.x, rr.y, 0, false); q = __builtin_amdgcn_cvt_pk_fp8_f32(rr.z, rr.w, q, true); o8[64 * j] = (unsigned)q; } } }
}

__device__ __forceinline__ void sgu_pair(Frame& F, int l, int ch, int gp) {
    constexpr int RS = 136;
    LAS bf16* Wb = (LAS bf16*)(F.lds);
    LAS bf16* Vt = (LAS bf16*)(F.lds + 128 * RS * 2);
    LAS float* st = (LAS float*)(F.lds + 2 * 128 * RS * 2);
    const bf16* GV = (const bf16*)(F.ws + WS_GV); const bf16* U = (const bf16*)(F.ws + WS_U); bf16* Y = (bf16*)(F.ws + WS_Y);
    const float* lng = inp(F, I_LNG) + l * SGW; const float* lnb = inp(F, I_LNB) + l * SGW;
    const int t0 = ch * 128, g0 = 2 * gp;
    if (F.wave == 0) { wait_ge(F.ctl + CW_UG + 64 * (32 * l + (ch >> 1)), 64u, F.ctl + CW_TMO); __builtin_amdgcn_fence(__ATOMIC_ACQUIRE, "agent"); asm volatile("s_waitcnt vmcnt(0)" ::: "memory"); }
    __syncthreads();
    const float* Wg = inp(F, I_SGW) + ((size_t)l * 8 + g0) * 128 * 128;
    const int fr = F.lane & 15, fq = F.lane >> 4, tw = F.wave * 16, tq = t0 + tw + fr;
    f32x4 wq[2][8]; v4u va[2][2], vb[2][2]; v2u uw[2][8];
#pragma unroll
    for (int gi = 0; gi < 2; ++gi)
#pragma unroll
        for (int i = 0; i < 8; ++i) { const int idx = F.tid + NTHR * i; wq[gi][i] = *(const GAS f32x4*)(Wg + gi * 128 * 128 + (idx >> 5) * 128 + (idx & 31) * 4); }
#pragma unroll
    for (int gi = 0; gi < 2; ++gi)
#pragma unroll
        for (int i = 0; i < 2; ++i) { const int idx = F.tid + NTHR * i, sp = idx & 63, kc = idx >> 6;
            va[gi][i] = *(const GAS v4u*)(GV + (size_t)(t0 + 2 * sp) * SGW + (g0 + gi) * 128 + 8 * kc); vb[gi][i] = *(const GAS v4u*)(GV + (size_t)(t0 + 2 * sp + 1) * SGW + (g0 + gi) * 128 + 8 * kc); }
#pragma unroll
    for (int gi = 0; gi < 2; ++gi)
#pragma unroll
        for (int kt = 0; kt < 8; ++kt) uw[gi][kt] = *(const GAS v2u*)(U + (size_t)tq * SGW + (g0 + gi) * 128 + kt * 16 + 4 * fq);
    float sbias[2];
#pragma unroll
    for (int gi = 0; gi < 2; ++gi) sbias[gi] = ((const GAS float*)(inp(F, I_SGB) + (l * 8 + g0 + gi) * 128))[tw + fr];
    {
        const int row = F.tid >> 2, part = F.tid & 3; const GAS v4u* rp = (const GAS v4u*)(GV + (size_t)(t0 + row) * SGW);
        float s = 0.f, q = 0.f;
#pragma unroll 16
        for (int i = 0; i < 32; ++i) { const v4u w = rp[part + 4 * i]; const unsigned ww[4] = {w.x, w.y, w.z, w.w};
#pragma unroll
            for (int j = 0; j < 4; ++j) { const float a = bfl(ww[j]), b = bfh(ww[j]); s += a + b; q += a * a + b * b; } }
        s += shfl_xor_l(s, 1, F.lane); s += shfl_xor_l(s, 2, F.lane); q += shfl_xor_l(q, 1, F.lane); q += shfl_xor_l(q, 2, F.lane);
        const float mu = s * (1.0f / SGW); const float var = fmaxf(q * (1.0f / SGW) - mu * mu, 0.f);
        if (part == 0) { st[row] = mu; st[128 + row] = 1.0f / sqrtf(var + EPS); }
    }
#pragma unroll
    for (int gi = 0; gi < 2; ++gi) {
        const int g = g0 + gi;
        f32x4 lg[2][2], lb[2][2];
#pragma unroll
        for (int i = 0; i < 2; ++i) { const int kc = (F.tid + NTHR * i) >> 6; const GAS f32x4* pg = (const GAS f32x4*)(lng + g * 128 + 8 * kc); const GAS f32x4* pb = (const GAS f32x4*)(lnb + g * 128 + 8 * kc);
            lg[i][0] = pg[0]; lg[i][1] = pg[1]; lb[i][0] = pb[0]; lb[i][1] = pb[1]; }
#pragma unroll
        for (int i = 0; i < 8; ++i) { const int idx = F.tid + NTHR * i; const int t = idx >> 5, s4 = (idx & 31) * 4; const f32x4 w = wq[gi][i];
            v2u o; o.x = pk2h(w.x, w.y); o.y = pk2h(w.z, w.w); *(LAS v2u*)(Wb + t * RS + s4) = o; }
        if (gi == 0) __syncthreads();
#pragma unroll
        for (int i = 0; i < 2; ++i) { const int idx = F.tid + NTHR * i, sp = idx & 63, kc = idx >> 6;
            const unsigned aw[4] = {va[gi][i].x, va[gi][i].y, va[gi][i].z, va[gi][i].w}, bw[4] = {vb[gi][i].x, vb[gi][i].y, vb[gi][i].z, vb[gi][i].w};
            const float mua = st[2 * sp], rsa = st[128 + 2 * sp], mub = st[2 * sp + 1], rsb = st[128 + 2 * sp + 1];
#pragma unroll
            for (int j = 0; j < 4; ++j) { const int k = 8 * kc + 2 * j; const float ga = lg[i][j >> 1][2 * (j & 1)], gb = lg[i][j >> 1][2 * (j & 1) + 1], ba = lb[i][j >> 1][2 * (j & 1)], bb = lb[i][j >> 1][2 * (j & 1) + 1];
                *(LAS unsigned*)(Vt + k * RS + 2 * sp) = pk2h((bfl(aw[j]) - mua) * rsa * ga + ba, (bfl(bw[j]) - mub) * rsb * ga + ba);
                *(LAS unsigned*)(Vt + (k + 1) * RS + 2 * sp) = pk2h((bfh(aw[j]) - mua) * rsa * gb + bb, (bfh(bw[j]) - mub) * rsb * gb + bb); } }
        __syncthreads();
        {
            const float bias = sbias[gi];
            bf16x8 af[4];
#pragma unroll
            for (int ks = 0; ks < 4; ++ks) af[ks] = *(const LAS bf16x8*)(Wb + (tw + fr) * RS + ks * 32 + fq * 8);
#pragma unroll
            for (int kt = 0; kt < 8; ++kt) { f32x4 acc = (f32x4){0.f, 0.f, 0.f, 0.f};
#pragma unroll
                for (int ks = 0; ks < 4; ++ks) { const bf16x8 bfv = *(const LAS bf16x8*)(Vt + (kt * 16 + fr) * RS + ks * 32 + fq * 8);
                    acc = __builtin_amdgcn_mfma_f32_16x16x32_bf16(bfv, af[ks], acc, 0, 0, 0); }
                const int kcol = g * 128 + kt * 16 + 4 * fq;
                v2u o; o.x = pk2h(bfl(uw[gi][kt].x) * (acc[0] + bias), bfh(uw[gi][kt].x) * (acc[1] + bias)); o.y = pk2h(bfl(uw[gi][kt].y) * (acc[2] + bias), bfh(uw[gi][kt].y) * (acc[3] + bias));
                *(GAS v2u*)(Y + (size_t)tq * DM + 1024 + kcol) = o; }
        }
        __syncthreads();
    }
}

__device__ __forceinline__ void hy_filter_gen(Frame& F, int l, int c0, unsigned* FSP) {
    const bf16* A2 = (const bf16*)(F.ws + WS_A2 + (size_t)l * MiB); const bf16* W3T = (const bf16*)(F.ws + WS_W3T + (size_t)(l & 1) * 512 * 1024);
    int lane = F.lane; asm volatile("" : "+v"(lane));
    const int fr = lane & 15, fq = lane >> 4;
    const int chl = fr >> 2, o = (fr >> 1) & 1, dir = fr & 1, col = dir * 2048 + o * 1024 + c0 + chl;
    const bf16x8 b0 = *(const GAS bf16x8*)(W3T + (size_t)col * 64 + fq * 8), b1 = *(const GAS bf16x8*)(W3T + (size_t)col * 64 + 32 + fq * 8);
    const float delta = 3.0701134573253944f + (float)(c0 + chl) * (12.280453829301579f / 1023.0f);
    const float kdec = -delta * 1.4426950408889634f / (float)(SEQ - 1);
    constexpr int RS = 2056;
    LAS bf16* Ft = (LAS bf16*)(F.lds);
    LAS unsigned short* carry = (LAS unsigned short*)(F.lds + 16 * RS * 2);
    const int rot = (c0 * 10) & 127;
#define FG_LOAD(c_, ib_, A0, A1) do { int _fr = fr, _fq = fq; asm volatile("" : "+v"(_fr), "+v"(_fq)); \
        _Pragma("unroll") for (int j = 0; j < 8; ++j) { const int t0 = (128 * (c_) + ((F.wave + 8 * ((ib_) * 8 + j) + rot) & 127)) * 16; \
            A0[j] = *(const GAS bf16x8*)(A2 + (size_t)(t0 + _fr) * 64 + _fq * 8); A1[j] = *(const GAS bf16x8*)(A2 + (size_t)(t0 + _fr) * 64 + 32 + _fq * 8); } } while (0)
#define FG_COMP(c_, ib_, A0, A1) do { int _fr = fr, _fq = fq; asm volatile("" : "+v"(_fr), "+v"(_fq)); \
        _Pragma("unroll") for (int j = 0; j < 8; ++j) { const int tl = ((F.wave + 8 * ((ib_) * 8 + j) + rot) & 127) * 16, tb = 2048 * (c_) + tl + 4 * _fq; \
            f32x4 acc = (f32x4){0.f, 0.f, 0.f, 0.f}; \
            acc = __builtin_amdgcn_mfma_f32_16x16x32_bf16(A0[j], b0, acc, 0, 0, 0); \
            acc = __builtin_amdgcn_mfma_f32_16x16x32_bf16(A1[j], b1, acc, 0, 0, 0); \
            _Pragma("unroll") for (int r = 0; r < 4; ++r) acc[r] *= __builtin_amdgcn_exp2f(kdec * (float)(tb + r)); \
            v2u w; w.x = pk2h(acc[0], acc[1]); w.y = pk2h(acc[2], acc[3]); \
            *(LAS v2u*)(Ft + _fr * RS + tl + 4 * _fq) = w; } } while (0)
    bf16x8 xa0[8], xa1[8], ya0[8], ya1[8];
    FG_LOAD(0, 0, xa0, xa1);
#pragma unroll 1
    for (int c = 0; c < 4; ++c) {
        FG_LOAD(c, 1, ya0, ya1);
        FG_COMP(c, 0, xa0, xa1);
        if (c < 3) FG_LOAD(c + 1, 0, xa0, xa1);
        FG_COMP(c, 1, ya0, ya1);
        __syncthreads();
        int tid2 = F.tid; asm volatile("" : "+v"(tid2));
        {
#pragma unroll
            for (int i = 0; i < 4; ++i) { const int idx = tid2 + NTHR * i, r8 = idx >> 8, pc = idx & 255; const int f = (r8 >> 1) * 4 + (r8 & 1) * 2;
                v4u w = *(const LAS v4u*)(Ft + f * RS + 8 * pc);
                if (c == 0 && pc == 0) { const float s0 = bfl(w.x) + bfl((unsigned)Ft[(f + 1) * RS]); w.x = (w.x & 0xffff0000u) | f2bf(s0); }
                *(GAS v4u*)(FSP + (size_t)r8 * 8192 + 1024 * c + 4 * pc) = w; }
        }
        {
#pragma unroll 4
            for (int i = 0; i < 16; ++i) { const int idx = tid2 + NTHR * i, r8 = idx >> 10, il = idx & 1023; const int f = (r8 >> 1) * 4 + (r8 & 1) * 2 + 1;
                const unsigned lo = Ft[f * RS + 2 * il]; const unsigned hi = (il > 0) ? (unsigned)Ft[f * RS + 2 * il - 1] : (unsigned)carry[(c & 1) * 8 + r8];
                const int ig = 1024 * c + il;
                if (ig > 0) FSP[(size_t)r8 * 8192 + 8192 - ig] = lo | (hi << 16); }
            if (F.tid < 8) { const int f = (F.tid >> 1) * 4 + (F.tid & 1) * 2 + 1; const unsigned short last = Ft[f * RS + 2047];
                carry[((c + 1) & 1) * 8 + F.tid] = last;
                if (c == 3) FSP[(size_t)F.tid * 8192 + 4096] = (unsigned)last << 16; }
        }
        __syncthreads();
    }
}
#undef FG_LOAD
#undef FG_COMP
__device__ __forceinline__ unsigned pk_c32(c32 v) { return pk2h(v.x, v.y); }
__device__ __forceinline__ c32 unpk_c32(unsigned u) { return cmk(bfl(u), bfh(u)); }
__device__ __forceinline__ void hyena_block(Frame& F, int l, int blk) {
    LAS c32* A = (LAS c32*)(F.lds); LAS c32* B = A + HY_LDS_C32;
    unsigned* FSP = (unsigned*)(F.ws + WS_FS) + (size_t)blk * 8 * 8192;
    const unsigned* ZT = (const unsigned*)(F.ws + WS_ZT); bf16* Y = (bf16*)(F.ws + WS_Y);
    const GAS float* cw = (const GAS float*)(inp(F, I_CONVW) + (size_t)l * 3 * NHY); const GAS float* cb = (const GAS float*)(inp(F, I_CONVB) + (size_t)l * NHY); const GAS float* skp = (const GAS float*)(inp(F, I_SKIP) + (size_t)l * 2 * HYW);
    const int c0 = blk * 4, tid = F.tid;
    __syncthreads();
    HPS(20); hy_filter_gen(F, l, c0, FSP);
    if (F.wave == 0) { const int pz = c0 >> 8; gu32* cz = F.ctl + CW_ZT + 64 * 16 * l;
        wait_ge(cz + 64 * pz, 256u, F.ctl + CW_TMO); wait_ge(cz + 64 * (4 + pz), 256u, F.ctl + CW_TMO); wait_ge(cz + 64 * (8 + pz), 256u, F.ctl + CW_TMO);
        __builtin_amdgcn_fence(__ATOMIC_ACQUIRE, "agent"); }
    VM_WAIT(); __syncthreads(); HPE(20); HPS(21);
    CvPipe cvp; float cvv[32];
    {
        const int nlate = 1152 - 4 * F.G, bx = (int)blockIdx.x;
        if (false && F.G == 256 && nlate == 128) { if (bx >= nlate) CV_START(F, cvp, cvv, 1, l, 2, (bx - nlate) * NWAVES + F.wave, 128 * NWAVES); else CV_START(F, cvp, cvv, 1, l, 1, bx * NWAVES + F.wave, 128 * NWAVES); }
        else CV_START(F, cvp, cvv, 1, l, 0, F.vcu * NWAVES + F.wave, F.G * NWAVES);
    }
    unsigned yb0[8], yb1[8], yb2[8], yb3[8];
#pragma unroll
    for (int q = 0; q < 8; ++q) { yb0[q] = 0u; yb1[q] = 0u; yb2[q] = 0u; yb3[q] = 0u; }
    const c32 tw1 = cis_pi(-2.0f * (float)tid / 8192.0f), tw2 = cis_pi(-2.0f * (float)(tid & 31) / 512.0f), twp = cis_pi(-(float)(tid & 31) / 32.0f), twl = cis_pi(-(float)(tid >> 5) / 8192.0f);
#pragma unroll 1
    for (int chl = 0; chl < 4; ++chl) {
        const int c = c0 + chl; const GAS unsigned* zk = (const GAS unsigned*)(FSP + (size_t)chl * 2 * 8192);
        c32 keep[8]; unsigned x1p[8], x2p[8];
        c32 s[16];
        {
            unsigned fw[16]; c32 fz[16];
            { int t2 = tid; HY_OPAQUE(t2);
#pragma unroll
              for (int q = 0; q < 16; ++q) fw[q] = zk[t2 + 512 * q]; }
            c32 xa[8], xb[8];
            hy_conv3_load(tid, ZT + (size_t)(2048 + c) * (SEQ / 2), cw[2048 + c], cw[NHY + 2048 + c], cw[2 * NHY + 2048 + c], cb[2048 + c], keep);
            hy_conv3_load(tid, ZT + (size_t)c * (SEQ / 2), cw[c], cw[NHY + c], cw[2 * NHY + c], cb[c], xa);
            hy_conv3_load(tid, ZT + (size_t)(1024 + c) * (SEQ / 2), cw[1024 + c], cw[NHY + 1024 + c], cw[2 * NHY + 1024 + c], cb[1024 + c], xb);
#pragma unroll
            for (int q = 0; q < 8; ++q) { x1p[q] = pk_c32(xa[q]); x2p[q] = pk_c32(xb[q]); }
#pragma unroll
            for (int q = 0; q < 16; ++q) fz[q] = cmk(bfl(fw[q]), bfh(fw[q]));
            fft_s1_fwd(tid, B, fz, tw1);
            hy_data_s1(tid, A, keep, tw1);
        }
        const float sk0 = skp[c], sk1 = skp[HYW + c];
#pragma unroll
        for (int ord = 0; ord < 2; ++ord) {
            __syncthreads();
            HPS(22); fft_s2_fwd(tid, A, tw2); fft_s2_fwd(tid, B, tw2);
            __syncthreads(); HPE(22); HPS(23);
            CV_STEP(F, cvp, cvv);
            fft_s3_read<-1>(tid, A, s); fft_s3_write(tid, A, s);
            fft_s3_read<-1>(tid, B, s); fft_s3_write(tid, B, s);
            unsigned fw[16];
            if (ord == 0) { int t2 = tid; HY_OPAQUE(t2);
#pragma unroll
                for (int q = 0; q < 16; ++q) fw[q] = zk[8192 + t2 + 512 * q]; }
            __syncthreads(); HPE(23); HPS(24);
            CV_STEP(F, cvp, cvv);
            pair_pass(tid, A, B, twp, twl);
            __syncthreads(); HPE(24); HPS(25);
            if (ord == 0) { c32 fz[16];
#pragma unroll
                for (int q = 0; q < 16; ++q) fz[q] = cmk(bfl(fw[q]), bfh(fw[q]));
                fft_s1_fwd(tid, B, fz, tw1); }
            fft_s3_read<1>(tid, A, s); fft_s3_write(tid, A, s);
            __syncthreads();
            CV_STEP(F, cvp, cvv);
            fft_s2_inv(tid, A, tw2);
            __syncthreads();
            fft_s1_inv(tid, A, s, tw1); HPE(25); HPS(26);
            if (ord == 0) {
#pragma unroll
                for (int q = 0; q < 8; ++q) { const c32 xv = unpk_c32(x1p[q]); keep[q] = cmk(FMUL(xv.x, FFMA(keep[q].x, sk0, s[q].x)), FMUL(xv.y, FFMA(keep[q].y, sk0, s[q].y))); }
                hy_data_s1(tid, A, keep, tw1);
            } else {
#pragma unroll
                for (int q = 0; q < 8; ++q) { const c32 xv = unpk_c32(x2p[q]); const unsigned yv = pk_c32(cmk(FMUL(xv.x, FFMA(keep[q].x, sk1, s[q].x)), FMUL(xv.y, FFMA(keep[q].y, sk1, s[q].y))));
                    yb0[q] = (chl == 0) ? yv : yb0[q]; yb1[q] = (chl == 1) ? yv : yb1[q]; yb2[q] = (chl == 2) ? yv : yb2[q]; yb3[q] = (chl == 3) ? yv : yb3[q]; }
            }
            HPE(26);
        }
        __syncthreads();
    }
    {
        int t2 = tid; HY_OPAQUE(t2);
#pragma unroll
        for (int q = 0; q < 8; ++q) { const int m = t2 + 512 * q;
            v2u lo, hi; lo.x = (yb0[q] & 0xffffu) | (yb1[q] << 16); lo.y = (yb2[q] & 0xffffu) | (yb3[q] << 16);
            hi.x = (yb0[q] >> 16) | (yb1[q] & 0xffff0000u); hi.y = (yb2[q] >> 16) | (yb3[q] & 0xffff0000u);
            *(GAS v2u*)(Y + (size_t)(2 * m) * DM + c0) = lo; *(GAS v2u*)(Y + (size_t)(2 * m + 1) * DM + c0) = hi; }
    }
    while (cvp.have) CV_STEP(F, cvp, cvv);
    HPE(21);
}

__device__ __forceinline__ void rt_split8(const f32x4 a, const f32x4 b, bf16x8& hi, bf16x8& lo) {
    const float v[8] = {a.x, a.y, a.z, a.w, b.x, b.y, b.z, b.w}; v4u hw, lw;
#pragma unroll
    for (int j = 0; j < 4; ++j) { const unsigned h = pk2h(v[2 * j], v[2 * j + 1]); const unsigned lo2 = pk2h(v[2 * j] - bfl(h), v[2 * j + 1] - bfh(h)); hw[j] = h; lw[j] = lo2; }
    hi = __builtin_bit_cast(bf16x8, hw); lo = __builtin_bit_cast(bf16x8, lw);
}
__device__ __forceinline__ void route_block(Frame& F, int l, int tb  ) {
    LAS int* lcnt = (LAS int*)(F.lds);
    LAS int* lbase = (LAS int*)(F.lds + 64);
    LAS int* le = (LAS int*)(F.lds + 128);
    LAS int* lp = (LAS int*)(F.lds + 128 + 256);
    LAS float* lw = (LAS float*)(F.lds + 128 + 512);
    LAS float* lr = (LAS float*)(F.lds + 128 + 768);
    LAS float* SS = (LAS float*)(F.lds + 1024);
    LAS float* PL = (LAS float*)(F.lds + 2048);
    const bf16* XR = (const bf16*)(F.ws + WS_XR); unsigned char* H8 = (unsigned char*)(F.ws + WS_XN); const float* WR = (const float*)(F.ws + WS_WR + (size_t)l * 256 * 1024);
    const float* g = inp(F, I_GFFN) + (size_t)l * DM; const float* brg = inp(F, I_BRG) + l * 4; const float* bre = inp(F, I_BRE) + l * 16;
    int* TOKLIST = (int*)(F.ws + WS_LISTS); float* WLIST = (float*)(F.ws + WS_LISTS + 512 * 1024); int* TOKPOS = (int*)(F.ws + WS_LISTS + 1 * MiB); float* RSLIST = (float*)(F.ws + WS_LISTS + 1 * MiB + 512 * 1024);
    gu32* gcnt = F.ctl + CW_CNT + 64 * 16 * l;
    if (F.wave == 0) { wait_ge(F.ctl + CW_XR + 64 * (32 * l + (tb >> 8)), 64u, F.ctl + CW_TMO); __builtin_amdgcn_fence(__ATOMIC_ACQUIRE, "agent"); asm volatile("s_waitcnt vmcnt(0)" ::: "memory"); }
    __syncthreads();
    if (F.tid < 16) lcnt[F.tid] = 0;
    const int ts = F.tid >> 4, part = F.tid & 15;
    {
        const int fr = F.lane & 15, fq = F.lane >> 4, kw = 256 * F.wave + 8 * fq;
        f32x4 acc[2][2];
#pragma unroll
        for (int a = 0; a < 2; ++a)
#pragma unroll
            for (int b = 0; b < 2; ++b) acc[a][b] = (f32x4){0.f, 0.f, 0.f, 0.f};
        float ssl[2] = {0.f, 0.f};
        const bf16* x0 = XR + (size_t)(tb + fr) * DM + kw; const bf16* x1 = x0 + (size_t)16 * DM;
        const float* w0 = WR + (size_t)fr * DM + kw; const float* w1 = WR + (size_t)(16 + (fr & 3)) * DM + kw;
        v4u xb[2]; f32x4 wa[2][2], ga[2];
#define RT_LD(ks) do { const int _k = 32 * (ks); xb[0] = *(const GAS v4u*)(x0 + _k); xb[1] = *(const GAS v4u*)(x1 + _k); \
            wa[0][0] = *(const GAS f32x4*)(w0 + _k); wa[0][1] = *(const GAS f32x4*)(w0 + _k + 4); wa[1][0] = *(const GAS f32x4*)(w1 + _k); wa[1][1] = *(const GAS f32x4*)(w1 + _k + 4); \
            ga[0] = *(const GAS f32x4*)(g + kw + _k); ga[1] = *(const GAS f32x4*)(g + kw + _k + 4); } while (0)
        RT_LD(0);
#pragma unroll 1
        for (int ks = 0; ks < 8; ++ks) {
            bf16x8 ah[2], al[2], bh[2], bl[2];
#pragma unroll
            for (int mt = 0; mt < 2; ++mt) { const v4u xw = xb[mt]; const f32x4 p = (f32x4){bfl(xw.x), bfh(xw.x), bfl(xw.y), bfh(xw.y)}, q = (f32x4){bfl(xw.z), bfh(xw.z), bfl(xw.w), bfh(xw.w)};
                ssl[mt] += ((p.x * p.x + p.y * p.y) + (p.z * p.z + p.w * p.w)) + ((q.x * q.x + q.y * q.y) + (q.z * q.z + q.w * q.w));
                const f32x4 pg = p * ga[0], qg = q * ga[1];
                rt_split8(pg, qg, ah[mt], al[mt]);
                int ha = __builtin_amdgcn_cvt_pk_fp8_f32(pg.x, pg.y, 0, false); ha = __builtin_amdgcn_cvt_pk_fp8_f32(pg.z, pg.w, ha, true);
                int hb = __builtin_amdgcn_cvt_pk_fp8_f32(qg.x, qg.y, 0, false); hb = __builtin_amdgcn_cvt_pk_fp8_f32(qg.z, qg.w, hb, true);
                *(GAS v2u*)(H8 + (size_t)(tb + 16 * mt + fr) * DM + kw + 32 * ks) = (v2u){(unsigned)ha, (unsigned)hb}; }
            rt_split8(wa[0][0], wa[0][1], bh[0], bl[0]);
            { const float z = (fr < 4) ? 1.f : 0.f; rt_split8(wa[1][0] * z, wa[1][1] * z, bh[1], bl[1]); }
            if (ks < 7) RT_LD(ks + 1);
#pragma unroll
            for (int mt = 0; mt < 2; ++mt)
#pragma unroll
                for (int nt = 0; nt < 2; ++nt) { acc[mt][nt] = __builtin_amdgcn_mfma_f32_16x16x32_bf16(ah[mt], bh[nt], acc[mt][nt], 0, 0, 0);
                    acc[mt][nt] = __builtin_amdgcn_mfma_f32_16x16x32_bf16(al[mt], bh[nt], acc[mt][nt], 0, 0, 0);
                    acc[mt][nt] = __builtin_amdgcn_mfma_f32_16x16x32_bf16(ah[mt], bl[nt], acc[mt][nt], 0, 0, 0); }
        }
#undef RT_LD
#pragma unroll
        for (int mt = 0; mt < 2; ++mt) { float s = ssl[mt]; s += shfl_xor_l(s, 16, F.lane); s += shfl_xor_l(s, 32, F.lane); if (fq == 0) SS[F.wave * 32 + 16 * mt + fr] = s;
#pragma unroll
            for (int nt = 0; nt < 2; ++nt)
#pragma unroll
                for (int r = 0; r < 4; ++r) PL[(F.wave * 32 + 16 * mt + 4 * fq + r) * 32 + 16 * nt + fr] = acc[mt][nt][r]; }
    }
    __syncthreads();
    float acc[20], ss = 0.f;
#pragma unroll
    for (int o = 0; o < 20; ++o) acc[o] = 0.f;
#pragma unroll
    for (int w = 0; w < 8; ++w) { ss += SS[w * 32 + ts];
#pragma unroll
        for (int o = 0; o < 20; ++o) acc[o] += PL[(w * 32 + ts) * 32 + o]; }
    const float rstd = 1.0f / sqrtf(ss * (1.0f / DM) + EPS);
    {
        float lg0 = acc[0] * rstd + brg[0], lg1 = acc[1] * rstd + brg[1], lg2 = acc[2] * rstd + brg[2], lg3 = acc[3] * rstd + brg[3];
        int grp = 0; float mx = lg0;
        if (lg1 > mx) { mx = lg1; grp = 1; } if (lg2 > mx) { mx = lg2; grp = 2; } if (lg3 > mx) { mx = lg3; grp = 3; }
        const float den = (__expf(lg0 - mx) + __expf(lg1 - mx)) + (__expf(lg2 - mx) + __expf(lg3 - mx));
        const float psel = 1.0f / den;
        const float m0 = (grp == 0) ? 1.f : 0.f, m1 = (grp == 1) ? 1.f : 0.f, m2 = (grp == 2) ? 1.f : 0.f, m3 = (grp == 3) ? 1.f : 0.f;
        float e0v = (m0 * acc[4] + m1 * acc[8]) + (m2 * acc[12] + m3 * acc[16]), e1v = (m0 * acc[5] + m1 * acc[9]) + (m2 * acc[13] + m3 * acc[17]);
        float e2v = (m0 * acc[6] + m1 * acc[10]) + (m2 * acc[14] + m3 * acc[18]), e3v = (m0 * acc[7] + m1 * acc[11]) + (m2 * acc[15] + m3 * acc[19]);
        e0v = e0v * rstd + bre[grp * 4 + 0]; e1v = e1v * rstd + bre[grp * 4 + 1]; e2v = e2v * rstd + bre[grp * 4 + 2]; e3v = e3v * rstd + bre[grp * 4 + 3];
        int i0 = 0; float v0 = e0v;
        if (e1v > v0) { v0 = e1v; i0 = 1; } if (e2v > v0) { v0 = e2v; i0 = 2; } if (e3v > v0) { v0 = e3v; i0 = 3; }
        int i1 = -1; float v1 = -3.0e38f;
        if (i0 != 0 && e0v > v1) { v1 = e0v; i1 = 0; } if (i0 != 1 && e1v > v1) { v1 = e1v; i1 = 1; } if (i0 != 2 && e2v > v1) { v1 = e2v; i1 = 2; } if (i0 != 3 && e3v > v1) { v1 = e3v; i1 = 3; }
        const float ex = __expf(v1 - v0); const float w0 = psel / (1.0f + ex), w1 = psel * ex / (1.0f + ex);
        if (part == 0) { const int ea = grp * 4 + i0, eb = grp * 4 + i1;
            le[ts * 2] = ea; le[ts * 2 + 1] = eb; lw[ts * 2] = w0; lw[ts * 2 + 1] = w1; lr[ts] = rstd;
            lp[ts * 2] = __hip_atomic_fetch_add(lcnt + ea, 1, __ATOMIC_RELAXED, __HIP_MEMORY_SCOPE_WORKGROUP); lp[ts * 2 + 1] = __hip_atomic_fetch_add(lcnt + eb, 1, __ATOMIC_RELAXED, __HIP_MEMORY_SCOPE_WORKGROUP); }
    }
    __syncthreads();
    if (F.tid < 16) lbase[F.tid] = (int)__hip_atomic_fetch_add(gcnt + 64 * F.tid, (unsigned)lcnt[F.tid], RLX_AGENT);
    __syncthreads();
    if (F.tid < 64) { const int t2 = F.tid >> 1; const int e = le[F.tid], pos = lbase[e] + lp[F.tid];
        TOKLIST[e * SEQ + pos] = tb + t2; WLIST[e * SEQ + pos] = lw[F.tid]; RSLIST[e * SEQ + pos] = lr[t2]; TOKPOS[(tb + t2) * 2 + (F.tid & 1)] = (e << 13) | pos; }
}
using pg8::Unit; using pg8::f32x2; using pg8::u32x4; using pg8::u32x2; using pg8::cvt_pk_bf16; using pg8::gelu_pk; using pg8::sigmoid_f;
__device__ __forceinline__ void tile_of(int idx, int nM, int nN, int& pm, int& pn) {
    const int nig = 8 * nN, gid = idx / nig, fm = gid * 8, gsz = (nM - fm) < 8 ? (nM - fm) : 8;
    pm = fm + ((idx % nig) % gsz); pn = (idx % nig) / gsz;
}
__device__ __forceinline__ int xcd_remap(int L, int nwg) { const int q = nwg / 8, r = nwg % 8, xcd = L % 8, off = L / 8; return (xcd < r ? xcd * (q + 1) : r * (q + 1) + (xcd - r) * q) + off; }

struct InProjSched {
    static constexpr bool GATHER = false, WAIT = false, HALF = false;
    const char* XN; const char* WIN; int G, c;
    __device__ __forceinline__ bool next(int i, Unit& u) const {
        const int L = i * G + c; if (L >= 640) return false;
        if (L < 384) { u.kind = 0; tile_of((L & 7) * 48 + (L >> 3), 12, 32, u.pm, u.pn); }
        else if (L < 640) { const int L1 = L - 384; u.kind = 1; tile_of((L1 & 7) * 32 + (L1 >> 3), 32, 8, u.pm, u.pn); }
        else { const int L2 = L - 640; u.kind = 1; tile_of((L2 & 7) * 64 + (L2 >> 3), 32, 16, u.pm, u.pn); u.pn += 8; }
        u.e = 0; u.row0 = 0; u.nvalid = 256; u.rt = 0; u.half = 0; return true;
    }
    __device__ __forceinline__ const char* a_base(const Unit& u) const { return (u.kind == 0 ? WIN : XN) + (size_t)u.pm * (256 * DM * 2); }
    __device__ __forceinline__ const char* b_base(const Unit& u) const { return (u.kind == 0 ? XN : WIN + (size_t)NHY * DM * 2) + (size_t)u.pn * (256 * DM * 2); }
    __device__ __forceinline__ unsigned a_goff(const Unit&, int) const { return 0u; }
};
struct EpiInProj {
    static constexpr bool PERM = true, MIDK = false, FP8 = false;
    bf16 *ZT, *U; const float* bin; gu32 *cz, *cu;
    __device__ __forceinline__ void operator()(const f32x4 (&acc)[2][2][4][2], const Unit& u, int wr, int wc, int fr, int fq) const {
        asm volatile("" : "+v"(fr), "+v"(fq));
        if (u.kind == 0) {
            const __amdgpu_buffer_rsrc_t rz = __builtin_amdgcn_make_buffer_rsrc(ZT, 0, NHY * SEQ * 2, 0x00020000);
            const int row0 = u.pm * 256 + wr * 64 + fr, col0 = u.pn * 256 + wc * 32 + 8 * fq;
            float brow[2][4];
#pragma unroll
            for (int ai = 0; ai < 2; ++ai)
#pragma unroll
                for (int m = 0; m < 4; ++m) brow[ai][m] = ((const GAS float*)bin)[row0 + ai * 128 + m * 16];
#pragma unroll
            for (int ai = 0; ai < 2; ++ai)
#pragma unroll
                for (int m = 0; m < 4; ++m) { const int row = row0 + ai * 128 + m * 16; const float b = brow[ai][m]; bf16* rowp = ZT + (size_t)row * SEQ + col0;
#pragma unroll
                    for (int bj = 0; bj < 2; ++bj) { const f32x4 v0 = acc[ai][bj][m][0] + b, v1 = acc[ai][bj][m][1] + b;
                        u32x4 w; w.x = cvt_pk_bf16(v0[0], v0[1]); w.y = cvt_pk_bf16(v0[2], v0[3]); w.z = cvt_pk_bf16(v1[0], v1[1]); w.w = cvt_pk_bf16(v1[2], v1[3]);
                        __builtin_amdgcn_raw_buffer_store_b128(w, rz, (int)((rowp + bj * 128 - ZT) * 2), 0, 16); } }
            asm volatile("s_waitcnt vmcnt(0)" ::: "memory");
            if (fr == 0 && fq == 0) __hip_atomic_fetch_add(cz + 64 * u.pm, 1u, RLX_AGENT);
        } else {
            const int seg = (u.pn < 4) ? 0 : (u.pn < 8) ? 1 : (u.pn < 16) ? 2 : 3;
            const int colt = (seg == 0) ? u.pn * 256 : (seg == 1) ? (u.pn - 4) * 256 : (seg == 2) ? (u.pn - 8) * 256 : (u.pn - 16) * 256;
            const int row0 = u.pm * 256 + wr * 64 + fr, col0 = colt + wc * 32 + 8 * fq, bcol0 = NHY + u.pn * 256 + wc * 32 + 8 * fq;
            f32x4 bv[2][2];
#pragma unroll
            for (int bj = 0; bj < 2; ++bj)
#pragma unroll
                for (int n = 0; n < 2; ++n) bv[bj][n] = *(const GAS f32x4*)(bin + bcol0 + bj * 128 + 4 * n);
            if (seg < 2) {
                const __amdgpu_buffer_rsrc_t ru = __builtin_amdgcn_make_buffer_rsrc(U, 0, 2 * SEQ * SGW * 2, 0x00020000);
                bf16* base = (bf16*)((char*)U + ((seg == 0) ? (size_t)0 : (size_t)(WS_GV - WS_U)));
#pragma unroll
                for (int ai = 0; ai < 2; ++ai)
#pragma unroll
                    for (int m = 0; m < 4; ++m) { bf16* rowp = base + (size_t)(row0 + ai * 128 + m * 16) * 1024 + col0;
#pragma unroll
                        for (int bj = 0; bj < 2; ++bj) { f32x4 v0 = acc[ai][bj][m][0] + bv[bj][0], v1 = acc[ai][bj][m][1] + bv[bj][1];
                            const f32x2 a = gelu_pk((f32x2){v0[0], v0[1]}), b = gelu_pk((f32x2){v0[2], v0[3]}), c = gelu_pk((f32x2){v1[0], v1[1]}), d = gelu_pk((f32x2){v1[2], v1[3]});
                            u32x4 w; w.x = cvt_pk_bf16(a.x, a.y); w.y = cvt_pk_bf16(b.x, b.y); w.z = cvt_pk_bf16(c.x, c.y); w.w = cvt_pk_bf16(d.x, d.y);
                            __builtin_amdgcn_raw_buffer_store_b128(w, ru, (int)((rowp + bj * 128 - U) * 2), 0, 16); } }
                asm volatile("s_waitcnt vmcnt(0)" ::: "memory");
                if (fr == 0 && fq == 0) __hip_atomic_fetch_add(cu + 64 * u.pm, 1u, RLX_AGENT);
            } else {
                unsigned char* base = (unsigned char*)U + ((seg == 2) ? (size_t)(WS_GH - WS_U) : (size_t)(WS_GS - WS_U));
#pragma unroll
                for (int ai = 0; ai < 2; ++ai)
#pragma unroll
                    for (int m = 0; m < 4; ++m) { unsigned char* rowp = base + (size_t)(row0 + ai * 128 + m * 16) * DM + col0;
#pragma unroll
                        for (int bj = 0; bj < 2; ++bj) { const f32x4 v0 = acc[ai][bj][m][0] + bv[bj][0], v1 = acc[ai][bj][m][1] + bv[bj][1];
                            unsigned w0 = 0u, w1 = 0u;
#pragma unroll
                            for (int j = 0; j < 4; ++j) { w0 = __builtin_amdgcn_cvt_pk_u8_f32(fmaxf(sigmoid_f(v0[j]) * 255.0f, 1.0f), j, w0); w1 = __builtin_amdgcn_cvt_pk_u8_f32(fmaxf(sigmoid_f(v1[j]) * 255.0f, 1.0f), j, w1); }
                            u32x2 w; w.x = w0; w.y = w1; *(GAS u32x2*)(rowp + bj * 128) = w; } }
            }
        }
    }
    __device__ __forceinline__ void mid(f32x4 (&)[2][2][4][2], const Unit&, int, int, int, int) const {}
};
struct GateSched8 {
    static constexpr bool GATHER = false, WAIT = false, HALF = false;
    const char* XN8; const char* W8; int G, c;
    __device__ __forceinline__ bool next(int i, Unit& u) const {
        int idx;
        if (G == 256) { const int x = c & 7, q = c >> 3; if (q < 16) { if (i >= 1) return false; idx = x * 64 + q; } else { if (i >= 3) return false; idx = x * 64 + 16 + 3 * (q - 16) + i; } }
        else { idx = i * G + c; if (idx >= 512) return false; }
        tile_of(idx, 32, 16, u.pm, u.pn); u.kind = 1; u.e = 0; u.row0 = 0; u.nvalid = 256; u.rt = 0; u.half = 0; return true;
    }
    __device__ __forceinline__ const char* a_base(const Unit& u) const { return XN8 + (size_t)u.pm * (256 * DM); }
    __device__ __forceinline__ const char* b_base(const Unit& u) const { return W8 + (size_t)u.pn * (256 * DM); }
    __device__ __forceinline__ unsigned a_goff(const Unit&, int) const { return 0u; }
};
struct EpiGate8 {
    static constexpr bool PERM = true, MIDK = false, FP8 = true;
    unsigned char *GH, *GS; const float* bin;
    __device__ __forceinline__ void operator()(const f32x4 (&acc)[2][2][4][2], const Unit& u, int wr, int wc, int fr, int fq) const {
        asm volatile("" : "+v"(fr), "+v"(fq));
        const int row0 = u.pm * 256 + wr * 64 + fr, col0 = (u.pn & 7) * 256 + wc * 32 + 8 * fq, bcol0 = NHY + (u.pn + 8) * 256 + wc * 32 + 8 * fq;
        f32x4 bv[2][2];
#pragma unroll
        for (int bj = 0; bj < 2; ++bj)
#pragma unroll
            for (int n = 0; n < 2; ++n) bv[bj][n] = *(const GAS f32x4*)(bin + bcol0 + bj * 128 + 4 * n);
        unsigned char* base = (u.pn < 8) ? GH : GS;
#pragma unroll
        for (int ai = 0; ai < 2; ++ai)
#pragma unroll
            for (int m = 0; m < 4; ++m) { unsigned char* rowp = base + (size_t)(row0 + ai * 128 + m * 16) * DM + col0;
#pragma unroll
                for (int bj = 0; bj < 2; ++bj) { const f32x4 v0 = acc[ai][bj][m][0] * (1.0f / 64.0f) + bv[bj][0], v1 = acc[ai][bj][m][1] * (1.0f / 64.0f) + bv[bj][1];
                    unsigned w0 = 0u, w1 = 0u;
#pragma unroll
                    for (int j = 0; j < 4; ++j) { w0 = __builtin_amdgcn_cvt_pk_u8_f32(fmaxf(sigmoid_f(v0[j]) * 255.0f, 1.0f), j, w0); w1 = __builtin_amdgcn_cvt_pk_u8_f32(fmaxf(sigmoid_f(v1[j]) * 255.0f, 1.0f), j, w1); }
                    u32x2 w; w.x = w0; w.y = w1; *(GAS u32x2*)(rowp + bj * 128) = w; } }
    }
    __device__ __forceinline__ void mid(f32x4 (&)[2][2][4][2], const Unit&, int, int, int, int) const {}
};
struct GridSched {
    static constexpr bool GATHER = false, WAIT = false, HALF = false;
    const char* A; const char* Bt; int nM, nN, K, G, c;
    __device__ __forceinline__ bool next(int i, Unit& u) const {
        const int L = i * G + c, nwg = nM * nN; if (L >= nwg) return false;
        tile_of(xcd_remap(L, nwg), nM, nN, u.pm, u.pn); u.kind = 0; u.e = 0; u.row0 = 0; u.nvalid = 256; u.rt = 0; u.half = 0; return true;
    }
    __device__ __forceinline__ const char* a_base(const Unit& u) const { return A + (size_t)u.pm * 512 * K; }
    __device__ __forceinline__ const char* b_base(const Unit& u) const { return Bt + (size_t)u.pn * 512 * K; }
    __device__ __forceinline__ unsigned a_goff(const Unit&, int) const { return 0u; }
};
struct GridSchedW : GridSched {
    static constexpr bool WAIT = true;
    gu32* pcnt; unsigned need; gu32* tmo;
    __device__ __forceinline__ void a_ready(const Unit& u, int wid) const {
        if (wid == 0) { wait_ge(pcnt + 64 * u.pm, need, tmo); __builtin_amdgcn_fence(__ATOMIC_ACQUIRE, "agent"); asm volatile("s_waitcnt vmcnt(0)" ::: "memory"); }
        asm volatile("" ::: "memory"); __builtin_amdgcn_s_barrier(); asm volatile("" ::: "memory");
    }
};
struct EpiMerge {
    static constexpr bool PERM = true, MIDK = true, FP8 = false;
    const unsigned char *GH, *GS; bf16* O; gu32* pcnt;
    __device__ __forceinline__ void mid(f32x4 (&acc)[2][2][4][2], const Unit& u, int wr, int wc, int fr, int fq) const {
        asm volatile("" : "+v"(fr), "+v"(fq));
        const int row0 = u.pm * 256 + wr * 64 + fr, col0 = u.pn * 256 + wc * 32 + 8 * fq;
        u32x2 hb[2][2], sb[2][2];
#define EM_LOAD(g, par) do { const size_t _o = (size_t)(row0 + ((g) >> 2) * 128 + ((g) & 3) * 16) * DM + col0; \
            hb[par][0] = *(const GAS u32x2*)(GH + _o); hb[par][1] = *(const GAS u32x2*)(GH + _o + 128); sb[par][0] = *(const GAS u32x2*)(GS + _o); sb[par][1] = *(const GAS u32x2*)(GS + _o + 128); } while (0)
        EM_LOAD(0, 0);
#pragma unroll
        for (int g = 0; g < 8; ++g) { const int ai = g >> 2, m = g & 3, par = g & 1;
            if (g + 1 < 8) EM_LOAD(g + 1, (g + 1) & 1);
            asm volatile("" ::: "memory");
#pragma unroll
            for (int bj = 0; bj < 2; ++bj) { const unsigned hh[2] = {hb[par][bj].x, hb[par][bj].y}, sv[2] = {sb[par][bj].x, sb[par][bj].y};
#pragma unroll
                for (int n = 0; n < 2; ++n)
#pragma unroll
                    for (int j = 0; j < 4; ++j) acc[ai][bj][m][n][j] *= (float)((hh[n] >> (8 * j)) & 0xffu) * __builtin_amdgcn_rcpf((float)((sv[n] >> (8 * j)) & 0xffu)); }
            asm volatile("" : "+v"(acc[ai][0][m][0]), "+v"(acc[ai][0][m][1]), "+v"(acc[ai][1][m][0]), "+v"(acc[ai][1][m][1])); }
#undef EM_LOAD
    }
    __device__ __forceinline__ void operator()(const f32x4 (&acc)[2][2][4][2], const Unit& u, int wr, int wc, int fr, int fq) const {
        asm volatile("" : "+v"(fr), "+v"(fq));
        const int row0 = u.pm * 256 + wr * 64 + fr, col0 = u.pn * 256 + wc * 32 + 8 * fq;
        u32x2 sb[2][2]; const __amdgpu_buffer_rsrc_t ro = __builtin_amdgcn_make_buffer_rsrc(O, 0, SEQ * DM * 2, 0x00020000);
#define EM_LOAD(g, par) do { const size_t _o = (size_t)(row0 + ((g) >> 2) * 128 + ((g) & 3) * 16) * DM + col0; sb[par][0] = *(const GAS u32x2*)(GS + _o); sb[par][1] = *(const GAS u32x2*)(GS + _o + 128); } while (0)
        EM_LOAD(0, 0); EM_LOAD(1, 1);
#pragma unroll
        for (int g = 0; g < 8; ++g) { const int ai = g >> 2, m = g & 3, par = g & 1; const size_t off = (size_t)(row0 + ai * 128 + m * 16) * DM + col0;
            u32x4 w[2];
#pragma unroll
            for (int bj = 0; bj < 2; ++bj) { const unsigned sv[2] = {sb[par][bj].x, sb[par][bj].y}; float o[8];
#pragma unroll
                for (int n = 0; n < 2; ++n)
#pragma unroll
                    for (int j = 0; j < 4; ++j) o[4 * n + j] = acc[ai][bj][m][n][j] * ((float)((sv[n] >> (8 * j)) & 0xffu) * (1.0f / 255.0f));
                w[bj].x = cvt_pk_bf16(o[0], o[1]); w[bj].y = cvt_pk_bf16(o[2], o[3]); w[bj].z = cvt_pk_bf16(o[4], o[5]); w[bj].w = cvt_pk_bf16(o[6], o[7]); }
            if (g + 2 < 8) EM_LOAD(g + 2, par);
            __builtin_amdgcn_raw_buffer_store_b128(w[0], ro, (int)(off * 2), 0, 16); __builtin_amdgcn_raw_buffer_store_b128(w[1], ro, (int)((off + 128) * 2), 0, 16);
            asm volatile("" ::: "memory"); }
#undef EM_LOAD
        asm volatile("s_waitcnt vmcnt(0)" ::: "memory");
        if (fr == 0 && fq == 0) __hip_atomic_fetch_add(pcnt + 64 * u.pm, 1u, RLX_AGENT);
    }
};
struct EpiResid {
    static constexpr bool PERM = true, MIDK = false, FP8 = false;
    const float* basef; const bf16* baseh; bf16* out; gu32* pcnt;
    __device__ __forceinline__ void operator()(const f32x4 (&acc)[2][2][4][2], const Unit& u, int wr, int wc, int fr, int fq) const {
        asm volatile("" : "+v"(fr), "+v"(fq));
        const int row0 = u.pm * 256 + wr * 64 + fr, col0 = u.pn * 256 + wc * 32 + 8 * fq;
        const __amdgpu_buffer_rsrc_t rx = __builtin_amdgcn_make_buffer_rsrc(out, 0, SEQ * DM * 2, 0x00020000);
        if (basef) {
            f32x4 bb[2][4];
#define ER_LOAD(g, par) do { const size_t _o = (size_t)(row0 + ((g) >> 2) * 128 + ((g) & 3) * 16) * DM + col0; \
                bb[par][0] = *(const GAS f32x4*)(basef + _o); bb[par][1] = *(const GAS f32x4*)(basef + _o + 4); bb[par][2] = *(const GAS f32x4*)(basef + _o + 128); bb[par][3] = *(const GAS f32x4*)(basef + _o + 132); } while (0)
            ER_LOAD(0, 0); ER_LOAD(1, 1);
#pragma unroll
            for (int g = 0; g < 8; ++g) { const int ai = g >> 2, m = g & 3, par = g & 1; const size_t off = (size_t)(row0 + ai * 128 + m * 16) * DM + col0;
                const f32x4 o0 = bb[par][0] + acc[ai][0][m][0], o1 = bb[par][1] + acc[ai][0][m][1], o2 = bb[par][2] + acc[ai][1][m][0], o3 = bb[par][3] + acc[ai][1][m][1];
                if (g + 2 < 8) ER_LOAD(g + 2, par);
                u32x4 w0, w1; w0.x = cvt_pk_bf16(o0[0], o0[1]); w0.y = cvt_pk_bf16(o0[2], o0[3]); w0.z = cvt_pk_bf16(o1[0], o1[1]); w0.w = cvt_pk_bf16(o1[2], o1[3]);
                w1.x = cvt_pk_bf16(o2[0], o2[1]); w1.y = cvt_pk_bf16(o2[2], o2[3]); w1.z = cvt_pk_bf16(o3[0], o3[1]); w1.w = cvt_pk_bf16(o3[2], o3[3]);
                __builtin_amdgcn_raw_buffer_store_b128(w0, rx, (int)(off * 2), 0, 16); __builtin_amdgcn_raw_buffer_store_b128(w1, rx, (int)((off + 128) * 2), 0, 16);
                asm volatile("" ::: "memory"); }
#undef ER_LOAD
        } else {
            u32x4 hb[2][2];
#define ER_LOAD(g, par) do { const size_t _o = (size_t)(row0 + ((g) >> 2) * 128 + ((g) & 3) * 16) * DM + col0; hb[par][0] = *(const GAS u32x4*)(baseh + _o); hb[par][1] = *(const GAS u32x4*)(baseh + _o + 128); } while (0)
            ER_LOAD(0, 0); ER_LOAD(1, 1);
#pragma unroll
            for (int g = 0; g < 8; ++g) { const int ai = g >> 2, m = g & 3, par = g & 1; const size_t off = (size_t)(row0 + ai * 128 + m * 16) * DM + col0;
                u32x4 w[2];
#pragma unroll
                for (int bj = 0; bj < 2; ++bj) { const unsigned hv[4] = {hb[par][bj].x, hb[par][bj].y, hb[par][bj].z, hb[par][bj].w}; const f32x4 v0 = acc[ai][bj][m][0], v1 = acc[ai][bj][m][1];
                    w[bj].x = cvt_pk_bf16(bfl(hv[0]) + v0[0], bfh(hv[0]) + v0[1]); w[bj].y = cvt_pk_bf16(bfl(hv[1]) + v0[2], bfh(hv[1]) + v0[3]);
                    w[bj].z = cvt_pk_bf16(bfl(hv[2]) + v1[0], bfh(hv[2]) + v1[1]); w[bj].w = cvt_pk_bf16(bfl(hv[3]) + v1[2], bfh(hv[3]) + v1[3]); }
                if (g + 2 < 8) ER_LOAD(g + 2, par);
                __builtin_amdgcn_raw_buffer_store_b128(w[0], rx, (int)(off * 2), 0, 16); __builtin_amdgcn_raw_buffer_store_b128(w[1], rx, (int)((off + 128) * 2), 0, 16);
                asm volatile("" ::: "memory"); }
#undef ER_LOAD
        }
        asm volatile("s_waitcnt vmcnt(0)" ::: "memory");
        if (fr == 0 && fq == 0) __hip_atomic_fetch_add(pcnt + 64 * u.pm, 1u, RLX_AGENT);
    }
    __device__ __forceinline__ void mid(f32x4 (&)[2][2][4][2], const Unit&, int, int, int, int) const {}
};
__device__ __forceinline__ void moe_tile_of(const LAS int* tab, int s, int& e, int& j0) {
    const int nfull = __builtin_amdgcn_readfirstlane(tab[68]);
    e = 0;
    if (s < nfull) {
#pragma unroll
        for (int j = 1; j < 16; ++j) e += (__builtin_amdgcn_readfirstlane(tab[52 + j]) <= s) ? 1 : 0;
        j0 = s - __builtin_amdgcn_readfirstlane(tab[52 + e]);
    } else { const int p = s - nfull;
#pragma unroll
        for (int j = 1; j < 16; ++j) e += (__builtin_amdgcn_readfirstlane(tab[70 + j]) <= p) ? 1 : 0;
        j0 = __builtin_amdgcn_readfirstlane(tab[e + 1]) - __builtin_amdgcn_readfirstlane(tab[e]) - 1; }
    e = __builtin_amdgcn_readfirstlane(e); j0 = __builtin_amdgcn_readfirstlane(j0);
}
struct MoeSched1 {
    static constexpr bool GATHER = true, WAIT = false, HALF = true;
    const LAS int* tab; const char* H; const char* W; const int* toklist; int G, c;
    __device__ __forceinline__ bool next(int i, Unit& u) const {
        const int L = i * G + c; const int total = __builtin_amdgcn_readfirstlane(tab[16]) * 4; if (L >= total) return false;
        int e, j0; moe_tile_of(tab, L >> 2, e, j0); const int rt = __builtin_amdgcn_readfirstlane(tab[e]) + j0;
        u.pm = j0; u.pn = L & 3; u.kind = 0; u.e = e; u.rt = rt; u.row0 = __builtin_amdgcn_readfirstlane(tab[17 + e]) + 256 * j0;
        const int rem = __builtin_amdgcn_readfirstlane(tab[34 + e]) - 256 * j0; u.nvalid = rem < 256 ? rem : 256; u.half = __builtin_amdgcn_readfirstlane((rem <= 128) ? 1 : 0); return true;
    }
    __device__ __forceinline__ const char* a_base(const Unit&) const { return H; }
    __device__ __forceinline__ const char* b_base(const Unit& u) const { return W + ((size_t)u.e * 1024 + (size_t)u.pn * 256) * DM; }
    __device__ __forceinline__ unsigned a_goff(const Unit& u, int r) const { const int tk = ((const GAS int*)toklist)[u.e * SEQ + u.pm * 256 + (r < u.nvalid ? r : 0)]; const int tok = (r < u.nvalid) ? tk : 0; return (unsigned)tok * (unsigned)DM; }
};
struct EpiMoe1 {
    static constexpr bool PERM = true, MIDK = false, FP8 = true;
    bf16* ACT; const float* wlist; const float* rslist; gu32* pcnt;
    __device__ __forceinline__ void operator()(const f32x4 (&acc)[2][2][4][2], const Unit& u, int wr, int wc, int fr, int fq) const {
        asm volatile("" : "+v"(fr), "+v"(fq));
        const int col0 = u.pn * 128 + wc * 32 + 8 * fq;
        const __amdgpu_buffer_rsrc_t ra = __builtin_amdgcn_make_buffer_rsrc(ACT, 0, 16640 * DEXP, 0x00020000);
        float wts[2][4], rss[2][4];
#pragma unroll
        for (int ai = 0; ai < 2; ++ai)
#pragma unroll
            for (int m = 0; m < 4; ++m) { const int rl = ai * 128 + wr * 64 + m * 16 + fr, rc = rl < u.nvalid ? rl : 0;
                wts[ai][m] = ((const GAS float*)wlist)[u.e * SEQ + u.pm * 256 + rc]; rss[ai][m] = ((const GAS float*)rslist)[u.e * SEQ + u.pm * 256 + rc]; }
#pragma unroll
        for (int ai = 0; ai < 2; ++ai)
#pragma unroll
            for (int m = 0; m < 4; ++m) { const int rl = ai * 128 + wr * 64 + m * 16 + fr;
                if (rl < u.nvalid) { const float wt = wts[ai][m], rs = rss[ai][m] * (1.0f / 64.0f);
                    const f32x4 g0 = acc[ai][0][m][0], g1 = acc[ai][0][m][1], u0 = acc[ai][1][m][0], u1 = acc[ai][1][m][1];
                    float o[8];
#pragma unroll
                    for (int j = 0; j < 4; ++j) { const float ga = g0[j] * rs, gb = g1[j] * rs; o[j] = ga * sigmoid_f(ga) * (u0[j] * rs) * wt; o[4 + j] = gb * sigmoid_f(gb) * (u1[j] * rs) * wt; }
#pragma unroll
                    for (int j = 0; j < 8; ++j) o[j] = __builtin_amdgcn_fmed3f(o[j] * 8.0f, -440.0f, 440.0f);
                    int wa = __builtin_amdgcn_cvt_pk_fp8_f32(o[0], o[1], 0, false); wa = __builtin_amdgcn_cvt_pk_fp8_f32(o[2], o[3], wa, true);
                    int wb = __builtin_amdgcn_cvt_pk_fp8_f32(o[4], o[5], 0, false); wb = __builtin_amdgcn_cvt_pk_fp8_f32(o[6], o[7], wb, true);
                    __builtin_amdgcn_raw_buffer_store_b64((u32x2){(unsigned)wa, (unsigned)wb}, ra, (int)((size_t)(u.row0 + rl) * DEXP + col0), 0, 16); } }
        asm volatile("s_waitcnt vmcnt(0)" ::: "memory");
        if (fr == 0 && fq == 0) __hip_atomic_fetch_add(pcnt + 64 * u.rt, 1u, RLX_AGENT);
    }
    __device__ __forceinline__ void mid(f32x4 (&)[2][2][4][2], const Unit&, int, int, int, int) const {}
};
struct MoeSched2 {
    static constexpr bool GATHER = false, WAIT = true, HALF = false;
    const LAS int* tab; const char* ACT; const char* W; int G, c; gu32* pcnt; gu32* tmo;
    __device__ __forceinline__ bool next(int i, Unit& u) const {
        if (c < 0) return false;
        const int L = i * G + c; const int total = __builtin_amdgcn_readfirstlane(tab[16]) * 8; if (L >= total) return false;
        int e, j0; moe_tile_of(tab, L >> 3, e, j0); const int rt = __builtin_amdgcn_readfirstlane(tab[e]) + j0;
        u.pm = j0; u.pn = L & 7; u.kind = 0; u.e = e; u.rt = rt; u.row0 = __builtin_amdgcn_readfirstlane(tab[17 + e]) + 256 * j0;
        const int rem = __builtin_amdgcn_readfirstlane(tab[34 + e]) - 256 * j0; u.nvalid = rem < 256 ? rem : 256; u.half = 0; return true;
    }
    __device__ __forceinline__ const char* a_base(const Unit& u) const { return ACT + (size_t)u.row0 * DEXP; }
    __device__ __forceinline__ const char* b_base(const Unit& u) const { return W + ((size_t)u.e * DM + (size_t)u.pn * 256) * DEXP; }
    __device__ __forceinline__ unsigned a_goff(const Unit&, int) const { return 0u; }
    __device__ __forceinline__ void a_ready(const Unit& u, int wid) const {
        if (wid == 0) {
            gu32* p = pcnt + 64 * u.rt; unsigned polls = 0;
            while ((unsigned)__builtin_amdgcn_readfirstlane(__hip_atomic_load(p, RLX_AGENT)) < 32u) {
                if (++polls > (1u << 22)) { if (threadIdx.x == 0) __hip_atomic_store(tmo, 1u, RLX_AGENT); break; }
                __builtin_amdgcn_s_sleep(2); }
            __builtin_amdgcn_fence(__ATOMIC_ACQUIRE, "agent");
            asm volatile("s_waitcnt vmcnt(0)" ::: "memory");
        }
        asm volatile("" ::: "memory"); __builtin_amdgcn_s_barrier(); asm volatile("" ::: "memory");
    }
};
struct EpiMoe2 {
    static constexpr bool PERM = true, MIDK = false, FP8 = true;
    bf16* MO;
    __device__ __forceinline__ void operator()(const f32x4 (&acc)[2][2][4][2], const Unit& u, int wr, int wc, int fr, int fq) const {
        asm volatile("" : "+v"(fr), "+v"(fq));
        const int col0 = u.pn * 256 + wc * 32 + 8 * fq;
#pragma unroll
        for (int ai = 0; ai < 2; ++ai)
#pragma unroll
            for (int m = 0; m < 4; ++m) { const int rl = ai * 128 + wr * 64 + m * 16 + fr;
                if (rl < u.nvalid) { bf16* rowp = MO + (size_t)(u.row0 + rl) * DM + col0;
#pragma unroll
                    for (int bj = 0; bj < 2; ++bj) { const f32x4 v0 = acc[ai][bj][m][0] * (1.0f / 512.0f), v1 = acc[ai][bj][m][1] * (1.0f / 512.0f);
                        u32x4 w; w.x = cvt_pk_bf16(v0[0], v0[1]); w.y = cvt_pk_bf16(v0[2], v0[3]); w.z = cvt_pk_bf16(v1[0], v1[1]); w.w = cvt_pk_bf16(v1[2], v1[3]);
                        *(GAS u32x4*)(rowp + bj * 128) = w; } } }
    }
    __device__ __forceinline__ void mid(f32x4 (&)[2][2][4][2], const Unit&, int, int, int, int) const {}
};
__device__ __forceinline__ void moe_tables(Frame& F, int l) {
    LAS int* tab = (LAS int*)(F.lds + MISC_OFF + 128);
    __syncthreads();
    if (F.tid < 16) tab[34 + F.tid] = (int)__hip_atomic_load(F.ctl + CW_CNT + 64 * (16 * l + F.tid), RLX_AGENT);
    __syncthreads();
    if (F.tid == 0) { int tp = 0, off = 0, fp = 0, pp = 0;
        for (int e = 0; e < 16; ++e) { const int c = tab[34 + e]; tab[e] = tp; tab[17 + e] = off; tab[52 + e] = fp; tab[70 + e] = pp;
            const int nt = (c + 255) >> 8, part = (nt > 0 && (c - 256 * (nt - 1)) <= 128) ? 1 : 0; tp += nt; off += c; fp += nt - part; pp += part; }
        tab[68] = fp; tab[86] = pp;
        tab[16] = tp; tab[33] = off; }
    __syncthreads();
}

struct Args { const float* in[29]; float* out; unsigned char* ws; int ph_lo, ph_hi; };
constexpr int NPHASE = 17;
__global__ void __launch_bounds__(NTHR, 2) fwd_kernel(Args args) {
    extern __shared__ __attribute__((aligned(16))) unsigned char lds[];
    Frame F;
    F.lds = (LAS unsigned char*)lds;
    F.MISC = (volatile LAS unsigned*)(F.lds + MISC_OFF);
    F.tid = threadIdx.x; F.lane = F.tid & 63; F.wave = __builtin_amdgcn_readfirstlane(F.tid >> 6);
    F.G = gridDim.x; { const int bx = blockIdx.x; F.vcu = (F.G % 8 == 0) ? (bx % 8) * (F.G / 8) + bx / 8 : bx; }
    F.ws = args.ws; F.out = args.out; F.ctl = (gu32*)(args.ws + WS_CTL);
    for (int u = F.tid; u < 256; u += NTHR) ((LAS unsigned*)(F.lds + MISC_OFF))[u] = 0u;
    F.inp = (const LAS unsigned long long*)(F.lds + MISC_OFF + 640);
    __syncthreads();
#pragma unroll
    for (int i = 0; i < 29; ++i) if (F.tid == i) ((LAS unsigned long long*)(F.lds + MISC_OFF + 640))[i] = (unsigned long long)args.in[i];
    __syncthreads();
    const int lo = args.ph_lo, hi = args.ph_hi;
    const bool multi = (hi - lo) > 1;
    XcdBarrier bar; bar.bar = (unsigned*)(F.ctl + CW_BAR); bar.x = 0; bar.st = nullptr;
    if (multi) bar = xcd_barrier_post((unsigned*)(F.ctl + CW_BAR), F.MISC + 8);
#ifndef PHASE_MASK
#define PHASE_MASK 0x7ff
#endif
#define IN(k) (lo <= (k) && (k) < hi)
#define ON(j) ((PHASE_MASK >> (j)) & 1)
#ifndef DUP_MASK
#define DUP_MASK 0
#endif
#define REP(j) for (int _rep = 0; _rep < (((DUP_MASK >> (j)) & 1) ? 2 : 1); ++_rep)
#define LAUNDER() do { int _l; asm volatile("v_mbcnt_lo_u32_b32 %0, -1, 0\n\tv_mbcnt_hi_u32_b32 %0, -1, %0" : "=v"(_l)); F.lane = _l; F.tid = F.wave * 64 + _l; { unsigned char* _w = F.ws; asm volatile("" : "+s"(_w)); F.ws = _w; } } while (0)
#ifndef PROBE_K
#define PROBE_K -1
#endif
#ifndef PROBE_PART
#define PROBE_PART 0
#endif
#ifndef PROBE_AMP
#define PROBE_AMP 8
#endif
    volatile LAS unsigned long long* pr = (volatile LAS unsigned long long*)(F.lds + MISC_OFF + 512);
#ifndef PROBE_BLK
#define PROBE_BLK 0
#endif
#define PR_ME (blockIdx.x == PROBE_BLK && threadIdx.x == 0)
#define PSTART(j) do { if (PROBE_K == (j) && PROBE_PART != 1 && PR_ME) pr[0] = __builtin_amdgcn_s_memrealtime(); } while (0)
#define PEND(j) do { if (PROBE_K == (j) && PR_ME) { const unsigned long long _n = __builtin_amdgcn_s_memrealtime(); if (PROBE_PART == 0 || (PROBE_PART == 2 && (j) == 8)) pr[1] += _n - pr[0]; else if (PROBE_PART == 1) pr[0] = _n; } } while (0)
#define PBAR(j) do { if (PROBE_K == (j) && PROBE_PART >= 1 && PR_ME) pr[1] += __builtin_amdgcn_s_memrealtime() - pr[0]; } while (0)
#define SEAM(k) do { if (IN(k) && IN((k) + 1)) xcd_barrier(bar); } while (0)
    const int gw = F.vcu * NWAVES + F.wave, NGW = F.G * NWAVES;
    for (int l = 0; l < DEPTH; ++l) {
        const int p0 = l * 8;
        if (ON(0) && IN(p0 + 0)) { LAUNDER(); PSTART(0);
            PSTART(10); if (l == 0) pa_convert_features(F); PEND(10);
            PSTART(11); if (l == 0) { for (int ll = 0; ll < DEPTH; ++ll) pa_router_t(F, ll); } PEND(11);
            PSTART(13);
            const float* g = inp(F, I_GMIX) + (size_t)l * DM;
            if (l == 0) { for (int m = gw; m < SEQ; m += 4 * NGW) norm_rows<0, false, 4>(F, m, NGW, inp(F, I_X), g, nullptr, nullptr); }
            else { for (int m = gw; m < SEQ; m += 2 * NGW) norm_rows<1, false, 2>(F, m, NGW, nullptr, g, F.ctl + CW_CNT + 64 * 16 * (l - 1), nullptr); }
            PEND(13);
        }
        PEND(0); SEAM(p0 + 0); PBAR(0);
        if (ON(1) && IN(p0 + 1)) { LAUNDER(); PSTART(1);
            InProjSched S{(const char*)(F.ws + WS_XN), (const char*)(F.ws + ((l & 1) ? WS_WIN2 : WS_WIN)), F.G, (int)blockIdx.x};
            EpiInProj E{(bf16*)(F.ws + WS_ZT), (bf16*)(F.ws + WS_U), inp(F, I_BIN) + (size_t)l * NIN, F.ctl + CW_ZT + 64 * 16 * l, F.ctl + CW_UG + 64 * 32 * l};
            REP(1) pg8::gemm_phase<EpiInProj, InProjSched>(F.lds, DM, S, E, F.tid);
            LAUNDER();
            GateSched8 S8{(const char*)(F.ws + WS_XN8), (const char*)(F.ws + WS_WIN8 + (size_t)(l & 1) * 8 * MiB), F.G, (int)blockIdx.x};
            EpiGate8 E8{(unsigned char*)(F.ws + WS_GH), (unsigned char*)(F.ws + WS_GS), inp(F, I_BIN) + (size_t)l * NIN};
            REP(1) pg8::gemm_phase<EpiGate8, GateSched8>(F.lds, DM / 2, S8, E8, F.tid);
        }
        PEND(1); PBAR(1);
        if (ON(2) && IN(p0 + 2)) { LAUNDER(); PSTART(2);
            if (ON(9)) {
                volatile LAS int* qs = (volatile LAS int*)(F.lds + MISC_OFF + 96);
                for (;;) { __syncthreads();
                    if (F.tid == 0) qs[0] = (int)__hip_atomic_fetch_add(F.ctl + CW_SGUQ + 64 * l, 1u, RLX_AGENT);
                    __syncthreads();
                    const int u = __builtin_amdgcn_readfirstlane(qs[0]); if (u >= 256) break;
                    sgu_pair(F, l, u >> 2, u & 3); } }
            if (ON(10)) REP(10) for (int b = F.vcu; b < 256; b += F.G) hyena_block(F, l, b);
        }
        PEND(2); SEAM(p0 + 2); PBAR(2);
        if (ON(3) && IN(p0 + 3)) { LAUNDER(); PSTART(3);
            GridSched S{(const char*)(F.ws + WS_Y), (const char*)(F.ws + WS_PT), 32, 8, DM, F.G, (int)blockIdx.x};
            EpiMerge E{(const unsigned char*)(F.ws + WS_GH), (const unsigned char*)(F.ws + WS_GS), (bf16*)(F.ws + WS_MERGED), F.ctl + CW_MG + 64 * 32 * l};
            REP(3) pg8::gemm_phase<EpiMerge, GridSched>(F.lds, DM, S, E, F.tid);
        }
        PEND(3); PBAR(3);
        if (ON(4) && IN(p0 + 4)) { LAUNDER(); PSTART(4);
            GridSchedW S; S.A = (const char*)(F.ws + WS_MERGED); S.Bt = (const char*)(F.ws + WS_WOT); S.nM = 32; S.nN = 8; S.K = DM; S.G = F.G; S.c = (int)blockIdx.x;
            S.pcnt = F.ctl + CW_MG + 64 * 32 * l; S.need = 64u; S.tmo = F.ctl + CW_TMO;
            EpiResid E{l == 0 ? inp(F, I_X) : nullptr, (const bf16*)(F.ws + WS_XR), (bf16*)(F.ws + WS_XR), F.ctl + CW_XR + 64 * 32 * l};
            REP(4) pg8::gemm_phase<EpiResid, GridSchedW>(F.lds, DM, S, E, F.tid);
        }
        PEND(4); PBAR(4);
        if (ON(5) && IN(p0 + 5)) { LAUNDER(); PSTART(5); for (int tb = F.vcu * 32; tb < SEQ; tb += F.G * 32) route_block(F, l, tb); }
        PEND(5); SEAM(p0 + 5); PBAR(5);
        if (ON(6) && IN(p0 + 6)) { LAUNDER(); PSTART(6);
            moe_tables(F, l);
            gu32* pc = F.ctl + CW_PANEL + 64 * 128 * l;
            {
                MoeSched1 S{(const LAS int*)(F.lds + MISC_OFF + 128), (const char*)(F.ws + WS_XN), (const char*)(F.ws + WS_WGU), (const int*)(F.ws + WS_LISTS), F.G, F.vcu};
                EpiMoe1 E{(bf16*)(F.ws + WS_ACT), (const float*)(F.ws + WS_LISTS + 512 * 1024), (const float*)(F.ws + WS_LISTS + 1 * MiB + 512 * 1024), pc};
                pg8::gemm_phase<EpiMoe1, MoeSched1>(F.lds, DM / 2, S, E, F.tid);
            }
            {
                LAUNDER();
                const int ng = __builtin_amdgcn_readfirstlane(((const LAS int*)(F.lds + MISC_OFF + 128))[16]) * 4;
                int n2 = ng - F.G; n2 = n2 < 0 ? 0 : n2; if (n2 >= F.G) n2 = 0;
                MoeSched2 S{(const LAS int*)(F.lds + MISC_OFF + 128), (const char*)(F.ws + WS_ACT), (const char*)(F.ws + WS_WD), F.G - n2, F.vcu - n2, pc, F.ctl + CW_TMO};
                EpiMoe2 E{(bf16*)(F.ws + WS_MOEOUT)};
                pg8::gemm_phase<EpiMoe2, MoeSched2>(F.lds, DEXP / 2, S, E, F.tid);
            }
        }
        PEND(6); SEAM(p0 + 6); PBAR(6);
    }
    if (ON(8) && IN(16)) { LAUNDER(); PSTART(8); for (int m = gw; m < SEQ; m += 2 * NGW) norm_rows<1, true, 2>(F, m, NGW, nullptr, inp(F, I_GFINAL), F.ctl + CW_CNT + 64 * 16 * (DEPTH - 1), F.out); }
    PEND(8);
    if (PROBE_K >= 0 && PR_ME) { const unsigned long long t0 = __builtin_amdgcn_s_memrealtime(), amt = pr[1] * PROBE_AMP; while (__builtin_amdgcn_s_memrealtime() - t0 < amt) __builtin_amdgcn_s_sleep(8); }
#undef IN
#undef SEAM
}

#ifndef MK_ONE_LAUNCH
#define MK_ONE_LAUNCH 0
#endif
extern "C" void kernel_launch(void* const* d_in, const int* in_sizes, int n_in, void* d_out, int out_size, void* d_ws, size_t ws_size, hipStream_t stream) {
    static int grid = 0;
    if (grid == 0) {
        if (n_in != 29 || ws_size < WS_END) { fprintf(stderr, "kernel_launch: unexpected n_in %d or ws %zu < %zu\n", n_in, ws_size, (size_t)WS_END); grid = -1; return; }
        int dev = 0, cus = 0, per_cu = 0;
        if (hipGetDevice(&dev) != hipSuccess || hipDeviceGetAttribute(&cus, hipDeviceAttributeMultiprocessorCount, dev) != hipSuccess) { grid = -1; return; }
        if (hipFuncSetAttribute((const void*)fwd_kernel, hipFuncAttributeMaxDynamicSharedMemorySize, LDS_BYTES) != hipSuccess) { fprintf(stderr, "kernel_launch: hipFuncSetAttribute failed\n"); grid = -1; return; }
        if (hipOccupancyMaxActiveBlocksPerMultiprocessor(&per_cu, (const void*)fwd_kernel, NTHR, LDS_BYTES) != hipSuccess || per_cu < 1) fprintf(stderr, "kernel_launch: occupancy query reports %d\n", per_cu);
        (void)hipGetLastError();
        grid = cus;
    }
    if (grid < 0) return;
    (void)hipMemsetAsync((char*)d_ws + WS_CTL, 0, CTL_ZERO_BYTES, stream);
    Args a{};
    for (int i = 0; i < 29; ++i) a.in[i] = (const float*)d_in[i];
    a.out = (float*)d_out; a.ws = (unsigned char*)d_ws;
#if MK_ONE_LAUNCH
    a.ph_lo = 0; a.ph_hi = NPHASE;
    hipLaunchKernelGGL(fwd_kernel, dim3(grid), dim3(NTHR), LDS_BYTES, stream, a);
#else
    for (int p = 0; p < NPHASE; ++p) { a.ph_lo = p; a.ph_hi = p + 1; hipLaunchKernelGGL(fwd_kernel, dim3(grid), dim3(NTHR), LDS_BYTES, stream, a); }
#endif
}
```
